# Optimizing an MI355X kernel written in HIP

```python
import math
import jax, jax.numpy as jnp
from jax import lax
import numpy as np

D_MODEL = 2048
BATCH = 1
SEQ = 8192
DEPTH = 4

HEAD_DIM = 64
DIFF_HEADS = D_MODEL // 4 // (2 * HEAD_DIM)
FOX_HEADS = D_MODEL // 4 // HEAD_DIM
NSA_HEADS = D_MODEL // 2 // HEAD_DIM
NSA_GROUPS = 4
NSA_HPG = NSA_HEADS // NSA_GROUPS
CMP_BLOCK = 32
CMP_STRIDE = 16
CMP_HIDDEN = 256
SEL_BLOCK = 64
SEL_TOPK = 16
WINDOW = 512
QBLK = 128
NUM_BUCKETS = 32
MAX_DISTANCE = 128
N_GROUPS = 8
EXPERTS_PER_GROUP = 8
N_EXPERTS = N_GROUPS * EXPERTS_PER_GROUP
TOP_K_EXPERTS = 2
D_EXPERT = D_MODEL // 8
MOE_CHUNK = 128
RMS_EPS = 1e-6
NEG_INF = -1e30
SEL_FORCE = 1e4

SPLIT_SIZES = (
    DIFF_HEADS * 2 * HEAD_DIM,
    DIFF_HEADS * 2 * HEAD_DIM,
    DIFF_HEADS * 2 * HEAD_DIM,
    FOX_HEADS * HEAD_DIM,
    FOX_HEADS * HEAD_DIM,
    FOX_HEADS * HEAD_DIM,
    FOX_HEADS,
    NSA_HEADS * HEAD_DIM,
    NSA_GROUPS * HEAD_DIM,
    NSA_GROUPS * HEAD_DIM,
    NSA_GROUPS * HEAD_DIM,
    NSA_GROUPS * HEAD_DIM,
    NSA_GROUPS * HEAD_DIM,
    NSA_GROUPS * HEAD_DIM,
    3 * NSA_HEADS,
)
D_IN = sum(SPLIT_SIZES)
D_MIX = DIFF_HEADS * 2 * HEAD_DIM + FOX_HEADS * HEAD_DIM + NSA_HEADS * HEAD_DIM

kernel_name = "hybrid_diff_fox_nsa_hmoe"


def rms_norm(x, g):
    x32 = x.astype(jnp.float32)
    y = x32 * lax.rsqrt(jnp.mean(x32 * x32, axis=-1, keepdims=True) + RMS_EPS)
    return (y * g.astype(jnp.float32)).astype(x.dtype)


def masked_softmax(logits, mask):
    return jax.nn.softmax(jnp.where(mask, logits, NEG_INF), axis=-1)


def t5_bucket(rel):
    n = jnp.maximum(rel, 0)
    max_exact = NUM_BUCKETS // 2
    nf = jnp.maximum(n, max_exact).astype(jnp.float32)
    large = max_exact + (jnp.log(nf / max_exact) / math.log(MAX_DISTANCE / max_exact)
                         * (NUM_BUCKETS - max_exact)).astype(jnp.int32)
    return jnp.where(n < max_exact, n, jnp.minimum(large, NUM_BUCKETS - 1))


def diff_attention(q, k, v, lam, bias_table):
    B, S, H = q.shape[:3]
    scale = HEAD_DIM ** -0.5
    kpos = jnp.arange(S)
    k1, k2 = k[:, :, :, 0], k[:, :, :, 1]
    table = bias_table.astype(jnp.float32)

    def block(i):
        q0 = i * QBLK
        qb = lax.dynamic_slice_in_dim(q, q0, QBLK, axis=1)
        rel = (q0 + jnp.arange(QBLK))[:, None] - kpos[None, :]
        mask = rel >= 0
        bias = jnp.transpose(table[t5_bucket(rel)], (2, 0, 1))
        s1 = jnp.einsum('bqhd,bkhd->bhqk', qb[:, :, :, 0], k1).astype(jnp.float32) * scale + bias
        s2 = jnp.einsum('bqhd,bkhd->bhqk', qb[:, :, :, 1], k2).astype(jnp.float32) * scale + bias
        a = masked_softmax(s1, mask) - lam * masked_softmax(s2, mask)
        return jnp.einsum('bhqk,bkhd->bqhd', a.astype(v.dtype), v)

    out = lax.map(block, jnp.arange(S // QBLK))
    return jnp.moveaxis(out, 0, 1).reshape(B, S, H, v.shape[-1])


def forgetting_attention(q, k, v, f_logit, b_f):
    B, S, H, _ = q.shape
    scale = HEAD_DIM ** -0.5
    kpos = jnp.arange(S)
    log_f = jax.nn.log_sigmoid(f_logit.astype(jnp.float32) + b_f.astype(jnp.float32))
    c = jnp.transpose(jnp.cumsum(log_f, axis=1), (0, 2, 1))

    def block(i):
        q0 = i * QBLK
        qb = lax.dynamic_slice_in_dim(q, q0, QBLK, axis=1)
        cq = lax.dynamic_slice_in_dim(c, q0, QBLK, axis=2)
        mask = (q0 + jnp.arange(QBLK))[:, None] >= kpos[None, :]
        s = (jnp.einsum('bqhd,bkhd->bhqk', qb, k).astype(jnp.float32) * scale
             + cq[..., :, None] - c[..., None, :])
        p = masked_softmax(s, mask)
        return jnp.einsum('bhqk,bkhd->bqhd', p.astype(v.dtype), v)

    out = lax.map(block, jnp.arange(S // QBLK))
    return jnp.moveaxis(out, 0, 1).reshape(B, S, H, HEAD_DIM)


def compress(kv, pos, w1, w2):
    B, S, G, Dh = kv.shape
    n_cmp = (S - CMP_BLOCK) // CMP_STRIDE + 1
    idx = CMP_STRIDE * jnp.arange(n_cmp)[:, None] + jnp.arange(CMP_BLOCK)[None, :]
    blocks = kv[:, idx] + pos[None, None, :, None, :]
    flat = jnp.transpose(blocks, (0, 1, 3, 2, 4)).reshape(B, n_cmp, G, CMP_BLOCK * Dh)
    return jax.nn.gelu(flat @ w1) @ w2


def nsa_attention(q, k_cmp, v_cmp, k_slc, v_slc, k_win, v_win, gates,
                  pos_k, w1_k, w2_k, pos_v, w1_v, w2_v, bias_table):
    B, S = q.shape[:2]
    G, HPG, Dh = NSA_GROUPS, NSA_HPG, HEAD_DIM
    scale = Dh ** -0.5
    kc = compress(k_cmp, pos_k, w1_k, w2_k)
    vc = compress(v_cmp, pos_v, w1_v, w2_v)
    n_cmp = kc.shape[1]
    cmp_start = CMP_STRIDE * jnp.arange(n_cmp)
    cmp_end = cmp_start + CMP_BLOCK - 1
    n_sel = S // SEL_BLOCK
    top_k = min(SEL_TOPK, n_sel)
    sel_idx = jnp.arange(n_sel)
    sel_start = SEL_BLOCK * sel_idx
    overlap = jnp.clip(jnp.minimum(cmp_start[:, None] + CMP_BLOCK, sel_start[None, :] + SEL_BLOCK)
                       - jnp.maximum(cmp_start[:, None], sel_start[None, :]), 0, None
                       ).astype(jnp.float32) / CMP_BLOCK
    k_slc_t = jnp.transpose(k_slc, (0, 2, 1, 3))
    v_slc_t = jnp.transpose(v_slc, (0, 2, 1, 3))
    pad = ((0, 0), (WINDOW, 0), (0, 0), (0, 0))
    k_win_p = jnp.pad(k_win, pad)
    v_win_p = jnp.pad(v_win, pad)
    bias_g = bias_table.astype(jnp.float32).reshape(NUM_BUCKETS, G, HPG)
    b_ix = jnp.arange(B)[:, None, None]
    g_ix = jnp.arange(G)[None, :, None]

    def block(i):
        q0 = i * QBLK
        t = q0 + jnp.arange(QBLK)
        qb = lax.dynamic_slice_in_dim(q, q0, QBLK, axis=1).reshape(B, QBLK, G, HPG, Dh)
        gb = lax.dynamic_slice_in_dim(gates, q0, QBLK, axis=1).reshape(B, QBLK, 3, G, HPG)
        s_c = jnp.einsum('bqghd,bngd->bghqn', qb, kc).astype(jnp.float32) * scale
        m_c = cmp_end[None, :] <= t[:, None]
        p_c = masked_softmax(s_c, m_c) * jnp.any(m_c, axis=-1)[:, None].astype(jnp.float32)
        o_c = jnp.einsum('bghqn,bngd->bqghd', p_c.astype(vc.dtype), vc)
        imp = jnp.einsum('bghqn,nj->bgqj', p_c, overlap)
        cur = t // SEL_BLOCK
        forced = ((sel_idx[None, :] == 0) | (sel_idx[None, :] == cur[:, None])
                  | (sel_idx[None, :] == cur[:, None] - 1))
        valid = sel_start[None, :] <= t[:, None]
        score = jnp.where(valid, imp + jnp.where(forced, SEL_FORCE, 0.0), NEG_INF)
        _, blk = lax.top_k(score, top_k)
        tok = (blk[..., None] * SEL_BLOCK + jnp.arange(SEL_BLOCK)).reshape(B, G, -1)
        ks = k_slc_t[b_ix, g_ix, tok].reshape(B, G, QBLK, top_k * SEL_BLOCK, Dh)
        vs = v_slc_t[b_ix, g_ix, tok].reshape(B, G, QBLK, top_k * SEL_BLOCK, Dh)
        rel_s = t[None, None, :, None] - tok.reshape(B, G, QBLK, top_k * SEL_BLOCK)
        b_s = jnp.moveaxis(bias_g[t5_bucket(rel_s), jnp.arange(G)[None, :, None, None]], -1, 2)
        s_s = jnp.einsum('bqghd,bgqkd->bghqk', qb, ks).astype(jnp.float32) * scale + b_s
        p_s = masked_softmax(s_s, (rel_s >= 0)[:, :, None])
        o_s = jnp.einsum('bghqk,bgqkd->bqghd', p_s.astype(vs.dtype), vs)
        kw = lax.dynamic_slice_in_dim(k_win_p, q0, WINDOW + QBLK, axis=1)
        vw = lax.dynamic_slice_in_dim(v_win_p, q0, WINDOW + QBLK, axis=1)
        s_pos = q0 - WINDOW + jnp.arange(WINDOW + QBLK)
        rel_w = t[:, None] - s_pos[None, :]
        m_w = (rel_w >= 0) & (rel_w < WINDOW) & (s_pos[None, :] >= 0)
        b_w = jnp.transpose(bias_g[t5_bucket(rel_w)], (2, 3, 0, 1))
        s_w = jnp.einsum('bqghd,bkgd->bghqk', qb, kw).astype(jnp.float32) * scale + b_w
        p_w = masked_softmax(s_w, m_w)
        o_w = jnp.einsum('bghqk,bkgd->bqghd', p_w.astype(vw.dtype), vw)
        o = (gb[:, :, 0, :, :, None] * o_c + gb[:, :, 1, :, :, None] * o_s
             + gb[:, :, 2, :, :, None] * o_w)
        return o.reshape(B, QBLK, G * HPG * Dh)

    out = lax.map(block, jnp.arange(S // QBLK))
    return jnp.moveaxis(out, 0, 1).reshape(B, S, G * HPG * Dh)


def hier_moe(h, wg, bg, we, be, w_gate, w_up, w_down):
    B, S, D = h.shape
    N = B * S
    xt = h.reshape(N, D)
    g_prob = jax.nn.softmax((xt @ wg).astype(jnp.float32) + bg.astype(jnp.float32), axis=-1)
    g_p, g_idx = lax.top_k(g_prob, 1)
    e_logits = ((xt @ we).astype(jnp.float32) + be.astype(jnp.float32)).reshape(N, N_GROUPS, EXPERTS_PER_GROUP)
    e_in = jnp.take_along_axis(e_logits, g_idx[:, :, None], axis=1)[:, 0]
    e_val, e_loc = lax.top_k(e_in, TOP_K_EXPERTS)
    weight = (g_p * jax.nn.softmax(e_val, axis=-1)).astype(h.dtype)
    eid = g_idx * EXPERTS_PER_GROUP + e_loc
    nk = N * TOP_K_EXPERTS
    flat_e = eid.reshape(-1)
    flat_w = weight.reshape(-1)
    flat_tok = jnp.repeat(jnp.arange(N), TOP_K_EXPERTS)
    order = jnp.argsort(flat_e)
    se, stok, sw = flat_e[order], flat_tok[order], flat_w[order]
    counts = jnp.bincount(flat_e, length=N_EXPERTS)
    start = jnp.cumsum(counts) - counts
    padded = (counts + MOE_CHUNK - 1) // MOE_CHUNK * MOE_CHUNK
    pend = jnp.cumsum(padded)
    dest = (pend - padded)[se] + jnp.arange(nk) - start[se]
    n_chunks = -(-nk // MOE_CHUNK) + N_EXPERTS
    P = n_chunks * MOE_CHUNK
    slot_tok = jnp.zeros((P,), jnp.int32).at[dest].set(stok)
    slot_w = jnp.zeros((P,), h.dtype).at[dest].set(sw)
    chunk_e = jnp.minimum(jnp.searchsorted(pend, jnp.arange(n_chunks) * MOE_CHUNK, side='right'),
                          N_EXPERTS - 1)
    xbuf = xt[slot_tok].reshape(n_chunks, MOE_CHUNK, D)

    def expert_chunk(args):
        xc, e = args
        return (jax.nn.silu(xc @ w_gate[e]) * (xc @ w_up[e])) @ w_down[e]

    ybuf = lax.map(expert_chunk, (xbuf, chunk_e)).reshape(P, D)
    y = jnp.zeros((N, D), h.dtype).at[slot_tok].add(ybuf * slot_w[:, None])
    return y.reshape(B, S, D)


def setup_inputs(seed: int = 0) -> dict:
    key = jax.random.key(seed)
    ks = jax.random.split(key, 24)

    def nrm(k, shape, scale):
        return jax.random.normal(k, shape, jnp.float32) * scale

    return {
        "x": nrm(ks[0], (BATCH, SEQ, D_MODEL), 1.0),
        "ln1": 1.0 + nrm(ks[1], (DEPTH, D_MODEL), 0.02),
        "w_in": nrm(ks[2], (DEPTH, D_MODEL, D_IN), D_MODEL ** -0.5),
        "diff_lambda": nrm(ks[3], (DEPTH, 4, HEAD_DIM), 0.1),
        "diff_subln": 1.0 + nrm(ks[4], (DEPTH, 2 * HEAD_DIM), 0.02),
        "fox_bf": 1.0 + 3.0 * jax.random.uniform(ks[5], (DEPTH, FOX_HEADS), jnp.float32),
        "cmp_pos_k": nrm(ks[6], (DEPTH, CMP_BLOCK, HEAD_DIM), 0.1),
        "cmp_w1_k": nrm(ks[7], (DEPTH, CMP_BLOCK * HEAD_DIM, CMP_HIDDEN), (CMP_BLOCK * HEAD_DIM) ** -0.5),
        "cmp_w2_k": nrm(ks[8], (DEPTH, CMP_HIDDEN, HEAD_DIM), CMP_HIDDEN ** -0.5),
        "cmp_pos_v": nrm(ks[9], (DEPTH, CMP_BLOCK, HEAD_DIM), 0.1),
        "cmp_w1_v": nrm(ks[10], (DEPTH, CMP_BLOCK * HEAD_DIM, CMP_HIDDEN), (CMP_BLOCK * HEAD_DIM) ** -0.5),
        "cmp_w2_v": nrm(ks[11], (DEPTH, CMP_HIDDEN, HEAD_DIM), CMP_HIDDEN ** -0.5),
        "t5_table": nrm(ks[12], (NUM_BUCKETS, DIFF_HEADS + NSA_HEADS), 0.5),
        "w_out": nrm(ks[13], (DEPTH, D_MIX, D_MODEL), D_MIX ** -0.5),
        "ln2": 1.0 + nrm(ks[14], (DEPTH, D_MODEL), 0.02),
        "router_group_w": nrm(ks[15], (DEPTH, D_MODEL, N_GROUPS), D_MODEL ** -0.5),
        "router_group_b": nrm(ks[16], (DEPTH, N_GROUPS), 0.01),
        "router_expert_w": nrm(ks[17], (DEPTH, D_MODEL, N_EXPERTS), D_MODEL ** -0.5),
        "router_expert_b": nrm(ks[18], (DEPTH, N_EXPERTS), 0.01),
        "w_gate": nrm(ks[19], (DEPTH, N_EXPERTS, D_MODEL, D_EXPERT), D_MODEL ** -0.5),
        "w_up": nrm(ks[20], (DEPTH, N_EXPERTS, D_MODEL, D_EXPERT), D_MODEL ** -0.5),
        "w_down": nrm(ks[21], (DEPTH, N_EXPERTS, D_EXPERT, D_MODEL), D_EXPERT ** -0.5),
        "ln_f": 1.0 + nrm(ks[22], (D_MODEL,), 0.02),
    }


def reference(x, ln1, w_in, diff_lambda, diff_subln, fox_bf, cmp_pos_k, cmp_w1_k, cmp_w2_k,
              cmp_pos_v, cmp_w1_v, cmp_w2_v, t5_table, w_out, ln2, router_group_w,
              router_group_b, router_expert_w, router_expert_b, w_gate, w_up, w_down, ln_f):
    B, S, _ = x.shape
    split_points = [int(v) for v in np.cumsum(SPLIT_SIZES)[:-1]]
    t5_a = t5_table[:, :DIFF_HEADS]
    t5_c = t5_table[:, DIFF_HEADS:]
    for l in range(DEPTH):
        h = rms_norm(x, ln1[l])
        proj = h @ w_in[l]
        (a_q, a_k, a_v, b_q, b_k, b_v, b_f, c_q, c_kc, c_vc, c_ks, c_vs, c_kw, c_vw,
         c_g) = jnp.split(proj, split_points, axis=-1)
        dl = diff_lambda[l].astype(jnp.float32)
        lam_init = 0.8 - 0.6 * math.exp(-0.3 * l)
        lam = jnp.exp(jnp.sum(dl[0] * dl[1])) - jnp.exp(jnp.sum(dl[2] * dl[3])) + lam_init
        o_a = diff_attention(a_q.reshape(B, S, DIFF_HEADS, 2, HEAD_DIM),
                             a_k.reshape(B, S, DIFF_HEADS, 2, HEAD_DIM),
                             a_v.reshape(B, S, DIFF_HEADS, 2 * HEAD_DIM), lam, t5_a)
        o_a = rms_norm(o_a, diff_subln[l]) * (1.0 - lam_init)
        o_b = forgetting_attention(b_q.reshape(B, S, FOX_HEADS, HEAD_DIM),
                                   b_k.reshape(B, S, FOX_HEADS, HEAD_DIM),
                                   b_v.reshape(B, S, FOX_HEADS, HEAD_DIM), b_f, fox_bf[l])
        kv_shape = (B, S, NSA_GROUPS, HEAD_DIM)
        o_c = nsa_attention(c_q.reshape(B, S, NSA_HEADS, HEAD_DIM),
                            c_kc.reshape(kv_shape), c_vc.reshape(kv_shape),
                            c_ks.reshape(kv_shape), c_vs.reshape(kv_shape),
                            c_kw.reshape(kv_shape), c_vw.reshape(kv_shape),
                            jax.nn.sigmoid(c_g.reshape(B, S, 3, NSA_HEADS)),
                            cmp_pos_k[l], cmp_w1_k[l], cmp_w2_k[l],
                            cmp_pos_v[l], cmp_w1_v[l], cmp_w2_v[l], t5_c)
        mix = jnp.concatenate([o_a.reshape(B, S, -1), o_b.reshape(B, S, -1), o_c], axis=-1)
        x = x + mix @ w_out[l]
        h = rms_norm(x, ln2[l])
        x = x + hier_moe(h, router_group_w[l], router_group_b[l], router_expert_w[l],
                         router_expert_b[l], w_gate[l], w_up[l], w_down[l])
    return rms_norm(x, ln_f)
```

```cpp
#include <hip/hip_runtime.h>
#include <cstdio>
#include <cstdint>
#include <cmath>
namespace pg8 {
#define PG8_LAS __attribute__((address_space(3)))
typedef unsigned short bf16_t;
typedef short bf16x8 __attribute__((ext_vector_type(8)));
typedef float f32x4 __attribute__((ext_vector_type(4)));
typedef unsigned u32x4 __attribute__((ext_vector_type(4)));
constexpr int BM = 256, BK = 64, HALF = 128, HTB = HALF * BK * 2  , STAGE_BYTES = 8 * HTB, NXCD = 8, WGM = 8;

__host__ __device__ __forceinline__ int lds_byte(int r, int c) { const int st = (r >> 4) * 2 + (c >> 5), rr = r & 15, cc = c & 31, ob = rr * 64 + cc * 2; return st * 1024 + (ob ^ (((ob >> 9) & 1) << 5)); }
__host__ __device__ __forceinline__ void stage_rc(int b, int& R, int& C) { const int st = b / 1024, sb = b % 1024, swz = sb ^ (((sb >> 9) & 1) << 5); R = (st >> 1) * 16 + swz / 64; C = (st & 1) * 32 + (swz % 64) / 2; }
__host__ __device__ __forceinline__ int perm32(int rho) { const int n = rho >> 4, i = rho & 15; return 8 * (i >> 2) + 4 * n + (i & 3); }

struct Unit { int pm, pn; };
struct Gemm { const bf16_t* A; const bf16_t* Bt; int M, N, K; };

struct StaticOrder {
    int nM, nN, nwg, G, c;
    __host__ __device__ void init(int M, int N, int G_, int c_) { nM = M / BM; nN = N / BM; nwg = nM * nN; G = G_; c = c_; }
    __host__ __device__ bool next(int i, Unit& u) const {
        const long L = (long)i * G + c; if (L >= nwg) return false;
        int wgid = (int)L; { const int q = nwg / NXCD, r = nwg % NXCD, xcd = wgid % NXCD, off = wgid / NXCD; wgid = (xcd < r ? xcd * (q + 1) : r * (q + 1) + (xcd - r) * q) + off; }
        const int nig = WGM * nN, gid = wgid / nig, fm = gid * WGM, gsz = (nM - fm) < WGM ? (nM - fm) : WGM;
        u.pm = fm + ((wgid % nig) % gsz); u.pn = (wgid % nig) / gsz; return true;
    }
    __device__ __forceinline__ void a_ready(const Unit&) const {}
    __device__ __forceinline__ void done(const Unit&) const {}
};
__device__ __forceinline__ unsigned cvt_pk_bf16(float lo, float hi) { unsigned r; asm volatile("v_cvt_pk_bf16_f32 %0, %1, %2" : "=v"(r) : "v"(lo), "v"(hi)); return r; }
struct EpiProj {
    static constexpr bool PERM = true, AFTER_DRAIN = false;
    bf16_t* O; float* aux;
    __device__ __forceinline__ void operator()(const f32x4 (&acc)[2][2][4][2], const Unit& u, int wr, int wc, int fr, int fq) const {
        const int row0 = u.pm * BM + wr * 64 + fr;
        if (u.pn < 22) {
            const int col0 = u.pn * BM + wc * 32 + 8 * fq;
#pragma unroll
            for (int ai = 0; ai < 2; ++ai)
#pragma unroll
                for (int m = 0; m < 4; ++m) { bf16_t* rowp = O + (size_t)(row0 + ai * HALF + m * 16) * 5632 + col0;
#pragma unroll
                    for (int bj = 0; bj < 2; ++bj) { const f32x4 v0 = acc[ai][bj][m][0], v1 = acc[ai][bj][m][1];
                        u32x4 w; w.x = cvt_pk_bf16(v0[0], v0[1]); w.y = cvt_pk_bf16(v0[2], v0[3]); w.z = cvt_pk_bf16(v1[0], v1[1]); w.w = cvt_pk_bf16(v1[2], v1[3]);
                        *(u32x4*)(rowp + bj * HALF) = w; } }
        } else if (wc < 2) {
            const int col0 = wc * 32 + 8 * fq;
#pragma unroll
            for (int ai = 0; ai < 2; ++ai)
#pragma unroll
                for (int m = 0; m < 4; ++m) { float* rowp = aux + (size_t)(row0 + ai * HALF + m * 16) * 64 + col0;
                    *(f32x4*)(rowp) = acc[ai][0][m][0]; *(f32x4*)(rowp + 4) = acc[ai][0][m][1]; }
        }
    }
};
struct EpiRes {
    static constexpr bool PERM = false, AFTER_DRAIN = false;
    const float* base; float* out;
    __device__ __forceinline__ void operator()(const f32x4 (&acc)[2][2][4][2], const Unit& u, int wr, int wc, int fr, int fq) const {
        const int row0 = u.pm * BM + wr * 64 + fr, col0 = u.pn * BM + wc * 32 + 4 * fq;
#pragma unroll
        for (int ai = 0; ai < 2; ++ai)
#pragma unroll
            for (int m = 0; m < 4; ++m) { const size_t off = (size_t)(row0 + ai * HALF + m * 16) * 2048 + col0;
#pragma unroll
                for (int bj = 0; bj < 2; ++bj)
#pragma unroll
                    for (int n = 0; n < 2; ++n) { const size_t o = off + bj * HALF + n * 16; *(f32x4*)(out + o) = *(const f32x4*)(base + o) + acc[ai][bj][m][n]; } }
    }
};
template <class Epi, class Sched, bool ALIGN_EPI = false, bool SP2 = false>
__device__ __forceinline__ void gemm_phase(PG8_LAS unsigned char* lds, const Gemm g, const Sched& S, const Epi& E, int wid_in  ) {
    int wid = wid_in; asm volatile("" : "+s"(wid));
    int lane = (int)__builtin_amdgcn_mbcnt_hi(~0u, __builtin_amdgcn_mbcnt_lo(~0u, 0u)); asm volatile("" : "+v"(lane));
    const int tid = wid * 64 + lane, wr = wid >> 2, wc = wid & 3, fr = lane & 15, fq = lane >> 4;
    const int K = g.K, nt = K / BK;
    unsigned voffA[2], voffB[2];
#pragma unroll
    for (int i = 0; i < 2; ++i) { int R, C; stage_rc(tid * 16 + i * 8192, R, C); const int Rb = Epi::PERM ? ((R & ~31) + perm32(R & 31)) : R;
        voffA[i] = (unsigned)(R * K + C) * 2u; voffB[i] = (unsigned)(Rb * K + C) * 2u; }
    const size_t kstep = (size_t)(BK * 2);
    const size_t hstep = (size_t)HALF * K * 2;
    const size_t tstep = 2 * hstep;
    const unsigned ldsw = (unsigned)wid * 1024u;
    const int aoff = lds_byte(wr * 64 + fr, fq * 8), boff = lds_byte(wc * 32 + fr, fq * 8);
#define PG8_SA(b, h) (((b) * 2 + (h)) * HTB)
#define PG8_SB(b, h) ((4 + (b) * 2 + (h)) * HTB)
#define PG8_STAGE(bufoff, gbase, voff) do { _Pragma("unroll") for (int _i = 0; _i < 2; ++_i) \
        __builtin_amdgcn_global_load_lds((const unsigned*)((const char*)(gbase) + (voff)[_i]), (PG8_LAS unsigned*)(lds + (bufoff) + ldsw + _i * 8192), 16, 0, 0); } while (0)
#define PG8_LDA(dst, b, h) do { _Pragma("unroll") for (int m = 0; m < 4; ++m) _Pragma("unroll") for (int k = 0; k < 2; ++k) dst[m][k] = *(const PG8_LAS bf16x8*)(lds + PG8_SA(b, h) + aoff + m * 2048 + k * 1024); } while (0)
#define PG8_LDB(dst, b, h) do { _Pragma("unroll") for (int n = 0; n < 2; ++n) _Pragma("unroll") for (int k = 0; k < 2; ++k) dst[n][k] = *(const PG8_LAS bf16x8*)(lds + PG8_SB(b, h) + boff + n * 2048 + k * 1024); } while (0)
#define PG8_MMA(ai, bj, At, Bt) do { __builtin_amdgcn_s_setprio(1); _Pragma("unroll") for (int m = 0; m < 4; ++m) _Pragma("unroll") for (int n = 0; n < 2; ++n) _Pragma("unroll") for (int k = 0; k < 2; ++k) \
        acc[ai][bj][m][n] = __builtin_amdgcn_mfma_f32_16x16x32_bf16(Bt[n][k], At[m][k], acc[ai][bj][m][n], 0, 0, 0); __builtin_amdgcn_s_setprio(0); } while (0)
#define PG8_WAIT_V(n) asm volatile("s_waitcnt vmcnt(" #n ")" ::: "memory")
#define PG8_WAIT_L(n) asm volatile("s_waitcnt lgkmcnt(" #n ")" ::: "memory")
#define PG8_BAR __builtin_amdgcn_s_barrier()
#define PG8_SCHED __builtin_amdgcn_sched_barrier(0)
    Unit cur, nxt; int ui = 0;
    if (!S.next(0, cur)) return;
    f32x4 acc[2][2][4][2];
#pragma unroll
    for (int a = 0; a < 2; ++a)
#pragma unroll
        for (int b = 0; b < 2; ++b)
#pragma unroll
            for (int m = 0; m < 4; ++m)
#pragma unroll
                for (int n = 0; n < 2; ++n) acc[a][b][m][n] = (f32x4){0.f, 0.f, 0.f, 0.f};
    bf16x8 At[4][2], B0[2][2], B1[2][2];
    const char* cA = (const char*)g.A + (size_t)cur.pm * tstep; const char* cB = (const char*)g.Bt + (size_t)cur.pn * tstep;
    S.a_ready(cur);
    if constexpr (SP2) {
        PG8_STAGE(PG8_SB(0, 0), cB, voffB); PG8_STAGE(PG8_SB(0, 1), cB + hstep, voffB); PG8_STAGE(PG8_SA(0, 0), cA, voffA); PG8_STAGE(PG8_SA(0, 1), cA + hstep, voffA);
        if (wr == 1) PG8_BAR;
        PG8_WAIT_V(2); PG8_BAR;
        PG8_STAGE(PG8_SB(1, 0), cB + kstep, voffB); PG8_STAGE(PG8_SA(1, 0), cA + kstep, voffA); PG8_STAGE(PG8_SB(1, 1), cB + hstep + kstep, voffB);
        PG8_WAIT_V(6); PG8_BAR;
    } else {
        PG8_STAGE(PG8_SB(0, 0), cB, voffB); PG8_STAGE(PG8_SA(0, 0), cA, voffA); PG8_STAGE(PG8_SB(0, 1), cB + hstep, voffB); PG8_STAGE(PG8_SA(0, 1), cA + hstep, voffA);
        if (wr == 1) PG8_BAR;
        PG8_WAIT_V(4); PG8_BAR;
        PG8_STAGE(PG8_SB(1, 0), cB + kstep, voffB); PG8_STAGE(PG8_SA(1, 0), cA + kstep, voffA); PG8_STAGE(PG8_SB(1, 1), cB + hstep + kstep, voffB);
        PG8_WAIT_V(6); PG8_BAR;
    }
    for (;;) {
        const bool has_next = S.next(ui + 1, nxt);
        const char* nA = has_next ? (const char*)g.A + (size_t)nxt.pm * tstep : cA; const char* nB = has_next ? (const char*)g.Bt + (size_t)nxt.pn * tstep : cB;
        for (int t = 0; t < nt; t += 2) {
            const bool last = (t == nt - 2);
            const char* a1 = cA + (size_t)(t + 1) * kstep;
            const char* a2 = last ? nA : cA + (size_t)(t + 2) * kstep; const char* b2 = last ? nB : cB + (size_t)(t + 2) * kstep;
            const char* a3 = a2 + kstep; const char* b3 = b2 + kstep;
            if (last && has_next) S.a_ready(nxt);
            if constexpr (SP2) {
            PG8_LDB(B0, 0, 0); PG8_LDB(B1, 0, 1); PG8_SCHED; PG8_LDA(At, 0, 0); PG8_STAGE(PG8_SA(1, 1), a1 + hstep, voffA);
            PG8_WAIT_V(8); PG8_WAIT_L(0); PG8_BAR; PG8_MMA(0, 0, At, B0); PG8_MMA(0, 1, At, B1); PG8_BAR; PG8_SCHED;
            PG8_LDA(At, 0, 1); PG8_STAGE(PG8_SB(0, 0), b2, voffB); PG8_STAGE(PG8_SB(0, 1), b2 + hstep, voffB); PG8_STAGE(PG8_SA(0, 0), a2, voffA);
            PG8_WAIT_V(8); PG8_WAIT_L(0); PG8_BAR; PG8_MMA(1, 0, At, B0); PG8_MMA(1, 1, At, B1); PG8_BAR; PG8_SCHED;
            PG8_LDB(B0, 1, 0); PG8_LDB(B1, 1, 1); PG8_SCHED; PG8_LDA(At, 1, 0); PG8_STAGE(PG8_SA(0, 1), a2 + hstep, voffA);
            PG8_WAIT_V(8); PG8_WAIT_L(0); PG8_BAR; PG8_MMA(0, 0, At, B0); PG8_MMA(0, 1, At, B1); PG8_BAR; PG8_SCHED;
            PG8_LDA(At, 1, 1); PG8_STAGE(PG8_SB(1, 0), b3, voffB); PG8_STAGE(PG8_SB(1, 1), b3 + hstep, voffB); PG8_STAGE(PG8_SA(1, 0), a3, voffA);
            PG8_WAIT_V(8); PG8_WAIT_L(0); PG8_BAR; PG8_MMA(1, 0, At, B0); PG8_MMA(1, 1, At, B1); PG8_BAR; PG8_SCHED;
            } else {
            PG8_LDB(B0, 0, 0); PG8_SCHED; PG8_LDA(At, 0, 0); PG8_STAGE(PG8_SA(1, 1), a1 + hstep, voffA);
            PG8_WAIT_L(8); PG8_BAR; PG8_WAIT_L(0); PG8_MMA(0, 0, At, B0); PG8_BAR; PG8_SCHED;
            PG8_LDB(B1, 0, 1); PG8_STAGE(PG8_SB(0, 0), b2, voffB);
            PG8_BAR; PG8_WAIT_L(0); PG8_MMA(0, 1, At, B1); PG8_BAR;
            PG8_LDA(At, 0, 1); PG8_STAGE(PG8_SA(0, 0), a2, voffA);
            PG8_BAR; PG8_WAIT_L(0); PG8_MMA(1, 0, At, B0); PG8_BAR; PG8_SCHED;
            PG8_STAGE(PG8_SB(0, 1), b2 + hstep, voffB);
            PG8_WAIT_V(6); PG8_BAR; PG8_MMA(1, 1, At, B1); PG8_BAR;
            PG8_LDB(B0, 1, 0); PG8_SCHED; PG8_LDA(At, 1, 0); PG8_STAGE(PG8_SA(0, 1), a2 + hstep, voffA);
            PG8_WAIT_L(8); PG8_BAR; PG8_WAIT_L(0); PG8_MMA(0, 0, At, B0); PG8_BAR; PG8_SCHED;
            PG8_LDB(B1, 1, 1); PG8_STAGE(PG8_SB(1, 0), b3, voffB);
            PG8_BAR; PG8_WAIT_L(0); PG8_MMA(0, 1, At, B1); PG8_BAR;
            PG8_LDA(At, 1, 1); PG8_STAGE(PG8_SA(1, 0), a3, voffA);
            PG8_BAR; PG8_WAIT_L(0); PG8_MMA(1, 0, At, B0); PG8_BAR; PG8_SCHED;
            PG8_STAGE(PG8_SB(1, 1), b3 + hstep, voffB);
            PG8_WAIT_V(6); PG8_BAR; PG8_MMA(1, 1, At, B1); PG8_BAR;
            }
        }
        if constexpr (ALIGN_EPI) { if (wr == 0) PG8_BAR; }
        if constexpr (!Epi::AFTER_DRAIN) { E(acc, cur, wr, wc, fr, fq); S.done(cur); }
        if (!has_next) break;
#pragma unroll
        for (int a = 0; a < 2; ++a)
#pragma unroll
            for (int b = 0; b < 2; ++b)
#pragma unroll
                for (int m = 0; m < 4; ++m)
#pragma unroll
                    for (int n = 0; n < 2; ++n) acc[a][b][m][n] = (f32x4){0.f, 0.f, 0.f, 0.f};
        cur = nxt; cA = nA; cB = nB; ++ui;
        if constexpr (ALIGN_EPI) { if (wr == 1) PG8_BAR; }
    }
    PG8_WAIT_V(0);
    if constexpr (!ALIGN_EPI) { if (wr == 0) PG8_BAR; }
    PG8_BAR;
    if constexpr (Epi::AFTER_DRAIN) { E.fused(acc, cur, wr, wc, fr, fq, lds, wid, lane); S.done(cur); }
#undef PG8_SA
#undef PG8_SB
#undef PG8_STAGE
#undef PG8_LDA
#undef PG8_LDB
#undef PG8_MMA
#undef PG8_WAIT_V
#undef PG8_WAIT_L
#undef PG8_BAR
#undef PG8_SCHED
}
}
#define GAS __attribute__((address_space(1)))
#define LAS __attribute__((address_space(3)))
typedef unsigned short bf16;
typedef unsigned v4u __attribute__((ext_vector_type(4)));
typedef float f32x4 __attribute__((ext_vector_type(4)));
typedef short bf16x8 __attribute__((ext_vector_type(8)));
typedef GAS unsigned gu32;
typedef GAS unsigned long long gu64;
#define RLX_AGENT __ATOMIC_RELAXED, __HIP_MEMORY_SCOPE_AGENT
#define LDS_WAIT() asm volatile("s_waitcnt lgkmcnt(0)" ::: "memory")
#define VM_WAIT() asm volatile("s_waitcnt vmcnt(0)" ::: "memory")
__device__ __forceinline__ unsigned long long rt() { return __builtin_amdgcn_s_memrealtime(); }
__device__ __forceinline__ unsigned f2bf(float f) { unsigned u = __builtin_bit_cast(unsigned, f); return (u + 0x7fffu + ((u >> 16) & 1u)) >> 16; }
__device__ __forceinline__ unsigned pk2(float lo, float hi) { return f2bf(lo) | (f2bf(hi) << 16); }
#define XB_TMO      128
#define XB_XCNT(j)  (256  + 64 * (j))
#define XB_XSUB(j)  (1280 + 64 * (j))
#define XB_XGEN(j)  (2304 + 64 * (j))
#define XB_TOP      3328
#define XB_TOPGEN   3392
#define XCD_BAR_WORDS 3456
#define XB_SPIN_CAP (1u << 18)

__device__ __forceinline__ unsigned xb_ld(unsigned* p)              { return __hip_atomic_load(p, __ATOMIC_RELAXED, __HIP_MEMORY_SCOPE_AGENT); }
__device__ __forceinline__ unsigned xb_add(unsigned* p, unsigned v) { return __hip_atomic_fetch_add(p, v, __ATOMIC_RELAXED, __HIP_MEMORY_SCOPE_AGENT); }
__device__ __forceinline__ unsigned xb_xcc_id() { return (unsigned)__builtin_amdgcn_s_getreg((3 << 11) | 20) & 0xFu; }
#define XB_SPIN(cond, bar) do { unsigned _sp = 0; while (cond) { __builtin_amdgcn_s_sleep(1); \
    if ((++_sp & 255u) == 0u) { if (xb_ld(&(bar)[XB_TMO])) break; if (_sp > XB_SPIN_CAP) { atomicAdd(&(bar)[XB_TMO], 1u); break; } } } } while (0)

struct XcdBarrier {
    unsigned* bar; unsigned x;
    unsigned w0;
    volatile LAS unsigned* st;
};

__device__ __forceinline__ XcdBarrier xcd_barrier_post(unsigned* bar, volatile LAS unsigned* st) {
    XcdBarrier b; b.bar = bar; b.x = xb_xcc_id(); b.st = st; b.w0 = (__builtin_amdgcn_readfirstlane(threadIdx.x >> 6) == 0) ? 1u : 0u;
    if (threadIdx.x == 0) (void)xb_add(&bar[XB_XCNT(b.x)], 1u);
    return b;
}
__device__ __forceinline__ void xcd_barrier_complete(unsigned* bar, unsigned x, unsigned& nloc, unsigned& nx) {
    const unsigned G = gridDim.x * gridDim.y * gridDim.z;
    unsigned sum, cnt, mine, sp = 0u;
    for (;;) {
        sum = 0u; cnt = 0u; mine = 0u;
#pragma unroll
        for (unsigned j = 0; j < 16; ++j) { const unsigned c = xb_ld(&bar[XB_XCNT(j)]); sum += c; cnt += (c > 0u) ? 1u : 0u; mine = (j == x) ? c : mine; }
        if (sum == G) break;
        __builtin_amdgcn_s_sleep(1);
        if ((++sp & 255u) == 0u) { if (xb_ld(&bar[XB_TMO])) break; if (sp > XB_SPIN_CAP) { atomicAdd(&bar[XB_TMO], 1u); break; } }
    }
    nloc = mine > 0u ? mine : 1u; nx = cnt > 0u ? cnt : 1u;
}

__device__ __forceinline__ void xcd_barrier(const XcdBarrier& b) {
    asm volatile("s_waitcnt vmcnt(0)" ::: "memory");
    __syncthreads();
    if (b.w0 != 0u && __builtin_amdgcn_mbcnt_hi(~0u, __builtin_amdgcn_mbcnt_lo(~0u, 0u)) == 0u) {
        unsigned* bar = b.bar;
        __builtin_amdgcn_s_waitcnt(0);
        unsigned nloc = b.st[0], nx = b.st[1];
        if (nloc == 0u) { xcd_barrier_complete(bar, b.x, nloc, nx); b.st[0] = nloc; b.st[1] = nx; }
        const unsigned old = xb_add(&bar[XB_XSUB(b.x)], 1u);
        const unsigned gen = old / nloc;
        if (old + 1u == (gen + 1u) * nloc) {
            __builtin_amdgcn_fence(__ATOMIC_RELEASE, "agent");
            asm volatile("s_waitcnt vmcnt(0)" ::: "memory");
            const unsigned og = xb_add(&bar[XB_TOP], 1u);
            const unsigned tg = og / nx;
            if (og + 1u == (tg + 1u) * nx) xb_add(&bar[XB_TOPGEN], 1u);
            else XB_SPIN(xb_ld(&bar[XB_TOPGEN]) == tg, bar);
            __builtin_amdgcn_fence(__ATOMIC_ACQUIRE, "agent");
            xb_add(&bar[XB_XGEN(b.x)], 1u);
            asm volatile("s_waitcnt vmcnt(0)" ::: "memory");
        } else {
            XB_SPIN(xb_ld(&bar[XB_XGEN(b.x)]) == gen, bar);
            __builtin_amdgcn_fence(__ATOMIC_ACQUIRE, "agent");
            asm volatile("s_waitcnt vmcnt(0)" ::: "memory");
        }
    }
    __syncthreads();
}
typedef unsigned u32x4 __attribute__((ext_vector_type(4)));

typedef short s16x4 __attribute__((ext_vector_type(4)));
typedef float f32x16 __attribute__((ext_vector_type(16)));
typedef unsigned u32x2 __attribute__((ext_vector_type(2)));
typedef float f32x2v __attribute__((ext_vector_type(2)));

constexpr int S = 8192, D = 2048, DEPTH = 4, DIN = 5688, NP = 5888, PITCH = 5632;
constexpr int C_AQ = 0, C_AK = 512, C_AV = 1024, C_BQ = 1536, C_BK = 2048, C_BV = 2560, C_CQ = 3072, C_KC = 4096, C_VC = 4352, C_KS = 4608, C_VS = 4864, C_KW = 5120, C_VW = 5376;
constexpr float RMS_EPS = 1e-6f, NEG = -1e30f, LOG2E = 1.4426950408889634f, SCL2 = 0.125f * 1.4426950408889634f;
constexpr int NWAVES = 8, NTHR = 512;

constexpr size_t MiB = 1u << 20;
constexpr size_t WS_CTL = 0, CTL_ZERO_BYTES = 1 * MiB;
constexpr size_t WS_WIN = 2 * MiB;
constexpr size_t WS_WOUT = 96 * MiB;
constexpr size_t WS_W1T = 128 * MiB;
constexpr size_t WS_W2T = 136 * MiB;
constexpr size_t WS_RWT = 137 * MiB;
constexpr size_t WS_C1 = 139 * MiB;
constexpr size_t WS_X = 144 * MiB;
constexpr size_t WS_XN = 208 * MiB;
constexpr size_t WS_PROJ = 240 * MiB;
constexpr size_t WS_AUX = 330 * MiB;
constexpr size_t WS_CUM = 332 * MiB;
constexpr size_t WS_KC = 333 * MiB;
constexpr size_t WS_VC = 334 * MiB;
constexpr size_t WS_MIX = 336 * MiB;
constexpr size_t WS_YB = 368 * MiB;
constexpr size_t WS_LIST = 432 * MiB;
constexpr size_t WS_TW = 436 * MiB;
constexpr size_t WS_END = 440 * MiB;
constexpr int CW_BAR = 4096;
constexpr int CW_Q = 8192;
constexpr int CW_CNT = 16384;

constexpr int LDS_BYTES = 160 * 1024;
constexpr int MISC_OFF = 150 * 1024;

struct Args { const float* in[23]; float* out; unsigned char* ws; int ph_lo, ph_hi; };
__device__ __forceinline__ int t5_bucket(int rel) { if (rel < 16) return rel; int b = 16;
    b += rel >= 19; b += rel >= 21; b += rel >= 24; b += rel >= 27; b += rel >= 31; b += rel >= 35; b += rel >= 40; b += rel >= 46; b += rel >= 52; b += rel >= 59; b += rel >= 67; b += rel >= 77; b += rel >= 87; b += rel >= 99; b += rel >= 113; return b; }

__device__ __forceinline__ float bf2f(unsigned short b) { return __uint_as_float((unsigned)b << 16); }
__device__ __forceinline__ float bflo(unsigned w) { return __uint_as_float(w << 16); }
__device__ __forceinline__ float bfhi(unsigned w) { return __uint_as_float(w & 0xffff0000u); }
typedef __bf16 bf16x2_t __attribute__((ext_vector_type(2)));
__device__ __forceinline__ unsigned cvtpk(float lo, float hi) { f32x2v v = {lo, hi}; bf16x2_t b = __builtin_convertvector(v, bf16x2_t); return __builtin_bit_cast(unsigned, b); }
__device__ __forceinline__ unsigned short f2bf16(float f) { return (unsigned short)(cvtpk(f, 0.f) & 0xffffu); }
__device__ __forceinline__ float wave_sum(float v) {
#pragma unroll
    for (int o = 1; o < 64; o <<= 1) v += __shfl_xor(v, o);
    return v;
}
__device__ __forceinline__ int crow(int r, int hi) { return (r & 3) + 8 * (r >> 2) + 4 * hi; }
#define MFMA32(a, b, c) __builtin_amdgcn_mfma_f32_32x32x16_bf16((a), (b), (c), 0, 0, 0)
#define MFMA16(a, b, c) __builtin_amdgcn_mfma_f32_16x16x32_bf16((a), (b), (c), 0, 0, 0)

__device__ __forceinline__ int src_col_win(int n) { if (n < 3072) return n; if (n < 5632) return n + 8; if (n < 5640) return n - 2560; if (n < 5688) return n; return -1; }

template <int MODE>
__device__ __forceinline__ void tr_item(const float* W, const float* W2, int ldw, int K, bf16* WT, int k0, int n0, LAS float* scr, int lane) {
    const int nn = n0 + (lane & 31);
    const float* src = W; int ld = ldw; bool ok = true;
    if (MODE == 0) { src = W + nn; }
    else if (MODE == 1) { const int c = src_col_win(nn); ok = c >= 0; src = W + (ok ? c : 0); }
    else { if (nn < 8) { src = W + nn; ld = 8; } else if (nn < 72) { src = W2 + (nn - 8); ld = 64; } else { ok = false; ld = 8; } }
#pragma unroll 8
    for (int i = 0; i < 32; ++i) { const int kk = 2 * i + (lane >> 5); scr[kk * 33 + (lane & 31)] = ok ? src[(size_t)(k0 + kk) * ld] : 0.f; }
    LDS_WAIT(); asm volatile("" ::: "memory");
    const int c = lane & 7;
#pragma unroll
    for (int j = 0; j < 4; ++j) { const int n = (lane >> 3) + 8 * j; const LAS float* s = scr + (8 * c) * 33 + n;
        v4u o; o.x = pk2(s[0 * 33], s[1 * 33]); o.y = pk2(s[2 * 33], s[3 * 33]); o.z = pk2(s[4 * 33], s[5 * 33]); o.w = pk2(s[6 * 33], s[7 * 33]);
        *(v4u*)(WT + (size_t)(n0 + n) * K + k0 + 8 * c) = o; }
    LDS_WAIT(); asm volatile("" ::: "memory");
}

template <int MODE>
__device__ __forceinline__ void norm_rows(const float* xsrc, float* X, bf16* XN, const bf16* YB, const float* TW, const float* gain, float* out, int gw, int NGW, int lane) {
    for (int row = gw; row < S; row += NGW) {
        const f32x4* xr = (const f32x4*)(xsrc + (size_t)row * D) + lane;
        f32x4 v[8];
#pragma unroll
        for (int j = 0; j < 8; ++j) v[j] = xr[64 * j];
        if (MODE >= 1) {
            const float w0 = TW[2 * row], w1 = TW[2 * row + 1];
            const u32x2* ya = (const u32x2*)(YB + (size_t)(2 * row) * D) + lane; const u32x2* yb = (const u32x2*)(YB + (size_t)(2 * row + 1) * D) + lane;
#pragma unroll
            for (int j = 0; j < 8; ++j) { const u32x2 a = ya[64 * j], b = yb[64 * j];
                v[j].x += w0 * bflo(a.x) + w1 * bflo(b.x); v[j].y += w0 * bfhi(a.x) + w1 * bfhi(b.x);
                v[j].z += w0 * bflo(a.y) + w1 * bflo(b.y); v[j].w += w0 * bfhi(a.y) + w1 * bfhi(b.y); }
        }
        float ss = 0.f;
#pragma unroll
        for (int j = 0; j < 8; ++j) ss += (v[j].x * v[j].x + v[j].y * v[j].y) + (v[j].z * v[j].z + v[j].w * v[j].w);
        ss = wave_sum(ss);
        const float rstd = 1.0f / sqrtf(ss * (1.0f / D) + RMS_EPS);
        if (MODE == 1) { f32x4* xo = (f32x4*)(X + (size_t)row * D) + lane;
#pragma unroll
            for (int j = 0; j < 8; ++j) xo[64 * j] = v[j]; }
        const f32x4* gr = (const f32x4*)gain + lane;
        if (MODE < 2) { u32x2* o8 = (u32x2*)(XN + (size_t)row * D) + lane;
#pragma unroll
            for (int j = 0; j < 8; ++j) { const f32x4 g = gr[64 * j]; u32x2 w; w.x = cvtpk(v[j].x * rstd * g.x, v[j].y * rstd * g.y); w.y = cvtpk(v[j].z * rstd * g.z, v[j].w * rstd * g.w); o8[64 * j] = w; }
        } else { f32x4* oo = (f32x4*)(out + (size_t)row * D) + lane;
#pragma unroll
            for (int j = 0; j < 8; ++j) { const f32x4 g = gr[64 * j]; oo[64 * j] = v[j] * rstd * g; } }
    }
}

__device__ __forceinline__ void p0_prologue(const Args& a, LAS unsigned char* lds, int bid, int G, int tid, int wid, int lane) {
    unsigned char* ws = a.ws;
    LAS float* scr = (LAS float*)(lds + wid * 8448);
    const int gw = bid * NWAVES + wid, NGW = G * NWAVES;
    constexpr int I_WIN = 32 * 184, I_WOUT = 32 * 64, I_W1 = 32 * 8, I_W2 = 4 * 2, I_RW = 32 * 3, I_L = I_WIN + I_WOUT + 2 * I_W1 + 2 * I_W2 + I_RW;
    for (int it = gw; it < DEPTH * I_L; it += NGW) {
        const int l = it / I_L; int r = it % I_L;
        if (r < I_WIN) { tr_item<1>(a.in[2] + (size_t)l * D * DIN, nullptr, DIN, D, (bf16*)(ws + WS_WIN) + (size_t)l * NP * D, 64 * (r / 184), 32 * (r % 184), scr, lane); continue; } r -= I_WIN;
        if (r < I_WOUT) { tr_item<0>(a.in[13] + (size_t)l * D * D, nullptr, D, D, (bf16*)(ws + WS_WOUT) + (size_t)l * D * D, 64 * (r / 64), 32 * (r % 64), scr, lane); continue; } r -= I_WOUT;
        if (r < 2 * I_W1) { const int kv = r / I_W1, q = r % I_W1; tr_item<0>(a.in[kv ? 10 : 7] + (size_t)l * 2048 * 256, nullptr, 256, 2048, (bf16*)(ws + WS_W1T) + (size_t)(l * 2 + kv) * 256 * 2048, 64 * (q / 8), 32 * (q % 8), scr, lane); continue; } r -= 2 * I_W1;
        if (r < 2 * I_W2) { const int kv = r / I_W2, q = r % I_W2; tr_item<0>(a.in[kv ? 11 : 8] + (size_t)l * 256 * 64, nullptr, 64, 256, (bf16*)(ws + WS_W2T) + (size_t)(l * 2 + kv) * 64 * 256, 64 * (q / 2), 32 * (q % 2), scr, lane); continue; } r -= 2 * I_W2;
        tr_item<2>(a.in[15] + (size_t)l * D * 8, a.in[17] + (size_t)l * D * 64, 8, D, (bf16*)(ws + WS_RWT) + (size_t)l * 96 * D, 64 * (r / 3), 32 * (r % 3), scr, lane);
    }
    for (int b = bid; b < 8; b += G) {
        const int l = b >> 1, kv = b & 1; const float* pos = a.in[kv ? 9 : 6] + (size_t)l * 2048; const float* w1 = a.in[kv ? 10 : 7] + (size_t)l * 2048 * 256;
        const int col = tid & 255, half = tid >> 8; float s = 0.f;
        for (int k = half * 1024; k < half * 1024 + 1024; ++k) s += pos[k] * w1[(size_t)k * 256 + col];
        LAS float* red = (LAS float*)(lds + 72 * 1024);
        red[tid] = s; __syncthreads();
        if (tid < 256) ((float*)(ws + WS_C1))[(l * 2 + kv) * 256 + col] = red[tid] + red[tid + 256];
        __syncthreads();
    }
    norm_rows<0>(a.in[0], nullptr, (bf16*)(ws + WS_XN), nullptr, nullptr, a.in[1], nullptr, gw, NGW, lane);
}

__device__ __forceinline__ float gelu_tanh(float x) { const float u = 0.7978845608028654f * (x + 0.044715f * x * x * x); const float t = 1.0f - 2.0f / (__expf(2.0f * u) + 1.0f); return 0.5f * x * (1.0f + t); }

__device__ __forceinline__ void compress_unit(int u, int l, const bf16* PROJ, const bf16* W1T, const bf16* W2T, const float* C1, bf16* KC, bf16* VC, LAS unsigned char* lds, int wid, int lane) {
    const int kv = u >> 6, rb = u & 63, r32 = lane & 31, hi = lane >> 5;
    const int R = 32 * rb + r32, g = R >> 9, n = R & 511;
    const int colb = (kv ? C_VC : C_KC) + 64 * g;
    const bf16* w1 = W1T + (size_t)(l * 2 + kv) * 256 * 2048 + (size_t)(32 * wid + r32) * 2048 + 8 * hi;
    const bf16* arow = PROJ + colb + 8 * hi;
    f32x16 acc = {};
#pragma unroll 4
    for (int s = 0; s < 128; ++s) {
        int tok = 16 * n + (s >> 2); tok = tok > (S - 1) ? (S - 1) : tok;
        const bf16x8 av = *(const bf16x8*)(arow + (size_t)tok * PITCH + (s & 3) * 16);
        const bf16x8 bv = *(const bf16x8*)(w1 + 16 * s);
        acc = MFMA32(av, bv, acc);
    }
    LAS bf16* hid = (LAS bf16*)lds;
    const float c1 = C1[(l * 2 + kv) * 256 + 32 * wid + r32];
#pragma unroll
    for (int r = 0; r < 16; ++r) hid[crow(r, hi) * 264 + 32 * wid + r32] = f2bf16(gelu_tanh(acc[r] + c1));
    __syncthreads();
    if (wid < 2) {
        f32x16 acc2 = {};
        const bf16* w2 = W2T + (size_t)(l * 2 + kv) * 64 * 256 + (size_t)(32 * wid + r32) * 256 + 8 * hi;
#pragma unroll 4
        for (int s = 0; s < 16; ++s) {
            const bf16x8 av = *(const LAS bf16x8*)(hid + r32 * 264 + 16 * s + 8 * hi);
            const bf16x8 bv = *(const bf16x8*)(w2 + 16 * s);
            acc2 = MFMA32(av, bv, acc2);
        }
        bf16* outp = kv ? VC : KC;
#pragma unroll
        for (int r = 0; r < 16; ++r) { const int Rr = 32 * rb + crow(r, hi); outp[(size_t)((Rr >> 9) * 512 + (Rr & 511)) * 64 + 32 * wid + r32] = f2bf16(acc2[r]); }
    }
    __syncthreads();
}

__device__ __forceinline__ void cumsum_unit(int h, int l, const float* AUX, const float* fox_bf, float* CUM, LAS unsigned char* lds, int tid) {
    const float bfv = fox_bf[l * 8 + h];
    float v[16]; float run = 0.f;
#pragma unroll
    for (int i = 0; i < 16; ++i) { const int t = 16 * tid + i; const float z = AUX[(size_t)t * 64 + h] + bfv; const float lf = fminf(z, 0.f) - log1pf(__expf(-fabsf(z))); run += lf; v[i] = run; }
    LAS float* tot = (LAS float*)lds;
    tot[tid] = run; __syncthreads();
    float off = 0.f;
    for (int j = 0; j < tid; ++j) off += tot[j];
#pragma unroll
    for (int i = 0; i < 16; ++i) CUM[(size_t)h * S + 16 * tid + i] = off + v[i];
    __syncthreads();
}

__device__ __forceinline__ int koff(int key, int c) { return c * 1024 + (((key + c) & 63) << 4); }
__device__ __forceinline__ int voff(int key, int c) { return (c >> 2) * 4096 + (key >> 4) * 1024 + (key & 15) * 64 + (c & 3) * 16; }
typedef short v4i16_t __attribute__((ext_vector_type(4)));
__device__ __forceinline__ s16x4 vtr(LAS const unsigned char* p) { return __builtin_bit_cast(s16x4, __builtin_amdgcn_ds_read_tr16_b64_v4i16((LAS v4i16_t*)p)); }

template <int NDT> struct AState { float m, l; f32x16 o[NDT]; };
template <int NDT> __device__ __forceinline__ void astate_init(AState<NDT>& st) { st.m = NEG; st.l = 0.f;
#pragma unroll
    for (int i = 0; i < NDT; ++i) st.o[i] = (f32x16){}; }

__device__ __forceinline__ void qk_tile(f32x16& p0, f32x16& p1, LAS const unsigned char* kt, int kchunk0, const bf16x8 (&qf)[4], int r32, int hi) {
    p0 = (f32x16){}; p1 = (f32x16){};
#pragma unroll
    for (int d0 = 0; d0 < 4; ++d0) {
        const int c = kchunk0 + 2 * d0 + hi;
        const bf16x8 a0 = *(const LAS bf16x8*)(kt + koff(r32, c));
        const bf16x8 a1 = *(const LAS bf16x8*)(kt + koff(r32 + 32, c));
        p0 = MFMA32(a0, qf[d0], p0); p1 = MFMA32(a1, qf[d0], p1);
    }
}
__device__ __forceinline__ void pack_p(bf16x8 (&pw)[4], const f32x16& p0, const f32x16& p1) {
    u32x4 w;
    w.x = cvtpk(p0[0], p0[1]); w.y = cvtpk(p0[2], p0[3]); w.z = cvtpk(p0[4], p0[5]); w.w = cvtpk(p0[6], p0[7]); pw[0] = __builtin_bit_cast(bf16x8, w);
    w.x = cvtpk(p0[8], p0[9]); w.y = cvtpk(p0[10], p0[11]); w.z = cvtpk(p0[12], p0[13]); w.w = cvtpk(p0[14], p0[15]); pw[1] = __builtin_bit_cast(bf16x8, w);
    w.x = cvtpk(p1[0], p1[1]); w.y = cvtpk(p1[2], p1[3]); w.z = cvtpk(p1[4], p1[5]); w.w = cvtpk(p1[6], p1[7]); pw[2] = __builtin_bit_cast(bf16x8, w);
    w.x = cvtpk(p1[8], p1[9]); w.y = cvtpk(p1[10], p1[11]); w.z = cvtpk(p1[12], p1[13]); w.w = cvtpk(p1[14], p1[15]); pw[3] = __builtin_bit_cast(bf16x8, w);
}
template <int NDT>
__device__ __forceinline__ void pv_tile(f32x16 (&o)[NDT], const bf16x8 (&pw)[4], LAS const unsigned char* vt, int lane) {
    const int hi = lane >> 5;
    LAS const unsigned char* vb = vt + ((lane >> 4) & 1) * 32 + (lane & 3) * 8 + (4 * hi + ((lane & 15) >> 2)) * 64;
#pragma unroll
    for (int dt = 0; dt < NDT; ++dt)
#pragma unroll
        for (int s = 0; s < 4; ++s) {
            const s16x4 lo = vtr(vb + dt * 4096 + s * 1024), hh = vtr(vb + dt * 4096 + s * 1024 + 512);
            const bf16x8 vf = (bf16x8){lo[0], lo[1], lo[2], lo[3], hh[0], hh[1], hh[2], hh[3]};
            o[dt] = MFMA32(vf, pw[s], o[dt]);
        }
}
template <int NDT>
__device__ __forceinline__ void softmax_pv(AState<NDT>& st, f32x16& p0, f32x16& p1, LAS const unsigned char* vt, int lane) {
    float mx = fmaxf(p0[0], p1[0]);
#pragma unroll
    for (int r = 1; r < 16; ++r) mx = fmaxf(mx, fmaxf(p0[r], p1[r]));
    mx = fmaxf(mx, __shfl_xor(mx, 32));
    const float mn = fmaxf(st.m, mx), alpha = __builtin_amdgcn_exp2f(st.m - mn); st.m = mn;
    float rs = 0.f;
#pragma unroll
    for (int r = 0; r < 16; ++r) { p0[r] = __builtin_amdgcn_exp2f(p0[r] - mn); p1[r] = __builtin_amdgcn_exp2f(p1[r] - mn); rs += p0[r] + p1[r]; }
    st.l = st.l * alpha + rs;
#pragma unroll
    for (int dt = 0; dt < NDT; ++dt)
#pragma unroll
        for (int r = 0; r < 16; ++r) st.o[dt][r] *= alpha;
    bf16x8 pw[4]; pack_p(pw, p0, p1);
    pv_tile<NDT>(st.o, pw, vt, lane);
}
__device__ __forceinline__ void softmax_stats(float& m, float& l, const f32x16& p0, const f32x16& p1) {
    float mx = fmaxf(p0[0], p1[0]);
#pragma unroll
    for (int r = 1; r < 16; ++r) mx = fmaxf(mx, fmaxf(p0[r], p1[r]));
    mx = fmaxf(mx, __shfl_xor(mx, 32));
    const float mn = fmaxf(m, mx), alpha = __builtin_amdgcn_exp2f(m - mn); m = mn;
    float rs = 0.f;
#pragma unroll
    for (int r = 0; r < 16; ++r) rs += __builtin_amdgcn_exp2f(p0[r] - mn) + __builtin_amdgcn_exp2f(p1[r] - mn);
    l = l * alpha + rs;
}

template <int KCH, int VCH> struct Stage { u32x4 k[KCH / 8], v[VCH / 8]; };
template <int KCH, int VCH>
__device__ __forceinline__ void stage_load(Stage<KCH, VCH>& sg, const bf16* ksrc, const bf16* vsrc, size_t pitch, int key0, int tid) {
#pragma unroll
    for (int i = 0; i < KCH / 8; ++i) { const int idx = tid + 512 * i, key = idx / KCH, c = idx % KCH; sg.k[i] = *(const u32x4*)(ksrc + (size_t)(key0 + key) * pitch + 8 * c); }
#pragma unroll
    for (int i = 0; i < VCH / 8; ++i) { const int idx = tid + 512 * i, key = idx / VCH, c = idx % VCH; sg.v[i] = *(const u32x4*)(vsrc + (size_t)(key0 + key) * pitch + 8 * c); }
}
template <int KCH, int VCH>
__device__ __forceinline__ void stage_write(const Stage<KCH, VCH>& sg, LAS unsigned char* kb, LAS unsigned char* vb, int tid) {
#pragma unroll
    for (int i = 0; i < KCH / 8; ++i) { const int idx = tid + 512 * i, key = idx / KCH, c = idx % KCH; *(LAS u32x4*)(kb + koff(key, c)) = sg.k[i]; }
#pragma unroll
    for (int i = 0; i < VCH / 8; ++i) { const int idx = tid + 512 * i, key = idx / VCH, c = idx % VCH; *(LAS u32x4*)(vb + voff(key, c)) = sg.v[i]; }
}

template <int KCH, int VCH, class Fn>
__device__ __forceinline__ void kv_loop(Fn& fn, const bf16x8 (&qf)[4], int kchunk0, const bf16* ksrc, const bf16* vsrc, size_t pitch, int t_lo, int t_hi,
                                        LAS unsigned char* KB, LAS unsigned char* VB, int tid, int lane) {
    constexpr int KBYTES = KCH * 1024, VBYTES = VCH * 1024;
    const int r32 = lane & 31, hi = lane >> 5;
    Stage<KCH, VCH> sg;
    stage_load<KCH, VCH>(sg, ksrc, vsrc, pitch, 64 * t_lo, tid);
    stage_write<KCH, VCH>(sg, KB, VB, tid);
    __syncthreads();
    for (int t = t_lo; t < t_hi; ++t) {
        const int b = (t - t_lo) & 1;
        if (t + 1 < t_hi) stage_load<KCH, VCH>(sg, ksrc, vsrc, pitch, 64 * (t + 1), tid);
        if (fn.need(t)) {
            f32x16 p0, p1;
            qk_tile(p0, p1, KB + b * KBYTES, kchunk0, qf, r32, hi);
            fn.tile(t, p0, p1, VB + b * VBYTES);
        }
        if (t + 1 < t_hi) stage_write<KCH, VCH>(sg, KB + (b ^ 1) * KBYTES, VB + (b ^ 1) * VBYTES, tid);
        __syncthreads();
    }
}

struct FoxFn {
    AState<2> st; const float* cum; float cq; int tq, tmax, lane;
    __device__ __forceinline__ bool need(int t) const { return 64 * t <= tmax; }
    __device__ __forceinline__ void tile(int t, f32x16& p0, f32x16& p1, LAS const unsigned char* vt) {
        const int hi = lane >> 5, k0 = 64 * t;
#pragma unroll
        for (int a = 0; a < 4; ++a) {
            const f32x4 c0 = *(const f32x4*)(cum + k0 + 8 * a + 4 * hi), c1 = *(const f32x4*)(cum + k0 + 32 + 8 * a + 4 * hi);
#pragma unroll
            for (int i = 0; i < 4; ++i) { const int r = 4 * a + i, key = k0 + 8 * a + 4 * hi + i;
                const float s0 = p0[r] * SCL2 + (cq - c0[i] * LOG2E), s1 = p1[r] * SCL2 + (cq - c1[i] * LOG2E);
                p0[r] = key <= tq ? s0 : NEG; p1[r] = key + 32 <= tq ? s1 : NEG; }
        }
        softmax_pv<2>(st, p0, p1, vt, lane);
    }
};
__device__ __forceinline__ void fox_unit(int h, int qb, const bf16* PROJ, const float* CUM, bf16* MIX, LAS unsigned char* lds, int tid, int wid, int lane) {
    const int r32 = lane & 31, hi = lane >> 5, q0 = 256 * qb, tq = q0 + 32 * wid + r32;
    bf16x8 qf[4];
#pragma unroll
    for (int d0 = 0; d0 < 4; ++d0) qf[d0] = *(const bf16x8*)(PROJ + (size_t)tq * PITCH + C_BQ + 64 * h + 16 * d0 + 8 * hi);
    FoxFn fn; astate_init<2>(fn.st); fn.cum = CUM + (size_t)h * S; fn.cq = fn.cum[tq] * LOG2E; fn.tq = tq; fn.tmax = q0 + 32 * wid + 31; fn.lane = lane;
    kv_loop<8, 8>(fn, qf, 0, PROJ + C_BK + 64 * h, PROJ + C_BV + 64 * h, PITCH, 0, 4 * (qb + 1), lds, lds + 16384, tid, lane);
    const float lt = fn.st.l + __shfl_xor(fn.st.l, 32), inv = 1.0f / lt;
    bf16* orow = MIX + (size_t)tq * D + 512 + 64 * h;
#pragma unroll
    for (int dt = 0; dt < 2; ++dt)
#pragma unroll
        for (int a = 0; a < 4; ++a) { u32x2 w; w.x = cvtpk(fn.st.o[dt][4 * a] * inv, fn.st.o[dt][4 * a + 1] * inv); w.y = cvtpk(fn.st.o[dt][4 * a + 2] * inv, fn.st.o[dt][4 * a + 3] * inv);
            *(u32x2*)(orow + 32 * dt + 8 * a + 4 * hi) = w; }
}

struct DiffFn {
    AState<4> st; LAS const float* lut; int tq, tmin, tmax, lane;
    __device__ __forceinline__ bool need(int t) const { return 64 * t <= tmax; }
    __device__ __forceinline__ void tile(int t, f32x16& p0, f32x16& p1, LAS const unsigned char* vt) {
        const int hi = lane >> 5, k0 = 64 * t;
        if (k0 + 63 + 127 <= tmin) {
            const float b = lut[127];
#pragma unroll
            for (int r = 0; r < 16; ++r) { p0[r] = p0[r] * SCL2 + b; p1[r] = p1[r] * SCL2 + b; }
        } else {
#pragma unroll
            for (int r = 0; r < 16; ++r) { const int rel0 = tq - (k0 + crow(r, hi)); const float b0 = lut[min(max(rel0, 0), 127)]; p0[r] = rel0 >= 0 ? p0[r] * SCL2 + b0 : NEG; }
            __builtin_amdgcn_sched_barrier(0);
#pragma unroll
            for (int r = 0; r < 16; ++r) { const int rel1 = tq - (k0 + 32 + crow(r, hi)); const float b1 = lut[min(max(rel1, 0), 127)]; p1[r] = rel1 >= 0 ? p1[r] * SCL2 + b1 : NEG; }
            __builtin_amdgcn_sched_barrier(0);
        }
        softmax_pv<4>(st, p0, p1, vt, lane);
    }
};
__device__ __forceinline__ void diff_unit(int h, int qb, int l, const Args& a, const bf16* PROJ, bf16* MIX, LAS unsigned char* lds, int tid, int wid, int lane) {
    const int r32 = lane & 31, hi = lane >> 5, q0 = 128 * qb, map = wid & 1, qs = wid >> 1, tq = q0 + 32 * qs + r32;
    LAS float* lut = (LAS float*)(lds + 65536); LAS float* lamw = (LAS float*)(lds + 65536 + 512);
    const float lam_init = 0.8f - 0.6f * expf(-0.3f * (float)l);
    if (tid < 128) lut[tid] = a.in[12][t5_bucket(tid) * 20 + h] * LOG2E;
    if (wid == 0) { const float* dl = a.in[3] + (size_t)l * 256;
        const float s1 = wave_sum(dl[lane] * dl[64 + lane]), s2 = wave_sum(dl[128 + lane] * dl[192 + lane]);
        if (lane == 0) lamw[0] = expf(s1) - expf(s2) + lam_init; }
    bf16x8 qf[4];
#pragma unroll
    for (int d0 = 0; d0 < 4; ++d0) qf[d0] = *(const bf16x8*)(PROJ + (size_t)tq * PITCH + C_AQ + 128 * h + 64 * map + 16 * d0 + 8 * hi);
    DiffFn fn; astate_init<4>(fn.st); fn.lut = lut; fn.tq = tq; fn.tmin = q0 + 32 * qs; fn.tmax = q0 + 32 * qs + 31; fn.lane = lane;
    kv_loop<16, 16>(fn, qf, 8 * map, PROJ + C_AK + 128 * h, PROJ + C_AV + 128 * h, PITCH, 0, 2 * (qb + 1), lds, lds + 32768, tid, lane);
    const float lt = fn.st.l + __shfl_xor(fn.st.l, 32), inv = 1.0f / lt;
    LAS float* ex = (LAS float*)(lds + qs * 16384);
    if (map == 1) {
#pragma unroll
        for (int dt = 0; dt < 4; ++dt)
#pragma unroll
            for (int r = 0; r < 16; ++r) ex[(32 * dt + crow(r, hi)) * 32 + r32] = fn.st.o[dt][r] * inv;
    }
    __syncthreads();
    if (map == 0) {
        const float lam = lamw[0]; float ss = 0.f;
#pragma unroll
        for (int dt = 0; dt < 4; ++dt)
#pragma unroll
            for (int r = 0; r < 16; ++r) { const float v = fn.st.o[dt][r] * inv - lam * ex[(32 * dt + crow(r, hi)) * 32 + r32]; fn.st.o[dt][r] = v; ss += v * v; }
        ss += __shfl_xor(ss, 32);
        const float rstd = (1.0f / sqrtf(ss * (1.0f / 128.0f) + RMS_EPS)) * (1.0f - lam_init);
        const float* sub = a.in[4] + (size_t)l * 128; bf16* orow = MIX + (size_t)tq * D + 128 * h;
#pragma unroll
        for (int dt = 0; dt < 4; ++dt)
#pragma unroll
            for (int q4 = 0; q4 < 4; ++q4) { const int d = 32 * dt + 8 * q4 + 4 * hi; const f32x4 g = *(const f32x4*)(sub + d);
                u32x2 w; w.x = cvtpk(fn.st.o[dt][4 * q4] * rstd * g.x, fn.st.o[dt][4 * q4 + 1] * rstd * g.y); w.y = cvtpk(fn.st.o[dt][4 * q4 + 2] * rstd * g.z, fn.st.o[dt][4 * q4 + 3] * rstd * g.w);
                *(u32x2*)(orow + d) = w; }
    }
    __syncthreads();
}

#define LADD(p, v) (void)__hip_atomic_fetch_add((p), (v), __ATOMIC_RELAXED, __HIP_MEMORY_SCOPE_WORKGROUP)
constexpr int NSA_IMP = 32768, NSA_SELW = 65536, NSA_LUT = 66560, NSA_FIN = 69632;

struct CmpStatFn {
    float m, l; int tq, lane, ncnt;
    __device__ __forceinline__ bool need(int) const { return true; }
    __device__ __forceinline__ void tile(int t, f32x16& p0, f32x16& p1, LAS const unsigned char*) {
        const int hi = lane >> 5, n0 = 64 * t;
#pragma unroll
        for (int r = 0; r < 16; ++r) { const int n = n0 + crow(r, hi);
            p0[r] = (16 * n + 31 <= tq) ? p0[r] * SCL2 : NEG; p1[r] = (16 * (n + 32) + 31 <= tq) ? p1[r] * SCL2 : NEG; }
        softmax_stats(m, l, p0, p1);
    }
};
struct CmpPvFn {
    f32x16 o[2]; float m, invl; int tq, ql, lane; LAS float* imp;
    __device__ __forceinline__ bool need(int) const { return true; }
    __device__ __forceinline__ void tile(int t, f32x16& p0, f32x16& p1, LAS const unsigned char* vt) {
        const int hi = lane >> 5, n0 = 64 * t;
#pragma unroll
        for (int r = 0; r < 16; ++r) { const int n = n0 + crow(r, hi);
            p0[r] = (16 * n + 31 <= tq) ? __builtin_amdgcn_exp2f(p0[r] * SCL2 - m) * invl : 0.f;
            p1[r] = (16 * (n + 32) + 31 <= tq) ? __builtin_amdgcn_exp2f(p1[r] * SCL2 - m) * invl : 0.f; }
        LAS float* row = imp + ql * 128;
#pragma unroll
        for (int a = 0; a < 4; ++a) {
            const int j0 = (n0 >> 2) + 2 * a + hi, j1 = j0 + 8;
            const float h0 = 0.5f * p0[4 * a + 3], h1 = 0.5f * p1[4 * a + 3];
            LADD(row + j0, p0[4 * a] + p0[4 * a + 1] + p0[4 * a + 2] + h0);
            if (j0 + 1 < 128) LADD(row + j0 + 1, h0);
            if (j1 < 128) LADD(row + j1, p1[4 * a] + p1[4 * a + 1] + p1[4 * a + 2] + h1);
            if (j1 + 1 < 128) LADD(row + j1 + 1, h1);
        }
        bf16x8 pw[4]; pack_p(pw, p0, p1);
        pv_tile<2>(o, pw, vt, lane);
    }
};
struct SelFn {
    AState<2> st; LAS const float* lut; int tq, tmin, lane, mode; unsigned sw0, sw1, sw2, sw3, uw0, uw1, uw2, uw3;
    __device__ __forceinline__ unsigned pick(int j, unsigned a, unsigned b, unsigned c, unsigned d) const { const int w = j >> 5; const unsigned x = (w == 0) ? a : (w == 1) ? b : (w == 2) ? c : d; return (x >> (j & 31)) & 1u; }
    __device__ __forceinline__ bool need(int t) const { return mode == 1 || pick(t, uw0, uw1, uw2, uw3) != 0u; }
    __device__ __forceinline__ void tile(int t, f32x16& p0, f32x16& p1, LAS const unsigned char* vt) {
        const int hi = lane >> 5, k0 = 64 * t;
        const bool bit = (mode == 1) || pick(t, sw0, sw1, sw2, sw3) != 0u;
#pragma unroll
        for (int r = 0; r < 16; ++r) { const int rel0 = tq - (k0 + crow(r, hi));
            const float b0 = lut[min(max(rel0, 0), 127)];
            const bool ok0 = bit && rel0 >= 0 && (mode == 0 || rel0 < 512);
            p0[r] = ok0 ? p0[r] * SCL2 + b0 : NEG; }
        __builtin_amdgcn_sched_barrier(0);
#pragma unroll
        for (int r = 0; r < 16; ++r) { const int rel1 = tq - (k0 + 32 + crow(r, hi));
            const float b1 = lut[min(max(rel1, 0), 127)];
            const bool ok1 = bit && rel1 >= 0 && (mode == 0 || rel1 < 512);
            p1[r] = ok1 ? p1[r] * SCL2 + b1 : NEG; }
        __builtin_amdgcn_sched_barrier(0);
        softmax_pv<2>(st, p0, p1, vt, lane);
    }
};

__device__ __forceinline__ void nsa_unit(int g, int qb, const Args& a, const bf16* PROJ, const float* AUX, const bf16* KC, const bf16* VC, bf16* MIX, LAS unsigned char* lds, int tid, int wid, int lane) {
    const int r32 = lane & 31, hi = lane >> 5, q0 = 64 * qb, cur = qb, ql = 8 * wid + (r32 >> 2), hp = r32 & 3, tq = q0 + ql, head = 4 * g + hp;
    LAS float* imp = (LAS float*)(lds + NSA_IMP); LAS unsigned* selw = (LAS unsigned*)(lds + NSA_SELW); LAS float* lut = (LAS float*)(lds + NSA_LUT);
#pragma unroll
    for (int i = 0; i < 16; ++i) imp[tid + 512 * i] = 0.f;
    if (tid < 256) selw[tid] = 0u;
    lut[tid] = a.in[12][t5_bucket(tid & 127) * 20 + 4 + 4 * g + (tid >> 7)] * LOG2E;
    bf16x8 qf[4];
#pragma unroll
    for (int d0 = 0; d0 < 4; ++d0) qf[d0] = *(const bf16x8*)(PROJ + (size_t)tq * PITCH + C_CQ + 64 * head + 16 * d0 + 8 * hi);
    const float* ga = AUX + (size_t)tq * 64 + 8 + head;
    const float gc = 1.0f / (1.0f + __expf(-ga[0])), gs = 1.0f / (1.0f + __expf(-ga[16])), gwn = 1.0f / (1.0f + __expf(-ga[32]));
    LAS float* finl = (LAS float*)(lds + NSA_FIN) + tid;
    {
        int ncnt = (q0 + 32) / 16 + 1; ncnt = ncnt > 511 ? 511 : ncnt; const int ntc = (ncnt + 63) >> 6;
        const bf16* kc = KC + (size_t)g * 512 * 64; const bf16* vc = VC + (size_t)g * 512 * 64;
        CmpStatFn f1; f1.m = NEG; f1.l = 0.f; f1.tq = tq; f1.lane = lane; f1.ncnt = ncnt;
        kv_loop<8, 8>(f1, qf, 0, kc, vc, 64, 0, ntc, lds, lds + 16384, tid, lane);
        const float lt = f1.l + __shfl_xor(f1.l, 32);
        CmpPvFn f2; f2.o[0] = (f32x16){}; f2.o[1] = (f32x16){}; f2.m = f1.m; f2.invl = (tq >= 31) ? 1.0f / lt : 0.f; f2.tq = tq; f2.ql = ql; f2.lane = lane; f2.imp = imp;
        kv_loop<8, 8>(f2, qf, 0, kc, vc, 64, 0, ntc, lds, lds + 16384, tid, lane);
#pragma unroll
        for (int r = 0; r < 16; ++r) { finl[512 * r] = gc * f2.o[0][r]; finl[512 * (16 + r)] = gc * f2.o[1][r]; }
    }
    if (cur < 16) { if (tid < 64) selw[tid * 4] = (2u << cur) - 1u; }
    else {
        const int qq = tid >> 3, sub = tid & 7;
        float val[16];
#pragma unroll
        for (int i = 0; i < 16; ++i) { const int j = 16 * sub + i; val[i] = (j >= 1 && j <= cur - 2) ? imp[qq * 128 + j] : -1.0f; }
        unsigned bits = 0u;
        for (int round = 0; round < 13; ++round) {
            float bv = val[0]; int bi = 0;
#pragma unroll
            for (int i = 1; i < 16; ++i) if (val[i] > bv) { bv = val[i]; bi = i; }
            int gj = 16 * sub + bi;
#pragma unroll
            for (int off = 1; off < 8; off <<= 1) { const float ov = __shfl_xor(bv, off); const int oj = __shfl_xor(gj, off); if (ov > bv || (ov == bv && oj < gj)) { bv = ov; gj = oj; } }
            const bool mine = (gj >> 4) == sub;
#pragma unroll
            for (int i = 0; i < 16; ++i) if (mine && (gj & 15) == i) { val[i] = -2.0f; bits |= 1u << i; }
        }
        if (sub == 0) bits |= 1u;
        if (((cur - 1) >> 4) == sub) bits |= 1u << ((cur - 1) & 15);
        if ((cur >> 4) == sub) bits |= 1u << (cur & 15);
        (void)__hip_atomic_fetch_or(selw + qq * 4 + (sub >> 1), bits << (16 * (sub & 1)), __ATOMIC_RELAXED, __HIP_MEMORY_SCOPE_WORKGROUP);
    }
    __syncthreads();
    SelFn fs; fs.lut = lut + hp * 128; fs.tq = tq; fs.tmin = q0 + 8 * wid; fs.lane = lane;
    fs.sw0 = selw[ql * 4 + 0]; fs.sw1 = selw[ql * 4 + 1]; fs.sw2 = selw[ql * 4 + 2]; fs.sw3 = selw[ql * 4 + 3];
    { unsigned u0 = 0u, u1 = 0u, u2 = 0u, u3 = 0u;
#pragma unroll
      for (int i = 0; i < 8; ++i) { u0 |= selw[(8 * wid + i) * 4 + 0]; u1 |= selw[(8 * wid + i) * 4 + 1]; u2 |= selw[(8 * wid + i) * 4 + 2]; u3 |= selw[(8 * wid + i) * 4 + 3]; }
      fs.uw0 = __builtin_amdgcn_readfirstlane(u0); fs.uw1 = __builtin_amdgcn_readfirstlane(u1); fs.uw2 = __builtin_amdgcn_readfirstlane(u2); fs.uw3 = __builtin_amdgcn_readfirstlane(u3); }
    fs.mode = 0; astate_init<2>(fs.st);
    kv_loop<8, 8>(fs, qf, 0, PROJ + C_KS + 64 * g, PROJ + C_VS + 64 * g, PITCH, 0, cur + 1, lds, lds + 16384, tid, lane);
    { const float lt = fs.st.l + __shfl_xor(fs.st.l, 32), sc = gs / lt;
#pragma unroll
      for (int r = 0; r < 16; ++r) { finl[512 * r] += sc * fs.st.o[0][r]; finl[512 * (16 + r)] += sc * fs.st.o[1][r]; } }
    fs.mode = 1; astate_init<2>(fs.st);
    kv_loop<8, 8>(fs, qf, 0, PROJ + C_KW + 64 * g, PROJ + C_VW + 64 * g, PITCH, cur >= 8 ? cur - 8 : 0, cur + 1, lds, lds + 16384, tid, lane);
    { const float lt = fs.st.l + __shfl_xor(fs.st.l, 32), sc = gwn / lt;
#pragma unroll
      for (int r = 0; r < 16; ++r) { fs.st.o[0][r] = finl[512 * r] + sc * fs.st.o[0][r]; fs.st.o[1][r] = finl[512 * (16 + r)] + sc * fs.st.o[1][r]; } }
    bf16* orow = MIX + (size_t)tq * D + 1024 + 64 * head;
#pragma unroll
    for (int dt = 0; dt < 2; ++dt)
#pragma unroll
        for (int q4 = 0; q4 < 4; ++q4) { u32x2 w; w.x = cvtpk(fs.st.o[dt][4 * q4], fs.st.o[dt][4 * q4 + 1]); w.y = cvtpk(fs.st.o[dt][4 * q4 + 2], fs.st.o[dt][4 * q4 + 3]); *(u32x2*)(orow + 32 * dt + 8 * q4 + 4 * hi) = w; }
}

__device__ __forceinline__ int dequeue(unsigned* head, volatile LAS unsigned* slot, int tid) {
    if (tid == 0) *slot = __hip_atomic_fetch_add(head, 1u, __ATOMIC_RELAXED, __HIP_MEMORY_SCOPE_AGENT);
    __syncthreads();
    const int v = (int)*slot;
    __syncthreads();
    return v;
}

constexpr int N2_HP = 4112, N2_PART = 66 * 1024, N2_LOG = 108 * 1024;
__device__ __forceinline__ void n2_unit(int u, int l, const Args& a, const float* X, bf16* XN, const bf16* RWT, unsigned* cnt, int* LIST, float* TW, LAS unsigned char* lds, int tid, int wid, int lane) {
    const float* gain = a.in[14] + (size_t)l * D;
#pragma unroll
    for (int rr = 0; rr < 2; ++rr) {
        const int lr = 2 * wid + rr, row = 16 * u + lr;
        const f32x4* xr = (const f32x4*)(X + (size_t)row * D) + lane;
        f32x4 v[8]; float ss = 0.f;
#pragma unroll
        for (int j = 0; j < 8; ++j) { v[j] = xr[64 * j]; ss += (v[j].x * v[j].x + v[j].y * v[j].y) + (v[j].z * v[j].z + v[j].w * v[j].w); }
        ss = wave_sum(ss);
        const float rstd = 1.0f / sqrtf(ss * (1.0f / D) + RMS_EPS);
        const f32x4* gr = (const f32x4*)gain + lane; u32x2* o8 = (u32x2*)(XN + (size_t)row * D) + lane;
#pragma unroll
        for (int j = 0; j < 8; ++j) { const f32x4 g = gr[64 * j]; u32x2 w; w.x = cvtpk(v[j].x * rstd * g.x, v[j].y * rstd * g.y); w.y = cvtpk(v[j].z * rstd * g.z, v[j].w * rstd * g.w);
            o8[64 * j] = w; *(LAS u32x2*)(lds + lr * N2_HP + (4 * lane + 256 * j) * 2) = w; }
    }
    __syncthreads();
    {
        const int fr = lane & 15, fq = lane >> 4;
        f32x4 acc[5];
#pragma unroll
        for (int nt = 0; nt < 5; ++nt) acc[nt] = (f32x4){0.f, 0.f, 0.f, 0.f};
        const bf16* rw = RWT + (size_t)l * 96 * D + (size_t)fr * D + 256 * wid + 8 * fq;
#pragma unroll
        for (int s = 0; s < 8; ++s) {
            const bf16x8 av = *(const LAS bf16x8*)(lds + fr * N2_HP + (256 * wid + 32 * s + 8 * fq) * 2);
#pragma unroll
            for (int nt = 0; nt < 5; ++nt) { const bf16x8 bv = *(const bf16x8*)(rw + (size_t)(16 * nt) * D + 32 * s); acc[nt] = MFMA16(av, bv, acc[nt]); }
        }
        LAS float* part = (LAS float*)(lds + N2_PART) + wid * 16 * 80;
#pragma unroll
        for (int nt = 0; nt < 5; ++nt)
#pragma unroll
            for (int i = 0; i < 4; ++i) part[(4 * fq + i) * 80 + 16 * nt + fr] = acc[nt][i];
    }
    __syncthreads();
    {
        LAS const float* part = (LAS const float*)(lds + N2_PART); LAS float* logit = (LAS float*)(lds + N2_LOG);
        for (int e = tid; e < 16 * 80; e += NTHR) { float s = 0.f;
#pragma unroll
            for (int w = 0; w < 8; ++w) s += part[w * 16 * 80 + e];
            logit[e] = s; }
    }
    __syncthreads();
    if (tid < 16) {
        LAS const float* lg = (LAS const float*)(lds + N2_LOG) + tid * 80;
        const float* bg = a.in[16] + l * 8; const float* be = a.in[18] + l * 64;
        float z[8]; float zm = -3.0e38f; int gi = 0;
#pragma unroll
        for (int i = 0; i < 8; ++i) { z[i] = lg[i] + bg[i]; if (z[i] > zm) { zm = z[i]; gi = i; } }
        float den = 0.f;
#pragma unroll
        for (int i = 0; i < 8; ++i) den += expf(z[i] - zm);
        const float gp = 1.0f / den;
        float e1 = -3.0e38f, e2 = -3.0e38f; int i1 = 0, i2 = 0;
#pragma unroll
        for (int i = 0; i < 8; ++i) { const float v = lg[8 + 8 * gi + i] + be[8 * gi + i];
            if (v > e1) { e2 = e1; i2 = i1; e1 = v; i1 = i; } else if (v > e2) { e2 = v; i2 = i; } }
        const float t2 = expf(e2 - e1), w1 = gp / (1.0f + t2), w2 = gp * t2 / (1.0f + t2);
        const int tok = 16 * u + tid, ea = 8 * gi + i1, eb = 8 * gi + i2;
        const unsigned pa = __hip_atomic_fetch_add(cnt + ea * 16, 1u, __ATOMIC_RELAXED, __HIP_MEMORY_SCOPE_AGENT);
        const unsigned pb = __hip_atomic_fetch_add(cnt + eb * 16, 1u, __ATOMIC_RELAXED, __HIP_MEMORY_SCOPE_AGENT);
        LIST[(size_t)ea * 16384 + pa] = 2 * tok; LIST[(size_t)eb * 16384 + pb] = 2 * tok + 1;
        TW[2 * tok] = w1; TW[2 * tok + 1] = w2;
    }
    __syncthreads();
}

constexpr int MO_B = 65536, MO_A = 131072, MO_APITCH = 2176, MO_ABUF = 4 * MO_APITCH, MO_ROW = MO_A + 2 * MO_ABUF, MO_PRE = MO_ROW + 512;
static_assert(MO_PRE + 272 <= MISC_OFF, "MoE LDS map");
__device__ __forceinline__ int mo_aoff(int row, int c) { return c * MO_APITCH + ((row + 2 * c) << 4); }
__device__ __forceinline__ int mo_hoff(int row, int c) { return c * 2048 + (row << 4); }

struct MoBStage { f32x4 v[4]; };
__device__ __forceinline__ void mo_bload(MoBStage& sg, const float* src0, const float* src1, size_t ld, int k0, int hb, int tid) {
    const int n4 = tid & 127, kg = tid >> 7;
    const float* p = (n4 < 64 ? src0 + 4 * n4 : src1 + 4 * (n4 - 64)) + (size_t)(k0 + 8 * kg + 4 * hb) * ld;
#pragma unroll
    for (int j = 0; j < 4; ++j) sg.v[j] = *(const f32x4*)(p + (size_t)j * ld);
}
__device__ __forceinline__ void mo_bwrite(const MoBStage& sg, LAS unsigned char* bb, int hb, int tid) {
    const int n4 = tid & 127, kg = tid >> 7;
#pragma unroll
    for (int i = 0; i < 4; ++i) { u32x2 w; w.x = cvtpk(sg.v[0][i], sg.v[1][i]); w.y = cvtpk(sg.v[2][i], sg.v[3][i]);
        *(LAS u32x2*)(bb + kg * 8192 + (32 * (n4 >> 3) + 8 * i + (n4 & 7)) * 16 + 8 * hb) = w; }
}
#define MO_KSTEP(ACC0, ACC1, AP, BP, B1OFF) do { \
        const bf16x8 b0_ = *(const LAS bf16x8*)(BP), b1_ = *(const LAS bf16x8*)((BP) + (B1OFF)); \
        _Pragma("unroll") for (int mt = 0; mt < 4; ++mt) { const bf16x8 af_ = *(const LAS bf16x8*)((AP) + mt * 512); \
            ACC0[mt] = MFMA32(af_, b0_, ACC0[mt]); ACC1[mt] = MFMA32(af_, b1_, ACC1[mt]); } } while (0)

__device__ __forceinline__ void moe_unit(int e, int c0, int nrows, const bf16* XN, const int* LIST, const float* Wg, const float* Wu, const float* Wd, bf16* YB, LAS unsigned char* lds, int tid, int wid, int lane) {
    const int r32 = lane & 31, hi = lane >> 5;
    LAS int* rowid = (LAS int*)(lds + MO_ROW);
    if (tid < 128) rowid[tid] = (tid < nrows) ? LIST[(size_t)e * 16384 + c0 + tid] : -1;
    __syncthreads();
    const float* wg = Wg + (size_t)e * D * 256; const float* wu = Wu + (size_t)e * D * 256; const float* wd = Wd + (size_t)e * 256 * D;
    f32x16 accg[4], accu[4];
#pragma unroll
    for (int i = 0; i < 4; ++i) { accg[i] = (f32x16){}; accu[i] = (f32x16){}; }
    const int arow = tid >> 2, ac = tid & 3; const int rid = rowid[arow]; const bf16* asrc = XN + (size_t)((rid < 0 ? 0 : rid) >> 1) * D + 8 * ac;
    LAS unsigned char* const awr = lds + MO_A + mo_aoff(arow, ac);
    LAS const unsigned char* const ard = lds + MO_A + mo_aoff(r32, hi);
    LAS const unsigned char* const brd = lds + MO_B + hi * 8192 + (32 * wid + r32) * 16;
    MoBStage sg; u32x4 areg;
    mo_bload(sg, wg, wu, 256, 0, 0, tid); mo_bwrite(sg, lds + MO_B, 0, tid);
    mo_bload(sg, wg, wu, 256, 0, 1, tid); mo_bwrite(sg, lds + MO_B, 1, tid);
    areg = *(const u32x4*)(asrc); *(LAS u32x4*)(awr) = areg;
    __syncthreads();
    for (int ks = 0; ks < 64; ++ks) {
        const int b = ks & 1; const bool more = ks + 1 < 64;
        LAS unsigned char* const bnx = lds + MO_B + (b ^ 1) * 32768;
        if (more) { mo_bload(sg, wg, wu, 256, 32 * (ks + 1), 0, tid); areg = *(const u32x4*)(asrc + 32 * (ks + 1)); }
        MO_KSTEP(accg, accu, ard + b * MO_ABUF, brd + b * 32768, 4096);
        if (more) { mo_bwrite(sg, bnx, 0, tid); *(LAS u32x4*)(awr + (b ^ 1) * MO_ABUF) = areg; mo_bload(sg, wg, wu, 256, 32 * (ks + 1), 1, tid); }
        MO_KSTEP(accg, accu, ard + b * MO_ABUF + 2 * MO_APITCH + 64, brd + b * 32768 + 16384, 4096);
        if (more) mo_bwrite(sg, bnx, 1, tid);
        __syncthreads();
    }
    {
        const int col = 32 * wid + 4 * (r32 & 7) + (r32 >> 3), cch = col >> 3;
#pragma unroll
        for (int mt = 0; mt < 4; ++mt)
#pragma unroll
            for (int r = 0; r < 16; ++r) { const float gt = accg[mt][r], up = accu[mt][r]; const float hv = gt / (1.0f + __expf(-gt)) * up;
                *(LAS unsigned short*)(lds + mo_hoff(32 * mt + crow(r, hi), cch) + (col & 7) * 2) = f2bf16(hv); }
    }
    mo_bload(sg, wd, wd + 256, D, 0, 0, tid); mo_bwrite(sg, lds + MO_B, 0, tid);
    mo_bload(sg, wd, wd + 256, D, 0, 1, tid); mo_bwrite(sg, lds + MO_B, 1, tid);
    __syncthreads();
#pragma unroll
    for (int i = 0; i < 4; ++i) { accg[i] = (f32x16){}; accu[i] = (f32x16){}; }
    LAS const unsigned char* const hrd = lds + mo_hoff(r32, hi);
    LAS const unsigned char* const brd2 = lds + MO_B + hi * 8192 + (64 * wid + r32) * 16;
    for (int st = 0; st < 32; ++st) {
        const int b = st & 1, pass = st >> 3, kk = st & 7; const bool more = st + 1 < 32;
        const int p1 = (st + 1) >> 3, k1 = (st + 1) & 7;
        LAS unsigned char* const bnx = lds + MO_B + (b ^ 1) * 32768;
        if (more) mo_bload(sg, wd + 512 * p1, wd + 512 * p1 + 256, D, 32 * k1, 0, tid);
        MO_KSTEP(accg, accu, hrd + kk * 8192, brd2 + b * 32768, 512);
        if (more) { mo_bwrite(sg, bnx, 0, tid); mo_bload(sg, wd + 512 * p1, wd + 512 * p1 + 256, D, 32 * k1, 1, tid); }
        MO_KSTEP(accg, accu, hrd + kk * 8192 + 4096, brd2 + b * 32768 + 16384, 512);
        if (more) mo_bwrite(sg, bnx, 1, tid);
        if (kk == 7) {
            const int colb = 512 * pass + 64 * wid + 4 * (r32 & 7) + (r32 >> 3);
#pragma unroll
            for (int mt = 0; mt < 4; ++mt)
#pragma unroll
                for (int r = 0; r < 16; ++r) { const int rr = rowid[32 * mt + crow(r, hi)];
                    if (rr >= 0) { bf16* yo = YB + (size_t)rr * D + colb; yo[0] = f2bf16(accg[mt][r]); yo[32] = f2bf16(accu[mt][r]); } }
#pragma unroll
            for (int i = 0; i < 4; ++i) { accg[i] = (f32x16){}; accu[i] = (f32x16){}; }
        }
        __syncthreads();
    }
}

constexpr int N_PHASES = 1 + 7 * DEPTH;
#ifndef PH_MASK
#define PH_MASK 0xFFFF
#endif
#define PHON(k) (((PH_MASK) >> (k)) & 1)
#ifndef MK_ONE_LAUNCH
#define MK_ONE_LAUNCH 0
#endif

__global__ void __launch_bounds__(NTHR, 2) fwd_kernel(Args args) {
    extern __shared__ __attribute__((aligned(16))) unsigned char lds_raw[];
    LAS unsigned char* lds = (LAS unsigned char*)lds_raw;
    volatile LAS unsigned* MISC = (volatile LAS unsigned*)(lds + MISC_OFF);
    const int wid = __builtin_amdgcn_readfirstlane(threadIdx.x >> 6);
    const int G = gridDim.x, bid = blockIdx.x;
    unsigned char* ws = args.ws;
    unsigned* ctl = (unsigned*)(ws + WS_CTL);
    if (threadIdx.x < 64) MISC[threadIdx.x] = 0u;
    __syncthreads();
    const int lo = args.ph_lo, hi_ph = args.ph_hi;
    XcdBarrier bar; bar.bar = ctl + CW_BAR; bar.x = 0; bar.st = MISC + 8; bar.w0 = 0;
    if (hi_ph - lo > 1) bar = xcd_barrier_post(ctl + CW_BAR, MISC + 8);
#define IN(k) (lo <= (k) && (k) < hi_ph)
#define FRESH() int wid_ = wid; asm volatile("" : "+s"(wid_)); int lane_ = (int)__builtin_amdgcn_mbcnt_hi(~0u, __builtin_amdgcn_mbcnt_lo(~0u, 0u)); asm volatile("" : "+v"(lane_)); const int tid_ = wid_ * 64 + lane_; (void)tid_
#define SEAM(k) do { if (IN(k) && IN((k) + 1)) xcd_barrier(bar); } while (0)

    bf16* WIN = (bf16*)(ws + WS_WIN); bf16* WOUT = (bf16*)(ws + WS_WOUT); bf16* W1T = (bf16*)(ws + WS_W1T); bf16* W2T = (bf16*)(ws + WS_W2T); bf16* RWT = (bf16*)(ws + WS_RWT);
    float* C1 = (float*)(ws + WS_C1); float* X = (float*)(ws + WS_X); bf16* XN = (bf16*)(ws + WS_XN); bf16* PROJ = (bf16*)(ws + WS_PROJ); float* AUX = (float*)(ws + WS_AUX);
    float* CUM = (float*)(ws + WS_CUM); bf16* KC = (bf16*)(ws + WS_KC); bf16* VC = (bf16*)(ws + WS_VC); bf16* MIX = (bf16*)(ws + WS_MIX); bf16* YB = (bf16*)(ws + WS_YB);
    int* LIST = (int*)(ws + WS_LIST); float* TW = (float*)(ws + WS_TW);
    const int NGW = G * NWAVES;

    if (PHON(0) && IN(0)) { FRESH(); p0_prologue(args, lds, bid, G, tid_, wid_, lane_); }
    SEAM(0);

    for (int l = 0; l < DEPTH; ++l) {
        const int pb = 1 + 7 * l;
        if (PHON(1) && IN(pb)) {
            pg8::Gemm g{XN, WIN + (size_t)l * NP * D, S, NP, D}; pg8::StaticOrder so; so.init(S, NP, G, bid);
            pg8::EpiProj E{PROJ, AUX};
            pg8::gemm_phase<pg8::EpiProj, pg8::StaticOrder, true, true>(lds, g, so, E, wid);
        }
        SEAM(pb);
        if (PHON(2) && IN(pb + 1)) {
            FRESH();
            for (int u = bid; u < 136; u += G) {
                if (u < 128) compress_unit(u, l, PROJ, W1T, W2T, C1, KC, VC, lds, wid_, lane_);
                else cumsum_unit(u - 128, l, AUX, args.in[5], CUM, lds, tid_);
            }
        }
        SEAM(pb + 1);
        if (IN(pb + 2)) {
            unsigned* qh = ctl + CW_Q + (l * 4) * 64;
            if (PHON(3)) { FRESH(); for (;;) { const int i = dequeue(qh, MISC + 16, tid_); if (i >= 256) break; fox_unit(i & 7, 31 - (i >> 3), PROJ, CUM, MIX, lds, tid_, wid_, lane_); } }
            if (PHON(4)) { FRESH(); for (;;) { const int i = dequeue(qh + 64, MISC + 17, tid_); if (i >= 256) break; diff_unit(i & 3, 63 - (i >> 2), l, args, PROJ, MIX, lds, tid_, wid_, lane_); } }
            if (PHON(5)) { FRESH(); for (;;) { const int i = dequeue(qh + 128, MISC + 18, tid_); if (i >= 512) break; nsa_unit(i & 3, 127 - (i >> 2), args, PROJ, AUX, KC, VC, MIX, lds, tid_, wid_, lane_); } }
        }
        SEAM(pb + 2);
        if (PHON(6) && IN(pb + 3)) {
            pg8::Gemm g{MIX, WOUT + (size_t)l * D * D, S, D, D}; pg8::StaticOrder so; so.init(S, D, G, bid);
            pg8::EpiRes E{l == 0 ? args.in[0] : X, X};
            pg8::gemm_phase<pg8::EpiRes, pg8::StaticOrder, true, true>(lds, g, so, E, wid);
        }
        SEAM(pb + 3);
        if (PHON(7) && IN(pb + 4)) {
            FRESH();
            for (int u = bid; u < S / 16; u += G) n2_unit(u, l, args, X, XN, RWT, ctl + CW_CNT + l * 1024, LIST, TW, lds, tid_, wid_, lane_);
        }
        SEAM(pb + 4);
        if (PHON(8) && IN(pb + 5)) {
            FRESH();
            LAS int* pre = (LAS int*)(lds + MO_PRE);
            if (tid_ == 0) { int s = 0; for (int e = 0; e < 64; ++e) { pre[e] = s; const int c = (int)__hip_atomic_load(ctl + CW_CNT + l * 1024 + e * 16, __ATOMIC_RELAXED, __HIP_MEMORY_SCOPE_AGENT); s += (c + 127) >> 7; } pre[64] = s; }
            __syncthreads();
            const int total = pre[64];
            for (int u = bid; u < total; u += G) {
                int e = 0;
                for (int k = 1; k < 64; ++k) e += (pre[k] <= u) ? 1 : 0;
                const int c0 = (u - pre[e]) * 128; const int cnt_e = (int)__hip_atomic_load(ctl + CW_CNT + l * 1024 + e * 16, __ATOMIC_RELAXED, __HIP_MEMORY_SCOPE_AGENT);
                const int nrows = (cnt_e - c0) < 128 ? (cnt_e - c0) : 128;
                moe_unit(e, c0, nrows, XN, LIST, args.in[19] + (size_t)l * 64 * D * 256, args.in[20] + (size_t)l * 64 * D * 256, args.in[21] + (size_t)l * 64 * 256 * D, YB, lds, tid_, wid_, lane_);
            }
        }
        SEAM(pb + 5);
        if (PHON(9) && IN(pb + 6)) {
            FRESH(); const int gw_ = bid * NWAVES + wid_;
            if (l + 1 < DEPTH) norm_rows<1>(X, X, XN, YB, TW, args.in[1] + (size_t)(l + 1) * D, nullptr, gw_, NGW, lane_);
            else norm_rows<2>(X, nullptr, nullptr, YB, TW, args.in[22], args.out, gw_, NGW, lane_);
        }
        if (l + 1 < DEPTH) SEAM(pb + 6);
    }
#undef IN
#undef SEAM
}

extern "C" void kernel_launch(void* const* d_in, const int* in_sizes, int n_in, void* d_out, int out_size, void* d_ws, size_t ws_size, hipStream_t stream) {
    static int grid = 0;
    if (grid == 0) {
        if (n_in != 23 || ws_size < WS_END || out_size != S * D) { fprintf(stderr, "kernel_launch: unexpected problem (n_in %d, out %d, ws %zu)\n", n_in, out_size, ws_size); grid = -1; return; }
        int dev = 0, cus = 0, per_cu = 0;
        if (hipGetDevice(&dev) != hipSuccess || hipDeviceGetAttribute(&cus, hipDeviceAttributeMultiprocessorCount, dev) != hipSuccess) { grid = -1; return; }
        if (hipFuncSetAttribute((const void*)fwd_kernel, hipFuncAttributeMaxDynamicSharedMemorySize, LDS_BYTES) != hipSuccess) { fprintf(stderr, "kernel_launch: hipFuncSetAttribute failed\n"); grid = -1; return; }
        if (hipOccupancyMaxActiveBlocksPerMultiprocessor(&per_cu, (const void*)fwd_kernel, NTHR, LDS_BYTES) != hipSuccess || per_cu < 1) fprintf(stderr, "kernel_launch: occupancy query says %d blocks per CU\n", per_cu);
        (void)hipGetLastError();
        grid = cus;
        if (grid < 136) { fprintf(stderr, "kernel_launch: too few CUs (%d)\n", grid); }
    }
    if (grid < 0) return;
    if (hipMemsetAsync((char*)d_ws + WS_CTL, 0, CTL_ZERO_BYTES, stream) != hipSuccess) { fprintf(stderr, "kernel_launch: memset failed\n"); return; }
    Args a{};
    for (int i = 0; i < 23; ++i) a.in[i] = (const float*)d_in[i];
    a.out = (float*)d_out; a.ws = (unsigned char*)d_ws;
#if MK_ONE_LAUNCH
    a.ph_lo = 0; a.ph_hi = N_PHASES;
    hipLaunchKernelGGL(fwd_kernel, dim3(grid), dim3(NTHR), LDS_BYTES, stream, a);
#else
    for (int p = 0; p < N_PHASES; ++p) { a.ph_lo = p; a.ph_hi = p + 1; hipLaunchKernelGGL(fwd_kernel, dim3(grid), dim3(NTHR), LDS_BYTES, stream, a); }
#endif
    const hipError_t le = hipPeekAtLastError();
    if (le != hipSuccess) fprintf(stderr, "kernel_launch: launch failed: %s\n", hipGetErrorName(le));
}
```

```cpp
#include <hip/hip_runtime.h>
#include <cstdio>
#include <cstdint>
#include <cmath>
namespace pg8 {
#define PG8_LAS __attribute__((address_space(3)))
typedef unsigned short bf16_t;
typedef short bf16x8 __attribute__((ext_vector_type(8)));
typedef float f32x4 __attribute__((ext_vector_type(4)));
typedef unsigned u32x4 __attribute__((ext_vector_type(4)));
constexpr int BM = 256, BK = 64, HALF = 128, HTB = HALF * BK * 2  , STAGE_BYTES = 8 * HTB, NXCD = 8, WGM = 8;

__host__ __device__ __forceinline__ int lds_byte(int r, int c) { const int st = (r >> 4) * 2 + (c >> 5), rr = r & 15, cc = c & 31, ob = rr * 64 + cc * 2; return st * 1024 + (ob ^ (((ob >> 9) & 1) << 5)); }
__host__ __device__ __forceinline__ void stage_rc(int b, int& R, int& C) { const int st = b / 1024, sb = b % 1024, swz = sb ^ (((sb >> 9) & 1) << 5); R = (st >> 1) * 16 + swz / 64; C = (st & 1) * 32 + (swz % 64) / 2; }
__host__ __device__ __forceinline__ int perm32(int rho) { const int n = rho >> 4, i = rho & 15; return 8 * (i >> 2) + 4 * n + (i & 3); }

struct Unit { int pm, pn; };
struct Gemm { const bf16_t* A; const bf16_t* Bt; int M, N, K; };

struct StaticOrder {
    int nM, nN, nwg, G, c;
    __host__ __device__ void init(int M, int N, int G_, int c_) { nM = M / BM; nN = N / BM; nwg = nM * nN; G = G_; c = c_; }
    __host__ __device__ bool next(int i, Unit& u) const {
        const long L = (long)i * G + c; if (L >= nwg) return false;
        int wgid = (int)L; { const int q = nwg / NXCD, r = nwg % NXCD, xcd = wgid % NXCD, off = wgid / NXCD; wgid = (xcd < r ? xcd * (q + 1) : r * (q + 1) + (xcd - r) * q) + off; }
        const int nig = WGM * nN, gid = wgid / nig, fm = gid * WGM, gsz = (nM - fm) < WGM ? (nM - fm) : WGM;
        u.pm = fm + ((wgid % nig) % gsz); u.pn = (wgid % nig) / gsz; return true;
    }
    __device__ __forceinline__ void a_ready(const Unit&) const {}
    __device__ __forceinline__ void done(const Unit&) const {}
};
__device__ __forceinline__ unsigned cvt_pk_bf16(float lo, float hi) { unsigned r; asm volatile("v_cvt_pk_bf16_f32 %0, %1, %2" : "=v"(r) : "v"(lo), "v"(hi)); return r; }
struct EpiProj {
    static constexpr bool PERM = true, AFTER_DRAIN = false;
    bf16_t* O; float* aux;
    __device__ __forceinline__ void operator()(const f32x4 (&acc)[2][2][4][2], const Unit& u, int wr, int wc, int fr, int fq) const {
        const int row0 = u.pm * BM + wr * 64 + fr;
        if (u.pn < 22) {
            const int col0 = u.pn * BM + wc * 32 + 8 * fq;
#pragma unroll
            for (int ai = 0; ai < 2; ++ai)
#pragma unroll
                for (int m = 0; m < 4; ++m) { bf16_t* rowp = O + (size_t)(row0 + ai * HALF + m * 16) * 5632 + col0;
#pragma unroll
                    for (int bj = 0; bj < 2; ++bj) { const f32x4 v0 = acc[ai][bj][m][0], v1 = acc[ai][bj][m][1];
                        u32x4 w; w.x = cvt_pk_bf16(v0[0], v0[1]); w.y = cvt_pk_bf16(v0[2], v0[3]); w.z = cvt_pk_bf16(v1[0], v1[1]); w.w = cvt_pk_bf16(v1[2], v1[3]);
                        *(u32x4*)(rowp + bj * HALF) = w; } }
        } else if (wc < 2) {
            const int col0 = wc * 32 + 8 * fq;
#pragma unroll
            for (int ai = 0; ai < 2; ++ai)
#pragma unroll
                for (int m = 0; m < 4; ++m) { float* rowp = aux + (size_t)(row0 + ai * HALF + m * 16) * 64 + col0;
                    *(f32x4*)(rowp) = acc[ai][0][m][0]; *(f32x4*)(rowp + 4) = acc[ai][0][m][1]; }
        }
    }
};
struct EpiRes {
    static constexpr bool PERM = true, AFTER_DRAIN = false;
    const float* basef; const bf16_t* baseb; bf16_t* out;
    __device__ __forceinline__ void operator()(const f32x4 (&acc)[2][2][4][2], const Unit& u, int wr, int wc, int fr, int fq) const {
        const int row0 = u.pm * BM + wr * 64 + fr, col0 = u.pn * BM + wc * 32 + 8 * fq;
#pragma unroll
        for (int ai = 0; ai < 2; ++ai)
#pragma unroll
            for (int m = 0; m < 4; ++m) { const size_t off = (size_t)(row0 + ai * HALF + m * 16) * 2048 + col0;
#pragma unroll
                for (int bj = 0; bj < 2; ++bj) { f32x4 v0 = acc[ai][bj][m][0], v1 = acc[ai][bj][m][1]; const size_t o = off + bj * HALF;
                    if (basef) { v0 += *(const f32x4*)(basef + o); v1 += *(const f32x4*)(basef + o + 4); }
                    else { const u32x4 b = *(const u32x4*)(baseb + o);
                        v0[0] += __uint_as_float(b.x << 16); v0[1] += __uint_as_float(b.x & 0xffff0000u); v0[2] += __uint_as_float(b.y << 16); v0[3] += __uint_as_float(b.y & 0xffff0000u);
                        v1[0] += __uint_as_float(b.z << 16); v1[1] += __uint_as_float(b.z & 0xffff0000u); v1[2] += __uint_as_float(b.w << 16); v1[3] += __uint_as_float(b.w & 0xffff0000u); }
                    u32x4 w; w.x = cvt_pk_bf16(v0[0], v0[1]); w.y = cvt_pk_bf16(v0[2], v0[3]); w.z = cvt_pk_bf16(v1[0], v1[1]); w.w = cvt_pk_bf16(v1[2], v1[3]);
                    *(u32x4*)(out + o) = w; } }
    }
};
template <class Epi, class Sched, bool ALIGN_EPI = false, bool SP2 = false>
__device__ __forceinline__ void gemm_phase(PG8_LAS unsigned char* lds, const Gemm g, const Sched& S, const Epi& E, int wid_in  ) {
    int wid = wid_in; asm volatile("" : "+s"(wid));
    int lane = (int)__builtin_amdgcn_mbcnt_hi(~0u, __builtin_amdgcn_mbcnt_lo(~0u, 0u)); asm volatile("" : "+v"(lane));
    const int tid = wid * 64 + lane, wr = wid >> 2, wc = wid & 3, fr = lane & 15, fq = lane >> 4;
    const int K = g.K, nt = K / BK;
    unsigned voffA[2], voffB[2];
#pragma unroll
    for (int i = 0; i < 2; ++i) { int R, C; stage_rc(tid * 16 + i * 8192, R, C); const int Rb = Epi::PERM ? ((R & ~31) + perm32(R & 31)) : R;
        voffA[i] = (unsigned)(R * K + C) * 2u; voffB[i] = (unsigned)(Rb * K + C) * 2u; }
    const size_t kstep = (size_t)(BK * 2);
    const size_t hstep = (size_t)HALF * K * 2;
    const size_t tstep = 2 * hstep;
    const unsigned ldsw = (unsigned)wid * 1024u;
    const int aoff = lds_byte(wr * 64 + fr, fq * 8), boff = lds_byte(wc * 32 + fr, fq * 8);
#define PG8_SA(b, h) (((b) * 2 + (h)) * HTB)
#define PG8_SB(b, h) ((4 + (b) * 2 + (h)) * HTB)
#define PG8_STAGE(bufoff, gbase, voff) do { _Pragma("unroll") for (int _i = 0; _i < 2; ++_i) \
        __builtin_amdgcn_global_load_lds((const unsigned*)((const char*)(gbase) + (voff)[_i]), (PG8_LAS unsigned*)(lds + (bufoff) + ldsw + _i * 8192), 16, 0, 0); } while (0)
#define PG8_LDA(dst, b, h) do { _Pragma("unroll") for (int m = 0; m < 4; ++m) _Pragma("unroll") for (int k = 0; k < 2; ++k) dst[m][k] = *(const PG8_LAS bf16x8*)(lds + PG8_SA(b, h) + aoff + m * 2048 + k * 1024); } while (0)
#define PG8_LDB(dst, b, h) do { _Pragma("unroll") for (int n = 0; n < 2; ++n) _Pragma("unroll") for (int k = 0; k < 2; ++k) dst[n][k] = *(const PG8_LAS bf16x8*)(lds + PG8_SB(b, h) + boff + n * 2048 + k * 1024); } while (0)
#define PG8_MMA(ai, bj, At, Bt) do { __builtin_amdgcn_s_setprio(1); _Pragma("unroll") for (int m = 0; m < 4; ++m) _Pragma("unroll") for (int n = 0; n < 2; ++n) _Pragma("unroll") for (int k = 0; k < 2; ++k) \
        acc[ai][bj][m][n] = __builtin_amdgcn_mfma_f32_16x16x32_bf16(Bt[n][k], At[m][k], acc[ai][bj][m][n], 0, 0, 0); __builtin_amdgcn_s_setprio(0); } while (0)
#define PG8_WAIT_V(n) asm volatile("s_waitcnt vmcnt(" #n ")" ::: "memory")
#define PG8_WAIT_L(n) asm volatile("s_waitcnt lgkmcnt(" #n ")" ::: "memory")
#define PG8_BAR __builtin_amdgcn_s_barrier()
#define PG8_SCHED __builtin_amdgcn_sched_barrier(0)
    Unit cur, nxt; int ui = 0;
    if (!S.next(0, cur)) return;
    f32x4 acc[2][2][4][2];
#pragma unroll
    for (int a = 0; a < 2; ++a)
#pragma unroll
        for (int b = 0; b < 2; ++b)
#pragma unroll
            for (int m = 0; m < 4; ++m)
#pragma unroll
                for (int n = 0; n < 2; ++n) acc[a][b][m][n] = (f32x4){0.f, 0.f, 0.f, 0.f};
    bf16x8 At[4][2], B0[2][2], B1[2][2];
    const char* cA = (const char*)g.A + (size_t)cur.pm * tstep; const char* cB = (const char*)g.Bt + (size_t)cur.pn * tstep;
    S.a_ready(cur);
    if constexpr (SP2) {
        PG8_STAGE(PG8_SB(0, 0), cB, voffB); PG8_STAGE(PG8_SB(0, 1), cB + hstep, voffB); PG8_STAGE(PG8_SA(0, 0), cA, voffA); PG8_STAGE(PG8_SA(0, 1), cA + hstep, voffA);
        if (wr == 1) PG8_BAR;
        PG8_WAIT_V(2); PG8_BAR;
        PG8_STAGE(PG8_SB(1, 0), cB + kstep, voffB); PG8_STAGE(PG8_SA(1, 0), cA + kstep, voffA); PG8_STAGE(PG8_SB(1, 1), cB + hstep + kstep, voffB);
        PG8_WAIT_V(6); PG8_BAR;
    } else {
        PG8_STAGE(PG8_SB(0, 0), cB, voffB); PG8_STAGE(PG8_SA(0, 0), cA, voffA); PG8_STAGE(PG8_SB(0, 1), cB + hstep, voffB); PG8_STAGE(PG8_SA(0, 1), cA + hstep, voffA);
        if (wr == 1) PG8_BAR;
        PG8_WAIT_V(4); PG8_BAR;
        PG8_STAGE(PG8_SB(1, 0), cB + kstep, voffB); PG8_STAGE(PG8_SA(1, 0), cA + kstep, voffA); PG8_STAGE(PG8_SB(1, 1), cB + hstep + kstep, voffB);
        PG8_WAIT_V(6); PG8_BAR;
    }
    for (;;) {
        const bool has_next = S.next(ui + 1, nxt);
        const char* nA = has_next ? (const char*)g.A + (size_t)nxt.pm * tstep : cA; const char* nB = has_next ? (const char*)g.Bt + (size_t)nxt.pn * tstep : cB;
        for (int t = 0; t < nt; t += 2) {
            const bool last = (t == nt - 2);
            const char* a1 = cA + (size_t)(t + 1) * kstep;
            const char* a2 = last ? nA : cA + (size_t)(t + 2) * kstep; const char* b2 = last ? nB : cB + (size_t)(t + 2) * kstep;
            const char* a3 = a2 + kstep; const char* b3 = b2 + kstep;
            if (last && has_next) S.a_ready(nxt);
            if constexpr (SP2) {
            PG8_LDB(B0, 0, 0); PG8_LDB(B1, 0, 1); PG8_SCHED; PG8_LDA(At, 0, 0); PG8_STAGE(PG8_SA(1, 1), a1 + hstep, voffA);
            PG8_WAIT_V(8); PG8_WAIT_L(0); PG8_BAR; PG8_MMA(0, 0, At, B0); PG8_MMA(0, 1, At, B1); PG8_BAR; PG8_SCHED;
            PG8_LDA(At, 0, 1); PG8_STAGE(PG8_SB(0, 0), b2, voffB); PG8_STAGE(PG8_SB(0, 1), b2 + hstep, voffB); PG8_STAGE(PG8_SA(0, 0), a2, voffA);
            PG8_WAIT_V(8); PG8_WAIT_L(0); PG8_BAR; PG8_MMA(1, 0, At, B0); PG8_MMA(1, 1, At, B1); PG8_BAR; PG8_SCHED;
            PG8_LDB(B0, 1, 0); PG8_LDB(B1, 1, 1); PG8_SCHED; PG8_LDA(At, 1, 0); PG8_STAGE(PG8_SA(0, 1), a2 + hstep, voffA);
            PG8_WAIT_V(8); PG8_WAIT_L(0); PG8_BAR; PG8_MMA(0, 0, At, B0); PG8_MMA(0, 1, At, B1); PG8_BAR; PG8_SCHED;
            PG8_LDA(At, 1, 1); PG8_STAGE(PG8_SB(1, 0), b3, voffB); PG8_STAGE(PG8_SB(1, 1), b3 + hstep, voffB); PG8_STAGE(PG8_SA(1, 0), a3, voffA);
            PG8_WAIT_V(8); PG8_WAIT_L(0); PG8_BAR; PG8_MMA(1, 0, At, B0); PG8_MMA(1, 1, At, B1); PG8_BAR; PG8_SCHED;
            } else {
            PG8_LDB(B0, 0, 0); PG8_SCHED; PG8_LDA(At, 0, 0); PG8_STAGE(PG8_SA(1, 1), a1 + hstep, voffA);
            PG8_WAIT_L(8); PG8_BAR; PG8_WAIT_L(0); PG8_MMA(0, 0, At, B0); PG8_BAR; PG8_SCHED;
            PG8_LDB(B1, 0, 1); PG8_STAGE(PG8_SB(0, 0), b2, voffB);
            PG8_BAR; PG8_WAIT_L(0); PG8_MMA(0, 1, At, B1); PG8_BAR;
            PG8_LDA(At, 0, 1); PG8_STAGE(PG8_SA(0, 0), a2, voffA);
            PG8_BAR; PG8_WAIT_L(0); PG8_MMA(1, 0, At, B0); PG8_BAR; PG8_SCHED;
            PG8_STAGE(PG8_SB(0, 1), b2 + hstep, voffB);
            PG8_WAIT_V(6); PG8_BAR; PG8_MMA(1, 1, At, B1); PG8_BAR;
            PG8_LDB(B0, 1, 0); PG8_SCHED; PG8_LDA(At, 1, 0); PG8_STAGE(PG8_SA(0, 1), a2 + hstep, voffA);
            PG8_WAIT_L(8); PG8_BAR; PG8_WAIT_L(0); PG8_MMA(0, 0, At, B0); PG8_BAR; PG8_SCHED;
            PG8_LDB(B1, 1, 1); PG8_STAGE(PG8_SB(1, 0), b3, voffB);
            PG8_BAR; PG8_WAIT_L(0); PG8_MMA(0, 1, At, B1); PG8_BAR;
            PG8_LDA(At, 1, 1); PG8_STAGE(PG8_SA(1, 0), a3, voffA);
            PG8_BAR; PG8_WAIT_L(0); PG8_MMA(1, 0, At, B0); PG8_BAR; PG8_SCHED;
            PG8_STAGE(PG8_SB(1, 1), b3 + hstep, voffB);
            PG8_WAIT_V(6); PG8_BAR; PG8_MMA(1, 1, At, B1); PG8_BAR;
            }
        }
        if constexpr (ALIGN_EPI) { if (wr == 0) PG8_BAR; }
        if constexpr (!Epi::AFTER_DRAIN) { E(acc, cur, wr, wc, fr, fq); S.done(cur); }
        if (!has_next) break;
#pragma unroll
        for (int a = 0; a < 2; ++a)
#pragma unroll
            for (int b = 0; b < 2; ++b)
#pragma unroll
                for (int m = 0; m < 4; ++m)
#pragma unroll
                    for (int n = 0; n < 2; ++n) acc[a][b][m][n] = (f32x4){0.f, 0.f, 0.f, 0.f};
        cur = nxt; cA = nA; cB = nB; ++ui;
        if constexpr (ALIGN_EPI) { if (wr == 1) PG8_BAR; }
    }
    PG8_WAIT_V(0);
    if constexpr (!ALIGN_EPI) { if (wr == 0) PG8_BAR; }
    PG8_BAR;
    if constexpr (Epi::AFTER_DRAIN) { E.fused(acc, cur, wr, wc, fr, fq, lds, wid, lane); S.done(cur); }
#undef PG8_SA
#undef PG8_SB
#undef PG8_STAGE
#undef PG8_LDA
#undef PG8_LDB
#undef PG8_MMA
#undef PG8_WAIT_V
#undef PG8_WAIT_L
#undef PG8_BAR
#undef PG8_SCHED
}
}
#define GAS __attribute__((address_space(1)))
#define LAS __attribute__((address_space(3)))
typedef unsigned short bf16;
typedef unsigned v4u __attribute__((ext_vector_type(4)));
typedef float f32x4 __attribute__((ext_vector_type(4)));
typedef short bf16x8 __attribute__((ext_vector_type(8)));
typedef GAS unsigned gu32;
typedef GAS unsigned long long gu64;
#define RLX_AGENT __ATOMIC_RELAXED, __HIP_MEMORY_SCOPE_AGENT
#define LDS_WAIT() asm volatile("s_waitcnt lgkmcnt(0)" ::: "memory")
#define VM_WAIT() asm volatile("s_waitcnt vmcnt(0)" ::: "memory")
__device__ __forceinline__ unsigned long long rt() { return __builtin_amdgcn_s_memrealtime(); }
__device__ __forceinline__ unsigned f2bf(float f) { unsigned u = __builtin_bit_cast(unsigned, f); return (u + 0x7fffu + ((u >> 16) & 1u)) >> 16; }
__device__ __forceinline__ unsigned pk2(float lo, float hi) { return f2bf(lo) | (f2bf(hi) << 16); }
#define XB_TMO      128
#define XB_XCNT(j)  (256  + 64 * (j))
#define XB_XSUB(j)  (1280 + 64 * (j))
#define XB_XGEN(j)  (2304 + 64 * (j))
#define XB_TOP      3328
#define XB_TOPGEN   3392
#define XCD_BAR_WORDS 3456
#define XB_SPIN_CAP (1u << 18)

__device__ __forceinline__ unsigned xb_ld(unsigned* p)              { return __hip_atomic_load(p, __ATOMIC_RELAXED, __HIP_MEMORY_SCOPE_AGENT); }
__device__ __forceinline__ unsigned xb_add(unsigned* p, unsigned v) { return __hip_atomic_fetch_add(p, v, __ATOMIC_RELAXED, __HIP_MEMORY_SCOPE_AGENT); }
__device__ __forceinline__ unsigned xb_xcc_id() { return (unsigned)__builtin_amdgcn_s_getreg((3 << 11) | 20) & 0xFu; }
#define XB_SPIN(cond, bar) do { unsigned _sp = 0; while (cond) { __builtin_amdgcn_s_sleep(1); \
    if ((++_sp & 255u) == 0u) { if (xb_ld(&(bar)[XB_TMO])) break; if (_sp > XB_SPIN_CAP) { atomicAdd(&(bar)[XB_TMO], 1u); break; } } } } while (0)

struct XcdBarrier {
    unsigned* bar; unsigned x;
    unsigned w0;
    volatile LAS unsigned* st;
};

__device__ __forceinline__ XcdBarrier xcd_barrier_post(unsigned* bar, volatile LAS unsigned* st) {
    XcdBarrier b; b.bar = bar; b.x = xb_xcc_id(); b.st = st; b.w0 = (__builtin_amdgcn_readfirstlane(threadIdx.x >> 6) == 0) ? 1u : 0u;
    if (threadIdx.x == 0) (void)xb_add(&bar[XB_XCNT(b.x)], 1u);
    return b;
}
__device__ __forceinline__ void xcd_barrier_complete(unsigned* bar, unsigned x, unsigned& nloc, unsigned& nx) {
    const unsigned G = gridDim.x * gridDim.y * gridDim.z;
    unsigned sum, cnt, mine, sp = 0u;
    for (;;) {
        sum = 0u; cnt = 0u; mine = 0u;
#pragma unroll
        for (unsigned j = 0; j < 16; ++j) { const unsigned c = xb_ld(&bar[XB_XCNT(j)]); sum += c; cnt += (c > 0u) ? 1u : 0u; mine = (j == x) ? c : mine; }
        if (sum == G) break;
        __builtin_amdgcn_s_sleep(1);
        if ((++sp & 255u) == 0u) { if (xb_ld(&bar[XB_TMO])) break; if (sp > XB_SPIN_CAP) { atomicAdd(&bar[XB_TMO], 1u); break; } }
    }
    nloc = mine > 0u ? mine : 1u; nx = cnt > 0u ? cnt : 1u;
}

__device__ __forceinline__ void xcd_barrier(const XcdBarrier& b) {
    asm volatile("s_waitcnt vmcnt(0)" ::: "memory");
    __syncthreads();
    if (b.w0 != 0u && __builtin_amdgcn_mbcnt_hi(~0u, __builtin_amdgcn_mbcnt_lo(~0u, 0u)) == 0u) {
        GAS unsigned* barg = (GAS unsigned*)b.bar; asm volatile("" : "+s"(barg)); unsigned* bar = (unsigned*)barg;
        __builtin_amdgcn_s_waitcnt(0);
        unsigned nloc = b.st[0], nx = b.st[1];
        if (nloc == 0u) { xcd_barrier_complete(bar, b.x, nloc, nx); b.st[0] = nloc; b.st[1] = nx; }
        const unsigned old = xb_add(&bar[XB_XSUB(b.x)], 1u);
        const unsigned gen = old / nloc;
        if (old + 1u == (gen + 1u) * nloc) {
            __builtin_amdgcn_fence(__ATOMIC_RELEASE, "agent");
            asm volatile("s_waitcnt vmcnt(0)" ::: "memory");
            const unsigned og = xb_add(&bar[XB_TOP], 1u);
            const unsigned tg = og / nx;
            if (og + 1u == (tg + 1u) * nx) xb_add(&bar[XB_TOPGEN], 1u);
            else XB_SPIN(xb_ld(&bar[XB_TOPGEN]) == tg, bar);
            __builtin_amdgcn_fence(__ATOMIC_ACQUIRE, "agent");
            xb_add(&bar[XB_XGEN(b.x)], 1u);
            asm volatile("s_waitcnt vmcnt(0)" ::: "memory");
        } else {
            XB_SPIN(xb_ld(&bar[XB_XGEN(b.x)]) == gen, bar);
            __builtin_amdgcn_fence(__ATOMIC_ACQUIRE, "agent");
            asm volatile("s_waitcnt vmcnt(0)" ::: "memory");
        }
    }
    __syncthreads();
}
typedef unsigned u32x4 __attribute__((ext_vector_type(4)));

typedef short s16x4 __attribute__((ext_vector_type(4)));
typedef float f32x16 __attribute__((ext_vector_type(16)));
typedef unsigned u32x2 __attribute__((ext_vector_type(2)));
typedef float f32x2v __attribute__((ext_vector_type(2)));

constexpr int S = 8192, D = 2048, DEPTH = 4, DIN = 5688, NP = 5888, PITCH = 5632;
constexpr int C_AQ = 0, C_AK = 512, C_AV = 1024, C_BQ = 1536, C_BK = 2048, C_BV = 2560, C_CQ = 3072, C_KC = 4096, C_VC = 4352, C_KS = 4608, C_VS = 4864, C_KW = 5120, C_VW = 5376;
constexpr float RMS_EPS = 1e-6f, NEG = -1e30f, LOG2E = 1.4426950408889634f, SCL2 = 0.125f * 1.4426950408889634f;
constexpr int NWAVES = 8, NTHR = 512;

constexpr size_t MiB = 1u << 20;
constexpr size_t WS_CTL = 0, CTL_ZERO_BYTES = 1 * MiB;
constexpr size_t WS_WIN = 2 * MiB;
constexpr size_t WS_WOUT = 96 * MiB;
constexpr size_t WS_W1T = 128 * MiB;
constexpr size_t WS_W2T = 136 * MiB;
constexpr size_t WS_RWT = 137 * MiB;
constexpr size_t WS_C1 = 139 * MiB;
constexpr size_t WS_X = 144 * MiB;
constexpr size_t WS_XN = 208 * MiB;
constexpr size_t WS_PROJ = 240 * MiB;
constexpr size_t WS_AUX = 330 * MiB;
constexpr size_t WS_CUM = 332 * MiB;
constexpr size_t WS_KC = 333 * MiB;
constexpr size_t WS_VC = 334 * MiB;
constexpr size_t WS_MIX = 336 * MiB;
constexpr size_t WS_YB = 368 * MiB;
constexpr size_t WS_LIST = 432 * MiB;
constexpr size_t WS_TW = 436 * MiB;
constexpr size_t WS_END = 440 * MiB;
constexpr int CW_BAR = 4096;
constexpr int CW_Q = 8192;
constexpr int CW_PQ = 24576, CW_PD = 25600;
constexpr int CW_CNT = 32768;

constexpr int LDS_BYTES = 160 * 1024;
constexpr int MISC_OFF = 150 * 1024;

struct Args { const float* in[23]; float* out; unsigned char* ws; int ph_lo, ph_hi; };
__device__ __forceinline__ int t5_bucket(int rel) { if (rel < 16) return rel; int b = 16;
    b += rel >= 19; b += rel >= 21; b += rel >= 24; b += rel >= 27; b += rel >= 31; b += rel >= 35; b += rel >= 40; b += rel >= 46; b += rel >= 52; b += rel >= 59; b += rel >= 67; b += rel >= 77; b += rel >= 87; b += rel >= 99; b += rel >= 113; return b; }

__device__ __forceinline__ float bf2f(unsigned short b) { return __uint_as_float((unsigned)b << 16); }
__device__ __forceinline__ float bflo(unsigned w) { return __uint_as_float(w << 16); }
__device__ __forceinline__ float bfhi(unsigned w) { return __uint_as_float(w & 0xffff0000u); }
typedef __bf16 bf16x2_t __attribute__((ext_vector_type(2)));
__device__ __forceinline__ unsigned cvtpk(float lo, float hi) { f32x2v v = {lo, hi}; bf16x2_t b = __builtin_convertvector(v, bf16x2_t); return __builtin_bit_cast(unsigned, b); }
__device__ __forceinline__ unsigned short f2bf16(float f) { return (unsigned short)(cvtpk(f, 0.f) & 0xffffu); }
__device__ __forceinline__ float wave_sum(float v) {
#pragma unroll
    for (int o = 1; o < 64; o <<= 1) v += __shfl_xor(v, o);
    return v;
}
__device__ __forceinline__ int crow(int r, int hi) { return (r & 3) + 8 * (r >> 2) + 4 * hi; }
#define MFMA32(a, b, c) __builtin_amdgcn_mfma_f32_32x32x16_bf16((a), (b), (c), 0, 0, 0)
#define MFMA16(a, b, c) __builtin_amdgcn_mfma_f32_16x16x32_bf16((a), (b), (c), 0, 0, 0)

__device__ __forceinline__ int src_col_win(int n) { if (n < 3072) return n; if (n < 5632) return n + 8; if (n < 5640) return n - 2560; if (n < 5688) return n; return -1; }

template <int MODE>
__device__ __forceinline__ void tr_item(const float* W, const float* W2, int ldw, int K, bf16* WT, int k0, int n0, LAS float* scr, int lane) {
    const int nn = n0 + (lane & 31);
    const float* src = W; int ld = ldw; bool ok = true;
    if (MODE == 0) { src = W + nn; }
    else if (MODE == 1) { const int c = src_col_win(nn); ok = c >= 0; src = W + (ok ? c : 0); }
    else { if (nn < 8) { src = W + nn; ld = 8; } else if (nn < 72) { src = W2 + (nn - 8); ld = 64; } else { ok = false; ld = 8; } }
    float tv[32];
#pragma unroll
    for (int i = 0; i < 32; ++i) { const int kk = 2 * i + (lane >> 5); tv[i] = ok ? src[(size_t)(k0 + kk) * ld] : 0.f; }
#pragma unroll
    for (int i = 0; i < 32; ++i) { const int kk = 2 * i + (lane >> 5); scr[kk * 33 + (lane & 31)] = tv[i]; }
    LDS_WAIT(); asm volatile("" ::: "memory");
    const int c = lane & 7;
#pragma unroll
    for (int j = 0; j < 4; ++j) { const int n = (lane >> 3) + 8 * j; const LAS float* s = scr + (8 * c) * 33 + n;
        v4u o; o.x = pk2(s[0 * 33], s[1 * 33]); o.y = pk2(s[2 * 33], s[3 * 33]); o.z = pk2(s[4 * 33], s[5 * 33]); o.w = pk2(s[6 * 33], s[7 * 33]);
        *(v4u*)(WT + (size_t)(n0 + n) * K + k0 + 8 * c) = o; }
    LDS_WAIT(); asm volatile("" ::: "memory");
}

template <int MODE>
__device__ __forceinline__ void norm_rows(const float* xsrc, const bf16* xb, bf16* X, bf16* XN, const bf16* YB, const float* TW, const float* gain, float* out, int gw, int NGW, int lane) {
    for (int row = gw; row < S; row += NGW) {
        f32x4 v[8];
        if (MODE == 0) { const f32x4* xr = (const f32x4*)(xsrc + (size_t)row * D) + lane;
#pragma unroll
            for (int j = 0; j < 8; ++j) v[j] = xr[64 * j];
        } else { const u32x2* xr = (const u32x2*)(xb + (size_t)row * D) + lane;
#pragma unroll
            for (int j = 0; j < 8; ++j) { const u32x2 r = xr[64 * j]; v[j] = (f32x4){bflo(r.x), bfhi(r.x), bflo(r.y), bfhi(r.y)}; } }
        if (MODE >= 1) {
            const float w0 = TW[2 * row], w1 = TW[2 * row + 1];
            const u32x2* ya = (const u32x2*)(YB + (size_t)(2 * row) * D) + lane; const u32x2* yb = (const u32x2*)(YB + (size_t)(2 * row + 1) * D) + lane;
#pragma unroll
            for (int j = 0; j < 8; ++j) { const u32x2 a = ya[64 * j], b = yb[64 * j];
                v[j].x += w0 * bflo(a.x) + w1 * bflo(b.x); v[j].y += w0 * bfhi(a.x) + w1 * bfhi(b.x);
                v[j].z += w0 * bflo(a.y) + w1 * bflo(b.y); v[j].w += w0 * bfhi(a.y) + w1 * bfhi(b.y); }
        }
        float ss = 0.f;
#pragma unroll
        for (int j = 0; j < 8; ++j) ss += (v[j].x * v[j].x + v[j].y * v[j].y) + (v[j].z * v[j].z + v[j].w * v[j].w);
        ss = wave_sum(ss);
        const float rstd = 1.0f / sqrtf(ss * (1.0f / D) + RMS_EPS);
        if (MODE == 1) { u32x2* xo = (u32x2*)(X + (size_t)row * D) + lane;
#pragma unroll
            for (int j = 0; j < 8; ++j) { u32x2 w; w.x = cvtpk(v[j].x, v[j].y); w.y = cvtpk(v[j].z, v[j].w); xo[64 * j] = w; } }
        const f32x4* gr = (const f32x4*)gain + lane;
        if (MODE < 2) { u32x2* o8 = (u32x2*)(XN + (size_t)row * D) + lane;
#pragma unroll
            for (int j = 0; j < 8; ++j) { const f32x4 g = gr[64 * j]; u32x2 w; w.x = cvtpk(v[j].x * rstd * g.x, v[j].y * rstd * g.y); w.y = cvtpk(v[j].z * rstd * g.z, v[j].w * rstd * g.w); o8[64 * j] = w; }
        } else { f32x4* oo = (f32x4*)(out + (size_t)row * D) + lane;
#pragma unroll
            for (int j = 0; j < 8; ++j) { const f32x4 g = gr[64 * j]; oo[64 * j] = v[j] * rstd * g; } }
    }
}

__device__ __forceinline__ void p0_prologue(const Args& a, LAS unsigned char* lds, int bid, int G, int tid, int wid, int lane) {
    unsigned char* ws = a.ws;
    LAS float* scr = (LAS float*)(lds + wid * 8448);
    const int gw = bid * NWAVES + wid, NGW = G * NWAVES;
    constexpr int I_WIN = 32 * 184, I_WOUT = 32 * 64, I_W1 = 32 * 8, I_W2 = 4 * 2, I_RW = 32 * 3, I_L = I_WIN + I_WOUT + 2 * I_W1 + 2 * I_W2 + I_RW;
    for (int it = gw; it < DEPTH * I_L; it += NGW) {
        const int l = it / I_L; int r = it % I_L;
        if (r < I_WIN) { tr_item<1>(a.in[2] + (size_t)l * D * DIN, nullptr, DIN, D, (bf16*)(ws + WS_WIN) + (size_t)l * NP * D, 64 * (r / 184), 32 * (r % 184), scr, lane); continue; } r -= I_WIN;
        if (r < I_WOUT) { tr_item<0>(a.in[13] + (size_t)l * D * D, nullptr, D, D, (bf16*)(ws + WS_WOUT) + (size_t)l * D * D, 64 * (r / 64), 32 * (r % 64), scr, lane); continue; } r -= I_WOUT;
        if (r < 2 * I_W1) { const int kv = r / I_W1, q = r % I_W1; tr_item<0>(a.in[kv ? 10 : 7] + (size_t)l * 2048 * 256, nullptr, 256, 2048, (bf16*)(ws + WS_W1T) + (size_t)(l * 2 + kv) * 256 * 2048, 64 * (q / 8), 32 * (q % 8), scr, lane); continue; } r -= 2 * I_W1;
        if (r < 2 * I_W2) { const int kv = r / I_W2, q = r % I_W2; tr_item<0>(a.in[kv ? 11 : 8] + (size_t)l * 256 * 64, nullptr, 64, 256, (bf16*)(ws + WS_W2T) + (size_t)(l * 2 + kv) * 64 * 256, 64 * (q / 2), 32 * (q % 2), scr, lane); continue; } r -= 2 * I_W2;
        tr_item<2>(a.in[15] + (size_t)l * D * 8, a.in[17] + (size_t)l * D * 64, 8, D, (bf16*)(ws + WS_RWT) + (size_t)l * 96 * D, 64 * (r / 3), 32 * (r % 3), scr, lane);
    }
    for (int b = bid; b < 256; b += G) {
        const int vec = b >> 5, cb = b & 31, l = vec >> 1, kv = vec & 1; const float* pos = a.in[kv ? 9 : 6] + (size_t)l * 2048; const float* w1 = a.in[kv ? 10 : 7] + (size_t)l * 2048 * 256 + 8 * cb;
        float acc[8];
#pragma unroll
        for (int i = 0; i < 8; ++i) acc[i] = 0.f;
#pragma unroll
        for (int j = 0; j < 4; ++j) { const int k = tid + 512 * j; const float pv = pos[k]; const f32x4 w0 = *(const f32x4*)(w1 + (size_t)k * 256), w1v = *(const f32x4*)(w1 + (size_t)k * 256 + 4);
            acc[0] += pv * w0.x; acc[1] += pv * w0.y; acc[2] += pv * w0.z; acc[3] += pv * w0.w; acc[4] += pv * w1v.x; acc[5] += pv * w1v.y; acc[6] += pv * w1v.z; acc[7] += pv * w1v.w; }
        LAS float* red = (LAS float*)(lds + 72 * 1024);
#pragma unroll
        for (int i = 0; i < 8; ++i) { const float sws = wave_sum(acc[i]); if (lane == 0) red[wid * 8 + i] = sws; }
        __syncthreads();
        if (tid < 8) { float sres = 0.f;
#pragma unroll
            for (int w = 0; w < 8; ++w) sres += red[w * 8 + tid];
            ((float*)(ws + WS_C1))[vec * 256 + 8 * cb + tid] = sres; }
        __syncthreads();
    }
    norm_rows<0>(a.in[0], nullptr, nullptr, (bf16*)(ws + WS_XN), nullptr, nullptr, a.in[1], nullptr, gw, NGW, lane);
}

__device__ __forceinline__ float gelu_tanh(float x) { const float u = 0.7978845608028654f * (x + 0.044715f * x * x * x); const float t = 1.0f - 2.0f / (__expf(2.0f * u) + 1.0f); return 0.5f * x * (1.0f + t); }

__device__ __forceinline__ void compress_unit(int u, int l, const bf16* PROJ, const bf16* W1T, const bf16* W2T, const float* C1, bf16* KC, bf16* VC, LAS unsigned char* lds, int wid, int lane) {
    const int kv = u >> 6, rb = u & 63, r32 = lane & 31, hi = lane >> 5;
    const int R = 32 * rb + r32, g = R >> 9, n = R & 511;
    const int colb = (kv ? C_VC : C_KC) + 64 * g;
    const bf16* w1 = W1T + (size_t)(l * 2 + kv) * 256 * 2048 + (size_t)(32 * wid + r32) * 2048 + 8 * hi;
    const bf16* arow = PROJ + colb + 8 * hi;
    f32x16 acc = {};
#pragma unroll 16
    for (int s = 0; s < 128; ++s) {
        int tok = 16 * n + (s >> 2); tok = tok > (S - 1) ? (S - 1) : tok;
        const bf16x8 av = *(const bf16x8*)(arow + (size_t)tok * PITCH + (s & 3) * 16);
        const bf16x8 bv = *(const bf16x8*)(w1 + 16 * s);
        acc = MFMA32(av, bv, acc);
    }
    LAS bf16* hid = (LAS bf16*)lds;
    const float c1 = C1[(l * 2 + kv) * 256 + 32 * wid + r32];
#pragma unroll
    for (int r = 0; r < 16; ++r) hid[crow(r, hi) * 264 + 32 * wid + r32] = f2bf16(gelu_tanh(acc[r] + c1));
    __syncthreads();
    if (wid < 2) {
        f32x16 acc2 = {};
        const bf16* w2 = W2T + (size_t)(l * 2 + kv) * 64 * 256 + (size_t)(32 * wid + r32) * 256 + 8 * hi;
#pragma unroll 4
        for (int s = 0; s < 16; ++s) {
            const bf16x8 av = *(const LAS bf16x8*)(hid + r32 * 264 + 16 * s + 8 * hi);
            const bf16x8 bv = *(const bf16x8*)(w2 + 16 * s);
            acc2 = MFMA32(av, bv, acc2);
        }
        bf16* outp = kv ? VC : KC;
#pragma unroll
        for (int r = 0; r < 16; ++r) { const int Rr = 32 * rb + crow(r, hi); outp[(size_t)((Rr >> 9) * 512 + (Rr & 511)) * 64 + 32 * wid + r32] = f2bf16(acc2[r]); }
    }
    __syncthreads();
}

__device__ __forceinline__ void cumsum_unit(int h, int l, const float* AUX, const float* fox_bf, float* CUM, LAS unsigned char* lds, int tid) {
    const float bfv = fox_bf[l * 8 + h];
    float v[16]; float run = 0.f;
#pragma unroll
    for (int i = 0; i < 16; ++i) { const int t = 16 * tid + i; const float z = AUX[(size_t)t * 64 + h] + bfv; const float lf = fminf(z, 0.f) - log1pf(__expf(-fabsf(z))); run += lf; v[i] = run; }
    LAS float* tot = (LAS float*)lds;
    tot[tid] = run; __syncthreads();
    float off = 0.f;
    for (int j = 0; j < tid; ++j) off += tot[j];
#pragma unroll
    for (int i = 0; i < 16; ++i) CUM[(size_t)h * S + 16 * tid + i] = off + v[i];
    __syncthreads();
}

__device__ __forceinline__ int koff(int key, int c) { return c * 1024 + (((key + c) & 63) << 4); }
__device__ __forceinline__ int voff(int key, int c) { return (c >> 2) * 4096 + (key >> 4) * 1024 + (key & 15) * 64 + (c & 3) * 16; }
typedef short v4i16_t __attribute__((ext_vector_type(4)));
__device__ __forceinline__ s16x4 vtr(LAS const unsigned char* p) { return __builtin_bit_cast(s16x4, __builtin_amdgcn_ds_read_tr16_b64_v4i16((LAS v4i16_t*)p)); }

template <int NDT> struct AState { float m, l; f32x16 o[NDT]; };
template <int NDT> __device__ __forceinline__ void astate_init(AState<NDT>& st) { st.m = 0.f; st.l = 0.f;
#pragma unroll
    for (int i = 0; i < NDT; ++i) st.o[i] = (f32x16){}; }

template <bool QLDS>
__device__ __forceinline__ void qk_tile(f32x16& p0, f32x16& p1, LAS const unsigned char* kt, int kchunk0, const bf16x8 (&qf)[4], LAS const unsigned char* qb, int r32, int hi) {
    bf16x8 ka[4], kb[4], q[4];
#pragma unroll
    for (int d0 = 0; d0 < 4; ++d0) {
        const int c = kchunk0 + 2 * d0 + hi;
        ka[d0] = *(const LAS bf16x8*)(kt + koff(r32, c));
        kb[d0] = *(const LAS bf16x8*)(kt + koff(r32 + 32, c));
        q[d0] = QLDS ? *(const LAS bf16x8*)(qb + d0 * 8192) : qf[d0];
    }
    __builtin_amdgcn_sched_barrier(0);
    p0 = (f32x16){}; p1 = (f32x16){};
#pragma unroll
    for (int d0 = 0; d0 < 4; ++d0) { p0 = MFMA32(ka[d0], q[d0], p0); p1 = MFMA32(kb[d0], q[d0], p1); }
    __builtin_amdgcn_sched_barrier(0);
}
__device__ __forceinline__ void pack_p(bf16x8 (&pw)[4], const f32x16& p0, const f32x16& p1) {
    u32x4 w;
    w.x = cvtpk(p0[0], p0[1]); w.y = cvtpk(p0[2], p0[3]); w.z = cvtpk(p0[4], p0[5]); w.w = cvtpk(p0[6], p0[7]); pw[0] = __builtin_bit_cast(bf16x8, w);
    w.x = cvtpk(p0[8], p0[9]); w.y = cvtpk(p0[10], p0[11]); w.z = cvtpk(p0[12], p0[13]); w.w = cvtpk(p0[14], p0[15]); pw[1] = __builtin_bit_cast(bf16x8, w);
    w.x = cvtpk(p1[0], p1[1]); w.y = cvtpk(p1[2], p1[3]); w.z = cvtpk(p1[4], p1[5]); w.w = cvtpk(p1[6], p1[7]); pw[2] = __builtin_bit_cast(bf16x8, w);
    w.x = cvtpk(p1[8], p1[9]); w.y = cvtpk(p1[10], p1[11]); w.z = cvtpk(p1[12], p1[13]); w.w = cvtpk(p1[14], p1[15]); pw[3] = __builtin_bit_cast(bf16x8, w);
}
struct VFrag { s16x4 lo[4], hh[4]; };
__device__ __forceinline__ LAS const unsigned char* vfrag_base(LAS const unsigned char* vt, int lane) { return vt + ((lane >> 4) & 1) * 32 + (lane & 3) * 8 + (4 * (lane >> 5) + ((lane & 15) >> 2)) * 64; }
__device__ __forceinline__ void vfrag_read(VFrag& f, LAS const unsigned char* vb, int dt) {
#pragma unroll
    for (int s = 0; s < 4; ++s) { f.lo[s] = vtr(vb + dt * 4096 + s * 1024); f.hh[s] = vtr(vb + dt * 4096 + s * 1024 + 512); }
}
__device__ __forceinline__ void vfrag_mma(f32x16& o, const VFrag& f, const bf16x8 (&pw)[4]) {
#pragma unroll
    for (int s = 0; s < 4; ++s) { const bf16x8 vf = (bf16x8){f.lo[s][0], f.lo[s][1], f.lo[s][2], f.lo[s][3], f.hh[s][0], f.hh[s][1], f.hh[s][2], f.hh[s][3]}; o = MFMA32(vf, pw[s], o); }
}
template <int NDT>
__device__ __forceinline__ void pv_tile_pre(f32x16 (&o)[NDT], const bf16x8 (&pw)[4], LAS const unsigned char* vb, VFrag& f0) {
    VFrag f1;
#pragma unroll
    for (int dt = 0; dt < NDT; dt += 2) {
        if (dt + 1 < NDT) vfrag_read(f1, vb, dt + 1);
        __builtin_amdgcn_sched_barrier(0);
        vfrag_mma(o[dt], f0, pw);
        if (dt + 1 < NDT) {
            if (dt + 2 < NDT) vfrag_read(f0, vb, dt + 2);
            __builtin_amdgcn_sched_barrier(0);
            vfrag_mma(o[dt + 1], f1, pw);
        }
    }
}
template <int NDT>
__device__ __forceinline__ void pv_tile(f32x16 (&o)[NDT], const bf16x8 (&pw)[4], LAS const unsigned char* vt, int lane) {
    LAS const unsigned char* vb = vfrag_base(vt, lane);
    VFrag f0; vfrag_read(f0, vb, 0);
    pv_tile_pre<NDT>(o, pw, vb, f0);
}
constexpr float SM_THR = 8.0f;
__device__ __forceinline__ float max3f(float a, float b, float c) { return __builtin_fmaxf(__builtin_fmaxf(a, b), c); }
__device__ __forceinline__ float halfmax(float m) { auto rr = __builtin_amdgcn_permlane32_swap(__float_as_uint(m), __float_as_uint(m), false, false); return fmaxf(__uint_as_float(rr[0]), __uint_as_float(rr[1])); }
__device__ __forceinline__ float halfsum(float v) { auto rr = __builtin_amdgcn_permlane32_swap(__float_as_uint(v), __float_as_uint(v), false, false); return __uint_as_float(rr[0]) + __uint_as_float(rr[1]); }
#ifndef SM_VPRE
#define SM_VPRE false
#endif
template <int NDT>
__device__ __forceinline__ void softmax_pv(AState<NDT>& st, f32x16& p0, f32x16& p1, LAS const unsigned char* vt, int lane) {
    LAS const unsigned char* vb = vfrag_base(vt, lane);
    constexpr bool VPRE = SM_VPRE;
    VFrag f0; if (VPRE) { vfrag_read(f0, vb, 0); __builtin_amdgcn_sched_barrier(0); }
    float ma = max3f(p0[0], p0[1], p0[2]), mb = max3f(p1[0], p1[1], p1[2]);
#pragma unroll
    for (int r = 3; r < 15; r += 2) { ma = max3f(ma, p0[r], p0[r + 1]); mb = max3f(mb, p1[r], p1[r + 1]); }
    float mx = max3f(ma, mb, fmaxf(p0[15], p1[15]));
    mx = halfmax(mx);
    if (__any(mx > SM_THR)) {
        const float d = fmaxf(mx, 0.f), alpha = __builtin_amdgcn_exp2f(-d); st.m += d; st.l *= alpha;
#pragma unroll
        for (int r = 0; r < 16; ++r) { p0[r] -= d; p1[r] -= d; }
#pragma unroll
        for (int dt = 0; dt < NDT; ++dt)
#pragma unroll
            for (int r = 0; r < 16; ++r) st.o[dt][r] *= alpha;
    }
    float rs = 0.f;
#pragma unroll
    for (int r = 0; r < 16; ++r) { p0[r] = __builtin_amdgcn_exp2f(p0[r]); p1[r] = __builtin_amdgcn_exp2f(p1[r]); rs += p0[r] + p1[r]; }
    st.l += rs;
    bf16x8 pw[4]; pack_p(pw, p0, p1);
    if (!VPRE) vfrag_read(f0, vb, 0);
    pv_tile_pre<NDT>(st.o, pw, vb, f0);
}
__device__ __forceinline__ void softmax_stats(float& m, float& l, const f32x16& p0, const f32x16& p1) {
    float mx = fmaxf(p0[0], p1[0]);
#pragma unroll
    for (int r = 1; r < 16; ++r) mx = fmaxf(mx, fmaxf(p0[r], p1[r]));
    mx = halfmax(mx);
    const float mn = fmaxf(m, mx), alpha = __builtin_amdgcn_exp2f(m - mn); m = mn;
    float rs = 0.f;
#pragma unroll
    for (int r = 0; r < 16; ++r) rs += __builtin_amdgcn_exp2f(p0[r] - mn) + __builtin_amdgcn_exp2f(p1[r] - mn);
    l = l * alpha + rs;
}

template <int KCH, int VCH> struct Stage { u32x4 k[KCH / 8], v[VCH / 8], x; };
template <int KCH, int VCH, bool XROW>
__device__ __forceinline__ void stage_load(Stage<KCH, VCH>& sg, const bf16* ksrc, const bf16* vsrc, const float* xsrc, size_t pitch, int key0, int tid) {
#pragma unroll
    for (int i = 0; i < KCH / 8; ++i) { const int idx = tid + 512 * i, key = idx / KCH, c = idx % KCH; sg.k[i] = *(const u32x4*)(ksrc + (size_t)(key0 + key) * pitch + 8 * c); }
#pragma unroll
    for (int i = 0; i < VCH / 8; ++i) { const int idx = tid + 512 * i, key = idx / VCH, c = idx % VCH; sg.v[i] = *(const u32x4*)(vsrc + (size_t)(key0 + key) * pitch + 8 * c); }
    if (XROW) sg.x = *(const u32x4*)(xsrc + key0 + 4 * (tid & 15));
}
template <int KCH, int VCH, bool XROW>
__device__ __forceinline__ void stage_write(const Stage<KCH, VCH>& sg, LAS unsigned char* kb, LAS unsigned char* vb, LAS unsigned char* xb, int tid) {
#pragma unroll
    for (int i = 0; i < KCH / 8; ++i) { const int idx = tid + 512 * i, key = idx / KCH, c = idx % KCH; *(LAS u32x4*)(kb + koff(key, c)) = sg.k[i]; }
#pragma unroll
    for (int i = 0; i < VCH / 8; ++i) { const int idx = tid + 512 * i, key = idx / VCH, c = idx % VCH; *(LAS u32x4*)(vb + voff(key, c)) = sg.v[i]; }
    if (XROW) { if (tid < 16) { f32x4 xv = __builtin_bit_cast(f32x4, sg.x); xv = xv * LOG2E; *(LAS f32x4*)(xb + 16 * tid) = xv; } }
}

template <int KCH, int VCH, bool XROW, int NST  , bool QLDS, class Fn>
__device__ __forceinline__ void kv_loop(Fn& fn, const bf16x8 (&qf)[4], LAS const unsigned char* qb, int kchunk0, const bf16* ksrc, const bf16* vsrc, const float* xsrc, size_t pitch, int t_lo, int t_hi,
                                        LAS unsigned char* KB, LAS unsigned char* VB, LAS unsigned char* XB, int tid, int lane) {
    constexpr int KBYTES = KCH * 1024, VBYTES = VCH * 1024;
    const int r32 = lane & 31, hi = lane >> 5, nt = t_hi - t_lo;
    if (NST == 1) {
        Stage<KCH, VCH> sg;
        stage_load<KCH, VCH, XROW>(sg, ksrc, vsrc, xsrc, pitch, 64 * t_lo, tid);
        stage_write<KCH, VCH, XROW>(sg, KB, VB, XB, tid);
        __syncthreads();
        for (int i = 0; i < nt; ++i) {
            const int b = i & 1;
            if (i + 1 < nt) stage_load<KCH, VCH, XROW>(sg, ksrc, vsrc, xsrc, pitch, 64 * (t_lo + i + 1), tid);
            if (fn.need(t_lo + i)) { f32x16 p0, p1; qk_tile<QLDS>(p0, p1, KB + b * KBYTES, kchunk0, qf, qb, r32, hi); fn.tile(t_lo + i, p0, p1, VB + b * VBYTES, XB + b * 256); }
            if (i + 1 < nt) stage_write<KCH, VCH, XROW>(sg, KB + (b ^ 1) * KBYTES, VB + (b ^ 1) * VBYTES, XB + (b ^ 1) * 256, tid);
            __syncthreads();
        }
        return;
    }
    Stage<KCH, VCH> sgA, sgB;
    stage_load<KCH, VCH, XROW>(sgA, ksrc, vsrc, xsrc, pitch, 64 * t_lo, tid);
    if (nt > 1) stage_load<KCH, VCH, XROW>(sgB, ksrc, vsrc, xsrc, pitch, 64 * (t_lo + 1), tid);
    stage_write<KCH, VCH, XROW>(sgA, KB, VB, XB, tid);
    __syncthreads();
    for (int i = 0; i < nt; i += 2) {
        if (i + 2 < nt) stage_load<KCH, VCH, XROW>(sgA, ksrc, vsrc, xsrc, pitch, 64 * (t_lo + i + 2), tid);
        if (fn.need(t_lo + i)) { f32x16 p0, p1; qk_tile<QLDS>(p0, p1, KB, kchunk0, qf, qb, r32, hi); fn.tile(t_lo + i, p0, p1, VB, XB); }
        if (i + 1 < nt) stage_write<KCH, VCH, XROW>(sgB, KB + KBYTES, VB + VBYTES, XB + 256, tid);
        __syncthreads();
        if (i + 1 >= nt) break;
        if (i + 3 < nt) stage_load<KCH, VCH, XROW>(sgB, ksrc, vsrc, xsrc, pitch, 64 * (t_lo + i + 3), tid);
        if (fn.need(t_lo + i + 1)) { f32x16 p0, p1; qk_tile<QLDS>(p0, p1, KB + KBYTES, kchunk0, qf, qb, r32, hi); fn.tile(t_lo + i + 1, p0, p1, VB + VBYTES, XB + 256); }
        if (i + 2 < nt) stage_write<KCH, VCH, XROW>(sgA, KB, VB, XB, tid);
        __syncthreads();
    }
}

#define SGB(mask, n) __builtin_amdgcn_sched_group_barrier(mask, n, 0)
template <int NDT>
__device__ __forceinline__ void sp_finish(AState<NDT>& st, f32x16& s0, f32x16& s1, bf16x8 (&pw)[4]) {
    float rs = 0.f;
#pragma unroll
    for (int r = 0; r < 16; ++r) { s0[r] = __builtin_amdgcn_exp2f(s0[r]); s1[r] = __builtin_amdgcn_exp2f(s1[r]); rs += s0[r] + s1[r]; }
    st.l += rs;
    pack_p(pw, s0, s1);
}
__device__ __forceinline__ float sp_rowmax(const f32x16& p0, const f32x16& p1) {
    float ma = max3f(p0[0], p0[1], p0[2]), mb = max3f(p1[0], p1[1], p1[2]);
#pragma unroll
    for (int r = 3; r < 15; r += 2) { ma = max3f(ma, p0[r], p0[r + 1]); mb = max3f(mb, p1[r], p1[r + 1]); }
    return max3f(ma, mb, fmaxf(p0[15], p1[15]));
}
template <int NDT>
__device__ __forceinline__ void sp_raise(AState<NDT>& st, f32x16& p0, f32x16& p1, float mx) {
    mx = halfmax(mx);
    if (__any(mx > SM_THR)) {
        const float d = fmaxf(mx, 0.f), alpha = __builtin_amdgcn_exp2f(-d); st.m += d; st.l *= alpha;
#pragma unroll
        for (int r = 0; r < 16; ++r) { p0[r] -= d; p1[r] -= d; }
#pragma unroll
        for (int dt = 0; dt < NDT; ++dt)
#pragma unroll
            for (int r = 0; r < 16; ++r) st.o[dt][r] *= alpha;
    }
}
__device__ __forceinline__ void sp_finish_part(int j, float& rs, f32x16& s0, f32x16& s1, u32x4 (&pu)[4]) {
#pragma unroll
    for (int r = 4 * j; r < 4 * j + 4; ++r) { s0[r] = __builtin_amdgcn_exp2f(s0[r]); s1[r] = __builtin_amdgcn_exp2f(s1[r]); rs += s0[r] + s1[r]; }
    const unsigned a0 = cvtpk(s0[4 * j], s0[4 * j + 1]), a1 = cvtpk(s0[4 * j + 2], s0[4 * j + 3]), b0 = cvtpk(s1[4 * j], s1[4 * j + 1]), b1 = cvtpk(s1[4 * j + 2], s1[4 * j + 3]);
    if (j & 1) { pu[j >> 1].z = a0; pu[j >> 1].w = a1; pu[2 + (j >> 1)].z = b0; pu[2 + (j >> 1)].w = b1; }
    else       { pu[j >> 1].x = a0; pu[j >> 1].y = a1; pu[2 + (j >> 1)].x = b0; pu[2 + (j >> 1)].y = b1; }
}
#define SP_STEADY(T, KBUF, XBUF, SP0, SP1, SN0, SN1)                                                                                                    \
    {   bf16x8 ka[4], kb[4], q[4];                                                                                                                      \
        _Pragma("unroll") for (int d0 = 0; d0 < 4; ++d0) { const int c = kchunk0 + 2 * d0 + hi;                                                         \
            ka[d0] = *(const LAS bf16x8*)((KBUF) + koff(r32, c)); kb[d0] = *(const LAS bf16x8*)((KBUF) + koff(r32 + 32, c));                             \
            q[d0] = QLDS ? *(const LAS bf16x8*)(qb + d0 * 8192) : qf[d0]; }                                                                             \
        LAS const unsigned char* vb = vfrag_base(VB + vp * VBYTES, lane);                                                                               \
        VFrag f0, f1; u32x4 pu[4]; float rs = 0.f;                                                                                                      \
        __builtin_amdgcn_sched_barrier(0);                                                                                                              \
        SN0 = (f32x16){}; SN1 = (f32x16){};                                                                                                             \
        _Pragma("unroll") for (int j = 0; j < 4; ++j) {                                                                                                 \
            SN0 = MFMA32(ka[j], q[j], SN0); SN1 = MFMA32(kb[j], q[j], SN1);                                                                             \
            sp_finish_part(j, rs, SP0, SP1, pu);                                                                                                        \
            if (NDT == 2 && j == 2) vfrag_read(f0, vb, 0);                                                                                              \
            if (NDT == 2 && j == 3) vfrag_read(f1, vb, 1);                                                                                              \
            __builtin_amdgcn_sched_barrier(0);                                                                                                          \
        }                                                                                                                                               \
        fn.st.l += rs;                                                                                                                                  \
        _Pragma("unroll") for (int k = 0; k < 4; ++k) pw[k] = __builtin_bit_cast(bf16x8, pu[k]);                                                        \
        float mx = NEG;                                                                                                                                 \
        _Pragma("unroll") for (int dt = 0; dt < NDT; dt += 2) {                                                                                         \
            if (NDT != 2) { vfrag_read(f0, vb, dt); vfrag_read(f1, vb, dt + 1); __builtin_amdgcn_sched_barrier(0); }                                    \
            _Pragma("unroll") for (int sx = 0; sx < 4; ++sx) {                                                                                          \
                { const bf16x8 vf = (bf16x8){f0.lo[sx][0], f0.lo[sx][1], f0.lo[sx][2], f0.lo[sx][3], f0.hh[sx][0], f0.hh[sx][1], f0.hh[sx][2], f0.hh[sx][3]}; fn.st.o[dt] = MFMA32(vf, pw[sx], fn.st.o[dt]); } \
                { const bf16x8 vf = (bf16x8){f1.lo[sx][0], f1.lo[sx][1], f1.lo[sx][2], f1.lo[sx][3], f1.hh[sx][0], f1.hh[sx][1], f1.hh[sx][2], f1.hh[sx][3]}; fn.st.o[dt + 1] = MFMA32(vf, pw[sx], fn.st.o[dt + 1]); } \
                if (dt == 0) { fn.score_part(sx, T, SN0, SN1, XBUF); mx = fn.max_part(sx, mx, SN0, SN1); }                                              \
                __builtin_amdgcn_sched_barrier(0);                                                                                                      \
            }                                                                                                                                           \
        }                                                                                                                                               \
        mx = fn.score_mask(T, mx, SN0, SN1);                                                                                                            \
        sp_raise<NDT>(fn.st, SN0, SN1, mx); }
template <int KCH, int VCH, bool XROW, bool QLDS, int NDT, class Fn>
__device__ __forceinline__ void kv_loop_sp(Fn& fn, const bf16x8 (&qf)[4], LAS const unsigned char* qb, int kchunk0, const bf16* ksrc, const bf16* vsrc, const float* xsrc, size_t pitch, int t_lo, int t_hi, int nw,
                                           LAS unsigned char* KB, LAS unsigned char* VB, LAS unsigned char* XB, int tid, int lane) {
    constexpr int KBYTES = KCH * 1024, VBYTES = VCH * 1024;
    const int r32 = lane & 31, hi = lane >> 5, nt = t_hi - t_lo;
    Stage<KCH, VCH> sg;
    stage_load<KCH, VCH, XROW>(sg, ksrc, vsrc, xsrc, pitch, 64 * t_lo, tid);
    stage_write<KCH, VCH, XROW>(sg, KB, VB, XB, tid);
    __syncthreads();
    f32x16 sa0, sa1, sb0, sb1; bf16x8 pw[4];
    int vc = 0, vp = 2, vn, i = 0;
#define SP_PRE(I)  if ((I) + 1 < nt) stage_load<KCH, VCH, XROW>(sg, ksrc, vsrc, xsrc, pitch, 64 * (t_lo + (I) + 1), tid);
#define SP_POST(I, KOFFN, XOFFN) vn = vc == 2 ? 0 : vc + 1; if ((I) + 1 < nt) stage_write<KCH, VCH, XROW>(sg, KB + (KOFFN), VB + vn * VBYTES, XB + (XOFFN), tid); __syncthreads(); vp = vc; vc = vn;
    SP_PRE(0)
    qk_tile<QLDS>(sa0, sa1, KB, kchunk0, qf, qb, r32, hi); fn.score(t_lo, sa0, sa1, XB); sp_raise<NDT>(fn.st, sa0, sa1, sp_rowmax(sa0, sa1));
    SP_POST(0, KBYTES, 256)
    i = 1;
    while (i + 1 < nw) {
        SP_PRE(i)
        SP_STEADY(t_lo + i, KB + KBYTES, XB + 256, sa0, sa1, sb0, sb1)
        SP_POST(i, 0, 0)
        SP_PRE(i + 1)
        SP_STEADY(t_lo + i + 1, KB, XB, sb0, sb1, sa0, sa1)
        SP_POST(i + 1, KBYTES, 256)
        i += 2;
    }
    if (i < nw) {
        SP_PRE(i)
        SP_STEADY(t_lo + i, KB + KBYTES, XB + 256, sa0, sa1, sb0, sb1)
        SP_POST(i, 0, 0)
        sa0 = sb0; sa1 = sb1; ++i;
    }
    if (i < nt) { SP_PRE(i) }
    sp_finish<NDT>(fn.st, sa0, sa1, pw); pv_tile<NDT>(fn.st.o, pw, VB + vp * VBYTES, lane);
    if (i < nt) { const int ko = (i & 1) ? 0 : KBYTES, xo = (i & 1) ? 0 : 256; SP_POST(i, ko, xo) ++i; }
    while (i < nt) { const int ko = (i & 1) ? 0 : KBYTES, xo = (i & 1) ? 0 : 256; SP_PRE(i) SP_POST(i, ko, xo) ++i; }
    __syncthreads();
#undef SP_PRE
#undef SP_POST
}

struct FoxFn {
    AState<2> st; float cq; int tq, tmin, tmax, lane;
    __device__ __forceinline__ bool need(int t) const { return 64 * t <= tmax; }
    __device__ __forceinline__ void score_part(int a, int t, f32x16& p0, f32x16& p1, LAS const unsigned char* xrow) {
        const int hi = lane >> 5; LAS const float* ck = (LAS const float*)xrow;
        const float cqm = cq - st.m;
        const f32x4 c0 = *(LAS const f32x4*)(ck + 8 * a + 4 * hi), c1 = *(LAS const f32x4*)(ck + 32 + 8 * a + 4 * hi);
#pragma unroll
        for (int i = 0; i < 4; ++i) { const int r = 4 * a + i; p0[r] = p0[r] * SCL2 + (cqm - c0[i]); p1[r] = p1[r] * SCL2 + (cqm - c1[i]); }
    }
    __device__ __forceinline__ float max_part(int a, float mx, const f32x16& p0, const f32x16& p1) const {
        return max3f(max3f(mx, p0[4 * a], p0[4 * a + 1]), max3f(p0[4 * a + 2], p0[4 * a + 3], p1[4 * a]), max3f(p1[4 * a + 1], p1[4 * a + 2], p1[4 * a + 3])); }
    __device__ __forceinline__ float score_mask(int t, float mx, f32x16& p0, f32x16& p1) const {
        const int hi = lane >> 5, k0 = 64 * t;
        if (k0 + 63 > tmin) {
#pragma unroll
            for (int r = 0; r < 16; ++r) { const int key = k0 + crow(r, hi); p0[r] = key <= tq ? p0[r] : NEG; p1[r] = key + 32 <= tq ? p1[r] : NEG; }
            mx = sp_rowmax(p0, p1);
        }
        return mx;
    }
    __device__ __forceinline__ void score(int t, f32x16& p0, f32x16& p1, LAS const unsigned char* xrow) {
#pragma unroll
        for (int a = 0; a < 4; ++a) score_part(a, t, p0, p1, xrow);
        score_mask(t, 0.f, p0, p1);
    }
};
__device__ __forceinline__ void fox_unit(int h, int qb, const bf16* PROJ, const float* CUM, bf16* MIX, LAS unsigned char* lds, int tid, int wid, int lane) {
    const int r32 = lane & 31, hi = lane >> 5, q0 = 256 * qb, tq = q0 + 32 * wid + r32;
    bf16x8 qf[4];
#pragma unroll
    for (int d0 = 0; d0 < 4; ++d0) qf[d0] = *(const bf16x8*)(PROJ + (size_t)tq * PITCH + C_BQ + 64 * h + 16 * d0 + 8 * hi);
    const float* cum = CUM + (size_t)h * S;
    FoxFn fn; astate_init<2>(fn.st); fn.cq = cum[tq] * LOG2E; fn.tq = tq; fn.tmin = q0 + 32 * wid; fn.tmax = q0 + 32 * wid + 31; fn.lane = lane;
    kv_loop_sp<8, 8, true, false, 2>(fn, qf, lds, 0, PROJ + C_BK + 64 * h, PROJ + C_BV + 64 * h, cum, PITCH, 0, 4 * (qb + 1), min(4 * (qb + 1), (fn.tmax >> 6) + 1), lds, lds + 16384, lds + 40960, tid, lane);
    const float lt = fn.st.l + __shfl_xor(fn.st.l, 32), inv = 1.0f / lt;
    bf16* orow = MIX + (size_t)tq * D + 512 + 64 * h;
#pragma unroll
    for (int dt = 0; dt < 2; ++dt)
#pragma unroll
        for (int a = 0; a < 4; ++a) { u32x2 w; w.x = cvtpk(fn.st.o[dt][4 * a] * inv, fn.st.o[dt][4 * a + 1] * inv); w.y = cvtpk(fn.st.o[dt][4 * a + 2] * inv, fn.st.o[dt][4 * a + 3] * inv);
            *(u32x2*)(orow + 32 * dt + 8 * a + 4 * hi) = w; }
}

struct DiffFn {
    AState<4> st; LAS const float* lut; int tq, tmin, tmax, lane;
    __device__ __forceinline__ bool need(int t) const { return 64 * t <= tmax; }
    __device__ __forceinline__ void tile(int t, f32x16& p0, f32x16& p1, LAS const unsigned char* vt, LAS const unsigned char*) {
        const int hi = lane >> 5, k0 = 64 * t;
        const float mref = st.m;
        if (k0 + 63 + 127 <= tmin) {
            const float b = lut[127] - mref;
#pragma unroll
            for (int r = 0; r < 16; ++r) { p0[r] = p0[r] * SCL2 + b; p1[r] = p1[r] * SCL2 + b; }
        } else {
#pragma unroll
            for (int r = 0; r < 16; ++r) { const int rel0 = tq - (k0 + crow(r, hi)); const float b0 = lut[min(max(rel0, 0), 127)] - mref; p0[r] = rel0 >= 0 ? p0[r] * SCL2 + b0 : NEG; }
            __builtin_amdgcn_sched_barrier(0);
#pragma unroll
            for (int r = 0; r < 16; ++r) { const int rel1 = tq - (k0 + 32 + crow(r, hi)); const float b1 = lut[min(max(rel1, 0), 127)] - mref; p1[r] = rel1 >= 0 ? p1[r] * SCL2 + b1 : NEG; }
            __builtin_amdgcn_sched_barrier(0);
        }
        softmax_pv<4>(st, p0, p1, vt, lane);
    }
};
__device__ __forceinline__ void diff_unit(int h, int qb, int l, const Args& a, const bf16* PROJ, bf16* MIX, LAS unsigned char* lds, int tid, int wid, int lane) {
    const int r32 = lane & 31, hi = lane >> 5, q0 = 128 * qb, map = wid & 1, qs = wid >> 1, tq = q0 + 32 * qs + r32;
    LAS float* lut = (LAS float*)(lds + 65536); LAS float* lamw = (LAS float*)(lds + 65536 + 512);
    const float lam_init = 0.8f - 0.6f * expf(-0.3f * (float)l);
    if (tid < 128) lut[tid] = a.in[12][t5_bucket(tid) * 20 + h] * LOG2E;
    if (wid == 0) { const float* dl = a.in[3] + (size_t)l * 256;
        const float s1 = wave_sum(dl[lane] * dl[64 + lane]), s2 = wave_sum(dl[128 + lane] * dl[192 + lane]);
        if (lane == 0) lamw[0] = expf(s1) - expf(s2) + lam_init; }
    bf16x8 qf[4];
#pragma unroll
    for (int d0 = 0; d0 < 4; ++d0) qf[d0] = *(const bf16x8*)(PROJ + (size_t)tq * PITCH + C_AQ + 128 * h + 64 * map + 16 * d0 + 8 * hi);
    DiffFn fn; astate_init<4>(fn.st); fn.lut = lut; fn.tq = tq; fn.tmin = q0 + 32 * qs; fn.tmax = q0 + 32 * qs + 31; fn.lane = lane;
    LAS unsigned char* const qlds = lds + 67584 + tid * 16;
#pragma unroll
    for (int d0 = 0; d0 < 4; ++d0) *(LAS bf16x8*)(qlds + d0 * 8192) = qf[d0];
    kv_loop<16, 16, false, 1, true>(fn, qf, qlds, 8 * map, PROJ + C_AK + 128 * h, PROJ + C_AV + 128 * h, nullptr, PITCH, 0, 2 * (qb + 1), lds, lds + 32768, lds, tid, lane);
    const float lt = fn.st.l + __shfl_xor(fn.st.l, 32), inv = 1.0f / lt;
    LAS float* ex = (LAS float*)(lds + qs * 16384);
    if (map == 1) {
#pragma unroll
        for (int dt = 0; dt < 4; ++dt)
#pragma unroll
            for (int r = 0; r < 16; ++r) ex[(32 * dt + crow(r, hi)) * 32 + r32] = fn.st.o[dt][r] * inv;
    }
    __syncthreads();
    if (map == 0) {
        const float lam = lamw[0]; float ss = 0.f;
#pragma unroll
        for (int dt = 0; dt < 4; ++dt)
#pragma unroll
            for (int r = 0; r < 16; ++r) { const float v = fn.st.o[dt][r] * inv - lam * ex[(32 * dt + crow(r, hi)) * 32 + r32]; fn.st.o[dt][r] = v; ss += v * v; }
        ss += __shfl_xor(ss, 32);
        const float rstd = (1.0f / sqrtf(ss * (1.0f / 128.0f) + RMS_EPS)) * (1.0f - lam_init);
        const float* sub = a.in[4] + (size_t)l * 128; bf16* orow = MIX + (size_t)tq * D + 128 * h;
#pragma unroll
        for (int dt = 0; dt < 4; ++dt)
#pragma unroll
            for (int q4 = 0; q4 < 4; ++q4) { const int d = 32 * dt + 8 * q4 + 4 * hi; const f32x4 g = *(const f32x4*)(sub + d);
                u32x2 w; w.x = cvtpk(fn.st.o[dt][4 * q4] * rstd * g.x, fn.st.o[dt][4 * q4 + 1] * rstd * g.y); w.y = cvtpk(fn.st.o[dt][4 * q4 + 2] * rstd * g.z, fn.st.o[dt][4 * q4 + 3] * rstd * g.w);
                *(u32x2*)(orow + d) = w; }
    }
    __syncthreads();
}

#ifndef NSA_DUP
#define NSA_DUP 0
#endif
constexpr int IMP_P = 132;
__device__ __forceinline__ float quad_sum(float v) {
    v += __builtin_bit_cast(float, __builtin_amdgcn_mov_dpp(__builtin_bit_cast(int, v), 0xB1, 0xF, 0xF, true));
    v += __builtin_bit_cast(float, __builtin_amdgcn_mov_dpp(__builtin_bit_cast(int, v), 0x4E, 0xF, 0xF, true));
    return v; }
#define LADD(p, v) (void)__hip_atomic_fetch_add((p), (v), __ATOMIC_RELAXED, __HIP_MEMORY_SCOPE_WORKGROUP)
constexpr int NSA_QF = 32768, NSA_SELW = 65536, NSA_LUT = 66560, NSA_IMP = 69632, NSA_FIN = 69632;

struct CmpStatFn {
    float m, l; int tq, lane, ncnt;
    __device__ __forceinline__ bool need(int) const { return true; }
    __device__ __forceinline__ void tile(int t, f32x16& p0, f32x16& p1, LAS const unsigned char*, LAS const unsigned char*) {
        const int hi = lane >> 5, n0 = 64 * t;
#pragma unroll
        for (int r = 0; r < 16; ++r) { const int n = n0 + crow(r, hi);
            p0[r] = (16 * n + 31 <= tq) ? p0[r] * SCL2 : NEG; p1[r] = (16 * (n + 32) + 31 <= tq) ? p1[r] * SCL2 : NEG; }
        softmax_stats(m, l, p0, p1);
    }
};
struct CmpPvFn {
    f32x16 o[2]; float m, invl; int tq, ql, lane; LAS float* imp;
    __device__ __forceinline__ bool need(int) const { return true; }
    __device__ __forceinline__ void tile(int t, f32x16& p0, f32x16& p1, LAS const unsigned char* vt, LAS const unsigned char*) {
        const int hi = lane >> 5, n0 = 64 * t;
#pragma unroll
        for (int r = 0; r < 16; ++r) { const int n = n0 + crow(r, hi);
            p0[r] = (16 * n + 31 <= tq) ? __builtin_amdgcn_exp2f(p0[r] * SCL2 - m) * invl : 0.f;
            p1[r] = (16 * (n + 32) + 31 <= tq) ? __builtin_amdgcn_exp2f(p1[r] * SCL2 - m) * invl : 0.f; }
        LAS float* row = imp + ql * IMP_P;
        const bool lead = (lane & 3) == 0;
#pragma unroll
        for (int a = 0; a < 4; ++a) {
            const int j0 = (n0 >> 2) + 2 * a + hi, j1 = j0 + 8;
            const float h0 = quad_sum(0.5f * p0[4 * a + 3]), h1 = quad_sum(0.5f * p1[4 * a + 3]);
            const float b0 = quad_sum(p0[4 * a] + p0[4 * a + 1] + p0[4 * a + 2]) + h0, b1 = quad_sum(p1[4 * a] + p1[4 * a + 1] + p1[4 * a + 2]) + h1;
            if (lead) {
                LADD(row + j0, b0);
                if (j0 + 1 < 128) LADD(row + j0 + 1, h0);
                if (j1 < 128) LADD(row + j1, b1);
                if (j1 + 1 < 128) LADD(row + j1 + 1, h1);
            }
        }
        bf16x8 pw[4]; pack_p(pw, p0, p1);
        pv_tile<2>(o, pw, vt, lane);
    }
};
struct SelFn {
    AState<2> st; LAS const float* lut; int tq, tmin, tmax, lane, mode; unsigned sw0, sw1, sw2, sw3, uw0, uw1, uw2, uw3;
    __device__ __forceinline__ unsigned pick(int j, unsigned a, unsigned b, unsigned c, unsigned d) const { const int w = j >> 5; const unsigned x = (w == 0) ? a : (w == 1) ? b : (w == 2) ? c : d; return (x >> (j & 31)) & 1u; }
    __device__ __forceinline__ bool need(int t) const { return mode == 1 || pick(t, uw0, uw1, uw2, uw3) != 0u; }
    __device__ __forceinline__ void tile(int t, f32x16& p0, f32x16& p1, LAS const unsigned char* vt, LAS const unsigned char*) {
        const int hi = lane >> 5, k0 = 64 * t;
        const bool bit = (mode == 1) || pick(t, sw0, sw1, sw2, sw3) != 0u;
        const bool far = k0 + 63 + 127 <= tmin;
        const bool wcut = (mode == 1) && (tmax - k0 >= 512);
        const float mref = st.m;
        if (far && !wcut) {
            const float b = lut[127] - mref;
#pragma unroll
            for (int r = 0; r < 16; ++r) { p0[r] = bit ? p0[r] * SCL2 + b : NEG; p1[r] = bit ? p1[r] * SCL2 + b : NEG; }
        } else {
#pragma unroll
            for (int r = 0; r < 16; ++r) { const int rel0 = tq - (k0 + crow(r, hi));
                const float b0 = lut[min(max(rel0, 0), 127)] - mref;
                const bool ok0 = bit && rel0 >= 0 && (mode == 0 || rel0 < 512);
                p0[r] = ok0 ? p0[r] * SCL2 + b0 : NEG; }
            __builtin_amdgcn_sched_barrier(0);
#pragma unroll
            for (int r = 0; r < 16; ++r) { const int rel1 = tq - (k0 + 32 + crow(r, hi));
                const float b1 = lut[min(max(rel1, 0), 127)] - mref;
                const bool ok1 = bit && rel1 >= 0 && (mode == 0 || rel1 < 512);
                p1[r] = ok1 ? p1[r] * SCL2 + b1 : NEG; }
            __builtin_amdgcn_sched_barrier(0);
        }
        softmax_pv<2>(st, p0, p1, vt, lane);
    }
};

__device__ __forceinline__ void nsa_unit(int g, int qb, const Args& a, const bf16* PROJ, const float* AUX, const bf16* KC, const bf16* VC, bf16* MIX, LAS unsigned char* lds, int tid, int wid, int lane) {
    const int r32 = lane & 31, hi = lane >> 5, q0 = 64 * qb, cur = qb, ql = 8 * wid + (r32 >> 2), hp = r32 & 3, tq = q0 + ql, head = 4 * g + hp;
    LAS float* imp = (LAS float*)(lds + NSA_IMP); LAS unsigned* selw = (LAS unsigned*)(lds + NSA_SELW); LAS float* lut = (LAS float*)(lds + NSA_LUT);
#pragma unroll
    for (int i = 0; i < 17; ++i) { const int e_ = tid + 512 * i; if (e_ < 64 * IMP_P) imp[e_] = 0.f; }
    if (tid < 256) selw[tid] = 0u;
    lut[tid] = a.in[12][t5_bucket(tid & 127) * 20 + 4 + 4 * g + (tid >> 7)] * LOG2E;
    bf16x8 qf[4];
#pragma unroll
    for (int d0 = 0; d0 < 4; ++d0) qf[d0] = *(const bf16x8*)(PROJ + (size_t)tq * PITCH + C_CQ + 64 * head + 16 * d0 + 8 * hi);
    LAS unsigned char* const qlds = lds + NSA_QF + tid * 16;
#pragma unroll
    for (int d0 = 0; d0 < 4; ++d0) *(LAS bf16x8*)(qlds + d0 * 8192) = qf[d0];
    const float* ga = AUX + (size_t)tq * 64 + 8 + head;
    const float gc = 1.0f / (1.0f + __expf(-ga[0])), gs = 1.0f / (1.0f + __expf(-ga[16])), gwn = 1.0f / (1.0f + __expf(-ga[32]));
    LAS float* finl = (LAS float*)(lds + NSA_FIN) + tid;
    f32x16 oc0, oc1;
    {
        int ncnt = (q0 + 32) / 16 + 1; ncnt = ncnt > 511 ? 511 : ncnt; const int ntc = (ncnt + 63) >> 6;
        const bf16* kc = KC + (size_t)g * 512 * 64; const bf16* vc = VC + (size_t)g * 512 * 64;
        CmpStatFn f1; f1.m = NEG; f1.l = 0.f; f1.tq = tq; f1.lane = lane; f1.ncnt = ncnt;
        kv_loop<8, 8, false, 1, true>(f1, qf, qlds, 0, kc, vc, nullptr, 64, 0, ntc, lds, lds + 16384, lds, tid, lane);
        if (NSA_DUP & 1) { f1.m = NEG; f1.l = 0.f; kv_loop<8, 8, false, 1, true>(f1, qf, qlds, 0, kc, vc, nullptr, 64, 0, ntc, lds, lds + 16384, lds, tid, lane); }
        const float lt = f1.l + __shfl_xor(f1.l, 32);
        CmpPvFn f2; f2.o[0] = (f32x16){}; f2.o[1] = (f32x16){}; f2.m = f1.m; f2.invl = (tq >= 31) ? 1.0f / lt : 0.f; f2.tq = tq; f2.ql = ql; f2.lane = lane; f2.imp = imp;
        if (NSA_DUP & 16) { kv_loop<8, 8, false, 1, true>(f2, qf, qlds, 0, kc, vc, nullptr, 64, 0, ntc, lds, lds + 16384, lds, tid, lane); f2.o[0] = (f32x16){}; f2.o[1] = (f32x16){};
#pragma unroll
            for (int i = 0; i < 17; ++i) { const int e_ = tid + 512 * i; if (e_ < 64 * IMP_P) imp[e_] = 0.f; }
            __syncthreads(); }
        kv_loop<8, 8, false, 1, true>(f2, qf, qlds, 0, kc, vc, nullptr, 64, 0, ntc, lds, lds + 16384, lds, tid, lane);
        oc0 = f2.o[0]; oc1 = f2.o[1];
    }
    for (int rep_ = 0; rep_ < ((NSA_DUP & 2) ? 2 : 1); ++rep_)
    if (cur < 16) { if (tid < 64) selw[tid * 4] = (2u << cur) - 1u; }
    else {
        const int qq = tid >> 3, sub = tid & 7;
        float val[16];
#pragma unroll
        for (int i = 0; i < 16; ++i) { const int j = 16 * sub + i; val[i] = (j >= 1 && j <= cur - 2) ? imp[qq * IMP_P + j] : -1.0f; }
        unsigned bits = 0u;
        for (int round = 0; round < 13; ++round) {
            float bv = val[0]; int bi = 0;
#pragma unroll
            for (int i = 1; i < 16; ++i) if (val[i] > bv) { bv = val[i]; bi = i; }
            int gj = 16 * sub + bi;
            { const float ov = __builtin_bit_cast(float, __builtin_amdgcn_mov_dpp(__builtin_bit_cast(int, bv), 0xB1, 0xF, 0xF, true)); const int oj = __builtin_amdgcn_mov_dpp(gj, 0xB1, 0xF, 0xF, true); if (ov > bv || (ov == bv && oj < gj)) { bv = ov; gj = oj; } }
            { const float ov = __builtin_bit_cast(float, __builtin_amdgcn_mov_dpp(__builtin_bit_cast(int, bv), 0x4E, 0xF, 0xF, true)); const int oj = __builtin_amdgcn_mov_dpp(gj, 0x4E, 0xF, 0xF, true); if (ov > bv || (ov == bv && oj < gj)) { bv = ov; gj = oj; } }
            { const float ov = __shfl_xor(bv, 4); const int oj = __shfl_xor(gj, 4); if (ov > bv || (ov == bv && oj < gj)) { bv = ov; gj = oj; } }
            const bool mine = (gj >> 4) == sub;
#pragma unroll
            for (int i = 0; i < 16; ++i) if (mine && (gj & 15) == i) { val[i] = -2.0f; bits |= 1u << i; }
        }
        if (sub == 0) bits |= 1u;
        if (((cur - 1) >> 4) == sub) bits |= 1u << ((cur - 1) & 15);
        if ((cur >> 4) == sub) bits |= 1u << (cur & 15);
        (void)__hip_atomic_fetch_or(selw + qq * 4 + (sub >> 1), bits << (16 * (sub & 1)), __ATOMIC_RELAXED, __HIP_MEMORY_SCOPE_WORKGROUP);
    }
    __syncthreads();
#pragma unroll
    for (int r = 0; r < 16; ++r) { finl[512 * r] = gc * oc0[r]; finl[512 * (16 + r)] = gc * oc1[r]; }
    SelFn fs; fs.lut = lut + hp * 128; fs.tq = tq; fs.tmin = q0 + 8 * wid; fs.tmax = q0 + 8 * wid + 7; fs.lane = lane;
    fs.sw0 = selw[ql * 4 + 0]; fs.sw1 = selw[ql * 4 + 1]; fs.sw2 = selw[ql * 4 + 2]; fs.sw3 = selw[ql * 4 + 3];
    { unsigned u0 = 0u, u1 = 0u, u2 = 0u, u3 = 0u;
#pragma unroll
      for (int i = 0; i < 8; ++i) { u0 |= selw[(8 * wid + i) * 4 + 0]; u1 |= selw[(8 * wid + i) * 4 + 1]; u2 |= selw[(8 * wid + i) * 4 + 2]; u3 |= selw[(8 * wid + i) * 4 + 3]; }
      fs.uw0 = __builtin_amdgcn_readfirstlane(u0); fs.uw1 = __builtin_amdgcn_readfirstlane(u1); fs.uw2 = __builtin_amdgcn_readfirstlane(u2); fs.uw3 = __builtin_amdgcn_readfirstlane(u3); }
    fs.mode = 0; astate_init<2>(fs.st);
    kv_loop<8, 8, false, 1, true>(fs, qf, qlds, 0, PROJ + C_KS + 64 * g, PROJ + C_VS + 64 * g, nullptr, PITCH, 0, cur + 1, lds, lds + 16384, lds, tid, lane);
    if (NSA_DUP & 4) { astate_init<2>(fs.st); kv_loop<8, 8, false, 1, true>(fs, qf, qlds, 0, PROJ + C_KS + 64 * g, PROJ + C_VS + 64 * g, nullptr, PITCH, 0, cur + 1, lds, lds + 16384, lds, tid, lane); }
    { const float lt = fs.st.l + __shfl_xor(fs.st.l, 32), sc = gs / lt;
#pragma unroll
      for (int r = 0; r < 16; ++r) { finl[512 * r] += sc * fs.st.o[0][r]; finl[512 * (16 + r)] += sc * fs.st.o[1][r]; } }
    fs.mode = 1; astate_init<2>(fs.st);
    kv_loop<8, 8, false, 1, true>(fs, qf, qlds, 0, PROJ + C_KW + 64 * g, PROJ + C_VW + 64 * g, nullptr, PITCH, cur >= 8 ? cur - 8 : 0, cur + 1, lds, lds + 16384, lds, tid, lane);
    if (NSA_DUP & 8) { astate_init<2>(fs.st); kv_loop<8, 8, false, 1, true>(fs, qf, qlds, 0, PROJ + C_KW + 64 * g, PROJ + C_VW + 64 * g, nullptr, PITCH, cur >= 8 ? cur - 8 : 0, cur + 1, lds, lds + 16384, lds, tid, lane); }
    { const float lt = fs.st.l + __shfl_xor(fs.st.l, 32), sc = gwn / lt;
#pragma unroll
      for (int r = 0; r < 16; ++r) { fs.st.o[0][r] = finl[512 * r] + sc * fs.st.o[0][r]; fs.st.o[1][r] = finl[512 * (16 + r)] + sc * fs.st.o[1][r]; } }
    bf16* orow = MIX + (size_t)tq * D + 1024 + 64 * head;
#pragma unroll
    for (int dt = 0; dt < 2; ++dt)
#pragma unroll
        for (int q4 = 0; q4 < 4; ++q4) { u32x2 w; w.x = cvtpk(fs.st.o[dt][4 * q4], fs.st.o[dt][4 * q4 + 1]); w.y = cvtpk(fs.st.o[dt][4 * q4 + 2], fs.st.o[dt][4 * q4 + 3]); *(u32x2*)(orow + 32 * dt + 8 * q4 + 4 * hi) = w; }
}

__device__ __forceinline__ int dequeue(unsigned* head, volatile LAS unsigned* slot, int tid) {
    if (tid == 0) *slot = __hip_atomic_fetch_add(head, 1u, __ATOMIC_RELAXED, __HIP_MEMORY_SCOPE_AGENT);
    __syncthreads();
    const int v = __builtin_amdgcn_readfirstlane((int)*slot);
    __syncthreads();
    return v;
}

constexpr int N2_HP = 4112, N2_PART = 66 * 1024, N2_LOG = 108 * 1024;
__device__ __forceinline__ void n2_unit(int u, int l, const Args& a, const bf16* X, bf16* XN, const bf16* RWT, unsigned* cnt, int* LIST, float* TW, LAS unsigned char* lds, int tid, int wid, int lane) {
    const float* gain = a.in[14] + (size_t)l * D;
#pragma unroll
    for (int rr = 0; rr < 2; ++rr) {
        const int lr = 2 * wid + rr, row = 16 * u + lr;
        const u32x2* xr = (const u32x2*)(X + (size_t)row * D) + lane;
        f32x4 v[8]; float ss = 0.f;
#pragma unroll
        for (int j = 0; j < 8; ++j) { const u32x2 r = xr[64 * j]; v[j] = (f32x4){bflo(r.x), bfhi(r.x), bflo(r.y), bfhi(r.y)}; ss += (v[j].x * v[j].x + v[j].y * v[j].y) + (v[j].z * v[j].z + v[j].w * v[j].w); }
        ss = wave_sum(ss);
        const float rstd = 1.0f / sqrtf(ss * (1.0f / D) + RMS_EPS);
        const f32x4* gr = (const f32x4*)gain + lane; u32x2* o8 = (u32x2*)(XN + (size_t)row * D) + lane;
#pragma unroll
        for (int j = 0; j < 8; ++j) { const f32x4 g = gr[64 * j]; u32x2 w; w.x = cvtpk(v[j].x * rstd * g.x, v[j].y * rstd * g.y); w.y = cvtpk(v[j].z * rstd * g.z, v[j].w * rstd * g.w);
            o8[64 * j] = w; *(LAS u32x2*)(lds + lr * N2_HP + (4 * lane + 256 * j) * 2) = w; }
    }
    __syncthreads();
    {
        const int fr = lane & 15, fq = lane >> 4;
        f32x4 acc[5];
#pragma unroll
        for (int nt = 0; nt < 5; ++nt) acc[nt] = (f32x4){0.f, 0.f, 0.f, 0.f};
        const bf16* rw = RWT + (size_t)l * 96 * D + (size_t)fr * D + 256 * wid + 8 * fq;
#pragma unroll
        for (int s = 0; s < 8; ++s) {
            const bf16x8 av = *(const LAS bf16x8*)(lds + fr * N2_HP + (256 * wid + 32 * s + 8 * fq) * 2);
#pragma unroll
            for (int nt = 0; nt < 5; ++nt) { const bf16x8 bv = *(const bf16x8*)(rw + (size_t)(16 * nt) * D + 32 * s); acc[nt] = MFMA16(av, bv, acc[nt]); }
        }
        LAS float* part = (LAS float*)(lds + N2_PART) + wid * 16 * 80;
#pragma unroll
        for (int nt = 0; nt < 5; ++nt)
#pragma unroll
            for (int i = 0; i < 4; ++i) part[(4 * fq + i) * 80 + 16 * nt + fr] = acc[nt][i];
    }
    __syncthreads();
    {
        LAS const float* part = (LAS const float*)(lds + N2_PART); LAS float* logit = (LAS float*)(lds + N2_LOG);
        for (int e = tid; e < 16 * 80; e += NTHR) { float s = 0.f;
#pragma unroll
            for (int w = 0; w < 8; ++w) s += part[w * 16 * 80 + e];
            logit[e] = s; }
    }
    __syncthreads();
    if (tid < 16) {
        LAS const float* lg = (LAS const float*)(lds + N2_LOG) + tid * 80;
        const float* bg = a.in[16] + l * 8; const float* be = a.in[18] + l * 64;
        float z[8]; float zm = -3.0e38f; int gi = 0;
#pragma unroll
        for (int i = 0; i < 8; ++i) { z[i] = lg[i] + bg[i]; if (z[i] > zm) { zm = z[i]; gi = i; } }
        float den = 0.f;
#pragma unroll
        for (int i = 0; i < 8; ++i) den += expf(z[i] - zm);
        const float gp = 1.0f / den;
        float e1 = -3.0e38f, e2 = -3.0e38f; int i1 = 0, i2 = 0;
#pragma unroll
        for (int i = 0; i < 8; ++i) { const float v = lg[8 + 8 * gi + i] + be[8 * gi + i];
            if (v > e1) { e2 = e1; i2 = i1; e1 = v; i1 = i; } else if (v > e2) { e2 = v; i2 = i; } }
        const float t2 = expf(e2 - e1), w1 = gp / (1.0f + t2), w2 = gp * t2 / (1.0f + t2);
        const int tok = 16 * u + tid, ea = 8 * gi + i1, eb = 8 * gi + i2;
        const unsigned pa = __hip_atomic_fetch_add(cnt + ea * 16, 1u, __ATOMIC_RELAXED, __HIP_MEMORY_SCOPE_AGENT);
        const unsigned pb = __hip_atomic_fetch_add(cnt + eb * 16, 1u, __ATOMIC_RELAXED, __HIP_MEMORY_SCOPE_AGENT);
        LIST[(size_t)ea * 16384 + pa] = 2 * tok; LIST[(size_t)eb * 16384 + pb] = 2 * tok + 1;
        TW[2 * tok] = w1; TW[2 * tok + 1] = w2;
    }
    __syncthreads();
}

constexpr int N2P_HALF = 16 * N2_HP, N2P_LOG = 2 * N2P_HALF;
__device__ __forceinline__ void n2_pair(int p, int l, const Args& a, const bf16* X, bf16* XN, const bf16* RWT, unsigned* cnt, int* LIST, float* TW, LAS unsigned char* lds, int tid, int wid, int lane) {
    const int half = wid >> 2, wl = wid & 3, u = 2 * p + half, th = tid & 255;
    LAS unsigned char* const hT = lds + half * N2P_HALF;
    const float* gain = a.in[14] + (size_t)l * D;
    {
        u32x2 raw[4][8];
#pragma unroll
        for (int rr = 0; rr < 4; ++rr) { const u32x2* xr = (const u32x2*)(X + (size_t)(16 * u + 4 * wl + rr) * D) + lane;
#pragma unroll
            for (int j = 0; j < 8; ++j) raw[rr][j] = xr[64 * j]; }
        f32x4 g[8]; { const f32x4* gr = (const f32x4*)gain + lane;
#pragma unroll
            for (int j = 0; j < 8; ++j) g[j] = gr[64 * j]; }
#pragma unroll
        for (int rr = 0; rr < 4; ++rr) {
            const int lr = 4 * wl + rr, row = 16 * u + lr;
            f32x4 v[8]; float ss = 0.f;
#pragma unroll
            for (int j = 0; j < 8; ++j) { const u32x2 r = raw[rr][j]; v[j] = (f32x4){bflo(r.x), bfhi(r.x), bflo(r.y), bfhi(r.y)}; ss += (v[j].x * v[j].x + v[j].y * v[j].y) + (v[j].z * v[j].z + v[j].w * v[j].w); }
            ss = wave_sum(ss);
            const float rstd = 1.0f / sqrtf(ss * (1.0f / D) + RMS_EPS);
            u32x2* o8 = (u32x2*)(XN + (size_t)row * D) + lane;
#pragma unroll
            for (int j = 0; j < 8; ++j) { u32x2 w; w.x = cvtpk(v[j].x * rstd * g[j].x, v[j].y * rstd * g[j].y); w.y = cvtpk(v[j].z * rstd * g[j].z, v[j].w * rstd * g[j].w);
                o8[64 * j] = w; *(LAS u32x2*)(hT + lr * N2_HP + (4 * lane + 256 * j) * 2) = w; }
        }
    }
    __syncthreads();
    const int fr = lane & 15, fq = lane >> 4;
    f32x4 acc[2][5];
#pragma unroll
    for (int hh = 0; hh < 2; ++hh)
#pragma unroll
        for (int nt = 0; nt < 5; ++nt) acc[hh][nt] = (f32x4){0.f, 0.f, 0.f, 0.f};
    {
        const bf16* rw = RWT + (size_t)l * 96 * D + (size_t)fr * D + 256 * wid + 8 * fq;
#pragma unroll 4
        for (int s = 0; s < 8; ++s) {
            const bf16x8 av0 = *(const LAS bf16x8*)(lds + fr * N2_HP + (256 * wid + 32 * s + 8 * fq) * 2);
            const bf16x8 av1 = *(const LAS bf16x8*)(lds + N2P_HALF + fr * N2_HP + (256 * wid + 32 * s + 8 * fq) * 2);
#pragma unroll
            for (int nt = 0; nt < 5; ++nt) { const bf16x8 bv = *(const bf16x8*)(rw + (size_t)(16 * nt) * D + 32 * s); acc[0][nt] = MFMA16(av0, bv, acc[0][nt]); acc[1][nt] = MFMA16(av1, bv, acc[1][nt]); }
        }
    }
    __syncthreads();
    {
        LAS float* part = (LAS float*)lds + wid * 32 * 80;
#pragma unroll
        for (int hh = 0; hh < 2; ++hh)
#pragma unroll
            for (int nt = 0; nt < 5; ++nt)
#pragma unroll
                for (int i = 0; i < 4; ++i) part[(16 * hh + 4 * fq + i) * 80 + 16 * nt + fr] = acc[hh][nt][i];
    }
    __syncthreads();
    {
        LAS const float* part = (LAS const float*)lds; LAS float* logit = (LAS float*)(lds + N2P_LOG);
        for (int e = tid; e < 32 * 80; e += NTHR) { float sres = 0.f;
#pragma unroll
            for (int w = 0; w < 8; ++w) sres += part[w * 32 * 80 + e];
            logit[e] = sres; }
    }
    __syncthreads();
    if (th < 16) {
        LAS const float* lg = (LAS const float*)(lds + N2P_LOG) + (16 * half + th) * 80;
        const float* bg = a.in[16] + l * 8; const float* be = a.in[18] + l * 64;
        float z[8]; float zm = -3.0e38f; int gi = 0;
#pragma unroll
        for (int i = 0; i < 8; ++i) { z[i] = lg[i] + bg[i]; if (z[i] > zm) { zm = z[i]; gi = i; } }
        float den = 0.f;
#pragma unroll
        for (int i = 0; i < 8; ++i) den += expf(z[i] - zm);
        const float gp = 1.0f / den;
        float e1 = -3.0e38f, e2 = -3.0e38f; int i1 = 0, i2 = 0;
#pragma unroll
        for (int i = 0; i < 8; ++i) { const float v = lg[8 + 8 * gi + i] + be[8 * gi + i];
            if (v > e1) { e2 = e1; i2 = i1; e1 = v; i1 = i; } else if (v > e2) { e2 = v; i2 = i; } }
        const float t2 = expf(e2 - e1), w1 = gp / (1.0f + t2), w2 = gp * t2 / (1.0f + t2);
        const int tok = 16 * u + th, ea = 8 * gi + i1, eb = 8 * gi + i2;
        const unsigned pa = __hip_atomic_fetch_add(cnt + ea * 16, 1u, __ATOMIC_RELAXED, __HIP_MEMORY_SCOPE_AGENT);
        const unsigned pb = __hip_atomic_fetch_add(cnt + eb * 16, 1u, __ATOMIC_RELAXED, __HIP_MEMORY_SCOPE_AGENT);
        LIST[(size_t)ea * 16384 + pa] = 2 * tok; LIST[(size_t)eb * 16384 + pb] = 2 * tok + 1;
        TW[2 * tok] = w1; TW[2 * tok + 1] = w2;
    }
    __syncthreads();
}

constexpr int MO_B = 65536, MO_BBUF = 16384, MO_A = 98304, MO_APITCH = 2176, MO_ABUF = 4 * MO_APITCH, MO_ROW = MO_A + 2 * MO_ABUF, MO_PRE = MO_ROW + 512;
constexpr int MO_STG = 117760;
static_assert(MO_PRE + 272 <= MO_STG && MO_STG + 8 * 4096 <= MISC_OFF, "MoE LDS map");
__device__ __forceinline__ int mo_aoff(int row, int c) { return c * MO_APITCH + ((row + 2 * c) << 4); }
__device__ __forceinline__ int mo_hoff(int row, int c) { return c * 2048 + (row << 4); }

struct MoBStage { f32x4 v[4]; };
__device__ __forceinline__ void mo_gl16(f32x4& d, const float* p) { asm volatile("global_load_dwordx4 %0, %1, off" : "=v"(d) : "v"(p) : "memory"); }
__device__ __forceinline__ void mo_gl16u(u32x4& d, const bf16* p) { asm volatile("global_load_dwordx4 %0, %1, off" : "=v"(d) : "v"(p) : "memory"); }
__device__ __forceinline__ void mo_bload(MoBStage& sg, const float* src0, const float* src1, size_t ld, int k0, int tid) {
    const int n4 = tid & 63, kg = tid >> 6;
    const float* p = (n4 < 32 ? src0 + 4 * n4 : src1 + 4 * (n4 - 32)) + (size_t)(k0 + 4 * kg) * ld;
    mo_gl16(sg.v[0], p); mo_gl16(sg.v[1], p + ld); mo_gl16(sg.v[2], p + 2 * ld); mo_gl16(sg.v[3], p + 3 * ld);
}
#define MO_WAIT5(N, SB, SA) asm volatile("s_waitcnt vmcnt(" #N ")" : "+v"(SB.v[0]), "+v"(SB.v[1]), "+v"(SB.v[2]), "+v"(SB.v[3]), "+v"(SA) :: "memory")
#define MO_WAIT4(N, SB) asm volatile("s_waitcnt vmcnt(" #N ")" : "+v"(SB.v[0]), "+v"(SB.v[1]), "+v"(SB.v[2]), "+v"(SB.v[3]) :: "memory")
__device__ __forceinline__ void mo_bwrite(const MoBStage& sg, LAS unsigned char* bb, int tid) {
    const int n4 = tid & 63, kg = tid >> 6;
#pragma unroll
    for (int i = 0; i < 4; ++i) { u32x2 w; w.x = cvtpk(sg.v[0][i], sg.v[1][i]); w.y = cvtpk(sg.v[2][i], sg.v[3][i]);
        *(LAS u32x2*)(bb + (kg >> 1) * 4096 + (32 * (n4 >> 3) + 8 * i + (n4 & 7)) * 16 + 8 * (kg & 1)) = w; }
}
#define MO_READ(AP, ASTEP, BP, B1OFF) bf16x8 fb0_[2], fb1_[2], fa_[2][2]; \
    _Pragma("unroll") for (int s_ = 0; s_ < 2; ++s_) { fb0_[s_] = *(const LAS bf16x8*)((BP) + s_ * 8192); fb1_[s_] = *(const LAS bf16x8*)((BP) + s_ * 8192 + (B1OFF)); \
        _Pragma("unroll") for (int mt = 0; mt < 2; ++mt) fa_[s_][mt] = *(const LAS bf16x8*)((AP) + s_ * (ASTEP) + mt * 512); } \
    __builtin_amdgcn_sched_barrier(0)
#define MO_MMA(ACC0, ACC1) do { __builtin_amdgcn_sched_barrier(0); _Pragma("unroll") for (int s_ = 0; s_ < 2; ++s_) _Pragma("unroll") for (int mt = 0; mt < 2; ++mt) { \
        ACC0[mt] = MFMA32(fa_[s_][mt], fb0_[s_], ACC0[mt]); ACC1[mt] = MFMA32(fa_[s_][mt], fb1_[s_], ACC1[mt]); } __builtin_amdgcn_sched_barrier(0); } while (0)

__device__ __forceinline__ void moe_unit(int e, int c0, int nrows, const bf16* XN, const int* LIST, const float* Wg, const float* Wu, const float* Wd, bf16* YB, LAS unsigned char* lds, int tid, int wid, int lane) {
    const int r32 = lane & 31, hi = lane >> 5, wn = wid & 3, wm = wid >> 2;
    LAS int* rowid = (LAS int*)(lds + MO_ROW);
    if (tid < 128) rowid[tid] = (tid < nrows) ? LIST[(size_t)e * 16384 + c0 + tid] : -1;
    __syncthreads();
    const float* wg = Wg + (size_t)e * D * 256; const float* wu = Wu + (size_t)e * D * 256; const float* wd = Wd + (size_t)e * 256 * D;
    f32x16 acc0[2], acc1[2];
#define MO_ZERO() do { acc0[0] = (f32x16){}; acc0[1] = (f32x16){}; acc1[0] = (f32x16){}; acc1[1] = (f32x16){}; } while (0)
    MO_ZERO();
    MoBStage s0, s1, s2, s3; u32x4 a0, a1, a2, a3;
    {
        const int arow = tid >> 2, ac = tid & 3; const int rid = rowid[arow]; const bf16* asrc = XN + (size_t)((rid < 0 ? 0 : rid) >> 1) * D + 8 * ac;
        LAS unsigned char* const awr = lds + MO_A + mo_aoff(arow, ac);
        LAS const unsigned char* const ard = lds + MO_A + mo_aoff(64 * wm + r32, hi);
        LAS const unsigned char* const brd = lds + MO_B + hi * 4096 + (32 * wn + r32) * 16;
#define G1_LOAD(SB, SA, t) do { const int t_ = (t); mo_gl16u(SA, asrc + 32 * (t_ & 63)); mo_bload(SB, wg + 128 * (t_ >> 6), wu + 128 * (t_ >> 6), 256, 32 * (t_ & 63), tid); } while (0)
#define G1_WRITE(SB, SA, b) do { *(LAS u32x4*)(awr + (b) * MO_ABUF) = SA; mo_bwrite(SB, lds + MO_B + (b) * MO_BBUF, tid); } while (0)
#define G1_STEP(t, b, SBL, SAL, SBW, SAW) do { const int tt_ = (t); \
            G1_LOAD(SBL, SAL, (tt_ + 4 < 128 ? tt_ + 4 : 127));     \
            MO_READ(ard + (b) * MO_ABUF, 2 * MO_APITCH + 64, brd + (b) * MO_BBUF, 2048); \
            MO_WAIT5(15, SBW, SAW); \
            if (tt_ + 1 < 128) G1_WRITE(SBW, SAW, (b) ^ 1); \
            MO_MMA(acc0, acc1); \
            if ((tt_ & 63) == 63) {     \
                const int col_ = 128 * (tt_ >> 6) + 32 * wn + 4 * (r32 & 7) + (r32 >> 3), cch_ = col_ >> 3; \
                _Pragma("unroll") for (int mt = 0; mt < 2; ++mt) _Pragma("unroll") for (int r = 0; r < 16; ++r) { const float gt = acc0[mt][r], up = acc1[mt][r]; const float hv = gt / (1.0f + __expf(-gt)) * up; \
                    *(LAS unsigned short*)(lds + mo_hoff(64 * wm + 32 * mt + crow(r, hi), cch_) + (col_ & 7) * 2) = f2bf16(hv); } \
                MO_ZERO(); } \
            __syncthreads(); } while (0)
        G1_LOAD(s0, a0, 0); G1_LOAD(s1, a1, 1); G1_LOAD(s2, a2, 2); G1_LOAD(s3, a3, 3);
        MO_WAIT5(15, s0, a0);
        G1_WRITE(s0, a0, 0);
        __syncthreads();
        for (int t = 0; t < 128; t += 4) {
            G1_STEP(t, 0, s0, a0, s1, a1);
            G1_STEP(t + 1, 1, s1, a1, s2, a2);
            G1_STEP(t + 2, 0, s2, a2, s3, a3);
            G1_STEP(t + 3, 1, s3, a3, s0, a0);
        }
        asm volatile("s_waitcnt vmcnt(0)" : "+v"(s0.v[0]), "+v"(s0.v[1]), "+v"(s0.v[2]), "+v"(s0.v[3]), "+v"(s1.v[0]), "+v"(s1.v[1]), "+v"(s1.v[2]), "+v"(s1.v[3]), "+v"(s2.v[0]), "+v"(s2.v[1]), "+v"(s2.v[2]), "+v"(s2.v[3]),
                     "+v"(s3.v[0]), "+v"(s3.v[1]), "+v"(s3.v[2]), "+v"(s3.v[3]), "+v"(a0), "+v"(a1), "+v"(a2), "+v"(a3) :: "memory");
#undef G1_LOAD
#undef G1_WRITE
#undef G1_STEP
    }
    {
        LAS const unsigned char* const hrd = lds + mo_hoff(64 * wm + r32, hi);
        LAS const unsigned char* const brd = lds + MO_B + hi * 4096 + (64 * wn + r32) * 16;
#define G2_LOAD(SB, t) do { const int t_ = (t); mo_bload(SB, wd + 256 * (t_ >> 3), wd + 256 * (t_ >> 3) + 128, D, 32 * (t_ & 7), tid); } while (0)
#define G2_STEP(t, b, SBL, SBW) do { const int tt_ = (t); \
            G2_LOAD(SBL, (tt_ + 4 < 64 ? tt_ + 4 : 63)); \
            MO_READ(hrd + (tt_ & 7) * 8192, 4096, brd + (b) * MO_BBUF, 512); \
            MO_WAIT4(12, SBW); \
            if (tt_ + 1 < 64) mo_bwrite(SBW, lds + MO_B + ((b) ^ 1) * MO_BBUF, tid); \
            MO_MMA(acc0, acc1); \
            if ((tt_ & 7) == 7) {     \
                LAS unsigned char* const stg_ = lds + MO_STG + wid * 4096; const int cidx_ = 4 * (r32 & 7) + (r32 >> 3); \
                _Pragma("unroll") for (int mt = 0; mt < 2; ++mt) { \
                    _Pragma("unroll") for (int r = 0; r < 16; ++r) { const int row_ = crow(r, hi); \
                        *(LAS unsigned short*)(stg_ + row_ * 128 + cidx_ * 2) = f2bf16(acc0[mt][r]); *(LAS unsigned short*)(stg_ + row_ * 128 + (cidx_ + 32) * 2) = f2bf16(acc1[mt][r]); } \
                    _Pragma("unroll") for (int k = 0; k < 4; ++k) { const int idx_ = lane + 64 * k, row_ = idx_ >> 3, ch_ = idx_ & 7; \
                        const u32x4 v_ = *(const LAS u32x4*)(stg_ + row_ * 128 + ch_ * 16); const int rr = rowid[64 * wm + 32 * mt + row_]; \
                        if (rr >= 0) *(u32x4*)(YB + (size_t)rr * D + 256 * (tt_ >> 3) + 64 * wn + 8 * ch_) = v_; } } \
                MO_ZERO(); } \
            __syncthreads(); } while (0)
        G2_LOAD(s0, 0); G2_LOAD(s1, 1); G2_LOAD(s2, 2); G2_LOAD(s3, 3);
        MO_WAIT4(12, s0);
        mo_bwrite(s0, lds + MO_B, tid);
        __syncthreads();
        for (int t = 0; t < 64; t += 4) {
            G2_STEP(t, 0, s0, s1);
            G2_STEP(t + 1, 1, s1, s2);
            G2_STEP(t + 2, 0, s2, s3);
            G2_STEP(t + 3, 1, s3, s0);
        }
        asm volatile("s_waitcnt vmcnt(0)" : "+v"(s0.v[0]), "+v"(s0.v[1]), "+v"(s0.v[2]), "+v"(s0.v[3]), "+v"(s1.v[0]), "+v"(s1.v[1]), "+v"(s1.v[2]), "+v"(s1.v[3]), "+v"(s2.v[0]), "+v"(s2.v[1]), "+v"(s2.v[2]), "+v"(s2.v[3]),
                     "+v"(s3.v[0]), "+v"(s3.v[1]), "+v"(s3.v[2]), "+v"(s3.v[3]) :: "memory");
#undef G2_LOAD
#undef G2_STEP
    }
#undef MO_ZERO
}

constexpr int N_PHASES = 1 + 7 * DEPTH;
#ifndef PH_MASK
#define PH_MASK 0xFFFF
#endif
#define PHON(k) (((PH_MASK) >> (k)) & 1)
#ifndef DUP_MASK
#define DUP_MASK 0
#endif
#define DUPON(k) ((((DUP_MASK) >> (k)) & 1) && (l == 0 || (((0x3FE) >> (k)) & 1)))
#ifndef MK_ONE_LAUNCH
#define MK_ONE_LAUNCH 1
#endif

__global__ void __launch_bounds__(NTHR, 2) fwd_kernel(Args args) {
    extern __shared__ __attribute__((aligned(16))) unsigned char lds_raw[];
    LAS unsigned char* lds = (LAS unsigned char*)lds_raw;
    volatile LAS unsigned* MISC = (volatile LAS unsigned*)(lds + MISC_OFF);
    const int wid = __builtin_amdgcn_readfirstlane(threadIdx.x >> 6);
    const int G = gridDim.x, bid = blockIdx.x;
    unsigned char* ws = args.ws;
    unsigned* const ctl0 = (unsigned*)(ws + WS_CTL);
    if (threadIdx.x < 64) MISC[threadIdx.x] = 0u;
    __syncthreads();
    const int lo = args.ph_lo, hi_ph = args.ph_hi;
    XcdBarrier bar; bar.bar = ctl0 + CW_BAR; bar.x = 0; bar.st = MISC + 8; bar.w0 = 0;
    if (hi_ph - lo > 1) bar = xcd_barrier_post(ctl0 + CW_BAR, MISC + 8);
#define IN(k) (lo <= (k) && (k) < hi_ph)
#define FRESH() int wid_ = wid; asm volatile("" : "+s"(wid_)); int lane_; asm volatile("v_mbcnt_lo_u32_b32 %0, -1, 0\n\tv_mbcnt_hi_u32_b32 %0, -1, %0" : "=v"(lane_)); const int tid_ = wid_ * 64 + lane_; (void)tid_
#define SEAM(k) do { if (IN(k) && IN((k) + 1)) xcd_barrier(bar); } while (0)

    const int NGW = G * NWAVES;

    if (PHON(0) && IN(0)) { FRESH(); p0_prologue(args, lds, bid, G, tid_, wid_, lane_); if ((DUP_MASK) & 1) p0_prologue(args, lds, bid, G, tid_, wid_, lane_); }
    SEAM(0);

#pragma unroll 1
    for (int lraw = 0; lraw < DEPTH; ++lraw) {
        int l = lraw; asm volatile("" : "+s"(l));
        GAS unsigned char* wsg = (GAS unsigned char*)ws; asm volatile("" : "+s"(wsg)); unsigned char* const wsl = (unsigned char*)wsg;
        unsigned* const ctl = (unsigned*)(wsl + WS_CTL);
        bf16* const WIN = (bf16*)(wsl + WS_WIN); bf16* const WOUT = (bf16*)(wsl + WS_WOUT); bf16* const W1T = (bf16*)(wsl + WS_W1T); bf16* const W2T = (bf16*)(wsl + WS_W2T); bf16* const RWT = (bf16*)(wsl + WS_RWT);
        float* const C1 = (float*)(wsl + WS_C1); bf16* const X = (bf16*)(wsl + WS_X); bf16* const XN = (bf16*)(wsl + WS_XN); bf16* const PROJ = (bf16*)(wsl + WS_PROJ); float* const AUX = (float*)(wsl + WS_AUX);
        float* const CUM = (float*)(wsl + WS_CUM); bf16* const KC = (bf16*)(wsl + WS_KC); bf16* const VC = (bf16*)(wsl + WS_VC); bf16* const MIX = (bf16*)(wsl + WS_MIX); bf16* const YB = (bf16*)(wsl + WS_YB);
        int* const LIST = (int*)(wsl + WS_LIST); float* const TW = (float*)(wsl + WS_TW);
        const int pb = 1 + 7 * l;
        if (PHON(1) && IN(pb)) {
            pg8::Gemm g{XN, WIN + (size_t)l * NP * D, S, NP, D}; pg8::StaticOrder so; so.init(S, NP, G, bid);
            pg8::EpiProj E{PROJ, AUX};
            pg8::gemm_phase<pg8::EpiProj, pg8::StaticOrder, true, true>(lds, g, so, E, wid);
            if (DUPON(1)) pg8::gemm_phase<pg8::EpiProj, pg8::StaticOrder, true, true>(lds, g, so, E, wid);
        }
        SEAM(pb);
        if (IN(pb + 2)) {
            const int x = bid & 7;
#define QHEAD(q) (ctl + CW_Q + (((l * 6 + (q)) * 8 + x) * 64))
            if (PHON(2)) { FRESH(); unsigned* const pdone = ctl + CW_PD + l * 64;
                for (;;) { const int i = dequeue(ctl + CW_PQ + l * 64, MISC + 19, tid_); if (i >= 136) break;
                    if (i < 8) cumsum_unit(i, l, AUX, args.in[5], CUM, lds, tid_); else compress_unit(i - 8, l, PROJ, W1T, W2T, C1, KC, VC, lds, wid_, lane_);
                    asm volatile("s_waitcnt vmcnt(0)" ::: "memory");
                    __syncthreads();
                    if (wid_ == 0) { __builtin_amdgcn_fence(__ATOMIC_RELEASE, "agent"); asm volatile("s_waitcnt vmcnt(0)" ::: "memory"); (void)__hip_atomic_fetch_add(pdone, 1u, __ATOMIC_RELAXED, __HIP_MEMORY_SCOPE_AGENT); }
                } }
            if (PHON(4)) { FRESH(); for (;;) { const int i = dequeue(QHEAD(1), MISC + 17, tid_); if (i >= 32) break; diff_unit(x & 3, 63 - 2 * i - (x >> 2), l, args, PROJ, MIX, lds, tid_, wid_, lane_); }
                if (DUPON(4)) for (;;) { const int i = dequeue(QHEAD(4), MISC + 17, tid_); if (i >= 32) break; diff_unit(x & 3, 63 - 2 * i - (x >> 2), l, args, PROJ, MIX, lds, tid_, wid_, lane_); } }
            if (PHON(2)) { FRESH();
                if (tid_ == 0) { unsigned* const pdone = ctl + CW_PD + l * 64; unsigned sp = 0;
                    while (__hip_atomic_load(pdone, __ATOMIC_RELAXED, __HIP_MEMORY_SCOPE_AGENT) < 136u * 64u) { __builtin_amdgcn_s_sleep(2); if (++sp > (1u << 20)) break; }
                    __builtin_amdgcn_fence(__ATOMIC_ACQUIRE, "agent"); asm volatile("s_waitcnt vmcnt(0)" ::: "memory"); }
                __syncthreads(); }
            if (PHON(3)) { FRESH(); for (;;) { const int i = dequeue(QHEAD(0), MISC + 16, tid_); if (i >= 32) break; fox_unit(x, 31 - i, PROJ, CUM, MIX, lds, tid_, wid_, lane_); }
                if (DUPON(3)) for (;;) { const int i = dequeue(QHEAD(3), MISC + 16, tid_); if (i >= 32) break; fox_unit(x, 31 - i, PROJ, CUM, MIX, lds, tid_, wid_, lane_); } }
            if (PHON(5)) { FRESH(); for (;;) { const int i = dequeue(QHEAD(2), MISC + 18, tid_); if (i >= 64) break; nsa_unit(x & 3, 127 - 2 * i - (x >> 2), args, PROJ, AUX, KC, VC, MIX, lds, tid_, wid_, lane_); }
                if (DUPON(5)) for (;;) { const int i = dequeue(QHEAD(5), MISC + 18, tid_); if (i >= 64) break; nsa_unit(x & 3, 127 - 2 * i - (x >> 2), args, PROJ, AUX, KC, VC, MIX, lds, tid_, wid_, lane_); } }
#undef QHEAD
        }
        SEAM(pb + 2);
        if (PHON(6) && IN(pb + 3)) {
            pg8::Gemm g{MIX, WOUT + (size_t)l * D * D, S, D, D}; pg8::StaticOrder so; so.init(S, D, G, bid);
            pg8::EpiRes E{l == 0 ? args.in[0] : nullptr, X, X};
            pg8::gemm_phase<pg8::EpiRes, pg8::StaticOrder, true, true>(lds, g, so, E, wid);
            if (DUPON(6)) { pg8::EpiRes E2{nullptr, X, YB}; pg8::gemm_phase<pg8::EpiRes, pg8::StaticOrder, true, true>(lds, g, so, E2, wid); }
        }
        SEAM(pb + 3);
        if (PHON(7) && IN(pb + 4)) {
            FRESH();
            for (int p = bid; p < S / 32; p += G) n2_pair(p, l, args, X, XN, RWT, ctl + CW_CNT + l * 1024, LIST, TW, lds, tid_, wid_, lane_);
            if (DUPON(7)) for (int u = bid; u < S / 16; u += G) n2_unit(u, l, args, X, XN, RWT, ctl + CW_CNT + (4 + l) * 1024, (int*)MIX, (float*)(MIX + 8 * 1024 * 1024), lds, tid_, wid_, lane_);
        }
        SEAM(pb + 4);
        if (PHON(8) && IN(pb + 5)) {
            FRESH();
            LAS int* pre = (LAS int*)(lds + MO_PRE);
            if (tid_ < 64) pre[tid_] = ((int)__hip_atomic_load(ctl + CW_CNT + l * 1024 + tid_ * 16, __ATOMIC_RELAXED, __HIP_MEMORY_SCOPE_AGENT) + 127) >> 7;
            __syncthreads();
            const int x = bid & 7, per = G >> 3;
            for (int rep = 0; rep < (DUPON(8) ? 2 : 1); ++rep)
            for (int slot = bid >> 3; ; slot += per) {
                int e = -1, c = 0, acc = 0;
                for (int k = 0; k < 8; ++k) { const int ee = x + 8 * k, n = pre[ee]; if (e < 0 && slot < acc + n) { e = ee; c = slot - acc; } acc += n; }
                if (e < 0) break;
                e = __builtin_amdgcn_readfirstlane(e); c = __builtin_amdgcn_readfirstlane(c);
                const int c0 = c * 128; const int cnt_e = (int)__hip_atomic_load(ctl + CW_CNT + l * 1024 + e * 16, __ATOMIC_RELAXED, __HIP_MEMORY_SCOPE_AGENT);
                const int nrows = (cnt_e - c0) < 128 ? (cnt_e - c0) : 128;
                moe_unit(e, c0, nrows, XN, LIST, args.in[19] + (size_t)l * 64 * D * 256, args.in[20] + (size_t)l * 64 * D * 256, args.in[21] + (size_t)l * 64 * 256 * D, YB, lds, tid_, wid_, lane_);
            }
        }
        SEAM(pb + 5);
        if (PHON(9) && IN(pb + 6)) {
            FRESH(); const int gw_ = bid * NWAVES + wid_;
            if (l + 1 < DEPTH) {
                norm_rows<1>(nullptr, X, X, XN, YB, TW, args.in[1] + (size_t)(l + 1) * D, nullptr, gw_, NGW, lane_);
                if (DUPON(9)) norm_rows<1>(nullptr, X, PROJ, MIX, YB, TW, args.in[1] + (size_t)(l + 1) * D, nullptr, gw_, NGW, lane_);
            } else norm_rows<2>(nullptr, X, nullptr, nullptr, YB, TW, args.in[22], args.out, gw_, NGW, lane_);
        }
        if (l + 1 < DEPTH) SEAM(pb + 6);
    }
#undef IN
#undef SEAM
}

extern "C" void kernel_launch(void* const* d_in, const int* in_sizes, int n_in, void* d_out, int out_size, void* d_ws, size_t ws_size, hipStream_t stream) {
    static int grid = 0;
    if (grid == 0) {
        if (n_in != 23 || ws_size < WS_END || out_size != S * D) { fprintf(stderr, "kernel_launch: unexpected problem (n_in %d, out %d, ws %zu)\n", n_in, out_size, ws_size); grid = -1; return; }
        int dev = 0, cus = 0, per_cu = 0;
        if (hipGetDevice(&dev) != hipSuccess || hipDeviceGetAttribute(&cus, hipDeviceAttributeMultiprocessorCount, dev) != hipSuccess) { grid = -1; return; }
        if (hipFuncSetAttribute((const void*)fwd_kernel, hipFuncAttributeMaxDynamicSharedMemorySize, LDS_BYTES) != hipSuccess) { fprintf(stderr, "kernel_launch: hipFuncSetAttribute failed\n"); grid = -1; return; }
        if (hipOccupancyMaxActiveBlocksPerMultiprocessor(&per_cu, (const void*)fwd_kernel, NTHR, LDS_BYTES) != hipSuccess || per_cu < 1) fprintf(stderr, "kernel_launch: occupancy query says %d blocks per CU\n", per_cu);
        (void)hipGetLastError();
        grid = cus;
        if (grid < 136) { fprintf(stderr, "kernel_launch: too few CUs (%d)\n", grid); }
    }
    if (grid < 0) return;
    if (hipMemsetAsync((char*)d_ws + WS_CTL, 0, CTL_ZERO_BYTES, stream) != hipSuccess) { fprintf(stderr, "kernel_launch: memset failed\n"); return; }
    Args a{};
    for (int i = 0; i < 23; ++i) a.in[i] = (const float*)d_in[i];
    a.out = (float*)d_out; a.ws = (unsigned char*)d_ws;
#if MK_ONE_LAUNCH
    a.ph_lo = 0; a.ph_hi = N_PHASES;
    hipLaunchKernelGGL(fwd_kernel, dim3(grid), dim3(NTHR), LDS_BYTES, stream, a);
#else
    for (int p = 0; p < N_PHASES; ++p) { a.ph_lo = p; a.ph_hi = p + 1; hipLaunchKernelGGL(fwd_kernel, dim3(grid), dim3(NTHR), LDS_BYTES, stream, a); }
#endif
    const hipError_t le = hipPeekAtLastError();
    if (le != hipSuccess) fprintf(stderr, "kernel_launch: launch failed: %s\n", hipGetErrorName(le));
}
```

```cpp
#include <hip/hip_runtime.h>
#include <cstdio>
#include <cstdint>
#include <cmath>
namespace pg8 {
#define PG8_LAS __attribute__((address_space(3)))
typedef unsigned short bf16_t;
typedef short bf16x8 __attribute__((ext_vector_type(8)));
typedef float f32x4 __attribute__((ext_vector_type(4)));
typedef unsigned u32x4 __attribute__((ext_vector_type(4)));
constexpr int BM = 256, BK = 64, HALF = 128, HTB = HALF * BK * 2  , STAGE_BYTES = 8 * HTB, NXCD = 8, WGM = 8;

__host__ __device__ __forceinline__ int lds_byte(int r, int c) { const int st = (r >> 4) * 2 + (c >> 5), rr = r & 15, cc = c & 31, ob = rr * 64 + cc * 2; return st * 1024 + (ob ^ (((ob >> 9) & 1) << 5)); }
__host__ __device__ __forceinline__ void stage_rc(int b, int& R, int& C) { const int st = b / 1024, sb = b % 1024, swz = sb ^ (((sb >> 9) & 1) << 5); R = (st >> 1) * 16 + swz / 64; C = (st & 1) * 32 + (swz % 64) / 2; }
__host__ __device__ __forceinline__ int perm32(int rho) { const int n = rho >> 4, i = rho & 15; return 8 * (i >> 2) + 4 * n + (i & 3); }

struct Unit { int pm, pn; };
struct Gemm { const bf16_t* A; const bf16_t* Bt; int M, N, K; };

struct StaticOrder {
    int nM, nN, nwg, G, c;
    __host__ __device__ void init(int M, int N, int G_, int c_) { nM = M / BM; nN = N / BM; nwg = nM * nN; G = G_; c = c_; }
    __host__ __device__ bool next(int i, Unit& u) const {
        const long L = (long)i * G + c; if (L >= nwg) return false;
        int wgid = (int)L; { const int q = nwg / NXCD, r = nwg % NXCD, xcd = wgid % NXCD, off = wgid / NXCD; wgid = (xcd < r ? xcd * (q + 1) : r * (q + 1) + (xcd - r) * q) + off; }
        const int nig = WGM * nN, gid = wgid / nig, fm = gid * WGM, gsz = (nM - fm) < WGM ? (nM - fm) : WGM;
        u.pm = fm + ((wgid % nig) % gsz); u.pn = (wgid % nig) / gsz; return true;
    }
    __device__ __forceinline__ void a_ready(const Unit&) const {}
    __device__ __forceinline__ void done(const Unit&) const {}
};
__device__ __forceinline__ unsigned cvt_pk_bf16(float lo, float hi) { unsigned r; asm volatile("v_cvt_pk_bf16_f32 %0, %1, %2" : "=v"(r) : "v"(lo), "v"(hi)); return r; }
struct EpiProj {
    static constexpr bool PERM = true, AFTER_DRAIN = false;
    bf16_t* O; float* aux;
    __device__ __forceinline__ void operator()(const f32x4 (&acc)[2][2][4][2], const Unit& u, int wr, int wc, int fr, int fq) const {
        const int row0 = u.pm * BM + wr * 64 + fr;
        if (u.pn < 22) {
            const int col0 = u.pn * BM + wc * 32 + 8 * fq;
#pragma unroll
            for (int ai = 0; ai < 2; ++ai)
#pragma unroll
                for (int m = 0; m < 4; ++m) { bf16_t* rowp = O + (size_t)(row0 + ai * HALF + m * 16) * 5632 + col0;
#pragma unroll
                    for (int bj = 0; bj < 2; ++bj) { const f32x4 v0 = acc[ai][bj][m][0], v1 = acc[ai][bj][m][1];
                        u32x4 w; w.x = cvt_pk_bf16(v0[0], v0[1]); w.y = cvt_pk_bf16(v0[2], v0[3]); w.z = cvt_pk_bf16(v1[0], v1[1]); w.w = cvt_pk_bf16(v1[2], v1[3]);
                        *(u32x4*)(rowp + bj * HALF) = w; } }
        } else if (wc < 2) {
            const int col0 = wc * 32 + 8 * fq;
#pragma unroll
            for (int ai = 0; ai < 2; ++ai)
#pragma unroll
                for (int m = 0; m < 4; ++m) { float* rowp = aux + (size_t)(row0 + ai * HALF + m * 16) * 64 + col0;
                    *(f32x4*)(rowp) = acc[ai][0][m][0]; *(f32x4*)(rowp + 4) = acc[ai][0][m][1]; }
        }
    }
};
struct EpiRes {
    static constexpr bool PERM = true, AFTER_DRAIN = false;
    const float* basef; const bf16_t* baseb; bf16_t* out;
    __device__ __forceinline__ void operator()(const f32x4 (&acc)[2][2][4][2], const Unit& u, int wr, int wc, int fr, int fq) const {
        const int row0 = u.pm * BM + wr * 64 + fr, col0 = u.pn * BM + wc * 32 + 8 * fq;
#pragma unroll
        for (int ai = 0; ai < 2; ++ai)
#pragma unroll
            for (int m = 0; m < 4; ++m) { const size_t off = (size_t)(row0 + ai * HALF + m * 16) * 2048 + col0;
#pragma unroll
                for (int bj = 0; bj < 2; ++bj) { f32x4 v0 = acc[ai][bj][m][0], v1 = acc[ai][bj][m][1]; const size_t o = off + bj * HALF;
                    if (basef) { v0 += *(const f32x4*)(basef + o); v1 += *(const f32x4*)(basef + o + 4); }
                    else { const u32x4 b = *(const u32x4*)(baseb + o);
                        v0[0] += __uint_as_float(b.x << 16); v0[1] += __uint_as_float(b.x & 0xffff0000u); v0[2] += __uint_as_float(b.y << 16); v0[3] += __uint_as_float(b.y & 0xffff0000u);
                        v1[0] += __uint_as_float(b.z << 16); v1[1] += __uint_as_float(b.z & 0xffff0000u); v1[2] += __uint_as_float(b.w << 16); v1[3] += __uint_as_float(b.w & 0xffff0000u); }
                    u32x4 w; w.x = cvt_pk_bf16(v0[0], v0[1]); w.y = cvt_pk_bf16(v0[2], v0[3]); w.z = cvt_pk_bf16(v1[0], v1[1]); w.w = cvt_pk_bf16(v1[2], v1[3]);
                    *(u32x4*)(out + o) = w; } }
    }
};
template <class Epi, class Sched, bool ALIGN_EPI = false, bool SP2 = false>
__device__ __forceinline__ void gemm_phase(PG8_LAS unsigned char* lds, const Gemm g, const Sched& S, const Epi& E, int wid_in  ) {
    int wid = wid_in; asm volatile("" : "+s"(wid));
    int lane = (int)__builtin_amdgcn_mbcnt_hi(~0u, __builtin_amdgcn_mbcnt_lo(~0u, 0u)); asm volatile("" : "+v"(lane));
    const int tid = wid * 64 + lane, wr = wid >> 2, wc = wid & 3, fr = lane & 15, fq = lane >> 4;
    const int K = g.K, nt = K / BK;
    unsigned voffA[2], voffB[2];
#pragma unroll
    for (int i = 0; i < 2; ++i) { int R, C; stage_rc(tid * 16 + i * 8192, R, C); const int Rb = Epi::PERM ? ((R & ~31) + perm32(R & 31)) : R;
        voffA[i] = (unsigned)(R * K + C) * 2u; voffB[i] = (unsigned)(Rb * K + C) * 2u; }
    const size_t kstep = (size_t)(BK * 2);
    const size_t hstep = (size_t)HALF * K * 2;
    const size_t tstep = 2 * hstep;
    const unsigned ldsw = (unsigned)wid * 1024u;
    const int aoff = lds_byte(wr * 64 + fr, fq * 8), boff = lds_byte(wc * 32 + fr, fq * 8);
#define PG8_SA(b, h) (((b) * 2 + (h)) * HTB)
#define PG8_SB(b, h) ((4 + (b) * 2 + (h)) * HTB)
#define PG8_STAGE(bufoff, gbase, voff) do { _Pragma("unroll") for (int _i = 0; _i < 2; ++_i) \
        __builtin_amdgcn_global_load_lds((const unsigned*)((const char*)(gbase) + (voff)[_i]), (PG8_LAS unsigned*)(lds + (bufoff) + ldsw + _i * 8192), 16, 0, 0); } while (0)
#define PG8_LDA(dst, b, h) do { _Pragma("unroll") for (int m = 0; m < 4; ++m) _Pragma("unroll") for (int k = 0; k < 2; ++k) dst[m][k] = *(const PG8_LAS bf16x8*)(lds + PG8_SA(b, h) + aoff + m * 2048 + k * 1024); } while (0)
#define PG8_LDB(dst, b, h) do { _Pragma("unroll") for (int n = 0; n < 2; ++n) _Pragma("unroll") for (int k = 0; k < 2; ++k) dst[n][k] = *(const PG8_LAS bf16x8*)(lds + PG8_SB(b, h) + boff + n * 2048 + k * 1024); } while (0)
#define PG8_MMA(ai, bj, At, Bt) do { __builtin_amdgcn_s_setprio(1); _Pragma("unroll") for (int m = 0; m < 4; ++m) _Pragma("unroll") for (int n = 0; n < 2; ++n) _Pragma("unroll") for (int k = 0; k < 2; ++k) \
        acc[ai][bj][m][n] = __builtin_amdgcn_mfma_f32_16x16x32_bf16(Bt[n][k], At[m][k], acc[ai][bj][m][n], 0, 0, 0); __builtin_amdgcn_s_setprio(0); } while (0)
#define PG8_WAIT_V(n) asm volatile("s_waitcnt vmcnt(" #n ")" ::: "memory")
#define PG8_WAIT_L(n) asm volatile("s_waitcnt lgkmcnt(" #n ")" ::: "memory")
#define PG8_BAR __builtin_amdgcn_s_barrier()
#define PG8_SCHED __builtin_amdgcn_sched_barrier(0)
    Unit cur, nxt; int ui = 0;
    if (!S.next(0, cur)) return;
    f32x4 acc[2][2][4][2];
#pragma unroll
    for (int a = 0; a < 2; ++a)
#pragma unroll
        for (int b = 0; b < 2; ++b)
#pragma unroll
            for (int m = 0; m < 4; ++m)
#pragma unroll
                for (int n = 0; n < 2; ++n) acc[a][b][m][n] = (f32x4){0.f, 0.f, 0.f, 0.f};
    bf16x8 At[4][2], B0[2][2], B1[2][2];
    const char* cA = (const char*)g.A + (size_t)cur.pm * tstep; const char* cB = (const char*)g.Bt + (size_t)cur.pn * tstep;
    S.a_ready(cur);
    if constexpr (SP2) {
        PG8_STAGE(PG8_SB(0, 0), cB, voffB); PG8_STAGE(PG8_SB(0, 1), cB + hstep, voffB); PG8_STAGE(PG8_SA(0, 0), cA, voffA); PG8_STAGE(PG8_SA(0, 1), cA + hstep, voffA);
        if (wr == 1) PG8_BAR;
        PG8_WAIT_V(2); PG8_BAR;
        PG8_STAGE(PG8_SB(1, 0), cB + kstep, voffB); PG8_STAGE(PG8_SA(1, 0), cA + kstep, voffA); PG8_STAGE(PG8_SB(1, 1), cB + hstep + kstep, voffB);
        PG8_WAIT_V(6); PG8_BAR;
    } else {
        PG8_STAGE(PG8_SB(0, 0), cB, voffB); PG8_STAGE(PG8_SA(0, 0), cA, voffA); PG8_STAGE(PG8_SB(0, 1), cB + hstep, voffB); PG8_STAGE(PG8_SA(0, 1), cA + hstep, voffA);
        if (wr == 1) PG8_BAR;
        PG8_WAIT_V(4); PG8_BAR;
        PG8_STAGE(PG8_SB(1, 0), cB + kstep, voffB); PG8_STAGE(PG8_SA(1, 0), cA + kstep, voffA); PG8_STAGE(PG8_SB(1, 1), cB + hstep + kstep, voffB);
        PG8_WAIT_V(6); PG8_BAR;
    }
    for (;;) {
        const bool has_next = S.next(ui + 1, nxt);
        const char* nA = has_next ? (const char*)g.A + (size_t)nxt.pm * tstep : cA; const char* nB = has_next ? (const char*)g.Bt + (size_t)nxt.pn * tstep : cB;
        for (int t = 0; t < nt; t += 2) {
            const bool last = (t == nt - 2);
            const char* a1 = cA + (size_t)(t + 1) * kstep;
            const char* a2 = last ? nA : cA + (size_t)(t + 2) * kstep; const char* b2 = last ? nB : cB + (size_t)(t + 2) * kstep;
            const char* a3 = a2 + kstep; const char* b3 = b2 + kstep;
            if (last && has_next) S.a_ready(nxt);
            if constexpr (SP2) {
            PG8_LDB(B0, 0, 0); PG8_LDB(B1, 0, 1); PG8_SCHED; PG8_LDA(At, 0, 0); PG8_STAGE(PG8_SA(1, 1), a1 + hstep, voffA);
            PG8_WAIT_V(8); PG8_WAIT_L(0); PG8_BAR; PG8_MMA(0, 0, At, B0); PG8_MMA(0, 1, At, B1); PG8_BAR; PG8_SCHED;
            PG8_LDA(At, 0, 1); PG8_STAGE(PG8_SB(0, 0), b2, voffB); PG8_STAGE(PG8_SB(0, 1), b2 + hstep, voffB); PG8_STAGE(PG8_SA(0, 0), a2, voffA);
            PG8_WAIT_V(8); PG8_WAIT_L(0); PG8_BAR; PG8_MMA(1, 0, At, B0); PG8_MMA(1, 1, At, B1); PG8_BAR; PG8_SCHED;
            PG8_LDB(B0, 1, 0); PG8_LDB(B1, 1, 1); PG8_SCHED; PG8_LDA(At, 1, 0); PG8_STAGE(PG8_SA(0, 1), a2 + hstep, voffA);
            PG8_WAIT_V(8); PG8_WAIT_L(0); PG8_BAR; PG8_MMA(0, 0, At, B0); PG8_MMA(0, 1, At, B1); PG8_BAR; PG8_SCHED;
            PG8_LDA(At, 1, 1); PG8_STAGE(PG8_SB(1, 0), b3, voffB); PG8_STAGE(PG8_SB(1, 1), b3 + hstep, voffB); PG8_STAGE(PG8_SA(1, 0), a3, voffA);
            PG8_WAIT_V(8); PG8_WAIT_L(0); PG8_BAR; PG8_MMA(1, 0, At, B0); PG8_MMA(1, 1, At, B1); PG8_BAR; PG8_SCHED;
            } else {
            PG8_LDB(B0, 0, 0); PG8_SCHED; PG8_LDA(At, 0, 0); PG8_STAGE(PG8_SA(1, 1), a1 + hstep, voffA);
            PG8_WAIT_L(8); PG8_BAR; PG8_WAIT_L(0); PG8_MMA(0, 0, At, B0); PG8_BAR; PG8_SCHED;
            PG8_LDB(B1, 0, 1); PG8_STAGE(PG8_SB(0, 0), b2, voffB);
            PG8_BAR; PG8_WAIT_L(0); PG8_MMA(0, 1, At, B1); PG8_BAR;
            PG8_LDA(At, 0, 1); PG8_STAGE(PG8_SA(0, 0), a2, voffA);
            PG8_BAR; PG8_WAIT_L(0); PG8_MMA(1, 0, At, B0); PG8_BAR; PG8_SCHED;
            PG8_STAGE(PG8_SB(0, 1), b2 + hstep, voffB);
            PG8_WAIT_V(6); PG8_BAR; PG8_MMA(1, 1, At, B1); PG8_BAR;
            PG8_LDB(B0, 1, 0); PG8_SCHED; PG8_LDA(At, 1, 0); PG8_STAGE(PG8_SA(0, 1), a2 + hstep, voffA);
            PG8_WAIT_L(8); PG8_BAR; PG8_WAIT_L(0); PG8_MMA(0, 0, At, B0); PG8_BAR; PG8_SCHED;
            PG8_LDB(B1, 1, 1); PG8_STAGE(PG8_SB(1, 0), b3, voffB);
            PG8_BAR; PG8_WAIT_L(0); PG8_MMA(0, 1, At, B1); PG8_BAR;
            PG8_LDA(At, 1, 1); PG8_STAGE(PG8_SA(1, 0), a3, voffA);
            PG8_BAR; PG8_WAIT_L(0); PG8_MMA(1, 0, At, B0); PG8_BAR; PG8_SCHED;
            PG8_STAGE(PG8_SB(1, 1), b3 + hstep, voffB);
            PG8_WAIT_V(6); PG8_BAR; PG8_MMA(1, 1, At, B1); PG8_BAR;
            }
        }
        if constexpr (ALIGN_EPI) { if (wr == 0) PG8_BAR; }
        if constexpr (!Epi::AFTER_DRAIN) { E(acc, cur, wr, wc, fr, fq); S.done(cur); }
        if (!has_next) break;
#pragma unroll
        for (int a = 0; a < 2; ++a)
#pragma unroll
            for (int b = 0; b < 2; ++b)
#pragma unroll
                for (int m = 0; m < 4; ++m)
#pragma unroll
                    for (int n = 0; n < 2; ++n) acc[a][b][m][n] = (f32x4){0.f, 0.f, 0.f, 0.f};
        cur = nxt; cA = nA; cB = nB; ++ui;
        if constexpr (ALIGN_EPI) { if (wr == 1) PG8_BAR; }
    }
    PG8_WAIT_V(0);
    if constexpr (!ALIGN_EPI) { if (wr == 0) PG8_BAR; }
    PG8_BAR;
    if constexpr (Epi::AFTER_DRAIN) { E.fused(acc, cur, wr, wc, fr, fq, lds, wid, lane); S.done(cur); }
#undef PG8_SA
#undef PG8_SB
#undef PG8_STAGE
#undef PG8_LDA
#undef PG8_LDB
#undef PG8_MMA
#undef PG8_WAIT_V
#undef PG8_WAIT_L
#undef PG8_BAR
#undef PG8_SCHED
}
}
#define GAS __attribute__((address_space(1)))
#define LAS __attribute__((address_space(3)))
typedef unsigned short bf16;
typedef unsigned v4u __attribute__((ext_vector_type(4)));
typedef float f32x4 __attribute__((ext_vector_type(4)));
typedef short bf16x8 __attribute__((ext_vector_type(8)));
typedef GAS unsigned gu32;
typedef GAS unsigned long long gu64;
#define RLX_AGENT __ATOMIC_RELAXED, __HIP_MEMORY_SCOPE_AGENT
#define LDS_WAIT() asm volatile("s_waitcnt lgkmcnt(0)" ::: "memory")
#define VM_WAIT() asm volatile("s_waitcnt vmcnt(0)" ::: "memory")
__device__ __forceinline__ unsigned long long rt() { return __builtin_amdgcn_s_memrealtime(); }
__device__ __forceinline__ unsigned f2bf(float f) { unsigned u = __builtin_bit_cast(unsigned, f); return (u + 0x7fffu + ((u >> 16) & 1u)) >> 16; }
__device__ __forceinline__ unsigned pk2(float lo, float hi) { return f2bf(lo) | (f2bf(hi) << 16); }
#define XB_TMO      128
#define XB_XCNT(j)  (256  + 64 * (j))
#define XB_XSUB(j)  (1280 + 64 * (j))
#define XB_XGEN(j)  (2304 + 64 * (j))
#define XB_TOP      3328
#define XB_TOPGEN   3392
#define XCD_BAR_WORDS 3456
#define XB_SPIN_CAP (1u << 18)

__device__ __forceinline__ unsigned xb_ld(unsigned* p)              { return __hip_atomic_load(p, __ATOMIC_RELAXED, __HIP_MEMORY_SCOPE_AGENT); }
__device__ __forceinline__ unsigned xb_add(unsigned* p, unsigned v) { return __hip_atomic_fetch_add(p, v, __ATOMIC_RELAXED, __HIP_MEMORY_SCOPE_AGENT); }
__device__ __forceinline__ unsigned xb_xcc_id() { return (unsigned)__builtin_amdgcn_s_getreg((3 << 11) | 20) & 0xFu; }
#define XB_SPIN(cond, bar) do { unsigned _sp = 0; while (cond) { __builtin_amdgcn_s_sleep(1); \
    if ((++_sp & 255u) == 0u) { if (xb_ld(&(bar)[XB_TMO])) break; if (_sp > XB_SPIN_CAP) { atomicAdd(&(bar)[XB_TMO], 1u); break; } } } } while (0)

struct XcdBarrier {
    unsigned* bar; unsigned x;
    unsigned w0;
    volatile LAS unsigned* st;
};

__device__ __forceinline__ XcdBarrier xcd_barrier_post(unsigned* bar, volatile LAS unsigned* st) {
    XcdBarrier b; b.bar = bar; b.x = xb_xcc_id(); b.st = st; b.w0 = (__builtin_amdgcn_readfirstlane(threadIdx.x >> 6) == 0) ? 1u : 0u;
    if (threadIdx.x == 0) (void)xb_add(&bar[XB_XCNT(b.x)], 1u);
    return b;
}
__device__ __forceinline__ void xcd_barrier_complete(unsigned* bar, unsigned x, unsigned& nloc, unsigned& nx) {
    const unsigned G = gridDim.x * gridDim.y * gridDim.z;
    unsigned sum, cnt, mine, sp = 0u;
    for (;;) {
        sum = 0u; cnt = 0u; mine = 0u;
#pragma unroll
        for (unsigned j = 0; j < 16; ++j) { const unsigned c = xb_ld(&bar[XB_XCNT(j)]); sum += c; cnt += (c > 0u) ? 1u : 0u; mine = (j == x) ? c : mine; }
        if (sum == G) break;
        __builtin_amdgcn_s_sleep(1);
        if ((++sp & 255u) == 0u) { if (xb_ld(&bar[XB_TMO])) break; if (sp > XB_SPIN_CAP) { atomicAdd(&bar[XB_TMO], 1u); break; } }
    }
    nloc = mine > 0u ? mine : 1u; nx = cnt > 0u ? cnt : 1u;
}

__device__ __forceinline__ void xcd_barrier(const XcdBarrier& b) {
    asm volatile("s_waitcnt vmcnt(0)" ::: "memory");
    __syncthreads();
    if (b.w0 != 0u && __builtin_amdgcn_mbcnt_hi(~0u, __builtin_amdgcn_mbcnt_lo(~0u, 0u)) == 0u) {
        GAS unsigned* barg = (GAS unsigned*)b.bar; asm volatile("" : "+s"(barg)); unsigned* bar = (unsigned*)barg;
        __builtin_amdgcn_s_waitcnt(0);
        unsigned nloc = b.st[0], nx = b.st[1];
        if (nloc == 0u) { xcd_barrier_complete(bar, b.x, nloc, nx); b.st[0] = nloc; b.st[1] = nx; }
        const unsigned old = xb_add(&bar[XB_XSUB(b.x)], 1u);
        const unsigned gen = old / nloc;
        if (old + 1u == (gen + 1u) * nloc) {
            __builtin_amdgcn_fence(__ATOMIC_RELEASE, "agent");
            asm volatile("s_waitcnt vmcnt(0)" ::: "memory");
            const unsigned og = xb_add(&bar[XB_TOP], 1u);
            const unsigned tg = og / nx;
            if (og + 1u == (tg + 1u) * nx) xb_add(&bar[XB_TOPGEN], 1u);
            else XB_SPIN(xb_ld(&bar[XB_TOPGEN]) == tg, bar);
            __builtin_amdgcn_fence(__ATOMIC_ACQUIRE, "agent");
            xb_add(&bar[XB_XGEN(b.x)], 1u);
            asm volatile("s_waitcnt vmcnt(0)" ::: "memory");
        } else {
            XB_SPIN(xb_ld(&bar[XB_XGEN(b.x)]) == gen, bar);
            __builtin_amdgcn_fence(__ATOMIC_ACQUIRE, "agent");
            asm volatile("s_waitcnt vmcnt(0)" ::: "memory");
        }
    }
    __syncthreads();
}
typedef unsigned u32x4 __attribute__((ext_vector_type(4)));

typedef short s16x4 __attribute__((ext_vector_type(4)));
typedef float f32x16 __attribute__((ext_vector_type(16)));
typedef unsigned u32x2 __attribute__((ext_vector_type(2)));
typedef float f32x2v __attribute__((ext_vector_type(2)));

constexpr int S = 8192, D = 2048, DEPTH = 4, DIN = 5688, NP = 5888, PITCH = 5632;
constexpr int C_AQ = 0, C_AK = 512, C_AV = 1024, C_BQ = 1536, C_BK = 2048, C_BV = 2560, C_CQ = 3072, C_KC = 4096, C_VC = 4352, C_KS = 4608, C_VS = 4864, C_KW = 5120, C_VW = 5376;
constexpr float RMS_EPS = 1e-6f, NEG = -1e30f, LOG2E = 1.4426950408889634f, SCL2 = 0.125f * 1.4426950408889634f;
constexpr int NWAVES = 8, NTHR = 512;

constexpr size_t MiB = 1u << 20;
constexpr size_t WS_CTL = 0, CTL_ZERO_BYTES = 1 * MiB;
constexpr size_t WS_WIN = 2 * MiB;
constexpr size_t WS_WOUT = 96 * MiB;
constexpr size_t WS_W1T = 128 * MiB;
constexpr size_t WS_W2T = 136 * MiB;
constexpr size_t WS_RWT = 137 * MiB;
constexpr size_t WS_C1 = 139 * MiB;
constexpr size_t WS_X = 144 * MiB;
constexpr size_t WS_XN = 208 * MiB;
constexpr size_t WS_PROJ = 240 * MiB;
constexpr size_t WS_AUX = 330 * MiB;
constexpr size_t WS_CUM = 332 * MiB;
constexpr size_t WS_KC = 333 * MiB;
constexpr size_t WS_VC = 334 * MiB;
constexpr size_t WS_MIX = 336 * MiB;
constexpr size_t WS_YB = 368 * MiB;
constexpr size_t WS_LIST = 432 * MiB;
constexpr size_t WS_TW = 436 * MiB;
constexpr size_t WS_END = 440 * MiB;
constexpr int CW_BAR = 4096;
constexpr int CW_Q = 8192;
constexpr int CW_PQ = 24576, CW_PD = 25600;
constexpr int CW_CNT = 32768;

constexpr int LDS_BYTES = 160 * 1024;
constexpr int MISC_OFF = 150 * 1024;

struct Args { const float* in[23]; float* out; unsigned char* ws; int ph_lo, ph_hi; };
__device__ __forceinline__ int t5_bucket(int rel) { if (rel < 16) return rel; int b = 16;
    b += rel >= 19; b += rel >= 21; b += rel >= 24; b += rel >= 27; b += rel >= 31; b += rel >= 35; b += rel >= 40; b += rel >= 46; b += rel >= 52; b += rel >= 59; b += rel >= 67; b += rel >= 77; b += rel >= 87; b += rel >= 99; b += rel >= 113; return b; }

__device__ __forceinline__ float bf2f(unsigned short b) { return __uint_as_float((unsigned)b << 16); }
__device__ __forceinline__ float bflo(unsigned w) { return __uint_as_float(w << 16); }
__device__ __forceinline__ float bfhi(unsigned w) { return __uint_as_float(w & 0xffff0000u); }
typedef __bf16 bf16x2_t __attribute__((ext_vector_type(2)));
__device__ __forceinline__ unsigned cvtpk(float lo, float hi) { f32x2v v = {lo, hi}; bf16x2_t b = __builtin_convertvector(v, bf16x2_t); return __builtin_bit_cast(unsigned, b); }
__device__ __forceinline__ unsigned short f2bf16(float f) { return (unsigned short)(cvtpk(f, 0.f) & 0xffffu); }
__device__ __forceinline__ float wave_sum(float v) {
#pragma unroll
    for (int o = 1; o < 64; o <<= 1) v += __shfl_xor(v, o);
    return v;
}
__device__ __forceinline__ int crow(int r, int hi) { return (r & 3) + 8 * (r >> 2) + 4 * hi; }
#define MFMA32(a, b, c) __builtin_amdgcn_mfma_f32_32x32x16_bf16((a), (b), (c), 0, 0, 0)
#define MFMA16(a, b, c) __builtin_amdgcn_mfma_f32_16x16x32_bf16((a), (b), (c), 0, 0, 0)

__device__ __forceinline__ int src_col_win(int n) { if (n < 3072) return n; if (n < 5632) return n + 8; if (n < 5640) return n - 2560; if (n < 5688) return n; return -1; }

template <int MODE>
__device__ __forceinline__ void tr_item(const float* W, const float* W2, int ldw, int K, bf16* WT, int k0, int n0, LAS float* scr, int lane) {
    const int nn = n0 + (lane & 31);
    const float* src = W; int ld = ldw; bool ok = true;
    if (MODE == 0) { src = W + nn; }
    else if (MODE == 1) { const int c = src_col_win(nn); ok = c >= 0; src = W + (ok ? c : 0); }
    else { if (nn < 8) { src = W + nn; ld = 8; } else if (nn < 72) { src = W2 + (nn - 8); ld = 64; } else { ok = false; ld = 8; } }
    float tv[32];
#pragma unroll
    for (int i = 0; i < 32; ++i) { const int kk = 2 * i + (lane >> 5); tv[i] = ok ? src[(size_t)(k0 + kk) * ld] : 0.f; }
#pragma unroll
    for (int i = 0; i < 32; ++i) { const int kk = 2 * i + (lane >> 5); scr[kk * 33 + (lane & 31)] = tv[i]; }
    LDS_WAIT(); asm volatile("" ::: "memory");
    const int c = lane & 7;
#pragma unroll
    for (int j = 0; j < 4; ++j) { const int n = (lane >> 3) + 8 * j; const LAS float* s = scr + (8 * c) * 33 + n;
        v4u o; o.x = pk2(s[0 * 33], s[1 * 33]); o.y = pk2(s[2 * 33], s[3 * 33]); o.z = pk2(s[4 * 33], s[5 * 33]); o.w = pk2(s[6 * 33], s[7 * 33]);
        *(v4u*)(WT + (size_t)(n0 + n) * K + k0 + 8 * c) = o; }
    LDS_WAIT(); asm volatile("" ::: "memory");
}

template <int MODE>
__device__ __forceinline__ void norm_rows(const float* xsrc, const bf16* xb, bf16* X, bf16* XN, const bf16* YB, const float* TW, const float* gain, float* out, int gw, int NGW, int lane) {
    for (int row = gw; row < S; row += NGW) {
        f32x4 v[8];
        if (MODE == 0) { const f32x4* xr = (const f32x4*)(xsrc + (size_t)row * D) + lane;
#pragma unroll
            for (int j = 0; j < 8; ++j) v[j] = xr[64 * j];
        } else { const u32x2* xr = (const u32x2*)(xb + (size_t)row * D) + lane;
#pragma unroll
            for (int j = 0; j < 8; ++j) { const u32x2 r = xr[64 * j]; v[j] = (f32x4){bflo(r.x), bfhi(r.x), bflo(r.y), bfhi(r.y)}; } }
        if (MODE >= 1) {
            const float w0 = TW[2 * row], w1 = TW[2 * row + 1];
            const u32x2* ya = (const u32x2*)(YB + (size_t)(2 * row) * D) + lane; const u32x2* yb = (const u32x2*)(YB + (size_t)(2 * row + 1) * D) + lane;
#pragma unroll
            for (int j = 0; j < 8; ++j) { const u32x2 a = ya[64 * j], b = yb[64 * j];
                v[j].x += w0 * bflo(a.x) + w1 * bflo(b.x); v[j].y += w0 * bfhi(a.x) + w1 * bfhi(b.x);
                v[j].z += w0 * bflo(a.y) + w1 * bflo(b.y); v[j].w += w0 * bfhi(a.y) + w1 * bfhi(b.y); }
        }
        float ss = 0.f;
#pragma unroll
        for (int j = 0; j < 8; ++j) ss += (v[j].x * v[j].x + v[j].y * v[j].y) + (v[j].z * v[j].z + v[j].w * v[j].w);
        ss = wave_sum(ss);
        const float rstd = 1.0f / sqrtf(ss * (1.0f / D) + RMS_EPS);
        if (MODE == 1) { u32x2* xo = (u32x2*)(X + (size_t)row * D) + lane;
#pragma unroll
            for (int j = 0; j < 8; ++j) { u32x2 w; w.x = cvtpk(v[j].x, v[j].y); w.y = cvtpk(v[j].z, v[j].w); xo[64 * j] = w; } }
        const f32x4* gr = (const f32x4*)gain + lane;
        if (MODE < 2) { u32x2* o8 = (u32x2*)(XN + (size_t)row * D) + lane;
#pragma unroll
            for (int j = 0; j < 8; ++j) { const f32x4 g = gr[64 * j]; u32x2 w; w.x = cvtpk(v[j].x * rstd * g.x, v[j].y * rstd * g.y); w.y = cvtpk(v[j].z * rstd * g.z, v[j].w * rstd * g.w); o8[64 * j] = w; }
        } else { f32x4* oo = (f32x4*)(out + (size_t)row * D) + lane;
#pragma unroll
            for (int j = 0; j < 8; ++j) { const f32x4 g = gr[64 * j]; oo[64 * j] = v[j] * rstd * g; } }
    }
}

__device__ __forceinline__ void p0_prologue(const Args& a, LAS unsigned char* lds, int bid, int G, int tid, int wid, int lane) {
    unsigned char* ws = a.ws;
    LAS float* scr = (LAS float*)(lds + wid * 8448);
    const int gw = bid * NWAVES + wid, NGW = G * NWAVES;
    constexpr int I_WIN = 32 * 184, I_WOUT = 32 * 64, I_W1 = 32 * 8, I_W2 = 4 * 2, I_RW = 32 * 3, I_L = I_WIN + I_WOUT + 2 * I_W1 + 2 * I_W2 + I_RW;
    for (int it = gw; it < DEPTH * I_L; it += NGW) {
        const int l = it / I_L; int r = it % I_L;
        if (r < I_WIN) { tr_item<1>(a.in[2] + (size_t)l * D * DIN, nullptr, DIN, D, (bf16*)(ws + WS_WIN) + (size_t)l * NP * D, 64 * (r / 184), 32 * (r % 184), scr, lane); continue; } r -= I_WIN;
        if (r < I_WOUT) { tr_item<0>(a.in[13] + (size_t)l * D * D, nullptr, D, D, (bf16*)(ws + WS_WOUT) + (size_t)l * D * D, 64 * (r / 64), 32 * (r % 64), scr, lane); continue; } r -= I_WOUT;
        if (r < 2 * I_W1) { const int kv = r / I_W1, q = r % I_W1; tr_item<0>(a.in[kv ? 10 : 7] + (size_t)l * 2048 * 256, nullptr, 256, 2048, (bf16*)(ws + WS_W1T) + (size_t)(l * 2 + kv) * 256 * 2048, 64 * (q / 8), 32 * (q % 8), scr, lane); continue; } r -= 2 * I_W1;
        if (r < 2 * I_W2) { const int kv = r / I_W2, q = r % I_W2; tr_item<0>(a.in[kv ? 11 : 8] + (size_t)l * 256 * 64, nullptr, 64, 256, (bf16*)(ws + WS_W2T) + (size_t)(l * 2 + kv) * 64 * 256, 64 * (q / 2), 32 * (q % 2), scr, lane); continue; } r -= 2 * I_W2;
        tr_item<2>(a.in[15] + (size_t)l * D * 8, a.in[17] + (size_t)l * D * 64, 8, D, (bf16*)(ws + WS_RWT) + (size_t)l * 96 * D, 64 * (r / 3), 32 * (r % 3), scr, lane);
    }
    for (int b = bid; b < 256; b += G) {
        const int vec = b >> 5, cb = b & 31, l = vec >> 1, kv = vec & 1; const float* pos = a.in[kv ? 9 : 6] + (size_t)l * 2048; const float* w1 = a.in[kv ? 10 : 7] + (size_t)l * 2048 * 256 + 8 * cb;
        float acc[8];
#pragma unroll
        for (int i = 0; i < 8; ++i) acc[i] = 0.f;
#pragma unroll
        for (int j = 0; j < 4; ++j) { const int k = tid + 512 * j; const float pv = pos[k]; const f32x4 w0 = *(const f32x4*)(w1 + (size_t)k * 256), w1v = *(const f32x4*)(w1 + (size_t)k * 256 + 4);
            acc[0] += pv * w0.x; acc[1] += pv * w0.y; acc[2] += pv * w0.z; acc[3] += pv * w0.w; acc[4] += pv * w1v.x; acc[5] += pv * w1v.y; acc[6] += pv * w1v.z; acc[7] += pv * w1v.w; }
        LAS float* red = (LAS float*)(lds + 72 * 1024);
#pragma unroll
        for (int i = 0; i < 8; ++i) { const float sws = wave_sum(acc[i]); if (lane == 0) red[wid * 8 + i] = sws; }
        __syncthreads();
        if (tid < 8) { float sres = 0.f;
#pragma unroll
            for (int w = 0; w < 8; ++w) sres += red[w * 8 + tid];
            ((float*)(ws + WS_C1))[vec * 256 + 8 * cb + tid] = sres; }
        __syncthreads();
    }
    norm_rows<0>(a.in[0], nullptr, nullptr, (bf16*)(ws + WS_XN), nullptr, nullptr, a.in[1], nullptr, gw, NGW, lane);
}

__device__ __forceinline__ float gelu_tanh(float x) { const float u = 0.7978845608028654f * (x + 0.044715f * x * x * x); const float t = 1.0f - 2.0f / (__expf(2.0f * u) + 1.0f); return 0.5f * x * (1.0f + t); }

__device__ __forceinline__ void compress_unit(int u, int l, const bf16* PROJ, const bf16* W1T, const bf16* W2T, const float* C1, bf16* KC, bf16* VC, LAS unsigned char* lds, int wid, int lane) {
    const int kv = u >> 6, rb = u & 63, r32 = lane & 31, hi = lane >> 5;
    const int R = 32 * rb + r32, g = R >> 9, n = R & 511;
    const int colb = (kv ? C_VC : C_KC) + 64 * g;
    const bf16* w1 = W1T + (size_t)(l * 2 + kv) * 256 * 2048 + (size_t)(32 * wid + r32) * 2048 + 8 * hi;
    const bf16* arow = PROJ + colb + 8 * hi;
    f32x16 acc = {};
#pragma unroll 4
    for (int s = 0; s < 128; ++s) {
        int tok = 16 * n + (s >> 2); tok = tok > (S - 1) ? (S - 1) : tok;
        const bf16x8 av = *(const bf16x8*)(arow + (size_t)tok * PITCH + (s & 3) * 16);
        const bf16x8 bv = *(const bf16x8*)(w1 + 16 * s);
        acc = MFMA32(av, bv, acc);
    }
    LAS bf16* hid = (LAS bf16*)lds;
    const float c1 = C1[(l * 2 + kv) * 256 + 32 * wid + r32];
#pragma unroll
    for (int r = 0; r < 16; ++r) hid[crow(r, hi) * 264 + 32 * wid + r32] = f2bf16(gelu_tanh(acc[r] + c1));
    __syncthreads();
    if (wid < 2) {
        f32x16 acc2 = {};
        const bf16* w2 = W2T + (size_t)(l * 2 + kv) * 64 * 256 + (size_t)(32 * wid + r32) * 256 + 8 * hi;
#pragma unroll 4
        for (int s = 0; s < 16; ++s) {
            const bf16x8 av = *(const LAS bf16x8*)(hid + r32 * 264 + 16 * s + 8 * hi);
            const bf16x8 bv = *(const bf16x8*)(w2 + 16 * s);
            acc2 = MFMA32(av, bv, acc2);
        }
        bf16* outp = kv ? VC : KC;
#pragma unroll
        for (int r = 0; r < 16; ++r) { const int Rr = 32 * rb + crow(r, hi); outp[(size_t)((Rr >> 9) * 512 + (Rr & 511)) * 64 + 32 * wid + r32] = f2bf16(acc2[r]); }
    }
    __syncthreads();
}

__device__ __forceinline__ void cumsum_unit(int h, int l, const float* AUX, const float* fox_bf, float* CUM, LAS unsigned char* lds, int tid) {
    const float bfv = fox_bf[l * 8 + h];
    float v[16]; float run = 0.f;
#pragma unroll
    for (int i = 0; i < 16; ++i) { const int t = 16 * tid + i; const float z = AUX[(size_t)t * 64 + h] + bfv; const float lf = fminf(z, 0.f) - log1pf(__expf(-fabsf(z))); run += lf; v[i] = run; }
    LAS float* tot = (LAS float*)lds;
    tot[tid] = run; __syncthreads();
    float off = 0.f;
    for (int j = 0; j < tid; ++j) off += tot[j];
#pragma unroll
    for (int i = 0; i < 16; ++i) CUM[(size_t)h * S + 16 * tid + i] = off + v[i];
    __syncthreads();
}

__device__ __forceinline__ int koff(int key, int c) { return c * 1024 + (((key + c) & 63) << 4); }
__device__ __forceinline__ int voff(int key, int c) { return (c >> 2) * 4096 + (key >> 4) * 1024 + (key & 15) * 64 + (c & 3) * 16; }
typedef short v4i16_t __attribute__((ext_vector_type(4)));
__device__ __forceinline__ s16x4 vtr(LAS const unsigned char* p) { return __builtin_bit_cast(s16x4, __builtin_amdgcn_ds_read_tr16_b64_v4i16((LAS v4i16_t*)p)); }

template <int NDT> struct AState { float m, l; f32x16 o[NDT]; };
template <int NDT> __device__ __forceinline__ void astate_init(AState<NDT>& st) { st.m = 0.f; st.l = 0.f;
#pragma unroll
    for (int i = 0; i < NDT; ++i) st.o[i] = (f32x16){}; }

template <bool QLDS>
__device__ __forceinline__ void qk_tile(f32x16& p0, f32x16& p1, LAS const unsigned char* kt, int kchunk0, const bf16x8 (&qf)[4], LAS const unsigned char* qb, int r32, int hi) {
    bf16x8 ka[4], kb[4], q[4];
#pragma unroll
    for (int d0 = 0; d0 < 4; ++d0) {
        const int c = kchunk0 + 2 * d0 + hi;
        ka[d0] = *(const LAS bf16x8*)(kt + koff(r32, c));
        kb[d0] = *(const LAS bf16x8*)(kt + koff(r32 + 32, c));
        q[d0] = QLDS ? *(const LAS bf16x8*)(qb + d0 * 8192) : qf[d0];
    }
    __builtin_amdgcn_sched_barrier(0);
    p0 = (f32x16){}; p1 = (f32x16){};
#pragma unroll
    for (int d0 = 0; d0 < 4; ++d0) { p0 = MFMA32(ka[d0], q[d0], p0); p1 = MFMA32(kb[d0], q[d0], p1); }
    __builtin_amdgcn_sched_barrier(0);
}
__device__ __forceinline__ void pack_p(bf16x8 (&pw)[4], const f32x16& p0, const f32x16& p1) {
    u32x4 w;
    w.x = cvtpk(p0[0], p0[1]); w.y = cvtpk(p0[2], p0[3]); w.z = cvtpk(p0[4], p0[5]); w.w = cvtpk(p0[6], p0[7]); pw[0] = __builtin_bit_cast(bf16x8, w);
    w.x = cvtpk(p0[8], p0[9]); w.y = cvtpk(p0[10], p0[11]); w.z = cvtpk(p0[12], p0[13]); w.w = cvtpk(p0[14], p0[15]); pw[1] = __builtin_bit_cast(bf16x8, w);
    w.x = cvtpk(p1[0], p1[1]); w.y = cvtpk(p1[2], p1[3]); w.z = cvtpk(p1[4], p1[5]); w.w = cvtpk(p1[6], p1[7]); pw[2] = __builtin_bit_cast(bf16x8, w);
    w.x = cvtpk(p1[8], p1[9]); w.y = cvtpk(p1[10], p1[11]); w.z = cvtpk(p1[12], p1[13]); w.w = cvtpk(p1[14], p1[15]); pw[3] = __builtin_bit_cast(bf16x8, w);
}
struct VFrag { s16x4 lo[4], hh[4]; };
__device__ __forceinline__ LAS const unsigned char* vfrag_base(LAS const unsigned char* vt, int lane) { return vt + ((lane >> 4) & 1) * 32 + (lane & 3) * 8 + (4 * (lane >> 5) + ((lane & 15) >> 2)) * 64; }
__device__ __forceinline__ void vfrag_read(VFrag& f, LAS const unsigned char* vb, int dt) {
#pragma unroll
    for (int s = 0; s < 4; ++s) { f.lo[s] = vtr(vb + dt * 4096 + s * 1024); f.hh[s] = vtr(vb + dt * 4096 + s * 1024 + 512); }
}
__device__ __forceinline__ void vfrag_mma(f32x16& o, const VFrag& f, const bf16x8 (&pw)[4]) {
#pragma unroll
    for (int s = 0; s < 4; ++s) { const bf16x8 vf = (bf16x8){f.lo[s][0], f.lo[s][1], f.lo[s][2], f.lo[s][3], f.hh[s][0], f.hh[s][1], f.hh[s][2], f.hh[s][3]}; o = MFMA32(vf, pw[s], o); }
}
template <int NDT>
__device__ __forceinline__ void pv_tile_pre(f32x16 (&o)[NDT], const bf16x8 (&pw)[4], LAS const unsigned char* vb, VFrag& f0) {
    VFrag f1;
#pragma unroll
    for (int dt = 0; dt < NDT; dt += 2) {
        if (dt + 1 < NDT) vfrag_read(f1, vb, dt + 1);
        __builtin_amdgcn_sched_barrier(0);
        vfrag_mma(o[dt], f0, pw);
        if (dt + 1 < NDT) {
            if (dt + 2 < NDT) vfrag_read(f0, vb, dt + 2);
            __builtin_amdgcn_sched_barrier(0);
            vfrag_mma(o[dt + 1], f1, pw);
        }
    }
}
template <int NDT>
__device__ __forceinline__ void pv_tile(f32x16 (&o)[NDT], const bf16x8 (&pw)[4], LAS const unsigned char* vt, int lane) {
    LAS const unsigned char* vb = vfrag_base(vt, lane);
    VFrag f0; vfrag_read(f0, vb, 0);
    pv_tile_pre<NDT>(o, pw, vb, f0);
}
constexpr float SM_THR = 8.0f;
__device__ __forceinline__ float max3f(float a, float b, float c) { return __builtin_fmaxf(__builtin_fmaxf(a, b), c); }
__device__ __forceinline__ float halfmax(float m) { auto rr = __builtin_amdgcn_permlane32_swap(__float_as_uint(m), __float_as_uint(m), false, false); return fmaxf(__uint_as_float(rr[0]), __uint_as_float(rr[1])); }
__device__ __forceinline__ float halfsum(float v) { auto rr = __builtin_amdgcn_permlane32_swap(__float_as_uint(v), __float_as_uint(v), false, false); return __uint_as_float(rr[0]) + __uint_as_float(rr[1]); }
#ifndef SM_VPRE
#define SM_VPRE false
#endif
template <int NDT>
__device__ __forceinline__ void softmax_pv(AState<NDT>& st, f32x16& p0, f32x16& p1, LAS const unsigned char* vt, int lane) {
    LAS const unsigned char* vb = vfrag_base(vt, lane);
    constexpr bool VPRE = SM_VPRE;
    VFrag f0; if (VPRE) { vfrag_read(f0, vb, 0); __builtin_amdgcn_sched_barrier(0); }
    float ma = max3f(p0[0], p0[1], p0[2]), mb = max3f(p1[0], p1[1], p1[2]);
#pragma unroll
    for (int r = 3; r < 15; r += 2) { ma = max3f(ma, p0[r], p0[r + 1]); mb = max3f(mb, p1[r], p1[r + 1]); }
    float mx = max3f(ma, mb, fmaxf(p0[15], p1[15]));
    mx = halfmax(mx);
    if (__any(mx > SM_THR)) {
        const float d = fmaxf(mx, 0.f), alpha = __builtin_amdgcn_exp2f(-d); st.m += d; st.l *= alpha;
#pragma unroll
        for (int r = 0; r < 16; ++r) { p0[r] -= d; p1[r] -= d; }
#pragma unroll
        for (int dt = 0; dt < NDT; ++dt)
#pragma unroll
            for (int r = 0; r < 16; ++r) st.o[dt][r] *= alpha;
    }
    float rs = 0.f;
#pragma unroll
    for (int r = 0; r < 16; ++r) { p0[r] = __builtin_amdgcn_exp2f(p0[r]); p1[r] = __builtin_amdgcn_exp2f(p1[r]); rs += p0[r] + p1[r]; }
    st.l += rs;
    bf16x8 pw[4]; pack_p(pw, p0, p1);
    if (!VPRE) vfrag_read(f0, vb, 0);
    pv_tile_pre<NDT>(st.o, pw, vb, f0);
}
__device__ __forceinline__ void softmax_stats(float& m, float& l, const f32x16& p0, const f32x16& p1) {
    float mx = fmaxf(p0[0], p1[0]);
#pragma unroll
    for (int r = 1; r < 16; ++r) mx = fmaxf(mx, fmaxf(p0[r], p1[r]));
    mx = halfmax(mx);
    const float mn = fmaxf(m, mx), alpha = __builtin_amdgcn_exp2f(m - mn); m = mn;
    float rs = 0.f;
#pragma unroll
    for (int r = 0; r < 16; ++r) rs += __builtin_amdgcn_exp2f(p0[r] - mn) + __builtin_amdgcn_exp2f(p1[r] - mn);
    l = l * alpha + rs;
}

template <int KCH, int VCH> struct Stage { u32x4 k[KCH / 8], v[VCH / 8], x; };
template <int KCH, int VCH, bool XROW>
__device__ __forceinline__ void stage_load(Stage<KCH, VCH>& sg, const bf16* ksrc, const bf16* vsrc, const float* xsrc, size_t pitch, int key0, int tid) {
#pragma unroll
    for (int i = 0; i < KCH / 8; ++i) { const int idx = tid + 512 * i, key = idx / KCH, c = idx % KCH; sg.k[i] = *(const u32x4*)(ksrc + (size_t)(key0 + key) * pitch + 8 * c); }
#pragma unroll
    for (int i = 0; i < VCH / 8; ++i) { const int idx = tid + 512 * i, key = idx / VCH, c = idx % VCH; sg.v[i] = *(const u32x4*)(vsrc + (size_t)(key0 + key) * pitch + 8 * c); }
    if (XROW) sg.x = *(const u32x4*)(xsrc + key0 + 4 * (tid & 15));
}
template <int KCH, int VCH, bool XROW>
__device__ __forceinline__ void stage_write(const Stage<KCH, VCH>& sg, LAS unsigned char* kb, LAS unsigned char* vb, LAS unsigned char* xb, int tid) {
#pragma unroll
    for (int i = 0; i < KCH / 8; ++i) { const int idx = tid + 512 * i, key = idx / KCH, c = idx % KCH; *(LAS u32x4*)(kb + koff(key, c)) = sg.k[i]; }
#pragma unroll
    for (int i = 0; i < VCH / 8; ++i) { const int idx = tid + 512 * i, key = idx / VCH, c = idx % VCH; *(LAS u32x4*)(vb + voff(key, c)) = sg.v[i]; }
    if (XROW) { if (tid < 16) { f32x4 xv = __builtin_bit_cast(f32x4, sg.x); xv = xv * LOG2E; *(LAS f32x4*)(xb + 16 * tid) = xv; } }
}

template <int KCH, int VCH, bool XROW, int NST  , bool QLDS, class Fn>
__device__ __forceinline__ void kv_loop(Fn& fn, const bf16x8 (&qf)[4], LAS const unsigned char* qb, int kchunk0, const bf16* ksrc, const bf16* vsrc, const float* xsrc, size_t pitch, int t_lo, int t_hi,
                                        LAS unsigned char* KB, LAS unsigned char* VB, LAS unsigned char* XB, int tid, int lane) {
    constexpr int KBYTES = KCH * 1024, VBYTES = VCH * 1024;
    const int r32 = lane & 31, hi = lane >> 5, nt = t_hi - t_lo;
    if (NST == 1) {
        Stage<KCH, VCH> sg;
        stage_load<KCH, VCH, XROW>(sg, ksrc, vsrc, xsrc, pitch, 64 * t_lo, tid);
        stage_write<KCH, VCH, XROW>(sg, KB, VB, XB, tid);
        __syncthreads();
        for (int i = 0; i < nt; ++i) {
            const int b = i & 1;
            if (i + 1 < nt) stage_load<KCH, VCH, XROW>(sg, ksrc, vsrc, xsrc, pitch, 64 * (t_lo + i + 1), tid);
            if (fn.need(t_lo + i)) { f32x16 p0, p1; qk_tile<QLDS>(p0, p1, KB + b * KBYTES, kchunk0, qf, qb, r32, hi); fn.tile(t_lo + i, p0, p1, VB + b * VBYTES, XB + b * 256); }
            if (i + 1 < nt) stage_write<KCH, VCH, XROW>(sg, KB + (b ^ 1) * KBYTES, VB + (b ^ 1) * VBYTES, XB + (b ^ 1) * 256, tid);
            __syncthreads();
        }
        return;
    }
    Stage<KCH, VCH> sgA, sgB;
    stage_load<KCH, VCH, XROW>(sgA, ksrc, vsrc, xsrc, pitch, 64 * t_lo, tid);
    if (nt > 1) stage_load<KCH, VCH, XROW>(sgB, ksrc, vsrc, xsrc, pitch, 64 * (t_lo + 1), tid);
    stage_write<KCH, VCH, XROW>(sgA, KB, VB, XB, tid);
    __syncthreads();
    for (int i = 0; i < nt; i += 2) {
        if (i + 2 < nt) stage_load<KCH, VCH, XROW>(sgA, ksrc, vsrc, xsrc, pitch, 64 * (t_lo + i + 2), tid);
        if (fn.need(t_lo + i)) { f32x16 p0, p1; qk_tile<QLDS>(p0, p1, KB, kchunk0, qf, qb, r32, hi); fn.tile(t_lo + i, p0, p1, VB, XB); }
        if (i + 1 < nt) stage_write<KCH, VCH, XROW>(sgB, KB + KBYTES, VB + VBYTES, XB + 256, tid);
        __syncthreads();
        if (i + 1 >= nt) break;
        if (i + 3 < nt) stage_load<KCH, VCH, XROW>(sgB, ksrc, vsrc, xsrc, pitch, 64 * (t_lo + i + 3), tid);
        if (fn.need(t_lo + i + 1)) { f32x16 p0, p1; qk_tile<QLDS>(p0, p1, KB + KBYTES, kchunk0, qf, qb, r32, hi); fn.tile(t_lo + i + 1, p0, p1, VB + VBYTES, XB + 256); }
        if (i + 2 < nt) stage_write<KCH, VCH, XROW>(sgA, KB, VB, XB, tid);
        __syncthreads();
    }
}

#define SGB(mask, n) __builtin_amdgcn_sched_group_barrier(mask, n, 0)
template <int NDT>
__device__ __forceinline__ void sp_finish(AState<NDT>& st, f32x16& s0, f32x16& s1, bf16x8 (&pw)[4]) {
    float rs = 0.f;
#pragma unroll
    for (int r = 0; r < 16; ++r) { s0[r] = __builtin_amdgcn_exp2f(s0[r]); s1[r] = __builtin_amdgcn_exp2f(s1[r]); rs += s0[r] + s1[r]; }
    st.l += rs;
    pack_p(pw, s0, s1);
}
__device__ __forceinline__ float sp_rowmax(const f32x16& p0, const f32x16& p1) {
    float ma = max3f(p0[0], p0[1], p0[2]), mb = max3f(p1[0], p1[1], p1[2]);
#pragma unroll
    for (int r = 3; r < 15; r += 2) { ma = max3f(ma, p0[r], p0[r + 1]); mb = max3f(mb, p1[r], p1[r + 1]); }
    return max3f(ma, mb, fmaxf(p0[15], p1[15]));
}
template <int NDT>
__device__ __forceinline__ void sp_raise(AState<NDT>& st, f32x16& p0, f32x16& p1, float mx) {
    mx = halfmax(mx);
    if (__any(mx > SM_THR)) {
        const float d = fmaxf(mx, 0.f), alpha = __builtin_amdgcn_exp2f(-d); st.m += d; st.l *= alpha;
#pragma unroll
        for (int r = 0; r < 16; ++r) { p0[r] -= d; p1[r] -= d; }
#pragma unroll
        for (int dt = 0; dt < NDT; ++dt)
#pragma unroll
            for (int r = 0; r < 16; ++r) st.o[dt][r] *= alpha;
    }
}
__device__ __forceinline__ void sp_finish_part(int j, float& rs, f32x16& s0, f32x16& s1, u32x4 (&pu)[4]) {
#pragma unroll
    for (int r = 4 * j; r < 4 * j + 4; ++r) { s0[r] = __builtin_amdgcn_exp2f(s0[r]); s1[r] = __builtin_amdgcn_exp2f(s1[r]); rs += s0[r] + s1[r]; }
    const unsigned a0 = cvtpk(s0[4 * j], s0[4 * j + 1]), a1 = cvtpk(s0[4 * j + 2], s0[4 * j + 3]), b0 = cvtpk(s1[4 * j], s1[4 * j + 1]), b1 = cvtpk(s1[4 * j + 2], s1[4 * j + 3]);
    if (j & 1) { pu[j >> 1].z = a0; pu[j >> 1].w = a1; pu[2 + (j >> 1)].z = b0; pu[2 + (j >> 1)].w = b1; }
    else       { pu[j >> 1].x = a0; pu[j >> 1].y = a1; pu[2 + (j >> 1)].x = b0; pu[2 + (j >> 1)].y = b1; }
}
#define SP_STEADY(T, KBUF, XBUF, SP0, SP1, SN0, SN1)                                                                                                    \
    {   bf16x8 ka[4], kb[4], q[4];                                                                                                                      \
        _Pragma("unroll") for (int d0 = 0; d0 < 4; ++d0) { const int c = kchunk0 + 2 * d0 + hi;                                                         \
            ka[d0] = *(const LAS bf16x8*)((KBUF) + koff(r32, c)); kb[d0] = *(const LAS bf16x8*)((KBUF) + koff(r32 + 32, c));                             \
            q[d0] = QLDS ? *(const LAS bf16x8*)(qb + d0 * 8192) : qf[d0]; }                                                                             \
        LAS const unsigned char* vb = vfrag_base(VB + vp * VBYTES, lane);                                                                               \
        VFrag f0, f1; u32x4 pu[4]; float rs = 0.f;                                                                                                      \
        __builtin_amdgcn_sched_barrier(0);                                                                                                              \
        SN0 = (f32x16){}; SN1 = (f32x16){};                                                                                                             \
        _Pragma("unroll") for (int j = 0; j < 4; ++j) {                                                                                                 \
            SN0 = MFMA32(ka[j], q[j], SN0); SN1 = MFMA32(kb[j], q[j], SN1);                                                                             \
            sp_finish_part(j, rs, SP0, SP1, pu);                                                                                                        \
            if (NDT == 2 && j == 2) vfrag_read(f0, vb, 0);                                                                                              \
            if (NDT == 2 && j == 3) vfrag_read(f1, vb, 1);                                                                                              \
            __builtin_amdgcn_sched_barrier(0);                                                                                                          \
        }                                                                                                                                               \
        fn.st.l += rs;                                                                                                                                  \
        _Pragma("unroll") for (int k = 0; k < 4; ++k) pw[k] = __builtin_bit_cast(bf16x8, pu[k]);                                                        \
        float mx = NEG;                                                                                                                                 \
        _Pragma("unroll") for (int dt = 0; dt < NDT; dt += 2) {                                                                                         \
            if (NDT != 2) { vfrag_read(f0, vb, dt); vfrag_read(f1, vb, dt + 1); __builtin_amdgcn_sched_barrier(0); }                                    \
            _Pragma("unroll") for (int sx = 0; sx < 4; ++sx) {                                                                                          \
                { const bf16x8 vf = (bf16x8){f0.lo[sx][0], f0.lo[sx][1], f0.lo[sx][2], f0.lo[sx][3], f0.hh[sx][0], f0.hh[sx][1], f0.hh[sx][2], f0.hh[sx][3]}; fn.st.o[dt] = MFMA32(vf, pw[sx], fn.st.o[dt]); } \
                { const bf16x8 vf = (bf16x8){f1.lo[sx][0], f1.lo[sx][1], f1.lo[sx][2], f1.lo[sx][3], f1.hh[sx][0], f1.hh[sx][1], f1.hh[sx][2], f1.hh[sx][3]}; fn.st.o[dt + 1] = MFMA32(vf, pw[sx], fn.st.o[dt + 1]); } \
                if (dt == 0) { fn.score_part(sx, T, SN0, SN1, XBUF); mx = fn.max_part(sx, mx, SN0, SN1); }                                              \
                __builtin_amdgcn_sched_barrier(0);                                                                                                      \
            }                                                                                                                                           \
        }                                                                                                                                               \
        mx = fn.score_mask(T, mx, SN0, SN1);                                                                                                            \
        sp_raise<NDT>(fn.st, SN0, SN1, mx); }
template <int KCH, int VCH, bool XROW, bool QLDS, int NDT, class Fn>
__device__ __forceinline__ void kv_loop_sp(Fn& fn, const bf16x8 (&qf)[4], LAS const unsigned char* qb, int kchunk0, const bf16* ksrc, const bf16* vsrc, const float* xsrc, size_t pitch, int t_lo, int t_hi, int nw,
                                           LAS unsigned char* KB, LAS unsigned char* VB, LAS unsigned char* XB, int tid, int lane) {
    constexpr int KBYTES = KCH * 1024, VBYTES = VCH * 1024;
    const int r32 = lane & 31, hi = lane >> 5, nt = t_hi - t_lo;
    Stage<KCH, VCH> sg;
    stage_load<KCH, VCH, XROW>(sg, ksrc, vsrc, xsrc, pitch, 64 * t_lo, tid);
    stage_write<KCH, VCH, XROW>(sg, KB, VB, XB, tid);
    __syncthreads();
    f32x16 sa0, sa1, sb0, sb1; bf16x8 pw[4];
    int vc = 0, vp = 2, vn, i = 0;
#define SP_PRE(I)  if ((I) + 1 < nt) stage_load<KCH, VCH, XROW>(sg, ksrc, vsrc, xsrc, pitch, 64 * (t_lo + (I) + 1), tid);
#define SP_POST(I, KOFFN, XOFFN) vn = vc == 2 ? 0 : vc + 1; if ((I) + 1 < nt) stage_write<KCH, VCH, XROW>(sg, KB + (KOFFN), VB + vn * VBYTES, XB + (XOFFN), tid); __syncthreads(); vp = vc; vc = vn;
    SP_PRE(0)
    qk_tile<QLDS>(sa0, sa1, KB, kchunk0, qf, qb, r32, hi); fn.score(t_lo, sa0, sa1, XB); sp_raise<NDT>(fn.st, sa0, sa1, sp_rowmax(sa0, sa1));
    SP_POST(0, KBYTES, 256)
    i = 1;
    while (i + 1 < nw) {
        SP_PRE(i)
        SP_STEADY(t_lo + i, KB + KBYTES, XB + 256, sa0, sa1, sb0, sb1)
        SP_POST(i, 0, 0)
        SP_PRE(i + 1)
        SP_STEADY(t_lo + i + 1, KB, XB, sb0, sb1, sa0, sa1)
        SP_POST(i + 1, KBYTES, 256)
        i += 2;
    }
    if (i < nw) {
        SP_PRE(i)
        SP_STEADY(t_lo + i, KB + KBYTES, XB + 256, sa0, sa1, sb0, sb1)
        SP_POST(i, 0, 0)
        sa0 = sb0; sa1 = sb1; ++i;
    }
    if (i < nt) { SP_PRE(i) }
    sp_finish<NDT>(fn.st, sa0, sa1, pw); pv_tile<NDT>(fn.st.o, pw, VB + vp * VBYTES, lane);
    if (i < nt) { const int ko = (i & 1) ? 0 : KBYTES, xo = (i & 1) ? 0 : 256; SP_POST(i, ko, xo) ++i; }
    while (i < nt) { const int ko = (i & 1) ? 0 : KBYTES, xo = (i & 1) ? 0 : 256; SP_PRE(i) SP_POST(i, ko, xo) ++i; }
    __syncthreads();
#undef SP_PRE
#undef SP_POST
}

struct FoxFn {
    AState<2> st; float cq; int tq, tmin, tmax, lane;
    __device__ __forceinline__ bool need(int t) const { return 64 * t <= tmax; }
    __device__ __forceinline__ void score_part(int a, int t, f32x16& p0, f32x16& p1, LAS const unsigned char* xrow) {
        const int hi = lane >> 5; LAS const float* ck = (LAS const float*)xrow;
        const float cqm = cq - st.m;
        const f32x4 c0 = *(LAS const f32x4*)(ck + 8 * a + 4 * hi), c1 = *(LAS const f32x4*)(ck + 32 + 8 * a + 4 * hi);
#pragma unroll
        for (int i = 0; i < 4; ++i) { const int r = 4 * a + i; p0[r] = p0[r] * SCL2 + (cqm - c0[i]); p1[r] = p1[r] * SCL2 + (cqm - c1[i]); }
    }
    __device__ __forceinline__ float max_part(int a, float mx, const f32x16& p0, const f32x16& p1) const {
        return max3f(max3f(mx, p0[4 * a], p0[4 * a + 1]), max3f(p0[4 * a + 2], p0[4 * a + 3], p1[4 * a]), max3f(p1[4 * a + 1], p1[4 * a + 2], p1[4 * a + 3])); }
    __device__ __forceinline__ float score_mask(int t, float mx, f32x16& p0, f32x16& p1) const {
        const int hi = lane >> 5, k0 = 64 * t;
        if (k0 + 63 > tmin) {
#pragma unroll
            for (int r = 0; r < 16; ++r) { const int key = k0 + crow(r, hi); p0[r] = key <= tq ? p0[r] : NEG; p1[r] = key + 32 <= tq ? p1[r] : NEG; }
            mx = sp_rowmax(p0, p1);
        }
        return mx;
    }
    __device__ __forceinline__ void score(int t, f32x16& p0, f32x16& p1, LAS const unsigned char* xrow) {
#pragma unroll
        for (int a = 0; a < 4; ++a) score_part(a, t, p0, p1, xrow);
        score_mask(t, 0.f, p0, p1);
    }
};
__device__ __forceinline__ void fox_unit(int h, int qb, const bf16* PROJ, const float* CUM, bf16* MIX, LAS unsigned char* lds, int tid, int wid, int lane) {
    const int r32 = lane & 31, hi = lane >> 5, q0 = 256 * qb, tq = q0 + 32 * wid + r32;
    bf16x8 qf[4];
#pragma unroll
    for (int d0 = 0; d0 < 4; ++d0) qf[d0] = *(const bf16x8*)(PROJ + (size_t)tq * PITCH + C_BQ + 64 * h + 16 * d0 + 8 * hi);
    const float* cum = CUM + (size_t)h * S;
    FoxFn fn; astate_init<2>(fn.st); fn.cq = cum[tq] * LOG2E; fn.tq = tq; fn.tmin = q0 + 32 * wid; fn.tmax = q0 + 32 * wid + 31; fn.lane = lane;
    kv_loop_sp<8, 8, true, false, 2>(fn, qf, lds, 0, PROJ + C_BK + 64 * h, PROJ + C_BV + 64 * h, cum, PITCH, 0, 4 * (qb + 1), min(4 * (qb + 1), (fn.tmax >> 6) + 1), lds, lds + 16384, lds + 40960, tid, lane);
    const float lt = fn.st.l + __shfl_xor(fn.st.l, 32), inv = 1.0f / lt;
    bf16* orow = MIX + (size_t)tq * D + 512 + 64 * h;
#pragma unroll
    for (int dt = 0; dt < 2; ++dt)
#pragma unroll
        for (int a = 0; a < 4; ++a) { u32x2 w; w.x = cvtpk(fn.st.o[dt][4 * a] * inv, fn.st.o[dt][4 * a + 1] * inv); w.y = cvtpk(fn.st.o[dt][4 * a + 2] * inv, fn.st.o[dt][4 * a + 3] * inv);
            *(u32x2*)(orow + 32 * dt + 8 * a + 4 * hi) = w; }
}

struct DiffFn {
    AState<4> st; LAS const float* lut; int tq, tmin, tmax, lane;
    __device__ __forceinline__ bool need(int t) const { return 64 * t <= tmax; }
    __device__ __forceinline__ void tile(int t, f32x16& p0, f32x16& p1, LAS const unsigned char* vt, LAS const unsigned char*) {
        const int hi = lane >> 5, k0 = 64 * t;
        const float mref = st.m;
        if (k0 + 63 + 127 <= tmin) {
            const float b = lut[127] - mref;
#pragma unroll
            for (int r = 0; r < 16; ++r) { p0[r] = p0[r] * SCL2 + b; p1[r] = p1[r] * SCL2 + b; }
        } else {
#pragma unroll
            for (int r = 0; r < 16; ++r) { const int rel0 = tq - (k0 + crow(r, hi)); const float b0 = lut[min(max(rel0, 0), 127)] - mref; p0[r] = rel0 >= 0 ? p0[r] * SCL2 + b0 : NEG; }
            __builtin_amdgcn_sched_barrier(0);
#pragma unroll
            for (int r = 0; r < 16; ++r) { const int rel1 = tq - (k0 + 32 + crow(r, hi)); const float b1 = lut[min(max(rel1, 0), 127)] - mref; p1[r] = rel1 >= 0 ? p1[r] * SCL2 + b1 : NEG; }
            __builtin_amdgcn_sched_barrier(0);
        }
        softmax_pv<4>(st, p0, p1, vt, lane);
    }
};
__device__ __forceinline__ void diff_unit(int h, int qb, int l, const Args& a, const bf16* PROJ, bf16* MIX, LAS unsigned char* lds, int tid, int wid, int lane) {
    const int r32 = lane & 31, hi = lane >> 5, q0 = 128 * qb, map = wid & 1, qs = wid >> 1, tq = q0 + 32 * qs + r32;
    LAS float* lut = (LAS float*)(lds + 65536); LAS float* lamw = (LAS float*)(lds + 65536 + 512);
    const float lam_init = 0.8f - 0.6f * expf(-0.3f * (float)l);
    if (tid < 128) lut[tid] = a.in[12][t5_bucket(tid) * 20 + h] * LOG2E;
    if (wid == 0) { const float* dl = a.in[3] + (size_t)l * 256;
        const float s1 = wave_sum(dl[lane] * dl[64 + lane]), s2 = wave_sum(dl[128 + lane] * dl[192 + lane]);
        if (lane == 0) lamw[0] = expf(s1) - expf(s2) + lam_init; }
    bf16x8 qf[4];
#pragma unroll
    for (int d0 = 0; d0 < 4; ++d0) qf[d0] = *(const bf16x8*)(PROJ + (size_t)tq * PITCH + C_AQ + 128 * h + 64 * map + 16 * d0 + 8 * hi);
    DiffFn fn; astate_init<4>(fn.st); fn.lut = lut; fn.tq = tq; fn.tmin = q0 + 32 * qs; fn.tmax = q0 + 32 * qs + 31; fn.lane = lane;
    LAS unsigned char* const qlds = lds + 67584 + tid * 16;
#pragma unroll
    for (int d0 = 0; d0 < 4; ++d0) *(LAS bf16x8*)(qlds + d0 * 8192) = qf[d0];
    kv_loop<16, 16, false, 1, true>(fn, qf, qlds, 8 * map, PROJ + C_AK + 128 * h, PROJ + C_AV + 128 * h, nullptr, PITCH, 0, 2 * (qb + 1), lds, lds + 32768, lds, tid, lane);
    const float lt = fn.st.l + __shfl_xor(fn.st.l, 32), inv = 1.0f / lt;
    LAS float* ex = (LAS float*)(lds + qs * 16384);
    if (map == 1) {
#pragma unroll
        for (int dt = 0; dt < 4; ++dt)
#pragma unroll
            for (int r = 0; r < 16; ++r) ex[(32 * dt + crow(r, hi)) * 32 + r32] = fn.st.o[dt][r] * inv;
    }
    __syncthreads();
    if (map == 0) {
        const float lam = lamw[0]; float ss = 0.f;
#pragma unroll
        for (int dt = 0; dt < 4; ++dt)
#pragma unroll
            for (int r = 0; r < 16; ++r) { const float v = fn.st.o[dt][r] * inv - lam * ex[(32 * dt + crow(r, hi)) * 32 + r32]; fn.st.o[dt][r] = v; ss += v * v; }
        ss += __shfl_xor(ss, 32);
        const float rstd = (1.0f / sqrtf(ss * (1.0f / 128.0f) + RMS_EPS)) * (1.0f - lam_init);
        const float* sub = a.in[4] + (size_t)l * 128; bf16* orow = MIX + (size_t)tq * D + 128 * h;
#pragma unroll
        for (int dt = 0; dt < 4; ++dt)
#pragma unroll
            for (int q4 = 0; q4 < 4; ++q4) { const int d = 32 * dt + 8 * q4 + 4 * hi; const f32x4 g = *(const f32x4*)(sub + d);
                u32x2 w; w.x = cvtpk(fn.st.o[dt][4 * q4] * rstd * g.x, fn.st.o[dt][4 * q4 + 1] * rstd * g.y); w.y = cvtpk(fn.st.o[dt][4 * q4 + 2] * rstd * g.z, fn.st.o[dt][4 * q4 + 3] * rstd * g.w);
                *(u32x2*)(orow + d) = w; }
    }
    __syncthreads();
}

#ifndef NSA_DUP
#define NSA_DUP 0
#endif
constexpr int IMP_P = 132;
__device__ __forceinline__ float quad_sum(float v) {
    v += __builtin_bit_cast(float, __builtin_amdgcn_mov_dpp(__builtin_bit_cast(int, v), 0xB1, 0xF, 0xF, true));
    v += __builtin_bit_cast(float, __builtin_amdgcn_mov_dpp(__builtin_bit_cast(int, v), 0x4E, 0xF, 0xF, true));
    return v; }
#define LADD(p, v) (void)__hip_atomic_fetch_add((p), (v), __ATOMIC_RELAXED, __HIP_MEMORY_SCOPE_WORKGROUP)
constexpr int NSA_QF = 32768, NSA_SELW = 65536, NSA_LUT = 66560, NSA_IMP = 69632, NSA_FIN = 69632;

struct CmpStatFn {
    float m, l; int tq, lane, ncnt;
    __device__ __forceinline__ bool need(int) const { return true; }
    __device__ __forceinline__ void tile(int t, f32x16& p0, f32x16& p1, LAS const unsigned char*, LAS const unsigned char*) {
        const int hi = lane >> 5, n0 = 64 * t;
#pragma unroll
        for (int r = 0; r < 16; ++r) { const int n = n0 + crow(r, hi);
            p0[r] = (16 * n + 31 <= tq) ? p0[r] * SCL2 : NEG; p1[r] = (16 * (n + 32) + 31 <= tq) ? p1[r] * SCL2 : NEG; }
        softmax_stats(m, l, p0, p1);
    }
};
struct CmpPvFn {
    f32x16 o[2]; float m, invl; int tq, ql, lane; LAS float* imp;
    __device__ __forceinline__ bool need(int) const { return true; }
    __device__ __forceinline__ void tile(int t, f32x16& p0, f32x16& p1, LAS const unsigned char* vt, LAS const unsigned char*) {
        const int hi = lane >> 5, n0 = 64 * t;
#pragma unroll
        for (int r = 0; r < 16; ++r) { const int n = n0 + crow(r, hi);
            p0[r] = (16 * n + 31 <= tq) ? __builtin_amdgcn_exp2f(p0[r] * SCL2 - m) * invl : 0.f;
            p1[r] = (16 * (n + 32) + 31 <= tq) ? __builtin_amdgcn_exp2f(p1[r] * SCL2 - m) * invl : 0.f; }
        LAS float* row = imp + ql * IMP_P;
        const bool lead = (lane & 3) == 0;
#pragma unroll
        for (int a = 0; a < 4; ++a) {
            const int j0 = (n0 >> 2) + 2 * a + hi, j1 = j0 + 8;
            const float h0 = quad_sum(0.5f * p0[4 * a + 3]), h1 = quad_sum(0.5f * p1[4 * a + 3]);
            const float b0 = quad_sum(p0[4 * a] + p0[4 * a + 1] + p0[4 * a + 2]) + h0, b1 = quad_sum(p1[4 * a] + p1[4 * a + 1] + p1[4 * a + 2]) + h1;
            if (lead) {
                LADD(row + j0, b0);
                if (j0 + 1 < 128) LADD(row + j0 + 1, h0);
                if (j1 < 128) LADD(row + j1, b1);
                if (j1 + 1 < 128) LADD(row + j1 + 1, h1);
            }
        }
        bf16x8 pw[4]; pack_p(pw, p0, p1);
        pv_tile<2>(o, pw, vt, lane);
    }
};
struct SelFn {
    AState<2> st; LAS const float* lut; int tq, tmin, tmax, lane, mode; unsigned sw0, sw1, sw2, sw3, uw0, uw1, uw2, uw3;
    __device__ __forceinline__ unsigned pick(int j, unsigned a, unsigned b, unsigned c, unsigned d) const { const int w = j >> 5; const unsigned x = (w == 0) ? a : (w == 1) ? b : (w == 2) ? c : d; return (x >> (j & 31)) & 1u; }
    __device__ __forceinline__ bool need(int t) const { return mode == 1 || pick(t, uw0, uw1, uw2, uw3) != 0u; }
    __device__ __forceinline__ void tile(int t, f32x16& p0, f32x16& p1, LAS const unsigned char* vt, LAS const unsigned char*) {
        const int hi = lane >> 5, k0 = 64 * t;
        const bool bit = (mode == 1) || pick(t, sw0, sw1, sw2, sw3) != 0u;
        const bool far = k0 + 63 + 127 <= tmin;
        const bool wcut = (mode == 1) && (tmax - k0 >= 512);
        const float mref = st.m;
        if (far && !wcut) {
            const float b = lut[127] - mref;
#pragma unroll
            for (int r = 0; r < 16; ++r) { p0[r] = bit ? p0[r] * SCL2 + b : NEG; p1[r] = bit ? p1[r] * SCL2 + b : NEG; }
        } else {
#pragma unroll
            for (int r = 0; r < 16; ++r) { const int rel0 = tq - (k0 + crow(r, hi));
                const float b0 = lut[min(max(rel0, 0), 127)] - mref;
                const bool ok0 = bit && rel0 >= 0 && (mode == 0 || rel0 < 512);
                p0[r] = ok0 ? p0[r] * SCL2 + b0 : NEG; }
            __builtin_amdgcn_sched_barrier(0);
#pragma unroll
            for (int r = 0; r < 16; ++r) { const int rel1 = tq - (k0 + 32 + crow(r, hi));
                const float b1 = lut[min(max(rel1, 0), 127)] - mref;
                const bool ok1 = bit && rel1 >= 0 && (mode == 0 || rel1 < 512);
                p1[r] = ok1 ? p1[r] * SCL2 + b1 : NEG; }
            __builtin_amdgcn_sched_barrier(0);
        }
        softmax_pv<2>(st, p0, p1, vt, lane);
    }
};

__device__ __forceinline__ void nsa_unit(int g, int qb, const Args& a, const bf16* PROJ, const float* AUX, const bf16* KC, const bf16* VC, bf16* MIX, LAS unsigned char* lds, int tid, int wid, int lane) {
    const int r32 = lane & 31, hi = lane >> 5, q0 = 64 * qb, cur = qb, ql = 8 * wid + (r32 >> 2), hp = r32 & 3, tq = q0 + ql, head = 4 * g + hp;
    LAS float* imp = (LAS float*)(lds + NSA_IMP); LAS unsigned* selw = (LAS unsigned*)(lds + NSA_SELW); LAS float* lut = (LAS float*)(lds + NSA_LUT);
#pragma unroll
    for (int i = 0; i < 17; ++i) { const int e_ = tid + 512 * i; if (e_ < 64 * IMP_P) imp[e_] = 0.f; }
    if (tid < 256) selw[tid] = 0u;
    lut[tid] = a.in[12][t5_bucket(tid & 127) * 20 + 4 + 4 * g + (tid >> 7)] * LOG2E;
    bf16x8 qf[4];
#pragma unroll
    for (int d0 = 0; d0 < 4; ++d0) qf[d0] = *(const bf16x8*)(PROJ + (size_t)tq * PITCH + C_CQ + 64 * head + 16 * d0 + 8 * hi);
    LAS unsigned char* const qlds = lds + NSA_QF + tid * 16;
#pragma unroll
    for (int d0 = 0; d0 < 4; ++d0) *(LAS bf16x8*)(qlds + d0 * 8192) = qf[d0];
    const float* ga = AUX + (size_t)tq * 64 + 8 + head;
    const float gc = 1.0f / (1.0f + __expf(-ga[0])), gs = 1.0f / (1.0f + __expf(-ga[16])), gwn = 1.0f / (1.0f + __expf(-ga[32]));
    LAS float* finl = (LAS float*)(lds + NSA_FIN) + tid;
    f32x16 oc0, oc1;
    {
        int ncnt = (q0 + 32) / 16 + 1; ncnt = ncnt > 511 ? 511 : ncnt; const int ntc = (ncnt + 63) >> 6;
        const bf16* kc = KC + (size_t)g * 512 * 64; const bf16* vc = VC + (size_t)g * 512 * 64;
        CmpStatFn f1; f1.m = NEG; f1.l = 0.f; f1.tq = tq; f1.lane = lane; f1.ncnt = ncnt;
        kv_loop<8, 8, false, 1, true>(f1, qf, qlds, 0, kc, vc, nullptr, 64, 0, ntc, lds, lds + 16384, lds, tid, lane);
        if (NSA_DUP & 1) { f1.m = NEG; f1.l = 0.f; kv_loop<8, 8, false, 1, true>(f1, qf, qlds, 0, kc, vc, nullptr, 64, 0, ntc, lds, lds + 16384, lds, tid, lane); }
        const float lt = f1.l + __shfl_xor(f1.l, 32);
        CmpPvFn f2; f2.o[0] = (f32x16){}; f2.o[1] = (f32x16){}; f2.m = f1.m; f2.invl = (tq >= 31) ? 1.0f / lt : 0.f; f2.tq = tq; f2.ql = ql; f2.lane = lane; f2.imp = imp;
        if (NSA_DUP & 16) { kv_loop<8, 8, false, 1, true>(f2, qf, qlds, 0, kc, vc, nullptr, 64, 0, ntc, lds, lds + 16384, lds, tid, lane); f2.o[0] = (f32x16){}; f2.o[1] = (f32x16){};
#pragma unroll
            for (int i = 0; i < 17; ++i) { const int e_ = tid + 512 * i; if (e_ < 64 * IMP_P) imp[e_] = 0.f; }
            __syncthreads(); }
        kv_loop<8, 8, false, 1, true>(f2, qf, qlds, 0, kc, vc, nullptr, 64, 0, ntc, lds, lds + 16384, lds, tid, lane);
        oc0 = f2.o[0]; oc1 = f2.o[1];
    }
    for (int rep_ = 0; rep_ < ((NSA_DUP & 2) ? 2 : 1); ++rep_)
    if (cur < 16) { if (tid < 64) selw[tid * 4] = (2u << cur) - 1u; }
    else {
        const int qq = tid >> 3, sub = tid & 7;
        float val[16];
#pragma unroll
        for (int i = 0; i < 16; ++i) { const int j = 16 * sub + i; val[i] = (j >= 1 && j <= cur - 2) ? imp[qq * IMP_P + j] : -1.0f; }
        unsigned bits = 0u;
        for (int round = 0; round < 13; ++round) {
            float bv = val[0]; int bi = 0;
#pragma unroll
            for (int i = 1; i < 16; ++i) if (val[i] > bv) { bv = val[i]; bi = i; }
            int gj = 16 * sub + bi;
            { const float ov = __builtin_bit_cast(float, __builtin_amdgcn_mov_dpp(__builtin_bit_cast(int, bv), 0xB1, 0xF, 0xF, true)); const int oj = __builtin_amdgcn_mov_dpp(gj, 0xB1, 0xF, 0xF, true); if (ov > bv || (ov == bv && oj < gj)) { bv = ov; gj = oj; } }
            { const float ov = __builtin_bit_cast(float, __builtin_amdgcn_mov_dpp(__builtin_bit_cast(int, bv), 0x4E, 0xF, 0xF, true)); const int oj = __builtin_amdgcn_mov_dpp(gj, 0x4E, 0xF, 0xF, true); if (ov > bv || (ov == bv && oj < gj)) { bv = ov; gj = oj; } }
            { const float ov = __shfl_xor(bv, 4); const int oj = __shfl_xor(gj, 4); if (ov > bv || (ov == bv && oj < gj)) { bv = ov; gj = oj; } }
            const bool mine = (gj >> 4) == sub;
#pragma unroll
            for (int i = 0; i < 16; ++i) if (mine && (gj & 15) == i) { val[i] = -2.0f; bits |= 1u << i; }
        }
        if (sub == 0) bits |= 1u;
        if (((cur - 1) >> 4) == sub) bits |= 1u << ((cur - 1) & 15);
        if ((cur >> 4) == sub) bits |= 1u << (cur & 15);
        (void)__hip_atomic_fetch_or(selw + qq * 4 + (sub >> 1), bits << (16 * (sub & 1)), __ATOMIC_RELAXED, __HIP_MEMORY_SCOPE_WORKGROUP);
    }
    __syncthreads();
#pragma unroll
    for (int r = 0; r < 16; ++r) { finl[512 * r] = gc * oc0[r]; finl[512 * (16 + r)] = gc * oc1[r]; }
    SelFn fs; fs.lut = lut + hp * 128; fs.tq = tq; fs.tmin = q0 + 8 * wid; fs.tmax = q0 + 8 * wid + 7; fs.lane = lane;
    fs.sw0 = selw[ql * 4 + 0]; fs.sw1 = selw[ql * 4 + 1]; fs.sw2 = selw[ql * 4 + 2]; fs.sw3 = selw[ql * 4 + 3];
    { unsigned u0 = 0u, u1 = 0u, u2 = 0u, u3 = 0u;
#pragma unroll
      for (int i = 0; i < 8; ++i) { u0 |= selw[(8 * wid + i) * 4 + 0]; u1 |= selw[(8 * wid + i) * 4 + 1]; u2 |= selw[(8 * wid + i) * 4 + 2]; u3 |= selw[(8 * wid + i) * 4 + 3]; }
      fs.uw0 = __builtin_amdgcn_readfirstlane(u0); fs.uw1 = __builtin_amdgcn_readfirstlane(u1); fs.uw2 = __builtin_amdgcn_readfirstlane(u2); fs.uw3 = __builtin_amdgcn_readfirstlane(u3); }
    fs.mode = 0; astate_init<2>(fs.st);
    kv_loop<8, 8, false, 1, true>(fs, qf, qlds, 0, PROJ + C_KS + 64 * g, PROJ + C_VS + 64 * g, nullptr, PITCH, 0, cur + 1, lds, lds + 16384, lds, tid, lane);
    if (NSA_DUP & 4) { astate_init<2>(fs.st); kv_loop<8, 8, false, 1, true>(fs, qf, qlds, 0, PROJ + C_KS + 64 * g, PROJ + C_VS + 64 * g, nullptr, PITCH, 0, cur + 1, lds, lds + 16384, lds, tid, lane); }
    { const float lt = fs.st.l + __shfl_xor(fs.st.l, 32), sc = gs / lt;
#pragma unroll
      for (int r = 0; r < 16; ++r) { finl[512 * r] += sc * fs.st.o[0][r]; finl[512 * (16 + r)] += sc * fs.st.o[1][r]; } }
    fs.mode = 1; astate_init<2>(fs.st);
    kv_loop<8, 8, false, 1, true>(fs, qf, qlds, 0, PROJ + C_KW + 64 * g, PROJ + C_VW + 64 * g, nullptr, PITCH, cur >= 8 ? cur - 8 : 0, cur + 1, lds, lds + 16384, lds, tid, lane);
    if (NSA_DUP & 8) { astate_init<2>(fs.st); kv_loop<8, 8, false, 1, true>(fs, qf, qlds, 0, PROJ + C_KW + 64 * g, PROJ + C_VW + 64 * g, nullptr, PITCH, cur >= 8 ? cur - 8 : 0, cur + 1, lds, lds + 16384, lds, tid, lane); }
    { const float lt = fs.st.l + __shfl_xor(fs.st.l, 32), sc = gwn / lt;
#pragma unroll
      for (int r = 0; r < 16; ++r) { fs.st.o[0][r] = finl[512 * r] + sc * fs.st.o[0][r]; fs.st.o[1][r] = finl[512 * (16 + r)] + sc * fs.st.o[1][r]; } }
    bf16* orow = MIX + (size_t)tq * D + 1024 + 64 * head;
#pragma unroll
    for (int dt = 0; dt < 2; ++dt)
#pragma unroll
        for (int q4 = 0; q4 < 4; ++q4) { u32x2 w; w.x = cvtpk(fs.st.o[dt][4 * q4], fs.st.o[dt][4 * q4 + 1]); w.y = cvtpk(fs.st.o[dt][4 * q4 + 2], fs.st.o[dt][4 * q4 + 3]); *(u32x2*)(orow + 32 * dt + 8 * q4 + 4 * hi) = w; }
}

__device__ __forceinline__ int dequeue(unsigned* head, volatile LAS unsigned* slot, int tid) {
    if (tid == 0) *slot = __hip_atomic_fetch_add(head, 1u, __ATOMIC_RELAXED, __HIP_MEMORY_SCOPE_AGENT);
    __syncthreads();
    const int v = __builtin_amdgcn_readfirstlane((int)*slot);
    __syncthreads();
    return v;
}

constexpr int N2_HP = 4112, N2_PART = 66 * 1024, N2_LOG = 108 * 1024;
__device__ __forceinline__ void n2_unit(int u, int l, const Args& a, const bf16* X, bf16* XN, const bf16* RWT, unsigned* cnt, int* LIST, float* TW, LAS unsigned char* lds, int tid, int wid, int lane) {
    const float* gain = a.in[14] + (size_t)l * D;
#pragma unroll
    for (int rr = 0; rr < 2; ++rr) {
        const int lr = 2 * wid + rr, row = 16 * u + lr;
        const u32x2* xr = (const u32x2*)(X + (size_t)row * D) + lane;
        f32x4 v[8]; float ss = 0.f;
#pragma unroll
        for (int j = 0; j < 8; ++j) { const u32x2 r = xr[64 * j]; v[j] = (f32x4){bflo(r.x), bfhi(r.x), bflo(r.y), bfhi(r.y)}; ss += (v[j].x * v[j].x + v[j].y * v[j].y) + (v[j].z * v[j].z + v[j].w * v[j].w); }
        ss = wave_sum(ss);
        const float rstd = 1.0f / sqrtf(ss * (1.0f / D) + RMS_EPS);
        const f32x4* gr = (const f32x4*)gain + lane; u32x2* o8 = (u32x2*)(XN + (size_t)row * D) + lane;
#pragma unroll
        for (int j = 0; j < 8; ++j) { const f32x4 g = gr[64 * j]; u32x2 w; w.x = cvtpk(v[j].x * rstd * g.x, v[j].y * rstd * g.y); w.y = cvtpk(v[j].z * rstd * g.z, v[j].w * rstd * g.w);
            o8[64 * j] = w; *(LAS u32x2*)(lds + lr * N2_HP + (4 * lane + 256 * j) * 2) = w; }
    }
    __syncthreads();
    {
        const int fr = lane & 15, fq = lane >> 4;
        f32x4 acc[5];
#pragma unroll
        for (int nt = 0; nt < 5; ++nt) acc[nt] = (f32x4){0.f, 0.f, 0.f, 0.f};
        const bf16* rw = RWT + (size_t)l * 96 * D + (size_t)fr * D + 256 * wid + 8 * fq;
#pragma unroll
        for (int s = 0; s < 8; ++s) {
            const bf16x8 av = *(const LAS bf16x8*)(lds + fr * N2_HP + (256 * wid + 32 * s + 8 * fq) * 2);
#pragma unroll
            for (int nt = 0; nt < 5; ++nt) { const bf16x8 bv = *(const bf16x8*)(rw + (size_t)(16 * nt) * D + 32 * s); acc[nt] = MFMA16(av, bv, acc[nt]); }
        }
        LAS float* part = (LAS float*)(lds + N2_PART) + wid * 16 * 80;
#pragma unroll
        for (int nt = 0; nt < 5; ++nt)
#pragma unroll
            for (int i = 0; i < 4; ++i) part[(4 * fq + i) * 80 + 16 * nt + fr] = acc[nt][i];
    }
    __syncthreads();
    {
        LAS const float* part = (LAS const float*)(lds + N2_PART); LAS float* logit = (LAS float*)(lds + N2_LOG);
        for (int e = tid; e < 16 * 80; e += NTHR) { float s = 0.f;
#pragma unroll
            for (int w = 0; w < 8; ++w) s += part[w * 16 * 80 + e];
            logit[e] = s; }
    }
    __syncthreads();
    if (tid < 16) {
        LAS const float* lg = (LAS const float*)(lds + N2_LOG) + tid * 80;
        const float* bg = a.in[16] + l * 8; const float* be = a.in[18] + l * 64;
        float z[8]; float zm = -3.0e38f; int gi = 0;
#pragma unroll
        for (int i = 0; i < 8; ++i) { z[i] = lg[i] + bg[i]; if (z[i] > zm) { zm = z[i]; gi = i; } }
        float den = 0.f;
#pragma unroll
        for (int i = 0; i < 8; ++i) den += expf(z[i] - zm);
        const float gp = 1.0f / den;
        float e1 = -3.0e38f, e2 = -3.0e38f; int i1 = 0, i2 = 0;
#pragma unroll
        for (int i = 0; i < 8; ++i) { const float v = lg[8 + 8 * gi + i] + be[8 * gi + i];
            if (v > e1) { e2 = e1; i2 = i1; e1 = v; i1 = i; } else if (v > e2) { e2 = v; i2 = i; } }
        const float t2 = expf(e2 - e1), w1 = gp / (1.0f + t2), w2 = gp * t2 / (1.0f + t2);
        const int tok = 16 * u + tid, ea = 8 * gi + i1, eb = 8 * gi + i2;
        const unsigned pa = __hip_atomic_fetch_add(cnt + ea * 16, 1u, __ATOMIC_RELAXED, __HIP_MEMORY_SCOPE_AGENT);
        const unsigned pb = __hip_atomic_fetch_add(cnt + eb * 16, 1u, __ATOMIC_RELAXED, __HIP_MEMORY_SCOPE_AGENT);
        LIST[(size_t)ea * 16384 + pa] = 2 * tok; LIST[(size_t)eb * 16384 + pb] = 2 * tok + 1;
        TW[2 * tok] = w1; TW[2 * tok + 1] = w2;
    }
    __syncthreads();
}

constexpr int N2P_HALF = 16 * N2_HP, N2P_LOG = 2 * N2P_HALF;
__device__ __forceinline__ void n2_pair(int p, int l, const Args& a, const bf16* X, bf16* XN, const bf16* RWT, unsigned* cnt, int* LIST, float* TW, LAS unsigned char* lds, int tid, int wid, int lane) {
    const int half = wid >> 2, wl = wid & 3, u = 2 * p + half, th = tid & 255;
    LAS unsigned char* const hT = lds + half * N2P_HALF;
    const float* gain = a.in[14] + (size_t)l * D;
    {
        u32x2 raw[4][8];
#pragma unroll
        for (int rr = 0; rr < 4; ++rr) { const u32x2* xr = (const u32x2*)(X + (size_t)(16 * u + 4 * wl + rr) * D) + lane;
#pragma unroll
            for (int j = 0; j < 8; ++j) raw[rr][j] = xr[64 * j]; }
        f32x4 g[8]; { const f32x4* gr = (const f32x4*)gain + lane;
#pragma unroll
            for (int j = 0; j < 8; ++j) g[j] = gr[64 * j]; }
#pragma unroll
        for (int rr = 0; rr < 4; ++rr) {
            const int lr = 4 * wl + rr, row = 16 * u + lr;
            f32x4 v[8]; float ss = 0.f;
#pragma unroll
            for (int j = 0; j < 8; ++j) { const u32x2 r = raw[rr][j]; v[j] = (f32x4){bflo(r.x), bfhi(r.x), bflo(r.y), bfhi(r.y)}; ss += (v[j].x * v[j].x + v[j].y * v[j].y) + (v[j].z * v[j].z + v[j].w * v[j].w); }
            ss = wave_sum(ss);
            const float rstd = 1.0f / sqrtf(ss * (1.0f / D) + RMS_EPS);
            u32x2* o8 = (u32x2*)(XN + (size_t)row * D) + lane;
#pragma unroll
            for (int j = 0; j < 8; ++j) { u32x2 w; w.x = cvtpk(v[j].x * rstd * g[j].x, v[j].y * rstd * g[j].y); w.y = cvtpk(v[j].z * rstd * g[j].z, v[j].w * rstd * g[j].w);
                o8[64 * j] = w; *(LAS u32x2*)(hT + lr * N2_HP + (4 * lane + 256 * j) * 2) = w; }
        }
    }
    __syncthreads();
    const int fr = lane & 15, fq = lane >> 4;
    f32x4 acc[2][5];
#pragma unroll
    for (int hh = 0; hh < 2; ++hh)
#pragma unroll
        for (int nt = 0; nt < 5; ++nt) acc[hh][nt] = (f32x4){0.f, 0.f, 0.f, 0.f};
    {
        const bf16* rw = RWT + (size_t)l * 96 * D + (size_t)fr * D + 256 * wid + 8 * fq;
#pragma unroll 4
        for (int s = 0; s < 8; ++s) {
            const bf16x8 av0 = *(const LAS bf16x8*)(lds + fr * N2_HP + (256 * wid + 32 * s + 8 * fq) * 2);
            const bf16x8 av1 = *(const LAS bf16x8*)(lds + N2P_HALF + fr * N2_HP + (256 * wid + 32 * s + 8 * fq) * 2);
#pragma unroll
            for (int nt = 0; nt < 5; ++nt) { const bf16x8 bv = *(const bf16x8*)(rw + (size_t)(16 * nt) * D + 32 * s); acc[0][nt] = MFMA16(av0, bv, acc[0][nt]); acc[1][nt] = MFMA16(av1, bv, acc[1][nt]); }
        }
    }
    __syncthreads();
    {
        LAS float* part = (LAS float*)lds + wid * 32 * 80;
#pragma unroll
        for (int hh = 0; hh < 2; ++hh)
#pragma unroll
            for (int nt = 0; nt < 5; ++nt)
#pragma unroll
                for (int i = 0; i < 4; ++i) part[(16 * hh + 4 * fq + i) * 80 + 16 * nt + fr] = acc[hh][nt][i];
    }
    __syncthreads();
    {
        LAS const float* part = (LAS const float*)lds; LAS float* logit = (LAS float*)(lds + N2P_LOG);
        for (int e = tid; e < 32 * 80; e += NTHR) { float sres = 0.f;
#pragma unroll
            for (int w = 0; w < 8; ++w) sres += part[w * 32 * 80 + e];
            logit[e] = sres; }
    }
    __syncthreads();
    if (th < 16) {
        LAS const float* lg = (LAS const float*)(lds + N2P_LOG) + (16 * half + th) * 80;
        const float* bg = a.in[16] + l * 8; const float* be = a.in[18] + l * 64;
        float z[8]; float zm = -3.0e38f; int gi = 0;
#pragma unroll
        for (int i = 0; i < 8; ++i) { z[i] = lg[i] + bg[i]; if (z[i] > zm) { zm = z[i]; gi = i; } }
        float den = 0.f;
#pragma unroll
        for (int i = 0; i < 8; ++i) den += expf(z[i] - zm);
        const float gp = 1.0f / den;
        float e1 = -3.0e38f, e2 = -3.0e38f; int i1 = 0, i2 = 0;
#pragma unroll
        for (int i = 0; i < 8; ++i) { const float v = lg[8 + 8 * gi + i] + be[8 * gi + i];
            if (v > e1) { e2 = e1; i2 = i1; e1 = v; i1 = i; } else if (v > e2) { e2 = v; i2 = i; } }
        const float t2 = expf(e2 - e1), w1 = gp / (1.0f + t2), w2 = gp * t2 / (1.0f + t2);
        const int tok = 16 * u + th, ea = 8 * gi + i1, eb = 8 * gi + i2;
        const unsigned pa = __hip_atomic_fetch_add(cnt + ea * 16, 1u, __ATOMIC_RELAXED, __HIP_MEMORY_SCOPE_AGENT);
        const unsigned pb = __hip_atomic_fetch_add(cnt + eb * 16, 1u, __ATOMIC_RELAXED, __HIP_MEMORY_SCOPE_AGENT);
        LIST[(size_t)ea * 16384 + pa] = 2 * tok; LIST[(size_t)eb * 16384 + pb] = 2 * tok + 1;
        TW[2 * tok] = w1; TW[2 * tok + 1] = w2;
    }
    __syncthreads();
}

constexpr int MO_B = 65536, MO_BBUF = 16384, MO_A = 98304, MO_APITCH = 2176, MO_ABUF = 4 * MO_APITCH, MO_ROW = MO_A + 2 * MO_ABUF, MO_PRE = MO_ROW + 512;
constexpr int MO_STG = 117760;
static_assert(MO_PRE + 272 <= MO_STG && MO_STG + 8 * 4096 <= MISC_OFF, "MoE LDS map");
__device__ __forceinline__ int mo_aoff(int row, int c) { return c * MO_APITCH + ((row + 2 * c) << 4); }
__device__ __forceinline__ int mo_hoff(int row, int c) { return c * 2048 + (row << 4); }

struct MoBStage { f32x4 v[4]; };
__device__ __forceinline__ void mo_gl16(f32x4& d, const float* p) { asm volatile("global_load_dwordx4 %0, %1, off" : "=v"(d) : "v"(p) : "memory"); }
__device__ __forceinline__ void mo_gl16u(u32x4& d, const bf16* p) { asm volatile("global_load_dwordx4 %0, %1, off" : "=v"(d) : "v"(p) : "memory"); }
__device__ __forceinline__ void mo_bload(MoBStage& sg, const float* src0, const float* src1, size_t ld, int k0, int tid) {
    const int n4 = tid & 63, kg = tid >> 6;
    const float* p = (n4 < 32 ? src0 + 4 * n4 : src1 + 4 * (n4 - 32)) + (size_t)(k0 + 4 * kg) * ld;
    mo_gl16(sg.v[0], p); mo_gl16(sg.v[1], p + ld); mo_gl16(sg.v[2], p + 2 * ld); mo_gl16(sg.v[3], p + 3 * ld);
}
#define MO_WAIT5(N, SB, SA) asm volatile("s_waitcnt vmcnt(" #N ")" : "+v"(SB.v[0]), "+v"(SB.v[1]), "+v"(SB.v[2]), "+v"(SB.v[3]), "+v"(SA) :: "memory")
#define MO_WAIT4(N, SB) asm volatile("s_waitcnt vmcnt(" #N ")" : "+v"(SB.v[0]), "+v"(SB.v[1]), "+v"(SB.v[2]), "+v"(SB.v[3]) :: "memory")
__device__ __forceinline__ void mo_bwrite(const MoBStage& sg, LAS unsigned char* bb, int tid) {
    const int n4 = tid & 63, kg = tid >> 6;
#pragma unroll
    for (int i = 0; i < 4; ++i) { u32x2 w; w.x = cvtpk(sg.v[0][i], sg.v[1][i]); w.y = cvtpk(sg.v[2][i], sg.v[3][i]);
        *(LAS u32x2*)(bb + (kg >> 1) * 4096 + (32 * (n4 >> 3) + 8 * i + (n4 & 7)) * 16 + 8 * (kg & 1)) = w; }
}
#define MO_READ(AP, ASTEP, BP, B1OFF) bf16x8 fb0_[2], fb1_[2], fa_[2][2]; \
    _Pragma("unroll") for (int s_ = 0; s_ < 2; ++s_) { fb0_[s_] = *(const LAS bf16x8*)((BP) + s_ * 8192); fb1_[s_] = *(const LAS bf16x8*)((BP) + s_ * 8192 + (B1OFF)); \
        _Pragma("unroll") for (int mt = 0; mt < 2; ++mt) fa_[s_][mt] = *(const LAS bf16x8*)((AP) + s_ * (ASTEP) + mt * 512); } \
    __builtin_amdgcn_sched_barrier(0)
#define MO_MMA(ACC0, ACC1) do { __builtin_amdgcn_sched_barrier(0); _Pragma("unroll") for (int s_ = 0; s_ < 2; ++s_) _Pragma("unroll") for (int mt = 0; mt < 2; ++mt) { \
        ACC0[mt] = MFMA32(fa_[s_][mt], fb0_[s_], ACC0[mt]); ACC1[mt] = MFMA32(fa_[s_][mt], fb1_[s_], ACC1[mt]); } __builtin_amdgcn_sched_barrier(0); } while (0)

__device__ __forceinline__ void moe_unit(int e, int c0, int nrows, const bf16* XN, const int* LIST, const float* Wg, const float* Wu, const float* Wd, bf16* YB, LAS unsigned char* lds, int tid, int wid, int lane) {
    const int r32 = lane & 31, hi = lane >> 5, wn = wid & 3, wm = wid >> 2;
    LAS int* rowid = (LAS int*)(lds + MO_ROW);
    if (tid < 128) rowid[tid] = (tid < nrows) ? LIST[(size_t)e * 16384 + c0 + tid] : -1;
    __syncthreads();
    const float* wg = Wg + (size_t)e * D * 256; const float* wu = Wu + (size_t)e * D * 256; const float* wd = Wd + (size_t)e * 256 * D;
    f32x16 acc0[2], acc1[2];
#define MO_ZERO() do { acc0[0] = (f32x16){}; acc0[1] = (f32x16){}; acc1[0] = (f32x16){}; acc1[1] = (f32x16){}; } while (0)
    MO_ZERO();
    MoBStage s0, s1, s2, s3; u32x4 a0, a1, a2, a3;
    {
        const int arow = tid >> 2, ac = tid & 3; const int rid = rowid[arow]; const bf16* asrc = XN + (size_t)((rid < 0 ? 0 : rid) >> 1) * D + 8 * ac;
        LAS unsigned char* const awr = lds + MO_A + mo_aoff(arow, ac);
        LAS const unsigned char* const ard = lds + MO_A + mo_aoff(64 * wm + r32, hi);
        LAS const unsigned char* const brd = lds + MO_B + hi * 4096 + (32 * wn + r32) * 16;
#define G1_LOAD(SB, SA, t) do { const int t_ = (t); mo_gl16u(SA, asrc + 32 * (t_ & 63)); mo_bload(SB, wg + 128 * (t_ >> 6), wu + 128 * (t_ >> 6), 256, 32 * (t_ & 63), tid); } while (0)
#define G1_WRITE(SB, SA, b) do { *(LAS u32x4*)(awr + (b) * MO_ABUF) = SA; mo_bwrite(SB, lds + MO_B + (b) * MO_BBUF, tid); } while (0)
#define G1_STEP(t, b, SBL, SAL, SBW, SAW) do { const int tt_ = (t); \
            MO_READ(ard + (b) * MO_ABUF, 2 * MO_APITCH + 64, brd + (b) * MO_BBUF, 2048);     \
            G1_LOAD(SBL, SAL, (tt_ + 4 < 128 ? tt_ + 4 : 127));     \
            __builtin_amdgcn_sched_barrier(0); \
            MO_WAIT5(15, SBW, SAW); \
            if (tt_ + 1 < 128) G1_WRITE(SBW, SAW, (b) ^ 1); \
            MO_MMA(acc0, acc1); \
            if ((tt_ & 63) == 63) {     \
                const int col_ = 128 * (tt_ >> 6) + 32 * wn + 4 * (r32 & 7) + (r32 >> 3), cch_ = col_ >> 3; \
                _Pragma("unroll") for (int mt = 0; mt < 2; ++mt) _Pragma("unroll") for (int r = 0; r < 16; ++r) { const float gt = acc0[mt][r], up = acc1[mt][r]; const float hv = gt / (1.0f + __expf(-gt)) * up; \
                    *(LAS unsigned short*)(lds + mo_hoff(64 * wm + 32 * mt + crow(r, hi), cch_) + (col_ & 7) * 2) = f2bf16(hv); } \
                MO_ZERO(); } \
            __syncthreads(); } while (0)
        G1_LOAD(s0, a0, 0); G1_LOAD(s1, a1, 1); G1_LOAD(s2, a2, 2); G1_LOAD(s3, a3, 3);
        MO_WAIT5(15, s0, a0);
        G1_WRITE(s0, a0, 0);
        __syncthreads();
        for (int t = 0; t < 128; t += 4) {
            G1_STEP(t, 0, s0, a0, s1, a1);
            G1_STEP(t + 1, 1, s1, a1, s2, a2);
            G1_STEP(t + 2, 0, s2, a2, s3, a3);
            G1_STEP(t + 3, 1, s3, a3, s0, a0);
        }
        asm volatile("s_waitcnt vmcnt(0)" : "+v"(s0.v[0]), "+v"(s0.v[1]), "+v"(s0.v[2]), "+v"(s0.v[3]), "+v"(s1.v[0]), "+v"(s1.v[1]), "+v"(s1.v[2]), "+v"(s1.v[3]), "+v"(s2.v[0]), "+v"(s2.v[1]), "+v"(s2.v[2]), "+v"(s2.v[3]),
                     "+v"(s3.v[0]), "+v"(s3.v[1]), "+v"(s3.v[2]), "+v"(s3.v[3]), "+v"(a0), "+v"(a1), "+v"(a2), "+v"(a3) :: "memory");
#undef G1_LOAD
#undef G1_WRITE
#undef G1_STEP
    }
    {
        LAS const unsigned char* const hrd = lds + mo_hoff(64 * wm + r32, hi);
        LAS const unsigned char* const brd = lds + MO_B + hi * 4096 + (64 * wn + r32) * 16;
#define G2_LOAD(SB, t) do { const int t_ = (t); mo_bload(SB, wd + 256 * (t_ >> 3), wd + 256 * (t_ >> 3) + 128, D, 32 * (t_ & 7), tid); } while (0)
#define G2_STEP(t, b, SBL, SBW) do { const int tt_ = (t); \
            MO_READ(hrd + (tt_ & 7) * 8192, 4096, brd + (b) * MO_BBUF, 512); \
            G2_LOAD(SBL, (tt_ + 4 < 64 ? tt_ + 4 : 63)); \
            __builtin_amdgcn_sched_barrier(0); \
            MO_WAIT4(12, SBW); \
            if (tt_ + 1 < 64) mo_bwrite(SBW, lds + MO_B + ((b) ^ 1) * MO_BBUF, tid); \
            MO_MMA(acc0, acc1); \
            if ((tt_ & 7) == 7) {     \
                LAS unsigned char* const stg_ = lds + MO_STG + wid * 4096; const int cidx_ = 4 * (r32 & 7) + (r32 >> 3); \
                _Pragma("unroll") for (int mt = 0; mt < 2; ++mt) { \
                    _Pragma("unroll") for (int r = 0; r < 16; ++r) { const int row_ = crow(r, hi); \
                        *(LAS unsigned short*)(stg_ + row_ * 128 + cidx_ * 2) = f2bf16(acc0[mt][r]); *(LAS unsigned short*)(stg_ + row_ * 128 + (cidx_ + 32) * 2) = f2bf16(acc1[mt][r]); } \
                    _Pragma("unroll") for (int k = 0; k < 4; ++k) { const int idx_ = lane + 64 * k, row_ = idx_ >> 3, ch_ = idx_ & 7; \
                        const u32x4 v_ = *(const LAS u32x4*)(stg_ + row_ * 128 + ch_ * 16); const int rr = rowid[64 * wm + 32 * mt + row_]; \
                        if (rr >= 0) *(u32x4*)(YB + (size_t)rr * D + 256 * (tt_ >> 3) + 64 * wn + 8 * ch_) = v_; } } \
                MO_ZERO(); } \
            __syncthreads(); } while (0)
        G2_LOAD(s0, 0); G2_LOAD(s1, 1); G2_LOAD(s2, 2); G2_LOAD(s3, 3);
        MO_WAIT4(12, s0);
        mo_bwrite(s0, lds + MO_B, tid);
        __syncthreads();
        for (int t = 0; t < 64; t += 4) {
            G2_STEP(t, 0, s0, s1);
            G2_STEP(t + 1, 1, s1, s2);
            G2_STEP(t + 2, 0, s2, s3);
            G2_STEP(t + 3, 1, s3, s0);
        }
        asm volatile("s_waitcnt vmcnt(0)" : "+v"(s0.v[0]), "+v"(s0.v[1]), "+v"(s0.v[2]), "+v"(s0.v[3]), "+v"(s1.v[0]), "+v"(s1.v[1]), "+v"(s1.v[2]), "+v"(s1.v[3]), "+v"(s2.v[0]), "+v"(s2.v[1]), "+v"(s2.v[2]), "+v"(s2.v[3]),
                     "+v"(s3.v[0]), "+v"(s3.v[1]), "+v"(s3.v[2]), "+v"(s3.v[3]) :: "memory");
#undef G2_LOAD
#undef G2_STEP
    }
#undef MO_ZERO
}

constexpr int N_PHASES = 1 + 7 * DEPTH;
#ifndef PH_MASK
#define PH_MASK 0xFFFF
#endif
#define PHON(k) (((PH_MASK) >> (k)) & 1)
#ifndef DUP_MASK
#define DUP_MASK 0
#endif
#define DUPON(k) ((((DUP_MASK) >> (k)) & 1) && (l == 0 || (((0x3FE) >> (k)) & 1)))
#ifndef MK_ONE_LAUNCH
#define MK_ONE_LAUNCH 1
#endif

__global__ void __launch_bounds__(NTHR, 2) fwd_kernel(Args args) {
    extern __shared__ __attribute__((aligned(16))) unsigned char lds_raw[];
    LAS unsigned char* lds = (LAS unsigned char*)lds_raw;
    volatile LAS unsigned* MISC = (volatile LAS unsigned*)(lds + MISC_OFF);
    const int wid = __builtin_amdgcn_readfirstlane(threadIdx.x >> 6);
    const int G = gridDim.x, bid = blockIdx.x;
    unsigned char* ws = args.ws;
    unsigned* const ctl0 = (unsigned*)(ws + WS_CTL);
    if (threadIdx.x < 64) MISC[threadIdx.x] = 0u;
    __syncthreads();
    const int lo = args.ph_lo, hi_ph = args.ph_hi;
    XcdBarrier bar; bar.bar = ctl0 + CW_BAR; bar.x = 0; bar.st = MISC + 8; bar.w0 = 0;
    if (hi_ph - lo > 1) bar = xcd_barrier_post(ctl0 + CW_BAR, MISC + 8);
#define IN(k) (lo <= (k) && (k) < hi_ph)
#define FRESH() int wid_ = wid; asm volatile("" : "+s"(wid_)); int lane_; asm volatile("v_mbcnt_lo_u32_b32 %0, -1, 0\n\tv_mbcnt_hi_u32_b32 %0, -1, %0" : "=v"(lane_)); const int tid_ = wid_ * 64 + lane_; (void)tid_
#define SEAM(k) do { if (IN(k) && IN((k) + 1)) xcd_barrier(bar); } while (0)

    const int NGW = G * NWAVES;

    if (PHON(0) && IN(0)) { FRESH(); p0_prologue(args, lds, bid, G, tid_, wid_, lane_); if ((DUP_MASK) & 1) p0_prologue(args, lds, bid, G, tid_, wid_, lane_); }
    SEAM(0);

#pragma unroll 1
    for (int lraw = 0; lraw < DEPTH; ++lraw) {
        int l = lraw; asm volatile("" : "+s"(l));
        GAS unsigned char* wsg = (GAS unsigned char*)ws; asm volatile("" : "+s"(wsg)); unsigned char* const wsl = (unsigned char*)wsg;
        unsigned* const ctl = (unsigned*)(wsl + WS_CTL);
        bf16* const WIN = (bf16*)(wsl + WS_WIN); bf16* const WOUT = (bf16*)(wsl + WS_WOUT); bf16* const W1T = (bf16*)(wsl + WS_W1T); bf16* const W2T = (bf16*)(wsl + WS_W2T); bf16* const RWT = (bf16*)(wsl + WS_RWT);
        float* const C1 = (float*)(wsl + WS_C1); bf16* const X = (bf16*)(wsl + WS_X); bf16* const XN = (bf16*)(wsl + WS_XN); bf16* const PROJ = (bf16*)(wsl + WS_PROJ); float* const AUX = (float*)(wsl + WS_AUX);
        float* const CUM = (float*)(wsl + WS_CUM); bf16* const KC = (bf16*)(wsl + WS_KC); bf16* const VC = (bf16*)(wsl + WS_VC); bf16* const MIX = (bf16*)(wsl + WS_MIX); bf16* const YB = (bf16*)(wsl + WS_YB);
        int* const LIST = (int*)(wsl + WS_LIST); float* const TW = (float*)(wsl + WS_TW);
        const int pb = 1 + 7 * l;
        if (PHON(1) && IN(pb)) {
            pg8::Gemm g{XN, WIN + (size_t)l * NP * D, S, NP, D}; pg8::StaticOrder so; so.init(S, NP, G, bid);
            pg8::EpiProj E{PROJ, AUX};
            pg8::gemm_phase<pg8::EpiProj, pg8::StaticOrder, true, true>(lds, g, so, E, wid);
            if (DUPON(1)) pg8::gemm_phase<pg8::EpiProj, pg8::StaticOrder, true, true>(lds, g, so, E, wid);
        }
        SEAM(pb);
        if (IN(pb + 2)) {
            const int x = bid & 7;
#define QHEAD(q) (ctl + CW_Q + (((l * 6 + (q)) * 8 + x) * 64))
            if (PHON(2)) { FRESH(); unsigned* const pdone = ctl + CW_PD + l * 64;
                for (;;) { const int i = dequeue(ctl + CW_PQ + l * 64, MISC + 19, tid_); if (i >= 136) break;
                    if (i < 8) cumsum_unit(i, l, AUX, args.in[5], CUM, lds, tid_); else compress_unit(i - 8, l, PROJ, W1T, W2T, C1, KC, VC, lds, wid_, lane_);
                    asm volatile("s_waitcnt vmcnt(0)" ::: "memory");
                    __syncthreads();
                    if (wid_ == 0) { __builtin_amdgcn_fence(__ATOMIC_RELEASE, "agent"); asm volatile("s_waitcnt vmcnt(0)" ::: "memory"); (void)__hip_atomic_fetch_add(pdone, 1u, __ATOMIC_RELAXED, __HIP_MEMORY_SCOPE_AGENT); }
                } }
            if (PHON(4)) { FRESH(); for (;;) { const int i = dequeue(QHEAD(1), MISC + 17, tid_); if (i >= 32) break; diff_unit(x & 3, 63 - 2 * i - (x >> 2), l, args, PROJ, MIX, lds, tid_, wid_, lane_); }
                if (DUPON(4)) for (;;) { const int i = dequeue(QHEAD(4), MISC + 17, tid_); if (i >= 32) break; diff_unit(x & 3, 63 - 2 * i - (x >> 2), l, args, PROJ, MIX, lds, tid_, wid_, lane_); } }
            if (PHON(2)) { FRESH();
                if (tid_ == 0) { unsigned* const pdone = ctl + CW_PD + l * 64; unsigned sp = 0;
                    while (__hip_atomic_load(pdone, __ATOMIC_RELAXED, __HIP_MEMORY_SCOPE_AGENT) < 136u * 64u) { __builtin_amdgcn_s_sleep(2); if (++sp > (1u << 20)) break; }
                    __builtin_amdgcn_fence(__ATOMIC_ACQUIRE, "agent"); asm volatile("s_waitcnt vmcnt(0)" ::: "memory"); }
                __syncthreads(); }
            if (PHON(3)) { FRESH(); for (;;) { const int i = dequeue(QHEAD(0), MISC + 16, tid_); if (i >= 32) break; fox_unit(x, 31 - i, PROJ, CUM, MIX, lds, tid_, wid_, lane_); }
                if (DUPON(3)) for (;;) { const int i = dequeue(QHEAD(3), MISC + 16, tid_); if (i >= 32) break; fox_unit(x, 31 - i, PROJ, CUM, MIX, lds, tid_, wid_, lane_); } }
            if (PHON(5)) { FRESH(); for (;;) { const int i = dequeue(QHEAD(2), MISC + 18, tid_); if (i >= 64) break; nsa_unit(x & 3, 127 - 2 * i - (x >> 2), args, PROJ, AUX, KC, VC, MIX, lds, tid_, wid_, lane_); }
                if (DUPON(5)) for (;;) { const int i = dequeue(QHEAD(5), MISC + 18, tid_); if (i >= 64) break; nsa_unit(x & 3, 127 - 2 * i - (x >> 2), args, PROJ, AUX, KC, VC, MIX, lds, tid_, wid_, lane_); } }
#undef QHEAD
        }
        SEAM(pb + 2);
        if (PHON(6) && IN(pb + 3)) {
            pg8::Gemm g{MIX, WOUT + (size_t)l * D * D, S, D, D}; pg8::StaticOrder so; so.init(S, D, G, bid);
            pg8::EpiRes E{l == 0 ? args.in[0] : nullptr, X, X};
            pg8::gemm_phase<pg8::EpiRes, pg8::StaticOrder, true, true>(lds, g, so, E, wid);
            if (DUPON(6)) { pg8::EpiRes E2{nullptr, X, YB}; pg8::gemm_phase<pg8::EpiRes, pg8::StaticOrder, true, true>(lds, g, so, E2, wid); }
        }
        SEAM(pb + 3);
        if (PHON(7) && IN(pb + 4)) {
            FRESH();
            for (int p = bid; p < S / 32; p += G) n2_pair(p, l, args, X, XN, RWT, ctl + CW_CNT + l * 1024, LIST, TW, lds, tid_, wid_, lane_);
            if (DUPON(7)) for (int u = bid; u < S / 16; u += G) n2_unit(u, l, args, X, XN, RWT, ctl + CW_CNT + (4 + l) * 1024, (int*)MIX, (float*)(MIX + 8 * 1024 * 1024), lds, tid_, wid_, lane_);
        }
        SEAM(pb + 4);
        if (PHON(8) && IN(pb + 5)) {
            FRESH();
            LAS int* pre = (LAS int*)(lds + MO_PRE);
            if (tid_ < 64) pre[tid_] = ((int)__hip_atomic_load(ctl + CW_CNT + l * 1024 + tid_ * 16, __ATOMIC_RELAXED, __HIP_MEMORY_SCOPE_AGENT) + 127) >> 7;
            __syncthreads();
            const int x = bid & 7, per = G >> 3;
            for (int rep = 0; rep < (DUPON(8) ? 2 : 1); ++rep)
            for (int slot = bid >> 3; ; slot += per) {
                int e = -1, c = 0, acc = 0;
                for (int k = 0; k < 8; ++k) { const int ee = x + 8 * k, n = pre[ee]; if (e < 0 && slot < acc + n) { e = ee; c = slot - acc; } acc += n; }
                if (e < 0) break;
                e = __builtin_amdgcn_readfirstlane(e); c = __builtin_amdgcn_readfirstlane(c);
                const int c0 = c * 128; const int cnt_e = (int)__hip_atomic_load(ctl + CW_CNT + l * 1024 + e * 16, __ATOMIC_RELAXED, __HIP_MEMORY_SCOPE_AGENT);
                const int nrows = (cnt_e - c0) < 128 ? (cnt_e - c0) : 128;
                moe_unit(e, c0, nrows, XN, LIST, args.in[19] + (size_t)l * 64 * D * 256, args.in[20] + (size_t)l * 64 * D * 256, args.in[21] + (size_t)l * 64 * 256 * D, YB, lds, tid_, wid_, lane_);
            }
        }
        SEAM(pb + 5);
        if (PHON(9) && IN(pb + 6)) {
            FRESH(); const int gw_ = bid * NWAVES + wid_;
            if (l + 1 < DEPTH) {
                norm_rows<1>(nullptr, X, X, XN, YB, TW, args.in[1] + (size_t)(l + 1) * D, nullptr, gw_, NGW, lane_);
                if (DUPON(9)) norm_rows<1>(nullptr, X, PROJ, MIX, YB, TW, args.in[1] + (size_t)(l + 1) * D, nullptr, gw_, NGW, lane_);
            } else norm_rows<2>(nullptr, X, nullptr, nullptr, YB, TW, args.in[22], args.out, gw_, NGW, lane_);
        }
        if (l + 1 < DEPTH) SEAM(pb + 6);
    }
#undef IN
#undef SEAM
}

extern "C" void kernel_launch(void* const* d_in, const int* in_sizes, int n_in, void* d_out, int out_size, void* d_ws, size_t ws_size, hipStream_t stream) {
    static int grid = 0;
    if (grid == 0) {
        if (n_in != 23 || ws_size < WS_END || out_size != S * D) { fprintf(stderr, "kernel_launch: unexpected problem (n_in %d, out %d, ws %zu)\n", n_in, out_size, ws_size); grid = -1; return; }
        int dev = 0, cus = 0, per_cu = 0;
        if (hipGetDevice(&dev) != hipSuccess || hipDeviceGetAttribute(&cus, hipDeviceAttributeMultiprocessorCount, dev) != hipSuccess) { grid = -1; return; }
        if (hipFuncSetAttribute((const void*)fwd_kernel, hipFuncAttributeMaxDynamicSharedMemorySize, LDS_BYTES) != hipSuccess) { fprintf(stderr, "kernel_launch: hipFuncSetAttribute failed\n"); grid = -1; return; }
        if (hipOccupancyMaxActiveBlocksPerMultiprocessor(&per_cu, (const void*)fwd_kernel, NTHR, LDS_BYTES) != hipSuccess || per_cu < 1) fprintf(stderr, "kernel_launch: occupancy query says %d blocks per CU\n", per_cu);
        (void)hipGetLastError();
        grid = cus;
        if (grid < 136) { fprintf(stderr, "kernel_launch: too few CUs (%d)\n", grid); }
    }
    if (grid < 0) return;
    if (hipMemsetAsync((char*)d_ws + WS_CTL, 0, CTL_ZERO_BYTES, stream) != hipSuccess) { fprintf(stderr, "kernel_launch: memset failed\n"); return; }
    Args a{};
    for (int i = 0; i < 23; ++i) a.in[i] = (const float*)d_in[i];
    a.out = (float*)d_out; a.ws = (unsigned char*)d_ws;
#if MK_ONE_LAUNCH
    a.ph_lo = 0; a.ph_hi = N_PHASES;
    hipLaunchKernelGGL(fwd_kernel, dim3(grid), dim3(NTHR), LDS_BYTES, stream, a);
#else
    for (int p = 0; p < N_PHASES; ++p) { a.ph_lo = p; a.ph_hi = p + 1; hipLaunchKernelGGL(fwd_kernel, dim3(grid), dim3(NTHR), LDS_BYTES, stream, a); }
#endif
    const hipError_t le = hipPeekAtLastError();
    if (le != hipSuccess) fprintf(stderr, "kernel_launch: launch failed: %s\n", hipGetErrorName(le));
}
```

```cpp
#include <hip/hip_runtime.h>
#include <cstdio>
#include <cstdint>
#include <cmath>
namespace pg8 {
#define PG8_LAS __attribute__((address_space(3)))
typedef unsigned short bf16_t;
typedef short bf16x8 __attribute__((ext_vector_type(8)));
typedef float f32x4 __attribute__((ext_vector_type(4)));
typedef unsigned u32x4 __attribute__((ext_vector_type(4)));
constexpr int BM = 256, BK = 64, HALF = 128, HTB = HALF * BK * 2  , STAGE_BYTES = 8 * HTB, NXCD = 8, WGM = 8;

__host__ __device__ __forceinline__ int lds_byte(int r, int c) { const int st = (r >> 4) * 2 + (c >> 5), rr = r & 15, cc = c & 31, ob = rr * 64 + cc * 2; return st * 1024 + (ob ^ (((ob >> 9) & 1) << 5)); }
__host__ __device__ __forceinline__ void stage_rc(int b, int& R, int& C) { const int st = b / 1024, sb = b % 1024, swz = sb ^ (((sb >> 9) & 1) << 5); R = (st >> 1) * 16 + swz / 64; C = (st & 1) * 32 + (swz % 64) / 2; }
__host__ __device__ __forceinline__ int perm32(int rho) { const int n = rho >> 4, i = rho & 15; return 8 * (i >> 2) + 4 * n + (i & 3); }

struct Unit { int pm, pn; };
struct Gemm { const bf16_t* A; const bf16_t* Bt; int M, N, K; };

struct StaticOrder {
    int nM, nN, nwg, G, c;
    __host__ __device__ void init(int M, int N, int G_, int c_) { nM = M / BM; nN = N / BM; nwg = nM * nN; G = G_; c = c_; }
    __host__ __device__ bool next(int i, Unit& u) const {
        const long L = (long)i * G + c; if (L >= nwg) return false;
        int wgid = (int)L; { const int q = nwg / NXCD, r = nwg % NXCD, xcd = wgid % NXCD, off = wgid / NXCD; wgid = (xcd < r ? xcd * (q + 1) : r * (q + 1) + (xcd - r) * q) + off; }
        const int nig = WGM * nN, gid = wgid / nig, fm = gid * WGM, gsz = (nM - fm) < WGM ? (nM - fm) : WGM;
        u.pm = fm + ((wgid % nig) % gsz); u.pn = (wgid % nig) / gsz; return true;
    }
    __device__ __forceinline__ void a_ready(const Unit&) const {}
    __device__ __forceinline__ void done(const Unit&) const {}
};
__device__ __forceinline__ unsigned cvt_pk_bf16(float lo, float hi) { unsigned r; asm volatile("v_cvt_pk_bf16_f32 %0, %1, %2" : "=v"(r) : "v"(lo), "v"(hi)); return r; }
struct EpiProj {
    static constexpr bool PERM = true, AFTER_DRAIN = false;
    bf16_t* O; float* aux;
    __device__ __forceinline__ void operator()(const f32x4 (&acc)[2][2][4][2], const Unit& u, int wr, int wc, int fr, int fq) const {
        const int row0 = u.pm * BM + wr * 64 + fr;
        if (u.pn < 22) {
            const int col0 = u.pn * BM + wc * 32 + 8 * fq;
#pragma unroll
            for (int ai = 0; ai < 2; ++ai)
#pragma unroll
                for (int m = 0; m < 4; ++m) { bf16_t* rowp = O + (size_t)(row0 + ai * HALF + m * 16) * 5632 + col0;
#pragma unroll
                    for (int bj = 0; bj < 2; ++bj) { const f32x4 v0 = acc[ai][bj][m][0], v1 = acc[ai][bj][m][1];
                        u32x4 w; w.x = cvt_pk_bf16(v0[0], v0[1]); w.y = cvt_pk_bf16(v0[2], v0[3]); w.z = cvt_pk_bf16(v1[0], v1[1]); w.w = cvt_pk_bf16(v1[2], v1[3]);
                        *(u32x4*)(rowp + bj * HALF) = w; } }
        } else if (wc < 2) {
            const int col0 = wc * 32 + 8 * fq;
#pragma unroll
            for (int ai = 0; ai < 2; ++ai)
#pragma unroll
                for (int m = 0; m < 4; ++m) { float* rowp = aux + (size_t)(row0 + ai * HALF + m * 16) * 64 + col0;
                    *(f32x4*)(rowp) = acc[ai][0][m][0]; *(f32x4*)(rowp + 4) = acc[ai][0][m][1]; }
        }
    }
};
struct EpiRes {
    static constexpr bool PERM = true, AFTER_DRAIN = false;
    const float* basef; const bf16_t* baseb; bf16_t* out;
    __device__ __forceinline__ void operator()(const f32x4 (&acc)[2][2][4][2], const Unit& u, int wr, int wc, int fr, int fq) const {
        const int row0 = u.pm * BM + wr * 64 + fr, col0 = u.pn * BM + wc * 32 + 8 * fq;
#pragma unroll
        for (int ai = 0; ai < 2; ++ai)
#pragma unroll
            for (int m = 0; m < 4; ++m) { const size_t off = (size_t)(row0 + ai * HALF + m * 16) * 2048 + col0;
#pragma unroll
                for (int bj = 0; bj < 2; ++bj) { f32x4 v0 = acc[ai][bj][m][0], v1 = acc[ai][bj][m][1]; const size_t o = off + bj * HALF;
                    if (basef) { v0 += *(const f32x4*)(basef + o); v1 += *(const f32x4*)(basef + o + 4); }
                    else { const u32x4 b = *(const u32x4*)(baseb + o);
                        v0[0] += __uint_as_float(b.x << 16); v0[1] += __uint_as_float(b.x & 0xffff0000u); v0[2] += __uint_as_float(b.y << 16); v0[3] += __uint_as_float(b.y & 0xffff0000u);
                        v1[0] += __uint_as_float(b.z << 16); v1[1] += __uint_as_float(b.z & 0xffff0000u); v1[2] += __uint_as_float(b.w << 16); v1[3] += __uint_as_float(b.w & 0xffff0000u); }
                    u32x4 w; w.x = cvt_pk_bf16(v0[0], v0[1]); w.y = cvt_pk_bf16(v0[2], v0[3]); w.z = cvt_pk_bf16(v1[0], v1[1]); w.w = cvt_pk_bf16(v1[2], v1[3]);
                    *(u32x4*)(out + o) = w; } }
    }
};
template <class Epi, class Sched, bool ALIGN_EPI = false, bool SP2 = false>
__device__ __forceinline__ void gemm_phase(PG8_LAS unsigned char* lds, const Gemm g, const Sched& S, const Epi& E, int wid_in  ) {
    int wid = wid_in; asm volatile("" : "+s"(wid));
    int lane = (int)__builtin_amdgcn_mbcnt_hi(~0u, __builtin_amdgcn_mbcnt_lo(~0u, 0u)); asm volatile("" : "+v"(lane));
    const int tid = wid * 64 + lane, wr = wid >> 2, wc = wid & 3, fr = lane & 15, fq = lane >> 4;
    const int K = g.K, nt = K / BK;
    unsigned voffA[2], voffB[2];
#pragma unroll
    for (int i = 0; i < 2; ++i) { int R, C; stage_rc(tid * 16 + i * 8192, R, C); const int Rb = Epi::PERM ? ((R & ~31) + perm32(R & 31)) : R;
        voffA[i] = (unsigned)(R * K + C) * 2u; voffB[i] = (unsigned)(Rb * K + C) * 2u; }
    const size_t kstep = (size_t)(BK * 2);
    const size_t hstep = (size_t)HALF * K * 2;
    const size_t tstep = 2 * hstep;
    const unsigned ldsw = (unsigned)wid * 1024u;
    const int aoff = lds_byte(wr * 64 + fr, fq * 8), boff = lds_byte(wc * 32 + fr, fq * 8);
#define PG8_SA(b, h) (((b) * 2 + (h)) * HTB)
#define PG8_SB(b, h) ((4 + (b) * 2 + (h)) * HTB)
#define PG8_STAGE(bufoff, gbase, voff) do { _Pragma("unroll") for (int _i = 0; _i < 2; ++_i) \
        __builtin_amdgcn_global_load_lds((const unsigned*)((const char*)(gbase) + (voff)[_i]), (PG8_LAS unsigned*)(lds + (bufoff) + ldsw + _i * 8192), 16, 0, 0); } while (0)
#define PG8_LDA(dst, b, h) do { _Pragma("unroll") for (int m = 0; m < 4; ++m) _Pragma("unroll") for (int k = 0; k < 2; ++k) dst[m][k] = *(const PG8_LAS bf16x8*)(lds + PG8_SA(b, h) + aoff + m * 2048 + k * 1024); } while (0)
#define PG8_LDB(dst, b, h) do { _Pragma("unroll") for (int n = 0; n < 2; ++n) _Pragma("unroll") for (int k = 0; k < 2; ++k) dst[n][k] = *(const PG8_LAS bf16x8*)(lds + PG8_SB(b, h) + boff + n * 2048 + k * 1024); } while (0)
#define PG8_MMA(ai, bj, At, Bt) do { __builtin_amdgcn_s_setprio(1); _Pragma("unroll") for (int m = 0; m < 4; ++m) _Pragma("unroll") for (int n = 0; n < 2; ++n) _Pragma("unroll") for (int k = 0; k < 2; ++k) \
        acc[ai][bj][m][n] = __builtin_amdgcn_mfma_f32_16x16x32_bf16(Bt[n][k], At[m][k], acc[ai][bj][m][n], 0, 0, 0); __builtin_amdgcn_s_setprio(0); } while (0)
#define PG8_WAIT_V(n) asm volatile("s_waitcnt vmcnt(" #n ")" ::: "memory")
#define PG8_WAIT_L(n) asm volatile("s_waitcnt lgkmcnt(" #n ")" ::: "memory")
#define PG8_BAR __builtin_amdgcn_s_barrier()
#define PG8_SCHED __builtin_amdgcn_sched_barrier(0)
    Unit cur, nxt; int ui = 0;
    if (!S.next(0, cur)) return;
    f32x4 acc[2][2][4][2];
#pragma unroll
    for (int a = 0; a < 2; ++a)
#pragma unroll
        for (int b = 0; b < 2; ++b)
#pragma unroll
            for (int m = 0; m < 4; ++m)
#pragma unroll
                for (int n = 0; n < 2; ++n) acc[a][b][m][n] = (f32x4){0.f, 0.f, 0.f, 0.f};
    bf16x8 At[4][2], B0[2][2], B1[2][2];
    const char* cA = (const char*)g.A + (size_t)cur.pm * tstep; const char* cB = (const char*)g.Bt + (size_t)cur.pn * tstep;
    S.a_ready(cur);
    if constexpr (SP2) {
        PG8_STAGE(PG8_SB(0, 0), cB, voffB); PG8_STAGE(PG8_SB(0, 1), cB + hstep, voffB); PG8_STAGE(PG8_SA(0, 0), cA, voffA); PG8_STAGE(PG8_SA(0, 1), cA + hstep, voffA);
        if (wr == 1) PG8_BAR;
        PG8_WAIT_V(2); PG8_BAR;
        PG8_STAGE(PG8_SB(1, 0), cB + kstep, voffB); PG8_STAGE(PG8_SA(1, 0), cA + kstep, voffA); PG8_STAGE(PG8_SB(1, 1), cB + hstep + kstep, voffB);
        PG8_WAIT_V(6); PG8_BAR;
    } else {
        PG8_STAGE(PG8_SB(0, 0), cB, voffB); PG8_STAGE(PG8_SA(0, 0), cA, voffA); PG8_STAGE(PG8_SB(0, 1), cB + hstep, voffB); PG8_STAGE(PG8_SA(0, 1), cA + hstep, voffA);
        if (wr == 1) PG8_BAR;
        PG8_WAIT_V(4); PG8_BAR;
        PG8_STAGE(PG8_SB(1, 0), cB + kstep, voffB); PG8_STAGE(PG8_SA(1, 0), cA + kstep, voffA); PG8_STAGE(PG8_SB(1, 1), cB + hstep + kstep, voffB);
        PG8_WAIT_V(6); PG8_BAR;
    }
    for (;;) {
        const bool has_next = S.next(ui + 1, nxt);
        const char* nA = has_next ? (const char*)g.A + (size_t)nxt.pm * tstep : cA; const char* nB = has_next ? (const char*)g.Bt + (size_t)nxt.pn * tstep : cB;
        for (int t = 0; t < nt; t += 2) {
            const bool last = (t == nt - 2);
            const char* a1 = cA + (size_t)(t + 1) * kstep;
            const char* a2 = last ? nA : cA + (size_t)(t + 2) * kstep; const char* b2 = last ? nB : cB + (size_t)(t + 2) * kstep;
            const char* a3 = a2 + kstep; const char* b3 = b2 + kstep;
            if (last && has_next) S.a_ready(nxt);
            if constexpr (SP2) {
            PG8_LDB(B0, 0, 0); PG8_LDB(B1, 0, 1); PG8_SCHED; PG8_LDA(At, 0, 0); PG8_STAGE(PG8_SA(1, 1), a1 + hstep, voffA);
            PG8_WAIT_V(8); PG8_WAIT_L(0); PG8_BAR; PG8_MMA(0, 0, At, B0); PG8_MMA(0, 1, At, B1); PG8_BAR; PG8_SCHED;
            PG8_LDA(At, 0, 1); PG8_STAGE(PG8_SB(0, 0), b2, voffB); PG8_STAGE(PG8_SB(0, 1), b2 + hstep, voffB); PG8_STAGE(PG8_SA(0, 0), a2, voffA);
            PG8_WAIT_V(8); PG8_WAIT_L(0); PG8_BAR; PG8_MMA(1, 0, At, B0); PG8_MMA(1, 1, At, B1); PG8_BAR; PG8_SCHED;
            PG8_LDB(B0, 1, 0); PG8_LDB(B1, 1, 1); PG8_SCHED; PG8_LDA(At, 1, 0); PG8_STAGE(PG8_SA(0, 1), a2 + hstep, voffA);
            PG8_WAIT_V(8); PG8_WAIT_L(0); PG8_BAR; PG8_MMA(0, 0, At, B0); PG8_MMA(0, 1, At, B1); PG8_BAR; PG8_SCHED;
            PG8_LDA(At, 1, 1); PG8_STAGE(PG8_SB(1, 0), b3, voffB); PG8_STAGE(PG8_SB(1, 1), b3 + hstep, voffB); PG8_STAGE(PG8_SA(1, 0), a3, voffA);
            PG8_WAIT_V(8); PG8_WAIT_L(0); PG8_BAR; PG8_MMA(1, 0, At, B0); PG8_MMA(1, 1, At, B1); PG8_BAR; PG8_SCHED;
            } else {
            PG8_LDB(B0, 0, 0); PG8_SCHED; PG8_LDA(At, 0, 0); PG8_STAGE(PG8_SA(1, 1), a1 + hstep, voffA);
            PG8_WAIT_L(8); PG8_BAR; PG8_WAIT_L(0); PG8_MMA(0, 0, At, B0); PG8_BAR; PG8_SCHED;
            PG8_LDB(B1, 0, 1); PG8_STAGE(PG8_SB(0, 0), b2, voffB);
            PG8_BAR; PG8_WAIT_L(0); PG8_MMA(0, 1, At, B1); PG8_BAR;
            PG8_LDA(At, 0, 1); PG8_STAGE(PG8_SA(0, 0), a2, voffA);
            PG8_BAR; PG8_WAIT_L(0); PG8_MMA(1, 0, At, B0); PG8_BAR; PG8_SCHED;
            PG8_STAGE(PG8_SB(0, 1), b2 + hstep, voffB);
            PG8_WAIT_V(6); PG8_BAR; PG8_MMA(1, 1, At, B1); PG8_BAR;
            PG8_LDB(B0, 1, 0); PG8_SCHED; PG8_LDA(At, 1, 0); PG8_STAGE(PG8_SA(0, 1), a2 + hstep, voffA);
            PG8_WAIT_L(8); PG8_BAR; PG8_WAIT_L(0); PG8_MMA(0, 0, At, B0); PG8_BAR; PG8_SCHED;
            PG8_LDB(B1, 1, 1); PG8_STAGE(PG8_SB(1, 0), b3, voffB);
            PG8_BAR; PG8_WAIT_L(0); PG8_MMA(0, 1, At, B1); PG8_BAR;
            PG8_LDA(At, 1, 1); PG8_STAGE(PG8_SA(1, 0), a3, voffA);
            PG8_BAR; PG8_WAIT_L(0); PG8_MMA(1, 0, At, B0); PG8_BAR; PG8_SCHED;
            PG8_STAGE(PG8_SB(1, 1), b3 + hstep, voffB);
            PG8_WAIT_V(6); PG8_BAR; PG8_MMA(1, 1, At, B1); PG8_BAR;
            }
        }
        if constexpr (ALIGN_EPI) { if (wr == 0) PG8_BAR; }
        if constexpr (!Epi::AFTER_DRAIN) { E(acc, cur, wr, wc, fr, fq); S.done(cur); }
        if (!has_next) break;
#pragma unroll
        for (int a = 0; a < 2; ++a)
#pragma unroll
            for (int b = 0; b < 2; ++b)
#pragma unroll
                for (int m = 0; m < 4; ++m)
#pragma unroll
                    for (int n = 0; n < 2; ++n) acc[a][b][m][n] = (f32x4){0.f, 0.f, 0.f, 0.f};
        cur = nxt; cA = nA; cB = nB; ++ui;
        if constexpr (ALIGN_EPI) { if (wr == 1) PG8_BAR; }
    }
    PG8_WAIT_V(0);
    if constexpr (!ALIGN_EPI) { if (wr == 0) PG8_BAR; }
    PG8_BAR;
    if constexpr (Epi::AFTER_DRAIN) { E.fused(acc, cur, wr, wc, fr, fq, lds, wid, lane); S.done(cur); }
#undef PG8_SA
#undef PG8_SB
#undef PG8_STAGE
#undef PG8_LDA
#undef PG8_LDB
#undef PG8_MMA
#undef PG8_WAIT_V
#undef PG8_WAIT_L
#undef PG8_BAR
#undef PG8_SCHED
}
}
#define GAS __attribute__((address_space(1)))
#define LAS __attribute__((address_space(3)))
typedef unsigned short bf16;
typedef unsigned v4u __attribute__((ext_vector_type(4)));
typedef float f32x4 __attribute__((ext_vector_type(4)));
typedef short bf16x8 __attribute__((ext_vector_type(8)));
typedef GAS unsigned gu32;
typedef GAS unsigned long long gu64;
#define RLX_AGENT __ATOMIC_RELAXED, __HIP_MEMORY_SCOPE_AGENT
#define LDS_WAIT() asm volatile("s_waitcnt lgkmcnt(0)" ::: "memory")
#define VM_WAIT() asm volatile("s_waitcnt vmcnt(0)" ::: "memory")
__device__ __forceinline__ unsigned long long rt() { return __builtin_amdgcn_s_memrealtime(); }
__device__ __forceinline__ unsigned f2bf(float f) { unsigned u = __builtin_bit_cast(unsigned, f); return (u + 0x7fffu + ((u >> 16) & 1u)) >> 16; }
__device__ __forceinline__ unsigned pk2(float lo, float hi) { return f2bf(lo) | (f2bf(hi) << 16); }
#define XB_TMO      128
#define XB_XCNT(j)  (256  + 64 * (j))
#define XB_XSUB(j)  (1280 + 64 * (j))
#define XB_XGEN(j)  (2304 + 64 * (j))
#define XB_TOP      3328
#define XB_TOPGEN   3392
#define XCD_BAR_WORDS 3456
#define XB_SPIN_CAP (1u << 18)

__device__ __forceinline__ unsigned xb_ld(unsigned* p)              { return __hip_atomic_load(p, __ATOMIC_RELAXED, __HIP_MEMORY_SCOPE_AGENT); }
__device__ __forceinline__ unsigned xb_add(unsigned* p, unsigned v) { return __hip_atomic_fetch_add(p, v, __ATOMIC_RELAXED, __HIP_MEMORY_SCOPE_AGENT); }
__device__ __forceinline__ unsigned xb_xcc_id() { return (unsigned)__builtin_amdgcn_s_getreg((3 << 11) | 20) & 0xFu; }
#define XB_SPIN(cond, bar) do { unsigned _sp = 0; while (cond) { __builtin_amdgcn_s_sleep(1); \
    if ((++_sp & 255u) == 0u) { if (xb_ld(&(bar)[XB_TMO])) break; if (_sp > XB_SPIN_CAP) { atomicAdd(&(bar)[XB_TMO], 1u); break; } } } } while (0)

struct XcdBarrier {
    unsigned* bar; unsigned x;
    unsigned w0;
    volatile LAS unsigned* st;
};

__device__ __forceinline__ XcdBarrier xcd_barrier_post(unsigned* bar, volatile LAS unsigned* st) {
    XcdBarrier b; b.bar = bar; b.x = xb_xcc_id(); b.st = st; b.w0 = (__builtin_amdgcn_readfirstlane(threadIdx.x >> 6) == 0) ? 1u : 0u;
    if (threadIdx.x == 0) (void)xb_add(&bar[XB_XCNT(b.x)], 1u);
    return b;
}
__device__ __forceinline__ void xcd_barrier_complete(unsigned* bar, unsigned x, unsigned& nloc, unsigned& nx) {
    const unsigned G = gridDim.x * gridDim.y * gridDim.z;
    unsigned sum, cnt, mine, sp = 0u;
    for (;;) {
        sum = 0u; cnt = 0u; mine = 0u;
#pragma unroll
        for (unsigned j = 0; j < 16; ++j) { const unsigned c = xb_ld(&bar[XB_XCNT(j)]); sum += c; cnt += (c > 0u) ? 1u : 0u; mine = (j == x) ? c : mine; }
        if (sum == G) break;
        __builtin_amdgcn_s_sleep(1);
        if ((++sp & 255u) == 0u) { if (xb_ld(&bar[XB_TMO])) break; if (sp > XB_SPIN_CAP) { atomicAdd(&bar[XB_TMO], 1u); break; } }
    }
    nloc = mine > 0u ? mine : 1u; nx = cnt > 0u ? cnt : 1u;
}

__device__ __forceinline__ void xcd_barrier(const XcdBarrier& b) {
    asm volatile("s_waitcnt vmcnt(0)" ::: "memory");
    __syncthreads();
    if (b.w0 != 0u && __builtin_amdgcn_mbcnt_hi(~0u, __builtin_amdgcn_mbcnt_lo(~0u, 0u)) == 0u) {
        GAS unsigned* barg = (GAS unsigned*)b.bar; asm volatile("" : "+s"(barg)); unsigned* bar = (unsigned*)barg;
        __builtin_amdgcn_s_waitcnt(0);
        unsigned nloc = b.st[0], nx = b.st[1];
        if (nloc == 0u) { xcd_barrier_complete(bar, b.x, nloc, nx); b.st[0] = nloc; b.st[1] = nx; }
        const unsigned old = xb_add(&bar[XB_XSUB(b.x)], 1u);
        const unsigned gen = old / nloc;
        if (old + 1u == (gen + 1u) * nloc) {
            __builtin_amdgcn_fence(__ATOMIC_RELEASE, "agent");
            asm volatile("s_waitcnt vmcnt(0)" ::: "memory");
            const unsigned og = xb_add(&bar[XB_TOP], 1u);
            const unsigned tg = og / nx;
            if (og + 1u == (tg + 1u) * nx) xb_add(&bar[XB_TOPGEN], 1u);
            else XB_SPIN(xb_ld(&bar[XB_TOPGEN]) == tg, bar);
            __builtin_amdgcn_fence(__ATOMIC_ACQUIRE, "agent");
            xb_add(&bar[XB_XGEN(b.x)], 1u);
            asm volatile("s_waitcnt vmcnt(0)" ::: "memory");
        } else {
            XB_SPIN(xb_ld(&bar[XB_XGEN(b.x)]) == gen, bar);
            __builtin_amdgcn_fence(__ATOMIC_ACQUIRE, "agent");
            asm volatile("s_waitcnt vmcnt(0)" ::: "memory");
        }
    }
    __syncthreads();
}
typedef unsigned u32x4 __attribute__((ext_vector_type(4)));

typedef short s16x4 __attribute__((ext_vector_type(4)));
typedef float f32x16 __attribute__((ext_vector_type(16)));
typedef unsigned u32x2 __attribute__((ext_vector_type(2)));
typedef float f32x2v __attribute__((ext_vector_type(2)));

constexpr int S = 8192, D = 2048, DEPTH = 4, DIN = 5688, NP = 5888, PITCH = 5632;
constexpr int C_AQ = 0, C_AK = 512, C_AV = 1024, C_BQ = 1536, C_BK = 2048, C_BV = 2560, C_CQ = 3072, C_KC = 4096, C_VC = 4352, C_KS = 4608, C_VS = 4864, C_KW = 5120, C_VW = 5376;
constexpr float RMS_EPS = 1e-6f, NEG = -1e30f, LOG2E = 1.4426950408889634f, SCL2 = 0.125f * 1.4426950408889634f;
constexpr int NWAVES = 8, NTHR = 512;

constexpr size_t MiB = 1u << 20;
constexpr size_t WS_CTL = 0, CTL_ZERO_BYTES = 1 * MiB;
constexpr size_t WS_WIN = 2 * MiB;
constexpr size_t WS_WOUT = 96 * MiB;
constexpr size_t WS_W1T = 128 * MiB;
constexpr size_t WS_W2T = 136 * MiB;
constexpr size_t WS_RWT = 137 * MiB;
constexpr size_t WS_C1 = 139 * MiB;
constexpr size_t WS_X = 144 * MiB;
constexpr size_t WS_XN = 208 * MiB;
constexpr size_t WS_PROJ = 240 * MiB;
constexpr size_t WS_AUX = 330 * MiB;
constexpr size_t WS_CUM = 332 * MiB;
constexpr size_t WS_KC = 333 * MiB;
constexpr size_t WS_VC = 334 * MiB;
constexpr size_t WS_MIX = 336 * MiB;
constexpr size_t WS_YB = 368 * MiB;
constexpr size_t WS_LIST = 432 * MiB;
constexpr size_t WS_TW = 436 * MiB;
constexpr size_t WS_END = 440 * MiB;
constexpr int CW_BAR = 4096;
constexpr int CW_Q = 8192;
constexpr int CW_PQ = 24576, CW_PD = 25600;
constexpr int CW_CNT = 32768;

constexpr int LDS_BYTES = 160 * 1024;
constexpr int MISC_OFF = 150 * 1024;

struct Args { const float* in[23]; float* out; unsigned char* ws; int ph_lo, ph_hi; };
__device__ __forceinline__ int t5_bucket(int rel) { if (rel < 16) return rel; int b = 16;
    b += rel >= 19; b += rel >= 21; b += rel >= 24; b += rel >= 27; b += rel >= 31; b += rel >= 35; b += rel >= 40; b += rel >= 46; b += rel >= 52; b += rel >= 59; b += rel >= 67; b += rel >= 77; b += rel >= 87; b += rel >= 99; b += rel >= 113; return b; }

__device__ __forceinline__ float bf2f(unsigned short b) { return __uint_as_float((unsigned)b << 16); }
__device__ __forceinline__ float bflo(unsigned w) { return __uint_as_float(w << 16); }
__device__ __forceinline__ float bfhi(unsigned w) { return __uint_as_float(w & 0xffff0000u); }
typedef __bf16 bf16x2_t __attribute__((ext_vector_type(2)));
__device__ __forceinline__ unsigned cvtpk(float lo, float hi) { f32x2v v = {lo, hi}; bf16x2_t b = __builtin_convertvector(v, bf16x2_t); return __builtin_bit_cast(unsigned, b); }
__device__ __forceinline__ unsigned short f2bf16(float f) { return (unsigned short)(cvtpk(f, 0.f) & 0xffffu); }
__device__ __forceinline__ float wave_sum(float v) {
#pragma unroll
    for (int o = 1; o < 64; o <<= 1) v += __shfl_xor(v, o);
    return v;
}
__device__ __forceinline__ int crow(int r, int hi) { return (r & 3) + 8 * (r >> 2) + 4 * hi; }
#define MFMA32(a, b, c) __builtin_amdgcn_mfma_f32_32x32x16_bf16((a), (b), (c), 0, 0, 0)
#define MFMA16(a, b, c) __builtin_amdgcn_mfma_f32_16x16x32_bf16((a), (b), (c), 0, 0, 0)

__device__ __forceinline__ int src_col_win(int n) { if (n < 3072) return n; if (n < 5632) return n + 8; if (n < 5640) return n - 2560; if (n < 5688) return n; return -1; }

template <int MODE>
__device__ __forceinline__ void tr_item(const float* W, const float* W2, int ldw, int K, bf16* WT, int k0, int n0, LAS float* scr, int lane) {
    const int nn = n0 + (lane & 31);
    const float* src = W; int ld = ldw; bool ok = true;
    if (MODE == 0) { src = W + nn; }
    else if (MODE == 1) { const int c = src_col_win(nn); ok = c >= 0; src = W + (ok ? c : 0); }
    else { if (nn < 8) { src = W + nn; ld = 8; } else if (nn < 72) { src = W2 + (nn - 8); ld = 64; } else { ok = false; ld = 8; } }
    float tv[32];
#pragma unroll
    for (int i = 0; i < 32; ++i) { const int kk = 2 * i + (lane >> 5); tv[i] = ok ? src[(size_t)(k0 + kk) * ld] : 0.f; }
#pragma unroll
    for (int i = 0; i < 32; ++i) { const int kk = 2 * i + (lane >> 5); scr[kk * 33 + (lane & 31)] = tv[i]; }
    LDS_WAIT(); asm volatile("" ::: "memory");
    const int c = lane & 7;
#pragma unroll
    for (int j = 0; j < 4; ++j) { const int n = (lane >> 3) + 8 * j; const LAS float* s = scr + (8 * c) * 33 + n;
        v4u o; o.x = pk2(s[0 * 33], s[1 * 33]); o.y = pk2(s[2 * 33], s[3 * 33]); o.z = pk2(s[4 * 33], s[5 * 33]); o.w = pk2(s[6 * 33], s[7 * 33]);
        *(v4u*)(WT + (size_t)(n0 + n) * K + k0 + 8 * c) = o; }
    LDS_WAIT(); asm volatile("" ::: "memory");
}

template <int MODE>
__device__ __forceinline__ void norm_rows(const float* xsrc, const bf16* xb, bf16* X, bf16* XN, const bf16* YB, const float* TW, const float* gain, float* out, int gw, int NGW, int lane) {
    for (int row = gw; row < S; row += NGW) {
        f32x4 v[8];
        if (MODE == 0) { const f32x4* xr = (const f32x4*)(xsrc + (size_t)row * D) + lane;
#pragma unroll
            for (int j = 0; j < 8; ++j) v[j] = xr[64 * j];
        } else { const u32x2* xr = (const u32x2*)(xb + (size_t)row * D) + lane;
#pragma unroll
            for (int j = 0; j < 8; ++j) { const u32x2 r = xr[64 * j]; v[j] = (f32x4){bflo(r.x), bfhi(r.x), bflo(r.y), bfhi(r.y)}; } }
        if (MODE >= 1) {
            const float w0 = TW[2 * row], w1 = TW[2 * row + 1];
            const u32x2* ya = (const u32x2*)(YB + (size_t)(2 * row) * D) + lane; const u32x2* yb = (const u32x2*)(YB + (size_t)(2 * row + 1) * D) + lane;
#pragma unroll
            for (int j = 0; j < 8; ++j) { const u32x2 a = ya[64 * j], b = yb[64 * j];
                v[j].x += w0 * bflo(a.x) + w1 * bflo(b.x); v[j].y += w0 * bfhi(a.x) + w1 * bfhi(b.x);
                v[j].z += w0 * bflo(a.y) + w1 * bflo(b.y); v[j].w += w0 * bfhi(a.y) + w1 * bfhi(b.y); }
        }
        float ss = 0.f;
#pragma unroll
        for (int j = 0; j < 8; ++j) ss += (v[j].x * v[j].x + v[j].y * v[j].y) + (v[j].z * v[j].z + v[j].w * v[j].w);
        ss = wave_sum(ss);
        const float rstd = 1.0f / sqrtf(ss * (1.0f / D) + RMS_EPS);
        if (MODE == 1) { u32x2* xo = (u32x2*)(X + (size_t)row * D) + lane;
#pragma unroll
            for (int j = 0; j < 8; ++j) { u32x2 w; w.x = cvtpk(v[j].x, v[j].y); w.y = cvtpk(v[j].z, v[j].w); xo[64 * j] = w; } }
        const f32x4* gr = (const f32x4*)gain + lane;
        if (MODE < 2) { u32x2* o8 = (u32x2*)(XN + (size_t)row * D) + lane;
#pragma unroll
            for (int j = 0; j < 8; ++j) { const f32x4 g = gr[64 * j]; u32x2 w; w.x = cvtpk(v[j].x * rstd * g.x, v[j].y * rstd * g.y); w.y = cvtpk(v[j].z * rstd * g.z, v[j].w * rstd * g.w); o8[64 * j] = w; }
        } else { f32x4* oo = (f32x4*)(out + (size_t)row * D) + lane;
#pragma unroll
            for (int j = 0; j < 8; ++j) { const f32x4 g = gr[64 * j]; oo[64 * j] = v[j] * rstd * g; } }
    }
}

__device__ __forceinline__ void p0_prologue(const Args& a, LAS unsigned char* lds, int bid, int G, int tid, int wid, int lane) {
    unsigned char* ws = a.ws;
    LAS float* scr = (LAS float*)(lds + wid * 8448);
    const int gw = bid * NWAVES + wid, NGW = G * NWAVES;
    constexpr int I_WIN = 32 * 184, I_WOUT = 32 * 64, I_W1 = 32 * 8, I_W2 = 4 * 2, I_RW = 32 * 3, I_L = I_WIN + I_WOUT + 2 * I_W1 + 2 * I_W2 + I_RW;
    for (int it = gw; it < DEPTH * I_L; it += NGW) {
        const int l = it / I_L; int r = it % I_L;
        if (r < I_WIN) { tr_item<1>(a.in[2] + (size_t)l * D * DIN, nullptr, DIN, D, (bf16*)(ws + WS_WIN) + (size_t)l * NP * D, 64 * (r / 184), 32 * (r % 184), scr, lane); continue; } r -= I_WIN;
        if (r < I_WOUT) { tr_item<0>(a.in[13] + (size_t)l * D * D, nullptr, D, D, (bf16*)(ws + WS_WOUT) + (size_t)l * D * D, 64 * (r / 64), 32 * (r % 64), scr, lane); continue; } r -= I_WOUT;
        if (r < 2 * I_W1) { const int kv = r / I_W1, q = r % I_W1; tr_item<0>(a.in[kv ? 10 : 7] + (size_t)l * 2048 * 256, nullptr, 256, 2048, (bf16*)(ws + WS_W1T) + (size_t)(l * 2 + kv) * 256 * 2048, 64 * (q / 8), 32 * (q % 8), scr, lane); continue; } r -= 2 * I_W1;
        if (r < 2 * I_W2) { const int kv = r / I_W2, q = r % I_W2; tr_item<0>(a.in[kv ? 11 : 8] + (size_t)l * 256 * 64, nullptr, 64, 256, (bf16*)(ws + WS_W2T) + (size_t)(l * 2 + kv) * 64 * 256, 64 * (q / 2), 32 * (q % 2), scr, lane); continue; } r -= 2 * I_W2;
        tr_item<2>(a.in[15] + (size_t)l * D * 8, a.in[17] + (size_t)l * D * 64, 8, D, (bf16*)(ws + WS_RWT) + (size_t)l * 96 * D, 64 * (r / 3), 32 * (r % 3), scr, lane);
    }
    for (int b = bid; b < 256; b += G) {
        const int vec = b >> 5, cb = b & 31, l = vec >> 1, kv = vec & 1; const float* pos = a.in[kv ? 9 : 6] + (size_t)l * 2048; const float* w1 = a.in[kv ? 10 : 7] + (size_t)l * 2048 * 256 + 8 * cb;
        float acc[8];
#pragma unroll
        for (int i = 0; i < 8; ++i) acc[i] = 0.f;
#pragma unroll
        for (int j = 0; j < 4; ++j) { const int k = tid + 512 * j; const float pv = pos[k]; const f32x4 w0 = *(const f32x4*)(w1 + (size_t)k * 256), w1v = *(const f32x4*)(w1 + (size_t)k * 256 + 4);
            acc[0] += pv * w0.x; acc[1] += pv * w0.y; acc[2] += pv * w0.z; acc[3] += pv * w0.w; acc[4] += pv * w1v.x; acc[5] += pv * w1v.y; acc[6] += pv * w1v.z; acc[7] += pv * w1v.w; }
        LAS float* red = (LAS float*)(lds + 72 * 1024);
#pragma unroll
        for (int i = 0; i < 8; ++i) { const float sws = wave_sum(acc[i]); if (lane == 0) red[wid * 8 + i] = sws; }
        __syncthreads();
        if (tid < 8) { float sres = 0.f;
#pragma unroll
            for (int w = 0; w < 8; ++w) sres += red[w * 8 + tid];
            ((float*)(ws + WS_C1))[vec * 256 + 8 * cb + tid] = sres; }
        __syncthreads();
    }
    norm_rows<0>(a.in[0], nullptr, nullptr, (bf16*)(ws + WS_XN), nullptr, nullptr, a.in[1], nullptr, gw, NGW, lane);
}

__device__ __forceinline__ float gelu_tanh(float x) { const float u = 0.7978845608028654f * (x + 0.044715f * x * x * x); const float t = 1.0f - 2.0f / (__expf(2.0f * u) + 1.0f); return 0.5f * x * (1.0f + t); }

__device__ __forceinline__ void compress_unit(int u, int l, const bf16* PROJ, const bf16* W1T, const bf16* W2T, const float* C1, bf16* KC, bf16* VC, LAS unsigned char* lds, int wid, int lane) {
    const int kv = u >> 6, rb = u & 63, r32 = lane & 31, hi = lane >> 5;
    const int R = 32 * rb + r32, g = R >> 9, n = R & 511;
    const int colb = (kv ? C_VC : C_KC) + 64 * g;
    const bf16* w1 = W1T + (size_t)(l * 2 + kv) * 256 * 2048 + (size_t)(32 * wid + r32) * 2048 + 8 * hi;
    const bf16* arow = PROJ + colb + 8 * hi;
    f32x16 acc = {};
#pragma unroll 4
    for (int s = 0; s < 128; ++s) {
        int tok = 16 * n + (s >> 2); tok = tok > (S - 1) ? (S - 1) : tok;
        const bf16x8 av = *(const bf16x8*)(arow + (size_t)tok * PITCH + (s & 3) * 16);
        const bf16x8 bv = *(const bf16x8*)(w1 + 16 * s);
        acc = MFMA32(av, bv, acc);
    }
    LAS bf16* hid = (LAS bf16*)lds;
    const float c1 = C1[(l * 2 + kv) * 256 + 32 * wid + r32];
#pragma unroll
    for (int r = 0; r < 16; ++r) hid[crow(r, hi) * 264 + 32 * wid + r32] = f2bf16(gelu_tanh(acc[r] + c1));
    __syncthreads();
    if (wid < 2) {
        f32x16 acc2 = {};
        const bf16* w2 = W2T + (size_t)(l * 2 + kv) * 64 * 256 + (size_t)(32 * wid + r32) * 256 + 8 * hi;
#pragma unroll 4
        for (int s = 0; s < 16; ++s) {
            const bf16x8 av = *(const LAS bf16x8*)(hid + r32 * 264 + 16 * s + 8 * hi);
            const bf16x8 bv = *(const bf16x8*)(w2 + 16 * s);
            acc2 = MFMA32(av, bv, acc2);
        }
        bf16* outp = kv ? VC : KC;
#pragma unroll
        for (int r = 0; r < 16; ++r) { const int Rr = 32 * rb + crow(r, hi); outp[(size_t)((Rr >> 9) * 512 + (Rr & 511)) * 64 + 32 * wid + r32] = f2bf16(acc2[r]); }
    }
    __syncthreads();
}

__device__ __forceinline__ void cumsum_unit(int h, int l, const float* AUX, const float* fox_bf, float* CUM, LAS unsigned char* lds, int tid) {
    const float bfv = fox_bf[l * 8 + h];
    float v[16]; float run = 0.f;
#pragma unroll
    for (int i = 0; i < 16; ++i) { const int t = 16 * tid + i; const float z = AUX[(size_t)t * 64 + h] + bfv; const float lf = fminf(z, 0.f) - log1pf(__expf(-fabsf(z))); run += lf; v[i] = run; }
    LAS float* tot = (LAS float*)lds;
    tot[tid] = run; __syncthreads();
    float off = 0.f;
    for (int j = 0; j < tid; ++j) off += tot[j];
#pragma unroll
    for (int i = 0; i < 16; ++i) CUM[(size_t)h * S + 16 * tid + i] = off + v[i];
    __syncthreads();
}

__device__ __forceinline__ int koff(int key, int c) { return c * 1024 + (((key + c) & 63) << 4); }
__device__ __forceinline__ int voff(int key, int c) { return (c >> 2) * 4096 + (key >> 4) * 1024 + (key & 15) * 64 + (c & 3) * 16; }
typedef short v4i16_t __attribute__((ext_vector_type(4)));
__device__ __forceinline__ s16x4 vtr(LAS const unsigned char* p) { return __builtin_bit_cast(s16x4, __builtin_amdgcn_ds_read_tr16_b64_v4i16((LAS v4i16_t*)p)); }

template <int NDT> struct AState { float m, l; f32x16 o[NDT]; };
template <int NDT> __device__ __forceinline__ void astate_init(AState<NDT>& st) { st.m = 0.f; st.l = 0.f;
#pragma unroll
    for (int i = 0; i < NDT; ++i) st.o[i] = (f32x16){}; }

template <bool QLDS>
__device__ __forceinline__ void qk_tile(f32x16& p0, f32x16& p1, LAS const unsigned char* kt, int kchunk0, const bf16x8 (&qf)[4], LAS const unsigned char* qb, int r32, int hi) {
    bf16x8 ka[4], kb[4], q[4];
#pragma unroll
    for (int d0 = 0; d0 < 4; ++d0) {
        const int c = kchunk0 + 2 * d0 + hi;
        ka[d0] = *(const LAS bf16x8*)(kt + koff(r32, c));
        kb[d0] = *(const LAS bf16x8*)(kt + koff(r32 + 32, c));
        q[d0] = QLDS ? *(const LAS bf16x8*)(qb + d0 * 8192) : qf[d0];
    }
    __builtin_amdgcn_sched_barrier(0);
    p0 = (f32x16){}; p1 = (f32x16){};
#pragma unroll
    for (int d0 = 0; d0 < 4; ++d0) { p0 = MFMA32(ka[d0], q[d0], p0); p1 = MFMA32(kb[d0], q[d0], p1); }
    __builtin_amdgcn_sched_barrier(0);
}
__device__ __forceinline__ void pack_p(bf16x8 (&pw)[4], const f32x16& p0, const f32x16& p1) {
    u32x4 w;
    w.x = cvtpk(p0[0], p0[1]); w.y = cvtpk(p0[2], p0[3]); w.z = cvtpk(p0[4], p0[5]); w.w = cvtpk(p0[6], p0[7]); pw[0] = __builtin_bit_cast(bf16x8, w);
    w.x = cvtpk(p0[8], p0[9]); w.y = cvtpk(p0[10], p0[11]); w.z = cvtpk(p0[12], p0[13]); w.w = cvtpk(p0[14], p0[15]); pw[1] = __builtin_bit_cast(bf16x8, w);
    w.x = cvtpk(p1[0], p1[1]); w.y = cvtpk(p1[2], p1[3]); w.z = cvtpk(p1[4], p1[5]); w.w = cvtpk(p1[6], p1[7]); pw[2] = __builtin_bit_cast(bf16x8, w);
    w.x = cvtpk(p1[8], p1[9]); w.y = cvtpk(p1[10], p1[11]); w.z = cvtpk(p1[12], p1[13]); w.w = cvtpk(p1[14], p1[15]); pw[3] = __builtin_bit_cast(bf16x8, w);
}
struct VFrag { s16x4 lo[4], hh[4]; };
__device__ __forceinline__ LAS const unsigned char* vfrag_base(LAS const unsigned char* vt, int lane) { return vt + ((lane >> 4) & 1) * 32 + (lane & 3) * 8 + (4 * (lane >> 5) + ((lane & 15) >> 2)) * 64; }
__device__ __forceinline__ void vfrag_read(VFrag& f, LAS const unsigned char* vb, int dt) {
#pragma unroll
    for (int s = 0; s < 4; ++s) { f.lo[s] = vtr(vb + dt * 4096 + s * 1024); f.hh[s] = vtr(vb + dt * 4096 + s * 1024 + 512); }
}
__device__ __forceinline__ void vfrag_mma(f32x16& o, const VFrag& f, const bf16x8 (&pw)[4]) {
#pragma unroll
    for (int s = 0; s < 4; ++s) { const bf16x8 vf = (bf16x8){f.lo[s][0], f.lo[s][1], f.lo[s][2], f.lo[s][3], f.hh[s][0], f.hh[s][1], f.hh[s][2], f.hh[s][3]}; o = MFMA32(vf, pw[s], o); }
}
template <int NDT>
__device__ __forceinline__ void pv_tile_pre(f32x16 (&o)[NDT], const bf16x8 (&pw)[4], LAS const unsigned char* vb, VFrag& f0) {
    VFrag f1;
#pragma unroll
    for (int dt = 0; dt < NDT; dt += 2) {
        if (dt + 1 < NDT) vfrag_read(f1, vb, dt + 1);
        __builtin_amdgcn_sched_barrier(0);
        vfrag_mma(o[dt], f0, pw);
        if (dt + 1 < NDT) {
            if (dt + 2 < NDT) vfrag_read(f0, vb, dt + 2);
            __builtin_amdgcn_sched_barrier(0);
            vfrag_mma(o[dt + 1], f1, pw);
        }
    }
}
template <int NDT>
__device__ __forceinline__ void pv_tile(f32x16 (&o)[NDT], const bf16x8 (&pw)[4], LAS const unsigned char* vt, int lane) {
    LAS const unsigned char* vb = vfrag_base(vt, lane);
    VFrag f0; vfrag_read(f0, vb, 0);
    pv_tile_pre<NDT>(o, pw, vb, f0);
}
constexpr float SM_THR = 8.0f;
__device__ __forceinline__ float max3f(float a, float b, float c) { return __builtin_fmaxf(__builtin_fmaxf(a, b), c); }
__device__ __forceinline__ float halfmax(float m) { auto rr = __builtin_amdgcn_permlane32_swap(__float_as_uint(m), __float_as_uint(m), false, false); return fmaxf(__uint_as_float(rr[0]), __uint_as_float(rr[1])); }
__device__ __forceinline__ float halfsum(float v) { auto rr = __builtin_amdgcn_permlane32_swap(__float_as_uint(v), __float_as_uint(v), false, false); return __uint_as_float(rr[0]) + __uint_as_float(rr[1]); }
#ifndef SM_VPRE
#define SM_VPRE false
#endif
template <int NDT>
__device__ __forceinline__ void softmax_pv(AState<NDT>& st, f32x16& p0, f32x16& p1, LAS const unsigned char* vt, int lane) {
    LAS const unsigned char* vb = vfrag_base(vt, lane);
    constexpr bool VPRE = SM_VPRE;
    VFrag f0; if (VPRE) { vfrag_read(f0, vb, 0); __builtin_amdgcn_sched_barrier(0); }
    float ma = max3f(p0[0], p0[1], p0[2]), mb = max3f(p1[0], p1[1], p1[2]);
#pragma unroll
    for (int r = 3; r < 15; r += 2) { ma = max3f(ma, p0[r], p0[r + 1]); mb = max3f(mb, p1[r], p1[r + 1]); }
    float mx = max3f(ma, mb, fmaxf(p0[15], p1[15]));
    mx = halfmax(mx);
    if (__any(mx > SM_THR)) {
        const float d = fmaxf(mx, 0.f), alpha = __builtin_amdgcn_exp2f(-d); st.m += d; st.l *= alpha;
#pragma unroll
        for (int r = 0; r < 16; ++r) { p0[r] -= d; p1[r] -= d; }
#pragma unroll
        for (int dt = 0; dt < NDT; ++dt)
#pragma unroll
            for (int r = 0; r < 16; ++r) st.o[dt][r] *= alpha;
    }
    float rs = 0.f;
#pragma unroll
    for (int r = 0; r < 16; ++r) { p0[r] = __builtin_amdgcn_exp2f(p0[r]); p1[r] = __builtin_amdgcn_exp2f(p1[r]); rs += p0[r] + p1[r]; }
    st.l += rs;
    bf16x8 pw[4]; pack_p(pw, p0, p1);
    if (!VPRE) vfrag_read(f0, vb, 0);
    pv_tile_pre<NDT>(st.o, pw, vb, f0);
}
__device__ __forceinline__ void softmax_stats(float& m, float& l, const f32x16& p0, const f32x16& p1) {
    float mx = fmaxf(p0[0], p1[0]);
#pragma unroll
    for (int r = 1; r < 16; ++r) mx = fmaxf(mx, fmaxf(p0[r], p1[r]));
    mx = halfmax(mx);
    const float mn = fmaxf(m, mx), alpha = __builtin_amdgcn_exp2f(m - mn); m = mn;
    float rs = 0.f;
#pragma unroll
    for (int r = 0; r < 16; ++r) rs += __builtin_amdgcn_exp2f(p0[r] - mn) + __builtin_amdgcn_exp2f(p1[r] - mn);
    l = l * alpha + rs;
}

template <int KCH, int VCH> struct Stage { u32x4 k[KCH / 8], v[VCH / 8], x; };
template <int KCH, int VCH, bool XROW>
__device__ __forceinline__ void stage_load(Stage<KCH, VCH>& sg, const bf16* ksrc, const bf16* vsrc, const float* xsrc, size_t pitch, int key0, int tid) {
#pragma unroll
    for (int i = 0; i < KCH / 8; ++i) { const int idx = tid + 512 * i, key = idx / KCH, c = idx % KCH; sg.k[i] = *(const u32x4*)(ksrc + (size_t)(key0 + key) * pitch + 8 * c); }
#pragma unroll
    for (int i = 0; i < VCH / 8; ++i) { const int idx = tid + 512 * i, key = idx / VCH, c = idx % VCH; sg.v[i] = *(const u32x4*)(vsrc + (size_t)(key0 + key) * pitch + 8 * c); }
    if (XROW) sg.x = *(const u32x4*)(xsrc + key0 + 4 * (tid & 15));
}
template <int KCH, int VCH, bool XROW>
__device__ __forceinline__ void stage_write(const Stage<KCH, VCH>& sg, LAS unsigned char* kb, LAS unsigned char* vb, LAS unsigned char* xb, int tid) {
#pragma unroll
    for (int i = 0; i < KCH / 8; ++i) { const int idx = tid + 512 * i, key = idx / KCH, c = idx % KCH; *(LAS u32x4*)(kb + koff(key, c)) = sg.k[i]; }
#pragma unroll
    for (int i = 0; i < VCH / 8; ++i) { const int idx = tid + 512 * i, key = idx / VCH, c = idx % VCH; *(LAS u32x4*)(vb + voff(key, c)) = sg.v[i]; }
    if (XROW) { if (tid < 16) { f32x4 xv = __builtin_bit_cast(f32x4, sg.x); xv = xv * LOG2E; *(LAS f32x4*)(xb + 16 * tid) = xv; } }
}

template <int KCH, int VCH, bool XROW, int NST  , bool QLDS, class Fn>
__device__ __forceinline__ void kv_loop(Fn& fn, const bf16x8 (&qf)[4], LAS const unsigned char* qb, int kchunk0, const bf16* ksrc, const bf16* vsrc, const float* xsrc, size_t pitch, int t_lo, int t_hi,
                                        LAS unsigned char* KB, LAS unsigned char* VB, LAS unsigned char* XB, int tid, int lane) {
    constexpr int KBYTES = KCH * 1024, VBYTES = VCH * 1024;
    const int r32 = lane & 31, hi = lane >> 5, nt = t_hi - t_lo;
    if (NST == 1) {
        Stage<KCH, VCH> sg;
        stage_load<KCH, VCH, XROW>(sg, ksrc, vsrc, xsrc, pitch, 64 * t_lo, tid);
        stage_write<KCH, VCH, XROW>(sg, KB, VB, XB, tid);
        __syncthreads();
        for (int i = 0; i < nt; ++i) {
            const int b = i & 1;
            if (i + 1 < nt) stage_load<KCH, VCH, XROW>(sg, ksrc, vsrc, xsrc, pitch, 64 * (t_lo + i + 1), tid);
            if (fn.need(t_lo + i)) { f32x16 p0, p1; qk_tile<QLDS>(p0, p1, KB + b * KBYTES, kchunk0, qf, qb, r32, hi); fn.tile(t_lo + i, p0, p1, VB + b * VBYTES, XB + b * 256); }
            if (i + 1 < nt) stage_write<KCH, VCH, XROW>(sg, KB + (b ^ 1) * KBYTES, VB + (b ^ 1) * VBYTES, XB + (b ^ 1) * 256, tid);
            __syncthreads();
        }
        return;
    }
    Stage<KCH, VCH> sgA, sgB;
    stage_load<KCH, VCH, XROW>(sgA, ksrc, vsrc, xsrc, pitch, 64 * t_lo, tid);
    if (nt > 1) stage_load<KCH, VCH, XROW>(sgB, ksrc, vsrc, xsrc, pitch, 64 * (t_lo + 1), tid);
    stage_write<KCH, VCH, XROW>(sgA, KB, VB, XB, tid);
    __syncthreads();
    for (int i = 0; i < nt; i += 2) {
        if (i + 2 < nt) stage_load<KCH, VCH, XROW>(sgA, ksrc, vsrc, xsrc, pitch, 64 * (t_lo + i + 2), tid);
        if (fn.need(t_lo + i)) { f32x16 p0, p1; qk_tile<QLDS>(p0, p1, KB, kchunk0, qf, qb, r32, hi); fn.tile(t_lo + i, p0, p1, VB, XB); }
        if (i + 1 < nt) stage_write<KCH, VCH, XROW>(sgB, KB + KBYTES, VB + VBYTES, XB + 256, tid);
        __syncthreads();
        if (i + 1 >= nt) break;
        if (i + 3 < nt) stage_load<KCH, VCH, XROW>(sgB, ksrc, vsrc, xsrc, pitch, 64 * (t_lo + i + 3), tid);
        if (fn.need(t_lo + i + 1)) { f32x16 p0, p1; qk_tile<QLDS>(p0, p1, KB + KBYTES, kchunk0, qf, qb, r32, hi); fn.tile(t_lo + i + 1, p0, p1, VB + VBYTES, XB + 256); }
        if (i + 2 < nt) stage_write<KCH, VCH, XROW>(sgA, KB, VB, XB, tid);
        __syncthreads();
    }
}

#define SGB(mask, n) __builtin_amdgcn_sched_group_barrier(mask, n, 0)
template <int NDT>
__device__ __forceinline__ void sp_finish(AState<NDT>& st, f32x16& s0, f32x16& s1, bf16x8 (&pw)[4]) {
    float rs = 0.f;
#pragma unroll
    for (int r = 0; r < 16; ++r) { s0[r] = __builtin_amdgcn_exp2f(s0[r]); s1[r] = __builtin_amdgcn_exp2f(s1[r]); rs += s0[r] + s1[r]; }
    st.l += rs;
    pack_p(pw, s0, s1);
}
__device__ __forceinline__ float sp_rowmax(const f32x16& p0, const f32x16& p1) {
    float ma = max3f(p0[0], p0[1], p0[2]), mb = max3f(p1[0], p1[1], p1[2]);
#pragma unroll
    for (int r = 3; r < 15; r += 2) { ma = max3f(ma, p0[r], p0[r + 1]); mb = max3f(mb, p1[r], p1[r + 1]); }
    return max3f(ma, mb, fmaxf(p0[15], p1[15]));
}
template <int NDT>
__device__ __forceinline__ void sp_raise(AState<NDT>& st, f32x16& p0, f32x16& p1, float mx) {
    mx = halfmax(mx);
    if (__any(mx > SM_THR)) {
        const float d = fmaxf(mx, 0.f), alpha = __builtin_amdgcn_exp2f(-d); st.m += d; st.l *= alpha;
#pragma unroll
        for (int r = 0; r < 16; ++r) { p0[r] -= d; p1[r] -= d; }
#pragma unroll
        for (int dt = 0; dt < NDT; ++dt)
#pragma unroll
            for (int r = 0; r < 16; ++r) st.o[dt][r] *= alpha;
    }
}
__device__ __forceinline__ void sp_finish_part(int j, float& rs, f32x16& s0, f32x16& s1, u32x4 (&pu)[4]) {
#pragma unroll
    for (int r = 4 * j; r < 4 * j + 4; ++r) { s0[r] = __builtin_amdgcn_exp2f(s0[r]); s1[r] = __builtin_amdgcn_exp2f(s1[r]); rs += s0[r] + s1[r]; }
    const unsigned a0 = cvtpk(s0[4 * j], s0[4 * j + 1]), a1 = cvtpk(s0[4 * j + 2], s0[4 * j + 3]), b0 = cvtpk(s1[4 * j], s1[4 * j + 1]), b1 = cvtpk(s1[4 * j + 2], s1[4 * j + 3]);
    if (j & 1) { pu[j >> 1].z = a0; pu[j >> 1].w = a1; pu[2 + (j >> 1)].z = b0; pu[2 + (j >> 1)].w = b1; }
    else       { pu[j >> 1].x = a0; pu[j >> 1].y = a1; pu[2 + (j >> 1)].x = b0; pu[2 + (j >> 1)].y = b1; }
}
#define SP_STEADY(T, KBUF, XBUF, SP0, SP1, SN0, SN1)                                                                                                    \
    {   bf16x8 ka[4], kb[4], q[4];                                                                                                                      \
        _Pragma("unroll") for (int d0 = 0; d0 < 4; ++d0) { const int c = kchunk0 + 2 * d0 + hi;                                                         \
            ka[d0] = *(const LAS bf16x8*)((KBUF) + koff(r32, c)); kb[d0] = *(const LAS bf16x8*)((KBUF) + koff(r32 + 32, c));                             \
            q[d0] = QLDS ? *(const LAS bf16x8*)(qb + d0 * 8192) : qf[d0]; }                                                                             \
        LAS const unsigned char* vb = vfrag_base(VB + vp * VBYTES, lane);                                                                               \
        VFrag f0, f1; u32x4 pu[4]; float rs = 0.f;                                                                                                      \
        __builtin_amdgcn_sched_barrier(0);                                                                                                              \
        SN0 = (f32x16){}; SN1 = (f32x16){};                                                                                                             \
        _Pragma("unroll") for (int j = 0; j < 4; ++j) {                                                                                                 \
            SN0 = MFMA32(ka[j], q[j], SN0); SN1 = MFMA32(kb[j], q[j], SN1);                                                                             \
            sp_finish_part(j, rs, SP0, SP1, pu);                                                                                                        \
            if (NDT == 2 && j == 2) vfrag_read(f0, vb, 0);                                                                                              \
            if (NDT == 2 && j == 3) vfrag_read(f1, vb, 1);                                                                                              \
            __builtin_amdgcn_sched_barrier(0);                                                                                                          \
        }                                                                                                                                               \
        fn.st.l += rs;                                                                                                                                  \
        _Pragma("unroll") for (int k = 0; k < 4; ++k) pw[k] = __builtin_bit_cast(bf16x8, pu[k]);                                                        \
        float mx = NEG;                                                                                                                                 \
        _Pragma("unroll") for (int dt = 0; dt < NDT; dt += 2) {                                                                                         \
            if (NDT != 2) { vfrag_read(f0, vb, dt); vfrag_read(f1, vb, dt + 1); __builtin_amdgcn_sched_barrier(0); }                                    \
            _Pragma("unroll") for (int sx = 0; sx < 4; ++sx) {                                                                                          \
                { const bf16x8 vf = (bf16x8){f0.lo[sx][0], f0.lo[sx][1], f0.lo[sx][2], f0.lo[sx][3], f0.hh[sx][0], f0.hh[sx][1], f0.hh[sx][2], f0.hh[sx][3]}; fn.st.o[dt] = MFMA32(vf, pw[sx], fn.st.o[dt]); } \
                { const bf16x8 vf = (bf16x8){f1.lo[sx][0], f1.lo[sx][1], f1.lo[sx][2], f1.lo[sx][3], f1.hh[sx][0], f1.hh[sx][1], f1.hh[sx][2], f1.hh[sx][3]}; fn.st.o[dt + 1] = MFMA32(vf, pw[sx], fn.st.o[dt + 1]); } \
                if (dt == 0) { fn.score_part(sx, T, SN0, SN1, XBUF); mx = fn.max_part(sx, mx, SN0, SN1); }                                              \
                __builtin_amdgcn_sched_barrier(0);                                                                                                      \
            }                                                                                                                                           \
        }                                                                                                                                               \
        mx = fn.score_mask(T, mx, SN0, SN1);                                                                                                            \
        sp_raise<NDT>(fn.st, SN0, SN1, mx); }
template <int KCH, int VCH, bool XROW, bool QLDS, int NDT, class Fn>
__device__ __forceinline__ void kv_loop_sp(Fn& fn, const bf16x8 (&qf)[4], LAS const unsigned char* qb, int kchunk0, const bf16* ksrc, const bf16* vsrc, const float* xsrc, size_t pitch, int t_lo, int t_hi, int nw,
                                           LAS unsigned char* KB, LAS unsigned char* VB, LAS unsigned char* XB, int tid, int lane) {
    constexpr int KBYTES = KCH * 1024, VBYTES = VCH * 1024;
    const int r32 = lane & 31, hi = lane >> 5, nt = t_hi - t_lo;
    Stage<KCH, VCH> sg;
    stage_load<KCH, VCH, XROW>(sg, ksrc, vsrc, xsrc, pitch, 64 * t_lo, tid);
    stage_write<KCH, VCH, XROW>(sg, KB, VB, XB, tid);
    __syncthreads();
    f32x16 sa0, sa1, sb0, sb1; bf16x8 pw[4];
    int vc = 0, vp = 2, vn, i = 0;
#define SP_PRE(I)  if ((I) + 1 < nt) stage_load<KCH, VCH, XROW>(sg, ksrc, vsrc, xsrc, pitch, 64 * (t_lo + (I) + 1), tid);
#define SP_POST(I, KOFFN, XOFFN) vn = vc == 2 ? 0 : vc + 1; if ((I) + 1 < nt) stage_write<KCH, VCH, XROW>(sg, KB + (KOFFN), VB + vn * VBYTES, XB + (XOFFN), tid); __syncthreads(); vp = vc; vc = vn;
    SP_PRE(0)
    qk_tile<QLDS>(sa0, sa1, KB, kchunk0, qf, qb, r32, hi); fn.score(t_lo, sa0, sa1, XB); sp_raise<NDT>(fn.st, sa0, sa1, sp_rowmax(sa0, sa1));
    SP_POST(0, KBYTES, 256)
    i = 1;
    while (i + 1 < nw) {
        SP_PRE(i)
        SP_STEADY(t_lo + i, KB + KBYTES, XB + 256, sa0, sa1, sb0, sb1)
        SP_POST(i, 0, 0)
        SP_PRE(i + 1)
        SP_STEADY(t_lo + i + 1, KB, XB, sb0, sb1, sa0, sa1)
        SP_POST(i + 1, KBYTES, 256)
        i += 2;
    }
    if (i < nw) {
        SP_PRE(i)
        SP_STEADY(t_lo + i, KB + KBYTES, XB + 256, sa0, sa1, sb0, sb1)
        SP_POST(i, 0, 0)
        sa0 = sb0; sa1 = sb1; ++i;
    }
    if (i < nt) { SP_PRE(i) }
    sp_finish<NDT>(fn.st, sa0, sa1, pw); pv_tile<NDT>(fn.st.o, pw, VB + vp * VBYTES, lane);
    if (i < nt) { const int ko = (i & 1) ? 0 : KBYTES, xo = (i & 1) ? 0 : 256; SP_POST(i, ko, xo) ++i; }
    while (i < nt) { const int ko = (i & 1) ? 0 : KBYTES, xo = (i & 1) ? 0 : 256; SP_PRE(i) SP_POST(i, ko, xo) ++i; }
    __syncthreads();
#undef SP_PRE
#undef SP_POST
}

struct FoxFn {
    AState<2> st; float cq; int tq, tmin, tmax, lane;
    __device__ __forceinline__ bool need(int t) const { return 64 * t <= tmax; }
    __device__ __forceinline__ void score_part(int a, int t, f32x16& p0, f32x16& p1, LAS const unsigned char* xrow) {
        const int hi = lane >> 5; LAS const float* ck = (LAS const float*)xrow;
        const float cqm = cq - st.m;
        const f32x4 c0 = *(LAS const f32x4*)(ck + 8 * a + 4 * hi), c1 = *(LAS const f32x4*)(ck + 32 + 8 * a + 4 * hi);
#pragma unroll
        for (int i = 0; i < 4; ++i) { const int r = 4 * a + i; p0[r] = p0[r] * SCL2 + (cqm - c0[i]); p1[r] = p1[r] * SCL2 + (cqm - c1[i]); }
    }
    __device__ __forceinline__ float max_part(int a, float mx, const f32x16& p0, const f32x16& p1) const {
        return max3f(max3f(mx, p0[4 * a], p0[4 * a + 1]), max3f(p0[4 * a + 2], p0[4 * a + 3], p1[4 * a]), max3f(p1[4 * a + 1], p1[4 * a + 2], p1[4 * a + 3])); }
    __device__ __forceinline__ float score_mask(int t, float mx, f32x16& p0, f32x16& p1) const {
        const int hi = lane >> 5, k0 = 64 * t;
        if (k0 + 63 > tmin) {
#pragma unroll
            for (int r = 0; r < 16; ++r) { const int key = k0 + crow(r, hi); p0[r] = key <= tq ? p0[r] : NEG; p1[r] = key + 32 <= tq ? p1[r] : NEG; }
            mx = sp_rowmax(p0, p1);
        }
        return mx;
    }
    __device__ __forceinline__ void score(int t, f32x16& p0, f32x16& p1, LAS const unsigned char* xrow) {
#pragma unroll
        for (int a = 0; a < 4; ++a) score_part(a, t, p0, p1, xrow);
        score_mask(t, 0.f, p0, p1);
    }
};
__device__ __forceinline__ void fox_unit(int h, int qb, const bf16* PROJ, const float* CUM, bf16* MIX, LAS unsigned char* lds, int tid, int wid, int lane) {
    const int r32 = lane & 31, hi = lane >> 5, q0 = 256 * qb, tq = q0 + 32 * wid + r32;
    bf16x8 qf[4];
#pragma unroll
    for (int d0 = 0; d0 < 4; ++d0) qf[d0] = *(const bf16x8*)(PROJ + (size_t)tq * PITCH + C_BQ + 64 * h + 16 * d0 + 8 * hi);
    const float* cum = CUM + (size_t)h * S;
    FoxFn fn; astate_init<2>(fn.st); fn.cq = cum[tq] * LOG2E; fn.tq = tq; fn.tmin = q0 + 32 * wid; fn.tmax = q0 + 32 * wid + 31; fn.lane = lane;
    kv_loop_sp<8, 8, true, false, 2>(fn, qf, lds, 0, PROJ + C_BK + 64 * h, PROJ + C_BV + 64 * h, cum, PITCH, 0, 4 * (qb + 1), min(4 * (qb + 1), (fn.tmax >> 6) + 1), lds, lds + 16384, lds + 40960, tid, lane);
    const float lt = fn.st.l + __shfl_xor(fn.st.l, 32), inv = 1.0f / lt;
    bf16* orow = MIX + (size_t)tq * D + 512 + 64 * h;
#pragma unroll
    for (int dt = 0; dt < 2; ++dt)
#pragma unroll
        for (int a = 0; a < 4; ++a) { u32x2 w; w.x = cvtpk(fn.st.o[dt][4 * a] * inv, fn.st.o[dt][4 * a + 1] * inv); w.y = cvtpk(fn.st.o[dt][4 * a + 2] * inv, fn.st.o[dt][4 * a + 3] * inv);
            *(u32x2*)(orow + 32 * dt + 8 * a + 4 * hi) = w; }
}

struct DiffFn {
    AState<4> st; LAS const float* lut; int tq, tmin, tmax, lane;
    __device__ __forceinline__ bool need(int t) const { return 64 * t <= tmax; }
    __device__ __forceinline__ void tile(int t, f32x16& p0, f32x16& p1, LAS const unsigned char* vt, LAS const unsigned char*) {
        const int hi = lane >> 5, k0 = 64 * t;
        const float mref = st.m;
        if (k0 + 63 + 127 <= tmin) {
            const float b = lut[127] - mref;
#pragma unroll
            for (int r = 0; r < 16; ++r) { p0[r] = p0[r] * SCL2 + b; p1[r] = p1[r] * SCL2 + b; }
        } else {
#pragma unroll
            for (int r = 0; r < 16; ++r) { const int rel0 = tq - (k0 + crow(r, hi)); const float b0 = lut[min(max(rel0, 0), 127)] - mref; p0[r] = rel0 >= 0 ? p0[r] * SCL2 + b0 : NEG; }
            __builtin_amdgcn_sched_barrier(0);
#pragma unroll
            for (int r = 0; r < 16; ++r) { const int rel1 = tq - (k0 + 32 + crow(r, hi)); const float b1 = lut[min(max(rel1, 0), 127)] - mref; p1[r] = rel1 >= 0 ? p1[r] * SCL2 + b1 : NEG; }
            __builtin_amdgcn_sched_barrier(0);
        }
        softmax_pv<4>(st, p0, p1, vt, lane);
    }
};
__device__ __forceinline__ void diff_unit(int h, int qb, int l, const Args& a, const bf16* PROJ, bf16* MIX, LAS unsigned char* lds, int tid, int wid, int lane) {
    const int r32 = lane & 31, hi = lane >> 5, q0 = 128 * qb, map = wid & 1, qs = wid >> 1, tq = q0 + 32 * qs + r32;
    LAS float* lut = (LAS float*)(lds + 65536); LAS float* lamw = (LAS float*)(lds + 65536 + 512);
    const float lam_init = 0.8f - 0.6f * expf(-0.3f * (float)l);
    if (tid < 128) lut[tid] = a.in[12][t5_bucket(tid) * 20 + h] * LOG2E;
    if (wid == 0) { const float* dl = a.in[3] + (size_t)l * 256;
        const float s1 = wave_sum(dl[lane] * dl[64 + lane]), s2 = wave_sum(dl[128 + lane] * dl[192 + lane]);
        if (lane == 0) lamw[0] = expf(s1) - expf(s2) + lam_init; }
    bf16x8 qf[4];
#pragma unroll
    for (int d0 = 0; d0 < 4; ++d0) qf[d0] = *(const bf16x8*)(PROJ + (size_t)tq * PITCH + C_AQ + 128 * h + 64 * map + 16 * d0 + 8 * hi);
    DiffFn fn; astate_init<4>(fn.st); fn.lut = lut; fn.tq = tq; fn.tmin = q0 + 32 * qs; fn.tmax = q0 + 32 * qs + 31; fn.lane = lane;
    LAS unsigned char* const qlds = lds + 67584 + tid * 16;
#pragma unroll
    for (int d0 = 0; d0 < 4; ++d0) *(LAS bf16x8*)(qlds + d0 * 8192) = qf[d0];
    kv_loop<16, 16, false, 1, true>(fn, qf, qlds, 8 * map, PROJ + C_AK + 128 * h, PROJ + C_AV + 128 * h, nullptr, PITCH, 0, 2 * (qb + 1), lds, lds + 32768, lds, tid, lane);
    const float lt = fn.st.l + __shfl_xor(fn.st.l, 32), inv = 1.0f / lt;
    LAS float* ex = (LAS float*)(lds + qs * 16384);
    if (map == 1) {
#pragma unroll
        for (int dt = 0; dt < 4; ++dt)
#pragma unroll
            for (int r = 0; r < 16; ++r) ex[(32 * dt + crow(r, hi)) * 32 + r32] = fn.st.o[dt][r] * inv;
    }
    __syncthreads();
    if (map == 0) {
        const float lam = lamw[0]; float ss = 0.f;
#pragma unroll
        for (int dt = 0; dt < 4; ++dt)
#pragma unroll
            for (int r = 0; r < 16; ++r) { const float v = fn.st.o[dt][r] * inv - lam * ex[(32 * dt + crow(r, hi)) * 32 + r32]; fn.st.o[dt][r] = v; ss += v * v; }
        ss += __shfl_xor(ss, 32);
        const float rstd = (1.0f / sqrtf(ss * (1.0f / 128.0f) + RMS_EPS)) * (1.0f - lam_init);
        const float* sub = a.in[4] + (size_t)l * 128; bf16* orow = MIX + (size_t)tq * D + 128 * h;
#pragma unroll
        for (int dt = 0; dt < 4; ++dt)
#pragma unroll
            for (int q4 = 0; q4 < 4; ++q4) { const int d = 32 * dt + 8 * q4 + 4 * hi; const f32x4 g = *(const f32x4*)(sub + d);
                u32x2 w; w.x = cvtpk(fn.st.o[dt][4 * q4] * rstd * g.x, fn.st.o[dt][4 * q4 + 1] * rstd * g.y); w.y = cvtpk(fn.st.o[dt][4 * q4 + 2] * rstd * g.z, fn.st.o[dt][4 * q4 + 3] * rstd * g.w);
                *(u32x2*)(orow + d) = w; }
    }
    __syncthreads();
}

#ifndef NSA_DUP
#define NSA_DUP 0
#endif
constexpr int IMP_P = 132;
__device__ __forceinline__ float quad_sum(float v) {
    v += __builtin_bit_cast(float, __builtin_amdgcn_mov_dpp(__builtin_bit_cast(int, v), 0xB1, 0xF, 0xF, true));
    v += __builtin_bit_cast(float, __builtin_amdgcn_mov_dpp(__builtin_bit_cast(int, v), 0x4E, 0xF, 0xF, true));
    return v; }
#define LADD(p, v) (void)__hip_atomic_fetch_add((p), (v), __ATOMIC_RELAXED, __HIP_MEMORY_SCOPE_WORKGROUP)
constexpr int NSA_QF = 32768, NSA_SELW = 65536, NSA_LUT = 66560, NSA_IMP = 69632, NSA_FIN = 69632;

struct CmpStatFn {
    float m, l; int tq, lane, ncnt;
    __device__ __forceinline__ bool need(int) const { return true; }
    __device__ __forceinline__ void tile(int t, f32x16& p0, f32x16& p1, LAS const unsigned char*, LAS const unsigned char*) {
        const int hi = lane >> 5, n0 = 64 * t;
#pragma unroll
        for (int r = 0; r < 16; ++r) { const int n = n0 + crow(r, hi);
            p0[r] = (16 * n + 31 <= tq) ? p0[r] * SCL2 : NEG; p1[r] = (16 * (n + 32) + 31 <= tq) ? p1[r] * SCL2 : NEG; }
        softmax_stats(m, l, p0, p1);
    }
};
struct CmpPvFn {
    f32x16 o[2]; float m, invl; int tq, ql, lane; LAS float* imp;
    __device__ __forceinline__ bool need(int) const { return true; }
    __device__ __forceinline__ void tile(int t, f32x16& p0, f32x16& p1, LAS const unsigned char* vt, LAS const unsigned char*) {
        const int hi = lane >> 5, n0 = 64 * t;
#pragma unroll
        for (int r = 0; r < 16; ++r) { const int n = n0 + crow(r, hi);
            p0[r] = (16 * n + 31 <= tq) ? __builtin_amdgcn_exp2f(p0[r] * SCL2 - m) * invl : 0.f;
            p1[r] = (16 * (n + 32) + 31 <= tq) ? __builtin_amdgcn_exp2f(p1[r] * SCL2 - m) * invl : 0.f; }
        LAS float* row = imp + ql * IMP_P;
        const bool lead = (lane & 3) == 0;
#pragma unroll
        for (int a = 0; a < 4; ++a) {
            const int j0 = (n0 >> 2) + 2 * a + hi, j1 = j0 + 8;
            const float h0 = quad_sum(0.5f * p0[4 * a + 3]), h1 = quad_sum(0.5f * p1[4 * a + 3]);
            const float b0 = quad_sum(p0[4 * a] + p0[4 * a + 1] + p0[4 * a + 2]) + h0, b1 = quad_sum(p1[4 * a] + p1[4 * a + 1] + p1[4 * a + 2]) + h1;
            if (lead) {
                LADD(row + j0, b0);
                if (j0 + 1 < 128) LADD(row + j0 + 1, h0);
                if (j1 < 128) LADD(row + j1, b1);
                if (j1 + 1 < 128) LADD(row + j1 + 1, h1);
            }
        }
        bf16x8 pw[4]; pack_p(pw, p0, p1);
        pv_tile<2>(o, pw, vt, lane);
    }
};
struct SelFn {
    AState<2> st; LAS const float* lut; int tq, tmin, tmax, lane, mode; unsigned sw0, sw1, sw2, sw3, uw0, uw1, uw2, uw3;
    __device__ __forceinline__ unsigned pick(int j, unsigned a, unsigned b, unsigned c, unsigned d) const { const int w = j >> 5; const unsigned x = (w == 0) ? a : (w == 1) ? b : (w == 2) ? c : d; return (x >> (j & 31)) & 1u; }
    __device__ __forceinline__ bool need(int t) const { return mode == 1 || pick(t, uw0, uw1, uw2, uw3) != 0u; }
    __device__ __forceinline__ void tile(int t, f32x16& p0, f32x16& p1, LAS const unsigned char* vt, LAS const unsigned char*) {
        const int hi = lane >> 5, k0 = 64 * t;
        const bool bit = (mode == 1) || pick(t, sw0, sw1, sw2, sw3) != 0u;
        const bool far = k0 + 63 + 127 <= tmin;
        const bool wcut = (mode == 1) && (tmax - k0 >= 512);
        const float mref = st.m;
        if (far && !wcut) {
            const float b = lut[127] - mref;
#pragma unroll
            for (int r = 0; r < 16; ++r) { p0[r] = bit ? p0[r] * SCL2 + b : NEG; p1[r] = bit ? p1[r] * SCL2 + b : NEG; }
        } else {
#pragma unroll
            for (int r = 0; r < 16; ++r) { const int rel0 = tq - (k0 + crow(r, hi));
                const float b0 = lut[min(max(rel0, 0), 127)] - mref;
                const bool ok0 = bit && rel0 >= 0 && (mode == 0 || rel0 < 512);
                p0[r] = ok0 ? p0[r] * SCL2 + b0 : NEG; }
            __builtin_amdgcn_sched_barrier(0);
#pragma unroll
            for (int r = 0; r < 16; ++r) { const int rel1 = tq - (k0 + 32 + crow(r, hi));
                const float b1 = lut[min(max(rel1, 0), 127)] - mref;
                const bool ok1 = bit && rel1 >= 0 && (mode == 0 || rel1 < 512);
                p1[r] = ok1 ? p1[r] * SCL2 + b1 : NEG; }
            __builtin_amdgcn_sched_barrier(0);
        }
        softmax_pv<2>(st, p0, p1, vt, lane);
    }
};

__device__ __forceinline__ void nsa_unit(int g, int qb, const Args& a, const bf16* PROJ, const float* AUX, const bf16* KC, const bf16* VC, bf16* MIX, LAS unsigned char* lds, int tid, int wid, int lane) {
    const int r32 = lane & 31, hi = lane >> 5, q0 = 64 * qb, cur = qb, ql = 8 * wid + (r32 >> 2), hp = r32 & 3, tq = q0 + ql, head = 4 * g + hp;
    LAS float* imp = (LAS float*)(lds + NSA_IMP); LAS unsigned* selw = (LAS unsigned*)(lds + NSA_SELW); LAS float* lut = (LAS float*)(lds + NSA_LUT);
#pragma unroll
    for (int i = 0; i < 17; ++i) { const int e_ = tid + 512 * i; if (e_ < 64 * IMP_P) imp[e_] = 0.f; }
    if (tid < 256) selw[tid] = 0u;
    lut[tid] = a.in[12][t5_bucket(tid & 127) * 20 + 4 + 4 * g + (tid >> 7)] * LOG2E;
    bf16x8 qf[4];
#pragma unroll
    for (int d0 = 0; d0 < 4; ++d0) qf[d0] = *(const bf16x8*)(PROJ + (size_t)tq * PITCH + C_CQ + 64 * head + 16 * d0 + 8 * hi);
    LAS unsigned char* const qlds = lds + NSA_QF + tid * 16;
#pragma unroll
    for (int d0 = 0; d0 < 4; ++d0) *(LAS bf16x8*)(qlds + d0 * 8192) = qf[d0];
    const float* ga = AUX + (size_t)tq * 64 + 8 + head;
    const float gc = 1.0f / (1.0f + __expf(-ga[0])), gs = 1.0f / (1.0f + __expf(-ga[16])), gwn = 1.0f / (1.0f + __expf(-ga[32]));
    LAS float* finl = (LAS float*)(lds + NSA_FIN) + tid;
    f32x16 oc0, oc1;
    {
        int ncnt = (q0 + 32) / 16 + 1; ncnt = ncnt > 511 ? 511 : ncnt; const int ntc = (ncnt + 63) >> 6;
        const bf16* kc = KC + (size_t)g * 512 * 64; const bf16* vc = VC + (size_t)g * 512 * 64;
        CmpStatFn f1; f1.m = NEG; f1.l = 0.f; f1.tq = tq; f1.lane = lane; f1.ncnt = ncnt;
        kv_loop<8, 8, false, 1, true>(f1, qf, qlds, 0, kc, vc, nullptr, 64, 0, ntc, lds, lds + 16384, lds, tid, lane);
        if (NSA_DUP & 1) { f1.m = NEG; f1.l = 0.f; kv_loop<8, 8, false, 1, true>(f1, qf, qlds, 0, kc, vc, nullptr, 64, 0, ntc, lds, lds + 16384, lds, tid, lane); }
        const float lt = f1.l + __shfl_xor(f1.l, 32);
        CmpPvFn f2; f2.o[0] = (f32x16){}; f2.o[1] = (f32x16){}; f2.m = f1.m; f2.invl = (tq >= 31) ? 1.0f / lt : 0.f; f2.tq = tq; f2.ql = ql; f2.lane = lane; f2.imp = imp;
        if (NSA_DUP & 16) { kv_loop<8, 8, false, 1, true>(f2, qf, qlds, 0, kc, vc, nullptr, 64, 0, ntc, lds, lds + 16384, lds, tid, lane); f2.o[0] = (f32x16){}; f2.o[1] = (f32x16){};
#pragma unroll
            for (int i = 0; i < 17; ++i) { const int e_ = tid + 512 * i; if (e_ < 64 * IMP_P) imp[e_] = 0.f; }
            __syncthreads(); }
        kv_loop<8, 8, false, 1, true>(f2, qf, qlds, 0, kc, vc, nullptr, 64, 0, ntc, lds, lds + 16384, lds, tid, lane);
        oc0 = f2.o[0]; oc1 = f2.o[1];
    }
    for (int rep_ = 0; rep_ < ((NSA_DUP & 2) ? 2 : 1); ++rep_)
    if (cur < 16) { if (tid < 64) selw[tid * 4] = (2u << cur) - 1u; }
    else {
        const int qq = tid >> 3, sub = tid & 7;
        float val[16];
#pragma unroll
        for (int i = 0; i < 16; ++i) { const int j = 16 * sub + i; val[i] = (j >= 1 && j <= cur - 2) ? imp[qq * IMP_P + j] : -1.0f; }
        unsigned bits = 0u;
        for (int round = 0; round < 13; ++round) {
            float bv = val[0]; int bi = 0;
#pragma unroll
            for (int i = 1; i < 16; ++i) if (val[i] > bv) { bv = val[i]; bi = i; }
            int gj = 16 * sub + bi;
            { const float ov = __builtin_bit_cast(float, __builtin_amdgcn_mov_dpp(__builtin_bit_cast(int, bv), 0xB1, 0xF, 0xF, true)); const int oj = __builtin_amdgcn_mov_dpp(gj, 0xB1, 0xF, 0xF, true); if (ov > bv || (ov == bv && oj < gj)) { bv = ov; gj = oj; } }
            { const float ov = __builtin_bit_cast(float, __builtin_amdgcn_mov_dpp(__builtin_bit_cast(int, bv), 0x4E, 0xF, 0xF, true)); const int oj = __builtin_amdgcn_mov_dpp(gj, 0x4E, 0xF, 0xF, true); if (ov > bv || (ov == bv && oj < gj)) { bv = ov; gj = oj; } }
            { const float ov = __shfl_xor(bv, 4); const int oj = __shfl_xor(gj, 4); if (ov > bv || (ov == bv && oj < gj)) { bv = ov; gj = oj; } }
            const bool mine = (gj >> 4) == sub;
#pragma unroll
            for (int i = 0; i < 16; ++i) if (mine && (gj & 15) == i) { val[i] = -2.0f; bits |= 1u << i; }
        }
        if (sub == 0) bits |= 1u;
        if (((cur - 1) >> 4) == sub) bits |= 1u << ((cur - 1) & 15);
        if ((cur >> 4) == sub) bits |= 1u << (cur & 15);
        (void)__hip_atomic_fetch_or(selw + qq * 4 + (sub >> 1), bits << (16 * (sub & 1)), __ATOMIC_RELAXED, __HIP_MEMORY_SCOPE_WORKGROUP);
    }
    __syncthreads();
#pragma unroll
    for (int r = 0; r < 16; ++r) { finl[512 * r] = gc * oc0[r]; finl[512 * (16 + r)] = gc * oc1[r]; }
    SelFn fs; fs.lut = lut + hp * 128; fs.tq = tq; fs.tmin = q0 + 8 * wid; fs.tmax = q0 + 8 * wid + 7; fs.lane = lane;
    fs.sw0 = selw[ql * 4 + 0]; fs.sw1 = selw[ql * 4 + 1]; fs.sw2 = selw[ql * 4 + 2]; fs.sw3 = selw[ql * 4 + 3];
    { unsigned u0 = 0u, u1 = 0u, u2 = 0u, u3 = 0u;
#pragma unroll
      for (int i = 0; i < 8; ++i) { u0 |= selw[(8 * wid + i) * 4 + 0]; u1 |= selw[(8 * wid + i) * 4 + 1]; u2 |= selw[(8 * wid + i) * 4 + 2]; u3 |= selw[(8 * wid + i) * 4 + 3]; }
      fs.uw0 = __builtin_amdgcn_readfirstlane(u0); fs.uw1 = __builtin_amdgcn_readfirstlane(u1); fs.uw2 = __builtin_amdgcn_readfirstlane(u2); fs.uw3 = __builtin_amdgcn_readfirstlane(u3); }
    fs.mode = 0; astate_init<2>(fs.st);
    kv_loop<8, 8, false, 1, false>(fs, qf, qlds, 0, PROJ + C_KS + 64 * g, PROJ + C_VS + 64 * g, nullptr, PITCH, 0, cur + 1, lds, lds + 16384, lds, tid, lane);
    if (NSA_DUP & 4) { astate_init<2>(fs.st); kv_loop<8, 8, false, 1, false>(fs, qf, qlds, 0, PROJ + C_KS + 64 * g, PROJ + C_VS + 64 * g, nullptr, PITCH, 0, cur + 1, lds, lds + 16384, lds, tid, lane); }
    { const float lt = fs.st.l + __shfl_xor(fs.st.l, 32), sc = gs / lt;
#pragma unroll
      for (int r = 0; r < 16; ++r) { finl[512 * r] += sc * fs.st.o[0][r]; finl[512 * (16 + r)] += sc * fs.st.o[1][r]; } }
    fs.mode = 1; astate_init<2>(fs.st);
    kv_loop<8, 8, false, 1, false>(fs, qf, qlds, 0, PROJ + C_KW + 64 * g, PROJ + C_VW + 64 * g, nullptr, PITCH, cur >= 8 ? cur - 8 : 0, cur + 1, lds, lds + 16384, lds, tid, lane);
    if (NSA_DUP & 8) { astate_init<2>(fs.st); kv_loop<8, 8, false, 1, false>(fs, qf, qlds, 0, PROJ + C_KW + 64 * g, PROJ + C_VW + 64 * g, nullptr, PITCH, cur >= 8 ? cur - 8 : 0, cur + 1, lds, lds + 16384, lds, tid, lane); }
    { const float lt = fs.st.l + __shfl_xor(fs.st.l, 32), sc = gwn / lt;
#pragma unroll
      for (int r = 0; r < 16; ++r) { fs.st.o[0][r] = finl[512 * r] + sc * fs.st.o[0][r]; fs.st.o[1][r] = finl[512 * (16 + r)] + sc * fs.st.o[1][r]; } }
    bf16* orow = MIX + (size_t)tq * D + 1024 + 64 * head;
#pragma unroll
    for (int dt = 0; dt < 2; ++dt)
#pragma unroll
        for (int q4 = 0; q4 < 4; ++q4) { u32x2 w; w.x = cvtpk(fs.st.o[dt][4 * q4], fs.st.o[dt][4 * q4 + 1]); w.y = cvtpk(fs.st.o[dt][4 * q4 + 2], fs.st.o[dt][4 * q4 + 3]); *(u32x2*)(orow + 32 * dt + 8 * q4 + 4 * hi) = w; }
}

__device__ __forceinline__ int dequeue(unsigned* head, volatile LAS unsigned* slot, int tid) {
    if (tid == 0) *slot = __hip_atomic_fetch_add(head, 1u, __ATOMIC_RELAXED, __HIP_MEMORY_SCOPE_AGENT);
    __syncthreads();
    const int v = __builtin_amdgcn_readfirstlane((int)*slot);
    __syncthreads();
    return v;
}

constexpr int N2_HP = 4112, N2_PART = 66 * 1024, N2_LOG = 108 * 1024;
__device__ __forceinline__ void n2_unit(int u, int l, const Args& a, const bf16* X, bf16* XN, const bf16* RWT, unsigned* cnt, int* LIST, float* TW, LAS unsigned char* lds, int tid, int wid, int lane) {
    const float* gain = a.in[14] + (size_t)l * D;
#pragma unroll
    for (int rr = 0; rr < 2; ++rr) {
        const int lr = 2 * wid + rr, row = 16 * u + lr;
        const u32x2* xr = (const u32x2*)(X + (size_t)row * D) + lane;
        f32x4 v[8]; float ss = 0.f;
#pragma unroll
        for (int j = 0; j < 8; ++j) { const u32x2 r = xr[64 * j]; v[j] = (f32x4){bflo(r.x), bfhi(r.x), bflo(r.y), bfhi(r.y)}; ss += (v[j].x * v[j].x + v[j].y * v[j].y) + (v[j].z * v[j].z + v[j].w * v[j].w); }
        ss = wave_sum(ss);
        const float rstd = 1.0f / sqrtf(ss * (1.0f / D) + RMS_EPS);
        const f32x4* gr = (const f32x4*)gain + lane; u32x2* o8 = (u32x2*)(XN + (size_t)row * D) + lane;
#pragma unroll
        for (int j = 0; j < 8; ++j) { const f32x4 g = gr[64 * j]; u32x2 w; w.x = cvtpk(v[j].x * rstd * g.x, v[j].y * rstd * g.y); w.y = cvtpk(v[j].z * rstd * g.z, v[j].w * rstd * g.w);
            o8[64 * j] = w; *(LAS u32x2*)(lds + lr * N2_HP + (4 * lane + 256 * j) * 2) = w; }
    }
    __syncthreads();
    {
        const int fr = lane & 15, fq = lane >> 4;
        f32x4 acc[5];
#pragma unroll
        for (int nt = 0; nt < 5; ++nt) acc[nt] = (f32x4){0.f, 0.f, 0.f, 0.f};
        const bf16* rw = RWT + (size_t)l * 96 * D + (size_t)fr * D + 256 * wid + 8 * fq;
#pragma unroll
        for (int s = 0; s < 8; ++s) {
            const bf16x8 av = *(const LAS bf16x8*)(lds + fr * N2_HP + (256 * wid + 32 * s + 8 * fq) * 2);
#pragma unroll
            for (int nt = 0; nt < 5; ++nt) { const bf16x8 bv = *(const bf16x8*)(rw + (size_t)(16 * nt) * D + 32 * s); acc[nt] = MFMA16(av, bv, acc[nt]); }
        }
        LAS float* part = (LAS float*)(lds + N2_PART) + wid * 16 * 80;
#pragma unroll
        for (int nt = 0; nt < 5; ++nt)
#pragma unroll
            for (int i = 0; i < 4; ++i) part[(4 * fq + i) * 80 + 16 * nt + fr] = acc[nt][i];
    }
    __syncthreads();
    {
        LAS const float* part = (LAS const float*)(lds + N2_PART); LAS float* logit = (LAS float*)(lds + N2_LOG);
        for (int e = tid; e < 16 * 80; e += NTHR) { float s = 0.f;
#pragma unroll
            for (int w = 0; w < 8; ++w) s += part[w * 16 * 80 + e];
            logit[e] = s; }
    }
    __syncthreads();
    if (tid < 16) {
        LAS const float* lg = (LAS const float*)(lds + N2_LOG) + tid * 80;
        const float* bg = a.in[16] + l * 8; const float* be = a.in[18] + l * 64;
        float z[8]; float zm = -3.0e38f; int gi = 0;
#pragma unroll
        for (int i = 0; i < 8; ++i) { z[i] = lg[i] + bg[i]; if (z[i] > zm) { zm = z[i]; gi = i; } }
        float den = 0.f;
#pragma unroll
        for (int i = 0; i < 8; ++i) den += expf(z[i] - zm);
        const float gp = 1.0f / den;
        float e1 = -3.0e38f, e2 = -3.0e38f; int i1 = 0, i2 = 0;
#pragma unroll
        for (int i = 0; i < 8; ++i) { const float v = lg[8 + 8 * gi + i] + be[8 * gi + i];
            if (v > e1) { e2 = e1; i2 = i1; e1 = v; i1 = i; } else if (v > e2) { e2 = v; i2 = i; } }
        const float t2 = expf(e2 - e1), w1 = gp / (1.0f + t2), w2 = gp * t2 / (1.0f + t2);
        const int tok = 16 * u + tid, ea = 8 * gi + i1, eb = 8 * gi + i2;
        const unsigned pa = __hip_atomic_fetch_add(cnt + ea * 16, 1u, __ATOMIC_RELAXED, __HIP_MEMORY_SCOPE_AGENT);
        const unsigned pb = __hip_atomic_fetch_add(cnt + eb * 16, 1u, __ATOMIC_RELAXED, __HIP_MEMORY_SCOPE_AGENT);
        LIST[(size_t)ea * 16384 + pa] = 2 * tok; LIST[(size_t)eb * 16384 + pb] = 2 * tok + 1;
        TW[2 * tok] = w1; TW[2 * tok + 1] = w2;
    }
    __syncthreads();
}

constexpr int N2P_HALF = 16 * N2_HP, N2P_LOG = 2 * N2P_HALF;
__device__ __forceinline__ void n2_pair(int p, int l, const Args& a, const bf16* X, bf16* XN, const bf16* RWT, unsigned* cnt, int* LIST, float* TW, LAS unsigned char* lds, int tid, int wid, int lane) {
    const int half = wid >> 2, wl = wid & 3, u = 2 * p + half, th = tid & 255;
    LAS unsigned char* const hT = lds + half * N2P_HALF;
    const float* gain = a.in[14] + (size_t)l * D;
    {
        u32x2 raw[4][8];
#pragma unroll
        for (int rr = 0; rr < 4; ++rr) { const u32x2* xr = (const u32x2*)(X + (size_t)(16 * u + 4 * wl + rr) * D) + lane;
#pragma unroll
            for (int j = 0; j < 8; ++j) raw[rr][j] = xr[64 * j]; }
        f32x4 g[8]; { const f32x4* gr = (const f32x4*)gain + lane;
#pragma unroll
            for (int j = 0; j < 8; ++j) g[j] = gr[64 * j]; }
#pragma unroll
        for (int rr = 0; rr < 4; ++rr) {
            const int lr = 4 * wl + rr, row = 16 * u + lr;
            f32x4 v[8]; float ss = 0.f;
#pragma unroll
            for (int j = 0; j < 8; ++j) { const u32x2 r = raw[rr][j]; v[j] = (f32x4){bflo(r.x), bfhi(r.x), bflo(r.y), bfhi(r.y)}; ss += (v[j].x * v[j].x + v[j].y * v[j].y) + (v[j].z * v[j].z + v[j].w * v[j].w); }
            ss = wave_sum(ss);
            const float rstd = 1.0f / sqrtf(ss * (1.0f / D) + RMS_EPS);
            u32x2* o8 = (u32x2*)(XN + (size_t)row * D) + lane;
#pragma unroll
            for (int j = 0; j < 8; ++j) { u32x2 w; w.x = cvtpk(v[j].x * rstd * g[j].x, v[j].y * rstd * g[j].y); w.y = cvtpk(v[j].z * rstd * g[j].z, v[j].w * rstd * g[j].w);
                o8[64 * j] = w; *(LAS u32x2*)(hT + lr * N2_HP + (4 * lane + 256 * j) * 2) = w; }
        }
    }
    __syncthreads();
    const int fr = lane & 15, fq = lane >> 4;
    f32x4 acc[2][5];
#pragma unroll
    for (int hh = 0; hh < 2; ++hh)
#pragma unroll
        for (int nt = 0; nt < 5; ++nt) acc[hh][nt] = (f32x4){0.f, 0.f, 0.f, 0.f};
    {
        const bf16* rw = RWT + (size_t)l * 96 * D + (size_t)fr * D + 256 * wid + 8 * fq;
#pragma unroll 4
        for (int s = 0; s < 8; ++s) {
            const bf16x8 av0 = *(const LAS bf16x8*)(lds + fr * N2_HP + (256 * wid + 32 * s + 8 * fq) * 2);
            const bf16x8 av1 = *(const LAS bf16x8*)(lds + N2P_HALF + fr * N2_HP + (256 * wid + 32 * s + 8 * fq) * 2);
#pragma unroll
            for (int nt = 0; nt < 5; ++nt) { const bf16x8 bv = *(const bf16x8*)(rw + (size_t)(16 * nt) * D + 32 * s); acc[0][nt] = MFMA16(av0, bv, acc[0][nt]); acc[1][nt] = MFMA16(av1, bv, acc[1][nt]); }
        }
    }
    __syncthreads();
    {
        LAS float* part = (LAS float*)lds + wid * 32 * 80;
#pragma unroll
        for (int hh = 0; hh < 2; ++hh)
#pragma unroll
            for (int nt = 0; nt < 5; ++nt)
#pragma unroll
                for (int i = 0; i < 4; ++i) part[(16 * hh + 4 * fq + i) * 80 + 16 * nt + fr] = acc[hh][nt][i];
    }
    __syncthreads();
    {
        LAS const float* part = (LAS const float*)lds; LAS float* logit = (LAS float*)(lds + N2P_LOG);
        for (int e = tid; e < 32 * 80; e += NTHR) { float sres = 0.f;
#pragma unroll
            for (int w = 0; w < 8; ++w) sres += part[w * 32 * 80 + e];
            logit[e] = sres; }
    }
    __syncthreads();
    if (th < 16) {
        LAS const float* lg = (LAS const float*)(lds + N2P_LOG) + (16 * half + th) * 80;
        const float* bg = a.in[16] + l * 8; const float* be = a.in[18] + l * 64;
        float z[8]; float zm = -3.0e38f; int gi = 0;
#pragma unroll
        for (int i = 0; i < 8; ++i) { z[i] = lg[i] + bg[i]; if (z[i] > zm) { zm = z[i]; gi = i; } }
        float den = 0.f;
#pragma unroll
        for (int i = 0; i < 8; ++i) den += expf(z[i] - zm);
        const float gp = 1.0f / den;
        float e1 = -3.0e38f, e2 = -3.0e38f; int i1 = 0, i2 = 0;
#pragma unroll
        for (int i = 0; i < 8; ++i) { const float v = lg[8 + 8 * gi + i] + be[8 * gi + i];
            if (v > e1) { e2 = e1; i2 = i1; e1 = v; i1 = i; } else if (v > e2) { e2 = v; i2 = i; } }
        const float t2 = expf(e2 - e1), w1 = gp / (1.0f + t2), w2 = gp * t2 / (1.0f + t2);
        const int tok = 16 * u + th, ea = 8 * gi + i1, eb = 8 * gi + i2;
        const unsigned pa = __hip_atomic_fetch_add(cnt + ea * 16, 1u, __ATOMIC_RELAXED, __HIP_MEMORY_SCOPE_AGENT);
        const unsigned pb = __hip_atomic_fetch_add(cnt + eb * 16, 1u, __ATOMIC_RELAXED, __HIP_MEMORY_SCOPE_AGENT);
        LIST[(size_t)ea * 16384 + pa] = 2 * tok; LIST[(size_t)eb * 16384 + pb] = 2 * tok + 1;
        TW[2 * tok] = w1; TW[2 * tok + 1] = w2;
    }
    __syncthreads();
}

constexpr int MO_B = 65536, MO_BBUF = 16384, MO_A = 98304, MO_APITCH = 2176, MO_ABUF = 4 * MO_APITCH, MO_ROW = MO_A + 2 * MO_ABUF, MO_PRE = MO_ROW + 512;
constexpr int MO_STG = 117760;
static_assert(MO_PRE + 272 <= MO_STG && MO_STG + 8 * 4096 <= MISC_OFF, "MoE LDS map");
__device__ __forceinline__ int mo_aoff(int row, int c) { return c * MO_APITCH + ((row + 2 * c) << 4); }
__device__ __forceinline__ int mo_hoff(int row, int c) { return c * 2048 + (row << 4); }

struct MoBStage { f32x4 v[4]; };
__device__ __forceinline__ void mo_gl16(f32x4& d, const float* p) { asm volatile("global_load_dwordx4 %0, %1, off" : "=v"(d) : "v"(p) : "memory"); }
__device__ __forceinline__ void mo_gl16u(u32x4& d, const bf16* p) { asm volatile("global_load_dwordx4 %0, %1, off" : "=v"(d) : "v"(p) : "memory"); }
__device__ __forceinline__ void mo_bload(MoBStage& sg, const float* src0, const float* src1, size_t ld, int k0, int tid) {
    const int n4 = tid & 63, kg = tid >> 6;
    const float* p = (n4 < 32 ? src0 + 4 * n4 : src1 + 4 * (n4 - 32)) + (size_t)(k0 + 4 * kg) * ld;
    mo_gl16(sg.v[0], p); mo_gl16(sg.v[1], p + ld); mo_gl16(sg.v[2], p + 2 * ld); mo_gl16(sg.v[3], p + 3 * ld);
}
#define MO_WAIT5(N, SB, SA) asm volatile("s_waitcnt vmcnt(" #N ")" : "+v"(SB.v[0]), "+v"(SB.v[1]), "+v"(SB.v[2]), "+v"(SB.v[3]), "+v"(SA) :: "memory")
#define MO_WAIT4(N, SB) asm volatile("s_waitcnt vmcnt(" #N ")" : "+v"(SB.v[0]), "+v"(SB.v[1]), "+v"(SB.v[2]), "+v"(SB.v[3]) :: "memory")
__device__ __forceinline__ void mo_bwrite(const MoBStage& sg, LAS unsigned char* bb, int tid) {
    const int n4 = tid & 63, kg = tid >> 6;
#pragma unroll
    for (int i = 0; i < 4; ++i) { u32x2 w; w.x = cvtpk(sg.v[0][i], sg.v[1][i]); w.y = cvtpk(sg.v[2][i], sg.v[3][i]);
        *(LAS u32x2*)(bb + (kg >> 1) * 4096 + (32 * (n4 >> 3) + 8 * i + (n4 & 7)) * 16 + 8 * (kg & 1)) = w; }
}
#define MO_READ(AP, ASTEP, BP, B1OFF) bf16x8 fb0_[2], fb1_[2], fa_[2][2]; \
    _Pragma("unroll") for (int s_ = 0; s_ < 2; ++s_) { fb0_[s_] = *(const LAS bf16x8*)((BP) + s_ * 8192); fb1_[s_] = *(const LAS bf16x8*)((BP) + s_ * 8192 + (B1OFF)); \
        _Pragma("unroll") for (int mt = 0; mt < 2; ++mt) fa_[s_][mt] = *(const LAS bf16x8*)((AP) + s_ * (ASTEP) + mt * 512); } \
    __builtin_amdgcn_sched_barrier(0)
#define MO_MMA(ACC0, ACC1) do { __builtin_amdgcn_sched_barrier(0); _Pragma("unroll") for (int s_ = 0; s_ < 2; ++s_) _Pragma("unroll") for (int mt = 0; mt < 2; ++mt) { \
        ACC0[mt] = MFMA32(fa_[s_][mt], fb0_[s_], ACC0[mt]); ACC1[mt] = MFMA32(fa_[s_][mt], fb1_[s_], ACC1[mt]); } __builtin_amdgcn_sched_barrier(0); } while (0)

__device__ __forceinline__ void moe_unit(int e, int c0, int nrows, const bf16* XN, const int* LIST, const float* Wg, const float* Wu, const float* Wd, bf16* YB, LAS unsigned char* lds, int tid, int wid, int lane) {
    const int r32 = lane & 31, hi = lane >> 5, wn = wid & 3, wm = wid >> 2;
    LAS int* rowid = (LAS int*)(lds + MO_ROW);
    if (tid < 128) rowid[tid] = (tid < nrows) ? LIST[(size_t)e * 16384 + c0 + tid] : -1;
    __syncthreads();
    const float* wg = Wg + (size_t)e * D * 256; const float* wu = Wu + (size_t)e * D * 256; const float* wd = Wd + (size_t)e * 256 * D;
    f32x16 acc0[2], acc1[2];
#define MO_ZERO() do { acc0[0] = (f32x16){}; acc0[1] = (f32x16){}; acc1[0] = (f32x16){}; acc1[1] = (f32x16){}; } while (0)
    MO_ZERO();
    MoBStage s0, s1, s2, s3; u32x4 a0, a1, a2, a3;
    {
        const int arow = tid >> 2, ac = tid & 3; const int rid = rowid[arow]; const bf16* asrc = XN + (size_t)((rid < 0 ? 0 : rid) >> 1) * D + 8 * ac;
        LAS unsigned char* const awr = lds + MO_A + mo_aoff(arow, ac);
        LAS const unsigned char* const ard = lds + MO_A + mo_aoff(64 * wm + r32, hi);
        LAS const unsigned char* const brd = lds + MO_B + hi * 4096 + (32 * wn + r32) * 16;
#define G1_LOAD(SB, SA, t) do { const int t_ = (t); mo_gl16u(SA, asrc + 32 * (t_ & 63)); mo_bload(SB, wg + 128 * (t_ >> 6), wu + 128 * (t_ >> 6), 256, 32 * (t_ & 63), tid); } while (0)
#define G1_WRITE(SB, SA, b) do { *(LAS u32x4*)(awr + (b) * MO_ABUF) = SA; mo_bwrite(SB, lds + MO_B + (b) * MO_BBUF, tid); } while (0)
#define G1_STEP(t, b, SBL, SAL, SBW, SAW) do { const int tt_ = (t); \
            MO_READ(ard + (b) * MO_ABUF, 2 * MO_APITCH + 64, brd + (b) * MO_BBUF, 2048);     \
            G1_LOAD(SBL, SAL, (tt_ + 4 < 128 ? tt_ + 4 : 127));     \
            __builtin_amdgcn_sched_barrier(0); \
            MO_WAIT5(15, SBW, SAW); \
            if (tt_ + 1 < 128) G1_WRITE(SBW, SAW, (b) ^ 1); \
            MO_MMA(acc0, acc1); \
            if ((tt_ & 63) == 63) {     \
                const int col_ = 128 * (tt_ >> 6) + 32 * wn + 4 * (r32 & 7) + (r32 >> 3), cch_ = col_ >> 3; \
                _Pragma("unroll") for (int mt = 0; mt < 2; ++mt) _Pragma("unroll") for (int r = 0; r < 16; ++r) { const float gt = acc0[mt][r], up = acc1[mt][r]; const float hv = gt / (1.0f + __expf(-gt)) * up; \
                    *(LAS unsigned short*)(lds + mo_hoff(64 * wm + 32 * mt + crow(r, hi), cch_) + (col_ & 7) * 2) = f2bf16(hv); } \
                MO_ZERO(); } \
            __syncthreads(); } while (0)
        G1_LOAD(s0, a0, 0); G1_LOAD(s1, a1, 1); G1_LOAD(s2, a2, 2); G1_LOAD(s3, a3, 3);
        MO_WAIT5(15, s0, a0);
        G1_WRITE(s0, a0, 0);
        __syncthreads();
        for (int t = 0; t < 128; t += 4) {
            G1_STEP(t, 0, s0, a0, s1, a1);
            G1_STEP(t + 1, 1, s1, a1, s2, a2);
            G1_STEP(t + 2, 0, s2, a2, s3, a3);
            G1_STEP(t + 3, 1, s3, a3, s0, a0);
        }
        asm volatile("s_waitcnt vmcnt(0)" : "+v"(s0.v[0]), "+v"(s0.v[1]), "+v"(s0.v[2]), "+v"(s0.v[3]), "+v"(s1.v[0]), "+v"(s1.v[1]), "+v"(s1.v[2]), "+v"(s1.v[3]), "+v"(s2.v[0]), "+v"(s2.v[1]), "+v"(s2.v[2]), "+v"(s2.v[3]),
                     "+v"(s3.v[0]), "+v"(s3.v[1]), "+v"(s3.v[2]), "+v"(s3.v[3]), "+v"(a0), "+v"(a1), "+v"(a2), "+v"(a3) :: "memory");
#undef G1_LOAD
#undef G1_WRITE
#undef G1_STEP
    }
    {
        LAS const unsigned char* const hrd = lds + mo_hoff(64 * wm + r32, hi);
        LAS const unsigned char* const brd = lds + MO_B + hi * 4096 + (64 * wn + r32) * 16;
#define G2_LOAD(SB, t) do { const int t_ = (t); mo_bload(SB, wd + 256 * (t_ >> 3), wd + 256 * (t_ >> 3) + 128, D, 32 * (t_ & 7), tid); } while (0)
#define G2_STEP(t, b, SBL, SBW) do { const int tt_ = (t); \
            MO_READ(hrd + (tt_ & 7) * 8192, 4096, brd + (b) * MO_BBUF, 512); \
            G2_LOAD(SBL, (tt_ + 4 < 64 ? tt_ + 4 : 63)); \
            __builtin_amdgcn_sched_barrier(0); \
            MO_WAIT4(12, SBW); \
            if (tt_ + 1 < 64) mo_bwrite(SBW, lds + MO_B + ((b) ^ 1) * MO_BBUF, tid); \
            MO_MMA(acc0, acc1); \
            if ((tt_ & 7) == 7) {     \
                LAS unsigned char* const stg_ = lds + MO_STG + wid * 4096; const int cidx_ = 4 * (r32 & 7) + (r32 >> 3); \
                _Pragma("unroll") for (int mt = 0; mt < 2; ++mt) { \
                    _Pragma("unroll") for (int r = 0; r < 16; ++r) { const int row_ = crow(r, hi); \
                        *(LAS unsigned short*)(stg_ + row_ * 128 + cidx_ * 2) = f2bf16(acc0[mt][r]); *(LAS unsigned short*)(stg_ + row_ * 128 + (cidx_ + 32) * 2) = f2bf16(acc1[mt][r]); } \
                    _Pragma("unroll") for (int k = 0; k < 4; ++k) { const int idx_ = lane + 64 * k, row_ = idx_ >> 3, ch_ = idx_ & 7; \
                        const u32x4 v_ = *(const LAS u32x4*)(stg_ + row_ * 128 + ch_ * 16); const int rr = rowid[64 * wm + 32 * mt + row_]; \
                        if (rr >= 0) *(u32x4*)(YB + (size_t)rr * D + 256 * (tt_ >> 3) + 64 * wn + 8 * ch_) = v_; } } \
                MO_ZERO(); } \
            __syncthreads(); } while (0)
        G2_LOAD(s0, 0); G2_LOAD(s1, 1); G2_LOAD(s2, 2); G2_LOAD(s3, 3);
        MO_WAIT4(12, s0);
        mo_bwrite(s0, lds + MO_B, tid);
        __syncthreads();
        for (int t = 0; t < 64; t += 4) {
            G2_STEP(t, 0, s0, s1);
            G2_STEP(t + 1, 1, s1, s2);
            G2_STEP(t + 2, 0, s2, s3);
            G2_STEP(t + 3, 1, s3, s0);
        }
        asm volatile("s_waitcnt vmcnt(0)" : "+v"(s0.v[0]), "+v"(s0.v[1]), "+v"(s0.v[2]), "+v"(s0.v[3]), "+v"(s1.v[0]), "+v"(s1.v[1]), "+v"(s1.v[2]), "+v"(s1.v[3]), "+v"(s2.v[0]), "+v"(s2.v[1]), "+v"(s2.v[2]), "+v"(s2.v[3]),
                     "+v"(s3.v[0]), "+v"(s3.v[1]), "+v"(s3.v[2]), "+v"(s3.v[3]) :: "memory");
#undef G2_LOAD
#undef G2_STEP
    }
#undef MO_ZERO
}

constexpr int N_PHASES = 1 + 7 * DEPTH;
#ifndef PH_MASK
#define PH_MASK 0xFFFF
#endif
#define PHON(k) (((PH_MASK) >> (k)) & 1)
#ifndef DUP_MASK
#define DUP_MASK 0
#endif
#define DUPON(k) ((((DUP_MASK) >> (k)) & 1) && (l == 0 || (((0x3FE) >> (k)) & 1)))
#ifndef MK_ONE_LAUNCH
#define MK_ONE_LAUNCH 1
#endif

__global__ void __launch_bounds__(NTHR, 2) fwd_kernel(Args args) {
    extern __shared__ __attribute__((aligned(16))) unsigned char lds_raw[];
    LAS unsigned char* lds = (LAS unsigned char*)lds_raw;
    volatile LAS unsigned* MISC = (volatile LAS unsigned*)(lds + MISC_OFF);
    const int wid = __builtin_amdgcn_readfirstlane(threadIdx.x >> 6);
    const int G = gridDim.x, bid = blockIdx.x;
    unsigned char* ws = args.ws;
    unsigned* const ctl0 = (unsigned*)(ws + WS_CTL);
    if (threadIdx.x < 64) MISC[threadIdx.x] = 0u;
    __syncthreads();
    const int lo = args.ph_lo, hi_ph = args.ph_hi;
    XcdBarrier bar; bar.bar = ctl0 + CW_BAR; bar.x = 0; bar.st = MISC + 8; bar.w0 = 0;
    if (hi_ph - lo > 1) bar = xcd_barrier_post(ctl0 + CW_BAR, MISC + 8);
#define IN(k) (lo <= (k) && (k) < hi_ph)
#define FRESH() int wid_ = wid; asm volatile("" : "+s"(wid_)); int lane_; asm volatile("v_mbcnt_lo_u32_b32 %0, -1, 0\n\tv_mbcnt_hi_u32_b32 %0, -1, %0" : "=v"(lane_)); const int tid_ = wid_ * 64 + lane_; (void)tid_
#define SEAM(k) do { if (IN(k) && IN((k) + 1)) xcd_barrier(bar); } while (0)

    const int NGW = G * NWAVES;

    if (PHON(0) && IN(0)) { FRESH(); p0_prologue(args, lds, bid, G, tid_, wid_, lane_); if ((DUP_MASK) & 1) p0_prologue(args, lds, bid, G, tid_, wid_, lane_); }
    SEAM(0);

#pragma unroll 1
    for (int lraw = 0; lraw < DEPTH; ++lraw) {
        int l = lraw; asm volatile("" : "+s"(l));
        GAS unsigned char* wsg = (GAS unsigned char*)ws; asm volatile("" : "+s"(wsg)); unsigned char* const wsl = (unsigned char*)wsg;
        unsigned* const ctl = (unsigned*)(wsl + WS_CTL);
        bf16* const WIN = (bf16*)(wsl + WS_WIN); bf16* const WOUT = (bf16*)(wsl + WS_WOUT); bf16* const W1T = (bf16*)(wsl + WS_W1T); bf16* const W2T = (bf16*)(wsl + WS_W2T); bf16* const RWT = (bf16*)(wsl + WS_RWT);
        float* const C1 = (float*)(wsl + WS_C1); bf16* const X = (bf16*)(wsl + WS_X); bf16* const XN = (bf16*)(wsl + WS_XN); bf16* const PROJ = (bf16*)(wsl + WS_PROJ); float* const AUX = (float*)(wsl + WS_AUX);
        float* const CUM = (float*)(wsl + WS_CUM); bf16* const KC = (bf16*)(wsl + WS_KC); bf16* const VC = (bf16*)(wsl + WS_VC); bf16* const MIX = (bf16*)(wsl + WS_MIX); bf16* const YB = (bf16*)(wsl + WS_YB);
        int* const LIST = (int*)(wsl + WS_LIST); float* const TW = (float*)(wsl + WS_TW);
        const int pb = 1 + 7 * l;
        if (PHON(1) && IN(pb)) {
            pg8::Gemm g{XN, WIN + (size_t)l * NP * D, S, NP, D}; pg8::StaticOrder so; so.init(S, NP, G, bid);
            pg8::EpiProj E{PROJ, AUX};
            pg8::gemm_phase<pg8::EpiProj, pg8::StaticOrder, true, true>(lds, g, so, E, wid);
            if (DUPON(1)) pg8::gemm_phase<pg8::EpiProj, pg8::StaticOrder, true, true>(lds, g, so, E, wid);
        }
        SEAM(pb);
        if (IN(pb + 2)) {
            const int x = bid & 7;
#define QHEAD(q) (ctl + CW_Q + (((l * 6 + (q)) * 8 + x) * 64))
            if (PHON(2)) { FRESH(); unsigned* const pdone = ctl + CW_PD + l * 64;
                for (;;) { const int i = dequeue(ctl + CW_PQ + l * 64, MISC + 19, tid_); if (i >= 136) break;
                    if (i < 8) cumsum_unit(i, l, AUX, args.in[5], CUM, lds, tid_); else compress_unit(i - 8, l, PROJ, W1T, W2T, C1, KC, VC, lds, wid_, lane_);
                    asm volatile("s_waitcnt vmcnt(0)" ::: "memory");
                    __syncthreads();
                    if (wid_ == 0) { __builtin_amdgcn_fence(__ATOMIC_RELEASE, "agent"); asm volatile("s_waitcnt vmcnt(0)" ::: "memory"); (void)__hip_atomic_fetch_add(pdone, 1u, __ATOMIC_RELAXED, __HIP_MEMORY_SCOPE_AGENT); }
                } }
            if (PHON(4)) { FRESH(); for (;;) { const int i = dequeue(QHEAD(1), MISC + 17, tid_); if (i >= 32) break; diff_unit(x & 3, 63 - 2 * i - (x >> 2), l, args, PROJ, MIX, lds, tid_, wid_, lane_); }
                if (DUPON(4)) for (;;) { const int i = dequeue(QHEAD(4), MISC + 17, tid_); if (i >= 32) break; diff_unit(x & 3, 63 - 2 * i - (x >> 2), l, args, PROJ, MIX, lds, tid_, wid_, lane_); } }
            if (PHON(2)) { FRESH();
                if (tid_ == 0) { unsigned* const pdone = ctl + CW_PD + l * 64; unsigned sp = 0;
                    while (__hip_atomic_load(pdone, __ATOMIC_RELAXED, __HIP_MEMORY_SCOPE_AGENT) < 136u * 64u) { __builtin_amdgcn_s_sleep(2); if (++sp > (1u << 20)) break; }
                    __builtin_amdgcn_fence(__ATOMIC_ACQUIRE, "agent"); asm volatile("s_waitcnt vmcnt(0)" ::: "memory"); }
                __syncthreads(); }
            if (PHON(3)) { FRESH(); for (;;) { const int i = dequeue(QHEAD(0), MISC + 16, tid_); if (i >= 32) break; fox_unit(x, 31 - i, PROJ, CUM, MIX, lds, tid_, wid_, lane_); }
                if (DUPON(3)) for (;;) { const int i = dequeue(QHEAD(3), MISC + 16, tid_); if (i >= 32) break; fox_unit(x, 31 - i, PROJ, CUM, MIX, lds, tid_, wid_, lane_); } }
            if (PHON(5)) { FRESH(); for (;;) { const int i = dequeue(QHEAD(2), MISC + 18, tid_); if (i >= 64) break; nsa_unit(x & 3, 127 - 2 * i - (x >> 2), args, PROJ, AUX, KC, VC, MIX, lds, tid_, wid_, lane_); }
                if (DUPON(5)) for (;;) { const int i = dequeue(QHEAD(5), MISC + 18, tid_); if (i >= 64) break; nsa_unit(x & 3, 127 - 2 * i - (x >> 2), args, PROJ, AUX, KC, VC, MIX, lds, tid_, wid_, lane_); } }
#undef QHEAD
        }
        SEAM(pb + 2);
        if (PHON(6) && IN(pb + 3)) {
            pg8::Gemm g{MIX, WOUT + (size_t)l * D * D, S, D, D}; pg8::StaticOrder so; so.init(S, D, G, bid);
            pg8::EpiRes E{l == 0 ? args.in[0] : nullptr, X, X};
            pg8::gemm_phase<pg8::EpiRes, pg8::StaticOrder, true, true>(lds, g, so, E, wid);
            if (DUPON(6)) { pg8::EpiRes E2{nullptr, X, YB}; pg8::gemm_phase<pg8::EpiRes, pg8::StaticOrder, true, true>(lds, g, so, E2, wid); }
        }
        SEAM(pb + 3);
        if (PHON(7) && IN(pb + 4)) {
            FRESH();
            for (int p = bid; p < S / 32; p += G) n2_pair(p, l, args, X, XN, RWT, ctl + CW_CNT + l * 1024, LIST, TW, lds, tid_, wid_, lane_);
            if (DUPON(7)) for (int u = bid; u < S / 16; u += G) n2_unit(u, l, args, X, XN, RWT, ctl + CW_CNT + (4 + l) * 1024, (int*)MIX, (float*)(MIX + 8 * 1024 * 1024), lds, tid_, wid_, lane_);
        }
        SEAM(pb + 4);
        if (PHON(8) && IN(pb + 5)) {
            FRESH();
            LAS int* pre = (LAS int*)(lds + MO_PRE);
            if (tid_ < 64) pre[tid_] = ((int)__hip_atomic_load(ctl + CW_CNT + l * 1024 + tid_ * 16, __ATOMIC_RELAXED, __HIP_MEMORY_SCOPE_AGENT) + 127) >> 7;
            __syncthreads();
            const int x = bid & 7, per = G >> 3;
            for (int rep = 0; rep < (DUPON(8) ? 2 : 1); ++rep)
            for (int slot = bid >> 3; ; slot += per) {
                int e = -1, c = 0, acc = 0;
                for (int k = 0; k < 8; ++k) { const int ee = x + 8 * k, n = pre[ee]; if (e < 0 && slot < acc + n) { e = ee; c = slot - acc; } acc += n; }
                if (e < 0) break;
                e = __builtin_amdgcn_readfirstlane(e); c = __builtin_amdgcn_readfirstlane(c);
                const int c0 = c * 128; const int cnt_e = (int)__hip_atomic_load(ctl + CW_CNT + l * 1024 + e * 16, __ATOMIC_RELAXED, __HIP_MEMORY_SCOPE_AGENT);
                const int nrows = (cnt_e - c0) < 128 ? (cnt_e - c0) : 128;
                moe_unit(e, c0, nrows, XN, LIST, args.in[19] + (size_t)l * 64 * D * 256, args.in[20] + (size_t)l * 64 * D * 256, args.in[21] + (size_t)l * 64 * 256 * D, YB, lds, tid_, wid_, lane_);
            }
        }
        SEAM(pb + 5);
        if (PHON(9) && IN(pb + 6)) {
            FRESH(); const int gw_ = bid * NWAVES + wid_;
            if (l + 1 < DEPTH) {
                norm_rows<1>(nullptr, X, X, XN, YB, TW, args.in[1] + (size_t)(l + 1) * D, nullptr, gw_, NGW, lane_);
                if (DUPON(9)) norm_rows<1>(nullptr, X, PROJ, MIX, YB, TW, args.in[1] + (size_t)(l + 1) * D, nullptr, gw_, NGW, lane_);
            } else norm_rows<2>(nullptr, X, nullptr, nullptr, YB, TW, args.in[22], args.out, gw_, NGW, lane_);
        }
        if (l + 1 < DEPTH) SEAM(pb + 6);
    }
#undef IN
#undef SEAM
}

extern "C" void kernel_launch(void* const* d_in, const int* in_sizes, int n_in, void* d_out, int out_size, void* d_ws, size_t ws_size, hipStream_t stream) {
    static int grid = 0;
    if (grid == 0) {
        if (n_in != 23 || ws_size < WS_END || out_size != S * D) { fprintf(stderr, "kernel_launch: unexpected problem (n_in %d, out %d, ws %zu)\n", n_in, out_size, ws_size); grid = -1; return; }
        int dev = 0, cus = 0, per_cu = 0;
        if (hipGetDevice(&dev) != hipSuccess || hipDeviceGetAttribute(&cus, hipDeviceAttributeMultiprocessorCount, dev) != hipSuccess) { grid = -1; return; }
        if (hipFuncSetAttribute((const void*)fwd_kernel, hipFuncAttributeMaxDynamicSharedMemorySize, LDS_BYTES) != hipSuccess) { fprintf(stderr, "kernel_launch: hipFuncSetAttribute failed\n"); grid = -1; return; }
        if (hipOccupancyMaxActiveBlocksPerMultiprocessor(&per_cu, (const void*)fwd_kernel, NTHR, LDS_BYTES) != hipSuccess || per_cu < 1) fprintf(stderr, "kernel_launch: occupancy query says %d blocks per CU\n", per_cu);
        (void)hipGetLastError();
        grid = cus;
        if (grid < 136) { fprintf(stderr, "kernel_launch: too few CUs (%d)\n", grid); }
    }
    if (grid < 0) return;
    if (hipMemsetAsync((char*)d_ws + WS_CTL, 0, CTL_ZERO_BYTES, stream) != hipSuccess) { fprintf(stderr, "kernel_launch: memset failed\n"); return; }
    Args a{};
    for (int i = 0; i < 23; ++i) a.in[i] = (const float*)d_in[i];
    a.out = (float*)d_out; a.ws = (unsigned char*)d_ws;
#if MK_ONE_LAUNCH
    a.ph_lo = 0; a.ph_hi = N_PHASES;
    hipLaunchKernelGGL(fwd_kernel, dim3(grid), dim3(NTHR), LDS_BYTES, stream, a);
#else
    for (int p = 0; p < N_PHASES; ++p) { a.ph_lo = p; a.ph_hi = p + 1; hipLaunchKernelGGL(fwd_kernel, dim3(grid), dim3(NTHR), LDS_BYTES, stream, a); }
#endif
    const hipError_t le = hipPeekAtLastError();
    if (le != hipSuccess) fprintf(stderr, "kernel_launch: launch failed: %s\n", hipGetErrorName(le));
}
```

```cpp
#include <hip/hip_runtime.h>
#include <cstdio>
#include <cstdint>
#include <cmath>
namespace pg8 {
#define PG8_LAS __attribute__((address_space(3)))
typedef unsigned short bf16_t;
typedef short bf16x8 __attribute__((ext_vector_type(8)));
typedef float f32x4 __attribute__((ext_vector_type(4)));
typedef unsigned u32x4 __attribute__((ext_vector_type(4)));
constexpr int BM = 256, BK = 64, HALF = 128, HTB = HALF * BK * 2  , STAGE_BYTES = 8 * HTB, NXCD = 8, WGM = 8;

__host__ __device__ __forceinline__ int lds_byte(int r, int c) { const int st = (r >> 4) * 2 + (c >> 5), rr = r & 15, cc = c & 31, ob = rr * 64 + cc * 2; return st * 1024 + (ob ^ (((ob >> 9) & 1) << 5)); }
__host__ __device__ __forceinline__ void stage_rc(int b, int& R, int& C) { const int st = b / 1024, sb = b % 1024, swz = sb ^ (((sb >> 9) & 1) << 5); R = (st >> 1) * 16 + swz / 64; C = (st & 1) * 32 + (swz % 64) / 2; }
__host__ __device__ __forceinline__ int perm32(int rho) { const int n = rho >> 4, i = rho & 15; return 8 * (i >> 2) + 4 * n + (i & 3); }

struct Unit { int pm, pn; };
struct Gemm { const bf16_t* A; const bf16_t* Bt; int M, N, K; };

struct StaticOrder {
    int nM, nN, nwg, G, c;
    __host__ __device__ void init(int M, int N, int G_, int c_) { nM = M / BM; nN = N / BM; nwg = nM * nN; G = G_; c = c_; }
    __host__ __device__ bool next(int i, Unit& u) const {
        const long L = (long)i * G + c; if (L >= nwg) return false;
        int wgid = (int)L; { const int q = nwg / NXCD, r = nwg % NXCD, xcd = wgid % NXCD, off = wgid / NXCD; wgid = (xcd < r ? xcd * (q + 1) : r * (q + 1) + (xcd - r) * q) + off; }
        const int nig = WGM * nN, gid = wgid / nig, fm = gid * WGM, gsz = (nM - fm) < WGM ? (nM - fm) : WGM;
        u.pm = fm + ((wgid % nig) % gsz); u.pn = (wgid % nig) / gsz; return true;
    }
    __device__ __forceinline__ void a_ready(const Unit&) const {}
    __device__ __forceinline__ void done(const Unit&) const {}
};
__device__ __forceinline__ unsigned cvt_pk_bf16(float lo, float hi) { unsigned r; asm volatile("v_cvt_pk_bf16_f32 %0, %1, %2" : "=v"(r) : "v"(lo), "v"(hi)); return r; }
struct EpiProj {
    static constexpr bool PERM = true, AFTER_DRAIN = false;
    bf16_t* O; float* aux;
    __device__ __forceinline__ void operator()(const f32x4 (&acc)[2][2][4][2], const Unit& u, int wr, int wc, int fr, int fq) const {
        const int row0 = u.pm * BM + wr * 64 + fr;
        if (u.pn < 22) {
            const int col0 = u.pn * BM + wc * 32 + 8 * fq;
#pragma unroll
            for (int ai = 0; ai < 2; ++ai)
#pragma unroll
                for (int m = 0; m < 4; ++m) { bf16_t* rowp = O + (size_t)(row0 + ai * HALF + m * 16) * 5632 + col0;
#pragma unroll
                    for (int bj = 0; bj < 2; ++bj) { const f32x4 v0 = acc[ai][bj][m][0], v1 = acc[ai][bj][m][1];
                        u32x4 w; w.x = cvt_pk_bf16(v0[0], v0[1]); w.y = cvt_pk_bf16(v0[2], v0[3]); w.z = cvt_pk_bf16(v1[0], v1[1]); w.w = cvt_pk_bf16(v1[2], v1[3]);
                        *(u32x4*)(rowp + bj * HALF) = w; } }
        } else if (wc < 2) {
            const int col0 = wc * 32 + 8 * fq;
#pragma unroll
            for (int ai = 0; ai < 2; ++ai)
#pragma unroll
                for (int m = 0; m < 4; ++m) { float* rowp = aux + (size_t)(row0 + ai * HALF + m * 16) * 64 + col0;
                    *(f32x4*)(rowp) = acc[ai][0][m][0]; *(f32x4*)(rowp + 4) = acc[ai][0][m][1]; }
        }
    }
};
struct EpiRes {
    static constexpr bool PERM = true, AFTER_DRAIN = false;
    const float* basef; const bf16_t* baseb; bf16_t* out;
    __device__ __forceinline__ void operator()(const f32x4 (&acc)[2][2][4][2], const Unit& u, int wr, int wc, int fr, int fq) const {
        const int row0 = u.pm * BM + wr * 64 + fr, col0 = u.pn * BM + wc * 32 + 8 * fq;
#pragma unroll
        for (int ai = 0; ai < 2; ++ai)
#pragma unroll
            for (int m = 0; m < 4; ++m) { const size_t off = (size_t)(row0 + ai * HALF + m * 16) * 2048 + col0;
#pragma unroll
                for (int bj = 0; bj < 2; ++bj) { f32x4 v0 = acc[ai][bj][m][0], v1 = acc[ai][bj][m][1]; const size_t o = off + bj * HALF;
                    if (basef) { v0 += *(const f32x4*)(basef + o); v1 += *(const f32x4*)(basef + o + 4); }
                    else { const u32x4 b = *(const u32x4*)(baseb + o);
                        v0[0] += __uint_as_float(b.x << 16); v0[1] += __uint_as_float(b.x & 0xffff0000u); v0[2] += __uint_as_float(b.y << 16); v0[3] += __uint_as_float(b.y & 0xffff0000u);
                        v1[0] += __uint_as_float(b.z << 16); v1[1] += __uint_as_float(b.z & 0xffff0000u); v1[2] += __uint_as_float(b.w << 16); v1[3] += __uint_as_float(b.w & 0xffff0000u); }
                    u32x4 w; w.x = cvt_pk_bf16(v0[0], v0[1]); w.y = cvt_pk_bf16(v0[2], v0[3]); w.z = cvt_pk_bf16(v1[0], v1[1]); w.w = cvt_pk_bf16(v1[2], v1[3]);
                    *(u32x4*)(out + o) = w; } }
    }
};
template <class Epi, class Sched, bool ALIGN_EPI = false, bool SP2 = false>
__device__ __forceinline__ void gemm_phase(PG8_LAS unsigned char* lds, const Gemm g, const Sched& S, const Epi& E, int wid_in  ) {
    int wid = wid_in; asm volatile("" : "+s"(wid));
    int lane = (int)__builtin_amdgcn_mbcnt_hi(~0u, __builtin_amdgcn_mbcnt_lo(~0u, 0u)); asm volatile("" : "+v"(lane));
    const int tid = wid * 64 + lane, wr = wid >> 2, wc = wid & 3, fr = lane & 15, fq = lane >> 4;
    const int K = g.K, nt = K / BK;
    unsigned voffA[2], voffB[2];
#pragma unroll
    for (int i = 0; i < 2; ++i) { int R, C; stage_rc(tid * 16 + i * 8192, R, C); const int Rb = Epi::PERM ? ((R & ~31) + perm32(R & 31)) : R;
        voffA[i] = (unsigned)(R * K + C) * 2u; voffB[i] = (unsigned)(Rb * K + C) * 2u; }
    const size_t kstep = (size_t)(BK * 2);
    const size_t hstep = (size_t)HALF * K * 2;
    const size_t tstep = 2 * hstep;
    const unsigned ldsw = (unsigned)wid * 1024u;
    const int aoff = lds_byte(wr * 64 + fr, fq * 8), boff = lds_byte(wc * 32 + fr, fq * 8);
#define PG8_SA(b, h) (((b) * 2 + (h)) * HTB)
#define PG8_SB(b, h) ((4 + (b) * 2 + (h)) * HTB)
#define PG8_STAGE(bufoff, gbase, voff) do { _Pragma("unroll") for (int _i = 0; _i < 2; ++_i) \
        __builtin_amdgcn_global_load_lds((const unsigned*)((const char*)(gbase) + (voff)[_i]), (PG8_LAS unsigned*)(lds + (bufoff) + ldsw + _i * 8192), 16, 0, 0); } while (0)
#define PG8_LDA(dst, b, h) do { _Pragma("unroll") for (int m = 0; m < 4; ++m) _Pragma("unroll") for (int k = 0; k < 2; ++k) dst[m][k] = *(const PG8_LAS bf16x8*)(lds + PG8_SA(b, h) + aoff + m * 2048 + k * 1024); } while (0)
#define PG8_LDB(dst, b, h) do { _Pragma("unroll") for (int n = 0; n < 2; ++n) _Pragma("unroll") for (int k = 0; k < 2; ++k) dst[n][k] = *(const PG8_LAS bf16x8*)(lds + PG8_SB(b, h) + boff + n * 2048 + k * 1024); } while (0)
#define PG8_MMA(ai, bj, At, Bt) do { __builtin_amdgcn_s_setprio(1); _Pragma("unroll") for (int m = 0; m < 4; ++m) _Pragma("unroll") for (int n = 0; n < 2; ++n) _Pragma("unroll") for (int k = 0; k < 2; ++k) \
        acc[ai][bj][m][n] = __builtin_amdgcn_mfma_f32_16x16x32_bf16(Bt[n][k], At[m][k], acc[ai][bj][m][n], 0, 0, 0); __builtin_amdgcn_s_setprio(0); } while (0)
#define PG8_WAIT_V(n) asm volatile("s_waitcnt vmcnt(" #n ")" ::: "memory")
#define PG8_WAIT_L(n) asm volatile("s_waitcnt lgkmcnt(" #n ")" ::: "memory")
#define PG8_BAR __builtin_amdgcn_s_barrier()
#define PG8_SCHED __builtin_amdgcn_sched_barrier(0)
    Unit cur, nxt; int ui = 0;
    if (!S.next(0, cur)) return;
    f32x4 acc[2][2][4][2];
#pragma unroll
    for (int a = 0; a < 2; ++a)
#pragma unroll
        for (int b = 0; b < 2; ++b)
#pragma unroll
            for (int m = 0; m < 4; ++m)
#pragma unroll
                for (int n = 0; n < 2; ++n) acc[a][b][m][n] = (f32x4){0.f, 0.f, 0.f, 0.f};
    bf16x8 At[4][2], B0[2][2], B1[2][2];
    const char* cA = (const char*)g.A + (size_t)cur.pm * tstep; const char* cB = (const char*)g.Bt + (size_t)cur.pn * tstep;
    S.a_ready(cur);
    if constexpr (SP2) {
        PG8_STAGE(PG8_SB(0, 0), cB, voffB); PG8_STAGE(PG8_SB(0, 1), cB + hstep, voffB); PG8_STAGE(PG8_SA(0, 0), cA, voffA); PG8_STAGE(PG8_SA(0, 1), cA + hstep, voffA);
        if (wr == 1) PG8_BAR;
        PG8_WAIT_V(2); PG8_BAR;
        PG8_STAGE(PG8_SB(1, 0), cB + kstep, voffB); PG8_STAGE(PG8_SA(1, 0), cA + kstep, voffA); PG8_STAGE(PG8_SB(1, 1), cB + hstep + kstep, voffB);
        PG8_WAIT_V(6); PG8_BAR;
    } else {
        PG8_STAGE(PG8_SB(0, 0), cB, voffB); PG8_STAGE(PG8_SA(0, 0), cA, voffA); PG8_STAGE(PG8_SB(0, 1), cB + hstep, voffB); PG8_STAGE(PG8_SA(0, 1), cA + hstep, voffA);
        if (wr == 1) PG8_BAR;
        PG8_WAIT_V(4); PG8_BAR;
        PG8_STAGE(PG8_SB(1, 0), cB + kstep, voffB); PG8_STAGE(PG8_SA(1, 0), cA + kstep, voffA); PG8_STAGE(PG8_SB(1, 1), cB + hstep + kstep, voffB);
        PG8_WAIT_V(6); PG8_BAR;
    }
    for (;;) {
        const bool has_next = S.next(ui + 1, nxt);
        const char* nA = has_next ? (const char*)g.A + (size_t)nxt.pm * tstep : cA; const char* nB = has_next ? (const char*)g.Bt + (size_t)nxt.pn * tstep : cB;
        for (int t = 0; t < nt; t += 2) {
            const bool last = (t == nt - 2);
            const char* a1 = cA + (size_t)(t + 1) * kstep;
            const char* a2 = last ? nA : cA + (size_t)(t + 2) * kstep; const char* b2 = last ? nB : cB + (size_t)(t + 2) * kstep;
            const char* a3 = a2 + kstep; const char* b3 = b2 + kstep;
            if (last && has_next) S.a_ready(nxt);
            if constexpr (SP2) {
            PG8_LDB(B0, 0, 0); PG8_LDB(B1, 0, 1); PG8_SCHED; PG8_LDA(At, 0, 0); PG8_STAGE(PG8_SA(1, 1), a1 + hstep, voffA);
            PG8_WAIT_V(8); PG8_WAIT_L(0); PG8_BAR; PG8_MMA(0, 0, At, B0); PG8_MMA(0, 1, At, B1); PG8_BAR; PG8_SCHED;
            PG8_LDA(At, 0, 1); PG8_STAGE(PG8_SB(0, 0), b2, voffB); PG8_STAGE(PG8_SB(0, 1), b2 + hstep, voffB); PG8_STAGE(PG8_SA(0, 0), a2, voffA);
            PG8_WAIT_V(8); PG8_WAIT_L(0); PG8_BAR; PG8_MMA(1, 0, At, B0); PG8_MMA(1, 1, At, B1); PG8_BAR; PG8_SCHED;
            PG8_LDB(B0, 1, 0); PG8_LDB(B1, 1, 1); PG8_SCHED; PG8_LDA(At, 1, 0); PG8_STAGE(PG8_SA(0, 1), a2 + hstep, voffA);
            PG8_WAIT_V(8); PG8_WAIT_L(0); PG8_BAR; PG8_MMA(0, 0, At, B0); PG8_MMA(0, 1, At, B1); PG8_BAR; PG8_SCHED;
            PG8_LDA(At, 1, 1); PG8_STAGE(PG8_SB(1, 0), b3, voffB); PG8_STAGE(PG8_SB(1, 1), b3 + hstep, voffB); PG8_STAGE(PG8_SA(1, 0), a3, voffA);
            PG8_WAIT_V(8); PG8_WAIT_L(0); PG8_BAR; PG8_MMA(1, 0, At, B0); PG8_MMA(1, 1, At, B1); PG8_BAR; PG8_SCHED;
            } else {
            PG8_LDB(B0, 0, 0); PG8_SCHED; PG8_LDA(At, 0, 0); PG8_STAGE(PG8_SA(1, 1), a1 + hstep, voffA);
            PG8_WAIT_L(8); PG8_BAR; PG8_WAIT_L(0); PG8_MMA(0, 0, At, B0); PG8_BAR; PG8_SCHED;
            PG8_LDB(B1, 0, 1); PG8_STAGE(PG8_SB(0, 0), b2, voffB);
            PG8_BAR; PG8_WAIT_L(0); PG8_MMA(0, 1, At, B1); PG8_BAR;
            PG8_LDA(At, 0, 1); PG8_STAGE(PG8_SA(0, 0), a2, voffA);
            PG8_BAR; PG8_WAIT_L(0); PG8_MMA(1, 0, At, B0); PG8_BAR; PG8_SCHED;
            PG8_STAGE(PG8_SB(0, 1), b2 + hstep, voffB);
            PG8_WAIT_V(6); PG8_BAR; PG8_MMA(1, 1, At, B1); PG8_BAR;
            PG8_LDB(B0, 1, 0); PG8_SCHED; PG8_LDA(At, 1, 0); PG8_STAGE(PG8_SA(0, 1), a2 + hstep, voffA);
            PG8_WAIT_L(8); PG8_BAR; PG8_WAIT_L(0); PG8_MMA(0, 0, At, B0); PG8_BAR; PG8_SCHED;
            PG8_LDB(B1, 1, 1); PG8_STAGE(PG8_SB(1, 0), b3, voffB);
            PG8_BAR; PG8_WAIT_L(0); PG8_MMA(0, 1, At, B1); PG8_BAR;
            PG8_LDA(At, 1, 1); PG8_STAGE(PG8_SA(1, 0), a3, voffA);
            PG8_BAR; PG8_WAIT_L(0); PG8_MMA(1, 0, At, B0); PG8_BAR; PG8_SCHED;
            PG8_STAGE(PG8_SB(1, 1), b3 + hstep, voffB);
            PG8_WAIT_V(6); PG8_BAR; PG8_MMA(1, 1, At, B1); PG8_BAR;
            }
        }
        if constexpr (ALIGN_EPI) { if (wr == 0) PG8_BAR; }
        if constexpr (!Epi::AFTER_DRAIN) { E(acc, cur, wr, wc, fr, fq); S.done(cur); }
        if (!has_next) break;
#pragma unroll
        for (int a = 0; a < 2; ++a)
#pragma unroll
            for (int b = 0; b < 2; ++b)
#pragma unroll
                for (int m = 0; m < 4; ++m)
#pragma unroll
                    for (int n = 0; n < 2; ++n) acc[a][b][m][n] = (f32x4){0.f, 0.f, 0.f, 0.f};
        cur = nxt; cA = nA; cB = nB; ++ui;
        if constexpr (ALIGN_EPI) { if (wr == 1) PG8_BAR; }
    }
    PG8_WAIT_V(0);
    if constexpr (!ALIGN_EPI) { if (wr == 0) PG8_BAR; }
    PG8_BAR;
    if constexpr (Epi::AFTER_DRAIN) { E.fused(acc, cur, wr, wc, fr, fq, lds, wid, lane); S.done(cur); }
#undef PG8_SA
#undef PG8_SB
#undef PG8_STAGE
#undef PG8_LDA
#undef PG8_LDB
#undef PG8_MMA
#undef PG8_WAIT_V
#undef PG8_WAIT_L
#undef PG8_BAR
#undef PG8_SCHED
}
}
#define GAS __attribute__((address_space(1)))
#define LAS __attribute__((address_space(3)))
typedef unsigned short bf16;
typedef unsigned v4u __attribute__((ext_vector_type(4)));
typedef float f32x4 __attribute__((ext_vector_type(4)));
typedef short bf16x8 __attribute__((ext_vector_type(8)));
typedef GAS unsigned gu32;
typedef GAS unsigned long long gu64;
#define RLX_AGENT __ATOMIC_RELAXED, __HIP_MEMORY_SCOPE_AGENT
#define LDS_WAIT() asm volatile("s_waitcnt lgkmcnt(0)" ::: "memory")
#define VM_WAIT() asm volatile("s_waitcnt vmcnt(0)" ::: "memory")
__device__ __forceinline__ unsigned long long rt() { return __builtin_amdgcn_s_memrealtime(); }
__device__ __forceinline__ unsigned f2bf(float f) { unsigned u = __builtin_bit_cast(unsigned, f); return (u + 0x7fffu + ((u >> 16) & 1u)) >> 16; }
__device__ __forceinline__ unsigned pk2(float lo, float hi) { return f2bf(lo) | (f2bf(hi) << 16); }
#define XB_TMO      128
#define XB_XCNT(j)  (256  + 64 * (j))
#define XB_XSUB(j)  (1280 + 64 * (j))
#define XB_XGEN(j)  (2304 + 64 * (j))
#define XB_TOP      3328
#define XB_TOPGEN   3392
#define XCD_BAR_WORDS 3456
#define XB_SPIN_CAP (1u << 18)

__device__ __forceinline__ unsigned xb_ld(unsigned* p)              { return __hip_atomic_load(p, __ATOMIC_RELAXED, __HIP_MEMORY_SCOPE_AGENT); }
__device__ __forceinline__ unsigned xb_add(unsigned* p, unsigned v) { return __hip_atomic_fetch_add(p, v, __ATOMIC_RELAXED, __HIP_MEMORY_SCOPE_AGENT); }
__device__ __forceinline__ unsigned xb_xcc_id() { return (unsigned)__builtin_amdgcn_s_getreg((3 << 11) | 20) & 0xFu; }
#define XB_SPIN(cond, bar) do { unsigned _sp = 0; while (cond) { __builtin_amdgcn_s_sleep(1); \
    if ((++_sp & 255u) == 0u) { if (xb_ld(&(bar)[XB_TMO])) break; if (_sp > XB_SPIN_CAP) { atomicAdd(&(bar)[XB_TMO], 1u); break; } } } } while (0)

struct XcdBarrier {
    unsigned* bar; unsigned x;
    unsigned w0;
    volatile LAS unsigned* st;
};

__device__ __forceinline__ XcdBarrier xcd_barrier_post(unsigned* bar, volatile LAS unsigned* st) {
    XcdBarrier b; b.bar = bar; b.x = xb_xcc_id(); b.st = st; b.w0 = (__builtin_amdgcn_readfirstlane(threadIdx.x >> 6) == 0) ? 1u : 0u;
    if (threadIdx.x == 0) (void)xb_add(&bar[XB_XCNT(b.x)], 1u);
    return b;
}
__device__ __forceinline__ void xcd_barrier_complete(unsigned* bar, unsigned x, unsigned& nloc, unsigned& nx) {
    const unsigned G = gridDim.x * gridDim.y * gridDim.z;
    unsigned sum, cnt, mine, sp = 0u;
    for (;;) {
        sum = 0u; cnt = 0u; mine = 0u;
#pragma unroll
        for (unsigned j = 0; j < 16; ++j) { const unsigned c = xb_ld(&bar[XB_XCNT(j)]); sum += c; cnt += (c > 0u) ? 1u : 0u; mine = (j == x) ? c : mine; }
        if (sum == G) break;
        __builtin_amdgcn_s_sleep(1);
        if ((++sp & 255u) == 0u) { if (xb_ld(&bar[XB_TMO])) break; if (sp > XB_SPIN_CAP) { atomicAdd(&bar[XB_TMO], 1u); break; } }
    }
    nloc = mine > 0u ? mine : 1u; nx = cnt > 0u ? cnt : 1u;
}

__device__ __forceinline__ void xcd_barrier(const XcdBarrier& b) {
    asm volatile("s_waitcnt vmcnt(0)" ::: "memory");
    __syncthreads();
    if (b.w0 != 0u && __builtin_amdgcn_mbcnt_hi(~0u, __builtin_amdgcn_mbcnt_lo(~0u, 0u)) == 0u) {
        GAS unsigned* barg = (GAS unsigned*)b.bar; asm volatile("" : "+s"(barg)); unsigned* bar = (unsigned*)barg;
        __builtin_amdgcn_s_waitcnt(0);
        unsigned nloc = b.st[0], nx = b.st[1];
        if (nloc == 0u) { xcd_barrier_complete(bar, b.x, nloc, nx); b.st[0] = nloc; b.st[1] = nx; }
        const unsigned old = xb_add(&bar[XB_XSUB(b.x)], 1u);
        const unsigned gen = old / nloc;
        if (old + 1u == (gen + 1u) * nloc) {
            __builtin_amdgcn_fence(__ATOMIC_RELEASE, "agent");
            asm volatile("s_waitcnt vmcnt(0)" ::: "memory");
            const unsigned og = xb_add(&bar[XB_TOP], 1u);
            const unsigned tg = og / nx;
            if (og + 1u == (tg + 1u) * nx) xb_add(&bar[XB_TOPGEN], 1u);
            else XB_SPIN(xb_ld(&bar[XB_TOPGEN]) == tg, bar);
            __builtin_amdgcn_fence(__ATOMIC_ACQUIRE, "agent");
            xb_add(&bar[XB_XGEN(b.x)], 1u);
            asm volatile("s_waitcnt vmcnt(0)" ::: "memory");
        } else {
            XB_SPIN(xb_ld(&bar[XB_XGEN(b.x)]) == gen, bar);
            __builtin_amdgcn_fence(__ATOMIC_ACQUIRE, "agent");
            asm volatile("s_waitcnt vmcnt(0)" ::: "memory");
        }
    }
    __syncthreads();
}
typedef unsigned u32x4 __attribute__((ext_vector_type(4)));

typedef short s16x4 __attribute__((ext_vector_type(4)));
typedef float f32x16 __attribute__((ext_vector_type(16)));
typedef unsigned u32x2 __attribute__((ext_vector_type(2)));
typedef float f32x2v __attribute__((ext_vector_type(2)));

constexpr int S = 8192, D = 2048, DEPTH = 4, DIN = 5688, NP = 5888, PITCH = 5632;
constexpr int C_AQ = 0, C_AK = 512, C_AV = 1024, C_BQ = 1536, C_BK = 2048, C_BV = 2560, C_CQ = 3072, C_KC = 4096, C_VC = 4352, C_KS = 4608, C_VS = 4864, C_KW = 5120, C_VW = 5376;
constexpr float RMS_EPS = 1e-6f, NEG = -1e30f, LOG2E = 1.4426950408889634f, SCL2 = 0.125f * 1.4426950408889634f;
constexpr int NWAVES = 8, NTHR = 512;

constexpr size_t MiB = 1u << 20;
constexpr size_t WS_CTL = 0, CTL_ZERO_BYTES = 1 * MiB;
constexpr size_t WS_WIN = 2 * MiB;
constexpr size_t WS_WOUT = 96 * MiB;
constexpr size_t WS_W1T = 128 * MiB;
constexpr size_t WS_W2T = 136 * MiB;
constexpr size_t WS_RWT = 137 * MiB;
constexpr size_t WS_C1 = 139 * MiB;
constexpr size_t WS_X = 144 * MiB;
constexpr size_t WS_XN = 208 * MiB;
constexpr size_t WS_PROJ = 240 * MiB;
constexpr size_t WS_AUX = 330 * MiB;
constexpr size_t WS_CUM = 332 * MiB;
constexpr size_t WS_KC = 333 * MiB;
constexpr size_t WS_VC = 334 * MiB;
constexpr size_t WS_MIX = 336 * MiB;
constexpr size_t WS_YB = 368 * MiB;
constexpr size_t WS_LIST = 432 * MiB;
constexpr size_t WS_TW = 436 * MiB;
constexpr size_t WS_END = 440 * MiB;
constexpr int CW_BAR = 4096;
constexpr int CW_Q = 8192;
constexpr int CW_PQ = 24576, CW_PD = 25600;
constexpr int CW_CNT = 32768;

constexpr int LDS_BYTES = 160 * 1024;
constexpr int MISC_OFF = 150 * 1024;

struct Args { const float* in[23]; float* out; unsigned char* ws; int ph_lo, ph_hi; };
__device__ __forceinline__ int t5_bucket(int rel) { if (rel < 16) return rel; int b = 16;
    b += rel >= 19; b += rel >= 21; b += rel >= 24; b += rel >= 27; b += rel >= 31; b += rel >= 35; b += rel >= 40; b += rel >= 46; b += rel >= 52; b += rel >= 59; b += rel >= 67; b += rel >= 77; b += rel >= 87; b += rel >= 99; b += rel >= 113; return b; }

__device__ __forceinline__ float bf2f(unsigned short b) { return __uint_as_float((unsigned)b << 16); }
__device__ __forceinline__ float bflo(unsigned w) { return __uint_as_float(w << 16); }
__device__ __forceinline__ float bfhi(unsigned w) { return __uint_as_float(w & 0xffff0000u); }
typedef __bf16 bf16x2_t __attribute__((ext_vector_type(2)));
__device__ __forceinline__ unsigned cvtpk(float lo, float hi) { f32x2v v = {lo, hi}; bf16x2_t b = __builtin_convertvector(v, bf16x2_t); return __builtin_bit_cast(unsigned, b); }
__device__ __forceinline__ unsigned short f2bf16(float f) { return (unsigned short)(cvtpk(f, 0.f) & 0xffffu); }
__device__ __forceinline__ float wave_sum(float v) {
#pragma unroll
    for (int o = 1; o < 64; o <<= 1) v += __shfl_xor(v, o);
    return v;
}
__device__ __forceinline__ int crow(int r, int hi) { return (r & 3) + 8 * (r >> 2) + 4 * hi; }
#define MFMA32(a, b, c) __builtin_amdgcn_mfma_f32_32x32x16_bf16((a), (b), (c), 0, 0, 0)
#define MFMA16(a, b, c) __builtin_amdgcn_mfma_f32_16x16x32_bf16((a), (b), (c), 0, 0, 0)

__device__ __forceinline__ int src_col_win(int n) { if (n < 3072) return n; if (n < 5632) return n + 8; if (n < 5640) return n - 2560; if (n < 5688) return n; return -1; }

template <int MODE>
__device__ __forceinline__ void tr_item(const float* W, const float* W2, int ldw, int K, bf16* WT, int k0, int n0, LAS float* scr, int lane) {
    const int nn = n0 + (lane & 31);
    const float* src = W; int ld = ldw; bool ok = true;
    if (MODE == 0) { src = W + nn; }
    else if (MODE == 1) { const int c = src_col_win(nn); ok = c >= 0; src = W + (ok ? c : 0); }
    else { if (nn < 8) { src = W + nn; ld = 8; } else if (nn < 72) { src = W2 + (nn - 8); ld = 64; } else { ok = false; ld = 8; } }
    float tv[32];
#pragma unroll
    for (int i = 0; i < 32; ++i) { const int kk = 2 * i + (lane >> 5); tv[i] = ok ? src[(size_t)(k0 + kk) * ld] : 0.f; }
#pragma unroll
    for (int i = 0; i < 32; ++i) { const int kk = 2 * i + (lane >> 5); scr[kk * 33 + (lane & 31)] = tv[i]; }
    LDS_WAIT(); asm volatile("" ::: "memory");
    const int c = lane & 7;
#pragma unroll
    for (int j = 0; j < 4; ++j) { const int n = (lane >> 3) + 8 * j; const LAS float* s = scr + (8 * c) * 33 + n;
        v4u o; o.x = pk2(s[0 * 33], s[1 * 33]); o.y = pk2(s[2 * 33], s[3 * 33]); o.z = pk2(s[4 * 33], s[5 * 33]); o.w = pk2(s[6 * 33], s[7 * 33]);
        *(v4u*)(WT + (size_t)(n0 + n) * K + k0 + 8 * c) = o; }
    LDS_WAIT(); asm volatile("" ::: "memory");
}

template <int MODE>
__device__ __forceinline__ void norm_rows(const float* xsrc, const bf16* xb, bf16* X, bf16* XN, const bf16* YB, const float* TW, const float* gain, float* out, int gw, int NGW, int lane) {
    for (int row = gw; row < S; row += NGW) {
        f32x4 v[8];
        if (MODE == 0) { const f32x4* xr = (const f32x4*)(xsrc + (size_t)row * D) + lane;
#pragma unroll
            for (int j = 0; j < 8; ++j) v[j] = xr[64 * j];
        } else { const u32x2* xr = (const u32x2*)(xb + (size_t)row * D) + lane;
#pragma unroll
            for (int j = 0; j < 8; ++j) { const u32x2 r = xr[64 * j]; v[j] = (f32x4){bflo(r.x), bfhi(r.x), bflo(r.y), bfhi(r.y)}; } }
        if (MODE >= 1) {
            const float w0 = TW[2 * row], w1 = TW[2 * row + 1];
            const u32x2* ya = (const u32x2*)(YB + (size_t)(2 * row) * D) + lane; const u32x2* yb = (const u32x2*)(YB + (size_t)(2 * row + 1) * D) + lane;
#pragma unroll
            for (int j = 0; j < 8; ++j) { const u32x2 a = ya[64 * j], b = yb[64 * j];
                v[j].x += w0 * bflo(a.x) + w1 * bflo(b.x); v[j].y += w0 * bfhi(a.x) + w1 * bfhi(b.x);
                v[j].z += w0 * bflo(a.y) + w1 * bflo(b.y); v[j].w += w0 * bfhi(a.y) + w1 * bfhi(b.y); }
        }
        float ss = 0.f;
#pragma unroll
        for (int j = 0; j < 8; ++j) ss += (v[j].x * v[j].x + v[j].y * v[j].y) + (v[j].z * v[j].z + v[j].w * v[j].w);
        ss = wave_sum(ss);
        const float rstd = 1.0f / sqrtf(ss * (1.0f / D) + RMS_EPS);
        if (MODE == 1) { u32x2* xo = (u32x2*)(X + (size_t)row * D) + lane;
#pragma unroll
            for (int j = 0; j < 8; ++j) { u32x2 w; w.x = cvtpk(v[j].x, v[j].y); w.y = cvtpk(v[j].z, v[j].w); xo[64 * j] = w; } }
        const f32x4* gr = (const f32x4*)gain + lane;
        if (MODE < 2) { u32x2* o8 = (u32x2*)(XN + (size_t)row * D) + lane;
#pragma unroll
            for (int j = 0; j < 8; ++j) { const f32x4 g = gr[64 * j]; u32x2 w; w.x = cvtpk(v[j].x * rstd * g.x, v[j].y * rstd * g.y); w.y = cvtpk(v[j].z * rstd * g.z, v[j].w * rstd * g.w); o8[64 * j] = w; }
        } else { f32x4* oo = (f32x4*)(out + (size_t)row * D) + lane;
#pragma unroll
            for (int j = 0; j < 8; ++j) { const f32x4 g = gr[64 * j]; oo[64 * j] = v[j] * rstd * g; } }
    }
}

constexpr int I_WIN = 32 * 184, I_WOUT = 32 * 64, I_W1 = 32 * 8, I_W2 = 4 * 2, I_RW = 32 * 3, I_L = I_WIN + I_WOUT + 2 * I_W1 + 2 * I_W2 + I_RW;
__device__ __forceinline__ void tr_dispatch(const Args& a, unsigned char* ws, int it, LAS float* scr, int lane) {
        const int l = it / I_L; int r = it % I_L;
        if (r < I_WIN) { tr_item<1>(a.in[2] + (size_t)l * D * DIN, nullptr, DIN, D, (bf16*)(ws + WS_WIN) + (size_t)l * NP * D, 64 * (r / 184), 32 * (r % 184), scr, lane); return; } r -= I_WIN;
        if (r < I_WOUT) { tr_item<0>(a.in[13] + (size_t)l * D * D, nullptr, D, D, (bf16*)(ws + WS_WOUT) + (size_t)l * D * D, 64 * (r / 64), 32 * (r % 64), scr, lane); return; } r -= I_WOUT;
        if (r < 2 * I_W1) { const int kv = r / I_W1, q = r % I_W1; tr_item<0>(a.in[kv ? 10 : 7] + (size_t)l * 2048 * 256, nullptr, 256, 2048, (bf16*)(ws + WS_W1T) + (size_t)(l * 2 + kv) * 256 * 2048, 64 * (q / 8), 32 * (q % 8), scr, lane); return; } r -= 2 * I_W1;
        if (r < 2 * I_W2) { const int kv = r / I_W2, q = r % I_W2; tr_item<0>(a.in[kv ? 11 : 8] + (size_t)l * 256 * 64, nullptr, 64, 256, (bf16*)(ws + WS_W2T) + (size_t)(l * 2 + kv) * 64 * 256, 64 * (q / 2), 32 * (q % 2), scr, lane); return; } r -= 2 * I_W2;
        tr_item<2>(a.in[15] + (size_t)l * D * 8, a.in[17] + (size_t)l * D * 64, 8, D, (bf16*)(ws + WS_RWT) + (size_t)l * 96 * D, 64 * (r / 3), 32 * (r % 3), scr, lane);
}

__device__ __forceinline__ void p0_prologue(const Args& a, LAS unsigned char* lds, int bid, int G, int tid, int wid, int lane) {
    unsigned char* ws = a.ws;
    LAS float* scr = (LAS float*)(lds + wid * 8448);
    const int gw = bid * NWAVES + wid, NGW = G * NWAVES;
    for (int j = gw; j < DEPTH * I_WIN; j += NGW) tr_dispatch(a, ws, (j / I_WIN) * I_L + (j % I_WIN), scr, lane);
    for (int b = bid; b < 256; b += G) {
        const int vec = b >> 5, cb = b & 31, l = vec >> 1, kv = vec & 1; const float* pos = a.in[kv ? 9 : 6] + (size_t)l * 2048; const float* w1 = a.in[kv ? 10 : 7] + (size_t)l * 2048 * 256 + 8 * cb;
        float acc[8];
#pragma unroll
        for (int i = 0; i < 8; ++i) acc[i] = 0.f;
#pragma unroll
        for (int j = 0; j < 4; ++j) { const int k = tid + 512 * j; const float pv = pos[k]; const f32x4 w0 = *(const f32x4*)(w1 + (size_t)k * 256), w1v = *(const f32x4*)(w1 + (size_t)k * 256 + 4);
            acc[0] += pv * w0.x; acc[1] += pv * w0.y; acc[2] += pv * w0.z; acc[3] += pv * w0.w; acc[4] += pv * w1v.x; acc[5] += pv * w1v.y; acc[6] += pv * w1v.z; acc[7] += pv * w1v.w; }
        LAS float* red = (LAS float*)(lds + 72 * 1024);
#pragma unroll
        for (int i = 0; i < 8; ++i) { const float sws = wave_sum(acc[i]); if (lane == 0) red[wid * 8 + i] = sws; }
        __syncthreads();
        if (tid < 8) { float sres = 0.f;
#pragma unroll
            for (int w = 0; w < 8; ++w) sres += red[w * 8 + tid];
            ((float*)(ws + WS_C1))[vec * 256 + 8 * cb + tid] = sres; }
        __syncthreads();
    }
    norm_rows<0>(a.in[0], nullptr, nullptr, (bf16*)(ws + WS_XN), nullptr, nullptr, a.in[1], nullptr, gw, NGW, lane);
}

__device__ __forceinline__ float gelu_tanh(float x) { const float u = 0.7978845608028654f * (x + 0.044715f * x * x * x); const float t = 1.0f - 2.0f / (__expf(2.0f * u) + 1.0f); return 0.5f * x * (1.0f + t); }

__device__ __forceinline__ void compress_unit(int u, int l, const bf16* PROJ, const bf16* W1T, const bf16* W2T, const float* C1, bf16* KC, bf16* VC, LAS unsigned char* lds, int wid, int lane) {
    const int kv = u >> 6, rb = u & 63, r32 = lane & 31, hi = lane >> 5;
    const int R = 32 * rb + r32, g = R >> 9, n = R & 511;
    const int colb = (kv ? C_VC : C_KC) + 64 * g;
    const bf16* w1 = W1T + (size_t)(l * 2 + kv) * 256 * 2048 + (size_t)(32 * wid + r32) * 2048 + 8 * hi;
    const bf16* arow = PROJ + colb + 8 * hi;
    f32x16 acc = {};
#pragma unroll 4
    for (int s = 0; s < 128; ++s) {
        int tok = 16 * n + (s >> 2); tok = tok > (S - 1) ? (S - 1) : tok;
        const bf16x8 av = *(const bf16x8*)(arow + (size_t)tok * PITCH + (s & 3) * 16);
        const bf16x8 bv = *(const bf16x8*)(w1 + 16 * s);
        acc = MFMA32(av, bv, acc);
    }
    LAS bf16* hid = (LAS bf16*)lds;
    const float c1 = C1[(l * 2 + kv) * 256 + 32 * wid + r32];
#pragma unroll
    for (int r = 0; r < 16; ++r) hid[crow(r, hi) * 264 + 32 * wid + r32] = f2bf16(gelu_tanh(acc[r] + c1));
    __syncthreads();
    if (wid < 2) {
        f32x16 acc2 = {};
        const bf16* w2 = W2T + (size_t)(l * 2 + kv) * 64 * 256 + (size_t)(32 * wid + r32) * 256 + 8 * hi;
#pragma unroll 4
        for (int s = 0; s < 16; ++s) {
            const bf16x8 av = *(const LAS bf16x8*)(hid + r32 * 264 + 16 * s + 8 * hi);
            const bf16x8 bv = *(const bf16x8*)(w2 + 16 * s);
            acc2 = MFMA32(av, bv, acc2);
        }
        bf16* outp = kv ? VC : KC;
#pragma unroll
        for (int r = 0; r < 16; ++r) { const int Rr = 32 * rb + crow(r, hi); outp[(size_t)((Rr >> 9) * 512 + (Rr & 511)) * 64 + 32 * wid + r32] = f2bf16(acc2[r]); }
    }
    __syncthreads();
}

__device__ __forceinline__ void cumsum_unit(int h, int l, const float* AUX, const float* fox_bf, float* CUM, LAS unsigned char* lds, int tid) {
    const float bfv = fox_bf[l * 8 + h];
    float v[16]; float run = 0.f;
#pragma unroll
    for (int i = 0; i < 16; ++i) { const int t = 16 * tid + i; const float z = AUX[(size_t)t * 64 + h] + bfv; const float lf = fminf(z, 0.f) - log1pf(__expf(-fabsf(z))); run += lf; v[i] = run; }
    LAS float* tot = (LAS float*)lds;
    tot[tid] = run; __syncthreads();
    float off = 0.f;
    for (int j = 0; j < tid; ++j) off += tot[j];
#pragma unroll
    for (int i = 0; i < 16; ++i) CUM[(size_t)h * S + 16 * tid + i] = off + v[i];
    __syncthreads();
}

__device__ __forceinline__ int koff(int key, int c) { return c * 1024 + (((key + c) & 63) << 4); }
__device__ __forceinline__ int voff(int key, int c) { return (c >> 2) * 4096 + (key >> 4) * 1024 + (key & 15) * 64 + (c & 3) * 16; }
typedef short v4i16_t __attribute__((ext_vector_type(4)));
__device__ __forceinline__ s16x4 vtr(LAS const unsigned char* p) { return __builtin_bit_cast(s16x4, __builtin_amdgcn_ds_read_tr16_b64_v4i16((LAS v4i16_t*)p)); }

template <int NDT> struct AState { float m, l; f32x16 o[NDT]; };
template <int NDT> __device__ __forceinline__ void astate_init(AState<NDT>& st) { st.m = 0.f; st.l = 0.f;
#pragma unroll
    for (int i = 0; i < NDT; ++i) st.o[i] = (f32x16){}; }

template <bool QLDS>
__device__ __forceinline__ void qk_tile(f32x16& p0, f32x16& p1, LAS const unsigned char* kt, int kchunk0, const bf16x8 (&qf)[4], LAS const unsigned char* qb, int r32, int hi) {
    bf16x8 ka[4], kb[4], q[4];
#pragma unroll
    for (int d0 = 0; d0 < 4; ++d0) {
        const int c = kchunk0 + 2 * d0 + hi;
        ka[d0] = *(const LAS bf16x8*)(kt + koff(r32, c));
        kb[d0] = *(const LAS bf16x8*)(kt + koff(r32 + 32, c));
        q[d0] = QLDS ? *(const LAS bf16x8*)(qb + d0 * 8192) : qf[d0];
    }
    __builtin_amdgcn_sched_barrier(0);
    p0 = (f32x16){}; p1 = (f32x16){};
#pragma unroll
    for (int d0 = 0; d0 < 4; ++d0) { p0 = MFMA32(ka[d0], q[d0], p0); p1 = MFMA32(kb[d0], q[d0], p1); }
    __builtin_amdgcn_sched_barrier(0);
}
__device__ __forceinline__ void pack_p(bf16x8 (&pw)[4], const f32x16& p0, const f32x16& p1) {
    u32x4 w;
    w.x = cvtpk(p0[0], p0[1]); w.y = cvtpk(p0[2], p0[3]); w.z = cvtpk(p0[4], p0[5]); w.w = cvtpk(p0[6], p0[7]); pw[0] = __builtin_bit_cast(bf16x8, w);
    w.x = cvtpk(p0[8], p0[9]); w.y = cvtpk(p0[10], p0[11]); w.z = cvtpk(p0[12], p0[13]); w.w = cvtpk(p0[14], p0[15]); pw[1] = __builtin_bit_cast(bf16x8, w);
    w.x = cvtpk(p1[0], p1[1]); w.y = cvtpk(p1[2], p1[3]); w.z = cvtpk(p1[4], p1[5]); w.w = cvtpk(p1[6], p1[7]); pw[2] = __builtin_bit_cast(bf16x8, w);
    w.x = cvtpk(p1[8], p1[9]); w.y = cvtpk(p1[10], p1[11]); w.z = cvtpk(p1[12], p1[13]); w.w = cvtpk(p1[14], p1[15]); pw[3] = __builtin_bit_cast(bf16x8, w);
}
struct VFrag { s16x4 lo[4], hh[4]; };
__device__ __forceinline__ LAS const unsigned char* vfrag_base(LAS const unsigned char* vt, int lane) { return vt + ((lane >> 4) & 1) * 32 + (lane & 3) * 8 + (4 * (lane >> 5) + ((lane & 15) >> 2)) * 64; }
__device__ __forceinline__ void vfrag_read(VFrag& f, LAS const unsigned char* vb, int dt) {
#pragma unroll
    for (int s = 0; s < 4; ++s) { f.lo[s] = vtr(vb + dt * 4096 + s * 1024); f.hh[s] = vtr(vb + dt * 4096 + s * 1024 + 512); }
}
__device__ __forceinline__ void vfrag_mma(f32x16& o, const VFrag& f, const bf16x8 (&pw)[4]) {
#pragma unroll
    for (int s = 0; s < 4; ++s) { const bf16x8 vf = (bf16x8){f.lo[s][0], f.lo[s][1], f.lo[s][2], f.lo[s][3], f.hh[s][0], f.hh[s][1], f.hh[s][2], f.hh[s][3]}; o = MFMA32(vf, pw[s], o); }
}
template <int NDT>
__device__ __forceinline__ void pv_tile_pre(f32x16 (&o)[NDT], const bf16x8 (&pw)[4], LAS const unsigned char* vb, VFrag& f0) {
    VFrag f1;
#pragma unroll
    for (int dt = 0; dt < NDT; dt += 2) {
        if (dt + 1 < NDT) vfrag_read(f1, vb, dt + 1);
        __builtin_amdgcn_sched_barrier(0);
        vfrag_mma(o[dt], f0, pw);
        if (dt + 1 < NDT) {
            if (dt + 2 < NDT) vfrag_read(f0, vb, dt + 2);
            __builtin_amdgcn_sched_barrier(0);
            vfrag_mma(o[dt + 1], f1, pw);
        }
    }
}
template <int NDT>
__device__ __forceinline__ void pv_tile(f32x16 (&o)[NDT], const bf16x8 (&pw)[4], LAS const unsigned char* vt, int lane) {
    LAS const unsigned char* vb = vfrag_base(vt, lane);
    VFrag f0; vfrag_read(f0, vb, 0);
    pv_tile_pre<NDT>(o, pw, vb, f0);
}
constexpr float SM_THR = 8.0f;
__device__ __forceinline__ float max3f(float a, float b, float c) { return __builtin_fmaxf(__builtin_fmaxf(a, b), c); }
__device__ __forceinline__ float halfmax(float m) { auto rr = __builtin_amdgcn_permlane32_swap(__float_as_uint(m), __float_as_uint(m), false, false); return fmaxf(__uint_as_float(rr[0]), __uint_as_float(rr[1])); }
__device__ __forceinline__ float halfsum(float v) { auto rr = __builtin_amdgcn_permlane32_swap(__float_as_uint(v), __float_as_uint(v), false, false); return __uint_as_float(rr[0]) + __uint_as_float(rr[1]); }
#ifndef SM_VPRE
#define SM_VPRE false
#endif
template <int NDT>
__device__ __forceinline__ void softmax_pv(AState<NDT>& st, f32x16& p0, f32x16& p1, LAS const unsigned char* vt, int lane) {
    LAS const unsigned char* vb = vfrag_base(vt, lane);
    constexpr bool VPRE = SM_VPRE;
    VFrag f0; if (VPRE) { vfrag_read(f0, vb, 0); __builtin_amdgcn_sched_barrier(0); }
    float ma = max3f(p0[0], p0[1], p0[2]), mb = max3f(p1[0], p1[1], p1[2]);
#pragma unroll
    for (int r = 3; r < 15; r += 2) { ma = max3f(ma, p0[r], p0[r + 1]); mb = max3f(mb, p1[r], p1[r + 1]); }
    float mx = max3f(ma, mb, fmaxf(p0[15], p1[15]));
    mx = halfmax(mx);
    if (__any(mx > SM_THR)) {
        const float d = fmaxf(mx, 0.f), alpha = __builtin_amdgcn_exp2f(-d); st.m += d; st.l *= alpha;
#pragma unroll
        for (int r = 0; r < 16; ++r) { p0[r] -= d; p1[r] -= d; }
#pragma unroll
        for (int dt = 0; dt < NDT; ++dt)
#pragma unroll
            for (int r = 0; r < 16; ++r) st.o[dt][r] *= alpha;
    }
    float rs = 0.f;
#pragma unroll
    for (int r = 0; r < 16; ++r) { p0[r] = __builtin_amdgcn_exp2f(p0[r]); p1[r] = __builtin_amdgcn_exp2f(p1[r]); rs += p0[r] + p1[r]; }
    st.l += rs;
    bf16x8 pw[4]; pack_p(pw, p0, p1);
    if (!VPRE) vfrag_read(f0, vb, 0);
    pv_tile_pre<NDT>(st.o, pw, vb, f0);
}
__device__ __forceinline__ void softmax_stats(float& m, float& l, const f32x16& p0, const f32x16& p1) {
    float mx = fmaxf(p0[0], p1[0]);
#pragma unroll
    for (int r = 1; r < 16; ++r) mx = fmaxf(mx, fmaxf(p0[r], p1[r]));
    mx = halfmax(mx);
    const float mn = fmaxf(m, mx), alpha = __builtin_amdgcn_exp2f(m - mn); m = mn;
    float rs = 0.f;
#pragma unroll
    for (int r = 0; r < 16; ++r) rs += __builtin_amdgcn_exp2f(p0[r] - mn) + __builtin_amdgcn_exp2f(p1[r] - mn);
    l = l * alpha + rs;
}

template <int KCH, int VCH> struct Stage { u32x4 k[KCH / 8], v[VCH / 8], x; };
template <int KCH, int VCH, bool XROW>
__device__ __forceinline__ void stage_load(Stage<KCH, VCH>& sg, const bf16* ksrc, const bf16* vsrc, const float* xsrc, size_t pitch, int key0, int tid) {
#pragma unroll
    for (int i = 0; i < KCH / 8; ++i) { const int idx = tid + 512 * i, key = idx / KCH, c = idx % KCH; sg.k[i] = *(const u32x4*)(ksrc + (size_t)(key0 + key) * pitch + 8 * c); }
#pragma unroll
    for (int i = 0; i < VCH / 8; ++i) { const int idx = tid + 512 * i, key = idx / VCH, c = idx % VCH; sg.v[i] = *(const u32x4*)(vsrc + (size_t)(key0 + key) * pitch + 8 * c); }
    if (XROW) sg.x = *(const u32x4*)(xsrc + key0 + 4 * (tid & 15));
}
template <int KCH, int VCH, bool XROW>
__device__ __forceinline__ void stage_write(const Stage<KCH, VCH>& sg, LAS unsigned char* kb, LAS unsigned char* vb, LAS unsigned char* xb, int tid) {
#pragma unroll
    for (int i = 0; i < KCH / 8; ++i) { const int idx = tid + 512 * i, key = idx / KCH, c = idx % KCH; *(LAS u32x4*)(kb + koff(key, c)) = sg.k[i]; }
#pragma unroll
    for (int i = 0; i < VCH / 8; ++i) { const int idx = tid + 512 * i, key = idx / VCH, c = idx % VCH; *(LAS u32x4*)(vb + voff(key, c)) = sg.v[i]; }
    if (XROW) { if (tid < 16) { f32x4 xv = __builtin_bit_cast(f32x4, sg.x); xv = xv * LOG2E; *(LAS f32x4*)(xb + 16 * tid) = xv; } }
}

template <int KCH, int VCH, bool XROW, int NST  , bool QLDS, class Fn>
__device__ __forceinline__ void kv_loop(Fn& fn, const bf16x8 (&qf)[4], LAS const unsigned char* qb, int kchunk0, const bf16* ksrc, const bf16* vsrc, const float* xsrc, size_t pitch, int t_lo, int t_hi,
                                        LAS unsigned char* KB, LAS unsigned char* VB, LAS unsigned char* XB, int tid, int lane) {
    constexpr int KBYTES = KCH * 1024, VBYTES = VCH * 1024;
    const int r32 = lane & 31, hi = lane >> 5, nt = t_hi - t_lo;
    if (NST == 1) {
        Stage<KCH, VCH> sg;
        stage_load<KCH, VCH, XROW>(sg, ksrc, vsrc, xsrc, pitch, 64 * t_lo, tid);
        stage_write<KCH, VCH, XROW>(sg, KB, VB, XB, tid);
        __syncthreads();
        for (int i = 0; i < nt; ++i) {
            const int b = i & 1;
            if (i + 1 < nt) stage_load<KCH, VCH, XROW>(sg, ksrc, vsrc, xsrc, pitch, 64 * (t_lo + i + 1), tid);
            if (fn.need(t_lo + i)) { f32x16 p0, p1; qk_tile<QLDS>(p0, p1, KB + b * KBYTES, kchunk0, qf, qb, r32, hi); fn.tile(t_lo + i, p0, p1, VB + b * VBYTES, XB + b * 256); }
            if (i + 1 < nt) stage_write<KCH, VCH, XROW>(sg, KB + (b ^ 1) * KBYTES, VB + (b ^ 1) * VBYTES, XB + (b ^ 1) * 256, tid);
            __syncthreads();
        }
        return;
    }
    Stage<KCH, VCH> sgA, sgB;
    stage_load<KCH, VCH, XROW>(sgA, ksrc, vsrc, xsrc, pitch, 64 * t_lo, tid);
    if (nt > 1) stage_load<KCH, VCH, XROW>(sgB, ksrc, vsrc, xsrc, pitch, 64 * (t_lo + 1), tid);
    stage_write<KCH, VCH, XROW>(sgA, KB, VB, XB, tid);
    __syncthreads();
    for (int i = 0; i < nt; i += 2) {
        if (i + 2 < nt) stage_load<KCH, VCH, XROW>(sgA, ksrc, vsrc, xsrc, pitch, 64 * (t_lo + i + 2), tid);
        if (fn.need(t_lo + i)) { f32x16 p0, p1; qk_tile<QLDS>(p0, p1, KB, kchunk0, qf, qb, r32, hi); fn.tile(t_lo + i, p0, p1, VB, XB); }
        if (i + 1 < nt) stage_write<KCH, VCH, XROW>(sgB, KB + KBYTES, VB + VBYTES, XB + 256, tid);
        __syncthreads();
        if (i + 1 >= nt) break;
        if (i + 3 < nt) stage_load<KCH, VCH, XROW>(sgB, ksrc, vsrc, xsrc, pitch, 64 * (t_lo + i + 3), tid);
        if (fn.need(t_lo + i + 1)) { f32x16 p0, p1; qk_tile<QLDS>(p0, p1, KB + KBYTES, kchunk0, qf, qb, r32, hi); fn.tile(t_lo + i + 1, p0, p1, VB + VBYTES, XB + 256); }
        if (i + 2 < nt) stage_write<KCH, VCH, XROW>(sgA, KB, VB, XB, tid);
        __syncthreads();
    }
}

#define SGB(mask, n) __builtin_amdgcn_sched_group_barrier(mask, n, 0)
template <int NDT>
__device__ __forceinline__ void sp_finish(AState<NDT>& st, f32x16& s0, f32x16& s1, bf16x8 (&pw)[4]) {
    float rs = 0.f;
#pragma unroll
    for (int r = 0; r < 16; ++r) { s0[r] = __builtin_amdgcn_exp2f(s0[r]); s1[r] = __builtin_amdgcn_exp2f(s1[r]); rs += s0[r] + s1[r]; }
    st.l += rs;
    pack_p(pw, s0, s1);
}
__device__ __forceinline__ float sp_rowmax(const f32x16& p0, const f32x16& p1) {
    float ma = max3f(p0[0], p0[1], p0[2]), mb = max3f(p1[0], p1[1], p1[2]);
#pragma unroll
    for (int r = 3; r < 15; r += 2) { ma = max3f(ma, p0[r], p0[r + 1]); mb = max3f(mb, p1[r], p1[r + 1]); }
    return max3f(ma, mb, fmaxf(p0[15], p1[15]));
}
template <int NDT>
__device__ __forceinline__ void sp_raise(AState<NDT>& st, f32x16& p0, f32x16& p1, float mx) {
    mx = halfmax(mx);
    if (__any(mx > SM_THR)) {
        const float d = fmaxf(mx, 0.f), alpha = __builtin_amdgcn_exp2f(-d); st.m += d; st.l *= alpha;
#pragma unroll
        for (int r = 0; r < 16; ++r) { p0[r] -= d; p1[r] -= d; }
#pragma unroll
        for (int dt = 0; dt < NDT; ++dt)
#pragma unroll
            for (int r = 0; r < 16; ++r) st.o[dt][r] *= alpha;
    }
}
__device__ __forceinline__ void sp_finish_part(int j, float& rs, f32x16& s0, f32x16& s1, u32x4 (&pu)[4]) {
#pragma unroll
    for (int r = 4 * j; r < 4 * j + 4; ++r) { s0[r] = __builtin_amdgcn_exp2f(s0[r]); s1[r] = __builtin_amdgcn_exp2f(s1[r]); rs += s0[r] + s1[r]; }
    const unsigned a0 = cvtpk(s0[4 * j], s0[4 * j + 1]), a1 = cvtpk(s0[4 * j + 2], s0[4 * j + 3]), b0 = cvtpk(s1[4 * j], s1[4 * j + 1]), b1 = cvtpk(s1[4 * j + 2], s1[4 * j + 3]);
    if (j & 1) { pu[j >> 1].z = a0; pu[j >> 1].w = a1; pu[2 + (j >> 1)].z = b0; pu[2 + (j >> 1)].w = b1; }
    else       { pu[j >> 1].x = a0; pu[j >> 1].y = a1; pu[2 + (j >> 1)].x = b0; pu[2 + (j >> 1)].y = b1; }
}
#define SP_STEADY(T, KBUF, XBUF, SP0, SP1, SN0, SN1)                                                                                                    \
    {   bf16x8 ka[4], kb[4], q[4];                                                                                                                      \
        _Pragma("unroll") for (int d0 = 0; d0 < 4; ++d0) { const int c = kchunk0 + 2 * d0 + hi;                                                         \
            ka[d0] = *(const LAS bf16x8*)((KBUF) + koff(r32, c)); kb[d0] = *(const LAS bf16x8*)((KBUF) + koff(r32 + 32, c));                             \
            q[d0] = QLDS ? *(const LAS bf16x8*)(qb + d0 * 8192) : qf[d0]; }                                                                             \
        LAS const unsigned char* vb = vfrag_base(VB + vp * VBYTES, lane);                                                                               \
        VFrag f0, f1; u32x4 pu[4]; float rs = 0.f;                                                                                                      \
        __builtin_amdgcn_sched_barrier(0);                                                                                                              \
        SN0 = (f32x16){}; SN1 = (f32x16){};                                                                                                             \
        _Pragma("unroll") for (int j = 0; j < 4; ++j) {                                                                                                 \
            SN0 = MFMA32(ka[j], q[j], SN0); SN1 = MFMA32(kb[j], q[j], SN1);                                                                             \
            sp_finish_part(j, rs, SP0, SP1, pu);                                                                                                        \
            if (NDT == 2 && j == 2) vfrag_read(f0, vb, 0);                                                                                              \
            if (NDT == 2 && j == 3) vfrag_read(f1, vb, 1);                                                                                              \
            __builtin_amdgcn_sched_barrier(0);                                                                                                          \
        }                                                                                                                                               \
        fn.st.l += rs;                                                                                                                                  \
        _Pragma("unroll") for (int k = 0; k < 4; ++k) pw[k] = __builtin_bit_cast(bf16x8, pu[k]);                                                        \
        float mx = NEG;                                                                                                                                 \
        _Pragma("unroll") for (int dt = 0; dt < NDT; dt += 2) {                                                                                         \
            if (NDT != 2) { vfrag_read(f0, vb, dt); vfrag_read(f1, vb, dt + 1); __builtin_amdgcn_sched_barrier(0); }                                    \
            _Pragma("unroll") for (int sx = 0; sx < 4; ++sx) {                                                                                          \
                { const bf16x8 vf = (bf16x8){f0.lo[sx][0], f0.lo[sx][1], f0.lo[sx][2], f0.lo[sx][3], f0.hh[sx][0], f0.hh[sx][1], f0.hh[sx][2], f0.hh[sx][3]}; fn.st.o[dt] = MFMA32(vf, pw[sx], fn.st.o[dt]); } \
                { const bf16x8 vf = (bf16x8){f1.lo[sx][0], f1.lo[sx][1], f1.lo[sx][2], f1.lo[sx][3], f1.hh[sx][0], f1.hh[sx][1], f1.hh[sx][2], f1.hh[sx][3]}; fn.st.o[dt + 1] = MFMA32(vf, pw[sx], fn.st.o[dt + 1]); } \
                if (dt == 0) { fn.score_part(sx, T, SN0, SN1, XBUF); mx = fn.max_part(sx, mx, SN0, SN1); }                                              \
                __builtin_amdgcn_sched_barrier(0);                                                                                                      \
            }                                                                                                                                           \
        }                                                                                                                                               \
        mx = fn.score_mask(T, mx, SN0, SN1);                                                                                                            \
        sp_raise<NDT>(fn.st, SN0, SN1, mx); }
template <int KCH, int VCH, bool XROW, bool QLDS, int NDT, class Fn>
__device__ __forceinline__ void kv_loop_sp(Fn& fn, const bf16x8 (&qf)[4], LAS const unsigned char* qb, int kchunk0, const bf16* ksrc, const bf16* vsrc, const float* xsrc, size_t pitch, int t_lo, int t_hi, int nw,
                                           LAS unsigned char* KB, LAS unsigned char* VB, LAS unsigned char* XB, int tid, int lane) {
    constexpr int KBYTES = KCH * 1024, VBYTES = VCH * 1024;
    const int r32 = lane & 31, hi = lane >> 5, nt = t_hi - t_lo;
    Stage<KCH, VCH> sg;
    stage_load<KCH, VCH, XROW>(sg, ksrc, vsrc, xsrc, pitch, 64 * t_lo, tid);
    stage_write<KCH, VCH, XROW>(sg, KB, VB, XB, tid);
    __syncthreads();
    f32x16 sa0, sa1, sb0, sb1; bf16x8 pw[4];
    int vc = 0, vp = 2, vn, i = 0;
#define SP_PRE(I)  if ((I) + 1 < nt) stage_load<KCH, VCH, XROW>(sg, ksrc, vsrc, xsrc, pitch, 64 * (t_lo + (I) + 1), tid);
#define SP_POST(I, KOFFN, XOFFN) vn = vc == 2 ? 0 : vc + 1; if ((I) + 1 < nt) stage_write<KCH, VCH, XROW>(sg, KB + (KOFFN), VB + vn * VBYTES, XB + (XOFFN), tid); __syncthreads(); vp = vc; vc = vn;
    SP_PRE(0)
    qk_tile<QLDS>(sa0, sa1, KB, kchunk0, qf, qb, r32, hi); fn.score(t_lo, sa0, sa1, XB); sp_raise<NDT>(fn.st, sa0, sa1, sp_rowmax(sa0, sa1));
    SP_POST(0, KBYTES, 256)
    i = 1;
    while (i + 1 < nw) {
        SP_PRE(i)
        SP_STEADY(t_lo + i, KB + KBYTES, XB + 256, sa0, sa1, sb0, sb1)
        SP_POST(i, 0, 0)
        SP_PRE(i + 1)
        SP_STEADY(t_lo + i + 1, KB, XB, sb0, sb1, sa0, sa1)
        SP_POST(i + 1, KBYTES, 256)
        i += 2;
    }
    if (i < nw) {
        SP_PRE(i)
        SP_STEADY(t_lo + i, KB + KBYTES, XB + 256, sa0, sa1, sb0, sb1)
        SP_POST(i, 0, 0)
        sa0 = sb0; sa1 = sb1; ++i;
    }
    if (i < nt) { SP_PRE(i) }
    sp_finish<NDT>(fn.st, sa0, sa1, pw); pv_tile<NDT>(fn.st.o, pw, VB + vp * VBYTES, lane);
    if (i < nt) { const int ko = (i & 1) ? 0 : KBYTES, xo = (i & 1) ? 0 : 256; SP_POST(i, ko, xo) ++i; }
    while (i < nt) { const int ko = (i & 1) ? 0 : KBYTES, xo = (i & 1) ? 0 : 256; SP_PRE(i) SP_POST(i, ko, xo) ++i; }
    __syncthreads();
#undef SP_PRE
#undef SP_POST
}

struct FoxFn {
    AState<2> st; float cq; int tq, tmin, tmax, lane;
    __device__ __forceinline__ bool need(int t) const { return 64 * t <= tmax; }
    __device__ __forceinline__ void score_part(int a, int t, f32x16& p0, f32x16& p1, LAS const unsigned char* xrow) {
        const int hi = lane >> 5; LAS const float* ck = (LAS const float*)xrow;
        const float cqm = cq - st.m;
        const f32x4 c0 = *(LAS const f32x4*)(ck + 8 * a + 4 * hi), c1 = *(LAS const f32x4*)(ck + 32 + 8 * a + 4 * hi);
#pragma unroll
        for (int i = 0; i < 4; ++i) { const int r = 4 * a + i; p0[r] = p0[r] * SCL2 + (cqm - c0[i]); p1[r] = p1[r] * SCL2 + (cqm - c1[i]); }
    }
    __device__ __forceinline__ float max_part(int a, float mx, const f32x16& p0, const f32x16& p1) const {
        return max3f(max3f(mx, p0[4 * a], p0[4 * a + 1]), max3f(p0[4 * a + 2], p0[4 * a + 3], p1[4 * a]), max3f(p1[4 * a + 1], p1[4 * a + 2], p1[4 * a + 3])); }
    __device__ __forceinline__ float score_mask(int t, float mx, f32x16& p0, f32x16& p1) const {
        const int hi = lane >> 5, k0 = 64 * t;
        if (k0 + 63 > tmin) {
#pragma unroll
            for (int r = 0; r < 16; ++r) { const int key = k0 + crow(r, hi); p0[r] = key <= tq ? p0[r] : NEG; p1[r] = key + 32 <= tq ? p1[r] : NEG; }
            mx = sp_rowmax(p0, p1);
        }
        return mx;
    }
    __device__ __forceinline__ void score(int t, f32x16& p0, f32x16& p1, LAS const unsigned char* xrow) {
#pragma unroll
        for (int a = 0; a < 4; ++a) score_part(a, t, p0, p1, xrow);
        score_mask(t, 0.f, p0, p1);
    }
};
__device__ __forceinline__ void fox_unit(int h, int qb, const bf16* PROJ, const float* CUM, bf16* MIX, LAS unsigned char* lds, int tid, int wid, int lane) {
    const int r32 = lane & 31, hi = lane >> 5, q0 = 256 * qb, tq = q0 + 32 * wid + r32;
    bf16x8 qf[4];
#pragma unroll
    for (int d0 = 0; d0 < 4; ++d0) qf[d0] = *(const bf16x8*)(PROJ + (size_t)tq * PITCH + C_BQ + 64 * h + 16 * d0 + 8 * hi);
    const float* cum = CUM + (size_t)h * S;
    FoxFn fn; astate_init<2>(fn.st); fn.cq = cum[tq] * LOG2E; fn.tq = tq; fn.tmin = q0 + 32 * wid; fn.tmax = q0 + 32 * wid + 31; fn.lane = lane;
    kv_loop_sp<8, 8, true, false, 2>(fn, qf, lds, 0, PROJ + C_BK + 64 * h, PROJ + C_BV + 64 * h, cum, PITCH, 0, 4 * (qb + 1), min(4 * (qb + 1), (fn.tmax >> 6) + 1), lds, lds + 16384, lds + 40960, tid, lane);
    const float lt = fn.st.l + __shfl_xor(fn.st.l, 32), inv = 1.0f / lt;
    bf16* orow = MIX + (size_t)tq * D + 512 + 64 * h;
#pragma unroll
    for (int dt = 0; dt < 2; ++dt)
#pragma unroll
        for (int a = 0; a < 4; ++a) { u32x2 w; w.x = cvtpk(fn.st.o[dt][4 * a] * inv, fn.st.o[dt][4 * a + 1] * inv); w.y = cvtpk(fn.st.o[dt][4 * a + 2] * inv, fn.st.o[dt][4 * a + 3] * inv);
            *(u32x2*)(orow + 32 * dt + 8 * a + 4 * hi) = w; }
}

struct DiffFn {
    AState<4> st; LAS const float* lut; int tq, tmin, tmax, lane;
    __device__ __forceinline__ bool need(int t) const { return 64 * t <= tmax; }
    __device__ __forceinline__ void tile(int t, f32x16& p0, f32x16& p1, LAS const unsigned char* vt, LAS const unsigned char*) {
        const int hi = lane >> 5, k0 = 64 * t;
        const float mref = st.m;
        if (k0 + 63 + 127 <= tmin) {
            const float b = lut[127] - mref;
#pragma unroll
            for (int r = 0; r < 16; ++r) { p0[r] = p0[r] * SCL2 + b; p1[r] = p1[r] * SCL2 + b; }
        } else {
#pragma unroll
            for (int r = 0; r < 16; ++r) { const int rel0 = tq - (k0 + crow(r, hi)); const float b0 = lut[min(max(rel0, 0), 127)] - mref; p0[r] = rel0 >= 0 ? p0[r] * SCL2 + b0 : NEG; }
            __builtin_amdgcn_sched_barrier(0);
#pragma unroll
            for (int r = 0; r < 16; ++r) { const int rel1 = tq - (k0 + 32 + crow(r, hi)); const float b1 = lut[min(max(rel1, 0), 127)] - mref; p1[r] = rel1 >= 0 ? p1[r] * SCL2 + b1 : NEG; }
            __builtin_amdgcn_sched_barrier(0);
        }
        softmax_pv<4>(st, p0, p1, vt, lane);
    }
};
__device__ __forceinline__ void diff_unit(int h, int qb, int l, const Args& a, const bf16* PROJ, bf16* MIX, LAS unsigned char* lds, int tid, int wid, int lane) {
    const int r32 = lane & 31, hi = lane >> 5, q0 = 128 * qb, map = wid & 1, qs = wid >> 1, tq = q0 + 32 * qs + r32;
    LAS float* lut = (LAS float*)(lds + 65536); LAS float* lamw = (LAS float*)(lds + 65536 + 512);
    const float lam_init = 0.8f - 0.6f * expf(-0.3f * (float)l);
    if (tid < 128) lut[tid] = a.in[12][t5_bucket(tid) * 20 + h] * LOG2E;
    if (wid == 0) { const float* dl = a.in[3] + (size_t)l * 256;
        const float s1 = wave_sum(dl[lane] * dl[64 + lane]), s2 = wave_sum(dl[128 + lane] * dl[192 + lane]);
        if (lane == 0) lamw[0] = expf(s1) - expf(s2) + lam_init; }
    bf16x8 qf[4];
#pragma unroll
    for (int d0 = 0; d0 < 4; ++d0) qf[d0] = *(const bf16x8*)(PROJ + (size_t)tq * PITCH + C_AQ + 128 * h + 64 * map + 16 * d0 + 8 * hi);
    DiffFn fn; astate_init<4>(fn.st); fn.lut = lut; fn.tq = tq; fn.tmin = q0 + 32 * qs; fn.tmax = q0 + 32 * qs + 31; fn.lane = lane;
    LAS unsigned char* const qlds = lds + 67584 + tid * 16;
#pragma unroll
    for (int d0 = 0; d0 < 4; ++d0) *(LAS bf16x8*)(qlds + d0 * 8192) = qf[d0];
    kv_loop<16, 16, false, 1, true>(fn, qf, qlds, 8 * map, PROJ + C_AK + 128 * h, PROJ + C_AV + 128 * h, nullptr, PITCH, 0, 2 * (qb + 1), lds, lds + 32768, lds, tid, lane);
    const float lt = fn.st.l + __shfl_xor(fn.st.l, 32), inv = 1.0f / lt;
    LAS float* ex = (LAS float*)(lds + qs * 16384);
    if (map == 1) {
#pragma unroll
        for (int dt = 0; dt < 4; ++dt)
#pragma unroll
            for (int r = 0; r < 16; ++r) ex[(32 * dt + crow(r, hi)) * 32 + r32] = fn.st.o[dt][r] * inv;
    }
    __syncthreads();
    if (map == 0) {
        const float lam = lamw[0]; float ss = 0.f;
#pragma unroll
        for (int dt = 0; dt < 4; ++dt)
#pragma unroll
            for (int r = 0; r < 16; ++r) { const float v = fn.st.o[dt][r] * inv - lam * ex[(32 * dt + crow(r, hi)) * 32 + r32]; fn.st.o[dt][r] = v; ss += v * v; }
        ss += __shfl_xor(ss, 32);
        const float rstd = (1.0f / sqrtf(ss * (1.0f / 128.0f) + RMS_EPS)) * (1.0f - lam_init);
        const float* sub = a.in[4] + (size_t)l * 128; bf16* orow = MIX + (size_t)tq * D + 128 * h;
#pragma unroll
        for (int dt = 0; dt < 4; ++dt)
#pragma unroll
            for (int q4 = 0; q4 < 4; ++q4) { const int d = 32 * dt + 8 * q4 + 4 * hi; const f32x4 g = *(const f32x4*)(sub + d);
                u32x2 w; w.x = cvtpk(fn.st.o[dt][4 * q4] * rstd * g.x, fn.st.o[dt][4 * q4 + 1] * rstd * g.y); w.y = cvtpk(fn.st.o[dt][4 * q4 + 2] * rstd * g.z, fn.st.o[dt][4 * q4 + 3] * rstd * g.w);
                *(u32x2*)(orow + d) = w; }
    }
    __syncthreads();
}

#ifndef NSA_DUP
#define NSA_DUP 0
#endif
constexpr int IMP_P = 132;
__device__ __forceinline__ float quad_sum(float v) {
    v += __builtin_bit_cast(float, __builtin_amdgcn_mov_dpp(__builtin_bit_cast(int, v), 0xB1, 0xF, 0xF, true));
    v += __builtin_bit_cast(float, __builtin_amdgcn_mov_dpp(__builtin_bit_cast(int, v), 0x4E, 0xF, 0xF, true));
    return v; }
#define LADD(p, v) (void)__hip_atomic_fetch_add((p), (v), __ATOMIC_RELAXED, __HIP_MEMORY_SCOPE_WORKGROUP)
constexpr int NSA_QF = 32768, NSA_SELW = 65536, NSA_LUT = 66560, NSA_IMP = 69632, NSA_FIN = 69632;

struct CmpStatFn {
    float m, l; int tq, lane, ncnt;
    __device__ __forceinline__ bool need(int) const { return true; }
    __device__ __forceinline__ void tile(int t, f32x16& p0, f32x16& p1, LAS const unsigned char*, LAS const unsigned char*) {
        const int hi = lane >> 5, n0 = 64 * t;
#pragma unroll
        for (int r = 0; r < 16; ++r) { const int n = n0 + crow(r, hi);
            p0[r] = (16 * n + 31 <= tq) ? p0[r] * SCL2 : NEG; p1[r] = (16 * (n + 32) + 31 <= tq) ? p1[r] * SCL2 : NEG; }
        softmax_stats(m, l, p0, p1);
    }
};
struct CmpPvFn {
    f32x16 o[2]; float m, invl; int tq, ql, lane; LAS float* imp;
    __device__ __forceinline__ bool need(int) const { return true; }
    __device__ __forceinline__ void tile(int t, f32x16& p0, f32x16& p1, LAS const unsigned char* vt, LAS const unsigned char*) {
        const int hi = lane >> 5, n0 = 64 * t;
#pragma unroll
        for (int r = 0; r < 16; ++r) { const int n = n0 + crow(r, hi);
            p0[r] = (16 * n + 31 <= tq) ? __builtin_amdgcn_exp2f(p0[r] * SCL2 - m) * invl : 0.f;
            p1[r] = (16 * (n + 32) + 31 <= tq) ? __builtin_amdgcn_exp2f(p1[r] * SCL2 - m) * invl : 0.f; }
        LAS float* row = imp + ql * IMP_P;
        const bool lead = (lane & 3) == 0;
#pragma unroll
        for (int a = 0; a < 4; ++a) {
            const int j0 = (n0 >> 2) + 2 * a + hi, j1 = j0 + 8;
            const float h0 = quad_sum(0.5f * p0[4 * a + 3]), h1 = quad_sum(0.5f * p1[4 * a + 3]);
            const float b0 = quad_sum(p0[4 * a] + p0[4 * a + 1] + p0[4 * a + 2]) + h0, b1 = quad_sum(p1[4 * a] + p1[4 * a + 1] + p1[4 * a + 2]) + h1;
            if (lead) {
                LADD(row + j0, b0);
                if (j0 + 1 < 128) LADD(row + j0 + 1, h0);
                if (j1 < 128) LADD(row + j1, b1);
                if (j1 + 1 < 128) LADD(row + j1 + 1, h1);
            }
        }
        bf16x8 pw[4]; pack_p(pw, p0, p1);
        pv_tile<2>(o, pw, vt, lane);
    }
};
struct SelFn {
    AState<2> st; LAS const float* lut; int tq, tmin, tmax, lane, mode; unsigned sw0, sw1, sw2, sw3, uw0, uw1, uw2, uw3;
    __device__ __forceinline__ unsigned pick(int j, unsigned a, unsigned b, unsigned c, unsigned d) const { const int w = j >> 5; const unsigned x = (w == 0) ? a : (w == 1) ? b : (w == 2) ? c : d; return (x >> (j & 31)) & 1u; }
    __device__ __forceinline__ bool need(int t) const { return mode == 1 || pick(t, uw0, uw1, uw2, uw3) != 0u; }
    __device__ __forceinline__ void tile(int t, f32x16& p0, f32x16& p1, LAS const unsigned char* vt, LAS const unsigned char*) {
        const int hi = lane >> 5, k0 = 64 * t;
        const bool bit = (mode == 1) || pick(t, sw0, sw1, sw2, sw3) != 0u;
        const bool far = k0 + 63 + 127 <= tmin;
        const bool wcut = (mode == 1) && (tmax - k0 >= 512);
        const float mref = st.m;
        if (far && !wcut) {
            const float b = lut[127] - mref;
#pragma unroll
            for (int r = 0; r < 16; ++r) { p0[r] = bit ? p0[r] * SCL2 + b : NEG; p1[r] = bit ? p1[r] * SCL2 + b : NEG; }
        } else {
#pragma unroll
            for (int r = 0; r < 16; ++r) { const int rel0 = tq - (k0 + crow(r, hi));
                const float b0 = lut[min(max(rel0, 0), 127)] - mref;
                const bool ok0 = bit && rel0 >= 0 && (mode == 0 || rel0 < 512);
                p0[r] = ok0 ? p0[r] * SCL2 + b0 : NEG; }
            __builtin_amdgcn_sched_barrier(0);
#pragma unroll
            for (int r = 0; r < 16; ++r) { const int rel1 = tq - (k0 + 32 + crow(r, hi));
                const float b1 = lut[min(max(rel1, 0), 127)] - mref;
                const bool ok1 = bit && rel1 >= 0 && (mode == 0 || rel1 < 512);
                p1[r] = ok1 ? p1[r] * SCL2 + b1 : NEG; }
            __builtin_amdgcn_sched_barrier(0);
        }
        softmax_pv<2>(st, p0, p1, vt, lane);
    }
};

__device__ __forceinline__ void nsa_unit(int g, int qb, const Args& a, const bf16* PROJ, const float* AUX, const bf16* KC, const bf16* VC, bf16* MIX, LAS unsigned char* lds, int tid, int wid, int lane) {
    const int r32 = lane & 31, hi = lane >> 5, q0 = 64 * qb, cur = qb, ql = 8 * wid + (r32 >> 2), hp = r32 & 3, tq = q0 + ql, head = 4 * g + hp;
    LAS float* imp = (LAS float*)(lds + NSA_IMP); LAS unsigned* selw = (LAS unsigned*)(lds + NSA_SELW); LAS float* lut = (LAS float*)(lds + NSA_LUT);
#pragma unroll
    for (int i = 0; i < 17; ++i) { const int e_ = tid + 512 * i; if (e_ < 64 * IMP_P) imp[e_] = 0.f; }
    if (tid < 256) selw[tid] = 0u;
    lut[tid] = a.in[12][t5_bucket(tid & 127) * 20 + 4 + 4 * g + (tid >> 7)] * LOG2E;
    bf16x8 qf[4];
#pragma unroll
    for (int d0 = 0; d0 < 4; ++d0) qf[d0] = *(const bf16x8*)(PROJ + (size_t)tq * PITCH + C_CQ + 64 * head + 16 * d0 + 8 * hi);
    LAS unsigned char* const qlds = lds + NSA_QF + tid * 16;
#pragma unroll
    for (int d0 = 0; d0 < 4; ++d0) *(LAS bf16x8*)(qlds + d0 * 8192) = qf[d0];
    const float* ga = AUX + (size_t)tq * 64 + 8 + head;
    const float gc = 1.0f / (1.0f + __expf(-ga[0])), gs = 1.0f / (1.0f + __expf(-ga[16])), gwn = 1.0f / (1.0f + __expf(-ga[32]));
    LAS float* finl = (LAS float*)(lds + NSA_FIN) + tid;
    f32x16 oc0, oc1;
    {
        int ncnt = (q0 + 32) / 16 + 1; ncnt = ncnt > 511 ? 511 : ncnt; const int ntc = (ncnt + 63) >> 6;
        const bf16* kc = KC + (size_t)g * 512 * 64; const bf16* vc = VC + (size_t)g * 512 * 64;
        CmpStatFn f1; f1.m = NEG; f1.l = 0.f; f1.tq = tq; f1.lane = lane; f1.ncnt = ncnt;
        kv_loop<8, 8, false, 1, true>(f1, qf, qlds, 0, kc, vc, nullptr, 64, 0, ntc, lds, lds + 16384, lds, tid, lane);
        if (NSA_DUP & 1) { f1.m = NEG; f1.l = 0.f; kv_loop<8, 8, false, 1, true>(f1, qf, qlds, 0, kc, vc, nullptr, 64, 0, ntc, lds, lds + 16384, lds, tid, lane); }
        const float lt = f1.l + __shfl_xor(f1.l, 32);
        CmpPvFn f2; f2.o[0] = (f32x16){}; f2.o[1] = (f32x16){}; f2.m = f1.m; f2.invl = (tq >= 31) ? 1.0f / lt : 0.f; f2.tq = tq; f2.ql = ql; f2.lane = lane; f2.imp = imp;
        if (NSA_DUP & 16) { kv_loop<8, 8, false, 1, true>(f2, qf, qlds, 0, kc, vc, nullptr, 64, 0, ntc, lds, lds + 16384, lds, tid, lane); f2.o[0] = (f32x16){}; f2.o[1] = (f32x16){};
#pragma unroll
            for (int i = 0; i < 17; ++i) { const int e_ = tid + 512 * i; if (e_ < 64 * IMP_P) imp[e_] = 0.f; }
            __syncthreads(); }
        kv_loop<8, 8, false, 1, true>(f2, qf, qlds, 0, kc, vc, nullptr, 64, 0, ntc, lds, lds + 16384, lds, tid, lane);
        oc0 = f2.o[0]; oc1 = f2.o[1];
    }
    for (int rep_ = 0; rep_ < ((NSA_DUP & 2) ? 2 : 1); ++rep_)
    if (cur < 16) { if (tid < 64) selw[tid * 4] = (2u << cur) - 1u; }
    else {
        const int qq = tid >> 3, sub = tid & 7;
        float val[16];
#pragma unroll
        for (int i = 0; i < 16; ++i) { const int j = 16 * sub + i; val[i] = (j >= 1 && j <= cur - 2) ? imp[qq * IMP_P + j] : -1.0f; }
        unsigned bits = 0u;
        for (int round = 0; round < 13; ++round) {
            float bv = val[0]; int bi = 0;
#pragma unroll
            for (int i = 1; i < 16; ++i) if (val[i] > bv) { bv = val[i]; bi = i; }
            int gj = 16 * sub + bi;
            { const float ov = __builtin_bit_cast(float, __builtin_amdgcn_mov_dpp(__builtin_bit_cast(int, bv), 0xB1, 0xF, 0xF, true)); const int oj = __builtin_amdgcn_mov_dpp(gj, 0xB1, 0xF, 0xF, true); if (ov > bv || (ov == bv && oj < gj)) { bv = ov; gj = oj; } }
            { const float ov = __builtin_bit_cast(float, __builtin_amdgcn_mov_dpp(__builtin_bit_cast(int, bv), 0x4E, 0xF, 0xF, true)); const int oj = __builtin_amdgcn_mov_dpp(gj, 0x4E, 0xF, 0xF, true); if (ov > bv || (ov == bv && oj < gj)) { bv = ov; gj = oj; } }
            { const float ov = __shfl_xor(bv, 4); const int oj = __shfl_xor(gj, 4); if (ov > bv || (ov == bv && oj < gj)) { bv = ov; gj = oj; } }
            const bool mine = (gj >> 4) == sub;
#pragma unroll
            for (int i = 0; i < 16; ++i) if (mine && (gj & 15) == i) { val[i] = -2.0f; bits |= 1u << i; }
        }
        if (sub == 0) bits |= 1u;
        if (((cur - 1) >> 4) == sub) bits |= 1u << ((cur - 1) & 15);
        if ((cur >> 4) == sub) bits |= 1u << (cur & 15);
        (void)__hip_atomic_fetch_or(selw + qq * 4 + (sub >> 1), bits << (16 * (sub & 1)), __ATOMIC_RELAXED, __HIP_MEMORY_SCOPE_WORKGROUP);
    }
    __syncthreads();
#pragma unroll
    for (int r = 0; r < 16; ++r) { finl[512 * r] = gc * oc0[r]; finl[512 * (16 + r)] = gc * oc1[r]; }
    SelFn fs; fs.lut = lut + hp * 128; fs.tq = tq; fs.tmin = q0 + 8 * wid; fs.tmax = q0 + 8 * wid + 7; fs.lane = lane;
    fs.sw0 = selw[ql * 4 + 0]; fs.sw1 = selw[ql * 4 + 1]; fs.sw2 = selw[ql * 4 + 2]; fs.sw3 = selw[ql * 4 + 3];
    { unsigned u0 = 0u, u1 = 0u, u2 = 0u, u3 = 0u;
#pragma unroll
      for (int i = 0; i < 8; ++i) { u0 |= selw[(8 * wid + i) * 4 + 0]; u1 |= selw[(8 * wid + i) * 4 + 1]; u2 |= selw[(8 * wid + i) * 4 + 2]; u3 |= selw[(8 * wid + i) * 4 + 3]; }
      fs.uw0 = __builtin_amdgcn_readfirstlane(u0); fs.uw1 = __builtin_amdgcn_readfirstlane(u1); fs.uw2 = __builtin_amdgcn_readfirstlane(u2); fs.uw3 = __builtin_amdgcn_readfirstlane(u3); }
    fs.mode = 0; astate_init<2>(fs.st);
    kv_loop<8, 8, false, 1, false>(fs, qf, qlds, 0, PROJ + C_KS + 64 * g, PROJ + C_VS + 64 * g, nullptr, PITCH, 0, cur + 1, lds, lds + 16384, lds, tid, lane);
    if (NSA_DUP & 4) { astate_init<2>(fs.st); kv_loop<8, 8, false, 1, false>(fs, qf, qlds, 0, PROJ + C_KS + 64 * g, PROJ + C_VS + 64 * g, nullptr, PITCH, 0, cur + 1, lds, lds + 16384, lds, tid, lane); }
    { const float lt = fs.st.l + __shfl_xor(fs.st.l, 32), sc = gs / lt;
#pragma unroll
      for (int r = 0; r < 16; ++r) { finl[512 * r] += sc * fs.st.o[0][r]; finl[512 * (16 + r)] += sc * fs.st.o[1][r]; } }
    fs.mode = 1; astate_init<2>(fs.st);
    kv_loop<8, 8, false, 1, false>(fs, qf, qlds, 0, PROJ + C_KW + 64 * g, PROJ + C_VW + 64 * g, nullptr, PITCH, cur >= 8 ? cur - 8 : 0, cur + 1, lds, lds + 16384, lds, tid, lane);
    if (NSA_DUP & 8) { astate_init<2>(fs.st); kv_loop<8, 8, false, 1, false>(fs, qf, qlds, 0, PROJ + C_KW + 64 * g, PROJ + C_VW + 64 * g, nullptr, PITCH, cur >= 8 ? cur - 8 : 0, cur + 1, lds, lds + 16384, lds, tid, lane); }
    { const float lt = fs.st.l + __shfl_xor(fs.st.l, 32), sc = gwn / lt;
#pragma unroll
      for (int r = 0; r < 16; ++r) { fs.st.o[0][r] = finl[512 * r] + sc * fs.st.o[0][r]; fs.st.o[1][r] = finl[512 * (16 + r)] + sc * fs.st.o[1][r]; } }
    bf16* orow = MIX + (size_t)tq * D + 1024 + 64 * head;
#pragma unroll
    for (int dt = 0; dt < 2; ++dt)
#pragma unroll
        for (int q4 = 0; q4 < 4; ++q4) { u32x2 w; w.x = cvtpk(fs.st.o[dt][4 * q4], fs.st.o[dt][4 * q4 + 1]); w.y = cvtpk(fs.st.o[dt][4 * q4 + 2], fs.st.o[dt][4 * q4 + 3]); *(u32x2*)(orow + 32 * dt + 8 * q4 + 4 * hi) = w; }
}

__device__ __forceinline__ int dequeue(unsigned* head, volatile LAS unsigned* slot, int tid) {
    if (tid == 0) *slot = __hip_atomic_fetch_add(head, 1u, __ATOMIC_RELAXED, __HIP_MEMORY_SCOPE_AGENT);
    __syncthreads();
    const int v = __builtin_amdgcn_readfirstlane((int)*slot);
    __syncthreads();
    return v;
}

constexpr int N2_HP = 4112, N2_PART = 66 * 1024, N2_LOG = 108 * 1024;
__device__ __forceinline__ void n2_unit(int u, int l, const Args& a, const bf16* X, bf16* XN, const bf16* RWT, unsigned* cnt, int* LIST, float* TW, LAS unsigned char* lds, int tid, int wid, int lane) {
    const float* gain = a.in[14] + (size_t)l * D;
#pragma unroll
    for (int rr = 0; rr < 2; ++rr) {
        const int lr = 2 * wid + rr, row = 16 * u + lr;
        const u32x2* xr = (const u32x2*)(X + (size_t)row * D) + lane;
        f32x4 v[8]; float ss = 0.f;
#pragma unroll
        for (int j = 0; j < 8; ++j) { const u32x2 r = xr[64 * j]; v[j] = (f32x4){bflo(r.x), bfhi(r.x), bflo(r.y), bfhi(r.y)}; ss += (v[j].x * v[j].x + v[j].y * v[j].y) + (v[j].z * v[j].z + v[j].w * v[j].w); }
        ss = wave_sum(ss);
        const float rstd = 1.0f / sqrtf(ss * (1.0f / D) + RMS_EPS);
        const f32x4* gr = (const f32x4*)gain + lane; u32x2* o8 = (u32x2*)(XN + (size_t)row * D) + lane;
#pragma unroll
        for (int j = 0; j < 8; ++j) { const f32x4 g = gr[64 * j]; u32x2 w; w.x = cvtpk(v[j].x * rstd * g.x, v[j].y * rstd * g.y); w.y = cvtpk(v[j].z * rstd * g.z, v[j].w * rstd * g.w);
            o8[64 * j] = w; *(LAS u32x2*)(lds + lr * N2_HP + (4 * lane + 256 * j) * 2) = w; }
    }
    __syncthreads();
    {
        const int fr = lane & 15, fq = lane >> 4;
        f32x4 acc[5];
#pragma unroll
        for (int nt = 0; nt < 5; ++nt) acc[nt] = (f32x4){0.f, 0.f, 0.f, 0.f};
        const bf16* rw = RWT + (size_t)l * 96 * D + (size_t)fr * D + 256 * wid + 8 * fq;
#pragma unroll
        for (int s = 0; s < 8; ++s) {
            const bf16x8 av = *(const LAS bf16x8*)(lds + fr * N2_HP + (256 * wid + 32 * s + 8 * fq) * 2);
#pragma unroll
            for (int nt = 0; nt < 5; ++nt) { const bf16x8 bv = *(const bf16x8*)(rw + (size_t)(16 * nt) * D + 32 * s); acc[nt] = MFMA16(av, bv, acc[nt]); }
        }
        LAS float* part = (LAS float*)(lds + N2_PART) + wid * 16 * 80;
#pragma unroll
        for (int nt = 0; nt < 5; ++nt)
#pragma unroll
            for (int i = 0; i < 4; ++i) part[(4 * fq + i) * 80 + 16 * nt + fr] = acc[nt][i];
    }
    __syncthreads();
    {
        LAS const float* part = (LAS const float*)(lds + N2_PART); LAS float* logit = (LAS float*)(lds + N2_LOG);
        for (int e = tid; e < 16 * 80; e += NTHR) { float s = 0.f;
#pragma unroll
            for (int w = 0; w < 8; ++w) s += part[w * 16 * 80 + e];
            logit[e] = s; }
    }
    __syncthreads();
    if (tid < 16) {
        LAS const float* lg = (LAS const float*)(lds + N2_LOG) + tid * 80;
        const float* bg = a.in[16] + l * 8; const float* be = a.in[18] + l * 64;
        float z[8]; float zm = -3.0e38f; int gi = 0;
#pragma unroll
        for (int i = 0; i < 8; ++i) { z[i] = lg[i] + bg[i]; if (z[i] > zm) { zm = z[i]; gi = i; } }
        float den = 0.f;
#pragma unroll
        for (int i = 0; i < 8; ++i) den += expf(z[i] - zm);
        const float gp = 1.0f / den;
        float e1 = -3.0e38f, e2 = -3.0e38f; int i1 = 0, i2 = 0;
#pragma unroll
        for (int i = 0; i < 8; ++i) { const float v = lg[8 + 8 * gi + i] + be[8 * gi + i];
            if (v > e1) { e2 = e1; i2 = i1; e1 = v; i1 = i; } else if (v > e2) { e2 = v; i2 = i; } }
        const float t2 = expf(e2 - e1), w1 = gp / (1.0f + t2), w2 = gp * t2 / (1.0f + t2);
        const int tok = 16 * u + tid, ea = 8 * gi + i1, eb = 8 * gi + i2;
        const unsigned pa = __hip_atomic_fetch_add(cnt + ea * 16, 1u, __ATOMIC_RELAXED, __HIP_MEMORY_SCOPE_AGENT);
        const unsigned pb = __hip_atomic_fetch_add(cnt + eb * 16, 1u, __ATOMIC_RELAXED, __HIP_MEMORY_SCOPE_AGENT);
        LIST[(size_t)ea * 16384 + pa] = 2 * tok; LIST[(size_t)eb * 16384 + pb] = 2 * tok + 1;
        TW[2 * tok] = w1; TW[2 * tok + 1] = w2;
    }
    __syncthreads();
}

constexpr int N2P_HALF = 16 * N2_HP, N2P_LOG = 2 * N2P_HALF;
__device__ __forceinline__ void n2_pair(int p, int l, const Args& a, const bf16* X, bf16* XN, const bf16* RWT, unsigned* cnt, int* LIST, float* TW, LAS unsigned char* lds, int tid, int wid, int lane) {
    const int half = wid >> 2, wl = wid & 3, u = 2 * p + half, th = tid & 255;
    LAS unsigned char* const hT = lds + half * N2P_HALF;
    const float* gain = a.in[14] + (size_t)l * D;
    {
        u32x2 raw[4][8];
#pragma unroll
        for (int rr = 0; rr < 4; ++rr) { const u32x2* xr = (const u32x2*)(X + (size_t)(16 * u + 4 * wl + rr) * D) + lane;
#pragma unroll
            for (int j = 0; j < 8; ++j) raw[rr][j] = xr[64 * j]; }
        f32x4 g[8]; { const f32x4* gr = (const f32x4*)gain + lane;
#pragma unroll
            for (int j = 0; j < 8; ++j) g[j] = gr[64 * j]; }
#pragma unroll
        for (int rr = 0; rr < 4; ++rr) {
            const int lr = 4 * wl + rr, row = 16 * u + lr;
            f32x4 v[8]; float ss = 0.f;
#pragma unroll
            for (int j = 0; j < 8; ++j) { const u32x2 r = raw[rr][j]; v[j] = (f32x4){bflo(r.x), bfhi(r.x), bflo(r.y), bfhi(r.y)}; ss += (v[j].x * v[j].x + v[j].y * v[j].y) + (v[j].z * v[j].z + v[j].w * v[j].w); }
            ss = wave_sum(ss);
            const float rstd = 1.0f / sqrtf(ss * (1.0f / D) + RMS_EPS);
            u32x2* o8 = (u32x2*)(XN + (size_t)row * D) + lane;
#pragma unroll
            for (int j = 0; j < 8; ++j) { u32x2 w; w.x = cvtpk(v[j].x * rstd * g[j].x, v[j].y * rstd * g[j].y); w.y = cvtpk(v[j].z * rstd * g[j].z, v[j].w * rstd * g[j].w);
                o8[64 * j] = w; *(LAS u32x2*)(hT + lr * N2_HP + (4 * lane + 256 * j) * 2) = w; }
        }
    }
    __syncthreads();
    const int fr = lane & 15, fq = lane >> 4;
    f32x4 acc[2][5];
#pragma unroll
    for (int hh = 0; hh < 2; ++hh)
#pragma unroll
        for (int nt = 0; nt < 5; ++nt) acc[hh][nt] = (f32x4){0.f, 0.f, 0.f, 0.f};
    {
        const bf16* rw = RWT + (size_t)l * 96 * D + (size_t)fr * D + 256 * wid + 8 * fq;
#pragma unroll 4
        for (int s = 0; s < 8; ++s) {
            const bf16x8 av0 = *(const LAS bf16x8*)(lds + fr * N2_HP + (256 * wid + 32 * s + 8 * fq) * 2);
            const bf16x8 av1 = *(const LAS bf16x8*)(lds + N2P_HALF + fr * N2_HP + (256 * wid + 32 * s + 8 * fq) * 2);
#pragma unroll
            for (int nt = 0; nt < 5; ++nt) { const bf16x8 bv = *(const bf16x8*)(rw + (size_t)(16 * nt) * D + 32 * s); acc[0][nt] = MFMA16(av0, bv, acc[0][nt]); acc[1][nt] = MFMA16(av1, bv, acc[1][nt]); }
        }
    }
    __syncthreads();
    {
        LAS float* part = (LAS float*)lds + wid * 32 * 80;
#pragma unroll
        for (int hh = 0; hh < 2; ++hh)
#pragma unroll
            for (int nt = 0; nt < 5; ++nt)
#pragma unroll
                for (int i = 0; i < 4; ++i) part[(16 * hh + 4 * fq + i) * 80 + 16 * nt + fr] = acc[hh][nt][i];
    }
    __syncthreads();
    {
        LAS const float* part = (LAS const float*)lds; LAS float* logit = (LAS float*)(lds + N2P_LOG);
        for (int e = tid; e < 32 * 80; e += NTHR) { float sres = 0.f;
#pragma unroll
            for (int w = 0; w < 8; ++w) sres += part[w * 32 * 80 + e];
            logit[e] = sres; }
    }
    __syncthreads();
    if (th < 16) {
        LAS const float* lg = (LAS const float*)(lds + N2P_LOG) + (16 * half + th) * 80;
        const float* bg = a.in[16] + l * 8; const float* be = a.in[18] + l * 64;
        float z[8]; float zm = -3.0e38f; int gi = 0;
#pragma unroll
        for (int i = 0; i < 8; ++i) { z[i] = lg[i] + bg[i]; if (z[i] > zm) { zm = z[i]; gi = i; } }
        float den = 0.f;
#pragma unroll
        for (int i = 0; i < 8; ++i) den += expf(z[i] - zm);
        const float gp = 1.0f / den;
        float e1 = -3.0e38f, e2 = -3.0e38f; int i1 = 0, i2 = 0;
#pragma unroll
        for (int i = 0; i < 8; ++i) { const float v = lg[8 + 8 * gi + i] + be[8 * gi + i];
            if (v > e1) { e2 = e1; i2 = i1; e1 = v; i1 = i; } else if (v > e2) { e2 = v; i2 = i; } }
        const float t2 = expf(e2 - e1), w1 = gp / (1.0f + t2), w2 = gp * t2 / (1.0f + t2);
        const int tok = 16 * u + th, ea = 8 * gi + i1, eb = 8 * gi + i2;
        const unsigned pa = __hip_atomic_fetch_add(cnt + ea * 16, 1u, __ATOMIC_RELAXED, __HIP_MEMORY_SCOPE_AGENT);
        const unsigned pb = __hip_atomic_fetch_add(cnt + eb * 16, 1u, __ATOMIC_RELAXED, __HIP_MEMORY_SCOPE_AGENT);
        LIST[(size_t)ea * 16384 + pa] = 2 * tok; LIST[(size_t)eb * 16384 + pb] = 2 * tok + 1;
        TW[2 * tok] = w1; TW[2 * tok + 1] = w2;
    }
    __syncthreads();
}

constexpr int MO_B = 65536, MO_BBUF = 16384, MO_A = 98304, MO_APITCH = 2176, MO_ABUF = 4 * MO_APITCH, MO_ROW = MO_A + 2 * MO_ABUF, MO_PRE = MO_ROW + 512;
constexpr int MO_STG = 117760;
static_assert(MO_PRE + 272 <= MO_STG && MO_STG + 8 * 4096 <= MISC_OFF, "MoE LDS map");
__device__ __forceinline__ int mo_aoff(int row, int c) { return c * MO_APITCH + ((row + 2 * c) << 4); }
__device__ __forceinline__ int mo_hoff(int row, int c) { return c * 2048 + (row << 4); }

struct MoBStage { f32x4 v[4]; };
__device__ __forceinline__ void mo_gl16(f32x4& d, const float* p) { asm volatile("global_load_dwordx4 %0, %1, off" : "=v"(d) : "v"(p) : "memory"); }
__device__ __forceinline__ void mo_gl16u(u32x4& d, const bf16* p) { asm volatile("global_load_dwordx4 %0, %1, off" : "=v"(d) : "v"(p) : "memory"); }
__device__ __forceinline__ void mo_bload(MoBStage& sg, const float* src0, const float* src1, size_t ld, int k0, int tid) {
    const int n4 = tid & 63, kg = tid >> 6;
    const float* p = (n4 < 32 ? src0 + 4 * n4 : src1 + 4 * (n4 - 32)) + (size_t)(k0 + 4 * kg) * ld;
    mo_gl16(sg.v[0], p); mo_gl16(sg.v[1], p + ld); mo_gl16(sg.v[2], p + 2 * ld); mo_gl16(sg.v[3], p + 3 * ld);
}
#define MO_WAIT5(N, SB, SA) asm volatile("s_waitcnt vmcnt(" #N ")" : "+v"(SB.v[0]), "+v"(SB.v[1]), "+v"(SB.v[2]), "+v"(SB.v[3]), "+v"(SA) :: "memory")
#define MO_WAIT4(N, SB) asm volatile("s_waitcnt vmcnt(" #N ")" : "+v"(SB.v[0]), "+v"(SB.v[1]), "+v"(SB.v[2]), "+v"(SB.v[3]) :: "memory")
__device__ __forceinline__ void mo_bwrite(const MoBStage& sg, LAS unsigned char* bb, int tid) {
    const int n4 = tid & 63, kg = tid >> 6;
#pragma unroll
    for (int i = 0; i < 4; ++i) { u32x2 w; w.x = cvtpk(sg.v[0][i], sg.v[1][i]); w.y = cvtpk(sg.v[2][i], sg.v[3][i]);
        *(LAS u32x2*)(bb + (kg >> 1) * 4096 + (32 * (n4 >> 3) + 8 * i + (n4 & 7)) * 16 + 8 * (kg & 1)) = w; }
}
#define MO_READ(AP, ASTEP, BP, B1OFF) bf16x8 fb0_[2], fb1_[2], fa_[2][2]; \
    _Pragma("unroll") for (int s_ = 0; s_ < 2; ++s_) { fb0_[s_] = *(const LAS bf16x8*)((BP) + s_ * 8192); fb1_[s_] = *(const LAS bf16x8*)((BP) + s_ * 8192 + (B1OFF)); \
        _Pragma("unroll") for (int mt = 0; mt < 2; ++mt) fa_[s_][mt] = *(const LAS bf16x8*)((AP) + s_ * (ASTEP) + mt * 512); } \
    __builtin_amdgcn_sched_barrier(0)
#define MO_MMA(ACC0, ACC1) do { __builtin_amdgcn_sched_barrier(0); _Pragma("unroll") for (int s_ = 0; s_ < 2; ++s_) _Pragma("unroll") for (int mt = 0; mt < 2; ++mt) { \
        ACC0[mt] = MFMA32(fa_[s_][mt], fb0_[s_], ACC0[mt]); ACC1[mt] = MFMA32(fa_[s_][mt], fb1_[s_], ACC1[mt]); } __builtin_amdgcn_sched_barrier(0); } while (0)

__device__ __forceinline__ void moe_unit(int e, int c0, int nrows, const bf16* XN, const int* LIST, const float* Wg, const float* Wu, const float* Wd, bf16* YB, LAS unsigned char* lds, int tid, int wid, int lane) {
    const int r32 = lane & 31, hi = lane >> 5, wn = wid & 3, wm = wid >> 2;
    LAS int* rowid = (LAS int*)(lds + MO_ROW);
    if (tid < 128) rowid[tid] = (tid < nrows) ? LIST[(size_t)e * 16384 + c0 + tid] : -1;
    __syncthreads();
    const float* wg = Wg + (size_t)e * D * 256; const float* wu = Wu + (size_t)e * D * 256; const float* wd = Wd + (size_t)e * 256 * D;
    f32x16 acc0[2], acc1[2];
#define MO_ZERO() do { acc0[0] = (f32x16){}; acc0[1] = (f32x16){}; acc1[0] = (f32x16){}; acc1[1] = (f32x16){}; } while (0)
    MO_ZERO();
    MoBStage s0, s1, s2, s3; u32x4 a0, a1, a2, a3;
    {
        const int arow = tid >> 2, ac = tid & 3; const int rid = rowid[arow]; const bf16* asrc = XN + (size_t)((rid < 0 ? 0 : rid) >> 1) * D + 8 * ac;
        LAS unsigned char* const awr = lds + MO_A + mo_aoff(arow, ac);
        LAS const unsigned char* const ard = lds + MO_A + mo_aoff(64 * wm + r32, hi);
        LAS const unsigned char* const brd = lds + MO_B + hi * 4096 + (32 * wn + r32) * 16;
#define G1_LOAD(SB, SA, t) do { const int t_ = (t); mo_gl16u(SA, asrc + 32 * (t_ & 63)); mo_bload(SB, wg + 128 * (t_ >> 6), wu + 128 * (t_ >> 6), 256, 32 * (t_ & 63), tid); } while (0)
#define G1_WRITE(SB, SA, b) do { *(LAS u32x4*)(awr + (b) * MO_ABUF) = SA; mo_bwrite(SB, lds + MO_B + (b) * MO_BBUF, tid); } while (0)
#define G1_STEP(t, b, SBL, SAL, SBW, SAW) do { const int tt_ = (t); \
            MO_READ(ard + (b) * MO_ABUF, 2 * MO_APITCH + 64, brd + (b) * MO_BBUF, 2048);     \
            G1_LOAD(SBL, SAL, (tt_ + 4 < 128 ? tt_ + 4 : 127));     \
            __builtin_amdgcn_sched_barrier(0); \
            MO_WAIT5(15, SBW, SAW); \
            if (tt_ + 1 < 128) G1_WRITE(SBW, SAW, (b) ^ 1); \
            MO_MMA(acc0, acc1); \
            if ((tt_ & 63) == 63) {     \
                const int col_ = 128 * (tt_ >> 6) + 32 * wn + 4 * (r32 & 7) + (r32 >> 3), cch_ = col_ >> 3; \
                _Pragma("unroll") for (int mt = 0; mt < 2; ++mt) _Pragma("unroll") for (int r = 0; r < 16; ++r) { const float gt = acc0[mt][r], up = acc1[mt][r]; const float hv = gt / (1.0f + __expf(-gt)) * up; \
                    *(LAS unsigned short*)(lds + mo_hoff(64 * wm + 32 * mt + crow(r, hi), cch_) + (col_ & 7) * 2) = f2bf16(hv); } \
                MO_ZERO(); } \
            __syncthreads(); } while (0)
        G1_LOAD(s0, a0, 0); G1_LOAD(s1, a1, 1); G1_LOAD(s2, a2, 2); G1_LOAD(s3, a3, 3);
        MO_WAIT5(15, s0, a0);
        G1_WRITE(s0, a0, 0);
        __syncthreads();
        for (int t = 0; t < 128; t += 4) {
            G1_STEP(t, 0, s0, a0, s1, a1);
            G1_STEP(t + 1, 1, s1, a1, s2, a2);
            G1_STEP(t + 2, 0, s2, a2, s3, a3);
            G1_STEP(t + 3, 1, s3, a3, s0, a0);
        }
        asm volatile("s_waitcnt vmcnt(0)" : "+v"(s0.v[0]), "+v"(s0.v[1]), "+v"(s0.v[2]), "+v"(s0.v[3]), "+v"(s1.v[0]), "+v"(s1.v[1]), "+v"(s1.v[2]), "+v"(s1.v[3]), "+v"(s2.v[0]), "+v"(s2.v[1]), "+v"(s2.v[2]), "+v"(s2.v[3]),
                     "+v"(s3.v[0]), "+v"(s3.v[1]), "+v"(s3.v[2]), "+v"(s3.v[3]), "+v"(a0), "+v"(a1), "+v"(a2), "+v"(a3) :: "memory");
#undef G1_LOAD
#undef G1_WRITE
#undef G1_STEP
    }
    {
        LAS const unsigned char* const hrd = lds + mo_hoff(64 * wm + r32, hi);
        LAS const unsigned char* const brd = lds + MO_B + hi * 4096 + (64 * wn + r32) * 16;
#define G2_LOAD(SB, t) do { const int t_ = (t); mo_bload(SB, wd + 256 * (t_ >> 3), wd + 256 * (t_ >> 3) + 128, D, 32 * (t_ & 7), tid); } while (0)
#define G2_STEP(t, b, SBL, SBW) do { const int tt_ = (t); \
            MO_READ(hrd + (tt_ & 7) * 8192, 4096, brd + (b) * MO_BBUF, 512); \
            G2_LOAD(SBL, (tt_ + 4 < 64 ? tt_ + 4 : 63)); \
            __builtin_amdgcn_sched_barrier(0); \
            MO_WAIT4(12, SBW); \
            if (tt_ + 1 < 64) mo_bwrite(SBW, lds + MO_B + ((b) ^ 1) * MO_BBUF, tid); \
            MO_MMA(acc0, acc1); \
            if ((tt_ & 7) == 7) {     \
                LAS unsigned char* const stg_ = lds + MO_STG + wid * 4096; const int cidx_ = 4 * (r32 & 7) + (r32 >> 3); \
                _Pragma("unroll") for (int mt = 0; mt < 2; ++mt) { \
                    _Pragma("unroll") for (int r = 0; r < 16; ++r) { const int row_ = crow(r, hi); \
                        *(LAS unsigned short*)(stg_ + row_ * 128 + cidx_ * 2) = f2bf16(acc0[mt][r]); *(LAS unsigned short*)(stg_ + row_ * 128 + (cidx_ + 32) * 2) = f2bf16(acc1[mt][r]); } \
                    _Pragma("unroll") for (int k = 0; k < 4; ++k) { const int idx_ = lane + 64 * k, row_ = idx_ >> 3, ch_ = idx_ & 7; \
                        const u32x4 v_ = *(const LAS u32x4*)(stg_ + row_ * 128 + ch_ * 16); const int rr = rowid[64 * wm + 32 * mt + row_]; \
                        if (rr >= 0) *(u32x4*)(YB + (size_t)rr * D + 256 * (tt_ >> 3) + 64 * wn + 8 * ch_) = v_; } } \
                MO_ZERO(); } \
            __syncthreads(); } while (0)
        G2_LOAD(s0, 0); G2_LOAD(s1, 1); G2_LOAD(s2, 2); G2_LOAD(s3, 3);
        MO_WAIT4(12, s0);
        mo_bwrite(s0, lds + MO_B, tid);
        __syncthreads();
        for (int t = 0; t < 64; t += 4) {
            G2_STEP(t, 0, s0, s1);
            G2_STEP(t + 1, 1, s1, s2);
            G2_STEP(t + 2, 0, s2, s3);
            G2_STEP(t + 3, 1, s3, s0);
        }
        asm volatile("s_waitcnt vmcnt(0)" : "+v"(s0.v[0]), "+v"(s0.v[1]), "+v"(s0.v[2]), "+v"(s0.v[3]), "+v"(s1.v[0]), "+v"(s1.v[1]), "+v"(s1.v[2]), "+v"(s1.v[3]), "+v"(s2.v[0]), "+v"(s2.v[1]), "+v"(s2.v[2]), "+v"(s2.v[3]),
                     "+v"(s3.v[0]), "+v"(s3.v[1]), "+v"(s3.v[2]), "+v"(s3.v[3]) :: "memory");
#undef G2_LOAD
#undef G2_STEP
    }
#undef MO_ZERO
}

constexpr int N_PHASES = 1 + 7 * DEPTH;
#ifndef PH_MASK
#define PH_MASK 0xFFFF
#endif
#define PHON(k) (((PH_MASK) >> (k)) & 1)
#ifndef DUP_MASK
#define DUP_MASK 0
#endif
#define DUPON(k) ((((DUP_MASK) >> (k)) & 1) && (l == 0 || (((0x3FE) >> (k)) & 1)))
#ifndef MK_ONE_LAUNCH
#define MK_ONE_LAUNCH 1
#endif

__global__ void __launch_bounds__(NTHR, 2) fwd_kernel(Args args) {
    extern __shared__ __attribute__((aligned(16))) unsigned char lds_raw[];
    LAS unsigned char* lds = (LAS unsigned char*)lds_raw;
    volatile LAS unsigned* MISC = (volatile LAS unsigned*)(lds + MISC_OFF);
    const int wid = __builtin_amdgcn_readfirstlane(threadIdx.x >> 6);
    const int G = gridDim.x, bid = blockIdx.x;
    unsigned char* ws = args.ws;
    unsigned* const ctl0 = (unsigned*)(ws + WS_CTL);
    if (threadIdx.x < 64) MISC[threadIdx.x] = 0u;
    __syncthreads();
    const int lo = args.ph_lo, hi_ph = args.ph_hi;
    XcdBarrier bar; bar.bar = ctl0 + CW_BAR; bar.x = 0; bar.st = MISC + 8; bar.w0 = 0;
    if (hi_ph - lo > 1) bar = xcd_barrier_post(ctl0 + CW_BAR, MISC + 8);
#define IN(k) (lo <= (k) && (k) < hi_ph)
#define FRESH() int wid_ = wid; asm volatile("" : "+s"(wid_)); int lane_; asm volatile("v_mbcnt_lo_u32_b32 %0, -1, 0\n\tv_mbcnt_hi_u32_b32 %0, -1, %0" : "=v"(lane_)); const int tid_ = wid_ * 64 + lane_; (void)tid_
#define SEAM(k) do { if (IN(k) && IN((k) + 1)) xcd_barrier(bar); } while (0)

    const int NGW = G * NWAVES;

    if (PHON(0) && IN(0)) { FRESH(); p0_prologue(args, lds, bid, G, tid_, wid_, lane_); if ((DUP_MASK) & 1) p0_prologue(args, lds, bid, G, tid_, wid_, lane_); }
    SEAM(0);

#pragma unroll 1
    for (int lraw = 0; lraw < DEPTH; ++lraw) {
        int l = lraw; asm volatile("" : "+s"(l));
        GAS unsigned char* wsg = (GAS unsigned char*)ws; asm volatile("" : "+s"(wsg)); unsigned char* const wsl = (unsigned char*)wsg;
        unsigned* const ctl = (unsigned*)(wsl + WS_CTL);
        bf16* const WIN = (bf16*)(wsl + WS_WIN); bf16* const WOUT = (bf16*)(wsl + WS_WOUT); bf16* const W1T = (bf16*)(wsl + WS_W1T); bf16* const W2T = (bf16*)(wsl + WS_W2T); bf16* const RWT = (bf16*)(wsl + WS_RWT);
        float* const C1 = (float*)(wsl + WS_C1); bf16* const X = (bf16*)(wsl + WS_X); bf16* const XN = (bf16*)(wsl + WS_XN); bf16* const PROJ = (bf16*)(wsl + WS_PROJ); float* const AUX = (float*)(wsl + WS_AUX);
        float* const CUM = (float*)(wsl + WS_CUM); bf16* const KC = (bf16*)(wsl + WS_KC); bf16* const VC = (bf16*)(wsl + WS_VC); bf16* const MIX = (bf16*)(wsl + WS_MIX); bf16* const YB = (bf16*)(wsl + WS_YB);
        int* const LIST = (int*)(wsl + WS_LIST); float* const TW = (float*)(wsl + WS_TW);
        const int pb = 1 + 7 * l;
        if (PHON(1) && IN(pb)) {
            pg8::Gemm g{XN, WIN + (size_t)l * NP * D, S, NP, D}; pg8::StaticOrder so; so.init(S, NP, G, bid);
            pg8::EpiProj E{PROJ, AUX};
            pg8::gemm_phase<pg8::EpiProj, pg8::StaticOrder, true, true>(lds, g, so, E, wid);
            {
                const int ntile = (S / 256) * (NP / 256), rmax = (ntile + G - 1) / G, mine = (ntile - bid + G - 1) / G, nh = G * rmax - ntile;
                if (nh == 0 || mine < rmax) {
                    FRESH(); __syncthreads();
                    LAS float* const scr = (LAS float*)(lds + wid_ * 8448);
                    const int hidx = nh == 0 ? bid : bid - (G - nh), nhw = (nh == 0 ? G : nh) * NWAVES;
                    for (int j = hidx * NWAVES + wid_; j < I_L - I_WIN; j += nhw) tr_dispatch(args, (unsigned char*)wsl, l * I_L + I_WIN + j, scr, lane_);
                }
            }
            if (DUPON(1)) pg8::gemm_phase<pg8::EpiProj, pg8::StaticOrder, true, true>(lds, g, so, E, wid);
        }
        SEAM(pb);
        if (IN(pb + 2)) {
            const int x = bid & 7;
#define QHEAD(q) (ctl + CW_Q + (((l * 6 + (q)) * 8 + x) * 64))
            if (PHON(2)) { FRESH(); unsigned* const pdone = ctl + CW_PD + l * 64;
                for (;;) { const int i = dequeue(ctl + CW_PQ + l * 64, MISC + 19, tid_); if (i >= 136) break;
                    if (i < 8) cumsum_unit(i, l, AUX, args.in[5], CUM, lds, tid_); else compress_unit(i - 8, l, PROJ, W1T, W2T, C1, KC, VC, lds, wid_, lane_);
                    asm volatile("s_waitcnt vmcnt(0)" ::: "memory");
                    __syncthreads();
                    if (wid_ == 0) { __builtin_amdgcn_fence(__ATOMIC_RELEASE, "agent"); asm volatile("s_waitcnt vmcnt(0)" ::: "memory"); (void)__hip_atomic_fetch_add(pdone, 1u, __ATOMIC_RELAXED, __HIP_MEMORY_SCOPE_AGENT); }
                } }
            if (PHON(4)) { FRESH(); for (;;) { const int i = dequeue(QHEAD(1), MISC + 17, tid_); if (i >= 32) break; diff_unit(x & 3, 63 - 2 * i - (x >> 2), l, args, PROJ, MIX, lds, tid_, wid_, lane_); }
                if (DUPON(4)) for (;;) { const int i = dequeue(QHEAD(4), MISC + 17, tid_); if (i >= 32) break; diff_unit(x & 3, 63 - 2 * i - (x >> 2), l, args, PROJ, MIX, lds, tid_, wid_, lane_); } }
            if (PHON(2)) { FRESH();
                if (tid_ == 0) { unsigned* const pdone = ctl + CW_PD + l * 64; unsigned sp = 0;
                    while (__hip_atomic_load(pdone, __ATOMIC_RELAXED, __HIP_MEMORY_SCOPE_AGENT) < 136u * 64u) { __builtin_amdgcn_s_sleep(2); if (++sp > (1u << 20)) break; }
                    __builtin_amdgcn_fence(__ATOMIC_ACQUIRE, "agent"); asm volatile("s_waitcnt vmcnt(0)" ::: "memory"); }
                __syncthreads(); }
            if (PHON(3)) { FRESH(); for (;;) { const int i = dequeue(QHEAD(0), MISC + 16, tid_); if (i >= 32) break; fox_unit(x, 31 - i, PROJ, CUM, MIX, lds, tid_, wid_, lane_); }
                if (DUPON(3)) for (;;) { const int i = dequeue(QHEAD(3), MISC + 16, tid_); if (i >= 32) break; fox_unit(x, 31 - i, PROJ, CUM, MIX, lds, tid_, wid_, lane_); } }
            if (PHON(5)) { FRESH(); for (;;) { const int i = dequeue(QHEAD(2), MISC + 18, tid_); if (i >= 64) break; nsa_unit(x & 3, 127 - 2 * i - (x >> 2), args, PROJ, AUX, KC, VC, MIX, lds, tid_, wid_, lane_); }
                if (DUPON(5)) for (;;) { const int i = dequeue(QHEAD(5), MISC + 18, tid_); if (i >= 64) break; nsa_unit(x & 3, 127 - 2 * i - (x >> 2), args, PROJ, AUX, KC, VC, MIX, lds, tid_, wid_, lane_); } }
#undef QHEAD
        }
        SEAM(pb + 2);
        if (PHON(6) && IN(pb + 3)) {
            pg8::Gemm g{MIX, WOUT + (size_t)l * D * D, S, D, D}; pg8::StaticOrder so; so.init(S, D, G, bid);
            pg8::EpiRes E{l == 0 ? args.in[0] : nullptr, X, X};
            pg8::gemm_phase<pg8::EpiRes, pg8::StaticOrder, true, true>(lds, g, so, E, wid);
            if (DUPON(6)) { pg8::EpiRes E2{nullptr, X, YB}; pg8::gemm_phase<pg8::EpiRes, pg8::StaticOrder, true, true>(lds, g, so, E2, wid); }
        }
        SEAM(pb + 3);
        if (PHON(7) && IN(pb + 4)) {
            FRESH();
            for (int p = bid; p < S / 32; p += G) n2_pair(p, l, args, X, XN, RWT, ctl + CW_CNT + l * 1024, LIST, TW, lds, tid_, wid_, lane_);
            if (DUPON(7)) for (int u = bid; u < S / 16; u += G) n2_unit(u, l, args, X, XN, RWT, ctl + CW_CNT + (4 + l) * 1024, (int*)MIX, (float*)(MIX + 8 * 1024 * 1024), lds, tid_, wid_, lane_);
        }
        SEAM(pb + 4);
        if (PHON(8) && IN(pb + 5)) {
            FRESH();
            LAS int* pre = (LAS int*)(lds + MO_PRE);
            if (tid_ < 64) pre[tid_] = ((int)__hip_atomic_load(ctl + CW_CNT + l * 1024 + tid_ * 16, __ATOMIC_RELAXED, __HIP_MEMORY_SCOPE_AGENT) + 127) >> 7;
            __syncthreads();
            const int x = bid & 7, per = G >> 3;
            for (int rep = 0; rep < (DUPON(8) ? 2 : 1); ++rep)
            for (int slot = bid >> 3; ; slot += per) {
                int e = -1, c = 0, acc = 0;
                for (int k = 0; k < 8; ++k) { const int ee = x + 8 * k, n = pre[ee]; if (e < 0 && slot < acc + n) { e = ee; c = slot - acc; } acc += n; }
                if (e < 0) break;
                e = __builtin_amdgcn_readfirstlane(e); c = __builtin_amdgcn_readfirstlane(c);
                const int c0 = c * 128; const int cnt_e = (int)__hip_atomic_load(ctl + CW_CNT + l * 1024 + e * 16, __ATOMIC_RELAXED, __HIP_MEMORY_SCOPE_AGENT);
                const int nrows = (cnt_e - c0) < 128 ? (cnt_e - c0) : 128;
                moe_unit(e, c0, nrows, XN, LIST, args.in[19] + (size_t)l * 64 * D * 256, args.in[20] + (size_t)l * 64 * D * 256, args.in[21] + (size_t)l * 64 * 256 * D, YB, lds, tid_, wid_, lane_);
            }
        }
        SEAM(pb + 5);
        if (PHON(9) && IN(pb + 6)) {
            FRESH(); const int gw_ = bid * NWAVES + wid_;
            if (l + 1 < DEPTH) {
                norm_rows<1>(nullptr, X, X, XN, YB, TW, args.in[1] + (size_t)(l + 1) * D, nullptr, gw_, NGW, lane_);
                if (DUPON(9)) norm_rows<1>(nullptr, X, PROJ, MIX, YB, TW, args.in[1] + (size_t)(l + 1) * D, nullptr, gw_, NGW, lane_);
            } else norm_rows<2>(nullptr, X, nullptr, nullptr, YB, TW, args.in[22], args.out, gw_, NGW, lane_);
        }
        if (l + 1 < DEPTH) SEAM(pb + 6);
    }
#undef IN
#undef SEAM
}

extern "C" void kernel_launch(void* const* d_in, const int* in_sizes, int n_in, void* d_out, int out_size, void* d_ws, size_t ws_size, hipStream_t stream) {
    static int grid = 0;
    if (grid == 0) {
        if (n_in != 23 || ws_size < WS_END || out_size != S * D) { fprintf(stderr, "kernel_launch: unexpected problem (n_in %d, out %d, ws %zu)\n", n_in, out_size, ws_size); grid = -1; return; }
        int dev = 0, cus = 0, per_cu = 0;
        if (hipGetDevice(&dev) != hipSuccess || hipDeviceGetAttribute(&cus, hipDeviceAttributeMultiprocessorCount, dev) != hipSuccess) { grid = -1; return; }
        if (hipFuncSetAttribute((const void*)fwd_kernel, hipFuncAttributeMaxDynamicSharedMemorySize, LDS_BYTES) != hipSuccess) { fprintf(stderr, "kernel_launch: hipFuncSetAttribute failed\n"); grid = -1; return; }
        if (hipOccupancyMaxActiveBlocksPerMultiprocessor(&per_cu, (const void*)fwd_kernel, NTHR, LDS_BYTES) != hipSuccess || per_cu < 1) fprintf(stderr, "kernel_launch: occupancy query says %d blocks per CU\n", per_cu);
        (void)hipGetLastError();
        grid = cus;
        if (grid < 136) { fprintf(stderr, "kernel_launch: too few CUs (%d)\n", grid); }
    }
    if (grid < 0) return;
    if (hipMemsetAsync((char*)d_ws + WS_CTL, 0, CTL_ZERO_BYTES, stream) != hipSuccess) { fprintf(stderr, "kernel_launch: memset failed\n"); return; }
    Args a{};
    for (int i = 0; i < 23; ++i) a.in[i] = (const float*)d_in[i];
    a.out = (float*)d_out; a.ws = (unsigned char*)d_ws;
#if MK_ONE_LAUNCH
    a.ph_lo = 0; a.ph_hi = N_PHASES;
    hipLaunchKernelGGL(fwd_kernel, dim3(grid), dim3(NTHR), LDS_BYTES, stream, a);
#else
    for (int p = 0; p < N_PHASES; ++p) { a.ph_lo = p; a.ph_hi = p + 1; hipLaunchKernelGGL(fwd_kernel, dim3(grid), dim3(NTHR), LDS_BYTES, stream, a); }
#endif
    const hipError_t le = hipPeekAtLastError();
    if (le != hipSuccess) fprintf(stderr, "kernel_launch: launch failed: %s\n", hipGetErrorName(le));
}
```

```cpp
#include <hip/hip_runtime.h>
#include <cstdio>
#include <cstdint>
#include <cmath>
namespace pg8 {
#define PG8_LAS __attribute__((address_space(3)))
typedef unsigned short bf16_t;
typedef short bf16x8 __attribute__((ext_vector_type(8)));
typedef float f32x4 __attribute__((ext_vector_type(4)));
typedef unsigned u32x4 __attribute__((ext_vector_type(4)));
constexpr int BM = 256, BK = 64, HALF = 128, HTB = HALF * BK * 2  , STAGE_BYTES = 8 * HTB, NXCD = 8, WGM = 8;

__host__ __device__ __forceinline__ int lds_byte(int r, int c) { const int st = (r >> 4) * 2 + (c >> 5), rr = r & 15, cc = c & 31, ob = rr * 64 + cc * 2; return st * 1024 + (ob ^ (((ob >> 9) & 1) << 5)); }
__host__ __device__ __forceinline__ void stage_rc(int b, int& R, int& C) { const int st = b / 1024, sb = b % 1024, swz = sb ^ (((sb >> 9) & 1) << 5); R = (st >> 1) * 16 + swz / 64; C = (st & 1) * 32 + (swz % 64) / 2; }
__host__ __device__ __forceinline__ int perm32(int rho) { const int n = rho >> 4, i = rho & 15; return 8 * (i >> 2) + 4 * n + (i & 3); }

struct Unit { int pm, pn; };
struct Gemm { const bf16_t* A; const bf16_t* Bt; int M, N, K; };

struct StaticOrder {
    int nM, nN, nwg, G, c;
    __host__ __device__ void init(int M, int N, int G_, int c_) { nM = M / BM; nN = N / BM; nwg = nM * nN; G = G_; c = c_; }
    __host__ __device__ bool next(int i, Unit& u) const {
        const long L = (long)i * G + c; if (L >= nwg) return false;
        int wgid = (int)L; { const int q = nwg / NXCD, r = nwg % NXCD, xcd = wgid % NXCD, off = wgid / NXCD; wgid = (xcd < r ? xcd * (q + 1) : r * (q + 1) + (xcd - r) * q) + off; }
        const int nig = WGM * nN, gid = wgid / nig, fm = gid * WGM, gsz = (nM - fm) < WGM ? (nM - fm) : WGM;
        u.pm = fm + ((wgid % nig) % gsz); u.pn = (wgid % nig) / gsz; return true;
    }
    __device__ __forceinline__ void a_ready(const Unit&) const {}
    __device__ __forceinline__ void done(const Unit&) const {}
};
__device__ __forceinline__ unsigned cvt_pk_bf16(float lo, float hi) { unsigned r; asm volatile("v_cvt_pk_bf16_f32 %0, %1, %2" : "=v"(r) : "v"(lo), "v"(hi)); return r; }
struct EpiProj {
    static constexpr bool PERM = true, AFTER_DRAIN = false;
    bf16_t* O; float* aux; const float* rstd;
    __device__ __forceinline__ void operator()(const f32x4 (&acc)[2][2][4][2], const Unit& u, int wr, int wc, int fr, int fq) const {
        const int row0 = u.pm * BM + wr * 64 + fr;
        if (u.pn < 22) {
            const int col0 = u.pn * BM + wc * 32 + 8 * fq;
#pragma unroll
            for (int ai = 0; ai < 2; ++ai)
#pragma unroll
                for (int m = 0; m < 4; ++m) { bf16_t* rowp = O + (size_t)(row0 + ai * HALF + m * 16) * 5632 + col0; const float rs = rstd[row0 + ai * HALF + m * 16];
#pragma unroll
                    for (int bj = 0; bj < 2; ++bj) { const f32x4 v0 = acc[ai][bj][m][0] * rs, v1 = acc[ai][bj][m][1] * rs;
                        u32x4 w; w.x = cvt_pk_bf16(v0[0], v0[1]); w.y = cvt_pk_bf16(v0[2], v0[3]); w.z = cvt_pk_bf16(v1[0], v1[1]); w.w = cvt_pk_bf16(v1[2], v1[3]);
                        *(u32x4*)(rowp + bj * HALF) = w; } }
        } else if (wc < 2) {
            const int col0 = wc * 32 + 8 * fq;
#pragma unroll
            for (int ai = 0; ai < 2; ++ai)
#pragma unroll
                for (int m = 0; m < 4; ++m) { float* rowp = aux + (size_t)(row0 + ai * HALF + m * 16) * 64 + col0; const float rs = rstd[row0 + ai * HALF + m * 16];
                    *(f32x4*)(rowp) = acc[ai][0][m][0] * rs; *(f32x4*)(rowp + 4) = acc[ai][0][m][1] * rs; }
        }
    }
};
struct EpiRes {
    static constexpr bool PERM = true, AFTER_DRAIN = false;
    const float* basef; const bf16_t* baseb; bf16_t* out;
    __device__ __forceinline__ void operator()(const f32x4 (&acc)[2][2][4][2], const Unit& u, int wr, int wc, int fr, int fq) const {
        const int row0 = u.pm * BM + wr * 64 + fr, col0 = u.pn * BM + wc * 32 + 8 * fq;
#pragma unroll
        for (int ai = 0; ai < 2; ++ai)
#pragma unroll
            for (int m = 0; m < 4; ++m) { const size_t off = (size_t)(row0 + ai * HALF + m * 16) * 2048 + col0;
#pragma unroll
                for (int bj = 0; bj < 2; ++bj) { f32x4 v0 = acc[ai][bj][m][0], v1 = acc[ai][bj][m][1]; const size_t o = off + bj * HALF;
                    if (basef) { v0 += *(const f32x4*)(basef + o); v1 += *(const f32x4*)(basef + o + 4); }
                    else { const u32x4 b = *(const u32x4*)(baseb + o);
                        v0[0] += __uint_as_float(b.x << 16); v0[1] += __uint_as_float(b.x & 0xffff0000u); v0[2] += __uint_as_float(b.y << 16); v0[3] += __uint_as_float(b.y & 0xffff0000u);
                        v1[0] += __uint_as_float(b.z << 16); v1[1] += __uint_as_float(b.z & 0xffff0000u); v1[2] += __uint_as_float(b.w << 16); v1[3] += __uint_as_float(b.w & 0xffff0000u); }
                    u32x4 w; w.x = cvt_pk_bf16(v0[0], v0[1]); w.y = cvt_pk_bf16(v0[2], v0[3]); w.z = cvt_pk_bf16(v1[0], v1[1]); w.w = cvt_pk_bf16(v1[2], v1[3]);
                    *(u32x4*)(out + o) = w; } }
    }
};
template <class Epi, class Sched, bool ALIGN_EPI = false, bool SP2 = false>
__device__ __forceinline__ void gemm_phase(PG8_LAS unsigned char* lds, const Gemm g, const Sched& S, const Epi& E, int wid_in  ) {
    int wid = wid_in; asm volatile("" : "+s"(wid));
    int lane = (int)__builtin_amdgcn_mbcnt_hi(~0u, __builtin_amdgcn_mbcnt_lo(~0u, 0u)); asm volatile("" : "+v"(lane));
    const int tid = wid * 64 + lane, wr = wid >> 2, wc = wid & 3, fr = lane & 15, fq = lane >> 4;
    const int K = g.K, nt = K / BK;
    unsigned voffA[2], voffB[2];
#pragma unroll
    for (int i = 0; i < 2; ++i) { int R, C; stage_rc(tid * 16 + i * 8192, R, C); const int Rb = Epi::PERM ? ((R & ~31) + perm32(R & 31)) : R;
        voffA[i] = (unsigned)(R * K + C) * 2u; voffB[i] = (unsigned)(Rb * K + C) * 2u; }
    const size_t kstep = (size_t)(BK * 2);
    const size_t hstep = (size_t)HALF * K * 2;
    const size_t tstep = 2 * hstep;
    const unsigned ldsw = (unsigned)wid * 1024u;
    const int aoff = lds_byte(wr * 64 + fr, fq * 8), boff = lds_byte(wc * 32 + fr, fq * 8);
#define PG8_SA(b, h) (((b) * 2 + (h)) * HTB)
#define PG8_SB(b, h) ((4 + (b) * 2 + (h)) * HTB)
#define PG8_STAGE(bufoff, gbase, voff) do { _Pragma("unroll") for (int _i = 0; _i < 2; ++_i) \
        __builtin_amdgcn_global_load_lds((const unsigned*)((const char*)(gbase) + (voff)[_i]), (PG8_LAS unsigned*)(lds + (bufoff) + ldsw + _i * 8192), 16, 0, 0); } while (0)
#define PG8_LDA(dst, b, h) do { _Pragma("unroll") for (int m = 0; m < 4; ++m) _Pragma("unroll") for (int k = 0; k < 2; ++k) dst[m][k] = *(const PG8_LAS bf16x8*)(lds + PG8_SA(b, h) + aoff + m * 2048 + k * 1024); } while (0)
#define PG8_LDB(dst, b, h) do { _Pragma("unroll") for (int n = 0; n < 2; ++n) _Pragma("unroll") for (int k = 0; k < 2; ++k) dst[n][k] = *(const PG8_LAS bf16x8*)(lds + PG8_SB(b, h) + boff + n * 2048 + k * 1024); } while (0)
#define PG8_MMA(ai, bj, At, Bt) do { __builtin_amdgcn_s_setprio(1); _Pragma("unroll") for (int m = 0; m < 4; ++m) _Pragma("unroll") for (int n = 0; n < 2; ++n) _Pragma("unroll") for (int k = 0; k < 2; ++k) \
        acc[ai][bj][m][n] = __builtin_amdgcn_mfma_f32_16x16x32_bf16(Bt[n][k], At[m][k], acc[ai][bj][m][n], 0, 0, 0); __builtin_amdgcn_s_setprio(0); } while (0)
#define PG8_WAIT_V(n) asm volatile("s_waitcnt vmcnt(" #n ")" ::: "memory")
#define PG8_WAIT_L(n) asm volatile("s_waitcnt lgkmcnt(" #n ")" ::: "memory")
#define PG8_BAR __builtin_amdgcn_s_barrier()
#define PG8_SCHED __builtin_amdgcn_sched_barrier(0)
    Unit cur, nxt; int ui = 0;
    if (!S.next(0, cur)) return;
    f32x4 acc[2][2][4][2];
#pragma unroll
    for (int a = 0; a < 2; ++a)
#pragma unroll
        for (int b = 0; b < 2; ++b)
#pragma unroll
            for (int m = 0; m < 4; ++m)
#pragma unroll
                for (int n = 0; n < 2; ++n) acc[a][b][m][n] = (f32x4){0.f, 0.f, 0.f, 0.f};
    bf16x8 At[4][2], B0[2][2], B1[2][2];
    const char* cA = (const char*)g.A + (size_t)cur.pm * tstep; const char* cB = (const char*)g.Bt + (size_t)cur.pn * tstep;
    S.a_ready(cur);
    if constexpr (SP2) {
        PG8_STAGE(PG8_SB(0, 0), cB, voffB); PG8_STAGE(PG8_SB(0, 1), cB + hstep, voffB); PG8_STAGE(PG8_SA(0, 0), cA, voffA); PG8_STAGE(PG8_SA(0, 1), cA + hstep, voffA);
        if (wr == 1) PG8_BAR;
        PG8_WAIT_V(2); PG8_BAR;
        PG8_STAGE(PG8_SB(1, 0), cB + kstep, voffB); PG8_STAGE(PG8_SA(1, 0), cA + kstep, voffA); PG8_STAGE(PG8_SB(1, 1), cB + hstep + kstep, voffB);
        PG8_WAIT_V(6); PG8_BAR;
    } else {
        PG8_STAGE(PG8_SB(0, 0), cB, voffB); PG8_STAGE(PG8_SA(0, 0), cA, voffA); PG8_STAGE(PG8_SB(0, 1), cB + hstep, voffB); PG8_STAGE(PG8_SA(0, 1), cA + hstep, voffA);
        if (wr == 1) PG8_BAR;
        PG8_WAIT_V(4); PG8_BAR;
        PG8_STAGE(PG8_SB(1, 0), cB + kstep, voffB); PG8_STAGE(PG8_SA(1, 0), cA + kstep, voffA); PG8_STAGE(PG8_SB(1, 1), cB + hstep + kstep, voffB);
        PG8_WAIT_V(6); PG8_BAR;
    }
    for (;;) {
        const bool has_next = S.next(ui + 1, nxt);
        const char* nA = has_next ? (const char*)g.A + (size_t)nxt.pm * tstep : cA; const char* nB = has_next ? (const char*)g.Bt + (size_t)nxt.pn * tstep : cB;
        for (int t = 0; t < nt; t += 2) {
            const bool last = (t == nt - 2);
            const char* a1 = cA + (size_t)(t + 1) * kstep;
            const char* a2 = last ? nA : cA + (size_t)(t + 2) * kstep; const char* b2 = last ? nB : cB + (size_t)(t + 2) * kstep;
            const char* a3 = a2 + kstep; const char* b3 = b2 + kstep;
            if (last && has_next) S.a_ready(nxt);
            if constexpr (SP2) {
            PG8_LDB(B0, 0, 0); PG8_LDB(B1, 0, 1); PG8_SCHED; PG8_LDA(At, 0, 0); PG8_STAGE(PG8_SA(1, 1), a1 + hstep, voffA);
            PG8_WAIT_V(8); PG8_WAIT_L(0); PG8_BAR; PG8_MMA(0, 0, At, B0); PG8_MMA(0, 1, At, B1); PG8_BAR; PG8_SCHED;
            PG8_LDA(At, 0, 1); PG8_STAGE(PG8_SB(0, 0), b2, voffB); PG8_STAGE(PG8_SB(0, 1), b2 + hstep, voffB); PG8_STAGE(PG8_SA(0, 0), a2, voffA);
            PG8_WAIT_V(8); PG8_WAIT_L(0); PG8_BAR; PG8_MMA(1, 0, At, B0); PG8_MMA(1, 1, At, B1); PG8_BAR; PG8_SCHED;
            PG8_LDB(B0, 1, 0); PG8_LDB(B1, 1, 1); PG8_SCHED; PG8_LDA(At, 1, 0); PG8_STAGE(PG8_SA(0, 1), a2 + hstep, voffA);
            PG8_WAIT_V(8); PG8_WAIT_L(0); PG8_BAR; PG8_MMA(0, 0, At, B0); PG8_MMA(0, 1, At, B1); PG8_BAR; PG8_SCHED;
            PG8_LDA(At, 1, 1); PG8_STAGE(PG8_SB(1, 0), b3, voffB); PG8_STAGE(PG8_SB(1, 1), b3 + hstep, voffB); PG8_STAGE(PG8_SA(1, 0), a3, voffA);
            PG8_WAIT_V(8); PG8_WAIT_L(0); PG8_BAR; PG8_MMA(1, 0, At, B0); PG8_MMA(1, 1, At, B1); PG8_BAR; PG8_SCHED;
            } else {
            PG8_LDB(B0, 0, 0); PG8_SCHED; PG8_LDA(At, 0, 0); PG8_STAGE(PG8_SA(1, 1), a1 + hstep, voffA);
            PG8_WAIT_L(8); PG8_BAR; PG8_WAIT_L(0); PG8_MMA(0, 0, At, B0); PG8_BAR; PG8_SCHED;
            PG8_LDB(B1, 0, 1); PG8_STAGE(PG8_SB(0, 0), b2, voffB);
            PG8_BAR; PG8_WAIT_L(0); PG8_MMA(0, 1, At, B1); PG8_BAR;
            PG8_LDA(At, 0, 1); PG8_STAGE(PG8_SA(0, 0), a2, voffA);
            PG8_BAR; PG8_WAIT_L(0); PG8_MMA(1, 0, At, B0); PG8_BAR; PG8_SCHED;
            PG8_STAGE(PG8_SB(0, 1), b2 + hstep, voffB);
            PG8_WAIT_V(6); PG8_BAR; PG8_MMA(1, 1, At, B1); PG8_BAR;
            PG8_LDB(B0, 1, 0); PG8_SCHED; PG8_LDA(At, 1, 0); PG8_STAGE(PG8_SA(0, 1), a2 + hstep, voffA);
            PG8_WAIT_L(8); PG8_BAR; PG8_WAIT_L(0); PG8_MMA(0, 0, At, B0); PG8_BAR; PG8_SCHED;
            PG8_LDB(B1, 1, 1); PG8_STAGE(PG8_SB(1, 0), b3, voffB);
            PG8_BAR; PG8_WAIT_L(0); PG8_MMA(0, 1, At, B1); PG8_BAR;
            PG8_LDA(At, 1, 1); PG8_STAGE(PG8_SA(1, 0), a3, voffA);
            PG8_BAR; PG8_WAIT_L(0); PG8_MMA(1, 0, At, B0); PG8_BAR; PG8_SCHED;
            PG8_STAGE(PG8_SB(1, 1), b3 + hstep, voffB);
            PG8_WAIT_V(6); PG8_BAR; PG8_MMA(1, 1, At, B1); PG8_BAR;
            }
        }
        if constexpr (ALIGN_EPI) { if (wr == 0) PG8_BAR; }
        if constexpr (!Epi::AFTER_DRAIN) { E(acc, cur, wr, wc, fr, fq); S.done(cur); }
        if (!has_next) break;
#pragma unroll
        for (int a = 0; a < 2; ++a)
#pragma unroll
            for (int b = 0; b < 2; ++b)
#pragma unroll
                for (int m = 0; m < 4; ++m)
#pragma unroll
                    for (int n = 0; n < 2; ++n) acc[a][b][m][n] = (f32x4){0.f, 0.f, 0.f, 0.f};
        cur = nxt; cA = nA; cB = nB; ++ui;
        if constexpr (ALIGN_EPI) { if (wr == 1) PG8_BAR; }
    }
    PG8_WAIT_V(0);
    if constexpr (!ALIGN_EPI) { if (wr == 0) PG8_BAR; }
    PG8_BAR;
    if constexpr (Epi::AFTER_DRAIN) { E.fused(acc, cur, wr, wc, fr, fq, lds, wid, lane); S.done(cur); }
#undef PG8_SA
#undef PG8_SB
#undef PG8_STAGE
#undef PG8_LDA
#undef PG8_LDB
#undef PG8_MMA
#undef PG8_WAIT_V
#undef PG8_WAIT_L
#undef PG8_BAR
#undef PG8_SCHED
}
}
#define GAS __attribute__((address_space(1)))
#define LAS __attribute__((address_space(3)))
typedef unsigned short bf16;
typedef unsigned v4u __attribute__((ext_vector_type(4)));
typedef float f32x4 __attribute__((ext_vector_type(4)));
typedef short bf16x8 __attribute__((ext_vector_type(8)));
typedef GAS unsigned gu32;
typedef GAS unsigned long long gu64;
#define RLX_AGENT __ATOMIC_RELAXED, __HIP_MEMORY_SCOPE_AGENT
#define LDS_WAIT() asm volatile("s_waitcnt lgkmcnt(0)" ::: "memory")
#define VM_WAIT() asm volatile("s_waitcnt vmcnt(0)" ::: "memory")
__device__ __forceinline__ unsigned long long rt() { return __builtin_amdgcn_s_memrealtime(); }
__device__ __forceinline__ unsigned f2bf(float f) { unsigned u = __builtin_bit_cast(unsigned, f); return (u + 0x7fffu + ((u >> 16) & 1u)) >> 16; }
__device__ __forceinline__ unsigned pk2(float lo, float hi) { return f2bf(lo) | (f2bf(hi) << 16); }
#define XB_TMO      128
#define XB_XCNT(j)  (256  + 64 * (j))
#define XB_XSUB(j)  (1280 + 64 * (j))
#define XB_XGEN(j)  (2304 + 64 * (j))
#define XB_TOP      3328
#define XB_TOPGEN   3392
#define XCD_BAR_WORDS 3456
#define XB_SPIN_CAP (1u << 18)

__device__ __forceinline__ unsigned xb_ld(unsigned* p)              { return __hip_atomic_load(p, __ATOMIC_RELAXED, __HIP_MEMORY_SCOPE_AGENT); }
__device__ __forceinline__ unsigned xb_add(unsigned* p, unsigned v) { return __hip_atomic_fetch_add(p, v, __ATOMIC_RELAXED, __HIP_MEMORY_SCOPE_AGENT); }
__device__ __forceinline__ unsigned xb_xcc_id() { return (unsigned)__builtin_amdgcn_s_getreg((3 << 11) | 20) & 0xFu; }
#define XB_SPIN(cond, bar) do { unsigned _sp = 0; while (cond) { __builtin_amdgcn_s_sleep(1); \
    if ((++_sp & 255u) == 0u) { if (xb_ld(&(bar)[XB_TMO])) break; if (_sp > XB_SPIN_CAP) { atomicAdd(&(bar)[XB_TMO], 1u); break; } } } } while (0)

struct XcdBarrier {
    unsigned* bar; unsigned x;
    unsigned w0;
    volatile LAS unsigned* st;
};

__device__ __forceinline__ XcdBarrier xcd_barrier_post(unsigned* bar, volatile LAS unsigned* st) {
    XcdBarrier b; b.bar = bar; b.x = xb_xcc_id(); b.st = st; b.w0 = (__builtin_amdgcn_readfirstlane(threadIdx.x >> 6) == 0) ? 1u : 0u;
    if (threadIdx.x == 0) (void)xb_add(&bar[XB_XCNT(b.x)], 1u);
    return b;
}
__device__ __forceinline__ void xcd_barrier_complete(unsigned* bar, unsigned x, unsigned& nloc, unsigned& nx) {
    const unsigned G = gridDim.x * gridDim.y * gridDim.z;
    unsigned sum, cnt, mine, sp = 0u;
    for (;;) {
        sum = 0u; cnt = 0u; mine = 0u;
#pragma unroll
        for (unsigned j = 0; j < 16; ++j) { const unsigned c = xb_ld(&bar[XB_XCNT(j)]); sum += c; cnt += (c > 0u) ? 1u : 0u; mine = (j == x) ? c : mine; }
        if (sum == G) break;
        __builtin_amdgcn_s_sleep(1);
        if ((++sp & 255u) == 0u) { if (xb_ld(&bar[XB_TMO])) break; if (sp > XB_SPIN_CAP) { atomicAdd(&bar[XB_TMO], 1u); break; } }
    }
    nloc = mine > 0u ? mine : 1u; nx = cnt > 0u ? cnt : 1u;
}

__device__ __forceinline__ void xcd_barrier(const XcdBarrier& b) {
    asm volatile("s_waitcnt vmcnt(0)" ::: "memory");
    __syncthreads();
    if (b.w0 != 0u && __builtin_amdgcn_mbcnt_hi(~0u, __builtin_amdgcn_mbcnt_lo(~0u, 0u)) == 0u) {
        GAS unsigned* barg = (GAS unsigned*)b.bar; asm volatile("" : "+s"(barg)); unsigned* bar = (unsigned*)barg;
        __builtin_amdgcn_s_waitcnt(0);
        unsigned nloc = b.st[0], nx = b.st[1];
        if (nloc == 0u) { xcd_barrier_complete(bar, b.x, nloc, nx); b.st[0] = nloc; b.st[1] = nx; }
        const unsigned old = xb_add(&bar[XB_XSUB(b.x)], 1u);
        const unsigned gen = old / nloc;
        if (old + 1u == (gen + 1u) * nloc) {
            __builtin_amdgcn_fence(__ATOMIC_RELEASE, "agent");
            asm volatile("s_waitcnt vmcnt(0)" ::: "memory");
            const unsigned og = xb_add(&bar[XB_TOP], 1u);
            const unsigned tg = og / nx;
            if (og + 1u == (tg + 1u) * nx) xb_add(&bar[XB_TOPGEN], 1u);
            else XB_SPIN(xb_ld(&bar[XB_TOPGEN]) == tg, bar);
            __builtin_amdgcn_fence(__ATOMIC_ACQUIRE, "agent");
            xb_add(&bar[XB_XGEN(b.x)], 1u);
            asm volatile("s_waitcnt vmcnt(0)" ::: "memory");
        } else {
            XB_SPIN(xb_ld(&bar[XB_XGEN(b.x)]) == gen, bar);
            __builtin_amdgcn_fence(__ATOMIC_ACQUIRE, "agent");
            asm volatile("s_waitcnt vmcnt(0)" ::: "memory");
        }
    }
    __syncthreads();
}
typedef unsigned u32x4 __attribute__((ext_vector_type(4)));

typedef short s16x4 __attribute__((ext_vector_type(4)));
typedef float f32x16 __attribute__((ext_vector_type(16)));
typedef unsigned u32x2 __attribute__((ext_vector_type(2)));
typedef float f32x2v __attribute__((ext_vector_type(2)));

constexpr int S = 8192, D = 2048, DEPTH = 4, DIN = 5688, NP = 5888, PITCH = 5632;
constexpr int C_AQ = 0, C_AK = 512, C_AV = 1024, C_BQ = 1536, C_BK = 2048, C_BV = 2560, C_CQ = 3072, C_KC = 4096, C_VC = 4352, C_KS = 4608, C_VS = 4864, C_KW = 5120, C_VW = 5376;
constexpr float RMS_EPS = 1e-6f, NEG = -1e30f, LOG2E = 1.4426950408889634f, SCL2 = 0.125f * 1.4426950408889634f;
constexpr int NWAVES = 8, NTHR = 512;

constexpr size_t MiB = 1u << 20;
constexpr size_t WS_CTL = 0, CTL_ZERO_BYTES = 1 * MiB;
constexpr size_t WS_WIN = 2 * MiB;
constexpr size_t WS_WOUT = 96 * MiB;
constexpr size_t WS_W1T = 128 * MiB;
constexpr size_t WS_W2T = 136 * MiB;
constexpr size_t WS_RWT = 137 * MiB;
constexpr size_t WS_C1 = 139 * MiB;
constexpr size_t WS_X = 144 * MiB;
constexpr size_t WS_XN = 208 * MiB;
constexpr size_t WS_PROJ = 240 * MiB;
constexpr size_t WS_AUX = 330 * MiB;
constexpr size_t WS_CUM = 332 * MiB;
constexpr size_t WS_KC = 333 * MiB;
constexpr size_t WS_VC = 334 * MiB;
constexpr size_t WS_MIX = 336 * MiB;
constexpr size_t WS_YB = 368 * MiB;
constexpr size_t WS_LIST = 432 * MiB;
constexpr size_t WS_TW = 436 * MiB;
constexpr size_t WS_RSTD = 437 * MiB;
constexpr size_t WS_END = 440 * MiB;
constexpr int CW_BAR = 4096;
constexpr int CW_Q = 8192;
constexpr int CW_PQ = 24576, CW_PD = 25600;
constexpr int CW_CNT = 32768;

constexpr int LDS_BYTES = 160 * 1024;
constexpr int MISC_OFF = 150 * 1024;

struct Args { const float* in[23]; float* out; unsigned char* ws; int ph_lo, ph_hi; };
__device__ __forceinline__ int t5_bucket(int rel) { if (rel < 16) return rel; int b = 16;
    b += rel >= 19; b += rel >= 21; b += rel >= 24; b += rel >= 27; b += rel >= 31; b += rel >= 35; b += rel >= 40; b += rel >= 46; b += rel >= 52; b += rel >= 59; b += rel >= 67; b += rel >= 77; b += rel >= 87; b += rel >= 99; b += rel >= 113; return b; }

__device__ __forceinline__ float bf2f(unsigned short b) { return __uint_as_float((unsigned)b << 16); }
__device__ __forceinline__ float bflo(unsigned w) { return __uint_as_float(w << 16); }
__device__ __forceinline__ float bfhi(unsigned w) { return __uint_as_float(w & 0xffff0000u); }
typedef __bf16 bf16x2_t __attribute__((ext_vector_type(2)));
__device__ __forceinline__ unsigned cvtpk(float lo, float hi) { f32x2v v = {lo, hi}; bf16x2_t b = __builtin_convertvector(v, bf16x2_t); return __builtin_bit_cast(unsigned, b); }
__device__ __forceinline__ unsigned short f2bf16(float f) { return (unsigned short)(cvtpk(f, 0.f) & 0xffffu); }
__device__ __forceinline__ float wave_sum(float v) {
#pragma unroll
    for (int o = 1; o < 64; o <<= 1) v += __shfl_xor(v, o);
    return v;
}
__device__ __forceinline__ int crow(int r, int hi) { return (r & 3) + 8 * (r >> 2) + 4 * hi; }
#define MFMA32(a, b, c) __builtin_amdgcn_mfma_f32_32x32x16_bf16((a), (b), (c), 0, 0, 0)
#define MFMA16(a, b, c) __builtin_amdgcn_mfma_f32_16x16x32_bf16((a), (b), (c), 0, 0, 0)

__device__ __forceinline__ int src_col_win(int n) { if (n < 3072) return n; if (n < 5632) return n + 8; if (n < 5640) return n - 2560; if (n < 5688) return n; return -1; }

template <int MODE>
__device__ __forceinline__ void tr_item(const float* W, const float* W2, int ldw, int K, bf16* WT, int k0, int n0, LAS float* scr, int lane, const float* kgain = nullptr  ) {
    const int nn = n0 + (lane & 31);
    const float* src = W; int ld = ldw; bool ok = true;
    if (MODE == 0) { src = W + nn; }
    else if (MODE == 1) { const int c = src_col_win(nn); ok = c >= 0; src = W + (ok ? c : 0); }
    else { if (nn < 8) { src = W + nn; ld = 8; } else if (nn < 72) { src = W2 + (nn - 8); ld = 64; } else { ok = false; ld = 8; } }
    float tv[32];
#pragma unroll
    for (int i = 0; i < 32; ++i) { const int kk = 2 * i + (lane >> 5); tv[i] = ok ? src[(size_t)(k0 + kk) * ld] : 0.f; }
#pragma unroll
    for (int i = 0; i < 32; ++i) { const int kk = 2 * i + (lane >> 5); scr[kk * 33 + (lane & 31)] = tv[i]; }
    LDS_WAIT(); asm volatile("" ::: "memory");
    const int c = lane & 7;
    f32x4 g0 = (f32x4){1.f, 1.f, 1.f, 1.f}, g1 = g0;
    if (MODE == 1) { g0 = *(const f32x4*)(kgain + k0 + 8 * c); g1 = *(const f32x4*)(kgain + k0 + 8 * c + 4); }
#pragma unroll
    for (int j = 0; j < 4; ++j) { const int n = (lane >> 3) + 8 * j; const LAS float* s = scr + (8 * c) * 33 + n;
        v4u o; o.x = pk2(s[0 * 33] * g0.x, s[1 * 33] * g0.y); o.y = pk2(s[2 * 33] * g0.z, s[3 * 33] * g0.w); o.z = pk2(s[4 * 33] * g1.x, s[5 * 33] * g1.y); o.w = pk2(s[6 * 33] * g1.z, s[7 * 33] * g1.w);
        *(v4u*)(WT + (size_t)(n0 + n) * K + k0 + 8 * c) = o; }
    LDS_WAIT(); asm volatile("" ::: "memory");
}

template <int MODE>
__device__ __forceinline__ void norm_rows(const float* xsrc, const bf16* xb, bf16* X, bf16* XN, const bf16* YB, const float* TW, const float* gain, float* out, float* RSTD, int gw, int NGW, int lane) {
    for (int row = gw; row < S; row += NGW) {
        f32x4 v[8];
        if (MODE == 0) { const f32x4* xr = (const f32x4*)(xsrc + (size_t)row * D) + lane;
#pragma unroll
            for (int j = 0; j < 8; ++j) v[j] = xr[64 * j];
        } else { const u32x2* xr = (const u32x2*)(xb + (size_t)row * D) + lane;
#pragma unroll
            for (int j = 0; j < 8; ++j) { const u32x2 r = xr[64 * j]; v[j] = (f32x4){bflo(r.x), bfhi(r.x), bflo(r.y), bfhi(r.y)}; } }
        if (MODE >= 1) {
            const float w0 = TW[2 * row], w1 = TW[2 * row + 1];
            const u32x2* ya = (const u32x2*)(YB + (size_t)(2 * row) * D) + lane; const u32x2* yb = (const u32x2*)(YB + (size_t)(2 * row + 1) * D) + lane;
#pragma unroll
            for (int j = 0; j < 8; ++j) { const u32x2 a = ya[64 * j], b = yb[64 * j];
                v[j].x += w0 * bflo(a.x) + w1 * bflo(b.x); v[j].y += w0 * bfhi(a.x) + w1 * bfhi(b.x);
                v[j].z += w0 * bflo(a.y) + w1 * bflo(b.y); v[j].w += w0 * bfhi(a.y) + w1 * bfhi(b.y); }
        }
        float ss = 0.f;
#pragma unroll
        for (int j = 0; j < 8; ++j) ss += (v[j].x * v[j].x + v[j].y * v[j].y) + (v[j].z * v[j].z + v[j].w * v[j].w);
        ss = wave_sum(ss);
        const float rstd = 1.0f / sqrtf(ss * (1.0f / D) + RMS_EPS);
        if (MODE <= 1) { u32x2* xo = (u32x2*)((MODE == 1 ? X : XN) + (size_t)row * D) + lane;
#pragma unroll
            for (int j = 0; j < 8; ++j) { u32x2 w; w.x = cvtpk(v[j].x, v[j].y); w.y = cvtpk(v[j].z, v[j].w); xo[64 * j] = w; }
            if (lane == 0) RSTD[row] = rstd; }
        const f32x4* gr = (const f32x4*)gain + lane;
        if (MODE < 0) { u32x2* o8 = (u32x2*)(XN + (size_t)row * D) + lane;
#pragma unroll
            for (int j = 0; j < 8; ++j) { const f32x4 g = gr[64 * j]; u32x2 w; w.x = cvtpk(v[j].x * rstd * g.x, v[j].y * rstd * g.y); w.y = cvtpk(v[j].z * rstd * g.z, v[j].w * rstd * g.w); o8[64 * j] = w; }
        } else if (MODE == 2) { f32x4* oo = (f32x4*)(out + (size_t)row * D) + lane;
#pragma unroll
            for (int j = 0; j < 8; ++j) { const f32x4 g = gr[64 * j]; oo[64 * j] = v[j] * rstd * g; } }
    }
}

constexpr int I_WIN = 32 * 184, I_WOUT = 32 * 64, I_W1 = 32 * 8, I_W2 = 4 * 2, I_RW = 32 * 3, I_L = I_WIN + I_WOUT + 2 * I_W1 + 2 * I_W2 + I_RW;
__device__ __forceinline__ void tr_dispatch(const Args& a, unsigned char* ws, int it, LAS float* scr, int lane) {
        const int l = it / I_L; int r = it % I_L;
        if (r < I_WIN) { tr_item<1>(a.in[2] + (size_t)l * D * DIN, nullptr, DIN, D, (bf16*)(ws + WS_WIN) + (size_t)l * NP * D, 64 * (r / 184), 32 * (r % 184), scr, lane, a.in[1] + (size_t)l * D); return; } r -= I_WIN;
        if (r < I_WOUT) { tr_item<0>(a.in[13] + (size_t)l * D * D, nullptr, D, D, (bf16*)(ws + WS_WOUT) + (size_t)l * D * D, 64 * (r / 64), 32 * (r % 64), scr, lane); return; } r -= I_WOUT;
        if (r < 2 * I_W1) { const int kv = r / I_W1, q = r % I_W1; tr_item<0>(a.in[kv ? 10 : 7] + (size_t)l * 2048 * 256, nullptr, 256, 2048, (bf16*)(ws + WS_W1T) + (size_t)(l * 2 + kv) * 256 * 2048, 64 * (q / 8), 32 * (q % 8), scr, lane); return; } r -= 2 * I_W1;
        if (r < 2 * I_W2) { const int kv = r / I_W2, q = r % I_W2; tr_item<0>(a.in[kv ? 11 : 8] + (size_t)l * 256 * 64, nullptr, 64, 256, (bf16*)(ws + WS_W2T) + (size_t)(l * 2 + kv) * 64 * 256, 64 * (q / 2), 32 * (q % 2), scr, lane); return; } r -= 2 * I_W2;
        tr_item<2>(a.in[15] + (size_t)l * D * 8, a.in[17] + (size_t)l * D * 64, 8, D, (bf16*)(ws + WS_RWT) + (size_t)l * 96 * D, 64 * (r / 3), 32 * (r % 3), scr, lane);
}

__device__ __forceinline__ void p0_prologue(const Args& a, LAS unsigned char* lds, int bid, int G, int tid, int wid, int lane) {
    unsigned char* ws = a.ws;
    LAS float* scr = (LAS float*)(lds + wid * 8448);
    const int gw = bid * NWAVES + wid, NGW = G * NWAVES;
    for (int j = gw; j < DEPTH * I_WIN; j += NGW) tr_dispatch(a, ws, (j / I_WIN) * I_L + (j % I_WIN), scr, lane);
    for (int b = bid; b < 256; b += G) {
        const int vec = b >> 5, cb = b & 31, l = vec >> 1, kv = vec & 1; const float* pos = a.in[kv ? 9 : 6] + (size_t)l * 2048; const float* w1 = a.in[kv ? 10 : 7] + (size_t)l * 2048 * 256 + 8 * cb;
        float acc[8];
#pragma unroll
        for (int i = 0; i < 8; ++i) acc[i] = 0.f;
#pragma unroll
        for (int j = 0; j < 4; ++j) { const int k = tid + 512 * j; const float pv = pos[k]; const f32x4 w0 = *(const f32x4*)(w1 + (size_t)k * 256), w1v = *(const f32x4*)(w1 + (size_t)k * 256 + 4);
            acc[0] += pv * w0.x; acc[1] += pv * w0.y; acc[2] += pv * w0.z; acc[3] += pv * w0.w; acc[4] += pv * w1v.x; acc[5] += pv * w1v.y; acc[6] += pv * w1v.z; acc[7] += pv * w1v.w; }
        LAS float* red = (LAS float*)(lds + 72 * 1024);
#pragma unroll
        for (int i = 0; i < 8; ++i) { const float sws = wave_sum(acc[i]); if (lane == 0) red[wid * 8 + i] = sws; }
        __syncthreads();
        if (tid < 8) { float sres = 0.f;
#pragma unroll
            for (int w = 0; w < 8; ++w) sres += red[w * 8 + tid];
            ((float*)(ws + WS_C1))[vec * 256 + 8 * cb + tid] = sres; }
        __syncthreads();
    }
    norm_rows<0>(a.in[0], nullptr, nullptr, (bf16*)(ws + WS_XN), nullptr, nullptr, a.in[1], nullptr, (float*)(ws + WS_RSTD), gw, NGW, lane);
}

__device__ __forceinline__ float gelu_tanh(float x) { const float u = 0.7978845608028654f * (x + 0.044715f * x * x * x); const float t = 1.0f - 2.0f / (__expf(2.0f * u) + 1.0f); return 0.5f * x * (1.0f + t); }

__device__ __forceinline__ void compress_unit(int u, int l, const bf16* PROJ, const bf16* W1T, const bf16* W2T, const float* C1, bf16* KC, bf16* VC, LAS unsigned char* lds, int wid, int lane) {
    const int kv = u >> 6, rb = u & 63, r32 = lane & 31, hi = lane >> 5;
    const int R = 32 * rb + r32, g = R >> 9, n = R & 511;
    const int colb = (kv ? C_VC : C_KC) + 64 * g;
    const bf16* w1 = W1T + (size_t)(l * 2 + kv) * 256 * 2048 + (size_t)(32 * wid + r32) * 2048 + 8 * hi;
    const bf16* arow = PROJ + colb + 8 * hi;
    f32x16 acc = {};
#pragma unroll 4
    for (int s = 0; s < 128; ++s) {
        int tok = 16 * n + (s >> 2); tok = tok > (S - 1) ? (S - 1) : tok;
        const bf16x8 av = *(const bf16x8*)(arow + (size_t)tok * PITCH + (s & 3) * 16);
        const bf16x8 bv = *(const bf16x8*)(w1 + 16 * s);
        acc = MFMA32(av, bv, acc);
    }
    LAS bf16* hid = (LAS bf16*)lds;
    const float c1 = C1[(l * 2 + kv) * 256 + 32 * wid + r32];
#pragma unroll
    for (int r = 0; r < 16; ++r) hid[crow(r, hi) * 264 + 32 * wid + r32] = f2bf16(gelu_tanh(acc[r] + c1));
    __syncthreads();
    if (wid < 2) {
        f32x16 acc2 = {};
        const bf16* w2 = W2T + (size_t)(l * 2 + kv) * 64 * 256 + (size_t)(32 * wid + r32) * 256 + 8 * hi;
#pragma unroll 4
        for (int s = 0; s < 16; ++s) {
            const bf16x8 av = *(const LAS bf16x8*)(hid + r32 * 264 + 16 * s + 8 * hi);
            const bf16x8 bv = *(const bf16x8*)(w2 + 16 * s);
            acc2 = MFMA32(av, bv, acc2);
        }
        bf16* outp = kv ? VC : KC;
#pragma unroll
        for (int r = 0; r < 16; ++r) { const int Rr = 32 * rb + crow(r, hi); outp[(size_t)((Rr >> 9) * 512 + (Rr & 511)) * 64 + 32 * wid + r32] = f2bf16(acc2[r]); }
    }
    __syncthreads();
}

__device__ __forceinline__ void cumsum_unit(int h, int l, const float* AUX, const float* fox_bf, float* CUM, LAS unsigned char* lds, int tid) {
    const float bfv = fox_bf[l * 8 + h];
    float v[16]; float run = 0.f;
#pragma unroll
    for (int i = 0; i < 16; ++i) { const int t = 16 * tid + i; const float z = AUX[(size_t)t * 64 + h] + bfv; const float lf = fminf(z, 0.f) - log1pf(__expf(-fabsf(z))); run += lf; v[i] = run; }
    LAS float* tot = (LAS float*)lds;
    tot[tid] = run; __syncthreads();
    float off = 0.f;
    for (int j = 0; j < tid; ++j) off += tot[j];
#pragma unroll
    for (int i = 0; i < 16; ++i) CUM[(size_t)h * S + 16 * tid + i] = off + v[i];
    __syncthreads();
}

__device__ __forceinline__ int koff(int key, int c) { return c * 1024 + (((key + c) & 63) << 4); }
__device__ __forceinline__ int voff(int key, int c) { return (c >> 2) * 4096 + (key >> 4) * 1024 + (key & 15) * 64 + (c & 3) * 16; }
typedef short v4i16_t __attribute__((ext_vector_type(4)));
__device__ __forceinline__ s16x4 vtr(LAS const unsigned char* p) { return __builtin_bit_cast(s16x4, __builtin_amdgcn_ds_read_tr16_b64_v4i16((LAS v4i16_t*)p)); }

template <int NDT> struct AState { float m, l; f32x16 o[NDT]; };
template <int NDT> __device__ __forceinline__ void astate_init(AState<NDT>& st) { st.m = 0.f; st.l = 0.f;
#pragma unroll
    for (int i = 0; i < NDT; ++i) st.o[i] = (f32x16){}; }

template <bool QLDS>
__device__ __forceinline__ void qk_tile(f32x16& p0, f32x16& p1, LAS const unsigned char* kt, int kchunk0, const bf16x8 (&qf)[4], LAS const unsigned char* qb, int r32, int hi) {
    bf16x8 ka[4], kb[4], q[4];
#pragma unroll
    for (int d0 = 0; d0 < 4; ++d0) {
        const int c = kchunk0 + 2 * d0 + hi;
        ka[d0] = *(const LAS bf16x8*)(kt + koff(r32, c));
        kb[d0] = *(const LAS bf16x8*)(kt + koff(r32 + 32, c));
        q[d0] = QLDS ? *(const LAS bf16x8*)(qb + d0 * 8192) : qf[d0];
    }
    __builtin_amdgcn_sched_barrier(0);
    p0 = (f32x16){}; p1 = (f32x16){};
#pragma unroll
    for (int d0 = 0; d0 < 4; ++d0) { p0 = MFMA32(ka[d0], q[d0], p0); p1 = MFMA32(kb[d0], q[d0], p1); }
    __builtin_amdgcn_sched_barrier(0);
}
__device__ __forceinline__ void pack_p(bf16x8 (&pw)[4], const f32x16& p0, const f32x16& p1) {
    u32x4 w;
    w.x = cvtpk(p0[0], p0[1]); w.y = cvtpk(p0[2], p0[3]); w.z = cvtpk(p0[4], p0[5]); w.w = cvtpk(p0[6], p0[7]); pw[0] = __builtin_bit_cast(bf16x8, w);
    w.x = cvtpk(p0[8], p0[9]); w.y = cvtpk(p0[10], p0[11]); w.z = cvtpk(p0[12], p0[13]); w.w = cvtpk(p0[14], p0[15]); pw[1] = __builtin_bit_cast(bf16x8, w);
    w.x = cvtpk(p1[0], p1[1]); w.y = cvtpk(p1[2], p1[3]); w.z = cvtpk(p1[4], p1[5]); w.w = cvtpk(p1[6], p1[7]); pw[2] = __builtin_bit_cast(bf16x8, w);
    w.x = cvtpk(p1[8], p1[9]); w.y = cvtpk(p1[10], p1[11]); w.z = cvtpk(p1[12], p1[13]); w.w = cvtpk(p1[14], p1[15]); pw[3] = __builtin_bit_cast(bf16x8, w);
}
struct VFrag { s16x4 lo[4], hh[4]; };
__device__ __forceinline__ LAS const unsigned char* vfrag_base(LAS const unsigned char* vt, int lane) { return vt + ((lane >> 4) & 1) * 32 + (lane & 3) * 8 + (4 * (lane >> 5) + ((lane & 15) >> 2)) * 64; }
__device__ __forceinline__ void vfrag_read(VFrag& f, LAS const unsigned char* vb, int dt) {
#pragma unroll
    for (int s = 0; s < 4; ++s) { f.lo[s] = vtr(vb + dt * 4096 + s * 1024); f.hh[s] = vtr(vb + dt * 4096 + s * 1024 + 512); }
}
__device__ __forceinline__ void vfrag_mma(f32x16& o, const VFrag& f, const bf16x8 (&pw)[4]) {
#pragma unroll
    for (int s = 0; s < 4; ++s) { const bf16x8 vf = (bf16x8){f.lo[s][0], f.lo[s][1], f.lo[s][2], f.lo[s][3], f.hh[s][0], f.hh[s][1], f.hh[s][2], f.hh[s][3]}; o = MFMA32(vf, pw[s], o); }
}
template <int NDT>
__device__ __forceinline__ void pv_tile_pre(f32x16 (&o)[NDT], const bf16x8 (&pw)[4], LAS const unsigned char* vb, VFrag& f0) {
    VFrag f1;
#pragma unroll
    for (int dt = 0; dt < NDT; dt += 2) {
        if (dt + 1 < NDT) vfrag_read(f1, vb, dt + 1);
        __builtin_amdgcn_sched_barrier(0);
        vfrag_mma(o[dt], f0, pw);
        if (dt + 1 < NDT) {
            if (dt + 2 < NDT) vfrag_read(f0, vb, dt + 2);
            __builtin_amdgcn_sched_barrier(0);
            vfrag_mma(o[dt + 1], f1, pw);
        }
    }
}
template <int NDT>
__device__ __forceinline__ void pv_tile(f32x16 (&o)[NDT], const bf16x8 (&pw)[4], LAS const unsigned char* vt, int lane) {
    LAS const unsigned char* vb = vfrag_base(vt, lane);
    VFrag f0; vfrag_read(f0, vb, 0);
    pv_tile_pre<NDT>(o, pw, vb, f0);
}
constexpr float SM_THR = 8.0f;
__device__ __forceinline__ float max3f(float a, float b, float c) { return __builtin_fmaxf(__builtin_fmaxf(a, b), c); }
__device__ __forceinline__ float halfmax(float m) { auto rr = __builtin_amdgcn_permlane32_swap(__float_as_uint(m), __float_as_uint(m), false, false); return fmaxf(__uint_as_float(rr[0]), __uint_as_float(rr[1])); }
__device__ __forceinline__ float halfsum(float v) { auto rr = __builtin_amdgcn_permlane32_swap(__float_as_uint(v), __float_as_uint(v), false, false); return __uint_as_float(rr[0]) + __uint_as_float(rr[1]); }
#ifndef SM_VPRE
#define SM_VPRE false
#endif
template <int NDT>
__device__ __forceinline__ void softmax_pv(AState<NDT>& st, f32x16& p0, f32x16& p1, LAS const unsigned char* vt, int lane) {
    LAS const unsigned char* vb = vfrag_base(vt, lane);
    constexpr bool VPRE = SM_VPRE;
    VFrag f0; if (VPRE) { vfrag_read(f0, vb, 0); __builtin_amdgcn_sched_barrier(0); }
    float ma = max3f(p0[0], p0[1], p0[2]), mb = max3f(p1[0], p1[1], p1[2]);
#pragma unroll
    for (int r = 3; r < 15; r += 2) { ma = max3f(ma, p0[r], p0[r + 1]); mb = max3f(mb, p1[r], p1[r + 1]); }
    float mx = max3f(ma, mb, fmaxf(p0[15], p1[15]));
    mx = halfmax(mx);
    if (__any(mx > SM_THR)) {
        const float d = fmaxf(mx, 0.f), alpha = __builtin_amdgcn_exp2f(-d); st.m += d; st.l *= alpha;
#pragma unroll
        for (int r = 0; r < 16; ++r) { p0[r] -= d; p1[r] -= d; }
#pragma unroll
        for (int dt = 0; dt < NDT; ++dt)
#pragma unroll
            for (int r = 0; r < 16; ++r) st.o[dt][r] *= alpha;
    }
    float rs = 0.f;
#pragma unroll
    for (int r = 0; r < 16; ++r) { p0[r] = __builtin_amdgcn_exp2f(p0[r]); p1[r] = __builtin_amdgcn_exp2f(p1[r]); rs += p0[r] + p1[r]; }
    st.l += rs;
    bf16x8 pw[4]; pack_p(pw, p0, p1);
    if (!VPRE) vfrag_read(f0, vb, 0);
    pv_tile_pre<NDT>(st.o, pw, vb, f0);
}
__device__ __forceinline__ void softmax_stats(float& m, float& l, const f32x16& p0, const f32x16& p1) {
    float mx = fmaxf(p0[0], p1[0]);
#pragma unroll
    for (int r = 1; r < 16; ++r) mx = fmaxf(mx, fmaxf(p0[r], p1[r]));
    mx = halfmax(mx);
    const float mn = fmaxf(m, mx), alpha = __builtin_amdgcn_exp2f(m - mn); m = mn;
    float rs = 0.f;
#pragma unroll
    for (int r = 0; r < 16; ++r) rs += __builtin_amdgcn_exp2f(p0[r] - mn) + __builtin_amdgcn_exp2f(p1[r] - mn);
    l = l * alpha + rs;
}

template <int KCH, int VCH> struct Stage { u32x4 k[KCH / 8], v[VCH / 8], x; };
template <int KCH, int VCH, bool XROW>
__device__ __forceinline__ void stage_load(Stage<KCH, VCH>& sg, const bf16* ksrc, const bf16* vsrc, const float* xsrc, size_t pitch, int key0, int tid) {
#pragma unroll
    for (int i = 0; i < KCH / 8; ++i) { const int idx = tid + 512 * i, key = idx / KCH, c = idx % KCH; sg.k[i] = *(const u32x4*)(ksrc + (size_t)(key0 + key) * pitch + 8 * c); }
#pragma unroll
    for (int i = 0; i < VCH / 8; ++i) { const int idx = tid + 512 * i, key = idx / VCH, c = idx % VCH; sg.v[i] = *(const u32x4*)(vsrc + (size_t)(key0 + key) * pitch + 8 * c); }
    if (XROW) sg.x = *(const u32x4*)(xsrc + key0 + 4 * (tid & 15));
}
template <int KCH, int VCH, bool XROW>
__device__ __forceinline__ void stage_write(const Stage<KCH, VCH>& sg, LAS unsigned char* kb, LAS unsigned char* vb, LAS unsigned char* xb, int tid) {
#pragma unroll
    for (int i = 0; i < KCH / 8; ++i) { const int idx = tid + 512 * i, key = idx / KCH, c = idx % KCH; *(LAS u32x4*)(kb + koff(key, c)) = sg.k[i]; }
#pragma unroll
    for (int i = 0; i < VCH / 8; ++i) { const int idx = tid + 512 * i, key = idx / VCH, c = idx % VCH; *(LAS u32x4*)(vb + voff(key, c)) = sg.v[i]; }
    if (XROW) { if (tid < 16) { f32x4 xv = __builtin_bit_cast(f32x4, sg.x); xv = xv * LOG2E; *(LAS f32x4*)(xb + 16 * tid) = xv; } }
}

template <int KCH, int VCH, bool XROW, int NST  , bool QLDS, class Fn>
__device__ __forceinline__ void kv_loop(Fn& fn, const bf16x8 (&qf)[4], LAS const unsigned char* qb, int kchunk0, const bf16* ksrc, const bf16* vsrc, const float* xsrc, size_t pitch, int t_lo, int t_hi,
                                        LAS unsigned char* KB, LAS unsigned char* VB, LAS unsigned char* XB, int tid, int lane) {
    constexpr int KBYTES = KCH * 1024, VBYTES = VCH * 1024;
    const int r32 = lane & 31, hi = lane >> 5, nt = t_hi - t_lo;
    if (NST == 1) {
        Stage<KCH, VCH> sg;
        stage_load<KCH, VCH, XROW>(sg, ksrc, vsrc, xsrc, pitch, 64 * t_lo, tid);
        stage_write<KCH, VCH, XROW>(sg, KB, VB, XB, tid);
        __syncthreads();
        for (int i = 0; i < nt; ++i) {
            const int b = i & 1;
            if (i + 1 < nt) stage_load<KCH, VCH, XROW>(sg, ksrc, vsrc, xsrc, pitch, 64 * (t_lo + i + 1), tid);
            if (fn.need(t_lo + i)) { f32x16 p0, p1; qk_tile<QLDS>(p0, p1, KB + b * KBYTES, kchunk0, qf, qb, r32, hi); fn.tile(t_lo + i, p0, p1, VB + b * VBYTES, XB + b * 256); }
            if (i + 1 < nt) stage_write<KCH, VCH, XROW>(sg, KB + (b ^ 1) * KBYTES, VB + (b ^ 1) * VBYTES, XB + (b ^ 1) * 256, tid);
            __syncthreads();
        }
        return;
    }
    Stage<KCH, VCH> sgA, sgB;
    stage_load<KCH, VCH, XROW>(sgA, ksrc, vsrc, xsrc, pitch, 64 * t_lo, tid);
    if (nt > 1) stage_load<KCH, VCH, XROW>(sgB, ksrc, vsrc, xsrc, pitch, 64 * (t_lo + 1), tid);
    stage_write<KCH, VCH, XROW>(sgA, KB, VB, XB, tid);
    __syncthreads();
    for (int i = 0; i < nt; i += 2) {
        if (i + 2 < nt) stage_load<KCH, VCH, XROW>(sgA, ksrc, vsrc, xsrc, pitch, 64 * (t_lo + i + 2), tid);
        if (fn.need(t_lo + i)) { f32x16 p0, p1; qk_tile<QLDS>(p0, p1, KB, kchunk0, qf, qb, r32, hi); fn.tile(t_lo + i, p0, p1, VB, XB); }
        if (i + 1 < nt) stage_write<KCH, VCH, XROW>(sgB, KB + KBYTES, VB + VBYTES, XB + 256, tid);
        __syncthreads();
        if (i + 1 >= nt) break;
        if (i + 3 < nt) stage_load<KCH, VCH, XROW>(sgB, ksrc, vsrc, xsrc, pitch, 64 * (t_lo + i + 3), tid);
        if (fn.need(t_lo + i + 1)) { f32x16 p0, p1; qk_tile<QLDS>(p0, p1, KB + KBYTES, kchunk0, qf, qb, r32, hi); fn.tile(t_lo + i + 1, p0, p1, VB + VBYTES, XB + 256); }
        if (i + 2 < nt) stage_write<KCH, VCH, XROW>(sgA, KB, VB, XB, tid);
        __syncthreads();
    }
}

#define SGB(mask, n) __builtin_amdgcn_sched_group_barrier(mask, n, 0)
template <int NDT>
__device__ __forceinline__ void sp_finish(AState<NDT>& st, f32x16& s0, f32x16& s1, bf16x8 (&pw)[4]) {
    float rs = 0.f;
#pragma unroll
    for (int r = 0; r < 16; ++r) { s0[r] = __builtin_amdgcn_exp2f(s0[r]); s1[r] = __builtin_amdgcn_exp2f(s1[r]); rs += s0[r] + s1[r]; }
    st.l += rs;
    pack_p(pw, s0, s1);
}
__device__ __forceinline__ float sp_rowmax(const f32x16& p0, const f32x16& p1) {
    float ma = max3f(p0[0], p0[1], p0[2]), mb = max3f(p1[0], p1[1], p1[2]);
#pragma unroll
    for (int r = 3; r < 15; r += 2) { ma = max3f(ma, p0[r], p0[r + 1]); mb = max3f(mb, p1[r], p1[r + 1]); }
    return max3f(ma, mb, fmaxf(p0[15], p1[15]));
}
template <int NDT>
__device__ __forceinline__ void sp_raise(AState<NDT>& st, f32x16& p0, f32x16& p1, float mx) {
    mx = halfmax(mx);
    if (__any(mx > SM_THR)) {
        const float d = fmaxf(mx, 0.f), alpha = __builtin_amdgcn_exp2f(-d); st.m += d; st.l *= alpha;
#pragma unroll
        for (int r = 0; r < 16; ++r) { p0[r] -= d; p1[r] -= d; }
#pragma unroll
        for (int dt = 0; dt < NDT; ++dt)
#pragma unroll
            for (int r = 0; r < 16; ++r) st.o[dt][r] *= alpha;
    }
}
__device__ __forceinline__ void sp_finish_part(int j, float& rs, f32x16& s0, f32x16& s1, u32x4 (&pu)[4]) {
#pragma unroll
    for (int r = 4 * j; r < 4 * j + 4; ++r) { s0[r] = __builtin_amdgcn_exp2f(s0[r]); s1[r] = __builtin_amdgcn_exp2f(s1[r]); rs += s0[r] + s1[r]; }
    const unsigned a0 = cvtpk(s0[4 * j], s0[4 * j + 1]), a1 = cvtpk(s0[4 * j + 2], s0[4 * j + 3]), b0 = cvtpk(s1[4 * j], s1[4 * j + 1]), b1 = cvtpk(s1[4 * j + 2], s1[4 * j + 3]);
    if (j & 1) { pu[j >> 1].z = a0; pu[j >> 1].w = a1; pu[2 + (j >> 1)].z = b0; pu[2 + (j >> 1)].w = b1; }
    else       { pu[j >> 1].x = a0; pu[j >> 1].y = a1; pu[2 + (j >> 1)].x = b0; pu[2 + (j >> 1)].y = b1; }
}
#define SP_STEADY(T, KBUF, XBUF, SP0, SP1, SN0, SN1)                                                                                                    \
    {   bf16x8 ka[4], kb[4], q[4];                                                                                                                      \
        _Pragma("unroll") for (int d0 = 0; d0 < 4; ++d0) { const int c = kchunk0 + 2 * d0 + hi;                                                         \
            ka[d0] = *(const LAS bf16x8*)((KBUF) + koff(r32, c)); kb[d0] = *(const LAS bf16x8*)((KBUF) + koff(r32 + 32, c));                             \
            q[d0] = QLDS ? *(const LAS bf16x8*)(qb + d0 * 8192) : qf[d0]; }                                                                             \
        LAS const unsigned char* vb = vfrag_base(VB + vp * VBYTES, lane);                                                                               \
        VFrag f0, f1; u32x4 pu[4]; float rs = 0.f;                                                                                                      \
        __builtin_amdgcn_sched_barrier(0);                                                                                                              \
        SN0 = (f32x16){}; SN1 = (f32x16){};                                                                                                             \
        _Pragma("unroll") for (int j = 0; j < 4; ++j) {                                                                                                 \
            SN0 = MFMA32(ka[j], q[j], SN0); SN1 = MFMA32(kb[j], q[j], SN1);                                                                             \
            sp_finish_part(j, rs, SP0, SP1, pu);                                                                                                        \
            if (NDT == 2 && j == 2) vfrag_read(f0, vb, 0);                                                                                              \
            if (NDT == 2 && j == 3) vfrag_read(f1, vb, 1);                                                                                              \
            __builtin_amdgcn_sched_barrier(0);                                                                                                          \
        }                                                                                                                                               \
        fn.st.l += rs;                                                                                                                                  \
        _Pragma("unroll") for (int k = 0; k < 4; ++k) pw[k] = __builtin_bit_cast(bf16x8, pu[k]);                                                        \
        float mx = NEG;                                                                                                                                 \
        _Pragma("unroll") for (int dt = 0; dt < NDT; dt += 2) {                                                                                         \
            if (NDT != 2) { vfrag_read(f0, vb, dt); vfrag_read(f1, vb, dt + 1); __builtin_amdgcn_sched_barrier(0); }                                    \
            _Pragma("unroll") for (int sx = 0; sx < 4; ++sx) {                                                                                          \
                { const bf16x8 vf = (bf16x8){f0.lo[sx][0], f0.lo[sx][1], f0.lo[sx][2], f0.lo[sx][3], f0.hh[sx][0], f0.hh[sx][1], f0.hh[sx][2], f0.hh[sx][3]}; fn.st.o[dt] = MFMA32(vf, pw[sx], fn.st.o[dt]); } \
                { const bf16x8 vf = (bf16x8){f1.lo[sx][0], f1.lo[sx][1], f1.lo[sx][2], f1.lo[sx][3], f1.hh[sx][0], f1.hh[sx][1], f1.hh[sx][2], f1.hh[sx][3]}; fn.st.o[dt + 1] = MFMA32(vf, pw[sx], fn.st.o[dt + 1]); } \
                if (dt == 0) { fn.score_part(sx, T, SN0, SN1, XBUF); mx = fn.max_part(sx, mx, SN0, SN1); }                                              \
                __builtin_amdgcn_sched_barrier(0);                                                                                                      \
            }                                                                                                                                           \
        }                                                                                                                                               \
        mx = fn.score_mask(T, mx, SN0, SN1);                                                                                                            \
        sp_raise<NDT>(fn.st, SN0, SN1, mx); }
template <int KCH, int VCH, bool XROW, bool QLDS, int NDT, class Fn>
__device__ __forceinline__ void kv_loop_sp(Fn& fn, const bf16x8 (&qf)[4], LAS const unsigned char* qb, int kchunk0, const bf16* ksrc, const bf16* vsrc, const float* xsrc, size_t pitch, int t_lo, int t_hi, int nw,
                                           LAS unsigned char* KB, LAS unsigned char* VB, LAS unsigned char* XB, int tid, int lane) {
    constexpr int KBYTES = KCH * 1024, VBYTES = VCH * 1024;
    const int r32 = lane & 31, hi = lane >> 5, nt = t_hi - t_lo;
    Stage<KCH, VCH> sg;
    stage_load<KCH, VCH, XROW>(sg, ksrc, vsrc, xsrc, pitch, 64 * t_lo, tid);
    stage_write<KCH, VCH, XROW>(sg, KB, VB, XB, tid);
    __syncthreads();
    f32x16 sa0, sa1, sb0, sb1; bf16x8 pw[4];
    int vc = 0, vp = 2, vn, i = 0;
#define SP_PRE(I)  if ((I) + 1 < nt) stage_load<KCH, VCH, XROW>(sg, ksrc, vsrc, xsrc, pitch, 64 * (t_lo + (I) + 1), tid);
#define SP_POST(I, KOFFN, XOFFN) vn = vc == 2 ? 0 : vc + 1; if ((I) + 1 < nt) stage_write<KCH, VCH, XROW>(sg, KB + (KOFFN), VB + vn * VBYTES, XB + (XOFFN), tid); __syncthreads(); vp = vc; vc = vn;
    SP_PRE(0)
    qk_tile<QLDS>(sa0, sa1, KB, kchunk0, qf, qb, r32, hi); fn.score(t_lo, sa0, sa1, XB); sp_raise<NDT>(fn.st, sa0, sa1, sp_rowmax(sa0, sa1));
    SP_POST(0, KBYTES, 256)
    i = 1;
    while (i + 1 < nw) {
        SP_PRE(i)
        SP_STEADY(t_lo + i, KB + KBYTES, XB + 256, sa0, sa1, sb0, sb1)
        SP_POST(i, 0, 0)
        SP_PRE(i + 1)
        SP_STEADY(t_lo + i + 1, KB, XB, sb0, sb1, sa0, sa1)
        SP_POST(i + 1, KBYTES, 256)
        i += 2;
    }
    if (i < nw) {
        SP_PRE(i)
        SP_STEADY(t_lo + i, KB + KBYTES, XB + 256, sa0, sa1, sb0, sb1)
        SP_POST(i, 0, 0)
        sa0 = sb0; sa1 = sb1; ++i;
    }
    if (i < nt) { SP_PRE(i) }
    sp_finish<NDT>(fn.st, sa0, sa1, pw); pv_tile<NDT>(fn.st.o, pw, VB + vp * VBYTES, lane);
    if (i < nt) { const int ko = (i & 1) ? 0 : KBYTES, xo = (i & 1) ? 0 : 256; SP_POST(i, ko, xo) ++i; }
    while (i < nt) { const int ko = (i & 1) ? 0 : KBYTES, xo = (i & 1) ? 0 : 256; SP_PRE(i) SP_POST(i, ko, xo) ++i; }
    __syncthreads();
#undef SP_PRE
#undef SP_POST
}

struct FoxFn {
    AState<2> st; float cq; int tq, tmin, tmax, lane;
    __device__ __forceinline__ bool need(int t) const { return 64 * t <= tmax; }
    __device__ __forceinline__ void score_part(int a, int t, f32x16& p0, f32x16& p1, LAS const unsigned char* xrow) {
        const int hi = lane >> 5; LAS const float* ck = (LAS const float*)xrow;
        const float cqm = cq - st.m;
        const f32x4 c0 = *(LAS const f32x4*)(ck + 8 * a + 4 * hi), c1 = *(LAS const f32x4*)(ck + 32 + 8 * a + 4 * hi);
#pragma unroll
        for (int i = 0; i < 4; ++i) { const int r = 4 * a + i; p0[r] = p0[r] * SCL2 + (cqm - c0[i]); p1[r] = p1[r] * SCL2 + (cqm - c1[i]); }
    }
    __device__ __forceinline__ float max_part(int a, float mx, const f32x16& p0, const f32x16& p1) const {
        return max3f(max3f(mx, p0[4 * a], p0[4 * a + 1]), max3f(p0[4 * a + 2], p0[4 * a + 3], p1[4 * a]), max3f(p1[4 * a + 1], p1[4 * a + 2], p1[4 * a + 3])); }
    __device__ __forceinline__ float score_mask(int t, float mx, f32x16& p0, f32x16& p1) const {
        const int hi = lane >> 5, k0 = 64 * t;
        if (k0 + 63 > tmin) {
#pragma unroll
            for (int r = 0; r < 16; ++r) { const int key = k0 + crow(r, hi); p0[r] = key <= tq ? p0[r] : NEG; p1[r] = key + 32 <= tq ? p1[r] : NEG; }
            mx = sp_rowmax(p0, p1);
        }
        return mx;
    }
    __device__ __forceinline__ void score(int t, f32x16& p0, f32x16& p1, LAS const unsigned char* xrow) {
#pragma unroll
        for (int a = 0; a < 4; ++a) score_part(a, t, p0, p1, xrow);
        score_mask(t, 0.f, p0, p1);
    }
};
__device__ __forceinline__ void fox_unit(int h, int qb, const bf16* PROJ, const float* CUM, bf16* MIX, LAS unsigned char* lds, int tid, int wid, int lane) {
    const int r32 = lane & 31, hi = lane >> 5, q0 = 256 * qb, tq = q0 + 32 * wid + r32;
    bf16x8 qf[4];
#pragma unroll
    for (int d0 = 0; d0 < 4; ++d0) qf[d0] = *(const bf16x8*)(PROJ + (size_t)tq * PITCH + C_BQ + 64 * h + 16 * d0 + 8 * hi);
    const float* cum = CUM + (size_t)h * S;
    FoxFn fn; astate_init<2>(fn.st); fn.cq = cum[tq] * LOG2E; fn.tq = tq; fn.tmin = q0 + 32 * wid; fn.tmax = q0 + 32 * wid + 31; fn.lane = lane;
    kv_loop_sp<8, 8, true, false, 2>(fn, qf, lds, 0, PROJ + C_BK + 64 * h, PROJ + C_BV + 64 * h, cum, PITCH, 0, 4 * (qb + 1), min(4 * (qb + 1), (fn.tmax >> 6) + 1), lds, lds + 16384, lds + 40960, tid, lane);
    const float lt = fn.st.l + __shfl_xor(fn.st.l, 32), inv = 1.0f / lt;
    bf16* orow = MIX + (size_t)tq * D + 512 + 64 * h;
#pragma unroll
    for (int dt = 0; dt < 2; ++dt)
#pragma unroll
        for (int a = 0; a < 4; ++a) { u32x2 w; w.x = cvtpk(fn.st.o[dt][4 * a] * inv, fn.st.o[dt][4 * a + 1] * inv); w.y = cvtpk(fn.st.o[dt][4 * a + 2] * inv, fn.st.o[dt][4 * a + 3] * inv);
            *(u32x2*)(orow + 32 * dt + 8 * a + 4 * hi) = w; }
}

struct DiffFn {
    AState<4> st; LAS const float* lut; int tq, tmin, tmax, lane;
    __device__ __forceinline__ bool need(int t) const { return 64 * t <= tmax; }
    __device__ __forceinline__ void tile(int t, f32x16& p0, f32x16& p1, LAS const unsigned char* vt, LAS const unsigned char*) {
        const int hi = lane >> 5, k0 = 64 * t;
        const float mref = st.m;
        if (k0 + 63 + 127 <= tmin) {
            const float b = lut[127] - mref;
#pragma unroll
            for (int r = 0; r < 16; ++r) { p0[r] = p0[r] * SCL2 + b; p1[r] = p1[r] * SCL2 + b; }
        } else {
#pragma unroll
            for (int r = 0; r < 16; ++r) { const int rel0 = tq - (k0 + crow(r, hi)); const float b0 = lut[min(max(rel0, 0), 127)] - mref; p0[r] = rel0 >= 0 ? p0[r] * SCL2 + b0 : NEG; }
            __builtin_amdgcn_sched_barrier(0);
#pragma unroll
            for (int r = 0; r < 16; ++r) { const int rel1 = tq - (k0 + 32 + crow(r, hi)); const float b1 = lut[min(max(rel1, 0), 127)] - mref; p1[r] = rel1 >= 0 ? p1[r] * SCL2 + b1 : NEG; }
            __builtin_amdgcn_sched_barrier(0);
        }
        softmax_pv<4>(st, p0, p1, vt, lane);
    }
};
__device__ __forceinline__ void diff_unit(int h, int qb, int l, const Args& a, const bf16* PROJ, bf16* MIX, LAS unsigned char* lds, int tid, int wid, int lane) {
    const int r32 = lane & 31, hi = lane >> 5, q0 = 128 * qb, map = wid & 1, qs = wid >> 1, tq = q0 + 32 * qs + r32;
    LAS float* lut = (LAS float*)(lds + 65536); LAS float* lamw = (LAS float*)(lds + 65536 + 512);
    const float lam_init = 0.8f - 0.6f * expf(-0.3f * (float)l);
    if (tid < 128) lut[tid] = a.in[12][t5_bucket(tid) * 20 + h] * LOG2E;
    if (wid == 0) { const float* dl = a.in[3] + (size_t)l * 256;
        const float s1 = wave_sum(dl[lane] * dl[64 + lane]), s2 = wave_sum(dl[128 + lane] * dl[192 + lane]);
        if (lane == 0) lamw[0] = expf(s1) - expf(s2) + lam_init; }
    bf16x8 qf[4];
#pragma unroll
    for (int d0 = 0; d0 < 4; ++d0) qf[d0] = *(const bf16x8*)(PROJ + (size_t)tq * PITCH + C_AQ + 128 * h + 64 * map + 16 * d0 + 8 * hi);
    DiffFn fn; astate_init<4>(fn.st); fn.lut = lut; fn.tq = tq; fn.tmin = q0 + 32 * qs; fn.tmax = q0 + 32 * qs + 31; fn.lane = lane;
    LAS unsigned char* const qlds = lds + 67584 + tid * 16;
#pragma unroll
    for (int d0 = 0; d0 < 4; ++d0) *(LAS bf16x8*)(qlds + d0 * 8192) = qf[d0];
    kv_loop<16, 16, false, 1, true>(fn, qf, qlds, 8 * map, PROJ + C_AK + 128 * h, PROJ + C_AV + 128 * h, nullptr, PITCH, 0, 2 * (qb + 1), lds, lds + 32768, lds, tid, lane);
    const float lt = fn.st.l + __shfl_xor(fn.st.l, 32), inv = 1.0f / lt;
    LAS float* ex = (LAS float*)(lds + qs * 16384);
    if (map == 1) {
#pragma unroll
        for (int dt = 0; dt < 4; ++dt)
#pragma unroll
            for (int r = 0; r < 16; ++r) ex[(32 * dt + crow(r, hi)) * 32 + r32] = fn.st.o[dt][r] * inv;
    }
    __syncthreads();
    if (map == 0) {
        const float lam = lamw[0]; float ss = 0.f;
#pragma unroll
        for (int dt = 0; dt < 4; ++dt)
#pragma unroll
            for (int r = 0; r < 16; ++r) { const float v = fn.st.o[dt][r] * inv - lam * ex[(32 * dt + crow(r, hi)) * 32 + r32]; fn.st.o[dt][r] = v; ss += v * v; }
        ss += __shfl_xor(ss, 32);
        const float rstd = (1.0f / sqrtf(ss * (1.0f / 128.0f) + RMS_EPS)) * (1.0f - lam_init);
        const float* sub = a.in[4] + (size_t)l * 128; bf16* orow = MIX + (size_t)tq * D + 128 * h;
#pragma unroll
        for (int dt = 0; dt < 4; ++dt)
#pragma unroll
            for (int q4 = 0; q4 < 4; ++q4) { const int d = 32 * dt + 8 * q4 + 4 * hi; const f32x4 g = *(const f32x4*)(sub + d);
                u32x2 w; w.x = cvtpk(fn.st.o[dt][4 * q4] * rstd * g.x, fn.st.o[dt][4 * q4 + 1] * rstd * g.y); w.y = cvtpk(fn.st.o[dt][4 * q4 + 2] * rstd * g.z, fn.st.o[dt][4 * q4 + 3] * rstd * g.w);
                *(u32x2*)(orow + d) = w; }
    }
    __syncthreads();
}

#ifndef NSA_DUP
#define NSA_DUP 0
#endif
constexpr int IMP_P = 132;
__device__ __forceinline__ float quad_sum(float v) {
    v += __builtin_bit_cast(float, __builtin_amdgcn_mov_dpp(__builtin_bit_cast(int, v), 0xB1, 0xF, 0xF, true));
    v += __builtin_bit_cast(float, __builtin_amdgcn_mov_dpp(__builtin_bit_cast(int, v), 0x4E, 0xF, 0xF, true));
    return v; }
#define LADD(p, v) (void)__hip_atomic_fetch_add((p), (v), __ATOMIC_RELAXED, __HIP_MEMORY_SCOPE_WORKGROUP)
constexpr int NSA_QF = 32768, NSA_SELW = 65536, NSA_LUT = 66560, NSA_IMP = 69632, NSA_FIN = 69632;

struct CmpStatFn {
    float m, l; int tq, lane, ncnt;
    __device__ __forceinline__ bool need(int) const { return true; }
    __device__ __forceinline__ void tile(int t, f32x16& p0, f32x16& p1, LAS const unsigned char*, LAS const unsigned char*) {
        const int hi = lane >> 5, n0 = 64 * t;
#pragma unroll
        for (int r = 0; r < 16; ++r) { const int n = n0 + crow(r, hi);
            p0[r] = (16 * n + 31 <= tq) ? p0[r] * SCL2 : NEG; p1[r] = (16 * (n + 32) + 31 <= tq) ? p1[r] * SCL2 : NEG; }
        softmax_stats(m, l, p0, p1);
    }
};
struct CmpPvFn {
    f32x16 o[2]; float m, invl; int tq, ql, lane; LAS float* imp;
    __device__ __forceinline__ bool need(int) const { return true; }
    __device__ __forceinline__ void tile(int t, f32x16& p0, f32x16& p1, LAS const unsigned char* vt, LAS const unsigned char*) {
        const int hi = lane >> 5, n0 = 64 * t;
#pragma unroll
        for (int r = 0; r < 16; ++r) { const int n = n0 + crow(r, hi);
            p0[r] = (16 * n + 31 <= tq) ? __builtin_amdgcn_exp2f(p0[r] * SCL2 - m) * invl : 0.f;
            p1[r] = (16 * (n + 32) + 31 <= tq) ? __builtin_amdgcn_exp2f(p1[r] * SCL2 - m) * invl : 0.f; }
        LAS float* row = imp + ql * IMP_P;
        const bool lead = (lane & 3) == 0;
#pragma unroll
        for (int a = 0; a < 4; ++a) {
            const int j0 = (n0 >> 2) + 2 * a + hi, j1 = j0 + 8;
            const float h0 = quad_sum(0.5f * p0[4 * a + 3]), h1 = quad_sum(0.5f * p1[4 * a + 3]);
            const float b0 = quad_sum(p0[4 * a] + p0[4 * a + 1] + p0[4 * a + 2]) + h0, b1 = quad_sum(p1[4 * a] + p1[4 * a + 1] + p1[4 * a + 2]) + h1;
            if (lead) {
                LADD(row + j0, b0);
                if (j0 + 1 < 128) LADD(row + j0 + 1, h0);
                if (j1 < 128) LADD(row + j1, b1);
                if (j1 + 1 < 128) LADD(row + j1 + 1, h1);
            }
        }
        bf16x8 pw[4]; pack_p(pw, p0, p1);
        pv_tile<2>(o, pw, vt, lane);
    }
};
struct SelFn {
    AState<2> st; LAS const float* lut; int tq, tmin, tmax, lane, mode; unsigned sw0, sw1, sw2, sw3, uw0, uw1, uw2, uw3;
    __device__ __forceinline__ unsigned pick(int j, unsigned a, unsigned b, unsigned c, unsigned d) const { const int w = j >> 5; const unsigned x = (w == 0) ? a : (w == 1) ? b : (w == 2) ? c : d; return (x >> (j & 31)) & 1u; }
    __device__ __forceinline__ bool need(int t) const { return mode == 1 || pick(t, uw0, uw1, uw2, uw3) != 0u; }
    __device__ __forceinline__ void tile(int t, f32x16& p0, f32x16& p1, LAS const unsigned char* vt, LAS const unsigned char*) {
        const int hi = lane >> 5, k0 = 64 * t;
        const bool bit = (mode == 1) || pick(t, sw0, sw1, sw2, sw3) != 0u;
        const bool far = k0 + 63 + 127 <= tmin;
        const bool wcut = (mode == 1) && (tmax - k0 >= 512);
        const float mref = st.m;
        if (far && !wcut) {
            const float b = lut[127] - mref;
#pragma unroll
            for (int r = 0; r < 16; ++r) { p0[r] = bit ? p0[r] * SCL2 + b : NEG; p1[r] = bit ? p1[r] * SCL2 + b : NEG; }
        } else {
#pragma unroll
            for (int r = 0; r < 16; ++r) { const int rel0 = tq - (k0 + crow(r, hi));
                const float b0 = lut[min(max(rel0, 0), 127)] - mref;
                const bool ok0 = bit && rel0 >= 0 && (mode == 0 || rel0 < 512);
                p0[r] = ok0 ? p0[r] * SCL2 + b0 : NEG; }
            __builtin_amdgcn_sched_barrier(0);
#pragma unroll
            for (int r = 0; r < 16; ++r) { const int rel1 = tq - (k0 + 32 + crow(r, hi));
                const float b1 = lut[min(max(rel1, 0), 127)] - mref;
                const bool ok1 = bit && rel1 >= 0 && (mode == 0 || rel1 < 512);
                p1[r] = ok1 ? p1[r] * SCL2 + b1 : NEG; }
            __builtin_amdgcn_sched_barrier(0);
        }
        softmax_pv<2>(st, p0, p1, vt, lane);
    }
};

__device__ __forceinline__ void nsa_unit(int g, int qb, const Args& a, const bf16* PROJ, const float* AUX, const bf16* KC, const bf16* VC, bf16* MIX, LAS unsigned char* lds, int tid, int wid, int lane) {
    const int r32 = lane & 31, hi = lane >> 5, q0 = 64 * qb, cur = qb, ql = 8 * wid + (r32 >> 2), hp = r32 & 3, tq = q0 + ql, head = 4 * g + hp;
    LAS float* imp = (LAS float*)(lds + NSA_IMP); LAS unsigned* selw = (LAS unsigned*)(lds + NSA_SELW); LAS float* lut = (LAS float*)(lds + NSA_LUT);
#pragma unroll
    for (int i = 0; i < 17; ++i) { const int e_ = tid + 512 * i; if (e_ < 64 * IMP_P) imp[e_] = 0.f; }
    if (tid < 256) selw[tid] = 0u;
    lut[tid] = a.in[12][t5_bucket(tid & 127) * 20 + 4 + 4 * g + (tid >> 7)] * LOG2E;
    bf16x8 qf[4];
#pragma unroll
    for (int d0 = 0; d0 < 4; ++d0) qf[d0] = *(const bf16x8*)(PROJ + (size_t)tq * PITCH + C_CQ + 64 * head + 16 * d0 + 8 * hi);
    LAS unsigned char* const qlds = lds + NSA_QF + tid * 16;
#pragma unroll
    for (int d0 = 0; d0 < 4; ++d0) *(LAS bf16x8*)(qlds + d0 * 8192) = qf[d0];
    const float* ga = AUX + (size_t)tq * 64 + 8 + head;
    const float gc = 1.0f / (1.0f + __expf(-ga[0])), gs = 1.0f / (1.0f + __expf(-ga[16])), gwn = 1.0f / (1.0f + __expf(-ga[32]));
    LAS float* finl = (LAS float*)(lds + NSA_FIN) + tid;
    f32x16 oc0, oc1;
    {
        int ncnt = (q0 + 32) / 16 + 1; ncnt = ncnt > 511 ? 511 : ncnt; const int ntc = (ncnt + 63) >> 6;
        const bf16* kc = KC + (size_t)g * 512 * 64; const bf16* vc = VC + (size_t)g * 512 * 64;
        CmpStatFn f1; f1.m = NEG; f1.l = 0.f; f1.tq = tq; f1.lane = lane; f1.ncnt = ncnt;
        kv_loop<8, 8, false, 1, true>(f1, qf, qlds, 0, kc, vc, nullptr, 64, 0, ntc, lds, lds + 16384, lds, tid, lane);
        if (NSA_DUP & 1) { f1.m = NEG; f1.l = 0.f; kv_loop<8, 8, false, 1, true>(f1, qf, qlds, 0, kc, vc, nullptr, 64, 0, ntc, lds, lds + 16384, lds, tid, lane); }
        const float lt = f1.l + __shfl_xor(f1.l, 32);
        CmpPvFn f2; f2.o[0] = (f32x16){}; f2.o[1] = (f32x16){}; f2.m = f1.m; f2.invl = (tq >= 31) ? 1.0f / lt : 0.f; f2.tq = tq; f2.ql = ql; f2.lane = lane; f2.imp = imp;
        if (NSA_DUP & 16) { kv_loop<8, 8, false, 1, true>(f2, qf, qlds, 0, kc, vc, nullptr, 64, 0, ntc, lds, lds + 16384, lds, tid, lane); f2.o[0] = (f32x16){}; f2.o[1] = (f32x16){};
#pragma unroll
            for (int i = 0; i < 17; ++i) { const int e_ = tid + 512 * i; if (e_ < 64 * IMP_P) imp[e_] = 0.f; }
            __syncthreads(); }
        kv_loop<8, 8, false, 1, true>(f2, qf, qlds, 0, kc, vc, nullptr, 64, 0, ntc, lds, lds + 16384, lds, tid, lane);
        oc0 = f2.o[0]; oc1 = f2.o[1];
    }
    for (int rep_ = 0; rep_ < ((NSA_DUP & 2) ? 2 : 1); ++rep_)
    if (cur < 16) { if (tid < 64) selw[tid * 4] = (2u << cur) - 1u; }
    else {
        const int qq = tid >> 3, sub = tid & 7;
        float val[16];
#pragma unroll
        for (int i = 0; i < 16; ++i) { const int j = 16 * sub + i; val[i] = (j >= 1 && j <= cur - 2) ? imp[qq * IMP_P + j] : -1.0f; }
        unsigned bits = 0u;
        for (int round = 0; round < 13; ++round) {
            float bv = val[0]; int bi = 0;
#pragma unroll
            for (int i = 1; i < 16; ++i) if (val[i] > bv) { bv = val[i]; bi = i; }
            int gj = 16 * sub + bi;
            { const float ov = __builtin_bit_cast(float, __builtin_amdgcn_mov_dpp(__builtin_bit_cast(int, bv), 0xB1, 0xF, 0xF, true)); const int oj = __builtin_amdgcn_mov_dpp(gj, 0xB1, 0xF, 0xF, true); if (ov > bv || (ov == bv && oj < gj)) { bv = ov; gj = oj; } }
            { const float ov = __builtin_bit_cast(float, __builtin_amdgcn_mov_dpp(__builtin_bit_cast(int, bv), 0x4E, 0xF, 0xF, true)); const int oj = __builtin_amdgcn_mov_dpp(gj, 0x4E, 0xF, 0xF, true); if (ov > bv || (ov == bv && oj < gj)) { bv = ov; gj = oj; } }
            { const float ov = __shfl_xor(bv, 4); const int oj = __shfl_xor(gj, 4); if (ov > bv || (ov == bv && oj < gj)) { bv = ov; gj = oj; } }
            const bool mine = (gj >> 4) == sub;
#pragma unroll
            for (int i = 0; i < 16; ++i) if (mine && (gj & 15) == i) { val[i] = -2.0f; bits |= 1u << i; }
        }
        if (sub == 0) bits |= 1u;
        if (((cur - 1) >> 4) == sub) bits |= 1u << ((cur - 1) & 15);
        if ((cur >> 4) == sub) bits |= 1u << (cur & 15);
        (void)__hip_atomic_fetch_or(selw + qq * 4 + (sub >> 1), bits << (16 * (sub & 1)), __ATOMIC_RELAXED, __HIP_MEMORY_SCOPE_WORKGROUP);
    }
    __syncthreads();
#pragma unroll
    for (int r = 0; r < 16; ++r) { finl[512 * r] = gc * oc0[r]; finl[512 * (16 + r)] = gc * oc1[r]; }
    SelFn fs; fs.lut = lut + hp * 128; fs.tq = tq; fs.tmin = q0 + 8 * wid; fs.tmax = q0 + 8 * wid + 7; fs.lane = lane;
    fs.sw0 = selw[ql * 4 + 0]; fs.sw1 = selw[ql * 4 + 1]; fs.sw2 = selw[ql * 4 + 2]; fs.sw3 = selw[ql * 4 + 3];
    { unsigned u0 = 0u, u1 = 0u, u2 = 0u, u3 = 0u;
#pragma unroll
      for (int i = 0; i < 8; ++i) { u0 |= selw[(8 * wid + i) * 4 + 0]; u1 |= selw[(8 * wid + i) * 4 + 1]; u2 |= selw[(8 * wid + i) * 4 + 2]; u3 |= selw[(8 * wid + i) * 4 + 3]; }
      fs.uw0 = __builtin_amdgcn_readfirstlane(u0); fs.uw1 = __builtin_amdgcn_readfirstlane(u1); fs.uw2 = __builtin_amdgcn_readfirstlane(u2); fs.uw3 = __builtin_amdgcn_readfirstlane(u3); }
    fs.mode = 0; astate_init<2>(fs.st);
    kv_loop<8, 8, false, 1, false>(fs, qf, qlds, 0, PROJ + C_KS + 64 * g, PROJ + C_VS + 64 * g, nullptr, PITCH, 0, cur + 1, lds, lds + 16384, lds, tid, lane);
    if (NSA_DUP & 4) { astate_init<2>(fs.st); kv_loop<8, 8, false, 1, false>(fs, qf, qlds, 0, PROJ + C_KS + 64 * g, PROJ + C_VS + 64 * g, nullptr, PITCH, 0, cur + 1, lds, lds + 16384, lds, tid, lane); }
    { const float lt = fs.st.l + __shfl_xor(fs.st.l, 32), sc = gs / lt;
#pragma unroll
      for (int r = 0; r < 16; ++r) { finl[512 * r] += sc * fs.st.o[0][r]; finl[512 * (16 + r)] += sc * fs.st.o[1][r]; } }
    fs.mode = 1; astate_init<2>(fs.st);
    kv_loop<8, 8, false, 1, false>(fs, qf, qlds, 0, PROJ + C_KW + 64 * g, PROJ + C_VW + 64 * g, nullptr, PITCH, cur >= 8 ? cur - 8 : 0, cur + 1, lds, lds + 16384, lds, tid, lane);
    if (NSA_DUP & 8) { astate_init<2>(fs.st); kv_loop<8, 8, false, 1, false>(fs, qf, qlds, 0, PROJ + C_KW + 64 * g, PROJ + C_VW + 64 * g, nullptr, PITCH, cur >= 8 ? cur - 8 : 0, cur + 1, lds, lds + 16384, lds, tid, lane); }
    { const float lt = fs.st.l + __shfl_xor(fs.st.l, 32), sc = gwn / lt;
#pragma unroll
      for (int r = 0; r < 16; ++r) { fs.st.o[0][r] = finl[512 * r] + sc * fs.st.o[0][r]; fs.st.o[1][r] = finl[512 * (16 + r)] + sc * fs.st.o[1][r]; } }
    bf16* orow = MIX + (size_t)tq * D + 1024 + 64 * head;
#pragma unroll
    for (int dt = 0; dt < 2; ++dt)
#pragma unroll
        for (int q4 = 0; q4 < 4; ++q4) { u32x2 w; w.x = cvtpk(fs.st.o[dt][4 * q4], fs.st.o[dt][4 * q4 + 1]); w.y = cvtpk(fs.st.o[dt][4 * q4 + 2], fs.st.o[dt][4 * q4 + 3]); *(u32x2*)(orow + 32 * dt + 8 * q4 + 4 * hi) = w; }
}

__device__ __forceinline__ int dequeue(unsigned* head, volatile LAS unsigned* slot, int tid) {
    if (tid == 0) *slot = __hip_atomic_fetch_add(head, 1u, __ATOMIC_RELAXED, __HIP_MEMORY_SCOPE_AGENT);
    __syncthreads();
    const int v = __builtin_amdgcn_readfirstlane((int)*slot);
    __syncthreads();
    return v;
}

constexpr int N2_HP = 4112, N2_PART = 66 * 1024, N2_LOG = 108 * 1024;
__device__ __forceinline__ void n2_unit(int u, int l, const Args& a, const bf16* X, bf16* XN, const bf16* RWT, unsigned* cnt, int* LIST, float* TW, LAS unsigned char* lds, int tid, int wid, int lane) {
    const float* gain = a.in[14] + (size_t)l * D;
#pragma unroll
    for (int rr = 0; rr < 2; ++rr) {
        const int lr = 2 * wid + rr, row = 16 * u + lr;
        const u32x2* xr = (const u32x2*)(X + (size_t)row * D) + lane;
        f32x4 v[8]; float ss = 0.f;
#pragma unroll
        for (int j = 0; j < 8; ++j) { const u32x2 r = xr[64 * j]; v[j] = (f32x4){bflo(r.x), bfhi(r.x), bflo(r.y), bfhi(r.y)}; ss += (v[j].x * v[j].x + v[j].y * v[j].y) + (v[j].z * v[j].z + v[j].w * v[j].w); }
        ss = wave_sum(ss);
        const float rstd = 1.0f / sqrtf(ss * (1.0f / D) + RMS_EPS);
        const f32x4* gr = (const f32x4*)gain + lane; u32x2* o8 = (u32x2*)(XN + (size_t)row * D) + lane;
#pragma unroll
        for (int j = 0; j < 8; ++j) { const f32x4 g = gr[64 * j]; u32x2 w; w.x = cvtpk(v[j].x * rstd * g.x, v[j].y * rstd * g.y); w.y = cvtpk(v[j].z * rstd * g.z, v[j].w * rstd * g.w);
            o8[64 * j] = w; *(LAS u32x2*)(lds + lr * N2_HP + (4 * lane + 256 * j) * 2) = w; }
    }
    __syncthreads();
    {
        const int fr = lane & 15, fq = lane >> 4;
        f32x4 acc[5];
#pragma unroll
        for (int nt = 0; nt < 5; ++nt) acc[nt] = (f32x4){0.f, 0.f, 0.f, 0.f};
        const bf16* rw = RWT + (size_t)l * 96 * D + (size_t)fr * D + 256 * wid + 8 * fq;
#pragma unroll
        for (int s = 0; s < 8; ++s) {
            const bf16x8 av = *(const LAS bf16x8*)(lds + fr * N2_HP + (256 * wid + 32 * s + 8 * fq) * 2);
#pragma unroll
            for (int nt = 0; nt < 5; ++nt) { const bf16x8 bv = *(const bf16x8*)(rw + (size_t)(16 * nt) * D + 32 * s); acc[nt] = MFMA16(av, bv, acc[nt]); }
        }
        LAS float* part = (LAS float*)(lds + N2_PART) + wid * 16 * 80;
#pragma unroll
        for (int nt = 0; nt < 5; ++nt)
#pragma unroll
            for (int i = 0; i < 4; ++i) part[(4 * fq + i) * 80 + 16 * nt + fr] = acc[nt][i];
    }
    __syncthreads();
    {
        LAS const float* part = (LAS const float*)(lds + N2_PART); LAS float* logit = (LAS float*)(lds + N2_LOG);
        for (int e = tid; e < 16 * 80; e += NTHR) { float s = 0.f;
#pragma unroll
            for (int w = 0; w < 8; ++w) s += part[w * 16 * 80 + e];
            logit[e] = s; }
    }
    __syncthreads();
    if (tid < 16) {
        LAS const float* lg = (LAS const float*)(lds + N2_LOG) + tid * 80;
        const float* bg = a.in[16] + l * 8; const float* be = a.in[18] + l * 64;
        float z[8]; float zm = -3.0e38f; int gi = 0;
#pragma unroll
        for (int i = 0; i < 8; ++i) { z[i] = lg[i] + bg[i]; if (z[i] > zm) { zm = z[i]; gi = i; } }
        float den = 0.f;
#pragma unroll
        for (int i = 0; i < 8; ++i) den += expf(z[i] - zm);
        const float gp = 1.0f / den;
        float e1 = -3.0e38f, e2 = -3.0e38f; int i1 = 0, i2 = 0;
#pragma unroll
        for (int i = 0; i < 8; ++i) { const float v = lg[8 + 8 * gi + i] + be[8 * gi + i];
            if (v > e1) { e2 = e1; i2 = i1; e1 = v; i1 = i; } else if (v > e2) { e2 = v; i2 = i; } }
        const float t2 = expf(e2 - e1), w1 = gp / (1.0f + t2), w2 = gp * t2 / (1.0f + t2);
        const int tok = 16 * u + tid, ea = 8 * gi + i1, eb = 8 * gi + i2;
        const unsigned pa = __hip_atomic_fetch_add(cnt + ea * 16, 1u, __ATOMIC_RELAXED, __HIP_MEMORY_SCOPE_AGENT);
        const unsigned pb = __hip_atomic_fetch_add(cnt + eb * 16, 1u, __ATOMIC_RELAXED, __HIP_MEMORY_SCOPE_AGENT);
        LIST[(size_t)ea * 16384 + pa] = 2 * tok; LIST[(size_t)eb * 16384 + pb] = 2 * tok + 1;
        TW[2 * tok] = w1; TW[2 * tok + 1] = w2;
    }
    __syncthreads();
}

constexpr int N2P_HALF = 16 * N2_HP, N2P_LOG = 2 * N2P_HALF;
__device__ __forceinline__ void n2_pair(int p, int l, const Args& a, const bf16* X, bf16* XN, const bf16* RWT, unsigned* cnt, int* LIST, float* TW, LAS unsigned char* lds, int tid, int wid, int lane) {
    const int half = wid >> 2, wl = wid & 3, u = 2 * p + half, th = tid & 255;
    LAS unsigned char* const hT = lds + half * N2P_HALF;
    const float* gain = a.in[14] + (size_t)l * D;
    {
        u32x2 raw[4][8];
#pragma unroll
        for (int rr = 0; rr < 4; ++rr) { const u32x2* xr = (const u32x2*)(X + (size_t)(16 * u + 4 * wl + rr) * D) + lane;
#pragma unroll
            for (int j = 0; j < 8; ++j) raw[rr][j] = xr[64 * j]; }
        f32x4 g[8]; { const f32x4* gr = (const f32x4*)gain + lane;
#pragma unroll
            for (int j = 0; j < 8; ++j) g[j] = gr[64 * j]; }
#pragma unroll
        for (int rr = 0; rr < 4; ++rr) {
            const int lr = 4 * wl + rr, row = 16 * u + lr;
            f32x4 v[8]; float ss = 0.f;
#pragma unroll
            for (int j = 0; j < 8; ++j) { const u32x2 r = raw[rr][j]; v[j] = (f32x4){bflo(r.x), bfhi(r.x), bflo(r.y), bfhi(r.y)}; ss += (v[j].x * v[j].x + v[j].y * v[j].y) + (v[j].z * v[j].z + v[j].w * v[j].w); }
            ss = wave_sum(ss);
            const float rstd = 1.0f / sqrtf(ss * (1.0f / D) + RMS_EPS);
            u32x2* o8 = (u32x2*)(XN + (size_t)row * D) + lane;
#pragma unroll
            for (int j = 0; j < 8; ++j) { u32x2 w; w.x = cvtpk(v[j].x * rstd * g[j].x, v[j].y * rstd * g[j].y); w.y = cvtpk(v[j].z * rstd * g[j].z, v[j].w * rstd * g[j].w);
                o8[64 * j] = w; *(LAS u32x2*)(hT + lr * N2_HP + (4 * lane + 256 * j) * 2) = w; }
        }
    }
    __syncthreads();
    const int fr = lane & 15, fq = lane >> 4;
    f32x4 acc[2][5];
#pragma unroll
    for (int hh = 0; hh < 2; ++hh)
#pragma unroll
        for (int nt = 0; nt < 5; ++nt) acc[hh][nt] = (f32x4){0.f, 0.f, 0.f, 0.f};
    {
        const bf16* rw = RWT + (size_t)l * 96 * D + (size_t)fr * D + 256 * wid + 8 * fq;
#pragma unroll 4
        for (int s = 0; s < 8; ++s) {
            const bf16x8 av0 = *(const LAS bf16x8*)(lds + fr * N2_HP + (256 * wid + 32 * s + 8 * fq) * 2);
            const bf16x8 av1 = *(const LAS bf16x8*)(lds + N2P_HALF + fr * N2_HP + (256 * wid + 32 * s + 8 * fq) * 2);
#pragma unroll
            for (int nt = 0; nt < 5; ++nt) { const bf16x8 bv = *(const bf16x8*)(rw + (size_t)(16 * nt) * D + 32 * s); acc[0][nt] = MFMA16(av0, bv, acc[0][nt]); acc[1][nt] = MFMA16(av1, bv, acc[1][nt]); }
        }
    }
    __syncthreads();
    {
        LAS float* part = (LAS float*)lds + wid * 32 * 80;
#pragma unroll
        for (int hh = 0; hh < 2; ++hh)
#pragma unroll
            for (int nt = 0; nt < 5; ++nt)
#pragma unroll
                for (int i = 0; i < 4; ++i) part[(16 * hh + 4 * fq + i) * 80 + 16 * nt + fr] = acc[hh][nt][i];
    }
    __syncthreads();
    {
        LAS const float* part = (LAS const float*)lds; LAS float* logit = (LAS float*)(lds + N2P_LOG);
        for (int e = tid; e < 32 * 80; e += NTHR) { float sres = 0.f;
#pragma unroll
            for (int w = 0; w < 8; ++w) sres += part[w * 32 * 80 + e];
            logit[e] = sres; }
    }
    __syncthreads();
    if (th < 16) {
        LAS const float* lg = (LAS const float*)(lds + N2P_LOG) + (16 * half + th) * 80;
        const float* bg = a.in[16] + l * 8; const float* be = a.in[18] + l * 64;
        float z[8]; float zm = -3.0e38f; int gi = 0;
#pragma unroll
        for (int i = 0; i < 8; ++i) { z[i] = lg[i] + bg[i]; if (z[i] > zm) { zm = z[i]; gi = i; } }
        float den = 0.f;
#pragma unroll
        for (int i = 0; i < 8; ++i) den += expf(z[i] - zm);
        const float gp = 1.0f / den;
        float e1 = -3.0e38f, e2 = -3.0e38f; int i1 = 0, i2 = 0;
#pragma unroll
        for (int i = 0; i < 8; ++i) { const float v = lg[8 + 8 * gi + i] + be[8 * gi + i];
            if (v > e1) { e2 = e1; i2 = i1; e1 = v; i1 = i; } else if (v > e2) { e2 = v; i2 = i; } }
        const float t2 = expf(e2 - e1), w1 = gp / (1.0f + t2), w2 = gp * t2 / (1.0f + t2);
        const int tok = 16 * u + th, ea = 8 * gi + i1, eb = 8 * gi + i2;
        const unsigned pa = __hip_atomic_fetch_add(cnt + ea * 16, 1u, __ATOMIC_RELAXED, __HIP_MEMORY_SCOPE_AGENT);
        const unsigned pb = __hip_atomic_fetch_add(cnt + eb * 16, 1u, __ATOMIC_RELAXED, __HIP_MEMORY_SCOPE_AGENT);
        LIST[(size_t)ea * 16384 + pa] = 2 * tok; LIST[(size_t)eb * 16384 + pb] = 2 * tok + 1;
        TW[2 * tok] = w1; TW[2 * tok + 1] = w2;
    }
    __syncthreads();
}

constexpr int MO_B = 65536, MO_BBUF = 16384, MO_A = 98304, MO_APITCH = 2176, MO_ABUF = 4 * MO_APITCH, MO_ROW = MO_A + 2 * MO_ABUF, MO_PRE = MO_ROW + 512;
constexpr int MO_STG = 117760;
static_assert(MO_PRE + 272 <= MO_STG && MO_STG + 8 * 4096 <= MISC_OFF, "MoE LDS map");
__device__ __forceinline__ int mo_aoff(int row, int c) { return c * MO_APITCH + ((row + 2 * c) << 4); }
__device__ __forceinline__ int mo_hoff(int row, int c) { return c * 2048 + (row << 4); }

struct MoBStage { f32x4 v[4]; };
__device__ __forceinline__ void mo_gl16(f32x4& d, const float* p) { asm volatile("global_load_dwordx4 %0, %1, off" : "=v"(d) : "v"(p) : "memory"); }
__device__ __forceinline__ void mo_gl16u(u32x4& d, const bf16* p) { asm volatile("global_load_dwordx4 %0, %1, off" : "=v"(d) : "v"(p) : "memory"); }
__device__ __forceinline__ void mo_bload(MoBStage& sg, const float* src0, const float* src1, size_t ld, int k0, int tid) {
    const int n4 = tid & 63, kg = tid >> 6;
    const float* p = (n4 < 32 ? src0 + 4 * n4 : src1 + 4 * (n4 - 32)) + (size_t)(k0 + 4 * kg) * ld;
    mo_gl16(sg.v[0], p); mo_gl16(sg.v[1], p + ld); mo_gl16(sg.v[2], p + 2 * ld); mo_gl16(sg.v[3], p + 3 * ld);
}
#define MO_WAIT5(N, SB, SA) asm volatile("s_waitcnt vmcnt(" #N ")" : "+v"(SB.v[0]), "+v"(SB.v[1]), "+v"(SB.v[2]), "+v"(SB.v[3]), "+v"(SA) :: "memory")
#define MO_WAIT4(N, SB) asm volatile("s_waitcnt vmcnt(" #N ")" : "+v"(SB.v[0]), "+v"(SB.v[1]), "+v"(SB.v[2]), "+v"(SB.v[3]) :: "memory")
__device__ __forceinline__ void mo_bwrite(const MoBStage& sg, LAS unsigned char* bb, int tid) {
    const int n4 = tid & 63, kg = tid >> 6;
#pragma unroll
    for (int i = 0; i < 4; ++i) { u32x2 w; w.x = cvtpk(sg.v[0][i], sg.v[1][i]); w.y = cvtpk(sg.v[2][i], sg.v[3][i]);
        *(LAS u32x2*)(bb + (kg >> 1) * 4096 + (32 * (n4 >> 3) + 8 * i + (n4 & 7)) * 16 + 8 * (kg & 1)) = w; }
}
#define MO_READ(AP, ASTEP, BP, B1OFF) bf16x8 fb0_[2], fb1_[2], fa_[2][2]; \
    _Pragma("unroll") for (int s_ = 0; s_ < 2; ++s_) { fb0_[s_] = *(const LAS bf16x8*)((BP) + s_ * 8192); fb1_[s_] = *(const LAS bf16x8*)((BP) + s_ * 8192 + (B1OFF)); \
        _Pragma("unroll") for (int mt = 0; mt < 2; ++mt) fa_[s_][mt] = *(const LAS bf16x8*)((AP) + s_ * (ASTEP) + mt * 512); } \
    __builtin_amdgcn_sched_barrier(0)
#define MO_MMA(ACC0, ACC1) do { __builtin_amdgcn_sched_barrier(0); _Pragma("unroll") for (int s_ = 0; s_ < 2; ++s_) _Pragma("unroll") for (int mt = 0; mt < 2; ++mt) { \
        ACC0[mt] = MFMA32(fa_[s_][mt], fb0_[s_], ACC0[mt]); ACC1[mt] = MFMA32(fa_[s_][mt], fb1_[s_], ACC1[mt]); } __builtin_amdgcn_sched_barrier(0); } while (0)

__device__ __forceinline__ void moe_unit(int e, int c0, int nrows, const bf16* XN, const int* LIST, const float* Wg, const float* Wu, const float* Wd, bf16* YB, LAS unsigned char* lds, int tid, int wid, int lane) {
    const int r32 = lane & 31, hi = lane >> 5, wn = wid & 3, wm = wid >> 2;
    LAS int* rowid = (LAS int*)(lds + MO_ROW);
    if (tid < 128) rowid[tid] = (tid < nrows) ? LIST[(size_t)e * 16384 + c0 + tid] : -1;
    __syncthreads();
    const float* wg = Wg + (size_t)e * D * 256; const float* wu = Wu + (size_t)e * D * 256; const float* wd = Wd + (size_t)e * 256 * D;
    f32x16 acc0[2], acc1[2];
#define MO_ZERO() do { acc0[0] = (f32x16){}; acc0[1] = (f32x16){}; acc1[0] = (f32x16){}; acc1[1] = (f32x16){}; } while (0)
    MO_ZERO();
    MoBStage s0, s1, s2, s3; u32x4 a0, a1, a2, a3;
    {
        const int arow = tid >> 2, ac = tid & 3; const int rid = rowid[arow]; const bf16* asrc = XN + (size_t)((rid < 0 ? 0 : rid) >> 1) * D + 8 * ac;
        LAS unsigned char* const awr = lds + MO_A + mo_aoff(arow, ac);
        LAS const unsigned char* const ard = lds + MO_A + mo_aoff(64 * wm + r32, hi);
        LAS const unsigned char* const brd = lds + MO_B + hi * 4096 + (32 * wn + r32) * 16;
#define G1_LOAD(SB, SA, t) do { const int t_ = (t); mo_gl16u(SA, asrc + 32 * (t_ & 63)); mo_bload(SB, wg + 128 * (t_ >> 6), wu + 128 * (t_ >> 6), 256, 32 * (t_ & 63), tid); } while (0)
#define G1_WRITE(SB, SA, b) do { *(LAS u32x4*)(awr + (b) * MO_ABUF) = SA; mo_bwrite(SB, lds + MO_B + (b) * MO_BBUF, tid); } while (0)
#define G1_STEP(t, b, SBL, SAL, SBW, SAW) do { const int tt_ = (t); \
            MO_READ(ard + (b) * MO_ABUF, 2 * MO_APITCH + 64, brd + (b) * MO_BBUF, 2048);     \
            G1_LOAD(SBL, SAL, (tt_ + 4 < 128 ? tt_ + 4 : 127));     \
            __builtin_amdgcn_sched_barrier(0); \
            MO_WAIT5(15, SBW, SAW); \
            if (tt_ + 1 < 128) G1_WRITE(SBW, SAW, (b) ^ 1); \
            MO_MMA(acc0, acc1); \
            if ((tt_ & 63) == 63) {     \
                const int col_ = 128 * (tt_ >> 6) + 32 * wn + 4 * (r32 & 7) + (r32 >> 3), cch_ = col_ >> 3; \
                _Pragma("unroll") for (int mt = 0; mt < 2; ++mt) _Pragma("unroll") for (int r = 0; r < 16; ++r) { const float gt = acc0[mt][r], up = acc1[mt][r]; const float hv = gt / (1.0f + __expf(-gt)) * up; \
                    *(LAS unsigned short*)(lds + mo_hoff(64 * wm + 32 * mt + crow(r, hi), cch_) + (col_ & 7) * 2) = f2bf16(hv); } \
                MO_ZERO(); } \
            __syncthreads(); } while (0)
        G1_LOAD(s0, a0, 0); G1_LOAD(s1, a1, 1); G1_LOAD(s2, a2, 2); G1_LOAD(s3, a3, 3);
        MO_WAIT5(15, s0, a0);
        G1_WRITE(s0, a0, 0);
        __syncthreads();
        for (int t = 0; t < 128; t += 4) {
            G1_STEP(t, 0, s0, a0, s1, a1);
            G1_STEP(t + 1, 1, s1, a1, s2, a2);
            G1_STEP(t + 2, 0, s2, a2, s3, a3);
            G1_STEP(t + 3, 1, s3, a3, s0, a0);
        }
        asm volatile("s_waitcnt vmcnt(0)" : "+v"(s0.v[0]), "+v"(s0.v[1]), "+v"(s0.v[2]), "+v"(s0.v[3]), "+v"(s1.v[0]), "+v"(s1.v[1]), "+v"(s1.v[2]), "+v"(s1.v[3]), "+v"(s2.v[0]), "+v"(s2.v[1]), "+v"(s2.v[2]), "+v"(s2.v[3]),
                     "+v"(s3.v[0]), "+v"(s3.v[1]), "+v"(s3.v[2]), "+v"(s3.v[3]), "+v"(a0), "+v"(a1), "+v"(a2), "+v"(a3) :: "memory");
#undef G1_LOAD
#undef G1_WRITE
#undef G1_STEP
    }
    {
        LAS const unsigned char* const hrd = lds + mo_hoff(64 * wm + r32, hi);
        LAS const unsigned char* const brd = lds + MO_B + hi * 4096 + (64 * wn + r32) * 16;
#define G2_LOAD(SB, t) do { const int t_ = (t); mo_bload(SB, wd + 256 * (t_ >> 3), wd + 256 * (t_ >> 3) + 128, D, 32 * (t_ & 7), tid); } while (0)
#define G2_STEP(t, b, SBL, SBW) do { const int tt_ = (t); \
            MO_READ(hrd + (tt_ & 7) * 8192, 4096, brd + (b) * MO_BBUF, 512); \
            G2_LOAD(SBL, (tt_ + 4 < 64 ? tt_ + 4 : 63)); \
            __builtin_amdgcn_sched_barrier(0); \
            MO_WAIT4(12, SBW); \
            if (tt_ + 1 < 64) mo_bwrite(SBW, lds + MO_B + ((b) ^ 1) * MO_BBUF, tid); \
            MO_MMA(acc0, acc1); \
            if ((tt_ & 7) == 7) {     \
                LAS unsigned char* const stg_ = lds + MO_STG + wid * 4096; const int cidx_ = 4 * (r32 & 7) + (r32 >> 3); \
                _Pragma("unroll") for (int mt = 0; mt < 2; ++mt) { \
                    _Pragma("unroll") for (int r = 0; r < 16; ++r) { const int row_ = crow(r, hi); \
                        *(LAS unsigned short*)(stg_ + row_ * 128 + cidx_ * 2) = f2bf16(acc0[mt][r]); *(LAS unsigned short*)(stg_ + row_ * 128 + (cidx_ + 32) * 2) = f2bf16(acc1[mt][r]); } \
                    _Pragma("unroll") for (int k = 0; k < 4; ++k) { const int idx_ = lane + 64 * k, row_ = idx_ >> 3, ch_ = idx_ & 7; \
                        const u32x4 v_ = *(const LAS u32x4*)(stg_ + row_ * 128 + ch_ * 16); const int rr = rowid[64 * wm + 32 * mt + row_]; \
                        if (rr >= 0) *(u32x4*)(YB + (size_t)rr * D + 256 * (tt_ >> 3) + 64 * wn + 8 * ch_) = v_; } } \
                MO_ZERO(); } \
            __syncthreads(); } while (0)
        G2_LOAD(s0, 0); G2_LOAD(s1, 1); G2_LOAD(s2, 2); G2_LOAD(s3, 3);
        MO_WAIT4(12, s0);
        mo_bwrite(s0, lds + MO_B, tid);
        __syncthreads();
        for (int t = 0; t < 64; t += 4) {
            G2_STEP(t, 0, s0, s1);
            G2_STEP(t + 1, 1, s1, s2);
            G2_STEP(t + 2, 0, s2, s3);
            G2_STEP(t + 3, 1, s3, s0);
        }
        asm volatile("s_waitcnt vmcnt(0)" : "+v"(s0.v[0]), "+v"(s0.v[1]), "+v"(s0.v[2]), "+v"(s0.v[3]), "+v"(s1.v[0]), "+v"(s1.v[1]), "+v"(s1.v[2]), "+v"(s1.v[3]), "+v"(s2.v[0]), "+v"(s2.v[1]), "+v"(s2.v[2]), "+v"(s2.v[3]),
                     "+v"(s3.v[0]), "+v"(s3.v[1]), "+v"(s3.v[2]), "+v"(s3.v[3]) :: "memory");
#undef G2_LOAD
#undef G2_STEP
    }
#undef MO_ZERO
}

constexpr int N_PHASES = 1 + 7 * DEPTH;
#ifndef PH_MASK
#define PH_MASK 0xFFFF
#endif
#define PHON(k) (((PH_MASK) >> (k)) & 1)
#ifndef DUP_MASK
#define DUP_MASK 0
#endif
#define DUPON(k) ((((DUP_MASK) >> (k)) & 1) && (l == 0 || (((0x3FE) >> (k)) & 1)))
#ifndef MK_ONE_LAUNCH
#define MK_ONE_LAUNCH 1
#endif

__global__ void __launch_bounds__(NTHR, 2) fwd_kernel(Args args) {
    extern __shared__ __attribute__((aligned(16))) unsigned char lds_raw[];
    LAS unsigned char* lds = (LAS unsigned char*)lds_raw;
    volatile LAS unsigned* MISC = (volatile LAS unsigned*)(lds + MISC_OFF);
    const int wid = __builtin_amdgcn_readfirstlane(threadIdx.x >> 6);
    const int G = gridDim.x, bid = blockIdx.x;
    unsigned char* ws = args.ws;
    unsigned* const ctl0 = (unsigned*)(ws + WS_CTL);
    if (threadIdx.x < 64) MISC[threadIdx.x] = 0u;
    __syncthreads();
    const int lo = args.ph_lo, hi_ph = args.ph_hi;
    XcdBarrier bar; bar.bar = ctl0 + CW_BAR; bar.x = 0; bar.st = MISC + 8; bar.w0 = 0;
    if (hi_ph - lo > 1) bar = xcd_barrier_post(ctl0 + CW_BAR, MISC + 8);
#define IN(k) (lo <= (k) && (k) < hi_ph)
#define FRESH() int wid_ = wid; asm volatile("" : "+s"(wid_)); int lane_; asm volatile("v_mbcnt_lo_u32_b32 %0, -1, 0\n\tv_mbcnt_hi_u32_b32 %0, -1, %0" : "=v"(lane_)); const int tid_ = wid_ * 64 + lane_; (void)tid_
#define SEAM(k) do { if (IN(k) && IN((k) + 1)) xcd_barrier(bar); } while (0)

    const int NGW = G * NWAVES;

    if (PHON(0) && IN(0)) { FRESH(); p0_prologue(args, lds, bid, G, tid_, wid_, lane_); if ((DUP_MASK) & 1) p0_prologue(args, lds, bid, G, tid_, wid_, lane_); }
    SEAM(0);

#pragma unroll 1
    for (int lraw = 0; lraw < DEPTH; ++lraw) {
        int l = lraw; asm volatile("" : "+s"(l));
        GAS unsigned char* wsg = (GAS unsigned char*)ws; asm volatile("" : "+s"(wsg)); unsigned char* const wsl = (unsigned char*)wsg;
        unsigned* const ctl = (unsigned*)(wsl + WS_CTL);
        bf16* const WIN = (bf16*)(wsl + WS_WIN); bf16* const WOUT = (bf16*)(wsl + WS_WOUT); bf16* const W1T = (bf16*)(wsl + WS_W1T); bf16* const W2T = (bf16*)(wsl + WS_W2T); bf16* const RWT = (bf16*)(wsl + WS_RWT);
        float* const C1 = (float*)(wsl + WS_C1); bf16* const X = (bf16*)(wsl + WS_X); bf16* const XN = (bf16*)(wsl + WS_XN); bf16* const PROJ = (bf16*)(wsl + WS_PROJ); float* const AUX = (float*)(wsl + WS_AUX);
        float* const CUM = (float*)(wsl + WS_CUM); bf16* const KC = (bf16*)(wsl + WS_KC); bf16* const VC = (bf16*)(wsl + WS_VC); bf16* const MIX = (bf16*)(wsl + WS_MIX); bf16* const YB = (bf16*)(wsl + WS_YB);
        int* const LIST = (int*)(wsl + WS_LIST); float* const TW = (float*)(wsl + WS_TW);
        const int pb = 1 + 7 * l;
        if (PHON(1) && IN(pb)) {
            pg8::Gemm g{l == 0 ? XN : X, WIN + (size_t)l * NP * D, S, NP, D}; pg8::StaticOrder so; so.init(S, NP, G, bid);
            pg8::EpiProj E{PROJ, AUX, (const float*)(wsl + WS_RSTD)};
            pg8::gemm_phase<pg8::EpiProj, pg8::StaticOrder, true, true>(lds, g, so, E, wid);
            {
                const int ntile = (S / 256) * (NP / 256), rmax = (ntile + G - 1) / G, mine = (ntile - bid + G - 1) / G, nh = G * rmax - ntile;
                if (nh == 0 || mine < rmax) {
                    FRESH(); __syncthreads();
                    LAS float* const scr = (LAS float*)(lds + wid_ * 8448);
                    const int hidx = nh == 0 ? bid : bid - (G - nh), nhw = (nh == 0 ? G : nh) * NWAVES;
                    for (int j = hidx * NWAVES + wid_; j < I_L - I_WIN; j += nhw) tr_dispatch(args, (unsigned char*)wsl, l * I_L + I_WIN + j, scr, lane_);
                }
            }
            if (DUPON(1)) pg8::gemm_phase<pg8::EpiProj, pg8::StaticOrder, true, true>(lds, g, so, E, wid);
        }
        SEAM(pb);
        if (IN(pb + 2)) {
            const int x = bid & 7;
#define QHEAD(q) (ctl + CW_Q + (((l * 6 + (q)) * 8 + x) * 64))
            if (PHON(2)) { FRESH(); unsigned* const pdone = ctl + CW_PD + l * 64;
                for (;;) { const int i = dequeue(ctl + CW_PQ + l * 64, MISC + 19, tid_); if (i >= 136) break;
                    if (i < 8) cumsum_unit(i, l, AUX, args.in[5], CUM, lds, tid_); else compress_unit(i - 8, l, PROJ, W1T, W2T, C1, KC, VC, lds, wid_, lane_);
                    asm volatile("s_waitcnt vmcnt(0)" ::: "memory");
                    __syncthreads();
                    if (wid_ == 0) { __builtin_amdgcn_fence(__ATOMIC_RELEASE, "agent"); asm volatile("s_waitcnt vmcnt(0)" ::: "memory"); (void)__hip_atomic_fetch_add(pdone, 1u, __ATOMIC_RELAXED, __HIP_MEMORY_SCOPE_AGENT); }
                } }
            if (PHON(4)) { FRESH(); for (;;) { const int i = dequeue(QHEAD(1), MISC + 17, tid_); if (i >= 32) break; diff_unit(x & 3, 63 - 2 * i - (x >> 2), l, args, PROJ, MIX, lds, tid_, wid_, lane_); }
                if (DUPON(4)) for (;;) { const int i = dequeue(QHEAD(4), MISC + 17, tid_); if (i >= 32) break; diff_unit(x & 3, 63 - 2 * i - (x >> 2), l, args, PROJ, MIX, lds, tid_, wid_, lane_); } }
            if (PHON(2)) { FRESH();
                if (tid_ == 0) { unsigned* const pdone = ctl + CW_PD + l * 64; unsigned sp = 0;
                    while (__hip_atomic_load(pdone, __ATOMIC_RELAXED, __HIP_MEMORY_SCOPE_AGENT) < 136u * 64u) { __builtin_amdgcn_s_sleep(2); if (++sp > (1u << 20)) break; }
                    __builtin_amdgcn_fence(__ATOMIC_ACQUIRE, "agent"); asm volatile("s_waitcnt vmcnt(0)" ::: "memory"); }
                __syncthreads(); }
            if (PHON(3)) { FRESH(); for (;;) { const int i = dequeue(QHEAD(0), MISC + 16, tid_); if (i >= 32) break; fox_unit(x, 31 - i, PROJ, CUM, MIX, lds, tid_, wid_, lane_); }
                if (DUPON(3)) for (;;) { const int i = dequeue(QHEAD(3), MISC + 16, tid_); if (i >= 32) break; fox_unit(x, 31 - i, PROJ, CUM, MIX, lds, tid_, wid_, lane_); } }
            if (PHON(5)) { FRESH(); for (;;) { const int i = dequeue(QHEAD(2), MISC + 18, tid_); if (i >= 64) break; nsa_unit(x & 3, 127 - 2 * i - (x >> 2), args, PROJ, AUX, KC, VC, MIX, lds, tid_, wid_, lane_); }
                if (DUPON(5)) for (;;) { const int i = dequeue(QHEAD(5), MISC + 18, tid_); if (i >= 64) break; nsa_unit(x & 3, 127 - 2 * i - (x >> 2), args, PROJ, AUX, KC, VC, MIX, lds, tid_, wid_, lane_); } }
#undef QHEAD
        }
        SEAM(pb + 2);
        if (PHON(6) && IN(pb + 3)) {
            pg8::Gemm g{MIX, WOUT + (size_t)l * D * D, S, D, D}; pg8::StaticOrder so; so.init(S, D, G, bid);
            pg8::EpiRes E{l == 0 ? args.in[0] : nullptr, X, X};
            pg8::gemm_phase<pg8::EpiRes, pg8::StaticOrder, true, true>(lds, g, so, E, wid);
            if (DUPON(6)) { pg8::EpiRes E2{nullptr, X, YB}; pg8::gemm_phase<pg8::EpiRes, pg8::StaticOrder, true, true>(lds, g, so, E2, wid); }
        }
        SEAM(pb + 3);
        if (PHON(7) && IN(pb + 4)) {
            FRESH();
            for (int p = bid; p < S / 32; p += G) n2_pair(p, l, args, X, XN, RWT, ctl + CW_CNT + l * 1024, LIST, TW, lds, tid_, wid_, lane_);
            if (DUPON(7)) for (int u = bid; u < S / 16; u += G) n2_unit(u, l, args, X, XN, RWT, ctl + CW_CNT + (4 + l) * 1024, (int*)MIX, (float*)(MIX + 8 * 1024 * 1024), lds, tid_, wid_, lane_);
        }
        SEAM(pb + 4);
        if (PHON(8) && IN(pb + 5)) {
            FRESH();
            LAS int* pre = (LAS int*)(lds + MO_PRE);
            if (tid_ < 64) pre[tid_] = ((int)__hip_atomic_load(ctl + CW_CNT + l * 1024 + tid_ * 16, __ATOMIC_RELAXED, __HIP_MEMORY_SCOPE_AGENT) + 127) >> 7;
            __syncthreads();
            const int x = bid & 7, per = G >> 3;
            for (int rep = 0; rep < (DUPON(8) ? 2 : 1); ++rep)
            for (int slot = bid >> 3; ; slot += per) {
                int e = -1, c = 0, acc = 0;
                for (int k = 0; k < 8; ++k) { const int ee = x + 8 * k, n = pre[ee]; if (e < 0 && slot < acc + n) { e = ee; c = slot - acc; } acc += n; }
                if (e < 0) break;
                e = __builtin_amdgcn_readfirstlane(e); c = __builtin_amdgcn_readfirstlane(c);
                const int c0 = c * 128; const int cnt_e = (int)__hip_atomic_load(ctl + CW_CNT + l * 1024 + e * 16, __ATOMIC_RELAXED, __HIP_MEMORY_SCOPE_AGENT);
                const int nrows = (cnt_e - c0) < 128 ? (cnt_e - c0) : 128;
                moe_unit(e, c0, nrows, XN, LIST, args.in[19] + (size_t)l * 64 * D * 256, args.in[20] + (size_t)l * 64 * D * 256, args.in[21] + (size_t)l * 64 * 256 * D, YB, lds, tid_, wid_, lane_);
            }
        }
        SEAM(pb + 5);
        if (PHON(9) && IN(pb + 6)) {
            FRESH(); const int gw_ = bid * NWAVES + wid_;
            if (l + 1 < DEPTH) {
                norm_rows<1>(nullptr, X, X, XN, YB, TW, args.in[1] + (size_t)(l + 1) * D, nullptr, (float*)(wsl + WS_RSTD), gw_, NGW, lane_);
                if (DUPON(9)) norm_rows<1>(nullptr, X, PROJ, MIX, YB, TW, args.in[1] + (size_t)(l + 1) * D, nullptr, (float*)MIX, gw_, NGW, lane_);
            } else norm_rows<2>(nullptr, X, nullptr, nullptr, YB, TW, args.in[22], args.out, nullptr, gw_, NGW, lane_);
        }
        if (l + 1 < DEPTH) SEAM(pb + 6);
    }
#undef IN
#undef SEAM
}

extern "C" void kernel_launch(void* const* d_in, const int* in_sizes, int n_in, void* d_out, int out_size, void* d_ws, size_t ws_size, hipStream_t stream) {
    static int grid = 0;
    if (grid == 0) {
        if (n_in != 23 || ws_size < WS_END || out_size != S * D) { fprintf(stderr, "kernel_launch: unexpected problem (n_in %d, out %d, ws %zu)\n", n_in, out_size, ws_size); grid = -1; return; }
        int dev = 0, cus = 0, per_cu = 0;
        if (hipGetDevice(&dev) != hipSuccess || hipDeviceGetAttribute(&cus, hipDeviceAttributeMultiprocessorCount, dev) != hipSuccess) { grid = -1; return; }
        if (hipFuncSetAttribute((const void*)fwd_kernel, hipFuncAttributeMaxDynamicSharedMemorySize, LDS_BYTES) != hipSuccess) { fprintf(stderr, "kernel_launch: hipFuncSetAttribute failed\n"); grid = -1; return; }
        if (hipOccupancyMaxActiveBlocksPerMultiprocessor(&per_cu, (const void*)fwd_kernel, NTHR, LDS_BYTES) != hipSuccess || per_cu < 1) fprintf(stderr, "kernel_launch: occupancy query says %d blocks per CU\n", per_cu);
        (void)hipGetLastError();
        grid = cus;
        if (grid < 136) { fprintf(stderr, "kernel_launch: too few CUs (%d)\n", grid); }
    }
    if (grid < 0) return;
    if (hipMemsetAsync((char*)d_ws + WS_CTL, 0, CTL_ZERO_BYTES, stream) != hipSuccess) { fprintf(stderr, "kernel_launch: memset failed\n"); return; }
    Args a{};
    for (int i = 0; i < 23; ++i) a.in[i] = (const float*)d_in[i];
    a.out = (float*)d_out; a.ws = (unsigned char*)d_ws;
#if MK_ONE_LAUNCH
    a.ph_lo = 0; a.ph_hi = N_PHASES;
    hipLaunchKernelGGL(fwd_kernel, dim3(grid), dim3(NTHR), LDS_BYTES, stream, a);
#else
    for (int p = 0; p < N_PHASES; ++p) { a.ph_lo = p; a.ph_hi = p + 1; hipLaunchKernelGGL(fwd_kernel, dim3(grid), dim3(NTHR), LDS_BYTES, stream, a); }
#endif
    const hipError_t le = hipPeekAtLastError();
    if (le != hipSuccess) fprintf(stderr, "kernel_launch: launch failed: %s\n", hipGetErrorName(le));
}
```

```cpp
#include <hip/hip_runtime.h>
#include <cstdio>
#include <cstdint>
#include <cmath>
namespace pg8 {
#define PG8_LAS __attribute__((address_space(3)))
typedef unsigned short bf16_t;
typedef short bf16x8 __attribute__((ext_vector_type(8)));
typedef float f32x4 __attribute__((ext_vector_type(4)));
typedef unsigned u32x4 __attribute__((ext_vector_type(4)));
constexpr int BM = 256, BK = 64, HALF = 128, HTB = HALF * BK * 2  , STAGE_BYTES = 8 * HTB, NXCD = 8, WGM = 8;

__host__ __device__ __forceinline__ int lds_byte(int r, int c) { const int st = (r >> 4) * 2 + (c >> 5), rr = r & 15, cc = c & 31, ob = rr * 64 + cc * 2; return st * 1024 + (ob ^ (((ob >> 9) & 1) << 5)); }
__host__ __device__ __forceinline__ void stage_rc(int b, int& R, int& C) { const int st = b / 1024, sb = b % 1024, swz = sb ^ (((sb >> 9) & 1) << 5); R = (st >> 1) * 16 + swz / 64; C = (st & 1) * 32 + (swz % 64) / 2; }
__host__ __device__ __forceinline__ int perm32(int rho) { const int n = rho >> 4, i = rho & 15; return 8 * (i >> 2) + 4 * n + (i & 3); }

struct Unit { int pm, pn; };
struct Gemm { const bf16_t* A; const bf16_t* Bt; int M, N, K; };

struct StaticOrder {
    int nM, nN, nwg, G, c;
    __host__ __device__ void init(int M, int N, int G_, int c_) { nM = M / BM; nN = N / BM; nwg = nM * nN; G = G_; c = c_; }
    __host__ __device__ bool next(int i, Unit& u) const {
        const long L = (long)i * G + c; if (L >= nwg) return false;
        int wgid = (int)L; { const int q = nwg / NXCD, r = nwg % NXCD, xcd = wgid % NXCD, off = wgid / NXCD; wgid = (xcd < r ? xcd * (q + 1) : r * (q + 1) + (xcd - r) * q) + off; }
        const int nig = WGM * nN, gid = wgid / nig, fm = gid * WGM, gsz = (nM - fm) < WGM ? (nM - fm) : WGM;
        u.pm = fm + ((wgid % nig) % gsz); u.pn = (wgid % nig) / gsz; return true;
    }
    __device__ __forceinline__ void a_ready(const Unit&) const {}
    __device__ __forceinline__ void done(const Unit&) const {}
};
__device__ __forceinline__ unsigned cvt_pk_bf16(float lo, float hi) { unsigned r; asm volatile("v_cvt_pk_bf16_f32 %0, %1, %2" : "=v"(r) : "v"(lo), "v"(hi)); return r; }
struct EpiProj {
    static constexpr bool PERM = true, AFTER_DRAIN = false;
    bf16_t* O; float* aux; const float* rstd;
    __device__ __forceinline__ void operator()(const f32x4 (&acc)[2][2][4][2], const Unit& u, int wr, int wc, int fr, int fq) const {
        const int row0 = u.pm * BM + wr * 64 + fr;
        if (u.pn < 22) {
            const int col0 = u.pn * BM + wc * 32 + 8 * fq;
#pragma unroll
            for (int ai = 0; ai < 2; ++ai)
#pragma unroll
                for (int m = 0; m < 4; ++m) { bf16_t* rowp = O + (size_t)(row0 + ai * HALF + m * 16) * 5632 + col0; const float rs = rstd[row0 + ai * HALF + m * 16];
#pragma unroll
                    for (int bj = 0; bj < 2; ++bj) { const f32x4 v0 = acc[ai][bj][m][0] * rs, v1 = acc[ai][bj][m][1] * rs;
                        u32x4 w; w.x = cvt_pk_bf16(v0[0], v0[1]); w.y = cvt_pk_bf16(v0[2], v0[3]); w.z = cvt_pk_bf16(v1[0], v1[1]); w.w = cvt_pk_bf16(v1[2], v1[3]);
                        *(u32x4*)(rowp + bj * HALF) = w; } }
        } else if (wc < 2) {
            const int col0 = wc * 32 + 8 * fq;
#pragma unroll
            for (int ai = 0; ai < 2; ++ai)
#pragma unroll
                for (int m = 0; m < 4; ++m) { float* rowp = aux + (size_t)(row0 + ai * HALF + m * 16) * 64 + col0; const float rs = rstd[row0 + ai * HALF + m * 16];
                    *(f32x4*)(rowp) = acc[ai][0][m][0] * rs; *(f32x4*)(rowp + 4) = acc[ai][0][m][1] * rs; }
        }
    }
};
struct EpiRes {
    static constexpr bool PERM = true, AFTER_DRAIN = false;
    const float* basef; const bf16_t* baseb; bf16_t* out;
    __device__ __forceinline__ void operator()(const f32x4 (&acc)[2][2][4][2], const Unit& u, int wr, int wc, int fr, int fq) const {
        const int row0 = u.pm * BM + wr * 64 + fr, col0 = u.pn * BM + wc * 32 + 8 * fq;
#pragma unroll
        for (int ai = 0; ai < 2; ++ai)
#pragma unroll
            for (int m = 0; m < 4; ++m) { const size_t off = (size_t)(row0 + ai * HALF + m * 16) * 2048 + col0;
#pragma unroll
                for (int bj = 0; bj < 2; ++bj) { f32x4 v0 = acc[ai][bj][m][0], v1 = acc[ai][bj][m][1]; const size_t o = off + bj * HALF;
                    if (basef) { v0 += *(const f32x4*)(basef + o); v1 += *(const f32x4*)(basef + o + 4); }
                    else { const u32x4 b = *(const u32x4*)(baseb + o);
                        v0[0] += __uint_as_float(b.x << 16); v0[1] += __uint_as_float(b.x & 0xffff0000u); v0[2] += __uint_as_float(b.y << 16); v0[3] += __uint_as_float(b.y & 0xffff0000u);
                        v1[0] += __uint_as_float(b.z << 16); v1[1] += __uint_as_float(b.z & 0xffff0000u); v1[2] += __uint_as_float(b.w << 16); v1[3] += __uint_as_float(b.w & 0xffff0000u); }
                    u32x4 w; w.x = cvt_pk_bf16(v0[0], v0[1]); w.y = cvt_pk_bf16(v0[2], v0[3]); w.z = cvt_pk_bf16(v1[0], v1[1]); w.w = cvt_pk_bf16(v1[2], v1[3]);
                    *(u32x4*)(out + o) = w; } }
    }
};
template <class Epi, class Sched, bool ALIGN_EPI = false, bool SP2 = false>
__device__ __forceinline__ void gemm_phase(PG8_LAS unsigned char* lds, const Gemm g, const Sched& S, const Epi& E, int wid_in  ) {
    int wid = wid_in; asm volatile("" : "+s"(wid));
    int lane = (int)__builtin_amdgcn_mbcnt_hi(~0u, __builtin_amdgcn_mbcnt_lo(~0u, 0u)); asm volatile("" : "+v"(lane));
    const int tid = wid * 64 + lane, wr = wid >> 2, wc = wid & 3, fr = lane & 15, fq = lane >> 4;
    const int K = g.K, nt = K / BK;
    unsigned voffA[2], voffB[2];
#pragma unroll
    for (int i = 0; i < 2; ++i) { int R, C; stage_rc(tid * 16 + i * 8192, R, C); const int Rb = Epi::PERM ? ((R & ~31) + perm32(R & 31)) : R;
        voffA[i] = (unsigned)(R * K + C) * 2u; voffB[i] = (unsigned)(Rb * K + C) * 2u; }
    const size_t kstep = (size_t)(BK * 2);
    const size_t hstep = (size_t)HALF * K * 2;
    const size_t tstep = 2 * hstep;
    const unsigned ldsw = (unsigned)wid * 1024u;
    const int aoff = lds_byte(wr * 64 + fr, fq * 8), boff = lds_byte(wc * 32 + fr, fq * 8);
#define PG8_SA(b, h) (((b) * 2 + (h)) * HTB)
#define PG8_SB(b, h) ((4 + (b) * 2 + (h)) * HTB)
#define PG8_STAGE(bufoff, gbase, voff) do { _Pragma("unroll") for (int _i = 0; _i < 2; ++_i) \
        __builtin_amdgcn_global_load_lds((const unsigned*)((const char*)(gbase) + (voff)[_i]), (PG8_LAS unsigned*)(lds + (bufoff) + ldsw + _i * 8192), 16, 0, 0); } while (0)
#define PG8_LDA(dst, b, h) do { _Pragma("unroll") for (int m = 0; m < 4; ++m) _Pragma("unroll") for (int k = 0; k < 2; ++k) dst[m][k] = *(const PG8_LAS bf16x8*)(lds + PG8_SA(b, h) + aoff + m * 2048 + k * 1024); } while (0)
#define PG8_LDB(dst, b, h) do { _Pragma("unroll") for (int n = 0; n < 2; ++n) _Pragma("unroll") for (int k = 0; k < 2; ++k) dst[n][k] = *(const PG8_LAS bf16x8*)(lds + PG8_SB(b, h) + boff + n * 2048 + k * 1024); } while (0)
#define PG8_MMA(ai, bj, At, Bt) do { __builtin_amdgcn_s_setprio(1); _Pragma("unroll") for (int m = 0; m < 4; ++m) _Pragma("unroll") for (int n = 0; n < 2; ++n) _Pragma("unroll") for (int k = 0; k < 2; ++k) \
        acc[ai][bj][m][n] = __builtin_amdgcn_mfma_f32_16x16x32_bf16(Bt[n][k], At[m][k], acc[ai][bj][m][n], 0, 0, 0); __builtin_amdgcn_s_setprio(0); } while (0)
#define PG8_WAIT_V(n) asm volatile("s_waitcnt vmcnt(" #n ")" ::: "memory")
#define PG8_WAIT_L(n) asm volatile("s_waitcnt lgkmcnt(" #n ")" ::: "memory")
#define PG8_BAR __builtin_amdgcn_s_barrier()
#define PG8_SCHED __builtin_amdgcn_sched_barrier(0)
    Unit cur, nxt; int ui = 0;
    if (!S.next(0, cur)) return;
    f32x4 acc[2][2][4][2];
#pragma unroll
    for (int a = 0; a < 2; ++a)
#pragma unroll
        for (int b = 0; b < 2; ++b)
#pragma unroll
            for (int m = 0; m < 4; ++m)
#pragma unroll
                for (int n = 0; n < 2; ++n) acc[a][b][m][n] = (f32x4){0.f, 0.f, 0.f, 0.f};
    bf16x8 At[4][2], B0[2][2], B1[2][2];
    const char* cA = (const char*)g.A + (size_t)cur.pm * tstep; const char* cB = (const char*)g.Bt + (size_t)cur.pn * tstep;
    S.a_ready(cur);
    if constexpr (SP2) {
        PG8_STAGE(PG8_SB(0, 0), cB, voffB); PG8_STAGE(PG8_SB(0, 1), cB + hstep, voffB); PG8_STAGE(PG8_SA(0, 0), cA, voffA); PG8_STAGE(PG8_SA(0, 1), cA + hstep, voffA);
        if (wr == 1) PG8_BAR;
        PG8_WAIT_V(2); PG8_BAR;
        PG8_STAGE(PG8_SB(1, 0), cB + kstep, voffB); PG8_STAGE(PG8_SA(1, 0), cA + kstep, voffA); PG8_STAGE(PG8_SB(1, 1), cB + hstep + kstep, voffB);
        PG8_WAIT_V(6); PG8_BAR;
    } else {
        PG8_STAGE(PG8_SB(0, 0), cB, voffB); PG8_STAGE(PG8_SA(0, 0), cA, voffA); PG8_STAGE(PG8_SB(0, 1), cB + hstep, voffB); PG8_STAGE(PG8_SA(0, 1), cA + hstep, voffA);
        if (wr == 1) PG8_BAR;
        PG8_WAIT_V(4); PG8_BAR;
        PG8_STAGE(PG8_SB(1, 0), cB + kstep, voffB); PG8_STAGE(PG8_SA(1, 0), cA + kstep, voffA); PG8_STAGE(PG8_SB(1, 1), cB + hstep + kstep, voffB);
        PG8_WAIT_V(6); PG8_BAR;
    }
    for (;;) {
        const bool has_next = S.next(ui + 1, nxt);
        const char* nA = has_next ? (const char*)g.A + (size_t)nxt.pm * tstep : cA; const char* nB = has_next ? (const char*)g.Bt + (size_t)nxt.pn * tstep : cB;
        for (int t = 0; t < nt; t += 2) {
            const bool last = (t == nt - 2);
            const char* a1 = cA + (size_t)(t + 1) * kstep;
            const char* a2 = last ? nA : cA + (size_t)(t + 2) * kstep; const char* b2 = last ? nB : cB + (size_t)(t + 2) * kstep;
            const char* a3 = a2 + kstep; const char* b3 = b2 + kstep;
            if (last && has_next) S.a_ready(nxt);
            if constexpr (SP2) {
            PG8_LDB(B0, 0, 0); PG8_LDB(B1, 0, 1); PG8_SCHED; PG8_LDA(At, 0, 0); PG8_STAGE(PG8_SA(1, 1), a1 + hstep, voffA);
            PG8_WAIT_V(8); PG8_WAIT_L(0); PG8_BAR; PG8_MMA(0, 0, At, B0); PG8_MMA(0, 1, At, B1); PG8_BAR; PG8_SCHED;
            PG8_LDA(At, 0, 1); PG8_STAGE(PG8_SB(0, 0), b2, voffB); PG8_STAGE(PG8_SB(0, 1), b2 + hstep, voffB); PG8_STAGE(PG8_SA(0, 0), a2, voffA);
            PG8_WAIT_V(8); PG8_WAIT_L(0); PG8_BAR; PG8_MMA(1, 0, At, B0); PG8_MMA(1, 1, At, B1); PG8_BAR; PG8_SCHED;
            PG8_LDB(B0, 1, 0); PG8_LDB(B1, 1, 1); PG8_SCHED; PG8_LDA(At, 1, 0); PG8_STAGE(PG8_SA(0, 1), a2 + hstep, voffA);
            PG8_WAIT_V(8); PG8_WAIT_L(0); PG8_BAR; PG8_MMA(0, 0, At, B0); PG8_MMA(0, 1, At, B1); PG8_BAR; PG8_SCHED;
            PG8_LDA(At, 1, 1); PG8_STAGE(PG8_SB(1, 0), b3, voffB); PG8_STAGE(PG8_SB(1, 1), b3 + hstep, voffB); PG8_STAGE(PG8_SA(1, 0), a3, voffA);
            PG8_WAIT_V(8); PG8_WAIT_L(0); PG8_BAR; PG8_MMA(1, 0, At, B0); PG8_MMA(1, 1, At, B1); PG8_BAR; PG8_SCHED;
            } else {
            PG8_LDB(B0, 0, 0); PG8_SCHED; PG8_LDA(At, 0, 0); PG8_STAGE(PG8_SA(1, 1), a1 + hstep, voffA);
            PG8_WAIT_L(8); PG8_BAR; PG8_WAIT_L(0); PG8_MMA(0, 0, At, B0); PG8_BAR; PG8_SCHED;
            PG8_LDB(B1, 0, 1); PG8_STAGE(PG8_SB(0, 0), b2, voffB);
            PG8_BAR; PG8_WAIT_L(0); PG8_MMA(0, 1, At, B1); PG8_BAR;
            PG8_LDA(At, 0, 1); PG8_STAGE(PG8_SA(0, 0), a2, voffA);
            PG8_BAR; PG8_WAIT_L(0); PG8_MMA(1, 0, At, B0); PG8_BAR; PG8_SCHED;
            PG8_STAGE(PG8_SB(0, 1), b2 + hstep, voffB);
            PG8_WAIT_V(6); PG8_BAR; PG8_MMA(1, 1, At, B1); PG8_BAR;
            PG8_LDB(B0, 1, 0); PG8_SCHED; PG8_LDA(At, 1, 0); PG8_STAGE(PG8_SA(0, 1), a2 + hstep, voffA);
            PG8_WAIT_L(8); PG8_BAR; PG8_WAIT_L(0); PG8_MMA(0, 0, At, B0); PG8_BAR; PG8_SCHED;
            PG8_LDB(B1, 1, 1); PG8_STAGE(PG8_SB(1, 0), b3, voffB);
            PG8_BAR; PG8_WAIT_L(0); PG8_MMA(0, 1, At, B1); PG8_BAR;
            PG8_LDA(At, 1, 1); PG8_STAGE(PG8_SA(1, 0), a3, voffA);
            PG8_BAR; PG8_WAIT_L(0); PG8_MMA(1, 0, At, B0); PG8_BAR; PG8_SCHED;
            PG8_STAGE(PG8_SB(1, 1), b3 + hstep, voffB);
            PG8_WAIT_V(6); PG8_BAR; PG8_MMA(1, 1, At, B1); PG8_BAR;
            }
        }
        if constexpr (ALIGN_EPI) { if (wr == 0) PG8_BAR; }
        if constexpr (!Epi::AFTER_DRAIN) { E(acc, cur, wr, wc, fr, fq); S.done(cur); }
        if (!has_next) break;
#pragma unroll
        for (int a = 0; a < 2; ++a)
#pragma unroll
            for (int b = 0; b < 2; ++b)
#pragma unroll
                for (int m = 0; m < 4; ++m)
#pragma unroll
                    for (int n = 0; n < 2; ++n) acc[a][b][m][n] = (f32x4){0.f, 0.f, 0.f, 0.f};
        cur = nxt; cA = nA; cB = nB; ++ui;
        if constexpr (ALIGN_EPI) { if (wr == 1) PG8_BAR; }
    }
    PG8_WAIT_V(0);
    if constexpr (!ALIGN_EPI) { if (wr == 0) PG8_BAR; }
    PG8_BAR;
    if constexpr (Epi::AFTER_DRAIN) { E.fused(acc, cur, wr, wc, fr, fq, lds, wid, lane); S.done(cur); }
#undef PG8_SA
#undef PG8_SB
#undef PG8_STAGE
#undef PG8_LDA
#undef PG8_LDB
#undef PG8_MMA
#undef PG8_WAIT_V
#undef PG8_WAIT_L
#undef PG8_BAR
#undef PG8_SCHED
}
}
#define GAS __attribute__((address_space(1)))
#define LAS __attribute__((address_space(3)))
typedef unsigned short bf16;
typedef unsigned v4u __attribute__((ext_vector_type(4)));
typedef float f32x4 __attribute__((ext_vector_type(4)));
typedef short bf16x8 __attribute__((ext_vector_type(8)));
typedef GAS unsigned gu32;
typedef GAS unsigned long long gu64;
#define RLX_AGENT __ATOMIC_RELAXED, __HIP_MEMORY_SCOPE_AGENT
#define LDS_WAIT() asm volatile("s_waitcnt lgkmcnt(0)" ::: "memory")
#define VM_WAIT() asm volatile("s_waitcnt vmcnt(0)" ::: "memory")
__device__ __forceinline__ unsigned long long rt() { return __builtin_amdgcn_s_memrealtime(); }
__device__ __forceinline__ unsigned f2bf(float f) { unsigned u = __builtin_bit_cast(unsigned, f); return (u + 0x7fffu + ((u >> 16) & 1u)) >> 16; }
__device__ __forceinline__ unsigned pk2(float lo, float hi) { return f2bf(lo) | (f2bf(hi) << 16); }
#define XB_TMO      128
#define XB_XCNT(j)  (256  + 64 * (j))
#define XB_XSUB(j)  (1280 + 64 * (j))
#define XB_XGEN(j)  (2304 + 64 * (j))
#define XB_TOP      3328
#define XB_TOPGEN   3392
#define XCD_BAR_WORDS 3456
#define XB_SPIN_CAP (1u << 18)

__device__ __forceinline__ unsigned xb_ld(unsigned* p)              { return __hip_atomic_load(p, __ATOMIC_RELAXED, __HIP_MEMORY_SCOPE_AGENT); }
__device__ __forceinline__ unsigned xb_add(unsigned* p, unsigned v) { return __hip_atomic_fetch_add(p, v, __ATOMIC_RELAXED, __HIP_MEMORY_SCOPE_AGENT); }
__device__ __forceinline__ unsigned xb_xcc_id() { return (unsigned)__builtin_amdgcn_s_getreg((3 << 11) | 20) & 0xFu; }
#define XB_SPIN(cond, bar) do { unsigned _sp = 0; while (cond) { __builtin_amdgcn_s_sleep(1); \
    if ((++_sp & 255u) == 0u) { if (xb_ld(&(bar)[XB_TMO])) break; if (_sp > XB_SPIN_CAP) { atomicAdd(&(bar)[XB_TMO], 1u); break; } } } } while (0)

struct XcdBarrier {
    unsigned* bar; unsigned x;
    unsigned w0;
    volatile LAS unsigned* st;
};

__device__ __forceinline__ XcdBarrier xcd_barrier_post(unsigned* bar, volatile LAS unsigned* st) {
    XcdBarrier b; b.bar = bar; b.x = xb_xcc_id(); b.st = st; b.w0 = (__builtin_amdgcn_readfirstlane(threadIdx.x >> 6) == 0) ? 1u : 0u;
    if (threadIdx.x == 0) (void)xb_add(&bar[XB_XCNT(b.x)], 1u);
    return b;
}
__device__ __forceinline__ void xcd_barrier_complete(unsigned* bar, unsigned x, unsigned& nloc, unsigned& nx) {
    const unsigned G = gridDim.x * gridDim.y * gridDim.z;
    unsigned sum, cnt, mine, sp = 0u;
    for (;;) {
        sum = 0u; cnt = 0u; mine = 0u;
#pragma unroll
        for (unsigned j = 0; j < 16; ++j) { const unsigned c = xb_ld(&bar[XB_XCNT(j)]); sum += c; cnt += (c > 0u) ? 1u : 0u; mine = (j == x) ? c : mine; }
        if (sum == G) break;
        __builtin_amdgcn_s_sleep(1);
        if ((++sp & 255u) == 0u) { if (xb_ld(&bar[XB_TMO])) break; if (sp > XB_SPIN_CAP) { atomicAdd(&bar[XB_TMO], 1u); break; } }
    }
    nloc = mine > 0u ? mine : 1u; nx = cnt > 0u ? cnt : 1u;
}

__device__ __forceinline__ void xcd_barrier(const XcdBarrier& b) {
    asm volatile("s_waitcnt vmcnt(0)" ::: "memory");
    __syncthreads();
    if (b.w0 != 0u && __builtin_amdgcn_mbcnt_hi(~0u, __builtin_amdgcn_mbcnt_lo(~0u, 0u)) == 0u) {
        GAS unsigned* barg = (GAS unsigned*)b.bar; asm volatile("" : "+s"(barg)); unsigned* bar = (unsigned*)barg;
        __builtin_amdgcn_s_waitcnt(0);
        unsigned nloc = b.st[0], nx = b.st[1];
        if (nloc == 0u) { xcd_barrier_complete(bar, b.x, nloc, nx); b.st[0] = nloc; b.st[1] = nx; }
        const unsigned old = xb_add(&bar[XB_XSUB(b.x)], 1u);
        const unsigned gen = old / nloc;
        if (old + 1u == (gen + 1u) * nloc) {
            __builtin_amdgcn_fence(__ATOMIC_RELEASE, "agent");
            asm volatile("s_waitcnt vmcnt(0)" ::: "memory");
            const unsigned og = xb_add(&bar[XB_TOP], 1u);
            const unsigned tg = og / nx;
            if (og + 1u == (tg + 1u) * nx) xb_add(&bar[XB_TOPGEN], 1u);
            else XB_SPIN(xb_ld(&bar[XB_TOPGEN]) == tg, bar);
            __builtin_amdgcn_fence(__ATOMIC_ACQUIRE, "agent");
            xb_add(&bar[XB_XGEN(b.x)], 1u);
            asm volatile("s_waitcnt vmcnt(0)" ::: "memory");
        } else {
            XB_SPIN(xb_ld(&bar[XB_XGEN(b.x)]) == gen, bar);
            __builtin_amdgcn_fence(__ATOMIC_ACQUIRE, "agent");
            asm volatile("s_waitcnt vmcnt(0)" ::: "memory");
        }
    }
    __syncthreads();
}
typedef unsigned u32x4 __attribute__((ext_vector_type(4)));

typedef short s16x4 __attribute__((ext_vector_type(4)));
typedef float f32x16 __attribute__((ext_vector_type(16)));
typedef unsigned u32x2 __attribute__((ext_vector_type(2)));
typedef float f32x2v __attribute__((ext_vector_type(2)));

constexpr int S = 8192, D = 2048, DEPTH = 4, DIN = 5688, NP = 5888, PITCH = 5632;
constexpr int C_AQ = 0, C_AK = 512, C_AV = 1024, C_BQ = 1536, C_BK = 2048, C_BV = 2560, C_CQ = 3072, C_KC = 4096, C_VC = 4352, C_KS = 4608, C_VS = 4864, C_KW = 5120, C_VW = 5376;
constexpr float RMS_EPS = 1e-6f, NEG = -1e30f, LOG2E = 1.4426950408889634f, SCL2 = 0.125f * 1.4426950408889634f;
constexpr int NWAVES = 8, NTHR = 512;

constexpr size_t MiB = 1u << 20;
constexpr size_t WS_CTL = 0, CTL_ZERO_BYTES = 1 * MiB;
constexpr size_t WS_WIN = 2 * MiB;
constexpr size_t WS_WOUT = 96 * MiB;
constexpr size_t WS_W1T = 128 * MiB;
constexpr size_t WS_W2T = 136 * MiB;
constexpr size_t WS_RWT = 137 * MiB;
constexpr size_t WS_C1 = 139 * MiB;
constexpr size_t WS_X = 144 * MiB;
constexpr size_t WS_XN = 208 * MiB;
constexpr size_t WS_PROJ = 240 * MiB;
constexpr size_t WS_AUX = 330 * MiB;
constexpr size_t WS_CUM = 332 * MiB;
constexpr size_t WS_KC = 333 * MiB;
constexpr size_t WS_VC = 334 * MiB;
constexpr size_t WS_MIX = 336 * MiB;
constexpr size_t WS_YB = 368 * MiB;
constexpr size_t WS_LIST = 432 * MiB;
constexpr size_t WS_TW = 436 * MiB;
constexpr size_t WS_RSTD = 437 * MiB;
constexpr size_t WS_END = 440 * MiB;
constexpr int CW_BAR = 4096;
constexpr int CW_Q = 8192;
constexpr int CW_PQ = 24576, CW_PD = 25600;
constexpr int CW_CNT = 32768;

constexpr int LDS_BYTES = 160 * 1024;
constexpr int MISC_OFF = 150 * 1024;

struct Args { const float* in[23]; float* out; unsigned char* ws; int ph_lo, ph_hi; };
__device__ __forceinline__ int t5_bucket(int rel) { if (rel < 16) return rel; int b = 16;
    b += rel >= 19; b += rel >= 21; b += rel >= 24; b += rel >= 27; b += rel >= 31; b += rel >= 35; b += rel >= 40; b += rel >= 46; b += rel >= 52; b += rel >= 59; b += rel >= 67; b += rel >= 77; b += rel >= 87; b += rel >= 99; b += rel >= 113; return b; }

__device__ __forceinline__ float bf2f(unsigned short b) { return __uint_as_float((unsigned)b << 16); }
__device__ __forceinline__ float bflo(unsigned w) { return __uint_as_float(w << 16); }
__device__ __forceinline__ float bfhi(unsigned w) { return __uint_as_float(w & 0xffff0000u); }
typedef __bf16 bf16x2_t __attribute__((ext_vector_type(2)));
__device__ __forceinline__ unsigned cvtpk(float lo, float hi) { f32x2v v = {lo, hi}; bf16x2_t b = __builtin_convertvector(v, bf16x2_t); return __builtin_bit_cast(unsigned, b); }
__device__ __forceinline__ unsigned short f2bf16(float f) { return (unsigned short)(cvtpk(f, 0.f) & 0xffffu); }
__device__ __forceinline__ float wave_sum(float v) {
#pragma unroll
    for (int o = 1; o < 64; o <<= 1) v += __shfl_xor(v, o);
    return v;
}
__device__ __forceinline__ int crow(int r, int hi) { return (r & 3) + 8 * (r >> 2) + 4 * hi; }
#define MFMA32(a, b, c) __builtin_amdgcn_mfma_f32_32x32x16_bf16((a), (b), (c), 0, 0, 0)
#define MFMA16(a, b, c) __builtin_amdgcn_mfma_f32_16x16x32_bf16((a), (b), (c), 0, 0, 0)

__device__ __forceinline__ int src_col_win(int n) { if (n < 3072) return n; if (n < 5632) return n + 8; if (n < 5640) return n - 2560; if (n < 5688) return n; return -1; }

template <int MODE>
__device__ __forceinline__ void tr_item(const float* W, const float* W2, int ldw, int K, bf16* WT, int k0, int n0, LAS float* scr, int lane, const float* kgain = nullptr  ) {
    const int nq = lane & 7, kq = lane >> 3, nn = n0 + 4 * nq;
    const float* src = W; int ld = ldw; bool ok = true;
    if (MODE == 0) { src = W + nn; }
    else if (MODE == 1) { const int c = src_col_win(nn); ok = c >= 0; src = W + (ok ? c : 0); }
    else { if (nn < 8) { src = W + nn; ld = 8; } else if (nn < 72) { src = W2 + (nn - 8); ld = 64; } else { ok = false; ld = 8; } }
    f32x4 tq[8];
#pragma unroll
    for (int i = 0; i < 8; ++i) { const int kk = 8 * i + kq; tq[i] = ok ? *(const f32x4*)(src + (size_t)(k0 + kk) * ld) : (f32x4){0.f, 0.f, 0.f, 0.f}; }
#pragma unroll
    for (int i = 0; i < 8; ++i) { const int kk = 8 * i + kq; LAS float* d = scr + kk * 33 + 4 * nq; d[0] = tq[i].x; d[1] = tq[i].y; d[2] = tq[i].z; d[3] = tq[i].w; }
    LDS_WAIT(); asm volatile("" ::: "memory");
    const int c = lane & 7;
    f32x4 g0 = (f32x4){1.f, 1.f, 1.f, 1.f}, g1 = g0;
    if (MODE == 1) { g0 = *(const f32x4*)(kgain + k0 + 8 * c); g1 = *(const f32x4*)(kgain + k0 + 8 * c + 4); }
#pragma unroll
    for (int j = 0; j < 4; ++j) { const int n = (lane >> 3) + 8 * j; const LAS float* s = scr + (8 * c) * 33 + n;
        v4u o; o.x = pk2(s[0 * 33] * g0.x, s[1 * 33] * g0.y); o.y = pk2(s[2 * 33] * g0.z, s[3 * 33] * g0.w); o.z = pk2(s[4 * 33] * g1.x, s[5 * 33] * g1.y); o.w = pk2(s[6 * 33] * g1.z, s[7 * 33] * g1.w);
        *(v4u*)(WT + (size_t)(n0 + n) * K + k0 + 8 * c) = o; }
    LDS_WAIT(); asm volatile("" ::: "memory");
}

template <int MODE>
__device__ __forceinline__ void norm_rows(const float* xsrc, const bf16* xb, bf16* X, bf16* XN, const bf16* YB, const float* TW, const float* gain, float* out, float* RSTD, int gw, int NGW, int lane) {
    for (int row = gw; row < S; row += NGW) {
        f32x4 v[8];
        if (MODE == 0) { const f32x4* xr = (const f32x4*)(xsrc + (size_t)row * D) + lane;
#pragma unroll
            for (int j = 0; j < 8; ++j) v[j] = xr[64 * j];
        } else { const u32x2* xr = (const u32x2*)(xb + (size_t)row * D) + lane;
#pragma unroll
            for (int j = 0; j < 8; ++j) { const u32x2 r = xr[64 * j]; v[j] = (f32x4){bflo(r.x), bfhi(r.x), bflo(r.y), bfhi(r.y)}; } }
        if (MODE >= 1) {
            const float w0 = TW[2 * row], w1 = TW[2 * row + 1];
            const u32x2* ya = (const u32x2*)(YB + (size_t)(2 * row) * D) + lane; const u32x2* yb = (const u32x2*)(YB + (size_t)(2 * row + 1) * D) + lane;
#pragma unroll
            for (int j = 0; j < 8; ++j) { const u32x2 a = ya[64 * j], b = yb[64 * j];
                v[j].x += w0 * bflo(a.x) + w1 * bflo(b.x); v[j].y += w0 * bfhi(a.x) + w1 * bfhi(b.x);
                v[j].z += w0 * bflo(a.y) + w1 * bflo(b.y); v[j].w += w0 * bfhi(a.y) + w1 * bfhi(b.y); }
        }
        float ss = 0.f;
#pragma unroll
        for (int j = 0; j < 8; ++j) ss += (v[j].x * v[j].x + v[j].y * v[j].y) + (v[j].z * v[j].z + v[j].w * v[j].w);
        ss = wave_sum(ss);
        const float rstd = 1.0f / sqrtf(ss * (1.0f / D) + RMS_EPS);
        if (MODE <= 1) { u32x2* xo = (u32x2*)((MODE == 1 ? X : XN) + (size_t)row * D) + lane;
#pragma unroll
            for (int j = 0; j < 8; ++j) { u32x2 w; w.x = cvtpk(v[j].x, v[j].y); w.y = cvtpk(v[j].z, v[j].w); xo[64 * j] = w; }
            if (lane == 0) RSTD[row] = rstd; }
        const f32x4* gr = (const f32x4*)gain + lane;
        if (MODE < 0) { u32x2* o8 = (u32x2*)(XN + (size_t)row * D) + lane;
#pragma unroll
            for (int j = 0; j < 8; ++j) { const f32x4 g = gr[64 * j]; u32x2 w; w.x = cvtpk(v[j].x * rstd * g.x, v[j].y * rstd * g.y); w.y = cvtpk(v[j].z * rstd * g.z, v[j].w * rstd * g.w); o8[64 * j] = w; }
        } else if (MODE == 2) { f32x4* oo = (f32x4*)(out + (size_t)row * D) + lane;
#pragma unroll
            for (int j = 0; j < 8; ++j) { const f32x4 g = gr[64 * j]; oo[64 * j] = v[j] * rstd * g; } }
    }
}

constexpr int I_WIN = 32 * 184, I_WOUT = 32 * 64, I_W1 = 32 * 8, I_W2 = 4 * 2, I_RW = 32 * 3, I_L = I_WIN + I_WOUT + 2 * I_W1 + 2 * I_W2 + I_RW;
__device__ __forceinline__ void tr_dispatch(const Args& a, unsigned char* ws, int it, LAS float* scr, int lane) {
        const int l = it / I_L; int r = it % I_L;
        if (r < I_WIN) { tr_item<1>(a.in[2] + (size_t)l * D * DIN, nullptr, DIN, D, (bf16*)(ws + WS_WIN) + (size_t)l * NP * D, 64 * (r / 184), 32 * (r % 184), scr, lane, a.in[1] + (size_t)l * D); return; } r -= I_WIN;
        if (r < I_WOUT) { tr_item<0>(a.in[13] + (size_t)l * D * D, nullptr, D, D, (bf16*)(ws + WS_WOUT) + (size_t)l * D * D, 64 * (r / 64), 32 * (r % 64), scr, lane); return; } r -= I_WOUT;
        if (r < 2 * I_W1) { const int kv = r / I_W1, q = r % I_W1; tr_item<0>(a.in[kv ? 10 : 7] + (size_t)l * 2048 * 256, nullptr, 256, 2048, (bf16*)(ws + WS_W1T) + (size_t)(l * 2 + kv) * 256 * 2048, 64 * (q / 8), 32 * (q % 8), scr, lane); return; } r -= 2 * I_W1;
        if (r < 2 * I_W2) { const int kv = r / I_W2, q = r % I_W2; tr_item<0>(a.in[kv ? 11 : 8] + (size_t)l * 256 * 64, nullptr, 64, 256, (bf16*)(ws + WS_W2T) + (size_t)(l * 2 + kv) * 64 * 256, 64 * (q / 2), 32 * (q % 2), scr, lane); return; } r -= 2 * I_W2;
        tr_item<2>(a.in[15] + (size_t)l * D * 8, a.in[17] + (size_t)l * D * 64, 8, D, (bf16*)(ws + WS_RWT) + (size_t)l * 96 * D, 64 * (r / 3), 32 * (r % 3), scr, lane);
}

__device__ __forceinline__ void p0_prologue(const Args& a, LAS unsigned char* lds, int bid, int G, int tid, int wid, int lane) {
    unsigned char* ws = a.ws;
    LAS float* scr = (LAS float*)(lds + wid * 8448);
    const int gw = bid * NWAVES + wid, NGW = G * NWAVES;
    for (int j = gw; j < DEPTH * I_WIN; j += NGW) tr_dispatch(a, ws, (j / I_WIN) * I_L + (j % I_WIN), scr, lane);
    for (int b = bid; b < 256; b += G) {
        const int vec = b >> 5, cb = b & 31, l = vec >> 1, kv = vec & 1; const float* pos = a.in[kv ? 9 : 6] + (size_t)l * 2048; const float* w1 = a.in[kv ? 10 : 7] + (size_t)l * 2048 * 256 + 8 * cb;
        float acc[8];
#pragma unroll
        for (int i = 0; i < 8; ++i) acc[i] = 0.f;
#pragma unroll
        for (int j = 0; j < 4; ++j) { const int k = tid + 512 * j; const float pv = pos[k]; const f32x4 w0 = *(const f32x4*)(w1 + (size_t)k * 256), w1v = *(const f32x4*)(w1 + (size_t)k * 256 + 4);
            acc[0] += pv * w0.x; acc[1] += pv * w0.y; acc[2] += pv * w0.z; acc[3] += pv * w0.w; acc[4] += pv * w1v.x; acc[5] += pv * w1v.y; acc[6] += pv * w1v.z; acc[7] += pv * w1v.w; }
        LAS float* red = (LAS float*)(lds + 72 * 1024);
#pragma unroll
        for (int i = 0; i < 8; ++i) { const float sws = wave_sum(acc[i]); if (lane == 0) red[wid * 8 + i] = sws; }
        __syncthreads();
        if (tid < 8) { float sres = 0.f;
#pragma unroll
            for (int w = 0; w < 8; ++w) sres += red[w * 8 + tid];
            ((float*)(ws + WS_C1))[vec * 256 + 8 * cb + tid] = sres; }
        __syncthreads();
    }
    norm_rows<0>(a.in[0], nullptr, nullptr, (bf16*)(ws + WS_XN), nullptr, nullptr, a.in[1], nullptr, (float*)(ws + WS_RSTD), gw, NGW, lane);
}

__device__ __forceinline__ float gelu_tanh(float x) { const float u = 0.7978845608028654f * (x + 0.044715f * x * x * x); const float t = 1.0f - 2.0f / (__expf(2.0f * u) + 1.0f); return 0.5f * x * (1.0f + t); }

__device__ __forceinline__ void compress_unit(int u, int l, const bf16* PROJ, const bf16* W1T, const bf16* W2T, const float* C1, bf16* KC, bf16* VC, LAS unsigned char* lds, int wid, int lane) {
    const int kv = u >> 6, rb = u & 63, r32 = lane & 31, hi = lane >> 5;
    const int R = 32 * rb + r32, g = R >> 9, n = R & 511;
    const int colb = (kv ? C_VC : C_KC) + 64 * g;
    const bf16* w1 = W1T + (size_t)(l * 2 + kv) * 256 * 2048 + (size_t)(32 * wid + r32) * 2048 + 8 * hi;
    const bf16* arow = PROJ + colb + 8 * hi;
    f32x16 acc = {};
#pragma unroll 4
    for (int s = 0; s < 128; ++s) {
        int tok = 16 * n + (s >> 2); tok = tok > (S - 1) ? (S - 1) : tok;
        const bf16x8 av = *(const bf16x8*)(arow + (size_t)tok * PITCH + (s & 3) * 16);
        const bf16x8 bv = *(const bf16x8*)(w1 + 16 * s);
        acc = MFMA32(av, bv, acc);
    }
    LAS bf16* hid = (LAS bf16*)lds;
    const float c1 = C1[(l * 2 + kv) * 256 + 32 * wid + r32];
#pragma unroll
    for (int r = 0; r < 16; ++r) hid[crow(r, hi) * 264 + 32 * wid + r32] = f2bf16(gelu_tanh(acc[r] + c1));
    __syncthreads();
    if (wid < 2) {
        f32x16 acc2 = {};
        const bf16* w2 = W2T + (size_t)(l * 2 + kv) * 64 * 256 + (size_t)(32 * wid + r32) * 256 + 8 * hi;
#pragma unroll 4
        for (int s = 0; s < 16; ++s) {
            const bf16x8 av = *(const LAS bf16x8*)(hid + r32 * 264 + 16 * s + 8 * hi);
            const bf16x8 bv = *(const bf16x8*)(w2 + 16 * s);
            acc2 = MFMA32(av, bv, acc2);
        }
        bf16* outp = kv ? VC : KC;
#pragma unroll
        for (int r = 0; r < 16; ++r) { const int Rr = 32 * rb + crow(r, hi); outp[(size_t)((Rr >> 9) * 512 + (Rr & 511)) * 64 + 32 * wid + r32] = f2bf16(acc2[r]); }
    }
    __syncthreads();
}

__device__ __forceinline__ void cumsum_unit(int h, int l, const float* AUX, const float* fox_bf, float* CUM, LAS unsigned char* lds, int tid) {
    const float bfv = fox_bf[l * 8 + h];
    float v[16]; float run = 0.f;
#pragma unroll
    for (int i = 0; i < 16; ++i) { const int t = 16 * tid + i; const float z = AUX[(size_t)t * 64 + h] + bfv; const float lf = fminf(z, 0.f) - log1pf(__expf(-fabsf(z))); run += lf; v[i] = run; }
    LAS float* tot = (LAS float*)lds;
    tot[tid] = run; __syncthreads();
    float off = 0.f;
    for (int j = 0; j < tid; ++j) off += tot[j];
#pragma unroll
    for (int i = 0; i < 16; ++i) CUM[(size_t)h * S + 16 * tid + i] = off + v[i];
    __syncthreads();
}

__device__ __forceinline__ int koff(int key, int c) { return c * 1024 + (((key + c) & 63) << 4); }
__device__ __forceinline__ int voff(int key, int c) { return (c >> 2) * 4096 + (key >> 4) * 1024 + (key & 15) * 64 + (c & 3) * 16; }
typedef short v4i16_t __attribute__((ext_vector_type(4)));
__device__ __forceinline__ s16x4 vtr(LAS const unsigned char* p) { return __builtin_bit_cast(s16x4, __builtin_amdgcn_ds_read_tr16_b64_v4i16((LAS v4i16_t*)p)); }

template <int NDT> struct AState { float m, l; f32x16 o[NDT]; };
template <int NDT> __device__ __forceinline__ void astate_init(AState<NDT>& st) { st.m = 0.f; st.l = 0.f;
#pragma unroll
    for (int i = 0; i < NDT; ++i) st.o[i] = (f32x16){}; }

template <bool QLDS>
__device__ __forceinline__ void qk_tile(f32x16& p0, f32x16& p1, LAS const unsigned char* kt, int kchunk0, const bf16x8 (&qf)[4], LAS const unsigned char* qb, int r32, int hi) {
    bf16x8 ka[4], kb[4], q[4];
#pragma unroll
    for (int d0 = 0; d0 < 4; ++d0) {
        const int c = kchunk0 + 2 * d0 + hi;
        ka[d0] = *(const LAS bf16x8*)(kt + koff(r32, c));
        kb[d0] = *(const LAS bf16x8*)(kt + koff(r32 + 32, c));
        q[d0] = QLDS ? *(const LAS bf16x8*)(qb + d0 * 8192) : qf[d0];
    }
    __builtin_amdgcn_sched_barrier(0);
    p0 = (f32x16){}; p1 = (f32x16){};
#pragma unroll
    for (int d0 = 0; d0 < 4; ++d0) { p0 = MFMA32(ka[d0], q[d0], p0); p1 = MFMA32(kb[d0], q[d0], p1); }
    __builtin_amdgcn_sched_barrier(0);
}
__device__ __forceinline__ void pack_p(bf16x8 (&pw)[4], const f32x16& p0, const f32x16& p1) {
    u32x4 w;
    w.x = cvtpk(p0[0], p0[1]); w.y = cvtpk(p0[2], p0[3]); w.z = cvtpk(p0[4], p0[5]); w.w = cvtpk(p0[6], p0[7]); pw[0] = __builtin_bit_cast(bf16x8, w);
    w.x = cvtpk(p0[8], p0[9]); w.y = cvtpk(p0[10], p0[11]); w.z = cvtpk(p0[12], p0[13]); w.w = cvtpk(p0[14], p0[15]); pw[1] = __builtin_bit_cast(bf16x8, w);
    w.x = cvtpk(p1[0], p1[1]); w.y = cvtpk(p1[2], p1[3]); w.z = cvtpk(p1[4], p1[5]); w.w = cvtpk(p1[6], p1[7]); pw[2] = __builtin_bit_cast(bf16x8, w);
    w.x = cvtpk(p1[8], p1[9]); w.y = cvtpk(p1[10], p1[11]); w.z = cvtpk(p1[12], p1[13]); w.w = cvtpk(p1[14], p1[15]); pw[3] = __builtin_bit_cast(bf16x8, w);
}
struct VFrag { s16x4 lo[4], hh[4]; };
__device__ __forceinline__ LAS const unsigned char* vfrag_base(LAS const unsigned char* vt, int lane) { return vt + ((lane >> 4) & 1) * 32 + (lane & 3) * 8 + (4 * (lane >> 5) + ((lane & 15) >> 2)) * 64; }
__device__ __forceinline__ void vfrag_read(VFrag& f, LAS const unsigned char* vb, int dt) {
#pragma unroll
    for (int s = 0; s < 4; ++s) { f.lo[s] = vtr(vb + dt * 4096 + s * 1024); f.hh[s] = vtr(vb + dt * 4096 + s * 1024 + 512); }
}
__device__ __forceinline__ void vfrag_mma(f32x16& o, const VFrag& f, const bf16x8 (&pw)[4]) {
#pragma unroll
    for (int s = 0; s < 4; ++s) { const bf16x8 vf = (bf16x8){f.lo[s][0], f.lo[s][1], f.lo[s][2], f.lo[s][3], f.hh[s][0], f.hh[s][1], f.hh[s][2], f.hh[s][3]}; o = MFMA32(vf, pw[s], o); }
}
template <int NDT>
__device__ __forceinline__ void pv_tile_pre(f32x16 (&o)[NDT], const bf16x8 (&pw)[4], LAS const unsigned char* vb, VFrag& f0) {
    VFrag f1;
#pragma unroll
    for (int dt = 0; dt < NDT; dt += 2) {
        if (dt + 1 < NDT) vfrag_read(f1, vb, dt + 1);
        __builtin_amdgcn_sched_barrier(0);
        vfrag_mma(o[dt], f0, pw);
        if (dt + 1 < NDT) {
            if (dt + 2 < NDT) vfrag_read(f0, vb, dt + 2);
            __builtin_amdgcn_sched_barrier(0);
            vfrag_mma(o[dt + 1], f1, pw);
        }
    }
}
template <int NDT>
__device__ __forceinline__ void pv_tile(f32x16 (&o)[NDT], const bf16x8 (&pw)[4], LAS const unsigned char* vt, int lane) {
    LAS const unsigned char* vb = vfrag_base(vt, lane);
    VFrag f0; vfrag_read(f0, vb, 0);
    pv_tile_pre<NDT>(o, pw, vb, f0);
}
constexpr float SM_THR = 8.0f;
__device__ __forceinline__ float max3f(float a, float b, float c) { return __builtin_fmaxf(__builtin_fmaxf(a, b), c); }
__device__ __forceinline__ float halfmax(float m) { auto rr = __builtin_amdgcn_permlane32_swap(__float_as_uint(m), __float_as_uint(m), false, false); return fmaxf(__uint_as_float(rr[0]), __uint_as_float(rr[1])); }
__device__ __forceinline__ float halfsum(float v) { auto rr = __builtin_amdgcn_permlane32_swap(__float_as_uint(v), __float_as_uint(v), false, false); return __uint_as_float(rr[0]) + __uint_as_float(rr[1]); }
#ifndef SM_VPRE
#define SM_VPRE false
#endif
template <int NDT>
__device__ __forceinline__ void softmax_pv(AState<NDT>& st, f32x16& p0, f32x16& p1, LAS const unsigned char* vt, int lane) {
    LAS const unsigned char* vb = vfrag_base(vt, lane);
    constexpr bool VPRE = SM_VPRE;
    VFrag f0; if (VPRE) { vfrag_read(f0, vb, 0); __builtin_amdgcn_sched_barrier(0); }
    float ma = max3f(p0[0], p0[1], p0[2]), mb = max3f(p1[0], p1[1], p1[2]);
#pragma unroll
    for (int r = 3; r < 15; r += 2) { ma = max3f(ma, p0[r], p0[r + 1]); mb = max3f(mb, p1[r], p1[r + 1]); }
    float mx = max3f(ma, mb, fmaxf(p0[15], p1[15]));
    mx = halfmax(mx);
    if (__any(mx > SM_THR)) {
        const float d = fmaxf(mx, 0.f), alpha = __builtin_amdgcn_exp2f(-d); st.m += d; st.l *= alpha;
#pragma unroll
        for (int r = 0; r < 16; ++r) { p0[r] -= d; p1[r] -= d; }
#pragma unroll
        for (int dt = 0; dt < NDT; ++dt)
#pragma unroll
            for (int r = 0; r < 16; ++r) st.o[dt][r] *= alpha;
    }
    float rs = 0.f;
#pragma unroll
    for (int r = 0; r < 16; ++r) { p0[r] = __builtin_amdgcn_exp2f(p0[r]); p1[r] = __builtin_amdgcn_exp2f(p1[r]); rs += p0[r] + p1[r]; }
    st.l += rs;
    bf16x8 pw[4]; pack_p(pw, p0, p1);
    if (!VPRE) vfrag_read(f0, vb, 0);
    pv_tile_pre<NDT>(st.o, pw, vb, f0);
}
__device__ __forceinline__ void softmax_stats(float& m, float& l, const f32x16& p0, const f32x16& p1) {
    float mx = fmaxf(p0[0], p1[0]);
#pragma unroll
    for (int r = 1; r < 16; ++r) mx = fmaxf(mx, fmaxf(p0[r], p1[r]));
    mx = halfmax(mx);
    const float mn = fmaxf(m, mx), alpha = __builtin_amdgcn_exp2f(m - mn); m = mn;
    float rs = 0.f;
#pragma unroll
    for (int r = 0; r < 16; ++r) rs += __builtin_amdgcn_exp2f(p0[r] - mn) + __builtin_amdgcn_exp2f(p1[r] - mn);
    l = l * alpha + rs;
}

template <int KCH, int VCH> struct Stage { u32x4 k[KCH / 8], v[VCH / 8], x; };
template <int KCH, int VCH, bool XROW>
__device__ __forceinline__ void stage_load(Stage<KCH, VCH>& sg, const bf16* ksrc, const bf16* vsrc, const float* xsrc, size_t pitch, int key0, int tid) {
#pragma unroll
    for (int i = 0; i < KCH / 8; ++i) { const int idx = tid + 512 * i, key = idx / KCH, c = idx % KCH; sg.k[i] = *(const u32x4*)(ksrc + (size_t)(key0 + key) * pitch + 8 * c); }
#pragma unroll
    for (int i = 0; i < VCH / 8; ++i) { const int idx = tid + 512 * i, key = idx / VCH, c = idx % VCH; sg.v[i] = *(const u32x4*)(vsrc + (size_t)(key0 + key) * pitch + 8 * c); }
    if (XROW) sg.x = *(const u32x4*)(xsrc + key0 + 4 * (tid & 15));
}
template <int KCH, int VCH, bool XROW>
__device__ __forceinline__ void stage_write(const Stage<KCH, VCH>& sg, LAS unsigned char* kb, LAS unsigned char* vb, LAS unsigned char* xb, int tid) {
#pragma unroll
    for (int i = 0; i < KCH / 8; ++i) { const int idx = tid + 512 * i, key = idx / KCH, c = idx % KCH; *(LAS u32x4*)(kb + koff(key, c)) = sg.k[i]; }
#pragma unroll
    for (int i = 0; i < VCH / 8; ++i) { const int idx = tid + 512 * i, key = idx / VCH, c = idx % VCH; *(LAS u32x4*)(vb + voff(key, c)) = sg.v[i]; }
    if (XROW) { if (tid < 16) { f32x4 xv = __builtin_bit_cast(f32x4, sg.x); xv = xv * LOG2E; *(LAS f32x4*)(xb + 16 * tid) = xv; } }
}

template <int KCH, int VCH, bool XROW, int NST  , bool QLDS, class Fn>
__device__ __forceinline__ void kv_loop(Fn& fn, const bf16x8 (&qf)[4], LAS const unsigned char* qb, int kchunk0, const bf16* ksrc, const bf16* vsrc, const float* xsrc, size_t pitch, int t_lo, int t_hi,
                                        LAS unsigned char* KB, LAS unsigned char* VB, LAS unsigned char* XB, int tid, int lane) {
    constexpr int KBYTES = KCH * 1024, VBYTES = VCH * 1024;
    const int r32 = lane & 31, hi = lane >> 5, nt = t_hi - t_lo;
    if (NST == 1) {
        Stage<KCH, VCH> sg;
        stage_load<KCH, VCH, XROW>(sg, ksrc, vsrc, xsrc, pitch, 64 * t_lo, tid);
        stage_write<KCH, VCH, XROW>(sg, KB, VB, XB, tid);
        __syncthreads();
        for (int i = 0; i < nt; ++i) {
            const int b = i & 1;
            if (i + 1 < nt) stage_load<KCH, VCH, XROW>(sg, ksrc, vsrc, xsrc, pitch, 64 * (t_lo + i + 1), tid);
            if (fn.need(t_lo + i)) { f32x16 p0, p1; qk_tile<QLDS>(p0, p1, KB + b * KBYTES, kchunk0, qf, qb, r32, hi); fn.tile(t_lo + i, p0, p1, VB + b * VBYTES, XB + b * 256); }
            if (i + 1 < nt) stage_write<KCH, VCH, XROW>(sg, KB + (b ^ 1) * KBYTES, VB + (b ^ 1) * VBYTES, XB + (b ^ 1) * 256, tid);
            __syncthreads();
        }
        return;
    }
    Stage<KCH, VCH> sgA, sgB;
    stage_load<KCH, VCH, XROW>(sgA, ksrc, vsrc, xsrc, pitch, 64 * t_lo, tid);
    if (nt > 1) stage_load<KCH, VCH, XROW>(sgB, ksrc, vsrc, xsrc, pitch, 64 * (t_lo + 1), tid);
    stage_write<KCH, VCH, XROW>(sgA, KB, VB, XB, tid);
    __syncthreads();
    for (int i = 0; i < nt; i += 2) {
        if (i + 2 < nt) stage_load<KCH, VCH, XROW>(sgA, ksrc, vsrc, xsrc, pitch, 64 * (t_lo + i + 2), tid);
        if (fn.need(t_lo + i)) { f32x16 p0, p1; qk_tile<QLDS>(p0, p1, KB, kchunk0, qf, qb, r32, hi); fn.tile(t_lo + i, p0, p1, VB, XB); }
        if (i + 1 < nt) stage_write<KCH, VCH, XROW>(sgB, KB + KBYTES, VB + VBYTES, XB + 256, tid);
        __syncthreads();
        if (i + 1 >= nt) break;
        if (i + 3 < nt) stage_load<KCH, VCH, XROW>(sgB, ksrc, vsrc, xsrc, pitch, 64 * (t_lo + i + 3), tid);
        if (fn.need(t_lo + i + 1)) { f32x16 p0, p1; qk_tile<QLDS>(p0, p1, KB + KBYTES, kchunk0, qf, qb, r32, hi); fn.tile(t_lo + i + 1, p0, p1, VB + VBYTES, XB + 256); }
        if (i + 2 < nt) stage_write<KCH, VCH, XROW>(sgA, KB, VB, XB, tid);
        __syncthreads();
    }
}

#define SGB(mask, n) __builtin_amdgcn_sched_group_barrier(mask, n, 0)
template <int NDT>
__device__ __forceinline__ void sp_finish(AState<NDT>& st, f32x16& s0, f32x16& s1, bf16x8 (&pw)[4]) {
    float rs = 0.f;
#pragma unroll
    for (int r = 0; r < 16; ++r) { s0[r] = __builtin_amdgcn_exp2f(s0[r]); s1[r] = __builtin_amdgcn_exp2f(s1[r]); rs += s0[r] + s1[r]; }
    st.l += rs;
    pack_p(pw, s0, s1);
}
__device__ __forceinline__ float sp_rowmax(const f32x16& p0, const f32x16& p1) {
    float ma = max3f(p0[0], p0[1], p0[2]), mb = max3f(p1[0], p1[1], p1[2]);
#pragma unroll
    for (int r = 3; r < 15; r += 2) { ma = max3f(ma, p0[r], p0[r + 1]); mb = max3f(mb, p1[r], p1[r + 1]); }
    return max3f(ma, mb, fmaxf(p0[15], p1[15]));
}
template <int NDT>
__device__ __forceinline__ void sp_raise(AState<NDT>& st, f32x16& p0, f32x16& p1, float mx) {
    mx = halfmax(mx);
    if (__any(mx > SM_THR)) {
        const float d = fmaxf(mx, 0.f), alpha = __builtin_amdgcn_exp2f(-d); st.m += d; st.l *= alpha;
#pragma unroll
        for (int r = 0; r < 16; ++r) { p0[r] -= d; p1[r] -= d; }
#pragma unroll
        for (int dt = 0; dt < NDT; ++dt)
#pragma unroll
            for (int r = 0; r < 16; ++r) st.o[dt][r] *= alpha;
    }
}
__device__ __forceinline__ void sp_finish_part(int j, float& rs, f32x16& s0, f32x16& s1, u32x4 (&pu)[4]) {
#pragma unroll
    for (int r = 4 * j; r < 4 * j + 4; ++r) { s0[r] = __builtin_amdgcn_exp2f(s0[r]); s1[r] = __builtin_amdgcn_exp2f(s1[r]); rs += s0[r] + s1[r]; }
    const unsigned a0 = cvtpk(s0[4 * j], s0[4 * j + 1]), a1 = cvtpk(s0[4 * j + 2], s0[4 * j + 3]), b0 = cvtpk(s1[4 * j], s1[4 * j + 1]), b1 = cvtpk(s1[4 * j + 2], s1[4 * j + 3]);
    if (j & 1) { pu[j >> 1].z = a0; pu[j >> 1].w = a1; pu[2 + (j >> 1)].z = b0; pu[2 + (j >> 1)].w = b1; }
    else       { pu[j >> 1].x = a0; pu[j >> 1].y = a1; pu[2 + (j >> 1)].x = b0; pu[2 + (j >> 1)].y = b1; }
}
#define SP_STEADY(T, KBUF, XBUF, SP0, SP1, SN0, SN1)                                                                                                    \
    {   bf16x8 ka[4], kb[4], q[4];                                                                                                                      \
        _Pragma("unroll") for (int d0 = 0; d0 < 4; ++d0) { const int c = kchunk0 + 2 * d0 + hi;                                                         \
            ka[d0] = *(const LAS bf16x8*)((KBUF) + koff(r32, c)); kb[d0] = *(const LAS bf16x8*)((KBUF) + koff(r32 + 32, c));                             \
            q[d0] = QLDS ? *(const LAS bf16x8*)(qb + d0 * 8192) : qf[d0]; }                                                                             \
        LAS const unsigned char* vb = vfrag_base(VB + vp * VBYTES, lane);                                                                               \
        VFrag f0, f1; u32x4 pu[4]; float rs = 0.f;                                                                                                      \
        __builtin_amdgcn_sched_barrier(0);                                                                                                              \
        SN0 = (f32x16){}; SN1 = (f32x16){};                                                                                                             \
        _Pragma("unroll") for (int j = 0; j < 4; ++j) {                                                                                                 \
            SN0 = MFMA32(ka[j], q[j], SN0); SN1 = MFMA32(kb[j], q[j], SN1);                                                                             \
            sp_finish_part(j, rs, SP0, SP1, pu);                                                                                                        \
            if (NDT == 2 && j == 2) vfrag_read(f0, vb, 0);                                                                                              \
            if (NDT == 2 && j == 3) vfrag_read(f1, vb, 1);                                                                                              \
            __builtin_amdgcn_sched_barrier(0);                                                                                                          \
        }                                                                                                                                               \
        fn.st.l += rs;                                                                                                                                  \
        _Pragma("unroll") for (int k = 0; k < 4; ++k) pw[k] = __builtin_bit_cast(bf16x8, pu[k]);                                                        \
        float mx = NEG;                                                                                                                                 \
        _Pragma("unroll") for (int dt = 0; dt < NDT; dt += 2) {                                                                                         \
            if (NDT != 2) { vfrag_read(f0, vb, dt); vfrag_read(f1, vb, dt + 1); __builtin_amdgcn_sched_barrier(0); }                                    \
            _Pragma("unroll") for (int sx = 0; sx < 4; ++sx) {                                                                                          \
                { const bf16x8 vf = (bf16x8){f0.lo[sx][0], f0.lo[sx][1], f0.lo[sx][2], f0.lo[sx][3], f0.hh[sx][0], f0.hh[sx][1], f0.hh[sx][2], f0.hh[sx][3]}; fn.st.o[dt] = MFMA32(vf, pw[sx], fn.st.o[dt]); } \
                { const bf16x8 vf = (bf16x8){f1.lo[sx][0], f1.lo[sx][1], f1.lo[sx][2], f1.lo[sx][3], f1.hh[sx][0], f1.hh[sx][1], f1.hh[sx][2], f1.hh[sx][3]}; fn.st.o[dt + 1] = MFMA32(vf, pw[sx], fn.st.o[dt + 1]); } \
                if (dt == 0) { fn.score_part(sx, T, SN0, SN1, XBUF); mx = fn.max_part(sx, mx, SN0, SN1); }                                              \
                __builtin_amdgcn_sched_barrier(0);                                                                                                      \
            }                                                                                                                                           \
        }                                                                                                                                               \
        mx = fn.score_mask(T, mx, SN0, SN1);                                                                                                            \
        sp_raise<NDT>(fn.st, SN0, SN1, mx); }
template <int KCH, int VCH, bool XROW, bool QLDS, int NDT, class Fn>
__device__ __forceinline__ void kv_loop_sp(Fn& fn, const bf16x8 (&qf)[4], LAS const unsigned char* qb, int kchunk0, const bf16* ksrc, const bf16* vsrc, const float* xsrc, size_t pitch, int t_lo, int t_hi, int nw,
                                           LAS unsigned char* KB, LAS unsigned char* VB, LAS unsigned char* XB, int tid, int lane) {
    constexpr int KBYTES = KCH * 1024, VBYTES = VCH * 1024;
    const int r32 = lane & 31, hi = lane >> 5, nt = t_hi - t_lo;
    Stage<KCH, VCH> sg;
    stage_load<KCH, VCH, XROW>(sg, ksrc, vsrc, xsrc, pitch, 64 * t_lo, tid);
    stage_write<KCH, VCH, XROW>(sg, KB, VB, XB, tid);
    __syncthreads();
    f32x16 sa0, sa1, sb0, sb1; bf16x8 pw[4];
    int vc = 0, vp = 2, vn, i = 0;
#define SP_PRE(I)  if ((I) + 1 < nt) stage_load<KCH, VCH, XROW>(sg, ksrc, vsrc, xsrc, pitch, 64 * (t_lo + (I) + 1), tid);
#define SP_POST(I, KOFFN, XOFFN) vn = vc == 2 ? 0 : vc + 1; if ((I) + 1 < nt) stage_write<KCH, VCH, XROW>(sg, KB + (KOFFN), VB + vn * VBYTES, XB + (XOFFN), tid); __syncthreads(); vp = vc; vc = vn;
    SP_PRE(0)
    qk_tile<QLDS>(sa0, sa1, KB, kchunk0, qf, qb, r32, hi); fn.score(t_lo, sa0, sa1, XB); sp_raise<NDT>(fn.st, sa0, sa1, sp_rowmax(sa0, sa1));
    SP_POST(0, KBYTES, 256)
    i = 1;
    while (i + 1 < nw) {
        SP_PRE(i)
        SP_STEADY(t_lo + i, KB + KBYTES, XB + 256, sa0, sa1, sb0, sb1)
        SP_POST(i, 0, 0)
        SP_PRE(i + 1)
        SP_STEADY(t_lo + i + 1, KB, XB, sb0, sb1, sa0, sa1)
        SP_POST(i + 1, KBYTES, 256)
        i += 2;
    }
    if (i < nw) {
        SP_PRE(i)
        SP_STEADY(t_lo + i, KB + KBYTES, XB + 256, sa0, sa1, sb0, sb1)
        SP_POST(i, 0, 0)
        sa0 = sb0; sa1 = sb1; ++i;
    }
    if (i < nt) { SP_PRE(i) }
    sp_finish<NDT>(fn.st, sa0, sa1, pw); pv_tile<NDT>(fn.st.o, pw, VB + vp * VBYTES, lane);
    if (i < nt) { const int ko = (i & 1) ? 0 : KBYTES, xo = (i & 1) ? 0 : 256; SP_POST(i, ko, xo) ++i; }
    while (i < nt) { const int ko = (i & 1) ? 0 : KBYTES, xo = (i & 1) ? 0 : 256; SP_PRE(i) SP_POST(i, ko, xo) ++i; }
    __syncthreads();
#undef SP_PRE
#undef SP_POST
}

struct FoxFn {
    AState<2> st; float cq; int tq, tmin, tmax, lane;
    __device__ __forceinline__ bool need(int t) const { return 64 * t <= tmax; }
    __device__ __forceinline__ void score_part(int a, int t, f32x16& p0, f32x16& p1, LAS const unsigned char* xrow) {
        const int hi = lane >> 5; LAS const float* ck = (LAS const float*)xrow;
        const float cqm = cq - st.m;
        const f32x4 c0 = *(LAS const f32x4*)(ck + 8 * a + 4 * hi), c1 = *(LAS const f32x4*)(ck + 32 + 8 * a + 4 * hi);
#pragma unroll
        for (int i = 0; i < 4; ++i) { const int r = 4 * a + i; p0[r] = p0[r] * SCL2 + (cqm - c0[i]); p1[r] = p1[r] * SCL2 + (cqm - c1[i]); }
    }
    __device__ __forceinline__ float max_part(int a, float mx, const f32x16& p0, const f32x16& p1) const {
        return max3f(max3f(mx, p0[4 * a], p0[4 * a + 1]), max3f(p0[4 * a + 2], p0[4 * a + 3], p1[4 * a]), max3f(p1[4 * a + 1], p1[4 * a + 2], p1[4 * a + 3])); }
    __device__ __forceinline__ float score_mask(int t, float mx, f32x16& p0, f32x16& p1) const {
        const int hi = lane >> 5, k0 = 64 * t;
        if (k0 + 63 > tmin) {
#pragma unroll
            for (int r = 0; r < 16; ++r) { const int key = k0 + crow(r, hi); p0[r] = key <= tq ? p0[r] : NEG; p1[r] = key + 32 <= tq ? p1[r] : NEG; }
            mx = sp_rowmax(p0, p1);
        }
        return mx;
    }
    __device__ __forceinline__ void score(int t, f32x16& p0, f32x16& p1, LAS const unsigned char* xrow) {
#pragma unroll
        for (int a = 0; a < 4; ++a) score_part(a, t, p0, p1, xrow);
        score_mask(t, 0.f, p0, p1);
    }
};
__device__ __forceinline__ void fox_unit(int h, int qb, const bf16* PROJ, const float* CUM, bf16* MIX, LAS unsigned char* lds, int tid, int wid, int lane) {
    const int r32 = lane & 31, hi = lane >> 5, q0 = 256 * qb, tq = q0 + 32 * wid + r32;
    bf16x8 qf[4];
#pragma unroll
    for (int d0 = 0; d0 < 4; ++d0) qf[d0] = *(const bf16x8*)(PROJ + (size_t)tq * PITCH + C_BQ + 64 * h + 16 * d0 + 8 * hi);
    const float* cum = CUM + (size_t)h * S;
    FoxFn fn; astate_init<2>(fn.st); fn.cq = cum[tq] * LOG2E; fn.tq = tq; fn.tmin = q0 + 32 * wid; fn.tmax = q0 + 32 * wid + 31; fn.lane = lane;
    kv_loop_sp<8, 8, true, false, 2>(fn, qf, lds, 0, PROJ + C_BK + 64 * h, PROJ + C_BV + 64 * h, cum, PITCH, 0, 4 * (qb + 1), min(4 * (qb + 1), (fn.tmax >> 6) + 1), lds, lds + 16384, lds + 40960, tid, lane);
    const float lt = fn.st.l + __shfl_xor(fn.st.l, 32), inv = 1.0f / lt;
    bf16* orow = MIX + (size_t)tq * D + 512 + 64 * h;
#pragma unroll
    for (int dt = 0; dt < 2; ++dt)
#pragma unroll
        for (int a = 0; a < 4; ++a) { u32x2 w; w.x = cvtpk(fn.st.o[dt][4 * a] * inv, fn.st.o[dt][4 * a + 1] * inv); w.y = cvtpk(fn.st.o[dt][4 * a + 2] * inv, fn.st.o[dt][4 * a + 3] * inv);
            *(u32x2*)(orow + 32 * dt + 8 * a + 4 * hi) = w; }
}

struct DiffFn {
    AState<4> st; LAS const float* lut; int tq, tmin, tmax, lane;
    __device__ __forceinline__ bool need(int t) const { return 64 * t <= tmax; }
    __device__ __forceinline__ void tile(int t, f32x16& p0, f32x16& p1, LAS const unsigned char* vt, LAS const unsigned char*) {
        const int hi = lane >> 5, k0 = 64 * t;
        const float mref = st.m;
        if (k0 + 63 + 127 <= tmin) {
            const float b = lut[127] - mref;
#pragma unroll
            for (int r = 0; r < 16; ++r) { p0[r] = p0[r] * SCL2 + b; p1[r] = p1[r] * SCL2 + b; }
        } else {
#pragma unroll
            for (int r = 0; r < 16; ++r) { const int rel0 = tq - (k0 + crow(r, hi)); const float b0 = lut[min(max(rel0, 0), 127)] - mref; p0[r] = rel0 >= 0 ? p0[r] * SCL2 + b0 : NEG; }
            __builtin_amdgcn_sched_barrier(0);
#pragma unroll
            for (int r = 0; r < 16; ++r) { const int rel1 = tq - (k0 + 32 + crow(r, hi)); const float b1 = lut[min(max(rel1, 0), 127)] - mref; p1[r] = rel1 >= 0 ? p1[r] * SCL2 + b1 : NEG; }
            __builtin_amdgcn_sched_barrier(0);
        }
        softmax_pv<4>(st, p0, p1, vt, lane);
    }
};
__device__ __forceinline__ void diff_unit(int h, int qb, int l, const Args& a, const bf16* PROJ, bf16* MIX, LAS unsigned char* lds, int tid, int wid, int lane) {
    const int r32 = lane & 31, hi = lane >> 5, q0 = 128 * qb, map = wid & 1, qs = wid >> 1, tq = q0 + 32 * qs + r32;
    LAS float* lut = (LAS float*)(lds + 65536); LAS float* lamw = (LAS float*)(lds + 65536 + 512);
    const float lam_init = 0.8f - 0.6f * expf(-0.3f * (float)l);
    if (tid < 128) lut[tid] = a.in[12][t5_bucket(tid) * 20 + h] * LOG2E;
    if (wid == 0) { const float* dl = a.in[3] + (size_t)l * 256;
        const float s1 = wave_sum(dl[lane] * dl[64 + lane]), s2 = wave_sum(dl[128 + lane] * dl[192 + lane]);
        if (lane == 0) lamw[0] = expf(s1) - expf(s2) + lam_init; }
    bf16x8 qf[4];
#pragma unroll
    for (int d0 = 0; d0 < 4; ++d0) qf[d0] = *(const bf16x8*)(PROJ + (size_t)tq * PITCH + C_AQ + 128 * h + 64 * map + 16 * d0 + 8 * hi);
    DiffFn fn; astate_init<4>(fn.st); fn.lut = lut; fn.tq = tq; fn.tmin = q0 + 32 * qs; fn.tmax = q0 + 32 * qs + 31; fn.lane = lane;
    LAS unsigned char* const qlds = lds + 67584 + tid * 16;
#pragma unroll
    for (int d0 = 0; d0 < 4; ++d0) *(LAS bf16x8*)(qlds + d0 * 8192) = qf[d0];
    kv_loop<16, 16, false, 1, true>(fn, qf, qlds, 8 * map, PROJ + C_AK + 128 * h, PROJ + C_AV + 128 * h, nullptr, PITCH, 0, 2 * (qb + 1), lds, lds + 32768, lds, tid, lane);
    const float lt = fn.st.l + __shfl_xor(fn.st.l, 32), inv = 1.0f / lt;
    LAS float* ex = (LAS float*)(lds + qs * 16384);
    if (map == 1) {
#pragma unroll
        for (int dt = 0; dt < 4; ++dt)
#pragma unroll
            for (int r = 0; r < 16; ++r) ex[(32 * dt + crow(r, hi)) * 32 + r32] = fn.st.o[dt][r] * inv;
    }
    __syncthreads();
    if (map == 0) {
        const float lam = lamw[0]; float ss = 0.f;
#pragma unroll
        for (int dt = 0; dt < 4; ++dt)
#pragma unroll
            for (int r = 0; r < 16; ++r) { const float v = fn.st.o[dt][r] * inv - lam * ex[(32 * dt + crow(r, hi)) * 32 + r32]; fn.st.o[dt][r] = v; ss += v * v; }
        ss += __shfl_xor(ss, 32);
        const float rstd = (1.0f / sqrtf(ss * (1.0f / 128.0f) + RMS_EPS)) * (1.0f - lam_init);
        const float* sub = a.in[4] + (size_t)l * 128; bf16* orow = MIX + (size_t)tq * D + 128 * h;
#pragma unroll
        for (int dt = 0; dt < 4; ++dt)
#pragma unroll
            for (int q4 = 0; q4 < 4; ++q4) { const int d = 32 * dt + 8 * q4 + 4 * hi; const f32x4 g = *(const f32x4*)(sub + d);
                u32x2 w; w.x = cvtpk(fn.st.o[dt][4 * q4] * rstd * g.x, fn.st.o[dt][4 * q4 + 1] * rstd * g.y); w.y = cvtpk(fn.st.o[dt][4 * q4 + 2] * rstd * g.z, fn.st.o[dt][4 * q4 + 3] * rstd * g.w);
                *(u32x2*)(orow + d) = w; }
    }
    __syncthreads();
}

#ifndef NSA_DUP
#define NSA_DUP 0
#endif
constexpr int IMP_P = 132;
__device__ __forceinline__ float quad_sum(float v) {
    v += __builtin_bit_cast(float, __builtin_amdgcn_mov_dpp(__builtin_bit_cast(int, v), 0xB1, 0xF, 0xF, true));
    v += __builtin_bit_cast(float, __builtin_amdgcn_mov_dpp(__builtin_bit_cast(int, v), 0x4E, 0xF, 0xF, true));
    return v; }
#define LADD(p, v) (void)__hip_atomic_fetch_add((p), (v), __ATOMIC_RELAXED, __HIP_MEMORY_SCOPE_WORKGROUP)
constexpr int NSA_QF = 32768, NSA_SELW = 65536, NSA_LUT = 66560, NSA_IMP = 69632, NSA_FIN = 69632;

struct CmpStatFn {
    float m, l; int tq, lane, ncnt;
    __device__ __forceinline__ bool need(int) const { return true; }
    __device__ __forceinline__ void tile(int t, f32x16& p0, f32x16& p1, LAS const unsigned char*, LAS const unsigned char*) {
        const int hi = lane >> 5, n0 = 64 * t;
#pragma unroll
        for (int r = 0; r < 16; ++r) { const int n = n0 + crow(r, hi);
            p0[r] = (16 * n + 31 <= tq) ? p0[r] * SCL2 : NEG; p1[r] = (16 * (n + 32) + 31 <= tq) ? p1[r] * SCL2 : NEG; }
        softmax_stats(m, l, p0, p1);
    }
};
struct CmpPvFn {
    f32x16 o[2]; float m, invl; int tq, ql, lane; LAS float* imp;
    __device__ __forceinline__ bool need(int) const { return true; }
    __device__ __forceinline__ void tile(int t, f32x16& p0, f32x16& p1, LAS const unsigned char* vt, LAS const unsigned char*) {
        const int hi = lane >> 5, n0 = 64 * t;
#pragma unroll
        for (int r = 0; r < 16; ++r) { const int n = n0 + crow(r, hi);
            p0[r] = (16 * n + 31 <= tq) ? __builtin_amdgcn_exp2f(p0[r] * SCL2 - m) * invl : 0.f;
            p1[r] = (16 * (n + 32) + 31 <= tq) ? __builtin_amdgcn_exp2f(p1[r] * SCL2 - m) * invl : 0.f; }
        LAS float* row = imp + ql * IMP_P;
        const bool lead = (lane & 3) == 0;
#pragma unroll
        for (int a = 0; a < 4; ++a) {
            const int j0 = (n0 >> 2) + 2 * a + hi, j1 = j0 + 8;
            const float h0 = quad_sum(0.5f * p0[4 * a + 3]), h1 = quad_sum(0.5f * p1[4 * a + 3]);
            const float b0 = quad_sum(p0[4 * a] + p0[4 * a + 1] + p0[4 * a + 2]) + h0, b1 = quad_sum(p1[4 * a] + p1[4 * a + 1] + p1[4 * a + 2]) + h1;
            if (lead) {
                LADD(row + j0, b0);
                if (j0 + 1 < 128) LADD(row + j0 + 1, h0);
                if (j1 < 128) LADD(row + j1, b1);
                if (j1 + 1 < 128) LADD(row + j1 + 1, h1);
            }
        }
        bf16x8 pw[4]; pack_p(pw, p0, p1);
        pv_tile<2>(o, pw, vt, lane);
    }
};
struct SelFn {
    AState<2> st; LAS const float* lut; int tq, tmin, tmax, lane, mode; unsigned sw0, sw1, sw2, sw3, uw0, uw1, uw2, uw3;
    __device__ __forceinline__ unsigned pick(int j, unsigned a, unsigned b, unsigned c, unsigned d) const { const int w = j >> 5; const unsigned x = (w == 0) ? a : (w == 1) ? b : (w == 2) ? c : d; return (x >> (j & 31)) & 1u; }
    __device__ __forceinline__ bool need(int t) const { return mode == 1 || pick(t, uw0, uw1, uw2, uw3) != 0u; }
    __device__ __forceinline__ void tile(int t, f32x16& p0, f32x16& p1, LAS const unsigned char* vt, LAS const unsigned char*) {
        const int hi = lane >> 5, k0 = 64 * t;
        const bool bit = (mode == 1) || pick(t, sw0, sw1, sw2, sw3) != 0u;
        const bool far = k0 + 63 + 127 <= tmin;
        const bool wcut = (mode == 1) && (tmax - k0 >= 512);
        const float mref = st.m;
        if (far && !wcut) {
            const float b = lut[127] - mref;
#pragma unroll
            for (int r = 0; r < 16; ++r) { p0[r] = bit ? p0[r] * SCL2 + b : NEG; p1[r] = bit ? p1[r] * SCL2 + b : NEG; }
        } else {
#pragma unroll
            for (int r = 0; r < 16; ++r) { const int rel0 = tq - (k0 + crow(r, hi));
                const float b0 = lut[min(max(rel0, 0), 127)] - mref;
                const bool ok0 = bit && rel0 >= 0 && (mode == 0 || rel0 < 512);
                p0[r] = ok0 ? p0[r] * SCL2 + b0 : NEG; }
            __builtin_amdgcn_sched_barrier(0);
#pragma unroll
            for (int r = 0; r < 16; ++r) { const int rel1 = tq - (k0 + 32 + crow(r, hi));
                const float b1 = lut[min(max(rel1, 0), 127)] - mref;
                const bool ok1 = bit && rel1 >= 0 && (mode == 0 || rel1 < 512);
                p1[r] = ok1 ? p1[r] * SCL2 + b1 : NEG; }
            __builtin_amdgcn_sched_barrier(0);
        }
        softmax_pv<2>(st, p0, p1, vt, lane);
    }
};

__device__ __forceinline__ void nsa_unit(int g, int qb, const Args& a, const bf16* PROJ, const float* AUX, const bf16* KC, const bf16* VC, bf16* MIX, LAS unsigned char* lds, int tid, int wid, int lane) {
    const int r32 = lane & 31, hi = lane >> 5, q0 = 64 * qb, cur = qb, ql = 8 * wid + (r32 >> 2), hp = r32 & 3, tq = q0 + ql, head = 4 * g + hp;
    LAS float* imp = (LAS float*)(lds + NSA_IMP); LAS unsigned* selw = (LAS unsigned*)(lds + NSA_SELW); LAS float* lut = (LAS float*)(lds + NSA_LUT);
#pragma unroll
    for (int i = 0; i < 17; ++i) { const int e_ = tid + 512 * i; if (e_ < 64 * IMP_P) imp[e_] = 0.f; }
    if (tid < 256) selw[tid] = 0u;
    lut[tid] = a.in[12][t5_bucket(tid & 127) * 20 + 4 + 4 * g + (tid >> 7)] * LOG2E;
    bf16x8 qf[4];
#pragma unroll
    for (int d0 = 0; d0 < 4; ++d0) qf[d0] = *(const bf16x8*)(PROJ + (size_t)tq * PITCH + C_CQ + 64 * head + 16 * d0 + 8 * hi);
    LAS unsigned char* const qlds = lds + NSA_QF + tid * 16;
#pragma unroll
    for (int d0 = 0; d0 < 4; ++d0) *(LAS bf16x8*)(qlds + d0 * 8192) = qf[d0];
    const float* ga = AUX + (size_t)tq * 64 + 8 + head;
    const float gc = 1.0f / (1.0f + __expf(-ga[0])), gs = 1.0f / (1.0f + __expf(-ga[16])), gwn = 1.0f / (1.0f + __expf(-ga[32]));
    LAS float* finl = (LAS float*)(lds + NSA_FIN) + tid;
    f32x16 oc0, oc1;
    {
        int ncnt = (q0 + 32) / 16 + 1; ncnt = ncnt > 511 ? 511 : ncnt; const int ntc = (ncnt + 63) >> 6;
        const bf16* kc = KC + (size_t)g * 512 * 64; const bf16* vc = VC + (size_t)g * 512 * 64;
        CmpStatFn f1; f1.m = NEG; f1.l = 0.f; f1.tq = tq; f1.lane = lane; f1.ncnt = ncnt;
        kv_loop<8, 8, false, 1, true>(f1, qf, qlds, 0, kc, vc, nullptr, 64, 0, ntc, lds, lds + 16384, lds, tid, lane);
        if (NSA_DUP & 1) { f1.m = NEG; f1.l = 0.f; kv_loop<8, 8, false, 1, true>(f1, qf, qlds, 0, kc, vc, nullptr, 64, 0, ntc, lds, lds + 16384, lds, tid, lane); }
        const float lt = f1.l + __shfl_xor(f1.l, 32);
        CmpPvFn f2; f2.o[0] = (f32x16){}; f2.o[1] = (f32x16){}; f2.m = f1.m; f2.invl = (tq >= 31) ? 1.0f / lt : 0.f; f2.tq = tq; f2.ql = ql; f2.lane = lane; f2.imp = imp;
        if (NSA_DUP & 16) { kv_loop<8, 8, false, 1, true>(f2, qf, qlds, 0, kc, vc, nullptr, 64, 0, ntc, lds, lds + 16384, lds, tid, lane); f2.o[0] = (f32x16){}; f2.o[1] = (f32x16){};
#pragma unroll
            for (int i = 0; i < 17; ++i) { const int e_ = tid + 512 * i; if (e_ < 64 * IMP_P) imp[e_] = 0.f; }
            __syncthreads(); }
        kv_loop<8, 8, false, 1, true>(f2, qf, qlds, 0, kc, vc, nullptr, 64, 0, ntc, lds, lds + 16384, lds, tid, lane);
        oc0 = f2.o[0]; oc1 = f2.o[1];
    }
    for (int rep_ = 0; rep_ < ((NSA_DUP & 2) ? 2 : 1); ++rep_)
    if (cur < 16) { if (tid < 64) selw[tid * 4] = (2u << cur) - 1u; }
    else {
        const int qq = tid >> 3, sub = tid & 7;
        float val[16];
#pragma unroll
        for (int i = 0; i < 16; ++i) { const int j = 16 * sub + i; val[i] = (j >= 1 && j <= cur - 2) ? imp[qq * IMP_P + j] : -1.0f; }
        unsigned bits = 0u;
        for (int round = 0; round < 13; ++round) {
            float bv = val[0]; int bi = 0;
#pragma unroll
            for (int i = 1; i < 16; ++i) if (val[i] > bv) { bv = val[i]; bi = i; }
            int gj = 16 * sub + bi;
            { const float ov = __builtin_bit_cast(float, __builtin_amdgcn_mov_dpp(__builtin_bit_cast(int, bv), 0xB1, 0xF, 0xF, true)); const int oj = __builtin_amdgcn_mov_dpp(gj, 0xB1, 0xF, 0xF, true); if (ov > bv || (ov == bv && oj < gj)) { bv = ov; gj = oj; } }
            { const float ov = __builtin_bit_cast(float, __builtin_amdgcn_mov_dpp(__builtin_bit_cast(int, bv), 0x4E, 0xF, 0xF, true)); const int oj = __builtin_amdgcn_mov_dpp(gj, 0x4E, 0xF, 0xF, true); if (ov > bv || (ov == bv && oj < gj)) { bv = ov; gj = oj; } }
            { const float ov = __shfl_xor(bv, 4); const int oj = __shfl_xor(gj, 4); if (ov > bv || (ov == bv && oj < gj)) { bv = ov; gj = oj; } }
            const bool mine = (gj >> 4) == sub;
#pragma unroll
            for (int i = 0; i < 16; ++i) if (mine && (gj & 15) == i) { val[i] = -2.0f; bits |= 1u << i; }
        }
        if (sub == 0) bits |= 1u;
        if (((cur - 1) >> 4) == sub) bits |= 1u << ((cur - 1) & 15);
        if ((cur >> 4) == sub) bits |= 1u << (cur & 15);
        (void)__hip_atomic_fetch_or(selw + qq * 4 + (sub >> 1), bits << (16 * (sub & 1)), __ATOMIC_RELAXED, __HIP_MEMORY_SCOPE_WORKGROUP);
    }
    __syncthreads();
#pragma unroll
    for (int r = 0; r < 16; ++r) { finl[512 * r] = gc * oc0[r]; finl[512 * (16 + r)] = gc * oc1[r]; }
    SelFn fs; fs.lut = lut + hp * 128; fs.tq = tq; fs.tmin = q0 + 8 * wid; fs.tmax = q0 + 8 * wid + 7; fs.lane = lane;
    fs.sw0 = selw[ql * 4 + 0]; fs.sw1 = selw[ql * 4 + 1]; fs.sw2 = selw[ql * 4 + 2]; fs.sw3 = selw[ql * 4 + 3];
    { unsigned u0 = 0u, u1 = 0u, u2 = 0u, u3 = 0u;
#pragma unroll
      for (int i = 0; i < 8; ++i) { u0 |= selw[(8 * wid + i) * 4 + 0]; u1 |= selw[(8 * wid + i) * 4 + 1]; u2 |= selw[(8 * wid + i) * 4 + 2]; u3 |= selw[(8 * wid + i) * 4 + 3]; }
      fs.uw0 = __builtin_amdgcn_readfirstlane(u0); fs.uw1 = __builtin_amdgcn_readfirstlane(u1); fs.uw2 = __builtin_amdgcn_readfirstlane(u2); fs.uw3 = __builtin_amdgcn_readfirstlane(u3); }
    fs.mode = 0; astate_init<2>(fs.st);
    kv_loop<8, 8, false, 1, false>(fs, qf, qlds, 0, PROJ + C_KS + 64 * g, PROJ + C_VS + 64 * g, nullptr, PITCH, 0, cur + 1, lds, lds + 16384, lds, tid, lane);
    if (NSA_DUP & 4) { astate_init<2>(fs.st); kv_loop<8, 8, false, 1, false>(fs, qf, qlds, 0, PROJ + C_KS + 64 * g, PROJ + C_VS + 64 * g, nullptr, PITCH, 0, cur + 1, lds, lds + 16384, lds, tid, lane); }
    { const float lt = fs.st.l + __shfl_xor(fs.st.l, 32), sc = gs / lt;
#pragma unroll
      for (int r = 0; r < 16; ++r) { finl[512 * r] += sc * fs.st.o[0][r]; finl[512 * (16 + r)] += sc * fs.st.o[1][r]; } }
    fs.mode = 1; astate_init<2>(fs.st);
    kv_loop<8, 8, false, 1, false>(fs, qf, qlds, 0, PROJ + C_KW + 64 * g, PROJ + C_VW + 64 * g, nullptr, PITCH, cur >= 8 ? cur - 8 : 0, cur + 1, lds, lds + 16384, lds, tid, lane);
    if (NSA_DUP & 8) { astate_init<2>(fs.st); kv_loop<8, 8, false, 1, false>(fs, qf, qlds, 0, PROJ + C_KW + 64 * g, PROJ + C_VW + 64 * g, nullptr, PITCH, cur >= 8 ? cur - 8 : 0, cur + 1, lds, lds + 16384, lds, tid, lane); }
    { const float lt = fs.st.l + __shfl_xor(fs.st.l, 32), sc = gwn / lt;
#pragma unroll
      for (int r = 0; r < 16; ++r) { fs.st.o[0][r] = finl[512 * r] + sc * fs.st.o[0][r]; fs.st.o[1][r] = finl[512 * (16 + r)] + sc * fs.st.o[1][r]; } }
    bf16* orow = MIX + (size_t)tq * D + 1024 + 64 * head;
#pragma unroll
    for (int dt = 0; dt < 2; ++dt)
#pragma unroll
        for (int q4 = 0; q4 < 4; ++q4) { u32x2 w; w.x = cvtpk(fs.st.o[dt][4 * q4], fs.st.o[dt][4 * q4 + 1]); w.y = cvtpk(fs.st.o[dt][4 * q4 + 2], fs.st.o[dt][4 * q4 + 3]); *(u32x2*)(orow + 32 * dt + 8 * q4 + 4 * hi) = w; }
}

__device__ __forceinline__ int dequeue(unsigned* head, volatile LAS unsigned* slot, int tid) {
    if (tid == 0) *slot = __hip_atomic_fetch_add(head, 1u, __ATOMIC_RELAXED, __HIP_MEMORY_SCOPE_AGENT);
    __syncthreads();
    const int v = __builtin_amdgcn_readfirstlane((int)*slot);
    __syncthreads();
    return v;
}

constexpr int N2_HP = 4112, N2_PART = 66 * 1024, N2_LOG = 108 * 1024;
__device__ __forceinline__ void n2_unit(int u, int l, const Args& a, const bf16* X, bf16* XN, const bf16* RWT, unsigned* cnt, int* LIST, float* TW, LAS unsigned char* lds, int tid, int wid, int lane) {
    const float* gain = a.in[14] + (size_t)l * D;
#pragma unroll
    for (int rr = 0; rr < 2; ++rr) {
        const int lr = 2 * wid + rr, row = 16 * u + lr;
        const u32x2* xr = (const u32x2*)(X + (size_t)row * D) + lane;
        f32x4 v[8]; float ss = 0.f;
#pragma unroll
        for (int j = 0; j < 8; ++j) { const u32x2 r = xr[64 * j]; v[j] = (f32x4){bflo(r.x), bfhi(r.x), bflo(r.y), bfhi(r.y)}; ss += (v[j].x * v[j].x + v[j].y * v[j].y) + (v[j].z * v[j].z + v[j].w * v[j].w); }
        ss = wave_sum(ss);
        const float rstd = 1.0f / sqrtf(ss * (1.0f / D) + RMS_EPS);
        const f32x4* gr = (const f32x4*)gain + lane; u32x2* o8 = (u32x2*)(XN + (size_t)row * D) + lane;
#pragma unroll
        for (int j = 0; j < 8; ++j) { const f32x4 g = gr[64 * j]; u32x2 w; w.x = cvtpk(v[j].x * rstd * g.x, v[j].y * rstd * g.y); w.y = cvtpk(v[j].z * rstd * g.z, v[j].w * rstd * g.w);
            o8[64 * j] = w; *(LAS u32x2*)(lds + lr * N2_HP + (4 * lane + 256 * j) * 2) = w; }
    }
    __syncthreads();
    {
        const int fr = lane & 15, fq = lane >> 4;
        f32x4 acc[5];
#pragma unroll
        for (int nt = 0; nt < 5; ++nt) acc[nt] = (f32x4){0.f, 0.f, 0.f, 0.f};
        const bf16* rw = RWT + (size_t)l * 96 * D + (size_t)fr * D + 256 * wid + 8 * fq;
#pragma unroll
        for (int s = 0; s < 8; ++s) {
            const bf16x8 av = *(const LAS bf16x8*)(lds + fr * N2_HP + (256 * wid + 32 * s + 8 * fq) * 2);
#pragma unroll
            for (int nt = 0; nt < 5; ++nt) { const bf16x8 bv = *(const bf16x8*)(rw + (size_t)(16 * nt) * D + 32 * s); acc[nt] = MFMA16(av, bv, acc[nt]); }
        }
        LAS float* part = (LAS float*)(lds + N2_PART) + wid * 16 * 80;
#pragma unroll
        for (int nt = 0; nt < 5; ++nt)
#pragma unroll
            for (int i = 0; i < 4; ++i) part[(4 * fq + i) * 80 + 16 * nt + fr] = acc[nt][i];
    }
    __syncthreads();
    {
        LAS const float* part = (LAS const float*)(lds + N2_PART); LAS float* logit = (LAS float*)(lds + N2_LOG);
        for (int e = tid; e < 16 * 80; e += NTHR) { float s = 0.f;
#pragma unroll
            for (int w = 0; w < 8; ++w) s += part[w * 16 * 80 + e];
            logit[e] = s; }
    }
    __syncthreads();
    if (tid < 16) {
        LAS const float* lg = (LAS const float*)(lds + N2_LOG) + tid * 80;
        const float* bg = a.in[16] + l * 8; const float* be = a.in[18] + l * 64;
        float z[8]; float zm = -3.0e38f; int gi = 0;
#pragma unroll
        for (int i = 0; i < 8; ++i) { z[i] = lg[i] + bg[i]; if (z[i] > zm) { zm = z[i]; gi = i; } }
        float den = 0.f;
#pragma unroll
        for (int i = 0; i < 8; ++i) den += expf(z[i] - zm);
        const float gp = 1.0f / den;
        float e1 = -3.0e38f, e2 = -3.0e38f; int i1 = 0, i2 = 0;
#pragma unroll
        for (int i = 0; i < 8; ++i) { const float v = lg[8 + 8 * gi + i] + be[8 * gi + i];
            if (v > e1) { e2 = e1; i2 = i1; e1 = v; i1 = i; } else if (v > e2) { e2 = v; i2 = i; } }
        const float t2 = expf(e2 - e1), w1 = gp / (1.0f + t2), w2 = gp * t2 / (1.0f + t2);
        const int tok = 16 * u + tid, ea = 8 * gi + i1, eb = 8 * gi + i2;
        const unsigned pa = __hip_atomic_fetch_add(cnt + ea * 16, 1u, __ATOMIC_RELAXED, __HIP_MEMORY_SCOPE_AGENT);
        const unsigned pb = __hip_atomic_fetch_add(cnt + eb * 16, 1u, __ATOMIC_RELAXED, __HIP_MEMORY_SCOPE_AGENT);
        LIST[(size_t)ea * 16384 + pa] = 2 * tok; LIST[(size_t)eb * 16384 + pb] = 2 * tok + 1;
        TW[2 * tok] = w1; TW[2 * tok + 1] = w2;
    }
    __syncthreads();
}

constexpr int N2P_HALF = 16 * N2_HP, N2P_LOG = 2 * N2P_HALF;
__device__ __forceinline__ void n2_pair(int p, int l, const Args& a, const bf16* X, bf16* XN, const bf16* RWT, unsigned* cnt, int* LIST, float* TW, LAS unsigned char* lds, int tid, int wid, int lane) {
    const int half = wid >> 2, wl = wid & 3, u = 2 * p + half, th = tid & 255;
    LAS unsigned char* const hT = lds + half * N2P_HALF;
    const float* gain = a.in[14] + (size_t)l * D;
    {
        u32x2 raw[4][8];
#pragma unroll
        for (int rr = 0; rr < 4; ++rr) { const u32x2* xr = (const u32x2*)(X + (size_t)(16 * u + 4 * wl + rr) * D) + lane;
#pragma unroll
            for (int j = 0; j < 8; ++j) raw[rr][j] = xr[64 * j]; }
        f32x4 g[8]; { const f32x4* gr = (const f32x4*)gain + lane;
#pragma unroll
            for (int j = 0; j < 8; ++j) g[j] = gr[64 * j]; }
#pragma unroll
        for (int rr = 0; rr < 4; ++rr) {
            const int lr = 4 * wl + rr, row = 16 * u + lr;
            f32x4 v[8]; float ss = 0.f;
#pragma unroll
            for (int j = 0; j < 8; ++j) { const u32x2 r = raw[rr][j]; v[j] = (f32x4){bflo(r.x), bfhi(r.x), bflo(r.y), bfhi(r.y)}; ss += (v[j].x * v[j].x + v[j].y * v[j].y) + (v[j].z * v[j].z + v[j].w * v[j].w); }
            ss = wave_sum(ss);
            const float rstd = 1.0f / sqrtf(ss * (1.0f / D) + RMS_EPS);
            u32x2* o8 = (u32x2*)(XN + (size_t)row * D) + lane;
#pragma unroll
            for (int j = 0; j < 8; ++j) { u32x2 w; w.x = cvtpk(v[j].x * rstd * g[j].x, v[j].y * rstd * g[j].y); w.y = cvtpk(v[j].z * rstd * g[j].z, v[j].w * rstd * g[j].w);
                o8[64 * j] = w; *(LAS u32x2*)(hT + lr * N2_HP + (4 * lane + 256 * j) * 2) = w; }
        }
    }
    __syncthreads();
    const int fr = lane & 15, fq = lane >> 4;
    f32x4 acc[2][5];
#pragma unroll
    for (int hh = 0; hh < 2; ++hh)
#pragma unroll
        for (int nt = 0; nt < 5; ++nt) acc[hh][nt] = (f32x4){0.f, 0.f, 0.f, 0.f};
    {
        const bf16* rw = RWT + (size_t)l * 96 * D + (size_t)fr * D + 256 * wid + 8 * fq;
#pragma unroll 4
        for (int s = 0; s < 8; ++s) {
            const bf16x8 av0 = *(const LAS bf16x8*)(lds + fr * N2_HP + (256 * wid + 32 * s + 8 * fq) * 2);
            const bf16x8 av1 = *(const LAS bf16x8*)(lds + N2P_HALF + fr * N2_HP + (256 * wid + 32 * s + 8 * fq) * 2);
#pragma unroll
            for (int nt = 0; nt < 5; ++nt) { const bf16x8 bv = *(const bf16x8*)(rw + (size_t)(16 * nt) * D + 32 * s); acc[0][nt] = MFMA16(av0, bv, acc[0][nt]); acc[1][nt] = MFMA16(av1, bv, acc[1][nt]); }
        }
    }
    __syncthreads();
    {
        LAS float* part = (LAS float*)lds + wid * 32 * 80;
#pragma unroll
        for (int hh = 0; hh < 2; ++hh)
#pragma unroll
            for (int nt = 0; nt < 5; ++nt)
#pragma unroll
                for (int i = 0; i < 4; ++i) part[(16 * hh + 4 * fq + i) * 80 + 16 * nt + fr] = acc[hh][nt][i];
    }
    __syncthreads();
    {
        LAS const float* part = (LAS const float*)lds; LAS float* logit = (LAS float*)(lds + N2P_LOG);
        for (int e = tid; e < 32 * 80; e += NTHR) { float sres = 0.f;
#pragma unroll
            for (int w = 0; w < 8; ++w) sres += part[w * 32 * 80 + e];
            logit[e] = sres; }
    }
    __syncthreads();
    if (th < 16) {
        LAS const float* lg = (LAS const float*)(lds + N2P_LOG) + (16 * half + th) * 80;
        const float* bg = a.in[16] + l * 8; const float* be = a.in[18] + l * 64;
        float z[8]; float zm = -3.0e38f; int gi = 0;
#pragma unroll
        for (int i = 0; i < 8; ++i) { z[i] = lg[i] + bg[i]; if (z[i] > zm) { zm = z[i]; gi = i; } }
        float den = 0.f;
#pragma unroll
        for (int i = 0; i < 8; ++i) den += expf(z[i] - zm);
        const float gp = 1.0f / den;
        float e1 = -3.0e38f, e2 = -3.0e38f; int i1 = 0, i2 = 0;
#pragma unroll
        for (int i = 0; i < 8; ++i) { const float v = lg[8 + 8 * gi + i] + be[8 * gi + i];
            if (v > e1) { e2 = e1; i2 = i1; e1 = v; i1 = i; } else if (v > e2) { e2 = v; i2 = i; } }
        const float t2 = expf(e2 - e1), w1 = gp / (1.0f + t2), w2 = gp * t2 / (1.0f + t2);
        const int tok = 16 * u + th, ea = 8 * gi + i1, eb = 8 * gi + i2;
        const unsigned pa = __hip_atomic_fetch_add(cnt + ea * 16, 1u, __ATOMIC_RELAXED, __HIP_MEMORY_SCOPE_AGENT);
        const unsigned pb = __hip_atomic_fetch_add(cnt + eb * 16, 1u, __ATOMIC_RELAXED, __HIP_MEMORY_SCOPE_AGENT);
        LIST[(size_t)ea * 16384 + pa] = 2 * tok; LIST[(size_t)eb * 16384 + pb] = 2 * tok + 1;
        TW[2 * tok] = w1; TW[2 * tok + 1] = w2;
    }
    __syncthreads();
}

constexpr int MO_B = 65536, MO_BBUF = 16384, MO_A = 98304, MO_APITCH = 2176, MO_ABUF = 4 * MO_APITCH, MO_ROW = MO_A + 2 * MO_ABUF, MO_PRE = MO_ROW + 512;
constexpr int MO_STG = 117760;
static_assert(MO_PRE + 272 <= MO_STG && MO_STG + 8 * 4096 <= MISC_OFF, "MoE LDS map");
__device__ __forceinline__ int mo_aoff(int row, int c) { return c * MO_APITCH + ((row + 2 * c) << 4); }
__device__ __forceinline__ int mo_hoff(int row, int c) { return c * 2048 + (row << 4); }

struct MoBStage { f32x4 v[4]; };
__device__ __forceinline__ void mo_gl16(f32x4& d, const float* p) { asm volatile("global_load_dwordx4 %0, %1, off" : "=v"(d) : "v"(p) : "memory"); }
__device__ __forceinline__ void mo_gl16u(u32x4& d, const bf16* p) { asm volatile("global_load_dwordx4 %0, %1, off" : "=v"(d) : "v"(p) : "memory"); }
__device__ __forceinline__ void mo_bload(MoBStage& sg, const float* src0, const float* src1, size_t ld, int k0, int tid) {
    const int n4 = tid & 63, kg = tid >> 6;
    const float* p = (n4 < 32 ? src0 + 4 * n4 : src1 + 4 * (n4 - 32)) + (size_t)(k0 + 4 * kg) * ld;
    mo_gl16(sg.v[0], p); mo_gl16(sg.v[1], p + ld); mo_gl16(sg.v[2], p + 2 * ld); mo_gl16(sg.v[3], p + 3 * ld);
}
#define MO_WAIT5(N, SB, SA) asm volatile("s_waitcnt vmcnt(" #N ")" : "+v"(SB.v[0]), "+v"(SB.v[1]), "+v"(SB.v[2]), "+v"(SB.v[3]), "+v"(SA) :: "memory")
#define MO_WAIT4(N, SB) asm volatile("s_waitcnt vmcnt(" #N ")" : "+v"(SB.v[0]), "+v"(SB.v[1]), "+v"(SB.v[2]), "+v"(SB.v[3]) :: "memory")
__device__ __forceinline__ void mo_bwrite(const MoBStage& sg, LAS unsigned char* bb, int tid) {
    const int n4 = tid & 63, kg = tid >> 6;
#pragma unroll
    for (int i = 0; i < 4; ++i) { u32x2 w; w.x = cvtpk(sg.v[0][i], sg.v[1][i]); w.y = cvtpk(sg.v[2][i], sg.v[3][i]);
        *(LAS u32x2*)(bb + (kg >> 1) * 4096 + (32 * (n4 >> 3) + 8 * i + (n4 & 7)) * 16 + 8 * (kg & 1)) = w; }
}
#define MO_READ(AP, ASTEP, BP, B1OFF) bf16x8 fb0_[2], fb1_[2], fa_[2][2]; \
    _Pragma("unroll") for (int s_ = 0; s_ < 2; ++s_) { fb0_[s_] = *(const LAS bf16x8*)((BP) + s_ * 8192); fb1_[s_] = *(const LAS bf16x8*)((BP) + s_ * 8192 + (B1OFF)); \
        _Pragma("unroll") for (int mt = 0; mt < 2; ++mt) fa_[s_][mt] = *(const LAS bf16x8*)((AP) + s_ * (ASTEP) + mt * 512); } \
    __builtin_amdgcn_sched_barrier(0)
#define MO_MMA(ACC0, ACC1) do { __builtin_amdgcn_sched_barrier(0); _Pragma("unroll") for (int s_ = 0; s_ < 2; ++s_) _Pragma("unroll") for (int mt = 0; mt < 2; ++mt) { \
        ACC0[mt] = MFMA32(fa_[s_][mt], fb0_[s_], ACC0[mt]); ACC1[mt] = MFMA32(fa_[s_][mt], fb1_[s_], ACC1[mt]); } __builtin_amdgcn_sched_barrier(0); } while (0)

__device__ __forceinline__ void moe_unit(int e, int c0, int nrows, const bf16* XN, const int* LIST, const float* Wg, const float* Wu, const float* Wd, bf16* YB, LAS unsigned char* lds, int tid, int wid, int lane) {
    const int r32 = lane & 31, hi = lane >> 5, wn = wid & 3, wm = wid >> 2;
    LAS int* rowid = (LAS int*)(lds + MO_ROW);
    if (tid < 128) rowid[tid] = (tid < nrows) ? LIST[(size_t)e * 16384 + c0 + tid] : -1;
    __syncthreads();
    const float* wg = Wg + (size_t)e * D * 256; const float* wu = Wu + (size_t)e * D * 256; const float* wd = Wd + (size_t)e * 256 * D;
    f32x16 acc0[2], acc1[2];
#define MO_ZERO() do { acc0[0] = (f32x16){}; acc0[1] = (f32x16){}; acc1[0] = (f32x16){}; acc1[1] = (f32x16){}; } while (0)
    MO_ZERO();
    MoBStage s0, s1, s2, s3; u32x4 a0, a1, a2, a3;
    {
        const int arow = tid >> 2, ac = tid & 3; const int rid = rowid[arow]; const bf16* asrc = XN + (size_t)((rid < 0 ? 0 : rid) >> 1) * D + 8 * ac;
        LAS unsigned char* const awr = lds + MO_A + mo_aoff(arow, ac);
        LAS const unsigned char* const ard = lds + MO_A + mo_aoff(64 * wm + r32, hi);
        LAS const unsigned char* const brd = lds + MO_B + hi * 4096 + (32 * wn + r32) * 16;
#define G1_LOAD(SB, SA, t) do { const int t_ = (t); mo_gl16u(SA, asrc + 32 * (t_ & 63)); mo_bload(SB, wg + 128 * (t_ >> 6), wu + 128 * (t_ >> 6), 256, 32 * (t_ & 63), tid); } while (0)
#define G1_WRITE(SB, SA, b) do { *(LAS u32x4*)(awr + (b) * MO_ABUF) = SA; mo_bwrite(SB, lds + MO_B + (b) * MO_BBUF, tid); } while (0)
#define G1_STEP(t, b, SBL, SAL, SBW, SAW) do { const int tt_ = (t); \
            MO_READ(ard + (b) * MO_ABUF, 2 * MO_APITCH + 64, brd + (b) * MO_BBUF, 2048);     \
            G1_LOAD(SBL, SAL, (tt_ + 4 < 128 ? tt_ + 4 : 127));     \
            __builtin_amdgcn_sched_barrier(0); \
            MO_WAIT5(15, SBW, SAW); \
            if (tt_ + 1 < 128) G1_WRITE(SBW, SAW, (b) ^ 1); \
            MO_MMA(acc0, acc1); \
            if ((tt_ & 63) == 63) {     \
                const int col_ = 128 * (tt_ >> 6) + 32 * wn + 4 * (r32 & 7) + (r32 >> 3), cch_ = col_ >> 3; \
                _Pragma("unroll") for (int mt = 0; mt < 2; ++mt) _Pragma("unroll") for (int r = 0; r < 16; ++r) { const float gt = acc0[mt][r], up = acc1[mt][r]; const float hv = gt / (1.0f + __expf(-gt)) * up; \
                    *(LAS unsigned short*)(lds + mo_hoff(64 * wm + 32 * mt + crow(r, hi), cch_) + (col_ & 7) * 2) = f2bf16(hv); } \
                MO_ZERO(); } \
            __syncthreads(); } while (0)
        G1_LOAD(s0, a0, 0); G1_LOAD(s1, a1, 1); G1_LOAD(s2, a2, 2); G1_LOAD(s3, a3, 3);
        MO_WAIT5(15, s0, a0);
        G1_WRITE(s0, a0, 0);
        __syncthreads();
        for (int t = 0; t < 128; t += 4) {
            G1_STEP(t, 0, s0, a0, s1, a1);
            G1_STEP(t + 1, 1, s1, a1, s2, a2);
            G1_STEP(t + 2, 0, s2, a2, s3, a3);
            G1_STEP(t + 3, 1, s3, a3, s0, a0);
        }
        asm volatile("s_waitcnt vmcnt(0)" : "+v"(s0.v[0]), "+v"(s0.v[1]), "+v"(s0.v[2]), "+v"(s0.v[3]), "+v"(s1.v[0]), "+v"(s1.v[1]), "+v"(s1.v[2]), "+v"(s1.v[3]), "+v"(s2.v[0]), "+v"(s2.v[1]), "+v"(s2.v[2]), "+v"(s2.v[3]),
                     "+v"(s3.v[0]), "+v"(s3.v[1]), "+v"(s3.v[2]), "+v"(s3.v[3]), "+v"(a0), "+v"(a1), "+v"(a2), "+v"(a3) :: "memory");
#undef G1_LOAD
#undef G1_WRITE
#undef G1_STEP
    }
    {
        LAS const unsigned char* const hrd = lds + mo_hoff(64 * wm + r32, hi);
        LAS const unsigned char* const brd = lds + MO_B + hi * 4096 + (64 * wn + r32) * 16;
#define G2_LOAD(SB, t) do { const int t_ = (t); mo_bload(SB, wd + 256 * (t_ >> 3), wd + 256 * (t_ >> 3) + 128, D, 32 * (t_ & 7), tid); } while (0)
#define G2_STEP(t, b, SBL, SBW) do { const int tt_ = (t); \
            MO_READ(hrd + (tt_ & 7) * 8192, 4096, brd + (b) * MO_BBUF, 512); \
            G2_LOAD(SBL, (tt_ + 4 < 64 ? tt_ + 4 : 63)); \
            __builtin_amdgcn_sched_barrier(0); \
            MO_WAIT4(12, SBW); \
            if (tt_ + 1 < 64) mo_bwrite(SBW, lds + MO_B + ((b) ^ 1) * MO_BBUF, tid); \
            MO_MMA(acc0, acc1); \
            if ((tt_ & 7) == 7) {     \
                LAS unsigned char* const stg_ = lds + MO_STG + wid * 4096; const int cidx_ = 4 * (r32 & 7) + (r32 >> 3); \
                _Pragma("unroll") for (int mt = 0; mt < 2; ++mt) { \
                    _Pragma("unroll") for (int r = 0; r < 16; ++r) { const int row_ = crow(r, hi); \
                        *(LAS unsigned short*)(stg_ + row_ * 128 + cidx_ * 2) = f2bf16(acc0[mt][r]); *(LAS unsigned short*)(stg_ + row_ * 128 + (cidx_ + 32) * 2) = f2bf16(acc1[mt][r]); } \
                    _Pragma("unroll") for (int k = 0; k < 4; ++k) { const int idx_ = lane + 64 * k, row_ = idx_ >> 3, ch_ = idx_ & 7; \
                        const u32x4 v_ = *(const LAS u32x4*)(stg_ + row_ * 128 + ch_ * 16); const int rr = rowid[64 * wm + 32 * mt + row_]; \
                        if (rr >= 0) *(u32x4*)(YB + (size_t)rr * D + 256 * (tt_ >> 3) + 64 * wn + 8 * ch_) = v_; } } \
                MO_ZERO(); } \
            __syncthreads(); } while (0)
        G2_LOAD(s0, 0); G2_LOAD(s1, 1); G2_LOAD(s2, 2); G2_LOAD(s3, 3);
        MO_WAIT4(12, s0);
        mo_bwrite(s0, lds + MO_B, tid);
        __syncthreads();
        for (int t = 0; t < 64; t += 4) {
            G2_STEP(t, 0, s0, s1);
            G2_STEP(t + 1, 1, s1, s2);
            G2_STEP(t + 2, 0, s2, s3);
            G2_STEP(t + 3, 1, s3, s0);
        }
        asm volatile("s_waitcnt vmcnt(0)" : "+v"(s0.v[0]), "+v"(s0.v[1]), "+v"(s0.v[2]), "+v"(s0.v[3]), "+v"(s1.v[0]), "+v"(s1.v[1]), "+v"(s1.v[2]), "+v"(s1.v[3]), "+v"(s2.v[0]), "+v"(s2.v[1]), "+v"(s2.v[2]), "+v"(s2.v[3]),
                     "+v"(s3.v[0]), "+v"(s3.v[1]), "+v"(s3.v[2]), "+v"(s3.v[3]) :: "memory");
#undef G2_LOAD
#undef G2_STEP
    }
#undef MO_ZERO
}

constexpr int N_PHASES = 1 + 7 * DEPTH;
#ifndef PH_MASK
#define PH_MASK 0xFFFF
#endif
#define PHON(k) (((PH_MASK) >> (k)) & 1)
#ifndef DUP_MASK
#define DUP_MASK 0
#endif
#define DUPON(k) ((((DUP_MASK) >> (k)) & 1) && (l == 0 || (((0x3FE) >> (k)) & 1)))
#ifndef MK_ONE_LAUNCH
#define MK_ONE_LAUNCH 1
#endif

__global__ void __launch_bounds__(NTHR, 2) fwd_kernel(Args args) {
    extern __shared__ __attribute__((aligned(16))) unsigned char lds_raw[];
    LAS unsigned char* lds = (LAS unsigned char*)lds_raw;
    volatile LAS unsigned* MISC = (volatile LAS unsigned*)(lds + MISC_OFF);
    const int wid = __builtin_amdgcn_readfirstlane(threadIdx.x >> 6);
    const int G = gridDim.x, bid = blockIdx.x;
    unsigned char* ws = args.ws;
    unsigned* const ctl0 = (unsigned*)(ws + WS_CTL);
    if (threadIdx.x < 64) MISC[threadIdx.x] = 0u;
    __syncthreads();
    const int lo = args.ph_lo, hi_ph = args.ph_hi;
    XcdBarrier bar; bar.bar = ctl0 + CW_BAR; bar.x = 0; bar.st = MISC + 8; bar.w0 = 0;
    if (hi_ph - lo > 1) bar = xcd_barrier_post(ctl0 + CW_BAR, MISC + 8);
#define IN(k) (lo <= (k) && (k) < hi_ph)
#define FRESH() int wid_ = wid; asm volatile("" : "+s"(wid_)); int lane_; asm volatile("v_mbcnt_lo_u32_b32 %0, -1, 0\n\tv_mbcnt_hi_u32_b32 %0, -1, %0" : "=v"(lane_)); const int tid_ = wid_ * 64 + lane_; (void)tid_
#define SEAM(k) do { if (IN(k) && IN((k) + 1)) xcd_barrier(bar); } while (0)

    const int NGW = G * NWAVES;

    if (PHON(0) && IN(0)) { FRESH(); p0_prologue(args, lds, bid, G, tid_, wid_, lane_); if ((DUP_MASK) & 1) p0_prologue(args, lds, bid, G, tid_, wid_, lane_); }
    SEAM(0);

#pragma unroll 1
    for (int lraw = 0; lraw < DEPTH; ++lraw) {
        int l = lraw; asm volatile("" : "+s"(l));
        GAS unsigned char* wsg = (GAS unsigned char*)ws; asm volatile("" : "+s"(wsg)); unsigned char* const wsl = (unsigned char*)wsg;
        unsigned* const ctl = (unsigned*)(wsl + WS_CTL);
        bf16* const WIN = (bf16*)(wsl + WS_WIN); bf16* const WOUT = (bf16*)(wsl + WS_WOUT); bf16* const W1T = (bf16*)(wsl + WS_W1T); bf16* const W2T = (bf16*)(wsl + WS_W2T); bf16* const RWT = (bf16*)(wsl + WS_RWT);
        float* const C1 = (float*)(wsl + WS_C1); bf16* const X = (bf16*)(wsl + WS_X); bf16* const XN = (bf16*)(wsl + WS_XN); bf16* const PROJ = (bf16*)(wsl + WS_PROJ); float* const AUX = (float*)(wsl + WS_AUX);
        float* const CUM = (float*)(wsl + WS_CUM); bf16* const KC = (bf16*)(wsl + WS_KC); bf16* const VC = (bf16*)(wsl + WS_VC); bf16* const MIX = (bf16*)(wsl + WS_MIX); bf16* const YB = (bf16*)(wsl + WS_YB);
        int* const LIST = (int*)(wsl + WS_LIST); float* const TW = (float*)(wsl + WS_TW);
        const int pb = 1 + 7 * l;
        if (PHON(1) && IN(pb)) {
            pg8::Gemm g{l == 0 ? XN : X, WIN + (size_t)l * NP * D, S, NP, D}; pg8::StaticOrder so; so.init(S, NP, G, bid);
            pg8::EpiProj E{PROJ, AUX, (const float*)(wsl + WS_RSTD)};
            pg8::gemm_phase<pg8::EpiProj, pg8::StaticOrder, true, true>(lds, g, so, E, wid);
            {
                const int ntile = (S / 256) * (NP / 256), rmax = (ntile + G - 1) / G, mine = (ntile - bid + G - 1) / G, nh = G * rmax - ntile;
                if (nh == 0 || mine < rmax) {
                    FRESH(); __syncthreads();
                    LAS float* const scr = (LAS float*)(lds + wid_ * 8448);
                    const int hidx = nh == 0 ? bid : bid - (G - nh), nhw = (nh == 0 ? G : nh) * NWAVES;
                    for (int j = hidx * NWAVES + wid_; j < I_L - I_WIN; j += nhw) tr_dispatch(args, (unsigned char*)wsl, l * I_L + I_WIN + j, scr, lane_);
                }
            }
            if (DUPON(1)) pg8::gemm_phase<pg8::EpiProj, pg8::StaticOrder, true, true>(lds, g, so, E, wid);
        }
        SEAM(pb);
        if (IN(pb + 2)) {
            const int x = bid & 7;
#define QHEAD(q) (ctl + CW_Q + (((l * 6 + (q)) * 8 + x) * 64))
            if (PHON(2)) { FRESH(); unsigned* const pdone = ctl + CW_PD + l * 64;
                for (;;) { const int i = dequeue(ctl + CW_PQ + l * 64, MISC + 19, tid_); if (i >= 136) break;
                    if (i < 8) cumsum_unit(i, l, AUX, args.in[5], CUM, lds, tid_); else compress_unit(i - 8, l, PROJ, W1T, W2T, C1, KC, VC, lds, wid_, lane_);
                    asm volatile("s_waitcnt vmcnt(0)" ::: "memory");
                    __syncthreads();
                    if (wid_ == 0) { __builtin_amdgcn_fence(__ATOMIC_RELEASE, "agent"); asm volatile("s_waitcnt vmcnt(0)" ::: "memory"); (void)__hip_atomic_fetch_add(pdone, 1u, __ATOMIC_RELAXED, __HIP_MEMORY_SCOPE_AGENT); }
                } }
            if (PHON(4)) { FRESH(); for (;;) { const int i = dequeue(QHEAD(1), MISC + 17, tid_); if (i >= 32) break; diff_unit(x & 3, 63 - 2 * i - (x >> 2), l, args, PROJ, MIX, lds, tid_, wid_, lane_); }
                if (DUPON(4)) for (;;) { const int i = dequeue(QHEAD(4), MISC + 17, tid_); if (i >= 32) break; diff_unit(x & 3, 63 - 2 * i - (x >> 2), l, args, PROJ, MIX, lds, tid_, wid_, lane_); } }
            if (PHON(2)) { FRESH();
                if (tid_ == 0) { unsigned* const pdone = ctl + CW_PD + l * 64; unsigned sp = 0;
                    while (__hip_atomic_load(pdone, __ATOMIC_RELAXED, __HIP_MEMORY_SCOPE_AGENT) < 136u * 64u) { __builtin_amdgcn_s_sleep(2); if (++sp > (1u << 20)) break; }
                    __builtin_amdgcn_fence(__ATOMIC_ACQUIRE, "agent"); asm volatile("s_waitcnt vmcnt(0)" ::: "memory"); }
                __syncthreads(); }
            if (PHON(3)) { FRESH(); for (;;) { const int i = dequeue(QHEAD(0), MISC + 16, tid_); if (i >= 32) break; fox_unit(x, 31 - i, PROJ, CUM, MIX, lds, tid_, wid_, lane_); }
                if (DUPON(3)) for (;;) { const int i = dequeue(QHEAD(3), MISC + 16, tid_); if (i >= 32) break; fox_unit(x, 31 - i, PROJ, CUM, MIX, lds, tid_, wid_, lane_); } }
            if (PHON(5)) { FRESH(); for (;;) { const int i = dequeue(QHEAD(2), MISC + 18, tid_); if (i >= 64) break; nsa_unit(x & 3, 127 - 2 * i - (x >> 2), args, PROJ, AUX, KC, VC, MIX, lds, tid_, wid_, lane_); }
                if (DUPON(5)) for (;;) { const int i = dequeue(QHEAD(5), MISC + 18, tid_); if (i >= 64) break; nsa_unit(x & 3, 127 - 2 * i - (x >> 2), args, PROJ, AUX, KC, VC, MIX, lds, tid_, wid_, lane_); } }
#undef QHEAD
        }
        SEAM(pb + 2);
        if (PHON(6) && IN(pb + 3)) {
            pg8::Gemm g{MIX, WOUT + (size_t)l * D * D, S, D, D}; pg8::StaticOrder so; so.init(S, D, G, bid);
            pg8::EpiRes E{l == 0 ? args.in[0] : nullptr, X, X};
            pg8::gemm_phase<pg8::EpiRes, pg8::StaticOrder, true, true>(lds, g, so, E, wid);
            if (DUPON(6)) { pg8::EpiRes E2{nullptr, X, YB}; pg8::gemm_phase<pg8::EpiRes, pg8::StaticOrder, true, true>(lds, g, so, E2, wid); }
        }
        SEAM(pb + 3);
        if (PHON(7) && IN(pb + 4)) {
            FRESH();
            for (int p = bid; p < S / 32; p += G) n2_pair(p, l, args, X, XN, RWT, ctl + CW_CNT + l * 1024, LIST, TW, lds, tid_, wid_, lane_);
            if (DUPON(7)) for (int u = bid; u < S / 16; u += G) n2_unit(u, l, args, X, XN, RWT, ctl + CW_CNT + (4 + l) * 1024, (int*)MIX, (float*)(MIX + 8 * 1024 * 1024), lds, tid_, wid_, lane_);
        }
        SEAM(pb + 4);
        if (PHON(8) && IN(pb + 5)) {
            FRESH();
            LAS int* pre = (LAS int*)(lds + MO_PRE);
            if (tid_ < 64) pre[tid_] = ((int)__hip_atomic_load(ctl + CW_CNT + l * 1024 + tid_ * 16, __ATOMIC_RELAXED, __HIP_MEMORY_SCOPE_AGENT) + 127) >> 7;
            __syncthreads();
            const int x = bid & 7, per = G >> 3;
            for (int rep = 0; rep < (DUPON(8) ? 2 : 1); ++rep)
            for (int slot = bid >> 3; ; slot += per) {
                int e = -1, c = 0, acc = 0;
                for (int k = 0; k < 8; ++k) { const int ee = x + 8 * k, n = pre[ee]; if (e < 0 && slot < acc + n) { e = ee; c = slot - acc; } acc += n; }
                if (e < 0) break;
                e = __builtin_amdgcn_readfirstlane(e); c = __builtin_amdgcn_readfirstlane(c);
                const int c0 = c * 128; const int cnt_e = (int)__hip_atomic_load(ctl + CW_CNT + l * 1024 + e * 16, __ATOMIC_RELAXED, __HIP_MEMORY_SCOPE_AGENT);
                const int nrows = (cnt_e - c0) < 128 ? (cnt_e - c0) : 128;
                moe_unit(e, c0, nrows, XN, LIST, args.in[19] + (size_t)l * 64 * D * 256, args.in[20] + (size_t)l * 64 * D * 256, args.in[21] + (size_t)l * 64 * 256 * D, YB, lds, tid_, wid_, lane_);
            }
        }
        SEAM(pb + 5);
        if (PHON(9) && IN(pb + 6)) {
            FRESH(); const int gw_ = bid * NWAVES + wid_;
            if (l + 1 < DEPTH) {
                norm_rows<1>(nullptr, X, X, XN, YB, TW, args.in[1] + (size_t)(l + 1) * D, nullptr, (float*)(wsl + WS_RSTD), gw_, NGW, lane_);
                if (DUPON(9)) norm_rows<1>(nullptr, X, PROJ, MIX, YB, TW, args.in[1] + (size_t)(l + 1) * D, nullptr, (float*)MIX, gw_, NGW, lane_);
            } else norm_rows<2>(nullptr, X, nullptr, nullptr, YB, TW, args.in[22], args.out, nullptr, gw_, NGW, lane_);
        }
        if (l + 1 < DEPTH) SEAM(pb + 6);
    }
#undef IN
#undef SEAM
}

extern "C" void kernel_launch(void* const* d_in, const int* in_sizes, int n_in, void* d_out, int out_size, void* d_ws, size_t ws_size, hipStream_t stream) {
    static int grid = 0;
    if (grid == 0) {
        if (n_in != 23 || ws_size < WS_END || out_size != S * D) { fprintf(stderr, "kernel_launch: unexpected problem (n_in %d, out %d, ws %zu)\n", n_in, out_size, ws_size); grid = -1; return; }
        int dev = 0, cus = 0, per_cu = 0;
        if (hipGetDevice(&dev) != hipSuccess || hipDeviceGetAttribute(&cus, hipDeviceAttributeMultiprocessorCount, dev) != hipSuccess) { grid = -1; return; }
        if (hipFuncSetAttribute((const void*)fwd_kernel, hipFuncAttributeMaxDynamicSharedMemorySize, LDS_BYTES) != hipSuccess) { fprintf(stderr, "kernel_launch: hipFuncSetAttribute failed\n"); grid = -1; return; }
        if (hipOccupancyMaxActiveBlocksPerMultiprocessor(&per_cu, (const void*)fwd_kernel, NTHR, LDS_BYTES) != hipSuccess || per_cu < 1) fprintf(stderr, "kernel_launch: occupancy query says %d blocks per CU\n", per_cu);
        (void)hipGetLastError();
        grid = cus;
        if (grid < 136) { fprintf(stderr, "kernel_launch: too few CUs (%d)\n", grid); }
    }
    if (grid < 0) return;
    if (hipMemsetAsync((char*)d_ws + WS_CTL, 0, CTL_ZERO_BYTES, stream) != hipSuccess) { fprintf(stderr, "kernel_launch: memset failed\n"); return; }
    Args a{};
    for (int i = 0; i < 23; ++i) a.in[i] = (const float*)d_in[i];
    a.out = (float*)d_out; a.ws = (unsigned char*)d_ws;
#if MK_ONE_LAUNCH
    a.ph_lo = 0; a.ph_hi = N_PHASES;
    hipLaunchKernelGGL(fwd_kernel, dim3(grid), dim3(NTHR), LDS_BYTES, stream, a);
#else
    for (int p = 0; p < N_PHASES; ++p) { a.ph_lo = p; a.ph_hi = p + 1; hipLaunchKernelGGL(fwd_kernel, dim3(grid), dim3(NTHR), LDS_BYTES, stream, a); }
#endif
    const hipError_t le = hipPeekAtLastError();
    if (le != hipSuccess) fprintf(stderr, "kernel_launch: launch failed: %s\n", hipGetErrorName(le));
}
```

```cpp
#include <hip/hip_runtime.h>
#include <cstdio>
#include <cstdint>
#include <cmath>
namespace pg8 {
#define PG8_LAS __attribute__((address_space(3)))
typedef unsigned short bf16_t;
typedef short bf16x8 __attribute__((ext_vector_type(8)));
typedef float f32x4 __attribute__((ext_vector_type(4)));
typedef unsigned u32x4 __attribute__((ext_vector_type(4)));
constexpr int BM = 256, BK = 64, HALF = 128, HTB = HALF * BK * 2  , STAGE_BYTES = 8 * HTB, NXCD = 8, WGM = 8;

__host__ __device__ __forceinline__ int lds_byte(int r, int c) { const int st = (r >> 4) * 2 + (c >> 5), rr = r & 15, cc = c & 31, ob = rr * 64 + cc * 2; return st * 1024 + (ob ^ (((ob >> 9) & 1) << 5)); }
__host__ __device__ __forceinline__ void stage_rc(int b, int& R, int& C) { const int st = b / 1024, sb = b % 1024, swz = sb ^ (((sb >> 9) & 1) << 5); R = (st >> 1) * 16 + swz / 64; C = (st & 1) * 32 + (swz % 64) / 2; }
__host__ __device__ __forceinline__ int perm32(int rho) { const int n = rho >> 4, i = rho & 15; return 8 * (i >> 2) + 4 * n + (i & 3); }

struct Unit { int pm, pn; };
struct Gemm { const bf16_t* A; const bf16_t* Bt; int M, N, K; };

struct StaticOrder {
    int nM, nN, nwg, G, c;
    __host__ __device__ void init(int M, int N, int G_, int c_) { nM = M / BM; nN = N / BM; nwg = nM * nN; G = G_; c = c_; }
    __host__ __device__ bool next(int i, Unit& u) const {
        const long L = (long)i * G + c; if (L >= nwg) return false;
        int wgid = (int)L; { const int q = nwg / NXCD, r = nwg % NXCD, xcd = wgid % NXCD, off = wgid / NXCD; wgid = (xcd < r ? xcd * (q + 1) : r * (q + 1) + (xcd - r) * q) + off; }
        const int nig = WGM * nN, gid = wgid / nig, fm = gid * WGM, gsz = (nM - fm) < WGM ? (nM - fm) : WGM;
        u.pm = fm + ((wgid % nig) % gsz); u.pn = (wgid % nig) / gsz; return true;
    }
    __device__ __forceinline__ void a_ready(const Unit&) const {}
    __device__ __forceinline__ void done(const Unit&) const {}
};
__device__ __forceinline__ unsigned cvt_pk_bf16(float lo, float hi) { unsigned r; asm volatile("v_cvt_pk_bf16_f32 %0, %1, %2" : "=v"(r) : "v"(lo), "v"(hi)); return r; }
struct EpiProj {
    static constexpr bool PERM = true, AFTER_DRAIN = false;
    bf16_t* O; float* aux; const float* rstd;
    __device__ __forceinline__ void operator()(const f32x4 (&acc)[2][2][4][2], const Unit& u, int wr, int wc, int fr, int fq) const {
        const int row0 = u.pm * BM + wr * 64 + fr;
        if (u.pn < 22) {
            const int col0 = u.pn * BM + wc * 32 + 8 * fq;
#pragma unroll
            for (int ai = 0; ai < 2; ++ai)
#pragma unroll
                for (int m = 0; m < 4; ++m) { bf16_t* rowp = O + (size_t)(row0 + ai * HALF + m * 16) * 5632 + col0; const float rs = rstd[row0 + ai * HALF + m * 16];
#pragma unroll
                    for (int bj = 0; bj < 2; ++bj) { const f32x4 v0 = acc[ai][bj][m][0] * rs, v1 = acc[ai][bj][m][1] * rs;
                        u32x4 w; w.x = cvt_pk_bf16(v0[0], v0[1]); w.y = cvt_pk_bf16(v0[2], v0[3]); w.z = cvt_pk_bf16(v1[0], v1[1]); w.w = cvt_pk_bf16(v1[2], v1[3]);
                        *(u32x4*)(rowp + bj * HALF) = w; } }
        } else if (wc < 2) {
            const int col0 = wc * 32 + 8 * fq;
#pragma unroll
            for (int ai = 0; ai < 2; ++ai)
#pragma unroll
                for (int m = 0; m < 4; ++m) { float* rowp = aux + (size_t)(row0 + ai * HALF + m * 16) * 64 + col0; const float rs = rstd[row0 + ai * HALF + m * 16];
                    *(f32x4*)(rowp) = acc[ai][0][m][0] * rs; *(f32x4*)(rowp + 4) = acc[ai][0][m][1] * rs; }
        }
    }
};
struct EpiRes {
    static constexpr bool PERM = true, AFTER_DRAIN = false;
    const float* basef; const bf16_t* baseb; bf16_t* out;
    __device__ __forceinline__ void operator()(const f32x4 (&acc)[2][2][4][2], const Unit& u, int wr, int wc, int fr, int fq) const {
        const int row0 = u.pm * BM + wr * 64 + fr, col0 = u.pn * BM + wc * 32 + 8 * fq;
#pragma unroll
        for (int ai = 0; ai < 2; ++ai)
#pragma unroll
            for (int m = 0; m < 4; ++m) { const size_t off = (size_t)(row0 + ai * HALF + m * 16) * 2048 + col0;
#pragma unroll
                for (int bj = 0; bj < 2; ++bj) { f32x4 v0 = acc[ai][bj][m][0], v1 = acc[ai][bj][m][1]; const size_t o = off + bj * HALF;
                    if (basef) { v0 += *(const f32x4*)(basef + o); v1 += *(const f32x4*)(basef + o + 4); }
                    else { const u32x4 b = *(const u32x4*)(baseb + o);
                        v0[0] += __uint_as_float(b.x << 16); v0[1] += __uint_as_float(b.x & 0xffff0000u); v0[2] += __uint_as_float(b.y << 16); v0[3] += __uint_as_float(b.y & 0xffff0000u);
                        v1[0] += __uint_as_float(b.z << 16); v1[1] += __uint_as_float(b.z & 0xffff0000u); v1[2] += __uint_as_float(b.w << 16); v1[3] += __uint_as_float(b.w & 0xffff0000u); }
                    u32x4 w; w.x = cvt_pk_bf16(v0[0], v0[1]); w.y = cvt_pk_bf16(v0[2], v0[3]); w.z = cvt_pk_bf16(v1[0], v1[1]); w.w = cvt_pk_bf16(v1[2], v1[3]);
                    *(u32x4*)(out + o) = w; } }
    }
};
template <class Epi, class Sched, bool ALIGN_EPI = false, bool SP2 = false>
__device__ __forceinline__ void gemm_phase(PG8_LAS unsigned char* lds, const Gemm g, const Sched& S, const Epi& E, int wid_in  ) {
    int wid = wid_in; asm volatile("" : "+s"(wid));
    int lane = (int)__builtin_amdgcn_mbcnt_hi(~0u, __builtin_amdgcn_mbcnt_lo(~0u, 0u)); asm volatile("" : "+v"(lane));
    const int tid = wid * 64 + lane, wr = wid >> 2, wc = wid & 3, fr = lane & 15, fq = lane >> 4;
    const int K = g.K, nt = K / BK;
    unsigned voffA[2], voffB[2];
#pragma unroll
    for (int i = 0; i < 2; ++i) { int R, C; stage_rc(tid * 16 + i * 8192, R, C); const int Rb = Epi::PERM ? ((R & ~31) + perm32(R & 31)) : R;
        voffA[i] = (unsigned)(R * K + C) * 2u; voffB[i] = (unsigned)(Rb * K + C) * 2u; }
    const size_t kstep = (size_t)(BK * 2);
    const size_t hstep = (size_t)HALF * K * 2;
    const size_t tstep = 2 * hstep;
    const unsigned ldsw = (unsigned)wid * 1024u;
    const int aoff = lds_byte(wr * 64 + fr, fq * 8), boff = lds_byte(wc * 32 + fr, fq * 8);
#define PG8_SA(b, h) (((b) * 2 + (h)) * HTB)
#define PG8_SB(b, h) ((4 + (b) * 2 + (h)) * HTB)
#define PG8_STAGE(bufoff, gbase, voff) do { _Pragma("unroll") for (int _i = 0; _i < 2; ++_i) \
        __builtin_amdgcn_global_load_lds((const unsigned*)((const char*)(gbase) + (voff)[_i]), (PG8_LAS unsigned*)(lds + (bufoff) + ldsw + _i * 8192), 16, 0, 0); } while (0)
#define PG8_LDA(dst, b, h) do { _Pragma("unroll") for (int m = 0; m < 4; ++m) _Pragma("unroll") for (int k = 0; k < 2; ++k) dst[m][k] = *(const PG8_LAS bf16x8*)(lds + PG8_SA(b, h) + aoff + m * 2048 + k * 1024); } while (0)
#define PG8_LDB(dst, b, h) do { _Pragma("unroll") for (int n = 0; n < 2; ++n) _Pragma("unroll") for (int k = 0; k < 2; ++k) dst[n][k] = *(const PG8_LAS bf16x8*)(lds + PG8_SB(b, h) + boff + n * 2048 + k * 1024); } while (0)
#define PG8_MMA(ai, bj, At, Bt) do { __builtin_amdgcn_s_setprio(1); _Pragma("unroll") for (int m = 0; m < 4; ++m) _Pragma("unroll") for (int n = 0; n < 2; ++n) _Pragma("unroll") for (int k = 0; k < 2; ++k) \
        acc[ai][bj][m][n] = __builtin_amdgcn_mfma_f32_16x16x32_bf16(Bt[n][k], At[m][k], acc[ai][bj][m][n], 0, 0, 0); __builtin_amdgcn_s_setprio(0); } while (0)
#define PG8_WAIT_V(n) asm volatile("s_waitcnt vmcnt(" #n ")" ::: "memory")
#define PG8_WAIT_L(n) asm volatile("s_waitcnt lgkmcnt(" #n ")" ::: "memory")
#define PG8_BAR __builtin_amdgcn_s_barrier()
#define PG8_SCHED __builtin_amdgcn_sched_barrier(0)
    Unit cur, nxt; int ui = 0;
    if (!S.next(0, cur)) return;
    f32x4 acc[2][2][4][2];
#pragma unroll
    for (int a = 0; a < 2; ++a)
#pragma unroll
        for (int b = 0; b < 2; ++b)
#pragma unroll
            for (int m = 0; m < 4; ++m)
#pragma unroll
                for (int n = 0; n < 2; ++n) acc[a][b][m][n] = (f32x4){0.f, 0.f, 0.f, 0.f};
    bf16x8 At[4][2], B0[2][2], B1[2][2];
    const char* cA = (const char*)g.A + (size_t)cur.pm * tstep; const char* cB = (const char*)g.Bt + (size_t)cur.pn * tstep;
    S.a_ready(cur);
    if constexpr (SP2) {
        PG8_STAGE(PG8_SB(0, 0), cB, voffB); PG8_STAGE(PG8_SB(0, 1), cB + hstep, voffB); PG8_STAGE(PG8_SA(0, 0), cA, voffA); PG8_STAGE(PG8_SA(0, 1), cA + hstep, voffA);
        if (wr == 1) PG8_BAR;
        PG8_WAIT_V(2); PG8_BAR;
        PG8_STAGE(PG8_SB(1, 0), cB + kstep, voffB); PG8_STAGE(PG8_SA(1, 0), cA + kstep, voffA); PG8_STAGE(PG8_SB(1, 1), cB + hstep + kstep, voffB);
        PG8_WAIT_V(6); PG8_BAR;
    } else {
        PG8_STAGE(PG8_SB(0, 0), cB, voffB); PG8_STAGE(PG8_SA(0, 0), cA, voffA); PG8_STAGE(PG8_SB(0, 1), cB + hstep, voffB); PG8_STAGE(PG8_SA(0, 1), cA + hstep, voffA);
        if (wr == 1) PG8_BAR;
        PG8_WAIT_V(4); PG8_BAR;
        PG8_STAGE(PG8_SB(1, 0), cB + kstep, voffB); PG8_STAGE(PG8_SA(1, 0), cA + kstep, voffA); PG8_STAGE(PG8_SB(1, 1), cB + hstep + kstep, voffB);
        PG8_WAIT_V(6); PG8_BAR;
    }
    for (;;) {
        const bool has_next = S.next(ui + 1, nxt);
        const char* nA = has_next ? (const char*)g.A + (size_t)nxt.pm * tstep : cA; const char* nB = has_next ? (const char*)g.Bt + (size_t)nxt.pn * tstep : cB;
        for (int t = 0; t < nt; t += 2) {
            const bool last = (t == nt - 2);
            const char* a1 = cA + (size_t)(t + 1) * kstep;
            const char* a2 = last ? nA : cA + (size_t)(t + 2) * kstep; const char* b2 = last ? nB : cB + (size_t)(t + 2) * kstep;
            const char* a3 = a2 + kstep; const char* b3 = b2 + kstep;
            if (last && has_next) S.a_ready(nxt);
            if constexpr (SP2) {
            PG8_LDB(B0, 0, 0); PG8_LDB(B1, 0, 1); PG8_SCHED; PG8_LDA(At, 0, 0); PG8_STAGE(PG8_SA(1, 1), a1 + hstep, voffA);
            PG8_WAIT_V(8); PG8_WAIT_L(0); PG8_BAR; PG8_MMA(0, 0, At, B0); PG8_MMA(0, 1, At, B1); PG8_BAR; PG8_SCHED;
            PG8_LDA(At, 0, 1); PG8_STAGE(PG8_SB(0, 0), b2, voffB); PG8_STAGE(PG8_SB(0, 1), b2 + hstep, voffB); PG8_STAGE(PG8_SA(0, 0), a2, voffA);
            PG8_WAIT_V(8); PG8_WAIT_L(0); PG8_BAR; PG8_MMA(1, 0, At, B0); PG8_MMA(1, 1, At, B1); PG8_BAR; PG8_SCHED;
            PG8_LDB(B0, 1, 0); PG8_LDB(B1, 1, 1); PG8_SCHED; PG8_LDA(At, 1, 0); PG8_STAGE(PG8_SA(0, 1), a2 + hstep, voffA);
            PG8_WAIT_V(8); PG8_WAIT_L(0); PG8_BAR; PG8_MMA(0, 0, At, B0); PG8_MMA(0, 1, At, B1); PG8_BAR; PG8_SCHED;
            PG8_LDA(At, 1, 1); PG8_STAGE(PG8_SB(1, 0), b3, voffB); PG8_STAGE(PG8_SB(1, 1), b3 + hstep, voffB); PG8_STAGE(PG8_SA(1, 0), a3, voffA);
            PG8_WAIT_V(8); PG8_WAIT_L(0); PG8_BAR; PG8_MMA(1, 0, At, B0); PG8_MMA(1, 1, At, B1); PG8_BAR; PG8_SCHED;
            } else {
            PG8_LDB(B0, 0, 0); PG8_SCHED; PG8_LDA(At, 0, 0); PG8_STAGE(PG8_SA(1, 1), a1 + hstep, voffA);
            PG8_WAIT_L(8); PG8_BAR; PG8_WAIT_L(0); PG8_MMA(0, 0, At, B0); PG8_BAR; PG8_SCHED;
            PG8_LDB(B1, 0, 1); PG8_STAGE(PG8_SB(0, 0), b2, voffB);
            PG8_BAR; PG8_WAIT_L(0); PG8_MMA(0, 1, At, B1); PG8_BAR;
            PG8_LDA(At, 0, 1); PG8_STAGE(PG8_SA(0, 0), a2, voffA);
            PG8_BAR; PG8_WAIT_L(0); PG8_MMA(1, 0, At, B0); PG8_BAR; PG8_SCHED;
            PG8_STAGE(PG8_SB(0, 1), b2 + hstep, voffB);
            PG8_WAIT_V(6); PG8_BAR; PG8_MMA(1, 1, At, B1); PG8_BAR;
            PG8_LDB(B0, 1, 0); PG8_SCHED; PG8_LDA(At, 1, 0); PG8_STAGE(PG8_SA(0, 1), a2 + hstep, voffA);
            PG8_WAIT_L(8); PG8_BAR; PG8_WAIT_L(0); PG8_MMA(0, 0, At, B0); PG8_BAR; PG8_SCHED;
            PG8_LDB(B1, 1, 1); PG8_STAGE(PG8_SB(1, 0), b3, voffB);
            PG8_BAR; PG8_WAIT_L(0); PG8_MMA(0, 1, At, B1); PG8_BAR;
            PG8_LDA(At, 1, 1); PG8_STAGE(PG8_SA(1, 0), a3, voffA);
            PG8_BAR; PG8_WAIT_L(0); PG8_MMA(1, 0, At, B0); PG8_BAR; PG8_SCHED;
            PG8_STAGE(PG8_SB(1, 1), b3 + hstep, voffB);
            PG8_WAIT_V(6); PG8_BAR; PG8_MMA(1, 1, At, B1); PG8_BAR;
            }
        }
        if constexpr (ALIGN_EPI) { if (wr == 0) PG8_BAR; }
        if constexpr (!Epi::AFTER_DRAIN) { E(acc, cur, wr, wc, fr, fq); S.done(cur); }
        if (!has_next) break;
#pragma unroll
        for (int a = 0; a < 2; ++a)
#pragma unroll
            for (int b = 0; b < 2; ++b)
#pragma unroll
                for (int m = 0; m < 4; ++m)
#pragma unroll
                    for (int n = 0; n < 2; ++n) acc[a][b][m][n] = (f32x4){0.f, 0.f, 0.f, 0.f};
        cur = nxt; cA = nA; cB = nB; ++ui;
        if constexpr (ALIGN_EPI) { if (wr == 1) PG8_BAR; }
    }
    PG8_WAIT_V(0);
    if constexpr (!ALIGN_EPI) { if (wr == 0) PG8_BAR; }
    PG8_BAR;
    if constexpr (Epi::AFTER_DRAIN) { E.fused(acc, cur, wr, wc, fr, fq, lds, wid, lane); S.done(cur); }
#undef PG8_SA
#undef PG8_SB
#undef PG8_STAGE
#undef PG8_LDA
#undef PG8_LDB
#undef PG8_MMA
#undef PG8_WAIT_V
#undef PG8_WAIT_L
#undef PG8_BAR
#undef PG8_SCHED
}
}
#define GAS __attribute__((address_space(1)))
#define LAS __attribute__((address_space(3)))
typedef unsigned short bf16;
typedef unsigned v4u __attribute__((ext_vector_type(4)));
typedef float f32x4 __attribute__((ext_vector_type(4)));
typedef short bf16x8 __attribute__((ext_vector_type(8)));
typedef GAS unsigned gu32;
typedef GAS unsigned long long gu64;
#define RLX_AGENT __ATOMIC_RELAXED, __HIP_MEMORY_SCOPE_AGENT
#define LDS_WAIT() asm volatile("s_waitcnt lgkmcnt(0)" ::: "memory")
#define VM_WAIT() asm volatile("s_waitcnt vmcnt(0)" ::: "memory")
__device__ __forceinline__ unsigned long long rt() { return __builtin_amdgcn_s_memrealtime(); }
__device__ __forceinline__ unsigned f2bf(float f) { unsigned u = __builtin_bit_cast(unsigned, f); return (u + 0x7fffu + ((u >> 16) & 1u)) >> 16; }
__device__ __forceinline__ unsigned pk2(float lo, float hi) { return f2bf(lo) | (f2bf(hi) << 16); }
#define XB_TMO      128
#define XB_XCNT(j)  (256  + 64 * (j))
#define XB_XSUB(j)  (1280 + 64 * (j))
#define XB_XGEN(j)  (2304 + 64 * (j))
#define XB_TOP      3328
#define XB_TOPGEN   3392
#define XCD_BAR_WORDS 3456
#define XB_SPIN_CAP (1u << 18)

__device__ __forceinline__ unsigned xb_ld(unsigned* p)              { return __hip_atomic_load(p, __ATOMIC_RELAXED, __HIP_MEMORY_SCOPE_AGENT); }
__device__ __forceinline__ unsigned xb_add(unsigned* p, unsigned v) { return __hip_atomic_fetch_add(p, v, __ATOMIC_RELAXED, __HIP_MEMORY_SCOPE_AGENT); }
__device__ __forceinline__ unsigned xb_xcc_id() { return (unsigned)__builtin_amdgcn_s_getreg((3 << 11) | 20) & 0xFu; }
#define XB_SPIN(cond, bar) do { unsigned _sp = 0; while (cond) { __builtin_amdgcn_s_sleep(1); \
    if ((++_sp & 255u) == 0u) { if (xb_ld(&(bar)[XB_TMO])) break; if (_sp > XB_SPIN_CAP) { atomicAdd(&(bar)[XB_TMO], 1u); break; } } } } while (0)

struct XcdBarrier {
    unsigned* bar; unsigned x;
    unsigned w0;
    volatile LAS unsigned* st;
};

__device__ __forceinline__ XcdBarrier xcd_barrier_post(unsigned* bar, volatile LAS unsigned* st) {
    XcdBarrier b; b.bar = bar; b.x = xb_xcc_id(); b.st = st; b.w0 = (__builtin_amdgcn_readfirstlane(threadIdx.x >> 6) == 0) ? 1u : 0u;
    if (threadIdx.x == 0) (void)xb_add(&bar[XB_XCNT(b.x)], 1u);
    return b;
}
__device__ __forceinline__ void xcd_barrier_complete(unsigned* bar, unsigned x, unsigned& nloc, unsigned& nx) {
    const unsigned G = gridDim.x * gridDim.y * gridDim.z;
    unsigned sum, cnt, mine, sp = 0u;
    for (;;) {
        sum = 0u; cnt = 0u; mine = 0u;
#pragma unroll
        for (unsigned j = 0; j < 16; ++j) { const unsigned c = xb_ld(&bar[XB_XCNT(j)]); sum += c; cnt += (c > 0u) ? 1u : 0u; mine = (j == x) ? c : mine; }
        if (sum == G) break;
        __builtin_amdgcn_s_sleep(1);
        if ((++sp & 255u) == 0u) { if (xb_ld(&bar[XB_TMO])) break; if (sp > XB_SPIN_CAP) { atomicAdd(&bar[XB_TMO], 1u); break; } }
    }
    nloc = mine > 0u ? mine : 1u; nx = cnt > 0u ? cnt : 1u;
}

__device__ __forceinline__ void xcd_barrier(const XcdBarrier& b) {
    asm volatile("s_waitcnt vmcnt(0)" ::: "memory");
    __syncthreads();
    if (b.w0 != 0u && __builtin_amdgcn_mbcnt_hi(~0u, __builtin_amdgcn_mbcnt_lo(~0u, 0u)) == 0u) {
        GAS unsigned* barg = (GAS unsigned*)b.bar; asm volatile("" : "+s"(barg)); unsigned* bar = (unsigned*)barg;
        __builtin_amdgcn_s_waitcnt(0);
        unsigned nloc = b.st[0], nx = b.st[1];
        if (nloc == 0u) { xcd_barrier_complete(bar, b.x, nloc, nx); b.st[0] = nloc; b.st[1] = nx; }
        const unsigned old = xb_add(&bar[XB_XSUB(b.x)], 1u);
        const unsigned gen = old / nloc;
        if (old + 1u == (gen + 1u) * nloc) {
            __builtin_amdgcn_fence(__ATOMIC_RELEASE, "agent");
            asm volatile("s_waitcnt vmcnt(0)" ::: "memory");
            const unsigned og = xb_add(&bar[XB_TOP], 1u);
            const unsigned tg = og / nx;
            if (og + 1u == (tg + 1u) * nx) xb_add(&bar[XB_TOPGEN], 1u);
            else XB_SPIN(xb_ld(&bar[XB_TOPGEN]) == tg, bar);
            __builtin_amdgcn_fence(__ATOMIC_ACQUIRE, "agent");
            xb_add(&bar[XB_XGEN(b.x)], 1u);
            asm volatile("s_waitcnt vmcnt(0)" ::: "memory");
        } else {
            XB_SPIN(xb_ld(&bar[XB_XGEN(b.x)]) == gen, bar);
            __builtin_amdgcn_fence(__ATOMIC_ACQUIRE, "agent");
            asm volatile("s_waitcnt vmcnt(0)" ::: "memory");
        }
    }
    __syncthreads();
}
typedef unsigned u32x4 __attribute__((ext_vector_type(4)));

typedef short s16x4 __attribute__((ext_vector_type(4)));
typedef float f32x16 __attribute__((ext_vector_type(16)));
typedef unsigned u32x2 __attribute__((ext_vector_type(2)));
typedef float f32x2v __attribute__((ext_vector_type(2)));

constexpr int S = 8192, D = 2048, DEPTH = 4, DIN = 5688, NP = 5888, PITCH = 5632;
constexpr int C_AQ = 0, C_AK = 512, C_AV = 1024, C_BQ = 1536, C_BK = 2048, C_BV = 2560, C_CQ = 3072, C_KC = 4096, C_VC = 4352, C_KS = 4608, C_VS = 4864, C_KW = 5120, C_VW = 5376;
constexpr float RMS_EPS = 1e-6f, NEG = -1e30f, LOG2E = 1.4426950408889634f, SCL2 = 0.125f * 1.4426950408889634f;
constexpr int NWAVES = 8, NTHR = 512;

constexpr size_t MiB = 1u << 20;
constexpr size_t WS_CTL = 0, CTL_ZERO_BYTES = 1 * MiB;
constexpr size_t WS_WIN = 2 * MiB;
constexpr size_t WS_WOUT = 96 * MiB;
constexpr size_t WS_W1T = 128 * MiB;
constexpr size_t WS_W2T = 136 * MiB;
constexpr size_t WS_RWT = 137 * MiB;
constexpr size_t WS_C1 = 139 * MiB;
constexpr size_t WS_X = 144 * MiB;
constexpr size_t WS_XN = 208 * MiB;
constexpr size_t WS_PROJ = 240 * MiB;
constexpr size_t WS_AUX = 330 * MiB;
constexpr size_t WS_CUM = 332 * MiB;
constexpr size_t WS_KC = 333 * MiB;
constexpr size_t WS_VC = 334 * MiB;
constexpr size_t WS_MIX = 336 * MiB;
constexpr size_t WS_YB = 368 * MiB;
constexpr size_t WS_LIST = 432 * MiB;
constexpr size_t WS_TW = 436 * MiB;
constexpr size_t WS_RSTD = 437 * MiB;
constexpr size_t WS_END = 440 * MiB;
constexpr int CW_BAR = 4096;
constexpr int CW_Q = 8192;
constexpr int CW_PQ = 24576, CW_PD = 25600;
constexpr int CW_CNT = 32768;

constexpr int LDS_BYTES = 160 * 1024;
constexpr int MISC_OFF = 150 * 1024;

struct Args { const float* in[23]; float* out; unsigned char* ws; int ph_lo, ph_hi; };
__device__ __forceinline__ int t5_bucket(int rel) { if (rel < 16) return rel; int b = 16;
    b += rel >= 19; b += rel >= 21; b += rel >= 24; b += rel >= 27; b += rel >= 31; b += rel >= 35; b += rel >= 40; b += rel >= 46; b += rel >= 52; b += rel >= 59; b += rel >= 67; b += rel >= 77; b += rel >= 87; b += rel >= 99; b += rel >= 113; return b; }

__device__ __forceinline__ float bf2f(unsigned short b) { return __uint_as_float((unsigned)b << 16); }
__device__ __forceinline__ float bflo(unsigned w) { return __uint_as_float(w << 16); }
__device__ __forceinline__ float bfhi(unsigned w) { return __uint_as_float(w & 0xffff0000u); }
typedef __bf16 bf16x2_t __attribute__((ext_vector_type(2)));
__device__ __forceinline__ unsigned cvtpk(float lo, float hi) { f32x2v v = {lo, hi}; bf16x2_t b = __builtin_convertvector(v, bf16x2_t); return __builtin_bit_cast(unsigned, b); }
__device__ __forceinline__ unsigned short f2bf16(float f) { return (unsigned short)(cvtpk(f, 0.f) & 0xffffu); }
__device__ __forceinline__ float wave_sum(float v) {
#pragma unroll
    for (int o = 1; o < 64; o <<= 1) v += __shfl_xor(v, o);
    return v;
}
__device__ __forceinline__ int crow(int r, int hi) { return (r & 3) + 8 * (r >> 2) + 4 * hi; }
#define MFMA32(a, b, c) __builtin_amdgcn_mfma_f32_32x32x16_bf16((a), (b), (c), 0, 0, 0)
#define MFMA16(a, b, c) __builtin_amdgcn_mfma_f32_16x16x32_bf16((a), (b), (c), 0, 0, 0)

__device__ __forceinline__ int src_col_win(int n) { if (n < 3072) return n; if (n < 5632) return n + 8; if (n < 5640) return n - 2560; if (n < 5688) return n; return -1; }

template <int MODE>
__device__ __forceinline__ void tr_item(const float* W, const float* W2, int ldw, int K, bf16* WT, int k0, int n0, LAS float* scr, int lane, const float* kgain = nullptr  ) {
    const int nq = lane & 7, kq = lane >> 3, nn = n0 + 4 * nq;
    const float* src = W; int ld = ldw; bool ok = true;
    if (MODE == 0) { src = W + nn; }
    else if (MODE == 1) { const int c = src_col_win(nn); ok = c >= 0; src = W + (ok ? c : 0); }
    else { if (nn < 8) { src = W + nn; ld = 8; } else if (nn < 72) { src = W2 + (nn - 8); ld = 64; } else { ok = false; ld = 8; } }
    f32x4 tq[8];
#pragma unroll
    for (int i = 0; i < 8; ++i) { const int kk = 8 * i + kq; tq[i] = ok ? *(const f32x4*)(src + (size_t)(k0 + kk) * ld) : (f32x4){0.f, 0.f, 0.f, 0.f}; }
#pragma unroll
    for (int i = 0; i < 8; ++i) { const int kk = 8 * i + kq; LAS float* d = scr + kk * 33 + 4 * nq; d[0] = tq[i].x; d[1] = tq[i].y; d[2] = tq[i].z; d[3] = tq[i].w; }
    LDS_WAIT(); asm volatile("" ::: "memory");
    const int c = lane & 7;
    f32x4 g0 = (f32x4){1.f, 1.f, 1.f, 1.f}, g1 = g0;
    if (MODE == 1) { g0 = *(const f32x4*)(kgain + k0 + 8 * c); g1 = *(const f32x4*)(kgain + k0 + 8 * c + 4); }
#pragma unroll
    for (int j = 0; j < 4; ++j) { const int n = (lane >> 3) + 8 * j; const LAS float* s = scr + (8 * c) * 33 + n;
        v4u o; o.x = pk2(s[0 * 33] * g0.x, s[1 * 33] * g0.y); o.y = pk2(s[2 * 33] * g0.z, s[3 * 33] * g0.w); o.z = pk2(s[4 * 33] * g1.x, s[5 * 33] * g1.y); o.w = pk2(s[6 * 33] * g1.z, s[7 * 33] * g1.w);
        *(v4u*)(WT + (size_t)(n0 + n) * K + k0 + 8 * c) = o; }
    LDS_WAIT(); asm volatile("" ::: "memory");
}

template <int MODE>
__device__ __forceinline__ void norm_rows(const float* xsrc, const bf16* xb, bf16* X, bf16* XN, const bf16* YB, const float* TW, const float* gain, float* out, float* RSTD, int gw, int NGW, int lane) {
    for (int row = gw; row < S; row += NGW) {
        f32x4 v[8];
        if (MODE == 0) { const f32x4* xr = (const f32x4*)(xsrc + (size_t)row * D) + lane;
#pragma unroll
            for (int j = 0; j < 8; ++j) v[j] = xr[64 * j];
        } else { const u32x2* xr = (const u32x2*)(xb + (size_t)row * D) + lane;
#pragma unroll
            for (int j = 0; j < 8; ++j) { const u32x2 r = xr[64 * j]; v[j] = (f32x4){bflo(r.x), bfhi(r.x), bflo(r.y), bfhi(r.y)}; } }
        if (MODE >= 1) {
            const float w0 = TW[2 * row], w1 = TW[2 * row + 1];
            const u32x2* ya = (const u32x2*)(YB + (size_t)(2 * row) * D) + lane; const u32x2* yb = (const u32x2*)(YB + (size_t)(2 * row + 1) * D) + lane;
#pragma unroll
            for (int j = 0; j < 8; ++j) { const u32x2 a = ya[64 * j], b = yb[64 * j];
                v[j].x += w0 * bflo(a.x) + w1 * bflo(b.x); v[j].y += w0 * bfhi(a.x) + w1 * bfhi(b.x);
                v[j].z += w0 * bflo(a.y) + w1 * bflo(b.y); v[j].w += w0 * bfhi(a.y) + w1 * bfhi(b.y); }
        }
        float ss = 0.f;
#pragma unroll
        for (int j = 0; j < 8; ++j) ss += (v[j].x * v[j].x + v[j].y * v[j].y) + (v[j].z * v[j].z + v[j].w * v[j].w);
        ss = wave_sum(ss);
        const float rstd = 1.0f / sqrtf(ss * (1.0f / D) + RMS_EPS);
        if (MODE <= 1) { u32x2* xo = (u32x2*)((MODE == 1 ? X : XN) + (size_t)row * D) + lane;
#pragma unroll
            for (int j = 0; j < 8; ++j) { u32x2 w; w.x = cvtpk(v[j].x, v[j].y); w.y = cvtpk(v[j].z, v[j].w); xo[64 * j] = w; }
            if (lane == 0) RSTD[row] = rstd; }
        const f32x4* gr = (const f32x4*)gain + lane;
        if (MODE < 0) { u32x2* o8 = (u32x2*)(XN + (size_t)row * D) + lane;
#pragma unroll
            for (int j = 0; j < 8; ++j) { const f32x4 g = gr[64 * j]; u32x2 w; w.x = cvtpk(v[j].x * rstd * g.x, v[j].y * rstd * g.y); w.y = cvtpk(v[j].z * rstd * g.z, v[j].w * rstd * g.w); o8[64 * j] = w; }
        } else if (MODE == 2) { f32x4* oo = (f32x4*)(out + (size_t)row * D) + lane;
#pragma unroll
            for (int j = 0; j < 8; ++j) { const f32x4 g = gr[64 * j]; oo[64 * j] = v[j] * rstd * g; } }
    }
}

constexpr int I_WIN = 32 * 184, I_WOUT = 32 * 64, I_W1 = 32 * 8, I_W2 = 4 * 2, I_RW = 32 * 3, I_L = I_WIN + I_WOUT + 2 * I_W1 + 2 * I_W2 + I_RW;
__device__ __forceinline__ void tr_dispatch(const Args& a, unsigned char* ws, int it, LAS float* scr, int lane) {
        const int l = it / I_L; int r = it % I_L;
        if (r < I_WIN) { tr_item<1>(a.in[2] + (size_t)l * D * DIN, nullptr, DIN, D, (bf16*)(ws + WS_WIN) + (size_t)l * NP * D, 64 * (r / 184), 32 * (r % 184), scr, lane, a.in[1] + (size_t)l * D); return; } r -= I_WIN;
        if (r < I_WOUT) { tr_item<0>(a.in[13] + (size_t)l * D * D, nullptr, D, D, (bf16*)(ws + WS_WOUT) + (size_t)l * D * D, 64 * (r / 64), 32 * (r % 64), scr, lane); return; } r -= I_WOUT;
        if (r < 2 * I_W1) { const int kv = r / I_W1, q = r % I_W1; tr_item<0>(a.in[kv ? 10 : 7] + (size_t)l * 2048 * 256, nullptr, 256, 2048, (bf16*)(ws + WS_W1T) + (size_t)(l * 2 + kv) * 256 * 2048, 64 * (q / 8), 32 * (q % 8), scr, lane); return; } r -= 2 * I_W1;
        if (r < 2 * I_W2) { const int kv = r / I_W2, q = r % I_W2; tr_item<0>(a.in[kv ? 11 : 8] + (size_t)l * 256 * 64, nullptr, 64, 256, (bf16*)(ws + WS_W2T) + (size_t)(l * 2 + kv) * 64 * 256, 64 * (q / 2), 32 * (q % 2), scr, lane); return; } r -= 2 * I_W2;
        tr_item<2>(a.in[15] + (size_t)l * D * 8, a.in[17] + (size_t)l * D * 64, 8, D, (bf16*)(ws + WS_RWT) + (size_t)l * 96 * D, 64 * (r / 3), 32 * (r % 3), scr, lane);
}

__device__ __forceinline__ void p0_prologue(const Args& a, LAS unsigned char* lds, int bid, int G, int tid, int wid, int lane) {
    unsigned char* ws = a.ws;
    LAS float* scr = (LAS float*)(lds + wid * 8448);
    const int gw = bid * NWAVES + wid, NGW = G * NWAVES;
    for (int j = gw; j < DEPTH * I_WIN; j += NGW) tr_dispatch(a, ws, (j / I_WIN) * I_L + (j % I_WIN), scr, lane);
    for (int b = bid; b < 256; b += G) {
        const int vec = b >> 5, cb = b & 31, l = vec >> 1, kv = vec & 1; const float* pos = a.in[kv ? 9 : 6] + (size_t)l * 2048; const float* w1 = a.in[kv ? 10 : 7] + (size_t)l * 2048 * 256 + 8 * cb;
        float acc[8];
#pragma unroll
        for (int i = 0; i < 8; ++i) acc[i] = 0.f;
#pragma unroll
        for (int j = 0; j < 4; ++j) { const int k = tid + 512 * j; const float pv = pos[k]; const f32x4 w0 = *(const f32x4*)(w1 + (size_t)k * 256), w1v = *(const f32x4*)(w1 + (size_t)k * 256 + 4);
            acc[0] += pv * w0.x; acc[1] += pv * w0.y; acc[2] += pv * w0.z; acc[3] += pv * w0.w; acc[4] += pv * w1v.x; acc[5] += pv * w1v.y; acc[6] += pv * w1v.z; acc[7] += pv * w1v.w; }
        LAS float* red = (LAS float*)(lds + 72 * 1024);
#pragma unroll
        for (int i = 0; i < 8; ++i) { const float sws = wave_sum(acc[i]); if (lane == 0) red[wid * 8 + i] = sws; }
        __syncthreads();
        if (tid < 8) { float sres = 0.f;
#pragma unroll
            for (int w = 0; w < 8; ++w) sres += red[w * 8 + tid];
            ((float*)(ws + WS_C1))[vec * 256 + 8 * cb + tid] = sres; }
        __syncthreads();
    }
    norm_rows<0>(a.in[0], nullptr, nullptr, (bf16*)(ws + WS_XN), nullptr, nullptr, a.in[1], nullptr, (float*)(ws + WS_RSTD), gw, NGW, lane);
}

__device__ __forceinline__ float gelu_tanh(float x) { const float u = 0.7978845608028654f * (x + 0.044715f * x * x * x); const float t = 1.0f - 2.0f / (__expf(2.0f * u) + 1.0f); return 0.5f * x * (1.0f + t); }

__device__ __forceinline__ void compress_unit(int u, int l, const bf16* PROJ, const bf16* W1T, const bf16* W2T, const float* C1, bf16* KC, bf16* VC, LAS unsigned char* lds, int wid, int lane) {
    const int kv = u >> 6, rb = u & 63, r32 = lane & 31, hi = lane >> 5;
    const int R = 32 * rb + r32, g = R >> 9, n = R & 511;
    const int colb = (kv ? C_VC : C_KC) + 64 * g;
    const bf16* w1 = W1T + (size_t)(l * 2 + kv) * 256 * 2048 + (size_t)(32 * wid + r32) * 2048 + 8 * hi;
    const bf16* arow = PROJ + colb + 8 * hi;
    f32x16 acc = {};
#pragma unroll 4
    for (int s = 0; s < 128; ++s) {
        int tok = 16 * n + (s >> 2); tok = tok > (S - 1) ? (S - 1) : tok;
        const bf16x8 av = *(const bf16x8*)(arow + (size_t)tok * PITCH + (s & 3) * 16);
        const bf16x8 bv = *(const bf16x8*)(w1 + 16 * s);
        acc = MFMA32(av, bv, acc);
    }
    LAS bf16* hid = (LAS bf16*)lds;
    const float c1 = C1[(l * 2 + kv) * 256 + 32 * wid + r32];
#pragma unroll
    for (int r = 0; r < 16; ++r) hid[crow(r, hi) * 264 + 32 * wid + r32] = f2bf16(gelu_tanh(acc[r] + c1));
    __syncthreads();
    if (wid < 2) {
        f32x16 acc2 = {};
        const bf16* w2 = W2T + (size_t)(l * 2 + kv) * 64 * 256 + (size_t)(32 * wid + r32) * 256 + 8 * hi;
#pragma unroll 4
        for (int s = 0; s < 16; ++s) {
            const bf16x8 av = *(const LAS bf16x8*)(hid + r32 * 264 + 16 * s + 8 * hi);
            const bf16x8 bv = *(const bf16x8*)(w2 + 16 * s);
            acc2 = MFMA32(av, bv, acc2);
        }
        bf16* outp = kv ? VC : KC;
#pragma unroll
        for (int r = 0; r < 16; ++r) { const int Rr = 32 * rb + crow(r, hi); outp[(size_t)((Rr >> 9) * 512 + (Rr & 511)) * 64 + 32 * wid + r32] = f2bf16(acc2[r]); }
    }
    __syncthreads();
}

__device__ __forceinline__ void cumsum_unit(int h, int l, const float* AUX, const float* fox_bf, float* CUM, LAS unsigned char* lds, int tid) {
    const float bfv = fox_bf[l * 8 + h];
    float v[16]; float run = 0.f;
#pragma unroll
    for (int i = 0; i < 16; ++i) { const int t = 16 * tid + i; const float z = AUX[(size_t)t * 64 + h] + bfv; const float lf = fminf(z, 0.f) - log1pf(__expf(-fabsf(z))); run += lf; v[i] = run; }
    LAS float* tot = (LAS float*)lds;
    tot[tid] = run; __syncthreads();
    float off = 0.f;
    for (int j = 0; j < tid; ++j) off += tot[j];
#pragma unroll
    for (int i = 0; i < 16; ++i) CUM[(size_t)h * S + 16 * tid + i] = off + v[i];
    __syncthreads();
}

__device__ __forceinline__ int koff(int key, int c) { return c * 1024 + (((key + c) & 63) << 4); }
__device__ __forceinline__ int voff(int key, int c) { return (c >> 2) * 4096 + (key >> 4) * 1024 + (key & 15) * 64 + (c & 3) * 16; }
typedef short v4i16_t __attribute__((ext_vector_type(4)));
__device__ __forceinline__ s16x4 vtr(LAS const unsigned char* p) { return __builtin_bit_cast(s16x4, __builtin_amdgcn_ds_read_tr16_b64_v4i16((LAS v4i16_t*)p)); }

template <int NDT> struct AState { float m, l; f32x16 o[NDT]; };
template <int NDT> __device__ __forceinline__ void astate_init(AState<NDT>& st) { st.m = 0.f; st.l = 0.f;
#pragma unroll
    for (int i = 0; i < NDT; ++i) st.o[i] = (f32x16){}; }

template <bool QLDS>
__device__ __forceinline__ void qk_tile(f32x16& p0, f32x16& p1, LAS const unsigned char* kt, int kchunk0, const bf16x8 (&qf)[4], LAS const unsigned char* qb, int r32, int hi) {
    bf16x8 ka[4], kb[4], q[4];
#pragma unroll
    for (int d0 = 0; d0 < 4; ++d0) {
        const int c = kchunk0 + 2 * d0 + hi;
        ka[d0] = *(const LAS bf16x8*)(kt + koff(r32, c));
        kb[d0] = *(const LAS bf16x8*)(kt + koff(r32 + 32, c));
        q[d0] = QLDS ? *(const LAS bf16x8*)(qb + d0 * 8192) : qf[d0];
    }
    __builtin_amdgcn_sched_barrier(0);
    p0 = (f32x16){}; p1 = (f32x16){};
#pragma unroll
    for (int d0 = 0; d0 < 4; ++d0) { p0 = MFMA32(ka[d0], q[d0], p0); p1 = MFMA32(kb[d0], q[d0], p1); }
    __builtin_amdgcn_sched_barrier(0);
}
__device__ __forceinline__ void pack_p(bf16x8 (&pw)[4], const f32x16& p0, const f32x16& p1) {
    u32x4 w;
    w.x = cvtpk(p0[0], p0[1]); w.y = cvtpk(p0[2], p0[3]); w.z = cvtpk(p0[4], p0[5]); w.w = cvtpk(p0[6], p0[7]); pw[0] = __builtin_bit_cast(bf16x8, w);
    w.x = cvtpk(p0[8], p0[9]); w.y = cvtpk(p0[10], p0[11]); w.z = cvtpk(p0[12], p0[13]); w.w = cvtpk(p0[14], p0[15]); pw[1] = __builtin_bit_cast(bf16x8, w);
    w.x = cvtpk(p1[0], p1[1]); w.y = cvtpk(p1[2], p1[3]); w.z = cvtpk(p1[4], p1[5]); w.w = cvtpk(p1[6], p1[7]); pw[2] = __builtin_bit_cast(bf16x8, w);
    w.x = cvtpk(p1[8], p1[9]); w.y = cvtpk(p1[10], p1[11]); w.z = cvtpk(p1[12], p1[13]); w.w = cvtpk(p1[14], p1[15]); pw[3] = __builtin_bit_cast(bf16x8, w);
}
struct VFrag { s16x4 lo[4], hh[4]; };
__device__ __forceinline__ LAS const unsigned char* vfrag_base(LAS const unsigned char* vt, int lane) { return vt + ((lane >> 4) & 1) * 32 + (lane & 3) * 8 + (4 * (lane >> 5) + ((lane & 15) >> 2)) * 64; }
__device__ __forceinline__ void vfrag_read(VFrag& f, LAS const unsigned char* vb, int dt) {
#pragma unroll
    for (int s = 0; s < 4; ++s) { f.lo[s] = vtr(vb + dt * 4096 + s * 1024); f.hh[s] = vtr(vb + dt * 4096 + s * 1024 + 512); }
}
__device__ __forceinline__ void vfrag_mma(f32x16& o, const VFrag& f, const bf16x8 (&pw)[4]) {
#pragma unroll
    for (int s = 0; s < 4; ++s) { const bf16x8 vf = (bf16x8){f.lo[s][0], f.lo[s][1], f.lo[s][2], f.lo[s][3], f.hh[s][0], f.hh[s][1], f.hh[s][2], f.hh[s][3]}; o = MFMA32(vf, pw[s], o); }
}
template <int NDT>
__device__ __forceinline__ void pv_tile_pre(f32x16 (&o)[NDT], const bf16x8 (&pw)[4], LAS const unsigned char* vb, VFrag& f0) {
    VFrag f1;
#pragma unroll
    for (int dt = 0; dt < NDT; dt += 2) {
        if (dt + 1 < NDT) vfrag_read(f1, vb, dt + 1);
        __builtin_amdgcn_sched_barrier(0);
        vfrag_mma(o[dt], f0, pw);
        if (dt + 1 < NDT) {
            if (dt + 2 < NDT) vfrag_read(f0, vb, dt + 2);
            __builtin_amdgcn_sched_barrier(0);
            vfrag_mma(o[dt + 1], f1, pw);
        }
    }
}
template <int NDT>
__device__ __forceinline__ void pv_tile(f32x16 (&o)[NDT], const bf16x8 (&pw)[4], LAS const unsigned char* vt, int lane) {
    LAS const unsigned char* vb = vfrag_base(vt, lane);
    VFrag f0; vfrag_read(f0, vb, 0);
    pv_tile_pre<NDT>(o, pw, vb, f0);
}
constexpr float SM_THR = 8.0f;
__device__ __forceinline__ float max3f(float a, float b, float c) { return __builtin_fmaxf(__builtin_fmaxf(a, b), c); }
__device__ __forceinline__ float halfmax(float m) { auto rr = __builtin_amdgcn_permlane32_swap(__float_as_uint(m), __float_as_uint(m), false, false); return fmaxf(__uint_as_float(rr[0]), __uint_as_float(rr[1])); }
__device__ __forceinline__ float halfsum(float v) { auto rr = __builtin_amdgcn_permlane32_swap(__float_as_uint(v), __float_as_uint(v), false, false); return __uint_as_float(rr[0]) + __uint_as_float(rr[1]); }
#ifndef SM_VPRE
#define SM_VPRE false
#endif
template <int NDT>
__device__ __forceinline__ void softmax_pv(AState<NDT>& st, f32x16& p0, f32x16& p1, LAS const unsigned char* vt, int lane) {
    LAS const unsigned char* vb = vfrag_base(vt, lane);
    constexpr bool VPRE = SM_VPRE;
    VFrag f0; if (VPRE) { vfrag_read(f0, vb, 0); __builtin_amdgcn_sched_barrier(0); }
    float ma = max3f(p0[0], p0[1], p0[2]), mb = max3f(p1[0], p1[1], p1[2]);
#pragma unroll
    for (int r = 3; r < 15; r += 2) { ma = max3f(ma, p0[r], p0[r + 1]); mb = max3f(mb, p1[r], p1[r + 1]); }
    float mx = max3f(ma, mb, fmaxf(p0[15], p1[15]));
    mx = halfmax(mx);
    if (__any(mx > SM_THR)) {
        const float d = fmaxf(mx, 0.f), alpha = __builtin_amdgcn_exp2f(-d); st.m += d; st.l *= alpha;
#pragma unroll
        for (int r = 0; r < 16; ++r) { p0[r] -= d; p1[r] -= d; }
#pragma unroll
        for (int dt = 0; dt < NDT; ++dt)
#pragma unroll
            for (int r = 0; r < 16; ++r) st.o[dt][r] *= alpha;
    }
    float rs = 0.f;
#pragma unroll
    for (int r = 0; r < 16; ++r) { p0[r] = __builtin_amdgcn_exp2f(p0[r]); p1[r] = __builtin_amdgcn_exp2f(p1[r]); rs += p0[r] + p1[r]; }
    st.l += rs;
    bf16x8 pw[4]; pack_p(pw, p0, p1);
    if (!VPRE) vfrag_read(f0, vb, 0);
    pv_tile_pre<NDT>(st.o, pw, vb, f0);
}
__device__ __forceinline__ void softmax_stats(float& m, float& l, const f32x16& p0, const f32x16& p1) {
    float mx = fmaxf(p0[0], p1[0]);
#pragma unroll
    for (int r = 1; r < 16; ++r) mx = fmaxf(mx, fmaxf(p0[r], p1[r]));
    mx = halfmax(mx);
    const float mn = fmaxf(m, mx), alpha = __builtin_amdgcn_exp2f(m - mn); m = mn;
    float rs = 0.f;
#pragma unroll
    for (int r = 0; r < 16; ++r) rs += __builtin_amdgcn_exp2f(p0[r] - mn) + __builtin_amdgcn_exp2f(p1[r] - mn);
    l = l * alpha + rs;
}

template <int KCH, int VCH> struct Stage { u32x4 k[KCH / 8], v[VCH / 8], x; };
template <int KCH, int VCH, bool XROW>
__device__ __forceinline__ void stage_load(Stage<KCH, VCH>& sg, const bf16* ksrc, const bf16* vsrc, const float* xsrc, size_t pitch, int key0, int tid) {
#pragma unroll
    for (int i = 0; i < KCH / 8; ++i) { const int idx = tid + 512 * i, key = idx / KCH, c = idx % KCH; sg.k[i] = *(const u32x4*)(ksrc + (size_t)(key0 + key) * pitch + 8 * c); }
#pragma unroll
    for (int i = 0; i < VCH / 8; ++i) { const int idx = tid + 512 * i, key = idx / VCH, c = idx % VCH; sg.v[i] = *(const u32x4*)(vsrc + (size_t)(key0 + key) * pitch + 8 * c); }
    if (XROW) sg.x = *(const u32x4*)(xsrc + key0 + 4 * (tid & 15));
}
template <int KCH, int VCH, bool XROW>
__device__ __forceinline__ void stage_write(const Stage<KCH, VCH>& sg, LAS unsigned char* kb, LAS unsigned char* vb, LAS unsigned char* xb, int tid) {
#pragma unroll
    for (int i = 0; i < KCH / 8; ++i) { const int idx = tid + 512 * i, key = idx / KCH, c = idx % KCH; *(LAS u32x4*)(kb + koff(key, c)) = sg.k[i]; }
#pragma unroll
    for (int i = 0; i < VCH / 8; ++i) { const int idx = tid + 512 * i, key = idx / VCH, c = idx % VCH; *(LAS u32x4*)(vb + voff(key, c)) = sg.v[i]; }
    if (XROW) { if (tid < 16) { f32x4 xv = __builtin_bit_cast(f32x4, sg.x); xv = xv * LOG2E; *(LAS f32x4*)(xb + 16 * tid) = xv; } }
}

template <int KCH, int VCH, bool XROW, int NST  , bool QLDS, class Fn>
__device__ __forceinline__ void kv_loop(Fn& fn, const bf16x8 (&qf)[4], LAS const unsigned char* qb, int kchunk0, const bf16* ksrc, const bf16* vsrc, const float* xsrc, size_t pitch, int t_lo, int t_hi,
                                        LAS unsigned char* KB, LAS unsigned char* VB, LAS unsigned char* XB, int tid, int lane) {
    constexpr int KBYTES = KCH * 1024, VBYTES = VCH * 1024;
    const int r32 = lane & 31, hi = lane >> 5, nt = t_hi - t_lo;
    if (NST == 1) {
        Stage<KCH, VCH> sg;
        stage_load<KCH, VCH, XROW>(sg, ksrc, vsrc, xsrc, pitch, 64 * t_lo, tid);
        stage_write<KCH, VCH, XROW>(sg, KB, VB, XB, tid);
        __syncthreads();
        for (int i = 0; i < nt; ++i) {
            const int b = i & 1;
            if (i + 1 < nt) stage_load<KCH, VCH, XROW>(sg, ksrc, vsrc, xsrc, pitch, 64 * (t_lo + i + 1), tid);
            if (fn.need(t_lo + i)) { f32x16 p0, p1; qk_tile<QLDS>(p0, p1, KB + b * KBYTES, kchunk0, qf, qb, r32, hi); fn.tile(t_lo + i, p0, p1, VB + b * VBYTES, XB + b * 256); }
            if (i + 1 < nt) stage_write<KCH, VCH, XROW>(sg, KB + (b ^ 1) * KBYTES, VB + (b ^ 1) * VBYTES, XB + (b ^ 1) * 256, tid);
            __syncthreads();
        }
        return;
    }
    Stage<KCH, VCH> sgA, sgB;
    stage_load<KCH, VCH, XROW>(sgA, ksrc, vsrc, xsrc, pitch, 64 * t_lo, tid);
    if (nt > 1) stage_load<KCH, VCH, XROW>(sgB, ksrc, vsrc, xsrc, pitch, 64 * (t_lo + 1), tid);
    stage_write<KCH, VCH, XROW>(sgA, KB, VB, XB, tid);
    __syncthreads();
    for (int i = 0; i < nt; i += 2) {
        if (i + 2 < nt) stage_load<KCH, VCH, XROW>(sgA, ksrc, vsrc, xsrc, pitch, 64 * (t_lo + i + 2), tid);
        if (fn.need(t_lo + i)) { f32x16 p0, p1; qk_tile<QLDS>(p0, p1, KB, kchunk0, qf, qb, r32, hi); fn.tile(t_lo + i, p0, p1, VB, XB); }
        if (i + 1 < nt) stage_write<KCH, VCH, XROW>(sgB, KB + KBYTES, VB + VBYTES, XB + 256, tid);
        __syncthreads();
        if (i + 1 >= nt) break;
        if (i + 3 < nt) stage_load<KCH, VCH, XROW>(sgB, ksrc, vsrc, xsrc, pitch, 64 * (t_lo + i + 3), tid);
        if (fn.need(t_lo + i + 1)) { f32x16 p0, p1; qk_tile<QLDS>(p0, p1, KB + KBYTES, kchunk0, qf, qb, r32, hi); fn.tile(t_lo + i + 1, p0, p1, VB + VBYTES, XB + 256); }
        if (i + 2 < nt) stage_write<KCH, VCH, XROW>(sgA, KB, VB, XB, tid);
        __syncthreads();
    }
}

#define SGB(mask, n) __builtin_amdgcn_sched_group_barrier(mask, n, 0)
template <int NDT>
__device__ __forceinline__ void sp_finish(AState<NDT>& st, f32x16& s0, f32x16& s1, bf16x8 (&pw)[4]) {
    float rs = 0.f;
#pragma unroll
    for (int r = 0; r < 16; ++r) { s0[r] = __builtin_amdgcn_exp2f(s0[r]); s1[r] = __builtin_amdgcn_exp2f(s1[r]); rs += s0[r] + s1[r]; }
    st.l += rs;
    pack_p(pw, s0, s1);
}
__device__ __forceinline__ float sp_rowmax(const f32x16& p0, const f32x16& p1) {
    float ma = max3f(p0[0], p0[1], p0[2]), mb = max3f(p1[0], p1[1], p1[2]);
#pragma unroll
    for (int r = 3; r < 15; r += 2) { ma = max3f(ma, p0[r], p0[r + 1]); mb = max3f(mb, p1[r], p1[r + 1]); }
    return max3f(ma, mb, fmaxf(p0[15], p1[15]));
}
template <int NDT>
__device__ __forceinline__ void sp_raise(AState<NDT>& st, f32x16& p0, f32x16& p1, float mx) {
    mx = halfmax(mx);
    if (__any(mx > SM_THR)) {
        const float d = fmaxf(mx, 0.f), alpha = __builtin_amdgcn_exp2f(-d); st.m += d; st.l *= alpha;
#pragma unroll
        for (int r = 0; r < 16; ++r) { p0[r] -= d; p1[r] -= d; }
#pragma unroll
        for (int dt = 0; dt < NDT; ++dt)
#pragma unroll
            for (int r = 0; r < 16; ++r) st.o[dt][r] *= alpha;
    }
}
__device__ __forceinline__ void sp_finish_part(int j, float& rs, f32x16& s0, f32x16& s1, u32x4 (&pu)[4]) {
#pragma unroll
    for (int r = 4 * j; r < 4 * j + 4; ++r) { s0[r] = __builtin_amdgcn_exp2f(s0[r]); s1[r] = __builtin_amdgcn_exp2f(s1[r]); rs += s0[r] + s1[r]; }
    const unsigned a0 = cvtpk(s0[4 * j], s0[4 * j + 1]), a1 = cvtpk(s0[4 * j + 2], s0[4 * j + 3]), b0 = cvtpk(s1[4 * j], s1[4 * j + 1]), b1 = cvtpk(s1[4 * j + 2], s1[4 * j + 3]);
    if (j & 1) { pu[j >> 1].z = a0; pu[j >> 1].w = a1; pu[2 + (j >> 1)].z = b0; pu[2 + (j >> 1)].w = b1; }
    else       { pu[j >> 1].x = a0; pu[j >> 1].y = a1; pu[2 + (j >> 1)].x = b0; pu[2 + (j >> 1)].y = b1; }
}
#define SP_STEADY(T, KBUF, XBUF, SP0, SP1, SN0, SN1)                                                                                                    \
    {   bf16x8 ka[4], kb[4], q[4];                                                                                                                      \
        _Pragma("unroll") for (int d0 = 0; d0 < 4; ++d0) { const int c = kchunk0 + 2 * d0 + hi;                                                         \
            ka[d0] = *(const LAS bf16x8*)((KBUF) + koff(r32, c)); kb[d0] = *(const LAS bf16x8*)((KBUF) + koff(r32 + 32, c));                             \
            q[d0] = QLDS ? *(const LAS bf16x8*)(qb + d0 * 8192) : qf[d0]; }                                                                             \
        LAS const unsigned char* vb = vfrag_base(VB + vp * VBYTES, lane);                                                                               \
        VFrag f0, f1; u32x4 pu[4]; float rs = 0.f;                                                                                                      \
        __builtin_amdgcn_sched_barrier(0);                                                                                                              \
        SN0 = (f32x16){}; SN1 = (f32x16){};                                                                                                             \
        _Pragma("unroll") for (int j = 0; j < 4; ++j) {                                                                                                 \
            SN0 = MFMA32(ka[j], q[j], SN0); SN1 = MFMA32(kb[j], q[j], SN1);                                                                             \
            sp_finish_part(j, rs, SP0, SP1, pu);                                                                                                        \
            if (NDT == 2 && j == 2) vfrag_read(f0, vb, 0);                                                                                              \
            if (NDT == 2 && j == 3) vfrag_read(f1, vb, 1);                                                                                              \
            __builtin_amdgcn_sched_barrier(0);                                                                                                          \
        }                                                                                                                                               \
        fn.st.l += rs;                                                                                                                                  \
        _Pragma("unroll") for (int k = 0; k < 4; ++k) pw[k] = __builtin_bit_cast(bf16x8, pu[k]);                                                        \
        float mx = NEG;                                                                                                                                 \
        _Pragma("unroll") for (int dt = 0; dt < NDT; dt += 2) {                                                                                         \
            if (NDT != 2) { vfrag_read(f0, vb, dt); vfrag_read(f1, vb, dt + 1); __builtin_amdgcn_sched_barrier(0); }                                    \
            _Pragma("unroll") for (int sx = 0; sx < 4; ++sx) {                                                                                          \
                { const bf16x8 vf = (bf16x8){f0.lo[sx][0], f0.lo[sx][1], f0.lo[sx][2], f0.lo[sx][3], f0.hh[sx][0], f0.hh[sx][1], f0.hh[sx][2], f0.hh[sx][3]}; fn.st.o[dt] = MFMA32(vf, pw[sx], fn.st.o[dt]); } \
                { const bf16x8 vf = (bf16x8){f1.lo[sx][0], f1.lo[sx][1], f1.lo[sx][2], f1.lo[sx][3], f1.hh[sx][0], f1.hh[sx][1], f1.hh[sx][2], f1.hh[sx][3]}; fn.st.o[dt + 1] = MFMA32(vf, pw[sx], fn.st.o[dt + 1]); } \
                if (dt == 0) { fn.score_part(sx, T, SN0, SN1, XBUF); mx = fn.max_part(sx, mx, SN0, SN1); }                                              \
                __builtin_amdgcn_sched_barrier(0);                                                                                                      \
            }                                                                                                                                           \
        }                                                                                                                                               \
        mx = fn.score_mask(T, mx, SN0, SN1);                                                                                                            \
        sp_raise<NDT>(fn.st, SN0, SN1, mx); }
template <int KCH, int VCH, bool XROW, bool QLDS, int NDT, class Fn>
__device__ __forceinline__ void kv_loop_sp(Fn& fn, const bf16x8 (&qf)[4], LAS const unsigned char* qb, int kchunk0, const bf16* ksrc, const bf16* vsrc, const float* xsrc, size_t pitch, int t_lo, int t_hi, int nw,
                                           LAS unsigned char* KB, LAS unsigned char* VB, LAS unsigned char* XB, int tid, int lane) {
    constexpr int KBYTES = KCH * 1024, VBYTES = VCH * 1024;
    const int r32 = lane & 31, hi = lane >> 5, nt = t_hi - t_lo;
    Stage<KCH, VCH> sg;
    stage_load<KCH, VCH, XROW>(sg, ksrc, vsrc, xsrc, pitch, 64 * t_lo, tid);
    stage_write<KCH, VCH, XROW>(sg, KB, VB, XB, tid);
    __syncthreads();
    f32x16 sa0, sa1, sb0, sb1; bf16x8 pw[4];
    int vc = 0, vp = 2, vn, i = 0;
#define SP_PRE(I)  if ((I) + 1 < nt) stage_load<KCH, VCH, XROW>(sg, ksrc, vsrc, xsrc, pitch, 64 * (t_lo + (I) + 1), tid);
#define SP_POST(I, KOFFN, XOFFN) vn = vc == 2 ? 0 : vc + 1; if ((I) + 1 < nt) stage_write<KCH, VCH, XROW>(sg, KB + (KOFFN), VB + vn * VBYTES, XB + (XOFFN), tid); __syncthreads(); vp = vc; vc = vn;
    SP_PRE(0)
    qk_tile<QLDS>(sa0, sa1, KB, kchunk0, qf, qb, r32, hi); fn.score(t_lo, sa0, sa1, XB); sp_raise<NDT>(fn.st, sa0, sa1, sp_rowmax(sa0, sa1));
    SP_POST(0, KBYTES, 256)
    i = 1;
    while (i + 1 < nw) {
        SP_PRE(i)
        SP_STEADY(t_lo + i, KB + KBYTES, XB + 256, sa0, sa1, sb0, sb1)
        SP_POST(i, 0, 0)
        SP_PRE(i + 1)
        SP_STEADY(t_lo + i + 1, KB, XB, sb0, sb1, sa0, sa1)
        SP_POST(i + 1, KBYTES, 256)
        i += 2;
    }
    if (i < nw) {
        SP_PRE(i)
        SP_STEADY(t_lo + i, KB + KBYTES, XB + 256, sa0, sa1, sb0, sb1)
        SP_POST(i, 0, 0)
        sa0 = sb0; sa1 = sb1; ++i;
    }
    if (i < nt) { SP_PRE(i) }
    sp_finish<NDT>(fn.st, sa0, sa1, pw); pv_tile<NDT>(fn.st.o, pw, VB + vp * VBYTES, lane);
    if (i < nt) { const int ko = (i & 1) ? 0 : KBYTES, xo = (i & 1) ? 0 : 256; SP_POST(i, ko, xo) ++i; }
    while (i < nt) { const int ko = (i & 1) ? 0 : KBYTES, xo = (i & 1) ? 0 : 256; SP_PRE(i) SP_POST(i, ko, xo) ++i; }
    __syncthreads();
#undef SP_PRE
#undef SP_POST
}

struct FoxFn {
    AState<2> st; float cq; int tq, tmin, tmax, lane;
    __device__ __forceinline__ bool need(int t) const { return 64 * t <= tmax; }
    __device__ __forceinline__ void score_part(int a, int t, f32x16& p0, f32x16& p1, LAS const unsigned char* xrow) {
        const int hi = lane >> 5; LAS const float* ck = (LAS const float*)xrow;
        const float cqm = cq - st.m;
        const f32x4 c0 = *(LAS const f32x4*)(ck + 8 * a + 4 * hi), c1 = *(LAS const f32x4*)(ck + 32 + 8 * a + 4 * hi);
#pragma unroll
        for (int i = 0; i < 4; ++i) { const int r = 4 * a + i; p0[r] = p0[r] * SCL2 + (cqm - c0[i]); p1[r] = p1[r] * SCL2 + (cqm - c1[i]); }
    }
    __device__ __forceinline__ float max_part(int a, float mx, const f32x16& p0, const f32x16& p1) const {
        return max3f(max3f(mx, p0[4 * a], p0[4 * a + 1]), max3f(p0[4 * a + 2], p0[4 * a + 3], p1[4 * a]), max3f(p1[4 * a + 1], p1[4 * a + 2], p1[4 * a + 3])); }
    __device__ __forceinline__ float score_mask(int t, float mx, f32x16& p0, f32x16& p1) const {
        const int hi = lane >> 5, k0 = 64 * t;
        if (k0 + 63 > tmin) {
#pragma unroll
            for (int r = 0; r < 16; ++r) { const int key = k0 + crow(r, hi); p0[r] = key <= tq ? p0[r] : NEG; p1[r] = key + 32 <= tq ? p1[r] : NEG; }
            mx = sp_rowmax(p0, p1);
        }
        return mx;
    }
    __device__ __forceinline__ void score(int t, f32x16& p0, f32x16& p1, LAS const unsigned char* xrow) {
#pragma unroll
        for (int a = 0; a < 4; ++a) score_part(a, t, p0, p1, xrow);
        score_mask(t, 0.f, p0, p1);
    }
};
__device__ __forceinline__ void fox_unit(int h, int qb, const bf16* PROJ, const float* CUM, bf16* MIX, LAS unsigned char* lds, int tid, int wid, int lane) {
    const int r32 = lane & 31, hi = lane >> 5, q0 = 256 * qb, tq = q0 + 32 * wid + r32;
    bf16x8 qf[4];
#pragma unroll
    for (int d0 = 0; d0 < 4; ++d0) qf[d0] = *(const bf16x8*)(PROJ + (size_t)tq * PITCH + C_BQ + 64 * h + 16 * d0 + 8 * hi);
    const float* cum = CUM + (size_t)h * S;
    FoxFn fn; astate_init<2>(fn.st); fn.cq = cum[tq] * LOG2E; fn.tq = tq; fn.tmin = q0 + 32 * wid; fn.tmax = q0 + 32 * wid + 31; fn.lane = lane;
    kv_loop_sp<8, 8, true, false, 2>(fn, qf, lds, 0, PROJ + C_BK + 64 * h, PROJ + C_BV + 64 * h, cum, PITCH, 0, 4 * (qb + 1), min(4 * (qb + 1), (fn.tmax >> 6) + 1), lds, lds + 16384, lds + 40960, tid, lane);
    const float lt = fn.st.l + __shfl_xor(fn.st.l, 32), inv = 1.0f / lt;
    bf16* orow = MIX + (size_t)tq * D + 512 + 64 * h;
#pragma unroll
    for (int dt = 0; dt < 2; ++dt)
#pragma unroll
        for (int a = 0; a < 4; ++a) { u32x2 w; w.x = cvtpk(fn.st.o[dt][4 * a] * inv, fn.st.o[dt][4 * a + 1] * inv); w.y = cvtpk(fn.st.o[dt][4 * a + 2] * inv, fn.st.o[dt][4 * a + 3] * inv);
            *(u32x2*)(orow + 32 * dt + 8 * a + 4 * hi) = w; }
}

struct DiffFn {
    AState<4> st; LAS const float* lut; int tq, tmin, tmax, lane;
    __device__ __forceinline__ bool need(int t) const { return 64 * t <= tmax; }
    __device__ __forceinline__ void tile(int t, f32x16& p0, f32x16& p1, LAS const unsigned char* vt, LAS const unsigned char*) {
        const int hi = lane >> 5, k0 = 64 * t;
        const float mref = st.m;
        if (k0 + 63 + 127 <= tmin) {
            const float b = lut[127] - mref;
#pragma unroll
            for (int r = 0; r < 16; ++r) { p0[r] = p0[r] * SCL2 + b; p1[r] = p1[r] * SCL2 + b; }
        } else {
#pragma unroll
            for (int r = 0; r < 16; ++r) { const int rel0 = tq - (k0 + crow(r, hi)); const float b0 = lut[min(max(rel0, 0), 127)] - mref; p0[r] = rel0 >= 0 ? p0[r] * SCL2 + b0 : NEG; }
            __builtin_amdgcn_sched_barrier(0);
#pragma unroll
            for (int r = 0; r < 16; ++r) { const int rel1 = tq - (k0 + 32 + crow(r, hi)); const float b1 = lut[min(max(rel1, 0), 127)] - mref; p1[r] = rel1 >= 0 ? p1[r] * SCL2 + b1 : NEG; }
            __builtin_amdgcn_sched_barrier(0);
        }
        softmax_pv<4>(st, p0, p1, vt, lane);
    }
};
__device__ __forceinline__ void diff_unit(int h, int qb, int l, const Args& a, const bf16* PROJ, bf16* MIX, LAS unsigned char* lds, int tid, int wid, int lane) {
    const int r32 = lane & 31, hi = lane >> 5, q0 = 128 * qb, map = wid & 1, qs = wid >> 1, tq = q0 + 32 * qs + r32;
    LAS float* lut = (LAS float*)(lds + 65536); LAS float* lamw = (LAS float*)(lds + 65536 + 512);
    const float lam_init = 0.8f - 0.6f * expf(-0.3f * (float)l);
    if (tid < 128) lut[tid] = a.in[12][t5_bucket(tid) * 20 + h] * LOG2E;
    if (wid == 0) { const float* dl = a.in[3] + (size_t)l * 256;
        const float s1 = wave_sum(dl[lane] * dl[64 + lane]), s2 = wave_sum(dl[128 + lane] * dl[192 + lane]);
        if (lane == 0) lamw[0] = expf(s1) - expf(s2) + lam_init; }
    bf16x8 qf[4];
#pragma unroll
    for (int d0 = 0; d0 < 4; ++d0) qf[d0] = *(const bf16x8*)(PROJ + (size_t)tq * PITCH + C_AQ + 128 * h + 64 * map + 16 * d0 + 8 * hi);
    DiffFn fn; astate_init<4>(fn.st); fn.lut = lut; fn.tq = tq; fn.tmin = q0 + 32 * qs; fn.tmax = q0 + 32 * qs + 31; fn.lane = lane;
    LAS unsigned char* const qlds = lds + 67584 + tid * 16;
#pragma unroll
    for (int d0 = 0; d0 < 4; ++d0) *(LAS bf16x8*)(qlds + d0 * 8192) = qf[d0];
    kv_loop<16, 16, false, 1, true>(fn, qf, qlds, 8 * map, PROJ + C_AK + 128 * h, PROJ + C_AV + 128 * h, nullptr, PITCH, 0, 2 * (qb + 1), lds, lds + 32768, lds, tid, lane);
    const float lt = fn.st.l + __shfl_xor(fn.st.l, 32), inv = 1.0f / lt;
    LAS float* ex = (LAS float*)(lds + qs * 16384);
    if (map == 1) {
#pragma unroll
        for (int dt = 0; dt < 4; ++dt)
#pragma unroll
            for (int r = 0; r < 16; ++r) ex[(32 * dt + crow(r, hi)) * 32 + r32] = fn.st.o[dt][r] * inv;
    }
    __syncthreads();
    if (map == 0) {
        const float lam = lamw[0]; float ss = 0.f;
#pragma unroll
        for (int dt = 0; dt < 4; ++dt)
#pragma unroll
            for (int r = 0; r < 16; ++r) { const float v = fn.st.o[dt][r] * inv - lam * ex[(32 * dt + crow(r, hi)) * 32 + r32]; fn.st.o[dt][r] = v; ss += v * v; }
        ss += __shfl_xor(ss, 32);
        const float rstd = (1.0f / sqrtf(ss * (1.0f / 128.0f) + RMS_EPS)) * (1.0f - lam_init);
        const float* sub = a.in[4] + (size_t)l * 128; bf16* orow = MIX + (size_t)tq * D + 128 * h;
#pragma unroll
        for (int dt = 0; dt < 4; ++dt)
#pragma unroll
            for (int q4 = 0; q4 < 4; ++q4) { const int d = 32 * dt + 8 * q4 + 4 * hi; const f32x4 g = *(const f32x4*)(sub + d);
                u32x2 w; w.x = cvtpk(fn.st.o[dt][4 * q4] * rstd * g.x, fn.st.o[dt][4 * q4 + 1] * rstd * g.y); w.y = cvtpk(fn.st.o[dt][4 * q4 + 2] * rstd * g.z, fn.st.o[dt][4 * q4 + 3] * rstd * g.w);
                *(u32x2*)(orow + d) = w; }
    }
    __syncthreads();
}

#ifndef NSA_DUP
#define NSA_DUP 0
#endif
constexpr int IMP_P = 132;
__device__ __forceinline__ float quad_sum(float v) {
    v += __builtin_bit_cast(float, __builtin_amdgcn_mov_dpp(__builtin_bit_cast(int, v), 0xB1, 0xF, 0xF, true));
    v += __builtin_bit_cast(float, __builtin_amdgcn_mov_dpp(__builtin_bit_cast(int, v), 0x4E, 0xF, 0xF, true));
    return v; }
#define LADD(p, v) (void)__hip_atomic_fetch_add((p), (v), __ATOMIC_RELAXED, __HIP_MEMORY_SCOPE_WORKGROUP)
constexpr int NSA_QF = 32768, NSA_SELW = 65536, NSA_LUT = 66560, NSA_IMP = 69632, NSA_FIN = 69632;

struct CmpStatFn {
    float m, l; int tq, lane, ncnt;
    __device__ __forceinline__ bool need(int) const { return true; }
    __device__ __forceinline__ void tile(int t, f32x16& p0, f32x16& p1, LAS const unsigned char*, LAS const unsigned char*) {
        const int hi = lane >> 5, n0 = 64 * t;
#pragma unroll
        for (int r = 0; r < 16; ++r) { const int n = n0 + crow(r, hi);
            p0[r] = (16 * n + 31 <= tq) ? p0[r] * SCL2 : NEG; p1[r] = (16 * (n + 32) + 31 <= tq) ? p1[r] * SCL2 : NEG; }
        softmax_stats(m, l, p0, p1);
    }
};
struct CmpPvFn {
    f32x16 o[2]; float m, invl; int tq, ql, lane; LAS float* imp;
    __device__ __forceinline__ bool need(int) const { return true; }
    __device__ __forceinline__ void tile(int t, f32x16& p0, f32x16& p1, LAS const unsigned char* vt, LAS const unsigned char*) {
        const int hi = lane >> 5, n0 = 64 * t;
#pragma unroll
        for (int r = 0; r < 16; ++r) { const int n = n0 + crow(r, hi);
            p0[r] = (16 * n + 31 <= tq) ? __builtin_amdgcn_exp2f(p0[r] * SCL2 - m) * invl : 0.f;
            p1[r] = (16 * (n + 32) + 31 <= tq) ? __builtin_amdgcn_exp2f(p1[r] * SCL2 - m) * invl : 0.f; }
        LAS float* row = imp + ql * IMP_P;
        const bool lead = (lane & 3) == 0;
#pragma unroll
        for (int a = 0; a < 4; ++a) {
            const int j0 = (n0 >> 2) + 2 * a + hi, j1 = j0 + 8;
            const float h0 = quad_sum(0.5f * p0[4 * a + 3]), h1 = quad_sum(0.5f * p1[4 * a + 3]);
            const float b0 = quad_sum(p0[4 * a] + p0[4 * a + 1] + p0[4 * a + 2]) + h0, b1 = quad_sum(p1[4 * a] + p1[4 * a + 1] + p1[4 * a + 2]) + h1;
            if (lead) {
                LADD(row + j0, b0);
                if (j0 + 1 < 128) LADD(row + j0 + 1, h0);
                if (j1 < 128) LADD(row + j1, b1);
                if (j1 + 1 < 128) LADD(row + j1 + 1, h1);
            }
        }
        bf16x8 pw[4]; pack_p(pw, p0, p1);
        pv_tile<2>(o, pw, vt, lane);
    }
};
struct SelFn {
    AState<2> st; LAS const float* lut; int tq, tmin, tmax, lane, mode; unsigned sw0, sw1, sw2, sw3, uw0, uw1, uw2, uw3;
    __device__ __forceinline__ unsigned pick(int j, unsigned a, unsigned b, unsigned c, unsigned d) const { const int w = j >> 5; const unsigned x = (w == 0) ? a : (w == 1) ? b : (w == 2) ? c : d; return (x >> (j & 31)) & 1u; }
    __device__ __forceinline__ bool need(int t) const { return mode == 1 || pick(t, uw0, uw1, uw2, uw3) != 0u; }
    __device__ __forceinline__ void tile(int t, f32x16& p0, f32x16& p1, LAS const unsigned char* vt, LAS const unsigned char*) {
        const int hi = lane >> 5, k0 = 64 * t;
        const bool bit = (mode == 1) || pick(t, sw0, sw1, sw2, sw3) != 0u;
        const bool far = k0 + 63 + 127 <= tmin;
        const bool wcut = (mode == 1) && (tmax - k0 >= 512);
        const float mref = st.m;
        if (far && !wcut) {
            const float b = lut[127] - mref;
#pragma unroll
            for (int r = 0; r < 16; ++r) { p0[r] = bit ? p0[r] * SCL2 + b : NEG; p1[r] = bit ? p1[r] * SCL2 + b : NEG; }
        } else {
#pragma unroll
            for (int r = 0; r < 16; ++r) { const int rel0 = tq - (k0 + crow(r, hi));
                const float b0 = lut[min(max(rel0, 0), 127)] - mref;
                const bool ok0 = bit && rel0 >= 0 && (mode == 0 || rel0 < 512);
                p0[r] = ok0 ? p0[r] * SCL2 + b0 : NEG; }
            __builtin_amdgcn_sched_barrier(0);
#pragma unroll
            for (int r = 0; r < 16; ++r) { const int rel1 = tq - (k0 + 32 + crow(r, hi));
                const float b1 = lut[min(max(rel1, 0), 127)] - mref;
                const bool ok1 = bit && rel1 >= 0 && (mode == 0 || rel1 < 512);
                p1[r] = ok1 ? p1[r] * SCL2 + b1 : NEG; }
            __builtin_amdgcn_sched_barrier(0);
        }
        softmax_pv<2>(st, p0, p1, vt, lane);
    }
};

__device__ __forceinline__ void nsa_unit(int g, int qb, const Args& a, const bf16* PROJ, const float* AUX, const bf16* KC, const bf16* VC, bf16* MIX, LAS unsigned char* lds, int tid, int wid, int lane) {
    const int r32 = lane & 31, hi = lane >> 5, q0 = 64 * qb, cur = qb, ql = 8 * wid + (r32 >> 2), hp = r32 & 3, tq = q0 + ql, head = 4 * g + hp;
    LAS float* imp = (LAS float*)(lds + NSA_IMP); LAS unsigned* selw = (LAS unsigned*)(lds + NSA_SELW); LAS float* lut = (LAS float*)(lds + NSA_LUT);
#pragma unroll
    for (int i = 0; i < 17; ++i) { const int e_ = tid + 512 * i; if (e_ < 64 * IMP_P) imp[e_] = 0.f; }
    if (tid < 256) selw[tid] = 0u;
    lut[tid] = a.in[12][t5_bucket(tid & 127) * 20 + 4 + 4 * g + (tid >> 7)] * LOG2E;
    bf16x8 qf[4];
#pragma unroll
    for (int d0 = 0; d0 < 4; ++d0) qf[d0] = *(const bf16x8*)(PROJ + (size_t)tq * PITCH + C_CQ + 64 * head + 16 * d0 + 8 * hi);
    LAS unsigned char* const qlds = lds + NSA_QF + tid * 16;
#pragma unroll
    for (int d0 = 0; d0 < 4; ++d0) *(LAS bf16x8*)(qlds + d0 * 8192) = qf[d0];
    const float* ga = AUX + (size_t)tq * 64 + 8 + head;
    const float gc = 1.0f / (1.0f + __expf(-ga[0])), gs = 1.0f / (1.0f + __expf(-ga[16])), gwn = 1.0f / (1.0f + __expf(-ga[32]));
    LAS float* finl = (LAS float*)(lds + NSA_FIN) + tid;
    f32x16 oc0, oc1;
    {
        int ncnt = (q0 + 32) / 16 + 1; ncnt = ncnt > 511 ? 511 : ncnt; const int ntc = (ncnt + 63) >> 6;
        const bf16* kc = KC + (size_t)g * 512 * 64; const bf16* vc = VC + (size_t)g * 512 * 64;
        CmpStatFn f1; f1.m = NEG; f1.l = 0.f; f1.tq = tq; f1.lane = lane; f1.ncnt = ncnt;
        kv_loop<8, 8, false, 1, true>(f1, qf, qlds, 0, kc, vc, nullptr, 64, 0, ntc, lds, lds + 16384, lds, tid, lane);
        if (NSA_DUP & 1) { f1.m = NEG; f1.l = 0.f; kv_loop<8, 8, false, 1, true>(f1, qf, qlds, 0, kc, vc, nullptr, 64, 0, ntc, lds, lds + 16384, lds, tid, lane); }
        const float lt = f1.l + __shfl_xor(f1.l, 32);
        CmpPvFn f2; f2.o[0] = (f32x16){}; f2.o[1] = (f32x16){}; f2.m = f1.m; f2.invl = (tq >= 31) ? 1.0f / lt : 0.f; f2.tq = tq; f2.ql = ql; f2.lane = lane; f2.imp = imp;
        if (NSA_DUP & 16) { kv_loop<8, 8, false, 1, true>(f2, qf, qlds, 0, kc, vc, nullptr, 64, 0, ntc, lds, lds + 16384, lds, tid, lane); f2.o[0] = (f32x16){}; f2.o[1] = (f32x16){};
#pragma unroll
            for (int i = 0; i < 17; ++i) { const int e_ = tid + 512 * i; if (e_ < 64 * IMP_P) imp[e_] = 0.f; }
            __syncthreads(); }
        kv_loop<8, 8, false, 1, true>(f2, qf, qlds, 0, kc, vc, nullptr, 64, 0, ntc, lds, lds + 16384, lds, tid, lane);
        oc0 = f2.o[0]; oc1 = f2.o[1];
    }
    for (int rep_ = 0; rep_ < ((NSA_DUP & 2) ? 2 : 1); ++rep_)
    if (cur < 16) { if (tid < 64) selw[tid * 4] = (2u << cur) - 1u; }
    else {
        const int qq = tid >> 3, sub = tid & 7;
        float val[16];
#pragma unroll
        for (int i = 0; i < 16; ++i) { const int j = 16 * sub + i; val[i] = (j >= 1 && j <= cur - 2) ? imp[qq * IMP_P + j] : -1.0f; }
        unsigned bits = 0u;
        for (int round = 0; round < 13; ++round) {
            float bv = val[0]; int bi = 0;
#pragma unroll
            for (int i = 1; i < 16; ++i) if (val[i] > bv) { bv = val[i]; bi = i; }
            int gj = 16 * sub + bi;
            { const float ov = __builtin_bit_cast(float, __builtin_amdgcn_mov_dpp(__builtin_bit_cast(int, bv), 0xB1, 0xF, 0xF, true)); const int oj = __builtin_amdgcn_mov_dpp(gj, 0xB1, 0xF, 0xF, true); if (ov > bv || (ov == bv && oj < gj)) { bv = ov; gj = oj; } }
            { const float ov = __builtin_bit_cast(float, __builtin_amdgcn_mov_dpp(__builtin_bit_cast(int, bv), 0x4E, 0xF, 0xF, true)); const int oj = __builtin_amdgcn_mov_dpp(gj, 0x4E, 0xF, 0xF, true); if (ov > bv || (ov == bv && oj < gj)) { bv = ov; gj = oj; } }
            { const float ov = __shfl_xor(bv, 4); const int oj = __shfl_xor(gj, 4); if (ov > bv || (ov == bv && oj < gj)) { bv = ov; gj = oj; } }
            const bool mine = (gj >> 4) == sub;
#pragma unroll
            for (int i = 0; i < 16; ++i) if (mine && (gj & 15) == i) { val[i] = -2.0f; bits |= 1u << i; }
        }
        if (sub == 0) bits |= 1u;
        if (((cur - 1) >> 4) == sub) bits |= 1u << ((cur - 1) & 15);
        if ((cur >> 4) == sub) bits |= 1u << (cur & 15);
        (void)__hip_atomic_fetch_or(selw + qq * 4 + (sub >> 1), bits << (16 * (sub & 1)), __ATOMIC_RELAXED, __HIP_MEMORY_SCOPE_WORKGROUP);
    }
    __syncthreads();
#pragma unroll
    for (int r = 0; r < 16; ++r) { finl[512 * r] = gc * oc0[r]; finl[512 * (16 + r)] = gc * oc1[r]; }
    SelFn fs; fs.lut = lut + hp * 128; fs.tq = tq; fs.tmin = q0 + 8 * wid; fs.tmax = q0 + 8 * wid + 7; fs.lane = lane;
    fs.sw0 = selw[ql * 4 + 0]; fs.sw1 = selw[ql * 4 + 1]; fs.sw2 = selw[ql * 4 + 2]; fs.sw3 = selw[ql * 4 + 3];
    { unsigned u0 = 0u, u1 = 0u, u2 = 0u, u3 = 0u;
#pragma unroll
      for (int i = 0; i < 8; ++i) { u0 |= selw[(8 * wid + i) * 4 + 0]; u1 |= selw[(8 * wid + i) * 4 + 1]; u2 |= selw[(8 * wid + i) * 4 + 2]; u3 |= selw[(8 * wid + i) * 4 + 3]; }
      fs.uw0 = __builtin_amdgcn_readfirstlane(u0); fs.uw1 = __builtin_amdgcn_readfirstlane(u1); fs.uw2 = __builtin_amdgcn_readfirstlane(u2); fs.uw3 = __builtin_amdgcn_readfirstlane(u3); }
    fs.mode = 0; astate_init<2>(fs.st);
    kv_loop<8, 8, false, 1, false>(fs, qf, qlds, 0, PROJ + C_KS + 64 * g, PROJ + C_VS + 64 * g, nullptr, PITCH, 0, cur + 1, lds, lds + 16384, lds, tid, lane);
    if (NSA_DUP & 4) { astate_init<2>(fs.st); kv_loop<8, 8, false, 1, false>(fs, qf, qlds, 0, PROJ + C_KS + 64 * g, PROJ + C_VS + 64 * g, nullptr, PITCH, 0, cur + 1, lds, lds + 16384, lds, tid, lane); }
    { const float lt = fs.st.l + __shfl_xor(fs.st.l, 32), sc = gs / lt;
#pragma unroll
      for (int r = 0; r < 16; ++r) { finl[512 * r] += sc * fs.st.o[0][r]; finl[512 * (16 + r)] += sc * fs.st.o[1][r]; } }
    fs.mode = 1; astate_init<2>(fs.st);
    kv_loop<8, 8, false, 1, false>(fs, qf, qlds, 0, PROJ + C_KW + 64 * g, PROJ + C_VW + 64 * g, nullptr, PITCH, cur >= 8 ? cur - 8 : 0, cur + 1, lds, lds + 16384, lds, tid, lane);
    if (NSA_DUP & 8) { astate_init<2>(fs.st); kv_loop<8, 8, false, 1, false>(fs, qf, qlds, 0, PROJ + C_KW + 64 * g, PROJ + C_VW + 64 * g, nullptr, PITCH, cur >= 8 ? cur - 8 : 0, cur + 1, lds, lds + 16384, lds, tid, lane); }
    { const float lt = fs.st.l + __shfl_xor(fs.st.l, 32), sc = gwn / lt;
#pragma unroll
      for (int r = 0; r < 16; ++r) { fs.st.o[0][r] = finl[512 * r] + sc * fs.st.o[0][r]; fs.st.o[1][r] = finl[512 * (16 + r)] + sc * fs.st.o[1][r]; } }
    bf16* orow = MIX + (size_t)tq * D + 1024 + 64 * head;
#pragma unroll
    for (int dt = 0; dt < 2; ++dt)
#pragma unroll
        for (int q4 = 0; q4 < 4; ++q4) { u32x2 w; w.x = cvtpk(fs.st.o[dt][4 * q4], fs.st.o[dt][4 * q4 + 1]); w.y = cvtpk(fs.st.o[dt][4 * q4 + 2], fs.st.o[dt][4 * q4 + 3]); *(u32x2*)(orow + 32 * dt + 8 * q4 + 4 * hi) = w; }
}

__device__ __forceinline__ int dequeue(unsigned* head, volatile LAS unsigned* slot, int tid) {
    if (tid == 0) *slot = __hip_atomic_fetch_add(head, 1u, __ATOMIC_RELAXED, __HIP_MEMORY_SCOPE_AGENT);
    __syncthreads();
    const int v = __builtin_amdgcn_readfirstlane((int)*slot);
    __syncthreads();
    return v;
}

constexpr int N2_HP = 4112, N2_PART = 66 * 1024, N2_LOG = 108 * 1024;
__device__ __forceinline__ void n2_unit(int u, int l, const Args& a, const bf16* X, bf16* XN, const bf16* RWT, unsigned* cnt, int* LIST, float* TW, LAS unsigned char* lds, int tid, int wid, int lane) {
    const float* gain = a.in[14] + (size_t)l * D;
#pragma unroll
    for (int rr = 0; rr < 2; ++rr) {
        const int lr = 2 * wid + rr, row = 16 * u + lr;
        const u32x2* xr = (const u32x2*)(X + (size_t)row * D) + lane;
        f32x4 v[8]; float ss = 0.f;
#pragma unroll
        for (int j = 0; j < 8; ++j) { const u32x2 r = xr[64 * j]; v[j] = (f32x4){bflo(r.x), bfhi(r.x), bflo(r.y), bfhi(r.y)}; ss += (v[j].x * v[j].x + v[j].y * v[j].y) + (v[j].z * v[j].z + v[j].w * v[j].w); }
        ss = wave_sum(ss);
        const float rstd = 1.0f / sqrtf(ss * (1.0f / D) + RMS_EPS);
        const f32x4* gr = (const f32x4*)gain + lane; u32x2* o8 = (u32x2*)(XN + (size_t)row * D) + lane;
#pragma unroll
        for (int j = 0; j < 8; ++j) { const f32x4 g = gr[64 * j]; u32x2 w; w.x = cvtpk(v[j].x * rstd * g.x, v[j].y * rstd * g.y); w.y = cvtpk(v[j].z * rstd * g.z, v[j].w * rstd * g.w);
            o8[64 * j] = w; *(LAS u32x2*)(lds + lr * N2_HP + (4 * lane + 256 * j) * 2) = w; }
    }
    __syncthreads();
    {
        const int fr = lane & 15, fq = lane >> 4;
        f32x4 acc[5];
#pragma unroll
        for (int nt = 0; nt < 5; ++nt) acc[nt] = (f32x4){0.f, 0.f, 0.f, 0.f};
        const bf16* rw = RWT + (size_t)l * 96 * D + (size_t)fr * D + 256 * wid + 8 * fq;
#pragma unroll
        for (int s = 0; s < 8; ++s) {
            const bf16x8 av = *(const LAS bf16x8*)(lds + fr * N2_HP + (256 * wid + 32 * s + 8 * fq) * 2);
#pragma unroll
            for (int nt = 0; nt < 5; ++nt) { const bf16x8 bv = *(const bf16x8*)(rw + (size_t)(16 * nt) * D + 32 * s); acc[nt] = MFMA16(av, bv, acc[nt]); }
        }
        LAS float* part = (LAS float*)(lds + N2_PART) + wid * 16 * 80;
#pragma unroll
        for (int nt = 0; nt < 5; ++nt)
#pragma unroll
            for (int i = 0; i < 4; ++i) part[(4 * fq + i) * 80 + 16 * nt + fr] = acc[nt][i];
    }
    __syncthreads();
    {
        LAS const float* part = (LAS const float*)(lds + N2_PART); LAS float* logit = (LAS float*)(lds + N2_LOG);
        for (int e = tid; e < 16 * 80; e += NTHR) { float s = 0.f;
#pragma unroll
            for (int w = 0; w < 8; ++w) s += part[w * 16 * 80 + e];
            logit[e] = s; }
    }
    __syncthreads();
    if (tid < 16) {
        LAS const float* lg = (LAS const float*)(lds + N2_LOG) + tid * 80;
        const float* bg = a.in[16] + l * 8; const float* be = a.in[18] + l * 64;
        float z[8]; float zm = -3.0e38f; int gi = 0;
#pragma unroll
        for (int i = 0; i < 8; ++i) { z[i] = lg[i] + bg[i]; if (z[i] > zm) { zm = z[i]; gi = i; } }
        float den = 0.f;
#pragma unroll
        for (int i = 0; i < 8; ++i) den += expf(z[i] - zm);
        const float gp = 1.0f / den;
        float e1 = -3.0e38f, e2 = -3.0e38f; int i1 = 0, i2 = 0;
#pragma unroll
        for (int i = 0; i < 8; ++i) { const float v = lg[8 + 8 * gi + i] + be[8 * gi + i];
            if (v > e1) { e2 = e1; i2 = i1; e1 = v; i1 = i; } else if (v > e2) { e2 = v; i2 = i; } }
        const float t2 = expf(e2 - e1), w1 = gp / (1.0f + t2), w2 = gp * t2 / (1.0f + t2);
        const int tok = 16 * u + tid, ea = 8 * gi + i1, eb = 8 * gi + i2;
        const unsigned pa = __hip_atomic_fetch_add(cnt + ea * 16, 1u, __ATOMIC_RELAXED, __HIP_MEMORY_SCOPE_AGENT);
        const unsigned pb = __hip_atomic_fetch_add(cnt + eb * 16, 1u, __ATOMIC_RELAXED, __HIP_MEMORY_SCOPE_AGENT);
        LIST[(size_t)ea * 16384 + pa] = 2 * tok; LIST[(size_t)eb * 16384 + pb] = 2 * tok + 1;
        TW[2 * tok] = w1; TW[2 * tok + 1] = w2;
    }
    __syncthreads();
}

constexpr int N2P_HALF = 16 * N2_HP, N2P_LOG = 2 * N2P_HALF;
__device__ __forceinline__ void n2_pair(int p, int l, const Args& a, const bf16* X, bf16* XN, const bf16* RWT, unsigned* cnt, int* LIST, float* TW, LAS unsigned char* lds, int tid, int wid, int lane) {
    const int half = wid >> 2, wl = wid & 3, u = 2 * p + half, th = tid & 255;
    LAS unsigned char* const hT = lds + half * N2P_HALF;
    const float* gain = a.in[14] + (size_t)l * D;
    {
        u32x2 raw[4][8];
#pragma unroll
        for (int rr = 0; rr < 4; ++rr) { const u32x2* xr = (const u32x2*)(X + (size_t)(16 * u + 4 * wl + rr) * D) + lane;
#pragma unroll
            for (int j = 0; j < 8; ++j) raw[rr][j] = xr[64 * j]; }
        f32x4 g[8]; { const f32x4* gr = (const f32x4*)gain + lane;
#pragma unroll
            for (int j = 0; j < 8; ++j) g[j] = gr[64 * j]; }
#pragma unroll
        for (int rr = 0; rr < 4; ++rr) {
            const int lr = 4 * wl + rr, row = 16 * u + lr;
            f32x4 v[8]; float ss = 0.f;
#pragma unroll
            for (int j = 0; j < 8; ++j) { const u32x2 r = raw[rr][j]; v[j] = (f32x4){bflo(r.x), bfhi(r.x), bflo(r.y), bfhi(r.y)}; ss += (v[j].x * v[j].x + v[j].y * v[j].y) + (v[j].z * v[j].z + v[j].w * v[j].w); }
            ss = wave_sum(ss);
            const float rstd = 1.0f / sqrtf(ss * (1.0f / D) + RMS_EPS);
            u32x2* o8 = (u32x2*)(XN + (size_t)row * D) + lane;
#pragma unroll
            for (int j = 0; j < 8; ++j) { u32x2 w; w.x = cvtpk(v[j].x * rstd * g[j].x, v[j].y * rstd * g[j].y); w.y = cvtpk(v[j].z * rstd * g[j].z, v[j].w * rstd * g[j].w);
                o8[64 * j] = w; *(LAS u32x2*)(hT + lr * N2_HP + (4 * lane + 256 * j) * 2) = w; }
        }
    }
    __syncthreads();
    const int fr = lane & 15, fq = lane >> 4;
    f32x4 acc[2][5];
#pragma unroll
    for (int hh = 0; hh < 2; ++hh)
#pragma unroll
        for (int nt = 0; nt < 5; ++nt) acc[hh][nt] = (f32x4){0.f, 0.f, 0.f, 0.f};
    {
        const bf16* rw = RWT + (size_t)l * 96 * D + (size_t)fr * D + 256 * wid + 8 * fq;
#pragma unroll 4
        for (int s = 0; s < 8; ++s) {
            const bf16x8 av0 = *(const LAS bf16x8*)(lds + fr * N2_HP + (256 * wid + 32 * s + 8 * fq) * 2);
            const bf16x8 av1 = *(const LAS bf16x8*)(lds + N2P_HALF + fr * N2_HP + (256 * wid + 32 * s + 8 * fq) * 2);
#pragma unroll
            for (int nt = 0; nt < 5; ++nt) { const bf16x8 bv = *(const bf16x8*)(rw + (size_t)(16 * nt) * D + 32 * s); acc[0][nt] = MFMA16(av0, bv, acc[0][nt]); acc[1][nt] = MFMA16(av1, bv, acc[1][nt]); }
        }
    }
    __syncthreads();
    {
        LAS float* part = (LAS float*)lds + wid * 32 * 80;
#pragma unroll
        for (int hh = 0; hh < 2; ++hh)
#pragma unroll
            for (int nt = 0; nt < 5; ++nt)
#pragma unroll
                for (int i = 0; i < 4; ++i) part[(16 * hh + 4 * fq + i) * 80 + 16 * nt + fr] = acc[hh][nt][i];
    }
    __syncthreads();
    {
        LAS const float* part = (LAS const float*)lds; LAS float* logit = (LAS float*)(lds + N2P_LOG);
        for (int e = tid; e < 32 * 80; e += NTHR) { float sres = 0.f;
#pragma unroll
            for (int w = 0; w < 8; ++w) sres += part[w * 32 * 80 + e];
            logit[e] = sres; }
    }
    __syncthreads();
    if (th < 16) {
        LAS const float* lg = (LAS const float*)(lds + N2P_LOG) + (16 * half + th) * 80;
        const float* bg = a.in[16] + l * 8; const float* be = a.in[18] + l * 64;
        float z[8]; float zm = -3.0e38f; int gi = 0;
#pragma unroll
        for (int i = 0; i < 8; ++i) { z[i] = lg[i] + bg[i]; if (z[i] > zm) { zm = z[i]; gi = i; } }
        float den = 0.f;
#pragma unroll
        for (int i = 0; i < 8; ++i) den += expf(z[i] - zm);
        const float gp = 1.0f / den;
        float e1 = -3.0e38f, e2 = -3.0e38f; int i1 = 0, i2 = 0;
#pragma unroll
        for (int i = 0; i < 8; ++i) { const float v = lg[8 + 8 * gi + i] + be[8 * gi + i];
            if (v > e1) { e2 = e1; i2 = i1; e1 = v; i1 = i; } else if (v > e2) { e2 = v; i2 = i; } }
        const float t2 = expf(e2 - e1), w1 = gp / (1.0f + t2), w2 = gp * t2 / (1.0f + t2);
        const int tok = 16 * u + th, ea = 8 * gi + i1, eb = 8 * gi + i2;
        const unsigned pa = __hip_atomic_fetch_add(cnt + ea * 16, 1u, __ATOMIC_RELAXED, __HIP_MEMORY_SCOPE_AGENT);
        const unsigned pb = __hip_atomic_fetch_add(cnt + eb * 16, 1u, __ATOMIC_RELAXED, __HIP_MEMORY_SCOPE_AGENT);
        LIST[(size_t)ea * 16384 + pa] = 2 * tok; LIST[(size_t)eb * 16384 + pb] = 2 * tok + 1;
        TW[2 * tok] = w1; TW[2 * tok + 1] = w2;
    }
    __syncthreads();
}

constexpr int MO_B = 65536, MO_BBUF = 16384, MO_A = 98304, MO_APITCH = 2176, MO_ABUF = 4 * MO_APITCH, MO_ROW = MO_A + 2 * MO_ABUF, MO_PRE = MO_ROW + 512;
constexpr int MO_STG = 117760;
static_assert(MO_PRE + 272 <= MO_STG && MO_STG + 8 * 4096 <= MISC_OFF, "MoE LDS map");
__device__ __forceinline__ int mo_aoff(int row, int c) { return c * MO_APITCH + ((row + 2 * c) << 4); }
__device__ __forceinline__ int mo_hoff(int row, int c) { return c * 2048 + (row << 4); }

struct MoBStage { f32x4 v[4]; };
__device__ __forceinline__ void mo_gl16(f32x4& d, const float* p) { asm volatile("global_load_dwordx4 %0, %1, off" : "=v"(d) : "v"(p) : "memory"); }
__device__ __forceinline__ void mo_gl16u(u32x4& d, const bf16* p) { asm volatile("global_load_dwordx4 %0, %1, off" : "=v"(d) : "v"(p) : "memory"); }
__device__ __forceinline__ void mo_bload(MoBStage& sg, const float* src0, const float* src1, size_t ld, int k0, int tid) {
    const int n4 = tid & 63, kg = tid >> 6;
    const float* p = (n4 < 32 ? src0 + 4 * n4 : src1 + 4 * (n4 - 32)) + (size_t)(k0 + 4 * kg) * ld;
    mo_gl16(sg.v[0], p); mo_gl16(sg.v[1], p + ld); mo_gl16(sg.v[2], p + 2 * ld); mo_gl16(sg.v[3], p + 3 * ld);
}
#define MO_WAIT5(N, SB, SA) asm volatile("s_waitcnt vmcnt(" #N ")" : "+v"(SB.v[0]), "+v"(SB.v[1]), "+v"(SB.v[2]), "+v"(SB.v[3]), "+v"(SA) :: "memory")
#define MO_WAIT4(N, SB) asm volatile("s_waitcnt vmcnt(" #N ")" : "+v"(SB.v[0]), "+v"(SB.v[1]), "+v"(SB.v[2]), "+v"(SB.v[3]) :: "memory")
__device__ __forceinline__ void mo_bwrite(const MoBStage& sg, LAS unsigned char* bb, int tid) {
    const int n4 = tid & 63, kg = tid >> 6;
#pragma unroll
    for (int i = 0; i < 4; ++i) { u32x2 w; w.x = cvtpk(sg.v[0][i], sg.v[1][i]); w.y = cvtpk(sg.v[2][i], sg.v[3][i]);
        *(LAS u32x2*)(bb + (kg >> 1) * 4096 + (32 * (n4 >> 3) + 8 * i + (n4 & 7)) * 16 + 8 * (kg & 1)) = w; }
}
#define MO_READ(AP, ASTEP, BP, B1OFF) bf16x8 fb0_[2], fb1_[2], fa_[2][2]; \
    _Pragma("unroll") for (int s_ = 0; s_ < 2; ++s_) { fb0_[s_] = *(const LAS bf16x8*)((BP) + s_ * 8192); fb1_[s_] = *(const LAS bf16x8*)((BP) + s_ * 8192 + (B1OFF)); \
        _Pragma("unroll") for (int mt = 0; mt < 2; ++mt) fa_[s_][mt] = *(const LAS bf16x8*)((AP) + s_ * (ASTEP) + mt * 512); } \
    __builtin_amdgcn_sched_barrier(0)
#define MO_MMA(ACC0, ACC1) do { __builtin_amdgcn_sched_barrier(0); _Pragma("unroll") for (int s_ = 0; s_ < 2; ++s_) _Pragma("unroll") for (int mt = 0; mt < 2; ++mt) { \
        ACC0[mt] = MFMA32(fa_[s_][mt], fb0_[s_], ACC0[mt]); ACC1[mt] = MFMA32(fa_[s_][mt], fb1_[s_], ACC1[mt]); } __builtin_amdgcn_sched_barrier(0); } while (0)

__device__ __forceinline__ void moe_unit(int e, int c0, int nrows, const bf16* XN, const int* LIST, const float* Wg, const float* Wu, const float* Wd, bf16* YB, LAS unsigned char* lds, int tid, int wid, int lane) {
    const int r32 = lane & 31, hi = lane >> 5, wn = wid & 3, wm = wid >> 2;
    LAS int* rowid = (LAS int*)(lds + MO_ROW);
    if (tid < 128) rowid[tid] = (tid < nrows) ? LIST[(size_t)e * 16384 + c0 + tid] : -1;
    __syncthreads();
    const float* wg = Wg + (size_t)e * D * 256; const float* wu = Wu + (size_t)e * D * 256; const float* wd = Wd + (size_t)e * 256 * D;
    f32x16 acc0[2], acc1[2];
#define MO_ZERO() do { acc0[0] = (f32x16){}; acc0[1] = (f32x16){}; acc1[0] = (f32x16){}; acc1[1] = (f32x16){}; } while (0)
    MO_ZERO();
    MoBStage s0, s1, s2, s3; u32x4 a0, a1, a2, a3;
    {
        const int arow = tid >> 2, ac = tid & 3; const int rid = rowid[arow]; const bf16* asrc = XN + (size_t)((rid < 0 ? 0 : rid) >> 1) * D + 8 * ac;
        LAS unsigned char* const awr = lds + MO_A + mo_aoff(arow, ac);
        LAS const unsigned char* const ard = lds + MO_A + mo_aoff(64 * wm + r32, hi);
        LAS const unsigned char* const brd = lds + MO_B + hi * 4096 + (32 * wn + r32) * 16;
#define G1_LOAD(SB, SA, t) do { const int t_ = (t); mo_gl16u(SA, asrc + 32 * (t_ & 63)); mo_bload(SB, wg + 128 * (t_ >> 6), wu + 128 * (t_ >> 6), 256, 32 * (t_ & 63), tid); } while (0)
#define G1_WRITE(SB, SA, b) do { *(LAS u32x4*)(awr + (b) * MO_ABUF) = SA; mo_bwrite(SB, lds + MO_B + (b) * MO_BBUF, tid); } while (0)
#define G1_STEP(t, b, SBL, SAL, SBW, SAW) do { const int tt_ = (t); \
            MO_READ(ard + (b) * MO_ABUF, 2 * MO_APITCH + 64, brd + (b) * MO_BBUF, 2048);     \
            G1_LOAD(SBL, SAL, (tt_ + 4 < 128 ? tt_ + 4 : 127));     \
            __builtin_amdgcn_sched_barrier(0); \
            MO_WAIT5(15, SBW, SAW); \
            if (tt_ + 1 < 128) G1_WRITE(SBW, SAW, (b) ^ 1); \
            MO_MMA(acc0, acc1); \
            if ((tt_ & 63) == 63) {     \
                const int col_ = 128 * (tt_ >> 6) + 32 * wn + 4 * (r32 & 7) + (r32 >> 3), cch_ = col_ >> 3; \
                _Pragma("unroll") for (int mt = 0; mt < 2; ++mt) _Pragma("unroll") for (int r = 0; r < 16; ++r) { const float gt = acc0[mt][r], up = acc1[mt][r]; const float hv = gt / (1.0f + __expf(-gt)) * up; \
                    *(LAS unsigned short*)(lds + mo_hoff(64 * wm + 32 * mt + crow(r, hi), cch_) + (col_ & 7) * 2) = f2bf16(hv); } \
                MO_ZERO(); } \
            __syncthreads(); } while (0)
        G1_LOAD(s0, a0, 0); G1_LOAD(s1, a1, 1); G1_LOAD(s2, a2, 2); G1_LOAD(s3, a3, 3);
        MO_WAIT5(15, s0, a0);
        G1_WRITE(s0, a0, 0);
        __syncthreads();
        for (int t = 0; t < 128; t += 4) {
            G1_STEP(t, 0, s0, a0, s1, a1);
            G1_STEP(t + 1, 1, s1, a1, s2, a2);
            G1_STEP(t + 2, 0, s2, a2, s3, a3);
            G1_STEP(t + 3, 1, s3, a3, s0, a0);
        }
        asm volatile("s_waitcnt vmcnt(0)" : "+v"(s0.v[0]), "+v"(s0.v[1]), "+v"(s0.v[2]), "+v"(s0.v[3]), "+v"(s1.v[0]), "+v"(s1.v[1]), "+v"(s1.v[2]), "+v"(s1.v[3]), "+v"(s2.v[0]), "+v"(s2.v[1]), "+v"(s2.v[2]), "+v"(s2.v[3]),
                     "+v"(s3.v[0]), "+v"(s3.v[1]), "+v"(s3.v[2]), "+v"(s3.v[3]), "+v"(a0), "+v"(a1), "+v"(a2), "+v"(a3) :: "memory");
#undef G1_LOAD
#undef G1_WRITE
#undef G1_STEP
    }
    {
        LAS const unsigned char* const hrd = lds + mo_hoff(64 * wm + r32, hi);
        LAS const unsigned char* const brd = lds + MO_B + hi * 4096 + (64 * wn + r32) * 16;
#define G2_LOAD(SB, t) do { const int t_ = (t); mo_bload(SB, wd + 256 * (t_ >> 3), wd + 256 * (t_ >> 3) + 128, D, 32 * (t_ & 7), tid); } while (0)
#define G2_STEP(t, b, SBL, SBW) do { const int tt_ = (t); \
            MO_READ(hrd + (tt_ & 7) * 8192, 4096, brd + (b) * MO_BBUF, 512); \
            G2_LOAD(SBL, (tt_ + 4 < 64 ? tt_ + 4 : 63)); \
            __builtin_amdgcn_sched_barrier(0); \
            MO_WAIT4(12, SBW); \
            if (tt_ + 1 < 64) mo_bwrite(SBW, lds + MO_B + ((b) ^ 1) * MO_BBUF, tid); \
            MO_MMA(acc0, acc1); \
            if ((tt_ & 7) == 7) {     \
                LAS unsigned char* const stg_ = lds + MO_STG + wid * 4096; const int cidx_ = 4 * (r32 & 7) + (r32 >> 3); \
                _Pragma("unroll") for (int mt = 0; mt < 2; ++mt) { \
                    _Pragma("unroll") for (int r = 0; r < 16; ++r) { const int row_ = crow(r, hi); \
                        *(LAS unsigned short*)(stg_ + row_ * 128 + cidx_ * 2) = f2bf16(acc0[mt][r]); *(LAS unsigned short*)(stg_ + row_ * 128 + (cidx_ + 32) * 2) = f2bf16(acc1[mt][r]); } \
                    _Pragma("unroll") for (int k = 0; k < 4; ++k) { const int idx_ = lane + 64 * k, row_ = idx_ >> 3, ch_ = idx_ & 7; \
                        const u32x4 v_ = *(const LAS u32x4*)(stg_ + row_ * 128 + ch_ * 16); const int rr = rowid[64 * wm + 32 * mt + row_]; \
                        if (rr >= 0) *(u32x4*)(YB + (size_t)rr * D + 256 * (tt_ >> 3) + 64 * wn + 8 * ch_) = v_; } } \
                MO_ZERO(); } \
            __syncthreads(); } while (0)
        G2_LOAD(s0, 0); G2_LOAD(s1, 1); G2_LOAD(s2, 2); G2_LOAD(s3, 3);
        MO_WAIT4(12, s0);
        mo_bwrite(s0, lds + MO_B, tid);
        __syncthreads();
        for (int t = 0; t < 64; t += 4) {
            G2_STEP(t, 0, s0, s1);
            G2_STEP(t + 1, 1, s1, s2);
            G2_STEP(t + 2, 0, s2, s3);
            G2_STEP(t + 3, 1, s3, s0);
        }
        asm volatile("s_waitcnt vmcnt(0)" : "+v"(s0.v[0]), "+v"(s0.v[1]), "+v"(s0.v[2]), "+v"(s0.v[3]), "+v"(s1.v[0]), "+v"(s1.v[1]), "+v"(s1.v[2]), "+v"(s1.v[3]), "+v"(s2.v[0]), "+v"(s2.v[1]), "+v"(s2.v[2]), "+v"(s2.v[3]),
                     "+v"(s3.v[0]), "+v"(s3.v[1]), "+v"(s3.v[2]), "+v"(s3.v[3]) :: "memory");
#undef G2_LOAD
#undef G2_STEP
    }
#undef MO_ZERO
}

constexpr int N_PHASES = 1 + 7 * DEPTH;
#ifndef PH_MASK
#define PH_MASK 0xFFFF
#endif
#define PHON(k) (((PH_MASK) >> (k)) & 1)
#ifndef DUP_MASK
#define DUP_MASK 0
#endif
#define DUPON(k) ((((DUP_MASK) >> (k)) & 1) && (l == 0 || (((0x3FE) >> (k)) & 1)))
#ifndef MK_ONE_LAUNCH
#define MK_ONE_LAUNCH 1
#endif

__global__ void __launch_bounds__(NTHR, 2) fwd_kernel(Args args) {
    extern __shared__ __attribute__((aligned(16))) unsigned char lds_raw[];
    LAS unsigned char* lds = (LAS unsigned char*)lds_raw;
    volatile LAS unsigned* MISC = (volatile LAS unsigned*)(lds + MISC_OFF);
    const int wid = __builtin_amdgcn_readfirstlane(threadIdx.x >> 6);
    const int G = gridDim.x, bid = blockIdx.x;
    unsigned char* ws = args.ws;
    unsigned* const ctl0 = (unsigned*)(ws + WS_CTL);
    if (threadIdx.x < 64) MISC[threadIdx.x] = 0u;
    __syncthreads();
    const int lo = args.ph_lo, hi_ph = args.ph_hi;
    XcdBarrier bar; bar.bar = ctl0 + CW_BAR; bar.x = 0; bar.st = MISC + 8; bar.w0 = 0;
    if (hi_ph - lo > 1) bar = xcd_barrier_post(ctl0 + CW_BAR, MISC + 8);
#define IN(k) (lo <= (k) && (k) < hi_ph)
#define FRESH() int wid_ = wid; asm volatile("" : "+s"(wid_)); int lane_; asm volatile("v_mbcnt_lo_u32_b32 %0, -1, 0\n\tv_mbcnt_hi_u32_b32 %0, -1, %0" : "=v"(lane_)); const int tid_ = wid_ * 64 + lane_; (void)tid_
#define SEAM(k) do { if (IN(k) && IN((k) + 1)) xcd_barrier(bar); } while (0)

    const int NGW = G * NWAVES;

    if (PHON(0) && IN(0)) { FRESH(); p0_prologue(args, lds, bid, G, tid_, wid_, lane_); if ((DUP_MASK) & 1) p0_prologue(args, lds, bid, G, tid_, wid_, lane_); }
    SEAM(0);

#pragma unroll 1
    for (int lraw = 0; lraw < DEPTH; ++lraw) {
        int l = lraw; asm volatile("" : "+s"(l));
        GAS unsigned char* wsg = (GAS unsigned char*)ws; asm volatile("" : "+s"(wsg)); unsigned char* const wsl = (unsigned char*)wsg;
        unsigned* const ctl = (unsigned*)(wsl + WS_CTL);
        bf16* const WIN = (bf16*)(wsl + WS_WIN); bf16* const WOUT = (bf16*)(wsl + WS_WOUT); bf16* const W1T = (bf16*)(wsl + WS_W1T); bf16* const W2T = (bf16*)(wsl + WS_W2T); bf16* const RWT = (bf16*)(wsl + WS_RWT);
        float* const C1 = (float*)(wsl + WS_C1); bf16* const X = (bf16*)(wsl + WS_X); bf16* const XN = (bf16*)(wsl + WS_XN); bf16* const PROJ = (bf16*)(wsl + WS_PROJ); float* const AUX = (float*)(wsl + WS_AUX);
        float* const CUM = (float*)(wsl + WS_CUM); bf16* const KC = (bf16*)(wsl + WS_KC); bf16* const VC = (bf16*)(wsl + WS_VC); bf16* const MIX = (bf16*)(wsl + WS_MIX); bf16* const YB = (bf16*)(wsl + WS_YB);
        int* const LIST = (int*)(wsl + WS_LIST); float* const TW = (float*)(wsl + WS_TW);
        const int pb = 1 + 7 * l;
        if (PHON(1) && IN(pb)) {
            pg8::Gemm g{l == 0 ? XN : X, WIN + (size_t)l * NP * D, S, NP, D}; pg8::StaticOrder so; so.init(S, NP, G, bid);
            pg8::EpiProj E{PROJ, AUX, (const float*)(wsl + WS_RSTD)};
            pg8::gemm_phase<pg8::EpiProj, pg8::StaticOrder, true, true>(lds, g, so, E, wid);
            {
                const int ntile = (S / 256) * (NP / 256), rmax = (ntile + G - 1) / G, mine = (ntile - bid + G - 1) / G, nh = G * rmax - ntile;
                if (nh == 0 || mine < rmax) {
                    FRESH(); __syncthreads();
                    LAS float* const scr = (LAS float*)(lds + wid_ * 8448);
                    const int hidx = nh == 0 ? bid : bid - (G - nh), nhw = (nh == 0 ? G : nh) * NWAVES;
                    for (int j = hidx * NWAVES + wid_; j < I_L - I_WIN; j += nhw) tr_dispatch(args, (unsigned char*)wsl, l * I_L + I_WIN + j, scr, lane_);
                }
            }
            if (DUPON(1)) pg8::gemm_phase<pg8::EpiProj, pg8::StaticOrder, true, true>(lds, g, so, E, wid);
        }
        SEAM(pb);
        if (IN(pb + 2)) {
            const int x = bid & 7;
#define QHEAD(q) (ctl + CW_Q + (((l * 6 + (q)) * 8 + x) * 64))
            if (PHON(2)) { FRESH(); unsigned* const pdone = ctl + CW_PD + l * 64;
                for (;;) { const int i = dequeue(ctl + CW_PQ + l * 64, MISC + 19, tid_); if (i >= 136) break;
                    if (i < 8) cumsum_unit(i, l, AUX, args.in[5], CUM, lds, tid_); else compress_unit(i - 8, l, PROJ, W1T, W2T, C1, KC, VC, lds, wid_, lane_);
                    asm volatile("s_waitcnt vmcnt(0)" ::: "memory");
                    __syncthreads();
                    if (wid_ == 0) { __builtin_amdgcn_fence(__ATOMIC_RELEASE, "agent"); asm volatile("s_waitcnt vmcnt(0)" ::: "memory"); (void)__hip_atomic_fetch_add(pdone, 1u, __ATOMIC_RELAXED, __HIP_MEMORY_SCOPE_AGENT); }
                } }
            if (PHON(4)) { FRESH(); for (;;) { const int i = dequeue(QHEAD(1), MISC + 17, tid_); if (i >= 32) break; diff_unit(x & 3, 63 - 2 * i - (x >> 2), l, args, PROJ, MIX, lds, tid_, wid_, lane_); }
                if (DUPON(4)) for (;;) { const int i = dequeue(QHEAD(4), MISC + 17, tid_); if (i >= 32) break; diff_unit(x & 3, 63 - 2 * i - (x >> 2), l, args, PROJ, MIX, lds, tid_, wid_, lane_); } }
            if (PHON(2)) { FRESH();
                if (tid_ == 0) { unsigned* const pdone = ctl + CW_PD + l * 64; unsigned sp = 0;
                    while (__hip_atomic_load(pdone, __ATOMIC_RELAXED, __HIP_MEMORY_SCOPE_AGENT) < 136u * 64u) { __builtin_amdgcn_s_sleep(2); if (++sp > (1u << 20)) break; }
                    __builtin_amdgcn_fence(__ATOMIC_ACQUIRE, "agent"); asm volatile("s_waitcnt vmcnt(0)" ::: "memory"); }
                __syncthreads(); }
            if (PHON(3)) { FRESH(); for (;;) { const int i = dequeue(QHEAD(0), MISC + 16, tid_); if (i >= 32) break; fox_unit(x, 31 - i, PROJ, CUM, MIX, lds, tid_, wid_, lane_); }
                if (DUPON(3)) for (;;) { const int i = dequeue(QHEAD(3), MISC + 16, tid_); if (i >= 32) break; fox_unit(x, 31 - i, PROJ, CUM, MIX, lds, tid_, wid_, lane_); } }
            if (PHON(5)) { FRESH(); for (;;) { const int i = dequeue(QHEAD(2), MISC + 18, tid_); if (i >= 64) break; nsa_unit(x & 3, 127 - 2 * i - (x >> 2), args, PROJ, AUX, KC, VC, MIX, lds, tid_, wid_, lane_); }
                if (DUPON(5)) for (;;) { const int i = dequeue(QHEAD(5), MISC + 18, tid_); if (i >= 64) break; nsa_unit(x & 3, 127 - 2 * i - (x >> 2), args, PROJ, AUX, KC, VC, MIX, lds, tid_, wid_, lane_); } }
#undef QHEAD
        }
        SEAM(pb + 2);
        if (PHON(6) && IN(pb + 3)) {
            pg8::Gemm g{MIX, WOUT + (size_t)l * D * D, S, D, D}; pg8::StaticOrder so; so.init(S, D, G, bid);
            pg8::EpiRes E{nullptr, l == 0 ? XN : X, X};
            pg8::gemm_phase<pg8::EpiRes, pg8::StaticOrder, true, true>(lds, g, so, E, wid);
            if (DUPON(6)) { pg8::EpiRes E2{nullptr, X, YB}; pg8::gemm_phase<pg8::EpiRes, pg8::StaticOrder, true, true>(lds, g, so, E2, wid); }
        }
        SEAM(pb + 3);
        if (PHON(7) && IN(pb + 4)) {
            FRESH();
            for (int p = bid; p < S / 32; p += G) n2_pair(p, l, args, X, XN, RWT, ctl + CW_CNT + l * 1024, LIST, TW, lds, tid_, wid_, lane_);
            if (DUPON(7)) for (int u = bid; u < S / 16; u += G) n2_unit(u, l, args, X, XN, RWT, ctl + CW_CNT + (4 + l) * 1024, (int*)MIX, (float*)(MIX + 8 * 1024 * 1024), lds, tid_, wid_, lane_);
        }
        SEAM(pb + 4);
        if (PHON(8) && IN(pb + 5)) {
            FRESH();
            LAS int* pre = (LAS int*)(lds + MO_PRE);
            if (tid_ < 64) pre[tid_] = ((int)__hip_atomic_load(ctl + CW_CNT + l * 1024 + tid_ * 16, __ATOMIC_RELAXED, __HIP_MEMORY_SCOPE_AGENT) + 127) >> 7;
            __syncthreads();
            const int x = bid & 7, per = G >> 3;
            for (int rep = 0; rep < (DUPON(8) ? 2 : 1); ++rep)
            for (int slot = bid >> 3; ; slot += per) {
                int e = -1, c = 0, acc = 0;
                for (int k = 0; k < 8; ++k) { const int ee = x + 8 * k, n = pre[ee]; if (e < 0 && slot < acc + n) { e = ee; c = slot - acc; } acc += n; }
                if (e < 0) break;
                e = __builtin_amdgcn_readfirstlane(e); c = __builtin_amdgcn_readfirstlane(c);
                const int c0 = c * 128; const int cnt_e = (int)__hip_atomic_load(ctl + CW_CNT + l * 1024 + e * 16, __ATOMIC_RELAXED, __HIP_MEMORY_SCOPE_AGENT);
                const int nrows = (cnt_e - c0) < 128 ? (cnt_e - c0) : 128;
                moe_unit(e, c0, nrows, XN, LIST, args.in[19] + (size_t)l * 64 * D * 256, args.in[20] + (size_t)l * 64 * D * 256, args.in[21] + (size_t)l * 64 * 256 * D, YB, lds, tid_, wid_, lane_);
            }
        }
        SEAM(pb + 5);
        if (PHON(9) && IN(pb + 6)) {
            FRESH(); const int gw_ = bid * NWAVES + wid_;
            if (l + 1 < DEPTH) {
                norm_rows<1>(nullptr, X, X, XN, YB, TW, args.in[1] + (size_t)(l + 1) * D, nullptr, (float*)(wsl + WS_RSTD), gw_, NGW, lane_);
                if (DUPON(9)) norm_rows<1>(nullptr, X, PROJ, MIX, YB, TW, args.in[1] + (size_t)(l + 1) * D, nullptr, (float*)MIX, gw_, NGW, lane_);
            } else norm_rows<2>(nullptr, X, nullptr, nullptr, YB, TW, args.in[22], args.out, nullptr, gw_, NGW, lane_);
        }
        if (l + 1 < DEPTH) SEAM(pb + 6);
    }
#undef IN
#undef SEAM
}

extern "C" void kernel_launch(void* const* d_in, const int* in_sizes, int n_in, void* d_out, int out_size, void* d_ws, size_t ws_size, hipStream_t stream) {
    static int grid = 0;
    if (grid == 0) {
        if (n_in != 23 || ws_size < WS_END || out_size != S * D) { fprintf(stderr, "kernel_launch: unexpected problem (n_in %d, out %d, ws %zu)\n", n_in, out_size, ws_size); grid = -1; return; }
        int dev = 0, cus = 0, per_cu = 0;
        if (hipGetDevice(&dev) != hipSuccess || hipDeviceGetAttribute(&cus, hipDeviceAttributeMultiprocessorCount, dev) != hipSuccess) { grid = -1; return; }
        if (hipFuncSetAttribute((const void*)fwd_kernel, hipFuncAttributeMaxDynamicSharedMemorySize, LDS_BYTES) != hipSuccess) { fprintf(stderr, "kernel_launch: hipFuncSetAttribute failed\n"); grid = -1; return; }
        if (hipOccupancyMaxActiveBlocksPerMultiprocessor(&per_cu, (const void*)fwd_kernel, NTHR, LDS_BYTES) != hipSuccess || per_cu < 1) fprintf(stderr, "kernel_launch: occupancy query says %d blocks per CU\n", per_cu);
        (void)hipGetLastError();
        grid = cus;
        if (grid < 136) { fprintf(stderr, "kernel_launch: too few CUs (%d)\n", grid); }
    }
    if (grid < 0) return;
    if (hipMemsetAsync((char*)d_ws + WS_CTL, 0, CTL_ZERO_BYTES, stream) != hipSuccess) { fprintf(stderr, "kernel_launch: memset failed\n"); return; }
    Args a{};
    for (int i = 0; i < 23; ++i) a.in[i] = (const float*)d_in[i];
    a.out = (float*)d_out; a.ws = (unsigned char*)d_ws;
#if MK_ONE_LAUNCH
    a.ph_lo = 0; a.ph_hi = N_PHASES;
    hipLaunchKernelGGL(fwd_kernel, dim3(grid), dim3(NTHR), LDS_BYTES, stream, a);
#else
    for (int p = 0; p < N_PHASES; ++p) { a.ph_lo = p; a.ph_hi = p + 1; hipLaunchKernelGGL(fwd_kernel, dim3(grid), dim3(NTHR), LDS_BYTES, stream, a); }
#endif
    const hipError_t le = hipPeekAtLastError();
    if (le != hipSuccess) fprintf(stderr, "kernel_launch: launch failed: %s\n", hipGetErrorName(le));
}
```

```cpp
#include <hip/hip_runtime.h>
#include <cstdio>
#include <cstdint>
#include <cmath>
namespace pg8 {
#define PG8_LAS __attribute__((address_space(3)))
typedef unsigned short bf16_t;
typedef short bf16x8 __attribute__((ext_vector_type(8)));
typedef float f32x4 __attribute__((ext_vector_type(4)));
typedef unsigned u32x4 __attribute__((ext_vector_type(4)));
constexpr int BM = 256, BK = 64, HALF = 128, HTB = HALF * BK * 2  , STAGE_BYTES = 8 * HTB, NXCD = 8, WGM = 8;

__host__ __device__ __forceinline__ int lds_byte(int r, int c) { const int st = (r >> 4) * 2 + (c >> 5), rr = r & 15, cc = c & 31, ob = rr * 64 + cc * 2; return st * 1024 + (ob ^ (((ob >> 9) & 1) << 5)); }
__host__ __device__ __forceinline__ void stage_rc(int b, int& R, int& C) { const int st = b / 1024, sb = b % 1024, swz = sb ^ (((sb >> 9) & 1) << 5); R = (st >> 1) * 16 + swz / 64; C = (st & 1) * 32 + (swz % 64) / 2; }
__host__ __device__ __forceinline__ int perm32(int rho) { const int n = rho >> 4, i = rho & 15; return 8 * (i >> 2) + 4 * n + (i & 3); }

struct Unit { int pm, pn; };
struct Gemm { const bf16_t* A; const bf16_t* Bt; int M, N, K; };

struct StaticOrder {
    int nM, nN, nwg, G, c;
    __host__ __device__ void init(int M, int N, int G_, int c_) { nM = M / BM; nN = N / BM; nwg = nM * nN; G = G_; c = c_; }
    __host__ __device__ bool next(int i, Unit& u) const {
        const long L = (long)i * G + c; if (L >= nwg) return false;
        int wgid = (int)L; { const int q = nwg / NXCD, r = nwg % NXCD, xcd = wgid % NXCD, off = wgid / NXCD; wgid = (xcd < r ? xcd * (q + 1) : r * (q + 1) + (xcd - r) * q) + off; }
        const int nig = WGM * nN, gid = wgid / nig, fm = gid * WGM, gsz = (nM - fm) < WGM ? (nM - fm) : WGM;
        u.pm = fm + ((wgid % nig) % gsz); u.pn = (wgid % nig) / gsz; return true;
    }
    __device__ __forceinline__ void a_ready(const Unit&) const {}
    __device__ __forceinline__ void done(const Unit&) const {}
};
__device__ __forceinline__ unsigned cvt_pk_bf16(float lo, float hi) { unsigned r; asm volatile("v_cvt_pk_bf16_f32 %0, %1, %2" : "=v"(r) : "v"(lo), "v"(hi)); return r; }
struct EpiProj {
    static constexpr bool PERM = true, AFTER_DRAIN = false;
    bf16_t* O; float* aux; const float* rstd;
    __device__ __forceinline__ void operator()(const f32x4 (&acc)[2][2][4][2], const Unit& u, int wr, int wc, int fr, int fq) const {
        const int row0 = u.pm * BM + wr * 64 + fr;
        if (u.pn < 22) {
            const int col0 = u.pn * BM + wc * 32 + 8 * fq;
#pragma unroll
            for (int ai = 0; ai < 2; ++ai)
#pragma unroll
                for (int m = 0; m < 4; ++m) { bf16_t* rowp = O + (size_t)(row0 + ai * HALF + m * 16) * 5632 + col0; const float rs = rstd[row0 + ai * HALF + m * 16];
#pragma unroll
                    for (int bj = 0; bj < 2; ++bj) { const f32x4 v0 = acc[ai][bj][m][0] * rs, v1 = acc[ai][bj][m][1] * rs;
                        u32x4 w; w.x = cvt_pk_bf16(v0[0], v0[1]); w.y = cvt_pk_bf16(v0[2], v0[3]); w.z = cvt_pk_bf16(v1[0], v1[1]); w.w = cvt_pk_bf16(v1[2], v1[3]);
                        *(u32x4*)(rowp + bj * HALF) = w; } }
        } else if (wc < 2) {
            const int col0 = wc * 32 + 8 * fq;
#pragma unroll
            for (int ai = 0; ai < 2; ++ai)
#pragma unroll
                for (int m = 0; m < 4; ++m) { float* rowp = aux + (size_t)(row0 + ai * HALF + m * 16) * 64 + col0; const float rs = rstd[row0 + ai * HALF + m * 16];
                    *(f32x4*)(rowp) = acc[ai][0][m][0] * rs; *(f32x4*)(rowp + 4) = acc[ai][0][m][1] * rs; }
        }
    }
};
struct EpiRes {
    static constexpr bool PERM = true, AFTER_DRAIN = false;
    const float* basef; const bf16_t* baseb; bf16_t* out;
    __device__ __forceinline__ void operator()(const f32x4 (&acc)[2][2][4][2], const Unit& u, int wr, int wc, int fr, int fq) const {
        const int row0 = u.pm * BM + wr * 64 + fr, col0 = u.pn * BM + wc * 32 + 8 * fq;
#pragma unroll
        for (int ai = 0; ai < 2; ++ai)
#pragma unroll
            for (int m = 0; m < 4; ++m) { const size_t off = (size_t)(row0 + ai * HALF + m * 16) * 2048 + col0;
#pragma unroll
                for (int bj = 0; bj < 2; ++bj) { f32x4 v0 = acc[ai][bj][m][0], v1 = acc[ai][bj][m][1]; const size_t o = off + bj * HALF;
                    if (basef) { v0 += *(const f32x4*)(basef + o); v1 += *(const f32x4*)(basef + o + 4); }
                    else { const u32x4 b = *(const u32x4*)(baseb + o);
                        v0[0] += __uint_as_float(b.x << 16); v0[1] += __uint_as_float(b.x & 0xffff0000u); v0[2] += __uint_as_float(b.y << 16); v0[3] += __uint_as_float(b.y & 0xffff0000u);
                        v1[0] += __uint_as_float(b.z << 16); v1[1] += __uint_as_float(b.z & 0xffff0000u); v1[2] += __uint_as_float(b.w << 16); v1[3] += __uint_as_float(b.w & 0xffff0000u); }
                    u32x4 w; w.x = cvt_pk_bf16(v0[0], v0[1]); w.y = cvt_pk_bf16(v0[2], v0[3]); w.z = cvt_pk_bf16(v1[0], v1[1]); w.w = cvt_pk_bf16(v1[2], v1[3]);
                    *(u32x4*)(out + o) = w; } }
    }
};
template <class Epi, class Sched, bool ALIGN_EPI = false, bool SP2 = false>
__device__ __forceinline__ void gemm_phase(PG8_LAS unsigned char* lds, const Gemm g, const Sched& S, const Epi& E, int wid_in  ) {
    int wid = wid_in; asm volatile("" : "+s"(wid));
    int lane = (int)__builtin_amdgcn_mbcnt_hi(~0u, __builtin_amdgcn_mbcnt_lo(~0u, 0u)); asm volatile("" : "+v"(lane));
    const int tid = wid * 64 + lane, wr = wid >> 2, wc = wid & 3, fr = lane & 15, fq = lane >> 4;
    const int K = g.K, nt = K / BK;
    unsigned voffA[2], voffB[2];
#pragma unroll
    for (int i = 0; i < 2; ++i) { int R, C; stage_rc(tid * 16 + i * 8192, R, C); const int Rb = Epi::PERM ? ((R & ~31) + perm32(R & 31)) : R;
        voffA[i] = (unsigned)(R * K + C) * 2u; voffB[i] = (unsigned)(Rb * K + C) * 2u; }
    const size_t kstep = (size_t)(BK * 2);
    const size_t hstep = (size_t)HALF * K * 2;
    const size_t tstep = 2 * hstep;
    const unsigned ldsw = (unsigned)wid * 1024u;
    const int aoff = lds_byte(wr * 64 + fr, fq * 8), boff = lds_byte(wc * 32 + fr, fq * 8);
#define PG8_SA(b, h) (((b) * 2 + (h)) * HTB)
#define PG8_SB(b, h) ((4 + (b) * 2 + (h)) * HTB)
#define PG8_STAGE(bufoff, gbase, voff) do { _Pragma("unroll") for (int _i = 0; _i < 2; ++_i) \
        __builtin_amdgcn_global_load_lds((const unsigned*)((const char*)(gbase) + (voff)[_i]), (PG8_LAS unsigned*)(lds + (bufoff) + ldsw + _i * 8192), 16, 0, 0); } while (0)
#define PG8_LDA(dst, b, h) do { _Pragma("unroll") for (int m = 0; m < 4; ++m) _Pragma("unroll") for (int k = 0; k < 2; ++k) dst[m][k] = *(const PG8_LAS bf16x8*)(lds + PG8_SA(b, h) + aoff + m * 2048 + k * 1024); } while (0)
#define PG8_LDB(dst, b, h) do { _Pragma("unroll") for (int n = 0; n < 2; ++n) _Pragma("unroll") for (int k = 0; k < 2; ++k) dst[n][k] = *(const PG8_LAS bf16x8*)(lds + PG8_SB(b, h) + boff + n * 2048 + k * 1024); } while (0)
#define PG8_MMA(ai, bj, At, Bt) do { __builtin_amdgcn_s_setprio(1); _Pragma("unroll") for (int m = 0; m < 4; ++m) _Pragma("unroll") for (int n = 0; n < 2; ++n) _Pragma("unroll") for (int k = 0; k < 2; ++k) \
        acc[ai][bj][m][n] = __builtin_amdgcn_mfma_f32_16x16x32_bf16(Bt[n][k], At[m][k], acc[ai][bj][m][n], 0, 0, 0); __builtin_amdgcn_s_setprio(0); } while (0)
#define PG8_WAIT_V(n) asm volatile("s_waitcnt vmcnt(" #n ")" ::: "memory")
#define PG8_WAIT_L(n) asm volatile("s_waitcnt lgkmcnt(" #n ")" ::: "memory")
#define PG8_BAR __builtin_amdgcn_s_barrier()
#define PG8_SCHED __builtin_amdgcn_sched_barrier(0)
    Unit cur, nxt; int ui = 0;
    if (!S.next(0, cur)) return;
    f32x4 acc[2][2][4][2];
#pragma unroll
    for (int a = 0; a < 2; ++a)
#pragma unroll
        for (int b = 0; b < 2; ++b)
#pragma unroll
            for (int m = 0; m < 4; ++m)
#pragma unroll
                for (int n = 0; n < 2; ++n) acc[a][b][m][n] = (f32x4){0.f, 0.f, 0.f, 0.f};
    bf16x8 At[4][2], B0[2][2], B1[2][2];
    const char* cA = (const char*)g.A + (size_t)cur.pm * tstep; const char* cB = (const char*)g.Bt + (size_t)cur.pn * tstep;
    S.a_ready(cur);
    if constexpr (SP2) {
        PG8_STAGE(PG8_SB(0, 0), cB, voffB); PG8_STAGE(PG8_SB(0, 1), cB + hstep, voffB); PG8_STAGE(PG8_SA(0, 0), cA, voffA); PG8_STAGE(PG8_SA(0, 1), cA + hstep, voffA);
        if (wr == 1) PG8_BAR;
        PG8_WAIT_V(2); PG8_BAR;
        PG8_STAGE(PG8_SB(1, 0), cB + kstep, voffB); PG8_STAGE(PG8_SA(1, 0), cA + kstep, voffA); PG8_STAGE(PG8_SB(1, 1), cB + hstep + kstep, voffB);
        PG8_WAIT_V(6); PG8_BAR;
    } else {
        PG8_STAGE(PG8_SB(0, 0), cB, voffB); PG8_STAGE(PG8_SA(0, 0), cA, voffA); PG8_STAGE(PG8_SB(0, 1), cB + hstep, voffB); PG8_STAGE(PG8_SA(0, 1), cA + hstep, voffA);
        if (wr == 1) PG8_BAR;
        PG8_WAIT_V(4); PG8_BAR;
        PG8_STAGE(PG8_SB(1, 0), cB + kstep, voffB); PG8_STAGE(PG8_SA(1, 0), cA + kstep, voffA); PG8_STAGE(PG8_SB(1, 1), cB + hstep + kstep, voffB);
        PG8_WAIT_V(6); PG8_BAR;
    }
    for (;;) {
        const bool has_next = S.next(ui + 1, nxt);
        const char* nA = has_next ? (const char*)g.A + (size_t)nxt.pm * tstep : cA; const char* nB = has_next ? (const char*)g.Bt + (size_t)nxt.pn * tstep : cB;
        for (int t = 0; t < nt; t += 2) {
            const bool last = (t == nt - 2);
            const char* a1 = cA + (size_t)(t + 1) * kstep;
            const char* a2 = last ? nA : cA + (size_t)(t + 2) * kstep; const char* b2 = last ? nB : cB + (size_t)(t + 2) * kstep;
            const char* a3 = a2 + kstep; const char* b3 = b2 + kstep;
            if (last && has_next) S.a_ready(nxt);
            if constexpr (SP2) {
            PG8_LDB(B0, 0, 0); PG8_LDB(B1, 0, 1); PG8_SCHED; PG8_LDA(At, 0, 0); PG8_STAGE(PG8_SA(1, 1), a1 + hstep, voffA);
            PG8_WAIT_V(8); PG8_WAIT_L(0); PG8_BAR; PG8_MMA(0, 0, At, B0); PG8_MMA(0, 1, At, B1); PG8_BAR; PG8_SCHED;
            PG8_LDA(At, 0, 1); PG8_STAGE(PG8_SB(0, 0), b2, voffB); PG8_STAGE(PG8_SB(0, 1), b2 + hstep, voffB); PG8_STAGE(PG8_SA(0, 0), a2, voffA);
            PG8_WAIT_V(8); PG8_WAIT_L(0); PG8_BAR; PG8_MMA(1, 0, At, B0); PG8_MMA(1, 1, At, B1); PG8_BAR; PG8_SCHED;
            PG8_LDB(B0, 1, 0); PG8_LDB(B1, 1, 1); PG8_SCHED; PG8_LDA(At, 1, 0); PG8_STAGE(PG8_SA(0, 1), a2 + hstep, voffA);
            PG8_WAIT_V(8); PG8_WAIT_L(0); PG8_BAR; PG8_MMA(0, 0, At, B0); PG8_MMA(0, 1, At, B1); PG8_BAR; PG8_SCHED;
            PG8_LDA(At, 1, 1); PG8_STAGE(PG8_SB(1, 0), b3, voffB); PG8_STAGE(PG8_SB(1, 1), b3 + hstep, voffB); PG8_STAGE(PG8_SA(1, 0), a3, voffA);
            PG8_WAIT_V(8); PG8_WAIT_L(0); PG8_BAR; PG8_MMA(1, 0, At, B0); PG8_MMA(1, 1, At, B1); PG8_BAR; PG8_SCHED;
            } else {
            PG8_LDB(B0, 0, 0); PG8_SCHED; PG8_LDA(At, 0, 0); PG8_STAGE(PG8_SA(1, 1), a1 + hstep, voffA);
            PG8_WAIT_L(8); PG8_BAR; PG8_WAIT_L(0); PG8_MMA(0, 0, At, B0); PG8_BAR; PG8_SCHED;
            PG8_LDB(B1, 0, 1); PG8_STAGE(PG8_SB(0, 0), b2, voffB);
            PG8_BAR; PG8_WAIT_L(0); PG8_MMA(0, 1, At, B1); PG8_BAR;
            PG8_LDA(At, 0, 1); PG8_STAGE(PG8_SA(0, 0), a2, voffA);
            PG8_BAR; PG8_WAIT_L(0); PG8_MMA(1, 0, At, B0); PG8_BAR; PG8_SCHED;
            PG8_STAGE(PG8_SB(0, 1), b2 + hstep, voffB);
            PG8_WAIT_V(6); PG8_BAR; PG8_MMA(1, 1, At, B1); PG8_BAR;
            PG8_LDB(B0, 1, 0); PG8_SCHED; PG8_LDA(At, 1, 0); PG8_STAGE(PG8_SA(0, 1), a2 + hstep, voffA);
            PG8_WAIT_L(8); PG8_BAR; PG8_WAIT_L(0); PG8_MMA(0, 0, At, B0); PG8_BAR; PG8_SCHED;
            PG8_LDB(B1, 1, 1); PG8_STAGE(PG8_SB(1, 0), b3, voffB);
            PG8_BAR; PG8_WAIT_L(0); PG8_MMA(0, 1, At, B1); PG8_BAR;
            PG8_LDA(At, 1, 1); PG8_STAGE(PG8_SA(1, 0), a3, voffA);
            PG8_BAR; PG8_WAIT_L(0); PG8_MMA(1, 0, At, B0); PG8_BAR; PG8_SCHED;
            PG8_STAGE(PG8_SB(1, 1), b3 + hstep, voffB);
            PG8_WAIT_V(6); PG8_BAR; PG8_MMA(1, 1, At, B1); PG8_BAR;
            }
        }
        if constexpr (ALIGN_EPI) { if (wr == 0) PG8_BAR; }
        if constexpr (!Epi::AFTER_DRAIN) { E(acc, cur, wr, wc, fr, fq); S.done(cur); }
        if (!has_next) break;
#pragma unroll
        for (int a = 0; a < 2; ++a)
#pragma unroll
            for (int b = 0; b < 2; ++b)
#pragma unroll
                for (int m = 0; m < 4; ++m)
#pragma unroll
                    for (int n = 0; n < 2; ++n) acc[a][b][m][n] = (f32x4){0.f, 0.f, 0.f, 0.f};
        cur = nxt; cA = nA; cB = nB; ++ui;
        if constexpr (ALIGN_EPI) { if (wr == 1) PG8_BAR; }
    }
    PG8_WAIT_V(0);
    if constexpr (!ALIGN_EPI) { if (wr == 0) PG8_BAR; }
    PG8_BAR;
    if constexpr (Epi::AFTER_DRAIN) { E.fused(acc, cur, wr, wc, fr, fq, lds, wid, lane); S.done(cur); }
#undef PG8_SA
#undef PG8_SB
#undef PG8_STAGE
#undef PG8_LDA
#undef PG8_LDB
#undef PG8_MMA
#undef PG8_WAIT_V
#undef PG8_WAIT_L
#undef PG8_BAR
#undef PG8_SCHED
}
}
#define GAS __attribute__((address_space(1)))
#define LAS __attribute__((address_space(3)))
typedef unsigned short bf16;
typedef unsigned v4u __attribute__((ext_vector_type(4)));
typedef float f32x4 __attribute__((ext_vector_type(4)));
typedef short bf16x8 __attribute__((ext_vector_type(8)));
typedef GAS unsigned gu32;
typedef GAS unsigned long long gu64;
#define RLX_AGENT __ATOMIC_RELAXED, __HIP_MEMORY_SCOPE_AGENT
#define LDS_WAIT() asm volatile("s_waitcnt lgkmcnt(0)" ::: "memory")
#define VM_WAIT() asm volatile("s_waitcnt vmcnt(0)" ::: "memory")
__device__ __forceinline__ unsigned long long rt() { return __builtin_amdgcn_s_memrealtime(); }
__device__ __forceinline__ unsigned f2bf(float f) { unsigned u = __builtin_bit_cast(unsigned, f); return (u + 0x7fffu + ((u >> 16) & 1u)) >> 16; }
__device__ __forceinline__ unsigned pk2(float lo, float hi) { return f2bf(lo) | (f2bf(hi) << 16); }
#define XB_TMO      128
#define XB_XCNT(j)  (256  + 64 * (j))
#define XB_XSUB(j)  (1280 + 64 * (j))
#define XB_XGEN(j)  (2304 + 64 * (j))
#define XB_TOP      3328
#define XB_TOPGEN   3392
#define XCD_BAR_WORDS 3456
#define XB_SPIN_CAP (1u << 18)

__device__ __forceinline__ unsigned xb_ld(unsigned* p)              { return __hip_atomic_load(p, __ATOMIC_RELAXED, __HIP_MEMORY_SCOPE_AGENT); }
__device__ __forceinline__ unsigned xb_add(unsigned* p, unsigned v) { return __hip_atomic_fetch_add(p, v, __ATOMIC_RELAXED, __HIP_MEMORY_SCOPE_AGENT); }
__device__ __forceinline__ unsigned xb_xcc_id() { return (unsigned)__builtin_amdgcn_s_getreg((3 << 11) | 20) & 0xFu; }
#define XB_SPIN(cond, bar) do { unsigned _sp = 0; while (cond) { __builtin_amdgcn_s_sleep(1); \
    if ((++_sp & 255u) == 0u) { if (xb_ld(&(bar)[XB_TMO])) break; if (_sp > XB_SPIN_CAP) { atomicAdd(&(bar)[XB_TMO], 1u); break; } } } } while (0)

struct XcdBarrier {
    unsigned* bar; unsigned x;
    unsigned w0;
    volatile LAS unsigned* st;
};

__device__ __forceinline__ XcdBarrier xcd_barrier_post(unsigned* bar, volatile LAS unsigned* st) {
    XcdBarrier b; b.bar = bar; b.x = xb_xcc_id(); b.st = st; b.w0 = (__builtin_amdgcn_readfirstlane(threadIdx.x >> 6) == 0) ? 1u : 0u;
    if (threadIdx.x == 0) (void)xb_add(&bar[XB_XCNT(b.x)], 1u);
    return b;
}
__device__ __forceinline__ void xcd_barrier_complete(unsigned* bar, unsigned x, unsigned& nloc, unsigned& nx) {
    const unsigned G = gridDim.x * gridDim.y * gridDim.z;
    unsigned sum, cnt, mine, sp = 0u;
    for (;;) {
        sum = 0u; cnt = 0u; mine = 0u;
#pragma unroll
        for (unsigned j = 0; j < 16; ++j) { const unsigned c = xb_ld(&bar[XB_XCNT(j)]); sum += c; cnt += (c > 0u) ? 1u : 0u; mine = (j == x) ? c : mine; }
        if (sum == G) break;
        __builtin_amdgcn_s_sleep(1);
        if ((++sp & 255u) == 0u) { if (xb_ld(&bar[XB_TMO])) break; if (sp > XB_SPIN_CAP) { atomicAdd(&bar[XB_TMO], 1u); break; } }
    }
    nloc = mine > 0u ? mine : 1u; nx = cnt > 0u ? cnt : 1u;
}

__device__ __forceinline__ void xcd_barrier(const XcdBarrier& b) {
    asm volatile("s_waitcnt vmcnt(0)" ::: "memory");
    __syncthreads();
    if (b.w0 != 0u && __builtin_amdgcn_mbcnt_hi(~0u, __builtin_amdgcn_mbcnt_lo(~0u, 0u)) == 0u) {
        GAS unsigned* barg = (GAS unsigned*)b.bar; asm volatile("" : "+s"(barg)); unsigned* bar = (unsigned*)barg;
        __builtin_amdgcn_s_waitcnt(0);
        unsigned nloc = b.st[0], nx = b.st[1];
        if (nloc == 0u) { xcd_barrier_complete(bar, b.x, nloc, nx); b.st[0] = nloc; b.st[1] = nx; }
        const unsigned old = xb_add(&bar[XB_XSUB(b.x)], 1u);
        const unsigned gen = old / nloc;
        if (old + 1u == (gen + 1u) * nloc) {
            __builtin_amdgcn_fence(__ATOMIC_RELEASE, "agent");
            asm volatile("s_waitcnt vmcnt(0)" ::: "memory");
            const unsigned og = xb_add(&bar[XB_TOP], 1u);
            const unsigned tg = og / nx;
            if (og + 1u == (tg + 1u) * nx) xb_add(&bar[XB_TOPGEN], 1u);
            else XB_SPIN(xb_ld(&bar[XB_TOPGEN]) == tg, bar);
            __builtin_amdgcn_fence(__ATOMIC_ACQUIRE, "agent");
            xb_add(&bar[XB_XGEN(b.x)], 1u);
            asm volatile("s_waitcnt vmcnt(0)" ::: "memory");
        } else {
            XB_SPIN(xb_ld(&bar[XB_XGEN(b.x)]) == gen, bar);
            __builtin_amdgcn_fence(__ATOMIC_ACQUIRE, "agent");
            asm volatile("s_waitcnt vmcnt(0)" ::: "memory");
        }
    }
    __syncthreads();
}
typedef unsigned u32x4 __attribute__((ext_vector_type(4)));

typedef short s16x4 __attribute__((ext_vector_type(4)));
typedef float f32x16 __attribute__((ext_vector_type(16)));
typedef unsigned u32x2 __attribute__((ext_vector_type(2)));
typedef float f32x2v __attribute__((ext_vector_type(2)));

constexpr int S = 8192, D = 2048, DEPTH = 4, DIN = 5688, NP = 5888, PITCH = 5632;
constexpr int C_AQ = 0, C_AK = 512, C_AV = 1024, C_BQ = 1536, C_BK = 2048, C_BV = 2560, C_CQ = 3072, C_KC = 4096, C_VC = 4352, C_KS = 4608, C_VS = 4864, C_KW = 5120, C_VW = 5376;
constexpr float RMS_EPS = 1e-6f, NEG = -1e30f, LOG2E = 1.4426950408889634f, SCL2 = 0.125f * 1.4426950408889634f;
constexpr int NWAVES = 8, NTHR = 512;

constexpr size_t MiB = 1u << 20;
constexpr size_t WS_CTL = 0, CTL_ZERO_BYTES = 1 * MiB;
constexpr size_t WS_WIN = 2 * MiB;
constexpr size_t WS_WOUT = 96 * MiB;
constexpr size_t WS_W1T = 128 * MiB;
constexpr size_t WS_W2T = 136 * MiB;
constexpr size_t WS_RWT = 137 * MiB;
constexpr size_t WS_C1 = 139 * MiB;
constexpr size_t WS_X = 144 * MiB;
constexpr size_t WS_XN = 208 * MiB;
constexpr size_t WS_PROJ = 240 * MiB;
constexpr size_t WS_AUX = 330 * MiB;
constexpr size_t WS_CUM = 332 * MiB;
constexpr size_t WS_KC = 333 * MiB;
constexpr size_t WS_VC = 334 * MiB;
constexpr size_t WS_MIX = 336 * MiB;
constexpr size_t WS_YB = 368 * MiB;
constexpr size_t WS_LIST = 432 * MiB;
constexpr size_t WS_TW = 436 * MiB;
constexpr size_t WS_RSTD = 437 * MiB;
constexpr size_t WS_END = 440 * MiB;
constexpr int CW_BAR = 4096;
constexpr int CW_Q = 8192;
constexpr int CW_PQ = 24576, CW_PD = 25600;
constexpr int CW_CNT = 32768;

constexpr int LDS_BYTES = 160 * 1024;
constexpr int MISC_OFF = 150 * 1024;

struct Args { const float* in[23]; float* out; unsigned char* ws; int ph_lo, ph_hi; };
__device__ __forceinline__ int t5_bucket(int rel) { if (rel < 16) return rel; int b = 16;
    b += rel >= 19; b += rel >= 21; b += rel >= 24; b += rel >= 27; b += rel >= 31; b += rel >= 35; b += rel >= 40; b += rel >= 46; b += rel >= 52; b += rel >= 59; b += rel >= 67; b += rel >= 77; b += rel >= 87; b += rel >= 99; b += rel >= 113; return b; }

__device__ __forceinline__ float bf2f(unsigned short b) { return __uint_as_float((unsigned)b << 16); }
__device__ __forceinline__ float bflo(unsigned w) { return __uint_as_float(w << 16); }
__device__ __forceinline__ float bfhi(unsigned w) { return __uint_as_float(w & 0xffff0000u); }
typedef __bf16 bf16x2_t __attribute__((ext_vector_type(2)));
__device__ __forceinline__ unsigned cvtpk(float lo, float hi) { f32x2v v = {lo, hi}; bf16x2_t b = __builtin_convertvector(v, bf16x2_t); return __builtin_bit_cast(unsigned, b); }
__device__ __forceinline__ unsigned short f2bf16(float f) { return (unsigned short)(cvtpk(f, 0.f) & 0xffffu); }
__device__ __forceinline__ float wave_sum(float v) {
#pragma unroll
    for (int o = 1; o < 64; o <<= 1) v += __shfl_xor(v, o);
    return v;
}
__device__ __forceinline__ int crow(int r, int hi) { return (r & 3) + 8 * (r >> 2) + 4 * hi; }
#define MFMA32(a, b, c) __builtin_amdgcn_mfma_f32_32x32x16_bf16((a), (b), (c), 0, 0, 0)
#define MFMA16(a, b, c) __builtin_amdgcn_mfma_f32_16x16x32_bf16((a), (b), (c), 0, 0, 0)

__device__ __forceinline__ int src_col_win(int n) { if (n < 3072) return n; if (n < 5632) return n + 8; if (n < 5640) return n - 2560; if (n < 5688) return n; return -1; }

template <int MODE>
__device__ __forceinline__ void tr_item(const float* W, const float* W2, int ldw, int K, bf16* WT, int k0, int n0, LAS float* scr, int lane, const float* kgain = nullptr  ) {
    const int nq = lane & 7, kq = lane >> 3, nn = n0 + 4 * nq;
    const float* src = W; int ld = ldw; bool ok = true;
    if (MODE == 0) { src = W + nn; }
    else if (MODE == 1) { const int c = src_col_win(nn); ok = c >= 0; src = W + (ok ? c : 0); }
    else { if (nn < 8) { src = W + nn; ld = 8; } else if (nn < 72) { src = W2 + (nn - 8); ld = 64; } else { ok = false; ld = 8; } }
    f32x4 tq[8];
#pragma unroll
    for (int i = 0; i < 8; ++i) { const int kk = 8 * i + kq; tq[i] = ok ? *(const f32x4*)(src + (size_t)(k0 + kk) * ld) : (f32x4){0.f, 0.f, 0.f, 0.f}; }
#pragma unroll
    for (int i = 0; i < 8; ++i) { const int kk = 8 * i + kq; *(LAS f32x4*)(scr + kk * 36 + ((4 * nq) ^ (4 * i))) = tq[i]; }
    LDS_WAIT(); asm volatile("" ::: "memory");
    const int c = lane & 7;
    f32x4 g0 = (f32x4){1.f, 1.f, 1.f, 1.f}, g1 = g0;
    if (MODE == 1) { g0 = *(const f32x4*)(kgain + k0 + 8 * c); g1 = *(const f32x4*)(kgain + k0 + 8 * c + 4); }
#pragma unroll
    for (int j = 0; j < 4; ++j) { const int n = (lane >> 3) + 8 * j; const LAS float* s = scr + (8 * c) * 36 + (n ^ (4 * c));
        v4u o; o.x = pk2(s[0 * 36] * g0.x, s[1 * 36] * g0.y); o.y = pk2(s[2 * 36] * g0.z, s[3 * 36] * g0.w); o.z = pk2(s[4 * 36] * g1.x, s[5 * 36] * g1.y); o.w = pk2(s[6 * 36] * g1.z, s[7 * 36] * g1.w);
        *(v4u*)(WT + (size_t)(n0 + n) * K + k0 + 8 * c) = o; }
    LDS_WAIT(); asm volatile("" ::: "memory");
}

template <int MODE>
__device__ __forceinline__ void norm_rows(const float* xsrc, const bf16* xb, bf16* X, bf16* XN, const bf16* YB, const float* TW, const float* gain, float* out, float* RSTD, int gw, int NGW, int lane) {
    for (int row = gw; row < S; row += NGW) {
        f32x4 v[8];
        if (MODE == 0) { const f32x4* xr = (const f32x4*)(xsrc + (size_t)row * D) + lane;
#pragma unroll
            for (int j = 0; j < 8; ++j) v[j] = xr[64 * j];
        } else { const u32x2* xr = (const u32x2*)(xb + (size_t)row * D) + lane;
#pragma unroll
            for (int j = 0; j < 8; ++j) { const u32x2 r = xr[64 * j]; v[j] = (f32x4){bflo(r.x), bfhi(r.x), bflo(r.y), bfhi(r.y)}; } }
        if (MODE >= 1) {
            const float w0 = TW[2 * row], w1 = TW[2 * row + 1];
            const u32x2* ya = (const u32x2*)(YB + (size_t)(2 * row) * D) + lane; const u32x2* yb = (const u32x2*)(YB + (size_t)(2 * row + 1) * D) + lane;
#pragma unroll
            for (int j = 0; j < 8; ++j) { const u32x2 a = ya[64 * j], b = yb[64 * j];
                v[j].x += w0 * bflo(a.x) + w1 * bflo(b.x); v[j].y += w0 * bfhi(a.x) + w1 * bfhi(b.x);
                v[j].z += w0 * bflo(a.y) + w1 * bflo(b.y); v[j].w += w0 * bfhi(a.y) + w1 * bfhi(b.y); }
        }
        float ss = 0.f;
#pragma unroll
        for (int j = 0; j < 8; ++j) ss += (v[j].x * v[j].x + v[j].y * v[j].y) + (v[j].z * v[j].z + v[j].w * v[j].w);
        ss = wave_sum(ss);
        const float rstd = 1.0f / sqrtf(ss * (1.0f / D) + RMS_EPS);
        if (MODE <= 1) { u32x2* xo = (u32x2*)((MODE == 1 ? X : XN) + (size_t)row * D) + lane;
#pragma unroll
            for (int j = 0; j < 8; ++j) { u32x2 w; w.x = cvtpk(v[j].x, v[j].y); w.y = cvtpk(v[j].z, v[j].w); xo[64 * j] = w; }
            if (lane == 0) RSTD[row] = rstd; }
        const f32x4* gr = (const f32x4*)gain + lane;
        if (MODE < 0) { u32x2* o8 = (u32x2*)(XN + (size_t)row * D) + lane;
#pragma unroll
            for (int j = 0; j < 8; ++j) { const f32x4 g = gr[64 * j]; u32x2 w; w.x = cvtpk(v[j].x * rstd * g.x, v[j].y * rstd * g.y); w.y = cvtpk(v[j].z * rstd * g.z, v[j].w * rstd * g.w); o8[64 * j] = w; }
        } else if (MODE == 2) { f32x4* oo = (f32x4*)(out + (size_t)row * D) + lane;
#pragma unroll
            for (int j = 0; j < 8; ++j) { const f32x4 g = gr[64 * j]; oo[64 * j] = v[j] * rstd * g; } }
    }
}

constexpr int I_WIN = 32 * 184, I_WOUT = 32 * 64, I_W1 = 32 * 8, I_W2 = 4 * 2, I_RW = 32 * 3, I_L = I_WIN + I_WOUT + 2 * I_W1 + 2 * I_W2 + I_RW;
__device__ __forceinline__ void tr_dispatch(const Args& a, unsigned char* ws, int it, LAS float* scr, int lane) {
        const int l = it / I_L; int r = it % I_L;
        if (r < I_WIN) { tr_item<1>(a.in[2] + (size_t)l * D * DIN, nullptr, DIN, D, (bf16*)(ws + WS_WIN) + (size_t)l * NP * D, 64 * (r / 184), 32 * (r % 184), scr, lane, a.in[1] + (size_t)l * D); return; } r -= I_WIN;
        if (r < I_WOUT) { tr_item<0>(a.in[13] + (size_t)l * D * D, nullptr, D, D, (bf16*)(ws + WS_WOUT) + (size_t)l * D * D, 64 * (r / 64), 32 * (r % 64), scr, lane); return; } r -= I_WOUT;
        if (r < 2 * I_W1) { const int kv = r / I_W1, q = r % I_W1; tr_item<0>(a.in[kv ? 10 : 7] + (size_t)l * 2048 * 256, nullptr, 256, 2048, (bf16*)(ws + WS_W1T) + (size_t)(l * 2 + kv) * 256 * 2048, 64 * (q / 8), 32 * (q % 8), scr, lane); return; } r -= 2 * I_W1;
        if (r < 2 * I_W2) { const int kv = r / I_W2, q = r % I_W2; tr_item<0>(a.in[kv ? 11 : 8] + (size_t)l * 256 * 64, nullptr, 64, 256, (bf16*)(ws + WS_W2T) + (size_t)(l * 2 + kv) * 64 * 256, 64 * (q / 2), 32 * (q % 2), scr, lane); return; } r -= 2 * I_W2;
        tr_item<2>(a.in[15] + (size_t)l * D * 8, a.in[17] + (size_t)l * D * 64, 8, D, (bf16*)(ws + WS_RWT) + (size_t)l * 96 * D, 64 * (r / 3), 32 * (r % 3), scr, lane);
}

__device__ __forceinline__ void p0_prologue(const Args& a, LAS unsigned char* lds, int bid, int G, int tid, int wid, int lane) {
    unsigned char* ws = a.ws;
    LAS float* scr = (LAS float*)(lds + wid * 9216);
    const int gw = bid * NWAVES + wid, NGW = G * NWAVES;
    for (int j = gw; j < DEPTH * I_WIN; j += NGW) tr_dispatch(a, ws, (j / I_WIN) * I_L + (j % I_WIN), scr, lane);
    for (int b = bid; b < 256; b += G) {
        const int vec = b >> 5, cb = b & 31, l = vec >> 1, kv = vec & 1; const float* pos = a.in[kv ? 9 : 6] + (size_t)l * 2048; const float* w1 = a.in[kv ? 10 : 7] + (size_t)l * 2048 * 256 + 8 * cb;
        float acc[8];
#pragma unroll
        for (int i = 0; i < 8; ++i) acc[i] = 0.f;
#pragma unroll
        for (int j = 0; j < 4; ++j) { const int k = tid + 512 * j; const float pv = pos[k]; const f32x4 w0 = *(const f32x4*)(w1 + (size_t)k * 256), w1v = *(const f32x4*)(w1 + (size_t)k * 256 + 4);
            acc[0] += pv * w0.x; acc[1] += pv * w0.y; acc[2] += pv * w0.z; acc[3] += pv * w0.w; acc[4] += pv * w1v.x; acc[5] += pv * w1v.y; acc[6] += pv * w1v.z; acc[7] += pv * w1v.w; }
        LAS float* red = (LAS float*)(lds + 72 * 1024);
#pragma unroll
        for (int i = 0; i < 8; ++i) { const float sws = wave_sum(acc[i]); if (lane == 0) red[wid * 8 + i] = sws; }
        __syncthreads();
        if (tid < 8) { float sres = 0.f;
#pragma unroll
            for (int w = 0; w < 8; ++w) sres += red[w * 8 + tid];
            ((float*)(ws + WS_C1))[vec * 256 + 8 * cb + tid] = sres; }
        __syncthreads();
    }
    norm_rows<0>(a.in[0], nullptr, nullptr, (bf16*)(ws + WS_XN), nullptr, nullptr, a.in[1], nullptr, (float*)(ws + WS_RSTD), gw, NGW, lane);
}

__device__ __forceinline__ float gelu_tanh(float x) { const float u = 0.7978845608028654f * (x + 0.044715f * x * x * x); const float t = 1.0f - 2.0f / (__expf(2.0f * u) + 1.0f); return 0.5f * x * (1.0f + t); }

__device__ __forceinline__ void compress_unit(int u, int l, const bf16* PROJ, const bf16* W1T, const bf16* W2T, const float* C1, bf16* KC, bf16* VC, LAS unsigned char* lds, int wid, int lane) {
    const int kv = u >> 6, rb = u & 63, r32 = lane & 31, hi = lane >> 5;
    const int R = 32 * rb + r32, g = R >> 9, n = R & 511;
    const int colb = (kv ? C_VC : C_KC) + 64 * g;
    const bf16* w1 = W1T + (size_t)(l * 2 + kv) * 256 * 2048 + (size_t)(32 * wid + r32) * 2048 + 8 * hi;
    const bf16* arow = PROJ + colb + 8 * hi;
    f32x16 acc = {};
#pragma unroll 4
    for (int s = 0; s < 128; ++s) {
        int tok = 16 * n + (s >> 2); tok = tok > (S - 1) ? (S - 1) : tok;
        const bf16x8 av = *(const bf16x8*)(arow + (size_t)tok * PITCH + (s & 3) * 16);
        const bf16x8 bv = *(const bf16x8*)(w1 + 16 * s);
        acc = MFMA32(av, bv, acc);
    }
    LAS bf16* hid = (LAS bf16*)lds;
    const float c1 = C1[(l * 2 + kv) * 256 + 32 * wid + r32];
#pragma unroll
    for (int r = 0; r < 16; ++r) hid[crow(r, hi) * 264 + 32 * wid + r32] = f2bf16(gelu_tanh(acc[r] + c1));
    __syncthreads();
    if (wid < 2) {
        f32x16 acc2 = {};
        const bf16* w2 = W2T + (size_t)(l * 2 + kv) * 64 * 256 + (size_t)(32 * wid + r32) * 256 + 8 * hi;
#pragma unroll 4
        for (int s = 0; s < 16; ++s) {
            const bf16x8 av = *(const LAS bf16x8*)(hid + r32 * 264 + 16 * s + 8 * hi);
            const bf16x8 bv = *(const bf16x8*)(w2 + 16 * s);
            acc2 = MFMA32(av, bv, acc2);
        }
        bf16* outp = kv ? VC : KC;
#pragma unroll
        for (int r = 0; r < 16; ++r) { const int Rr = 32 * rb + crow(r, hi); outp[(size_t)((Rr >> 9) * 512 + (Rr & 511)) * 64 + 32 * wid + r32] = f2bf16(acc2[r]); }
    }
    __syncthreads();
}

__device__ __forceinline__ void cumsum_unit(int h, int l, const float* AUX, const float* fox_bf, float* CUM, LAS unsigned char* lds, int tid) {
    const float bfv = fox_bf[l * 8 + h];
    float v[16]; float run = 0.f;
#pragma unroll
    for (int i = 0; i < 16; ++i) { const int t = 16 * tid + i; const float z = AUX[(size_t)t * 64 + h] + bfv; const float lf = fminf(z, 0.f) - log1pf(__expf(-fabsf(z))); run += lf; v[i] = run; }
    LAS float* tot = (LAS float*)lds;
    tot[tid] = run; __syncthreads();
    float off = 0.f;
    for (int j = 0; j < tid; ++j) off += tot[j];
#pragma unroll
    for (int i = 0; i < 16; ++i) CUM[(size_t)h * S + 16 * tid + i] = off + v[i];
    __syncthreads();
}

__device__ __forceinline__ int koff(int key, int c) { return c * 1024 + (((key + c) & 63) << 4); }
__device__ __forceinline__ int voff(int key, int c) { return (c >> 2) * 4096 + (key >> 4) * 1024 + (key & 15) * 64 + (c & 3) * 16; }
typedef short v4i16_t __attribute__((ext_vector_type(4)));
__device__ __forceinline__ s16x4 vtr(LAS const unsigned char* p) { return __builtin_bit_cast(s16x4, __builtin_amdgcn_ds_read_tr16_b64_v4i16((LAS v4i16_t*)p)); }

template <int NDT> struct AState { float m, l; f32x16 o[NDT]; };
template <int NDT> __device__ __forceinline__ void astate_init(AState<NDT>& st) { st.m = 0.f; st.l = 0.f;
#pragma unroll
    for (int i = 0; i < NDT; ++i) st.o[i] = (f32x16){}; }

template <bool QLDS>
__device__ __forceinline__ void qk_tile(f32x16& p0, f32x16& p1, LAS const unsigned char* kt, int kchunk0, const bf16x8 (&qf)[4], LAS const unsigned char* qb, int r32, int hi) {
    bf16x8 ka[4], kb[4], q[4];
#pragma unroll
    for (int d0 = 0; d0 < 4; ++d0) {
        const int c = kchunk0 + 2 * d0 + hi;
        ka[d0] = *(const LAS bf16x8*)(kt + koff(r32, c));
        kb[d0] = *(const LAS bf16x8*)(kt + koff(r32 + 32, c));
        q[d0] = QLDS ? *(const LAS bf16x8*)(qb + d0 * 8192) : qf[d0];
    }
    __builtin_amdgcn_sched_barrier(0);
    p0 = (f32x16){}; p1 = (f32x16){};
#pragma unroll
    for (int d0 = 0; d0 < 4; ++d0) { p0 = MFMA32(ka[d0], q[d0], p0); p1 = MFMA32(kb[d0], q[d0], p1); }
    __builtin_amdgcn_sched_barrier(0);
}
__device__ __forceinline__ void pack_p(bf16x8 (&pw)[4], const f32x16& p0, const f32x16& p1) {
    u32x4 w;
    w.x = cvtpk(p0[0], p0[1]); w.y = cvtpk(p0[2], p0[3]); w.z = cvtpk(p0[4], p0[5]); w.w = cvtpk(p0[6], p0[7]); pw[0] = __builtin_bit_cast(bf16x8, w);
    w.x = cvtpk(p0[8], p0[9]); w.y = cvtpk(p0[10], p0[11]); w.z = cvtpk(p0[12], p0[13]); w.w = cvtpk(p0[14], p0[15]); pw[1] = __builtin_bit_cast(bf16x8, w);
    w.x = cvtpk(p1[0], p1[1]); w.y = cvtpk(p1[2], p1[3]); w.z = cvtpk(p1[4], p1[5]); w.w = cvtpk(p1[6], p1[7]); pw[2] = __builtin_bit_cast(bf16x8, w);
    w.x = cvtpk(p1[8], p1[9]); w.y = cvtpk(p1[10], p1[11]); w.z = cvtpk(p1[12], p1[13]); w.w = cvtpk(p1[14], p1[15]); pw[3] = __builtin_bit_cast(bf16x8, w);
}
struct VFrag { s16x4 lo[4], hh[4]; };
__device__ __forceinline__ LAS const unsigned char* vfrag_base(LAS const unsigned char* vt, int lane) { return vt + ((lane >> 4) & 1) * 32 + (lane & 3) * 8 + (4 * (lane >> 5) + ((lane & 15) >> 2)) * 64; }
__device__ __forceinline__ void vfrag_read(VFrag& f, LAS const unsigned char* vb, int dt) {
#pragma unroll
    for (int s = 0; s < 4; ++s) { f.lo[s] = vtr(vb + dt * 4096 + s * 1024); f.hh[s] = vtr(vb + dt * 4096 + s * 1024 + 512); }
}
__device__ __forceinline__ void vfrag_mma(f32x16& o, const VFrag& f, const bf16x8 (&pw)[4]) {
#pragma unroll
    for (int s = 0; s < 4; ++s) { const bf16x8 vf = (bf16x8){f.lo[s][0], f.lo[s][1], f.lo[s][2], f.lo[s][3], f.hh[s][0], f.hh[s][1], f.hh[s][2], f.hh[s][3]}; o = MFMA32(vf, pw[s], o); }
}
template <int NDT>
__device__ __forceinline__ void pv_tile_pre(f32x16 (&o)[NDT], const bf16x8 (&pw)[4], LAS const unsigned char* vb, VFrag& f0) {
    VFrag f1;
#pragma unroll
    for (int dt = 0; dt < NDT; dt += 2) {
        if (dt + 1 < NDT) vfrag_read(f1, vb, dt + 1);
        __builtin_amdgcn_sched_barrier(0);
        vfrag_mma(o[dt], f0, pw);
        if (dt + 1 < NDT) {
            if (dt + 2 < NDT) vfrag_read(f0, vb, dt + 2);
            __builtin_amdgcn_sched_barrier(0);
            vfrag_mma(o[dt + 1], f1, pw);
        }
    }
}
template <int NDT>
__device__ __forceinline__ void pv_tile(f32x16 (&o)[NDT], const bf16x8 (&pw)[4], LAS const unsigned char* vt, int lane) {
    LAS const unsigned char* vb = vfrag_base(vt, lane);
    VFrag f0; vfrag_read(f0, vb, 0);
    pv_tile_pre<NDT>(o, pw, vb, f0);
}
constexpr float SM_THR = 8.0f;
__device__ __forceinline__ float max3f(float a, float b, float c) { return __builtin_fmaxf(__builtin_fmaxf(a, b), c); }
__device__ __forceinline__ float halfmax(float m) { auto rr = __builtin_amdgcn_permlane32_swap(__float_as_uint(m), __float_as_uint(m), false, false); return fmaxf(__uint_as_float(rr[0]), __uint_as_float(rr[1])); }
__device__ __forceinline__ float halfsum(float v) { auto rr = __builtin_amdgcn_permlane32_swap(__float_as_uint(v), __float_as_uint(v), false, false); return __uint_as_float(rr[0]) + __uint_as_float(rr[1]); }
#ifndef SM_VPRE
#define SM_VPRE false
#endif
template <int NDT>
__device__ __forceinline__ void softmax_pv(AState<NDT>& st, f32x16& p0, f32x16& p1, LAS const unsigned char* vt, int lane) {
    LAS const unsigned char* vb = vfrag_base(vt, lane);
    constexpr bool VPRE = SM_VPRE;
    VFrag f0; if (VPRE) { vfrag_read(f0, vb, 0); __builtin_amdgcn_sched_barrier(0); }
    float ma = max3f(p0[0], p0[1], p0[2]), mb = max3f(p1[0], p1[1], p1[2]);
#pragma unroll
    for (int r = 3; r < 15; r += 2) { ma = max3f(ma, p0[r], p0[r + 1]); mb = max3f(mb, p1[r], p1[r + 1]); }
    float mx = max3f(ma, mb, fmaxf(p0[15], p1[15]));
    mx = halfmax(mx);
    if (__any(mx > SM_THR)) {
        const float d = fmaxf(mx, 0.f), alpha = __builtin_amdgcn_exp2f(-d); st.m += d; st.l *= alpha;
#pragma unroll
        for (int r = 0; r < 16; ++r) { p0[r] -= d; p1[r] -= d; }
#pragma unroll
        for (int dt = 0; dt < NDT; ++dt)
#pragma unroll
            for (int r = 0; r < 16; ++r) st.o[dt][r] *= alpha;
    }
    float rs = 0.f;
#pragma unroll
    for (int r = 0; r < 16; ++r) { p0[r] = __builtin_amdgcn_exp2f(p0[r]); p1[r] = __builtin_amdgcn_exp2f(p1[r]); rs += p0[r] + p1[r]; }
    st.l += rs;
    bf16x8 pw[4]; pack_p(pw, p0, p1);
    if (!VPRE) vfrag_read(f0, vb, 0);
    pv_tile_pre<NDT>(st.o, pw, vb, f0);
}
__device__ __forceinline__ void softmax_stats(float& m, float& l, const f32x16& p0, const f32x16& p1) {
    float mx = fmaxf(p0[0], p1[0]);
#pragma unroll
    for (int r = 1; r < 16; ++r) mx = fmaxf(mx, fmaxf(p0[r], p1[r]));
    mx = halfmax(mx);
    const float mn = fmaxf(m, mx), alpha = __builtin_amdgcn_exp2f(m - mn); m = mn;
    float rs = 0.f;
#pragma unroll
    for (int r = 0; r < 16; ++r) rs += __builtin_amdgcn_exp2f(p0[r] - mn) + __builtin_amdgcn_exp2f(p1[r] - mn);
    l = l * alpha + rs;
}

template <int KCH, int VCH> struct Stage { u32x4 k[KCH / 8], v[VCH / 8], x; };
template <int KCH, int VCH, bool XROW>
__device__ __forceinline__ void stage_load(Stage<KCH, VCH>& sg, const bf16* ksrc, const bf16* vsrc, const float* xsrc, size_t pitch, int key0, int tid) {
#pragma unroll
    for (int i = 0; i < KCH / 8; ++i) { const int idx = tid + 512 * i, key = idx / KCH, c = idx % KCH; sg.k[i] = *(const u32x4*)(ksrc + (size_t)(key0 + key) * pitch + 8 * c); }
#pragma unroll
    for (int i = 0; i < VCH / 8; ++i) { const int idx = tid + 512 * i, key = idx / VCH, c = idx % VCH; sg.v[i] = *(const u32x4*)(vsrc + (size_t)(key0 + key) * pitch + 8 * c); }
    if (XROW) sg.x = *(const u32x4*)(xsrc + key0 + 4 * (tid & 15));
}
template <int KCH, int VCH, bool XROW>
__device__ __forceinline__ void stage_write(const Stage<KCH, VCH>& sg, LAS unsigned char* kb, LAS unsigned char* vb, LAS unsigned char* xb, int tid) {
#pragma unroll
    for (int i = 0; i < KCH / 8; ++i) { const int idx = tid + 512 * i, key = idx / KCH, c = idx % KCH; *(LAS u32x4*)(kb + koff(key, c)) = sg.k[i]; }
#pragma unroll
    for (int i = 0; i < VCH / 8; ++i) { const int idx = tid + 512 * i, key = idx / VCH, c = idx % VCH; *(LAS u32x4*)(vb + voff(key, c)) = sg.v[i]; }
    if (XROW) { if (tid < 16) { f32x4 xv = __builtin_bit_cast(f32x4, sg.x); xv = xv * LOG2E; *(LAS f32x4*)(xb + 16 * tid) = xv; } }
}

template <int KCH, int VCH, bool XROW, int NST  , bool QLDS, class Fn>
__device__ __forceinline__ void kv_loop(Fn& fn, const bf16x8 (&qf)[4], LAS const unsigned char* qb, int kchunk0, const bf16* ksrc, const bf16* vsrc, const float* xsrc, size_t pitch, int t_lo, int t_hi,
                                        LAS unsigned char* KB, LAS unsigned char* VB, LAS unsigned char* XB, int tid, int lane) {
    constexpr int KBYTES = KCH * 1024, VBYTES = VCH * 1024;
    const int r32 = lane & 31, hi = lane >> 5, nt = t_hi - t_lo;
    if (NST == 1) {
        Stage<KCH, VCH> sg;
        stage_load<KCH, VCH, XROW>(sg, ksrc, vsrc, xsrc, pitch, 64 * t_lo, tid);
        stage_write<KCH, VCH, XROW>(sg, KB, VB, XB, tid);
        __syncthreads();
        for (int i = 0; i < nt; ++i) {
            const int b = i & 1;
            if (i + 1 < nt) stage_load<KCH, VCH, XROW>(sg, ksrc, vsrc, xsrc, pitch, 64 * (t_lo + i + 1), tid);
            if (fn.need(t_lo + i)) { f32x16 p0, p1; qk_tile<QLDS>(p0, p1, KB + b * KBYTES, kchunk0, qf, qb, r32, hi); fn.tile(t_lo + i, p0, p1, VB + b * VBYTES, XB + b * 256); }
            if (i + 1 < nt) stage_write<KCH, VCH, XROW>(sg, KB + (b ^ 1) * KBYTES, VB + (b ^ 1) * VBYTES, XB + (b ^ 1) * 256, tid);
            __syncthreads();
        }
        return;
    }
    Stage<KCH, VCH> sgA, sgB;
    stage_load<KCH, VCH, XROW>(sgA, ksrc, vsrc, xsrc, pitch, 64 * t_lo, tid);
    if (nt > 1) stage_load<KCH, VCH, XROW>(sgB, ksrc, vsrc, xsrc, pitch, 64 * (t_lo + 1), tid);
    stage_write<KCH, VCH, XROW>(sgA, KB, VB, XB, tid);
    __syncthreads();
    for (int i = 0; i < nt; i += 2) {
        if (i + 2 < nt) stage_load<KCH, VCH, XROW>(sgA, ksrc, vsrc, xsrc, pitch, 64 * (t_lo + i + 2), tid);
        if (fn.need(t_lo + i)) { f32x16 p0, p1; qk_tile<QLDS>(p0, p1, KB, kchunk0, qf, qb, r32, hi); fn.tile(t_lo + i, p0, p1, VB, XB); }
        if (i + 1 < nt) stage_write<KCH, VCH, XROW>(sgB, KB + KBYTES, VB + VBYTES, XB + 256, tid);
        __syncthreads();
        if (i + 1 >= nt) break;
        if (i + 3 < nt) stage_load<KCH, VCH, XROW>(sgB, ksrc, vsrc, xsrc, pitch, 64 * (t_lo + i + 3), tid);
        if (fn.need(t_lo + i + 1)) { f32x16 p0, p1; qk_tile<QLDS>(p0, p1, KB + KBYTES, kchunk0, qf, qb, r32, hi); fn.tile(t_lo + i + 1, p0, p1, VB + VBYTES, XB + 256); }
        if (i + 2 < nt) stage_write<KCH, VCH, XROW>(sgA, KB, VB, XB, tid);
        __syncthreads();
    }
}

#define SGB(mask, n) __builtin_amdgcn_sched_group_barrier(mask, n, 0)
template <int NDT>
__device__ __forceinline__ void sp_finish(AState<NDT>& st, f32x16& s0, f32x16& s1, bf16x8 (&pw)[4]) {
    float rs = 0.f;
#pragma unroll
    for (int r = 0; r < 16; ++r) { s0[r] = __builtin_amdgcn_exp2f(s0[r]); s1[r] = __builtin_amdgcn_exp2f(s1[r]); rs += s0[r] + s1[r]; }
    st.l += rs;
    pack_p(pw, s0, s1);
}
__device__ __forceinline__ float sp_rowmax(const f32x16& p0, const f32x16& p1) {
    float ma = max3f(p0[0], p0[1], p0[2]), mb = max3f(p1[0], p1[1], p1[2]);
#pragma unroll
    for (int r = 3; r < 15; r += 2) { ma = max3f(ma, p0[r], p0[r + 1]); mb = max3f(mb, p1[r], p1[r + 1]); }
    return max3f(ma, mb, fmaxf(p0[15], p1[15]));
}
template <int NDT>
__device__ __forceinline__ void sp_raise(AState<NDT>& st, f32x16& p0, f32x16& p1, float mx) {
    mx = halfmax(mx);
    if (__any(mx > SM_THR)) {
        const float d = fmaxf(mx, 0.f), alpha = __builtin_amdgcn_exp2f(-d); st.m += d; st.l *= alpha;
#pragma unroll
        for (int r = 0; r < 16; ++r) { p0[r] -= d; p1[r] -= d; }
#pragma unroll
        for (int dt = 0; dt < NDT; ++dt)
#pragma unroll
            for (int r = 0; r < 16; ++r) st.o[dt][r] *= alpha;
    }
}
__device__ __forceinline__ void sp_finish_part(int j, float& rs, f32x16& s0, f32x16& s1, u32x4 (&pu)[4]) {
#pragma unroll
    for (int r = 4 * j; r < 4 * j + 4; ++r) { s0[r] = __builtin_amdgcn_exp2f(s0[r]); s1[r] = __builtin_amdgcn_exp2f(s1[r]); rs += s0[r] + s1[r]; }
    const unsigned a0 = cvtpk(s0[4 * j], s0[4 * j + 1]), a1 = cvtpk(s0[4 * j + 2], s0[4 * j + 3]), b0 = cvtpk(s1[4 * j], s1[4 * j + 1]), b1 = cvtpk(s1[4 * j + 2], s1[4 * j + 3]);
    if (j & 1) { pu[j >> 1].z = a0; pu[j >> 1].w = a1; pu[2 + (j >> 1)].z = b0; pu[2 + (j >> 1)].w = b1; }
    else       { pu[j >> 1].x = a0; pu[j >> 1].y = a1; pu[2 + (j >> 1)].x = b0; pu[2 + (j >> 1)].y = b1; }
}
#define SP_STEADY(T, KBUF, XBUF, SP0, SP1, SN0, SN1)                                                                                                    \
    {   bf16x8 ka[4], kb[4], q[4];                                                                                                                      \
        _Pragma("unroll") for (int d0 = 0; d0 < 4; ++d0) { const int c = kchunk0 + 2 * d0 + hi;                                                         \
            ka[d0] = *(const LAS bf16x8*)((KBUF) + koff(r32, c)); kb[d0] = *(const LAS bf16x8*)((KBUF) + koff(r32 + 32, c));                             \
            q[d0] = QLDS ? *(const LAS bf16x8*)(qb + d0 * 8192) : qf[d0]; }                                                                             \
        LAS const unsigned char* vb = vfrag_base(VB + vp * VBYTES, lane);                                                                               \
        VFrag f0, f1; u32x4 pu[4]; float rs = 0.f;                                                                                                      \
        __builtin_amdgcn_sched_barrier(0);                                                                                                              \
        SN0 = (f32x16){}; SN1 = (f32x16){};                                                                                                             \
        _Pragma("unroll") for (int j = 0; j < 4; ++j) {                                                                                                 \
            SN0 = MFMA32(ka[j], q[j], SN0); SN1 = MFMA32(kb[j], q[j], SN1);                                                                             \
            sp_finish_part(j, rs, SP0, SP1, pu);                                                                                                        \
            if (NDT == 2 && j == 2) vfrag_read(f0, vb, 0);                                                                                              \
            if (NDT == 2 && j == 3) vfrag_read(f1, vb, 1);                                                                                              \
            __builtin_amdgcn_sched_barrier(0);                                                                                                          \
        }                                                                                                                                               \
        fn.st.l += rs;                                                                                                                                  \
        _Pragma("unroll") for (int k = 0; k < 4; ++k) pw[k] = __builtin_bit_cast(bf16x8, pu[k]);                                                        \
        float mx = NEG;                                                                                                                                 \
        _Pragma("unroll") for (int dt = 0; dt < NDT; dt += 2) {                                                                                         \
            if (NDT != 2) { vfrag_read(f0, vb, dt); vfrag_read(f1, vb, dt + 1); __builtin_amdgcn_sched_barrier(0); }                                    \
            _Pragma("unroll") for (int sx = 0; sx < 4; ++sx) {                                                                                          \
                { const bf16x8 vf = (bf16x8){f0.lo[sx][0], f0.lo[sx][1], f0.lo[sx][2], f0.lo[sx][3], f0.hh[sx][0], f0.hh[sx][1], f0.hh[sx][2], f0.hh[sx][3]}; fn.st.o[dt] = MFMA32(vf, pw[sx], fn.st.o[dt]); } \
                { const bf16x8 vf = (bf16x8){f1.lo[sx][0], f1.lo[sx][1], f1.lo[sx][2], f1.lo[sx][3], f1.hh[sx][0], f1.hh[sx][1], f1.hh[sx][2], f1.hh[sx][3]}; fn.st.o[dt + 1] = MFMA32(vf, pw[sx], fn.st.o[dt + 1]); } \
                if (dt == 0) { fn.score_part(sx, T, SN0, SN1, XBUF); mx = fn.max_part(sx, mx, SN0, SN1); }                                              \
                __builtin_amdgcn_sched_barrier(0);                                                                                                      \
            }                                                                                                                                           \
        }                                                                                                                                               \
        mx = fn.score_mask(T, mx, SN0, SN1);                                                                                                            \
        sp_raise<NDT>(fn.st, SN0, SN1, mx); }
template <int KCH, int VCH, bool XROW, bool QLDS, int NDT, class Fn>
__device__ __forceinline__ void kv_loop_sp(Fn& fn, const bf16x8 (&qf)[4], LAS const unsigned char* qb, int kchunk0, const bf16* ksrc, const bf16* vsrc, const float* xsrc, size_t pitch, int t_lo, int t_hi, int nw,
                                           LAS unsigned char* KB, LAS unsigned char* VB, LAS unsigned char* XB, int tid, int lane) {
    constexpr int KBYTES = KCH * 1024, VBYTES = VCH * 1024;
    const int r32 = lane & 31, hi = lane >> 5, nt = t_hi - t_lo;
    Stage<KCH, VCH> sg;
    stage_load<KCH, VCH, XROW>(sg, ksrc, vsrc, xsrc, pitch, 64 * t_lo, tid);
    stage_write<KCH, VCH, XROW>(sg, KB, VB, XB, tid);
    __syncthreads();
    f32x16 sa0, sa1, sb0, sb1; bf16x8 pw[4];
    int vc = 0, vp = 2, vn, i = 0;
#define SP_PRE(I)  if ((I) + 1 < nt) stage_load<KCH, VCH, XROW>(sg, ksrc, vsrc, xsrc, pitch, 64 * (t_lo + (I) + 1), tid);
#define SP_POST(I, KOFFN, XOFFN) vn = vc == 2 ? 0 : vc + 1; if ((I) + 1 < nt) stage_write<KCH, VCH, XROW>(sg, KB + (KOFFN), VB + vn * VBYTES, XB + (XOFFN), tid); __syncthreads(); vp = vc; vc = vn;
    SP_PRE(0)
    qk_tile<QLDS>(sa0, sa1, KB, kchunk0, qf, qb, r32, hi); fn.score(t_lo, sa0, sa1, XB); sp_raise<NDT>(fn.st, sa0, sa1, sp_rowmax(sa0, sa1));
    SP_POST(0, KBYTES, 256)
    i = 1;
    while (i + 1 < nw) {
        SP_PRE(i)
        SP_STEADY(t_lo + i, KB + KBYTES, XB + 256, sa0, sa1, sb0, sb1)
        SP_POST(i, 0, 0)
        SP_PRE(i + 1)
        SP_STEADY(t_lo + i + 1, KB, XB, sb0, sb1, sa0, sa1)
        SP_POST(i + 1, KBYTES, 256)
        i += 2;
    }
    if (i < nw) {
        SP_PRE(i)
        SP_STEADY(t_lo + i, KB + KBYTES, XB + 256, sa0, sa1, sb0, sb1)
        SP_POST(i, 0, 0)
        sa0 = sb0; sa1 = sb1; ++i;
    }
    if (i < nt) { SP_PRE(i) }
    sp_finish<NDT>(fn.st, sa0, sa1, pw); pv_tile<NDT>(fn.st.o, pw, VB + vp * VBYTES, lane);
    if (i < nt) { const int ko = (i & 1) ? 0 : KBYTES, xo = (i & 1) ? 0 : 256; SP_POST(i, ko, xo) ++i; }
    while (i < nt) { const int ko = (i & 1) ? 0 : KBYTES, xo = (i & 1) ? 0 : 256; SP_PRE(i) SP_POST(i, ko, xo) ++i; }
    __syncthreads();
#undef SP_PRE
#undef SP_POST
}

struct FoxFn {
    AState<2> st; float cq; int tq, tmin, tmax, lane;
    __device__ __forceinline__ bool need(int t) const { return 64 * t <= tmax; }
    __device__ __forceinline__ void score_part(int a, int t, f32x16& p0, f32x16& p1, LAS const unsigned char* xrow) {
        const int hi = lane >> 5; LAS const float* ck = (LAS const float*)xrow;
        const float cqm = cq - st.m;
        const f32x4 c0 = *(LAS const f32x4*)(ck + 8 * a + 4 * hi), c1 = *(LAS const f32x4*)(ck + 32 + 8 * a + 4 * hi);
#pragma unroll
        for (int i = 0; i < 4; ++i) { const int r = 4 * a + i; p0[r] = p0[r] * SCL2 + (cqm - c0[i]); p1[r] = p1[r] * SCL2 + (cqm - c1[i]); }
    }
    __device__ __forceinline__ float max_part(int a, float mx, const f32x16& p0, const f32x16& p1) const {
        return max3f(max3f(mx, p0[4 * a], p0[4 * a + 1]), max3f(p0[4 * a + 2], p0[4 * a + 3], p1[4 * a]), max3f(p1[4 * a + 1], p1[4 * a + 2], p1[4 * a + 3])); }
    __device__ __forceinline__ float score_mask(int t, float mx, f32x16& p0, f32x16& p1) const {
        const int hi = lane >> 5, k0 = 64 * t;
        if (k0 + 63 > tmin) {
#pragma unroll
            for (int r = 0; r < 16; ++r) { const int key = k0 + crow(r, hi); p0[r] = key <= tq ? p0[r] : NEG; p1[r] = key + 32 <= tq ? p1[r] : NEG; }
            mx = sp_rowmax(p0, p1);
        }
        return mx;
    }
    __device__ __forceinline__ void score(int t, f32x16& p0, f32x16& p1, LAS const unsigned char* xrow) {
#pragma unroll
        for (int a = 0; a < 4; ++a) score_part(a, t, p0, p1, xrow);
        score_mask(t, 0.f, p0, p1);
    }
};
__device__ __forceinline__ void fox_unit(int h, int qb, const bf16* PROJ, const float* CUM, bf16* MIX, LAS unsigned char* lds, int tid, int wid, int lane) {
    const int r32 = lane & 31, hi = lane >> 5, q0 = 256 * qb, tq = q0 + 32 * wid + r32;
    bf16x8 qf[4];
#pragma unroll
    for (int d0 = 0; d0 < 4; ++d0) qf[d0] = *(const bf16x8*)(PROJ + (size_t)tq * PITCH + C_BQ + 64 * h + 16 * d0 + 8 * hi);
    const float* cum = CUM + (size_t)h * S;
    FoxFn fn; astate_init<2>(fn.st); fn.cq = cum[tq] * LOG2E; fn.tq = tq; fn.tmin = q0 + 32 * wid; fn.tmax = q0 + 32 * wid + 31; fn.lane = lane;
    kv_loop_sp<8, 8, true, false, 2>(fn, qf, lds, 0, PROJ + C_BK + 64 * h, PROJ + C_BV + 64 * h, cum, PITCH, 0, 4 * (qb + 1), min(4 * (qb + 1), (fn.tmax >> 6) + 1), lds, lds + 16384, lds + 40960, tid, lane);
    const float lt = fn.st.l + __shfl_xor(fn.st.l, 32), inv = 1.0f / lt;
    bf16* orow = MIX + (size_t)tq * D + 512 + 64 * h;
#pragma unroll
    for (int dt = 0; dt < 2; ++dt)
#pragma unroll
        for (int a = 0; a < 4; ++a) { u32x2 w; w.x = cvtpk(fn.st.o[dt][4 * a] * inv, fn.st.o[dt][4 * a + 1] * inv); w.y = cvtpk(fn.st.o[dt][4 * a + 2] * inv, fn.st.o[dt][4 * a + 3] * inv);
            *(u32x2*)(orow + 32 * dt + 8 * a + 4 * hi) = w; }
}

struct DiffFn {
    AState<4> st; LAS const float* lut; int tq, tmin, tmax, lane;
    __device__ __forceinline__ bool need(int t) const { return 64 * t <= tmax; }
    __device__ __forceinline__ void tile(int t, f32x16& p0, f32x16& p1, LAS const unsigned char* vt, LAS const unsigned char*) {
        const int hi = lane >> 5, k0 = 64 * t;
        const float mref = st.m;
        if (k0 + 63 + 127 <= tmin) {
            const float b = lut[127] - mref;
#pragma unroll
            for (int r = 0; r < 16; ++r) { p0[r] = p0[r] * SCL2 + b; p1[r] = p1[r] * SCL2 + b; }
        } else {
#pragma unroll
            for (int r = 0; r < 16; ++r) { const int rel0 = tq - (k0 + crow(r, hi)); const float b0 = lut[min(max(rel0, 0), 127)] - mref; p0[r] = rel0 >= 0 ? p0[r] * SCL2 + b0 : NEG; }
            __builtin_amdgcn_sched_barrier(0);
#pragma unroll
            for (int r = 0; r < 16; ++r) { const int rel1 = tq - (k0 + 32 + crow(r, hi)); const float b1 = lut[min(max(rel1, 0), 127)] - mref; p1[r] = rel1 >= 0 ? p1[r] * SCL2 + b1 : NEG; }
            __builtin_amdgcn_sched_barrier(0);
        }
        softmax_pv<4>(st, p0, p1, vt, lane);
    }
};
__device__ __forceinline__ void diff_unit(int h, int qb, int l, const Args& a, const bf16* PROJ, bf16* MIX, LAS unsigned char* lds, int tid, int wid, int lane) {
    const int r32 = lane & 31, hi = lane >> 5, q0 = 128 * qb, map = wid & 1, qs = wid >> 1, tq = q0 + 32 * qs + r32;
    LAS float* lut = (LAS float*)(lds + 65536); LAS float* lamw = (LAS float*)(lds + 65536 + 512);
    const float lam_init = 0.8f - 0.6f * expf(-0.3f * (float)l);
    if (tid < 128) lut[tid] = a.in[12][t5_bucket(tid) * 20 + h] * LOG2E;
    if (wid == 0) { const float* dl = a.in[3] + (size_t)l * 256;
        const float s1 = wave_sum(dl[lane] * dl[64 + lane]), s2 = wave_sum(dl[128 + lane] * dl[192 + lane]);
        if (lane == 0) lamw[0] = expf(s1) - expf(s2) + lam_init; }
    bf16x8 qf[4];
#pragma unroll
    for (int d0 = 0; d0 < 4; ++d0) qf[d0] = *(const bf16x8*)(PROJ + (size_t)tq * PITCH + C_AQ + 128 * h + 64 * map + 16 * d0 + 8 * hi);
    DiffFn fn; astate_init<4>(fn.st); fn.lut = lut; fn.tq = tq; fn.tmin = q0 + 32 * qs; fn.tmax = q0 + 32 * qs + 31; fn.lane = lane;
    LAS unsigned char* const qlds = lds + 67584 + tid * 16;
#pragma unroll
    for (int d0 = 0; d0 < 4; ++d0) *(LAS bf16x8*)(qlds + d0 * 8192) = qf[d0];
    kv_loop<16, 16, false, 1, true>(fn, qf, qlds, 8 * map, PROJ + C_AK + 128 * h, PROJ + C_AV + 128 * h, nullptr, PITCH, 0, 2 * (qb + 1), lds, lds + 32768, lds, tid, lane);
    const float lt = fn.st.l + __shfl_xor(fn.st.l, 32), inv = 1.0f / lt;
    LAS float* ex = (LAS float*)(lds + qs * 16384);
    if (map == 1) {
#pragma unroll
        for (int dt = 0; dt < 4; ++dt)
#pragma unroll
            for (int r = 0; r < 16; ++r) ex[(32 * dt + crow(r, hi)) * 32 + r32] = fn.st.o[dt][r] * inv;
    }
    __syncthreads();
    if (map == 0) {
        const float lam = lamw[0]; float ss = 0.f;
#pragma unroll
        for (int dt = 0; dt < 4; ++dt)
#pragma unroll
            for (int r = 0; r < 16; ++r) { const float v = fn.st.o[dt][r] * inv - lam * ex[(32 * dt + crow(r, hi)) * 32 + r32]; fn.st.o[dt][r] = v; ss += v * v; }
        ss += __shfl_xor(ss, 32);
        const float rstd = (1.0f / sqrtf(ss * (1.0f / 128.0f) + RMS_EPS)) * (1.0f - lam_init);
        const float* sub = a.in[4] + (size_t)l * 128; bf16* orow = MIX + (size_t)tq * D + 128 * h;
#pragma unroll
        for (int dt = 0; dt < 4; ++dt)
#pragma unroll
            for (int q4 = 0; q4 < 4; ++q4) { const int d = 32 * dt + 8 * q4 + 4 * hi; const f32x4 g = *(const f32x4*)(sub + d);
                u32x2 w; w.x = cvtpk(fn.st.o[dt][4 * q4] * rstd * g.x, fn.st.o[dt][4 * q4 + 1] * rstd * g.y); w.y = cvtpk(fn.st.o[dt][4 * q4 + 2] * rstd * g.z, fn.st.o[dt][4 * q4 + 3] * rstd * g.w);
                *(u32x2*)(orow + d) = w; }
    }
    __syncthreads();
}

#ifndef NSA_DUP
#define NSA_DUP 0
#endif
constexpr int IMP_P = 132;
__device__ __forceinline__ float quad_sum(float v) {
    v += __builtin_bit_cast(float, __builtin_amdgcn_mov_dpp(__builtin_bit_cast(int, v), 0xB1, 0xF, 0xF, true));
    v += __builtin_bit_cast(float, __builtin_amdgcn_mov_dpp(__builtin_bit_cast(int, v), 0x4E, 0xF, 0xF, true));
    return v; }
#define LADD(p, v) (void)__hip_atomic_fetch_add((p), (v), __ATOMIC_RELAXED, __HIP_MEMORY_SCOPE_WORKGROUP)
constexpr int NSA_QF = 32768, NSA_SELW = 65536, NSA_LUT = 66560, NSA_IMP = 69632, NSA_FIN = 69632;

struct CmpStatFn {
    float m, l; int tq, lane, ncnt;
    __device__ __forceinline__ bool need(int) const { return true; }
    __device__ __forceinline__ void tile(int t, f32x16& p0, f32x16& p1, LAS const unsigned char*, LAS const unsigned char*) {
        const int hi = lane >> 5, n0 = 64 * t;
#pragma unroll
        for (int r = 0; r < 16; ++r) { const int n = n0 + crow(r, hi);
            p0[r] = (16 * n + 31 <= tq) ? p0[r] * SCL2 : NEG; p1[r] = (16 * (n + 32) + 31 <= tq) ? p1[r] * SCL2 : NEG; }
        softmax_stats(m, l, p0, p1);
    }
};
struct CmpPvFn {
    f32x16 o[2]; float m, invl; int tq, ql, lane; LAS float* imp;
    __device__ __forceinline__ bool need(int) const { return true; }
    __device__ __forceinline__ void tile(int t, f32x16& p0, f32x16& p1, LAS const unsigned char* vt, LAS const unsigned char*) {
        const int hi = lane >> 5, n0 = 64 * t;
#pragma unroll
        for (int r = 0; r < 16; ++r) { const int n = n0 + crow(r, hi);
            p0[r] = (16 * n + 31 <= tq) ? __builtin_amdgcn_exp2f(p0[r] * SCL2 - m) * invl : 0.f;
            p1[r] = (16 * (n + 32) + 31 <= tq) ? __builtin_amdgcn_exp2f(p1[r] * SCL2 - m) * invl : 0.f; }
        LAS float* row = imp + ql * IMP_P;
        const bool lead = (lane & 3) == 0;
#pragma unroll
        for (int a = 0; a < 4; ++a) {
            const int j0 = (n0 >> 2) + 2 * a + hi, j1 = j0 + 8;
            const float h0 = quad_sum(0.5f * p0[4 * a + 3]), h1 = quad_sum(0.5f * p1[4 * a + 3]);
            const float b0 = quad_sum(p0[4 * a] + p0[4 * a + 1] + p0[4 * a + 2]) + h0, b1 = quad_sum(p1[4 * a] + p1[4 * a + 1] + p1[4 * a + 2]) + h1;
            if (lead) {
                LADD(row + j0, b0);
                if (j0 + 1 < 128) LADD(row + j0 + 1, h0);
                if (j1 < 128) LADD(row + j1, b1);
                if (j1 + 1 < 128) LADD(row + j1 + 1, h1);
            }
        }
        bf16x8 pw[4]; pack_p(pw, p0, p1);
        pv_tile<2>(o, pw, vt, lane);
    }
};
struct SelFn {
    AState<2> st; LAS const float* lut; int tq, tmin, tmax, lane, mode; unsigned sw0, sw1, sw2, sw3, uw0, uw1, uw2, uw3;
    __device__ __forceinline__ unsigned pick(int j, unsigned a, unsigned b, unsigned c, unsigned d) const { const int w = j >> 5; const unsigned x = (w == 0) ? a : (w == 1) ? b : (w == 2) ? c : d; return (x >> (j & 31)) & 1u; }
    __device__ __forceinline__ bool need(int t) const { return mode == 1 || pick(t, uw0, uw1, uw2, uw3) != 0u; }
    __device__ __forceinline__ void tile(int t, f32x16& p0, f32x16& p1, LAS const unsigned char* vt, LAS const unsigned char*) {
        const int hi = lane >> 5, k0 = 64 * t;
        const bool bit = (mode == 1) || pick(t, sw0, sw1, sw2, sw3) != 0u;
        const bool far = k0 + 63 + 127 <= tmin;
        const bool wcut = (mode == 1) && (tmax - k0 >= 512);
        const float mref = st.m;
        if (far && !wcut) {
            const float b = lut[127] - mref;
#pragma unroll
            for (int r = 0; r < 16; ++r) { p0[r] = bit ? p0[r] * SCL2 + b : NEG; p1[r] = bit ? p1[r] * SCL2 + b : NEG; }
        } else {
#pragma unroll
            for (int r = 0; r < 16; ++r) { const int rel0 = tq - (k0 + crow(r, hi));
                const float b0 = lut[min(max(rel0, 0), 127)] - mref;
                const bool ok0 = bit && rel0 >= 0 && (mode == 0 || rel0 < 512);
                p0[r] = ok0 ? p0[r] * SCL2 + b0 : NEG; }
            __builtin_amdgcn_sched_barrier(0);
#pragma unroll
            for (int r = 0; r < 16; ++r) { const int rel1 = tq - (k0 + 32 + crow(r, hi));
                const float b1 = lut[min(max(rel1, 0), 127)] - mref;
                const bool ok1 = bit && rel1 >= 0 && (mode == 0 || rel1 < 512);
                p1[r] = ok1 ? p1[r] * SCL2 + b1 : NEG; }
            __builtin_amdgcn_sched_barrier(0);
        }
        softmax_pv<2>(st, p0, p1, vt, lane);
    }
};

__device__ __forceinline__ void nsa_unit(int g, int qb, const Args& a, const bf16* PROJ, const float* AUX, const bf16* KC, const bf16* VC, bf16* MIX, LAS unsigned char* lds, int tid, int wid, int lane) {
    const int r32 = lane & 31, hi = lane >> 5, q0 = 64 * qb, cur = qb, ql = 8 * wid + (r32 >> 2), hp = r32 & 3, tq = q0 + ql, head = 4 * g + hp;
    LAS float* imp = (LAS float*)(lds + NSA_IMP); LAS unsigned* selw = (LAS unsigned*)(lds + NSA_SELW); LAS float* lut = (LAS float*)(lds + NSA_LUT);
#pragma unroll
    for (int i = 0; i < 17; ++i) { const int e_ = tid + 512 * i; if (e_ < 64 * IMP_P) imp[e_] = 0.f; }
    if (tid < 256) selw[tid] = 0u;
    lut[tid] = a.in[12][t5_bucket(tid & 127) * 20 + 4 + 4 * g + (tid >> 7)] * LOG2E;
    bf16x8 qf[4];
#pragma unroll
    for (int d0 = 0; d0 < 4; ++d0) qf[d0] = *(const bf16x8*)(PROJ + (size_t)tq * PITCH + C_CQ + 64 * head + 16 * d0 + 8 * hi);
    LAS unsigned char* const qlds = lds + NSA_QF + tid * 16;
#pragma unroll
    for (int d0 = 0; d0 < 4; ++d0) *(LAS bf16x8*)(qlds + d0 * 8192) = qf[d0];
    const float* ga = AUX + (size_t)tq * 64 + 8 + head;
    const float gc = 1.0f / (1.0f + __expf(-ga[0])), gs = 1.0f / (1.0f + __expf(-ga[16])), gwn = 1.0f / (1.0f + __expf(-ga[32]));
    LAS float* finl = (LAS float*)(lds + NSA_FIN) + tid;
    f32x16 oc0, oc1;
    {
        int ncnt = (q0 + 32) / 16 + 1; ncnt = ncnt > 511 ? 511 : ncnt; const int ntc = (ncnt + 63) >> 6;
        const bf16* kc = KC + (size_t)g * 512 * 64; const bf16* vc = VC + (size_t)g * 512 * 64;
        CmpStatFn f1; f1.m = NEG; f1.l = 0.f; f1.tq = tq; f1.lane = lane; f1.ncnt = ncnt;
        kv_loop<8, 8, false, 1, true>(f1, qf, qlds, 0, kc, vc, nullptr, 64, 0, ntc, lds, lds + 16384, lds, tid, lane);
        if (NSA_DUP & 1) { f1.m = NEG; f1.l = 0.f; kv_loop<8, 8, false, 1, true>(f1, qf, qlds, 0, kc, vc, nullptr, 64, 0, ntc, lds, lds + 16384, lds, tid, lane); }
        const float lt = f1.l + __shfl_xor(f1.l, 32);
        CmpPvFn f2; f2.o[0] = (f32x16){}; f2.o[1] = (f32x16){}; f2.m = f1.m; f2.invl = (tq >= 31) ? 1.0f / lt : 0.f; f2.tq = tq; f2.ql = ql; f2.lane = lane; f2.imp = imp;
        if (NSA_DUP & 16) { kv_loop<8, 8, false, 1, true>(f2, qf, qlds, 0, kc, vc, nullptr, 64, 0, ntc, lds, lds + 16384, lds, tid, lane); f2.o[0] = (f32x16){}; f2.o[1] = (f32x16){};
#pragma unroll
            for (int i = 0; i < 17; ++i) { const int e_ = tid + 512 * i; if (e_ < 64 * IMP_P) imp[e_] = 0.f; }
            __syncthreads(); }
        kv_loop<8, 8, false, 1, true>(f2, qf, qlds, 0, kc, vc, nullptr, 64, 0, ntc, lds, lds + 16384, lds, tid, lane);
        oc0 = f2.o[0]; oc1 = f2.o[1];
    }
    for (int rep_ = 0; rep_ < ((NSA_DUP & 2) ? 2 : 1); ++rep_)
    if (cur < 16) { if (tid < 64) selw[tid * 4] = (2u << cur) - 1u; }
    else {
        const int qq = tid >> 3, sub = tid & 7;
        float val[16];
#pragma unroll
        for (int i = 0; i < 16; ++i) { const int j = 16 * sub + i; val[i] = (j >= 1 && j <= cur - 2) ? imp[qq * IMP_P + j] : -1.0f; }
        unsigned bits = 0u;
        for (int round = 0; round < 13; ++round) {
            float bv = val[0]; int bi = 0;
#pragma unroll
            for (int i = 1; i < 16; ++i) if (val[i] > bv) { bv = val[i]; bi = i; }
            int gj = 16 * sub + bi;
            { const float ov = __builtin_bit_cast(float, __builtin_amdgcn_mov_dpp(__builtin_bit_cast(int, bv), 0xB1, 0xF, 0xF, true)); const int oj = __builtin_amdgcn_mov_dpp(gj, 0xB1, 0xF, 0xF, true); if (ov > bv || (ov == bv && oj < gj)) { bv = ov; gj = oj; } }
            { const float ov = __builtin_bit_cast(float, __builtin_amdgcn_mov_dpp(__builtin_bit_cast(int, bv), 0x4E, 0xF, 0xF, true)); const int oj = __builtin_amdgcn_mov_dpp(gj, 0x4E, 0xF, 0xF, true); if (ov > bv || (ov == bv && oj < gj)) { bv = ov; gj = oj; } }
            { const float ov = __shfl_xor(bv, 4); const int oj = __shfl_xor(gj, 4); if (ov > bv || (ov == bv && oj < gj)) { bv = ov; gj = oj; } }
            const bool mine = (gj >> 4) == sub;
#pragma unroll
            for (int i = 0; i < 16; ++i) if (mine && (gj & 15) == i) { val[i] = -2.0f; bits |= 1u << i; }
        }
        if (sub == 0) bits |= 1u;
        if (((cur - 1) >> 4) == sub) bits |= 1u << ((cur - 1) & 15);
        if ((cur >> 4) == sub) bits |= 1u << (cur & 15);
        (void)__hip_atomic_fetch_or(selw + qq * 4 + (sub >> 1), bits << (16 * (sub & 1)), __ATOMIC_RELAXED, __HIP_MEMORY_SCOPE_WORKGROUP);
    }
    __syncthreads();
#pragma unroll
    for (int r = 0; r < 16; ++r) { finl[512 * r] = gc * oc0[r]; finl[512 * (16 + r)] = gc * oc1[r]; }
    SelFn fs; fs.lut = lut + hp * 128; fs.tq = tq; fs.tmin = q0 + 8 * wid; fs.tmax = q0 + 8 * wid + 7; fs.lane = lane;
    fs.sw0 = selw[ql * 4 + 0]; fs.sw1 = selw[ql * 4 + 1]; fs.sw2 = selw[ql * 4 + 2]; fs.sw3 = selw[ql * 4 + 3];
    { unsigned u0 = 0u, u1 = 0u, u2 = 0u, u3 = 0u;
#pragma unroll
      for (int i = 0; i < 8; ++i) { u0 |= selw[(8 * wid + i) * 4 + 0]; u1 |= selw[(8 * wid + i) * 4 + 1]; u2 |= selw[(8 * wid + i) * 4 + 2]; u3 |= selw[(8 * wid + i) * 4 + 3]; }
      fs.uw0 = __builtin_amdgcn_readfirstlane(u0); fs.uw1 = __builtin_amdgcn_readfirstlane(u1); fs.uw2 = __builtin_amdgcn_readfirstlane(u2); fs.uw3 = __builtin_amdgcn_readfirstlane(u3); }
    fs.mode = 0; astate_init<2>(fs.st);
    kv_loop<8, 8, false, 1, false>(fs, qf, qlds, 0, PROJ + C_KS + 64 * g, PROJ + C_VS + 64 * g, nullptr, PITCH, 0, cur + 1, lds, lds + 16384, lds, tid, lane);
    if (NSA_DUP & 4) { astate_init<2>(fs.st); kv_loop<8, 8, false, 1, false>(fs, qf, qlds, 0, PROJ + C_KS + 64 * g, PROJ + C_VS + 64 * g, nullptr, PITCH, 0, cur + 1, lds, lds + 16384, lds, tid, lane); }
    { const float lt = fs.st.l + __shfl_xor(fs.st.l, 32), sc = gs / lt;
#pragma unroll
      for (int r = 0; r < 16; ++r) { finl[512 * r] += sc * fs.st.o[0][r]; finl[512 * (16 + r)] += sc * fs.st.o[1][r]; } }
    fs.mode = 1; astate_init<2>(fs.st);
    kv_loop<8, 8, false, 1, false>(fs, qf, qlds, 0, PROJ + C_KW + 64 * g, PROJ + C_VW + 64 * g, nullptr, PITCH, cur >= 8 ? cur - 8 : 0, cur + 1, lds, lds + 16384, lds, tid, lane);
    if (NSA_DUP & 8) { astate_init<2>(fs.st); kv_loop<8, 8, false, 1, false>(fs, qf, qlds, 0, PROJ + C_KW + 64 * g, PROJ + C_VW + 64 * g, nullptr, PITCH, cur >= 8 ? cur - 8 : 0, cur + 1, lds, lds + 16384, lds, tid, lane); }
    { const float lt = fs.st.l + __shfl_xor(fs.st.l, 32), sc = gwn / lt;
#pragma unroll
      for (int r = 0; r < 16; ++r) { fs.st.o[0][r] = finl[512 * r] + sc * fs.st.o[0][r]; fs.st.o[1][r] = finl[512 * (16 + r)] + sc * fs.st.o[1][r]; } }
    bf16* orow = MIX + (size_t)tq * D + 1024 + 64 * head;
#pragma unroll
    for (int dt = 0; dt < 2; ++dt)
#pragma unroll
        for (int q4 = 0; q4 < 4; ++q4) { u32x2 w; w.x = cvtpk(fs.st.o[dt][4 * q4], fs.st.o[dt][4 * q4 + 1]); w.y = cvtpk(fs.st.o[dt][4 * q4 + 2], fs.st.o[dt][4 * q4 + 3]); *(u32x2*)(orow + 32 * dt + 8 * q4 + 4 * hi) = w; }
}

__device__ __forceinline__ int dequeue(unsigned* head, volatile LAS unsigned* slot, int tid) {
    if (tid == 0) *slot = __hip_atomic_fetch_add(head, 1u, __ATOMIC_RELAXED, __HIP_MEMORY_SCOPE_AGENT);
    __syncthreads();
    const int v = __builtin_amdgcn_readfirstlane((int)*slot);
    __syncthreads();
    return v;
}

constexpr int N2_HP = 4112, N2_PART = 66 * 1024, N2_LOG = 108 * 1024;
__device__ __forceinline__ void n2_unit(int u, int l, const Args& a, const bf16* X, bf16* XN, const bf16* RWT, unsigned* cnt, int* LIST, float* TW, LAS unsigned char* lds, int tid, int wid, int lane) {
    const float* gain = a.in[14] + (size_t)l * D;
#pragma unroll
    for (int rr = 0; rr < 2; ++rr) {
        const int lr = 2 * wid + rr, row = 16 * u + lr;
        const u32x2* xr = (const u32x2*)(X + (size_t)row * D) + lane;
        f32x4 v[8]; float ss = 0.f;
#pragma unroll
        for (int j = 0; j < 8; ++j) { const u32x2 r = xr[64 * j]; v[j] = (f32x4){bflo(r.x), bfhi(r.x), bflo(r.y), bfhi(r.y)}; ss += (v[j].x * v[j].x + v[j].y * v[j].y) + (v[j].z * v[j].z + v[j].w * v[j].w); }
        ss = wave_sum(ss);
        const float rstd = 1.0f / sqrtf(ss * (1.0f / D) + RMS_EPS);
        const f32x4* gr = (const f32x4*)gain + lane; u32x2* o8 = (u32x2*)(XN + (size_t)row * D) + lane;
#pragma unroll
        for (int j = 0; j < 8; ++j) { const f32x4 g = gr[64 * j]; u32x2 w; w.x = cvtpk(v[j].x * rstd * g.x, v[j].y * rstd * g.y); w.y = cvtpk(v[j].z * rstd * g.z, v[j].w * rstd * g.w);
            o8[64 * j] = w; *(LAS u32x2*)(lds + lr * N2_HP + (4 * lane + 256 * j) * 2) = w; }
    }
    __syncthreads();
    {
        const int fr = lane & 15, fq = lane >> 4;
        f32x4 acc[5];
#pragma unroll
        for (int nt = 0; nt < 5; ++nt) acc[nt] = (f32x4){0.f, 0.f, 0.f, 0.f};
        const bf16* rw = RWT + (size_t)l * 96 * D + (size_t)fr * D + 256 * wid + 8 * fq;
#pragma unroll
        for (int s = 0; s < 8; ++s) {
            const bf16x8 av = *(const LAS bf16x8*)(lds + fr * N2_HP + (256 * wid + 32 * s + 8 * fq) * 2);
#pragma unroll
            for (int nt = 0; nt < 5; ++nt) { const bf16x8 bv = *(const bf16x8*)(rw + (size_t)(16 * nt) * D + 32 * s); acc[nt] = MFMA16(av, bv, acc[nt]); }
        }
        LAS float* part = (LAS float*)(lds + N2_PART) + wid * 16 * 80;
#pragma unroll
        for (int nt = 0; nt < 5; ++nt)
#pragma unroll
            for (int i = 0; i < 4; ++i) part[(4 * fq + i) * 80 + 16 * nt + fr] = acc[nt][i];
    }
    __syncthreads();
    {
        LAS const float* part = (LAS const float*)(lds + N2_PART); LAS float* logit = (LAS float*)(lds + N2_LOG);
        for (int e = tid; e < 16 * 80; e += NTHR) { float s = 0.f;
#pragma unroll
            for (int w = 0; w < 8; ++w) s += part[w * 16 * 80 + e];
            logit[e] = s; }
    }
    __syncthreads();
    if (tid < 16) {
        LAS const float* lg = (LAS const float*)(lds + N2_LOG) + tid * 80;
        const float* bg = a.in[16] + l * 8; const float* be = a.in[18] + l * 64;
        float z[8]; float zm = -3.0e38f; int gi = 0;
#pragma unroll
        for (int i = 0; i < 8; ++i) { z[i] = lg[i] + bg[i]; if (z[i] > zm) { zm = z[i]; gi = i; } }
        float den = 0.f;
#pragma unroll
        for (int i = 0; i < 8; ++i) den += expf(z[i] - zm);
        const float gp = 1.0f / den;
        float e1 = -3.0e38f, e2 = -3.0e38f; int i1 = 0, i2 = 0;
#pragma unroll
        for (int i = 0; i < 8; ++i) { const float v = lg[8 + 8 * gi + i] + be[8 * gi + i];
            if (v > e1) { e2 = e1; i2 = i1; e1 = v; i1 = i; } else if (v > e2) { e2 = v; i2 = i; } }
        const float t2 = expf(e2 - e1), w1 = gp / (1.0f + t2), w2 = gp * t2 / (1.0f + t2);
        const int tok = 16 * u + tid, ea = 8 * gi + i1, eb = 8 * gi + i2;
        const unsigned pa = __hip_atomic_fetch_add(cnt + ea * 16, 1u, __ATOMIC_RELAXED, __HIP_MEMORY_SCOPE_AGENT);
        const unsigned pb = __hip_atomic_fetch_add(cnt + eb * 16, 1u, __ATOMIC_RELAXED, __HIP_MEMORY_SCOPE_AGENT);
        LIST[(size_t)ea * 16384 + pa] = 2 * tok; LIST[(size_t)eb * 16384 + pb] = 2 * tok + 1;
        TW[2 * tok] = w1; TW[2 * tok + 1] = w2;
    }
    __syncthreads();
}

constexpr int N2P_HALF = 16 * N2_HP, N2P_LOG = 2 * N2P_HALF;
__device__ __forceinline__ void n2_pair(int p, int l, const Args& a, const bf16* X, bf16* XN, const bf16* RWT, unsigned* cnt, int* LIST, float* TW, LAS unsigned char* lds, int tid, int wid, int lane) {
    const int half = wid >> 2, wl = wid & 3, u = 2 * p + half, th = tid & 255;
    LAS unsigned char* const hT = lds + half * N2P_HALF;
    const float* gain = a.in[14] + (size_t)l * D;
    {
        u32x2 raw[4][8];
#pragma unroll
        for (int rr = 0; rr < 4; ++rr) { const u32x2* xr = (const u32x2*)(X + (size_t)(16 * u + 4 * wl + rr) * D) + lane;
#pragma unroll
            for (int j = 0; j < 8; ++j) raw[rr][j] = xr[64 * j]; }
        f32x4 g[8]; { const f32x4* gr = (const f32x4*)gain + lane;
#pragma unroll
            for (int j = 0; j < 8; ++j) g[j] = gr[64 * j]; }
#pragma unroll
        for (int rr = 0; rr < 4; ++rr) {
            const int lr = 4 * wl + rr, row = 16 * u + lr;
            f32x4 v[8]; float ss = 0.f;
#pragma unroll
            for (int j = 0; j < 8; ++j) { const u32x2 r = raw[rr][j]; v[j] = (f32x4){bflo(r.x), bfhi(r.x), bflo(r.y), bfhi(r.y)}; ss += (v[j].x * v[j].x + v[j].y * v[j].y) + (v[j].z * v[j].z + v[j].w * v[j].w); }
            ss = wave_sum(ss);
            const float rstd = 1.0f / sqrtf(ss * (1.0f / D) + RMS_EPS);
            u32x2* o8 = (u32x2*)(XN + (size_t)row * D) + lane;
#pragma unroll
            for (int j = 0; j < 8; ++j) { u32x2 w; w.x = cvtpk(v[j].x * rstd * g[j].x, v[j].y * rstd * g[j].y); w.y = cvtpk(v[j].z * rstd * g[j].z, v[j].w * rstd * g[j].w);
                o8[64 * j] = w; *(LAS u32x2*)(hT + lr * N2_HP + (4 * lane + 256 * j) * 2) = w; }
        }
    }
    __syncthreads();
    const int fr = lane & 15, fq = lane >> 4;
    f32x4 acc[2][5];
#pragma unroll
    for (int hh = 0; hh < 2; ++hh)
#pragma unroll
        for (int nt = 0; nt < 5; ++nt) acc[hh][nt] = (f32x4){0.f, 0.f, 0.f, 0.f};
    {
        const bf16* rw = RWT + (size_t)l * 96 * D + (size_t)fr * D + 256 * wid + 8 * fq;
#pragma unroll 4
        for (int s = 0; s < 8; ++s) {
            const bf16x8 av0 = *(const LAS bf16x8*)(lds + fr * N2_HP + (256 * wid + 32 * s + 8 * fq) * 2);
            const bf16x8 av1 = *(const LAS bf16x8*)(lds + N2P_HALF + fr * N2_HP + (256 * wid + 32 * s + 8 * fq) * 2);
#pragma unroll
            for (int nt = 0; nt < 5; ++nt) { const bf16x8 bv = *(const bf16x8*)(rw + (size_t)(16 * nt) * D + 32 * s); acc[0][nt] = MFMA16(av0, bv, acc[0][nt]); acc[1][nt] = MFMA16(av1, bv, acc[1][nt]); }
        }
    }
    __syncthreads();
    {
        LAS float* part = (LAS float*)lds + wid * 32 * 80;
#pragma unroll
        for (int hh = 0; hh < 2; ++hh)
#pragma unroll
            for (int nt = 0; nt < 5; ++nt)
#pragma unroll
                for (int i = 0; i < 4; ++i) part[(16 * hh + 4 * fq + i) * 80 + 16 * nt + fr] = acc[hh][nt][i];
    }
    __syncthreads();
    {
        LAS const float* part = (LAS const float*)lds; LAS float* logit = (LAS float*)(lds + N2P_LOG);
        for (int e = tid; e < 32 * 80; e += NTHR) { float sres = 0.f;
#pragma unroll
            for (int w = 0; w < 8; ++w) sres += part[w * 32 * 80 + e];
            logit[e] = sres; }
    }
    __syncthreads();
    if (th < 16) {
        LAS const float* lg = (LAS const float*)(lds + N2P_LOG) + (16 * half + th) * 80;
        const float* bg = a.in[16] + l * 8; const float* be = a.in[18] + l * 64;
        float z[8]; float zm = -3.0e38f; int gi = 0;
#pragma unroll
        for (int i = 0; i < 8; ++i) { z[i] = lg[i] + bg[i]; if (z[i] > zm) { zm = z[i]; gi = i; } }
        float den = 0.f;
#pragma unroll
        for (int i = 0; i < 8; ++i) den += expf(z[i] - zm);
        const float gp = 1.0f / den;
        float e1 = -3.0e38f, e2 = -3.0e38f; int i1 = 0, i2 = 0;
#pragma unroll
        for (int i = 0; i < 8; ++i) { const float v = lg[8 + 8 * gi + i] + be[8 * gi + i];
            if (v > e1) { e2 = e1; i2 = i1; e1 = v; i1 = i; } else if (v > e2) { e2 = v; i2 = i; } }
        const float t2 = expf(e2 - e1), w1 = gp / (1.0f + t2), w2 = gp * t2 / (1.0f + t2);
        const int tok = 16 * u + th, ea = 8 * gi + i1, eb = 8 * gi + i2;
        const unsigned pa = __hip_atomic_fetch_add(cnt + ea * 16, 1u, __ATOMIC_RELAXED, __HIP_MEMORY_SCOPE_AGENT);
        const unsigned pb = __hip_atomic_fetch_add(cnt + eb * 16, 1u, __ATOMIC_RELAXED, __HIP_MEMORY_SCOPE_AGENT);
        LIST[(size_t)ea * 16384 + pa] = 2 * tok; LIST[(size_t)eb * 16384 + pb] = 2 * tok + 1;
        TW[2 * tok] = w1; TW[2 * tok + 1] = w2;
    }
    __syncthreads();
}

constexpr int MO_B = 65536, MO_BBUF = 16384, MO_A = 98304, MO_APITCH = 2176, MO_ABUF = 4 * MO_APITCH, MO_ROW = MO_A + 2 * MO_ABUF, MO_PRE = MO_ROW + 512;
constexpr int MO_STG = 117760;
static_assert(MO_PRE + 272 <= MO_STG && MO_STG + 8 * 4096 <= MISC_OFF, "MoE LDS map");
__device__ __forceinline__ int mo_aoff(int row, int c) { return c * MO_APITCH + ((row + 2 * c) << 4); }
__device__ __forceinline__ int mo_hoff(int row, int c) { return c * 2048 + (row << 4); }

struct MoBStage { f32x4 v[4]; };
__device__ __forceinline__ void mo_gl16(f32x4& d, const float* p) { asm volatile("global_load_dwordx4 %0, %1, off" : "=v"(d) : "v"(p) : "memory"); }
__device__ __forceinline__ void mo_gl16u(u32x4& d, const bf16* p) { asm volatile("global_load_dwordx4 %0, %1, off" : "=v"(d) : "v"(p) : "memory"); }
__device__ __forceinline__ void mo_bload(MoBStage& sg, const float* src0, const float* src1, size_t ld, int k0, int tid) {
    const int n4 = tid & 63, kg = tid >> 6;
    const float* p = (n4 < 32 ? src0 + 4 * n4 : src1 + 4 * (n4 - 32)) + (size_t)(k0 + 4 * kg) * ld;
    mo_gl16(sg.v[0], p); mo_gl16(sg.v[1], p + ld); mo_gl16(sg.v[2], p + 2 * ld); mo_gl16(sg.v[3], p + 3 * ld);
}
#define MO_WAIT5(N, SB, SA) asm volatile("s_waitcnt vmcnt(" #N ")" : "+v"(SB.v[0]), "+v"(SB.v[1]), "+v"(SB.v[2]), "+v"(SB.v[3]), "+v"(SA) :: "memory")
#define MO_WAIT4(N, SB) asm volatile("s_waitcnt vmcnt(" #N ")" : "+v"(SB.v[0]), "+v"(SB.v[1]), "+v"(SB.v[2]), "+v"(SB.v[3]) :: "memory")
__device__ __forceinline__ void mo_bwrite(const MoBStage& sg, LAS unsigned char* bb, int tid) {
    const int n4 = tid & 63, kg = tid >> 6;
#pragma unroll
    for (int i = 0; i < 4; ++i) { u32x2 w; w.x = cvtpk(sg.v[0][i], sg.v[1][i]); w.y = cvtpk(sg.v[2][i], sg.v[3][i]);
        *(LAS u32x2*)(bb + (kg >> 1) * 4096 + (32 * (n4 >> 3) + 8 * i + (n4 & 7)) * 16 + 8 * (kg & 1)) = w; }
}
#define MO_READ(AP, ASTEP, BP, B1OFF) bf16x8 fb0_[2], fb1_[2], fa_[2][2]; \
    _Pragma("unroll") for (int s_ = 0; s_ < 2; ++s_) { fb0_[s_] = *(const LAS bf16x8*)((BP) + s_ * 8192); fb1_[s_] = *(const LAS bf16x8*)((BP) + s_ * 8192 + (B1OFF)); \
        _Pragma("unroll") for (int mt = 0; mt < 2; ++mt) fa_[s_][mt] = *(const LAS bf16x8*)((AP) + s_ * (ASTEP) + mt * 512); } \
    __builtin_amdgcn_sched_barrier(0)
#define MO_MMA(ACC0, ACC1) do { __builtin_amdgcn_sched_barrier(0); _Pragma("unroll") for (int s_ = 0; s_ < 2; ++s_) _Pragma("unroll") for (int mt = 0; mt < 2; ++mt) { \
        ACC0[mt] = MFMA32(fa_[s_][mt], fb0_[s_], ACC0[mt]); ACC1[mt] = MFMA32(fa_[s_][mt], fb1_[s_], ACC1[mt]); } __builtin_amdgcn_sched_barrier(0); } while (0)

__device__ __forceinline__ void moe_unit(int e, int c0, int nrows, const bf16* XN, const int* LIST, const float* Wg, const float* Wu, const float* Wd, bf16* YB, LAS unsigned char* lds, int tid, int wid, int lane) {
    const int r32 = lane & 31, hi = lane >> 5, wn = wid & 3, wm = wid >> 2;
    LAS int* rowid = (LAS int*)(lds + MO_ROW);
    if (tid < 128) rowid[tid] = (tid < nrows) ? LIST[(size_t)e * 16384 + c0 + tid] : -1;
    __syncthreads();
    const float* wg = Wg + (size_t)e * D * 256; const float* wu = Wu + (size_t)e * D * 256; const float* wd = Wd + (size_t)e * 256 * D;
    f32x16 acc0[2], acc1[2];
#define MO_ZERO() do { acc0[0] = (f32x16){}; acc0[1] = (f32x16){}; acc1[0] = (f32x16){}; acc1[1] = (f32x16){}; } while (0)
    MO_ZERO();
    MoBStage s0, s1, s2, s3; u32x4 a0, a1, a2, a3;
    {
        const int arow = tid >> 2, ac = tid & 3; const int rid = rowid[arow]; const bf16* asrc = XN + (size_t)((rid < 0 ? 0 : rid) >> 1) * D + 8 * ac;
        LAS unsigned char* const awr = lds + MO_A + mo_aoff(arow, ac);
        LAS const unsigned char* const ard = lds + MO_A + mo_aoff(64 * wm + r32, hi);
        LAS const unsigned char* const brd = lds + MO_B + hi * 4096 + (32 * wn + r32) * 16;
#define G1_LOAD(SB, SA, t) do { const int t_ = (t); mo_gl16u(SA, asrc + 32 * (t_ & 63)); mo_bload(SB, wg + 128 * (t_ >> 6), wu + 128 * (t_ >> 6), 256, 32 * (t_ & 63), tid); } while (0)
#define G1_WRITE(SB, SA, b) do { *(LAS u32x4*)(awr + (b) * MO_ABUF) = SA; mo_bwrite(SB, lds + MO_B + (b) * MO_BBUF, tid); } while (0)
#define G1_STEP(t, b, SBL, SAL, SBW, SAW) do { const int tt_ = (t); \
            MO_READ(ard + (b) * MO_ABUF, 2 * MO_APITCH + 64, brd + (b) * MO_BBUF, 2048);     \
            G1_LOAD(SBL, SAL, (tt_ + 4 < 128 ? tt_ + 4 : 127));     \
            __builtin_amdgcn_sched_barrier(0); \
            MO_WAIT5(15, SBW, SAW); \
            if (tt_ + 1 < 128) G1_WRITE(SBW, SAW, (b) ^ 1); \
            MO_MMA(acc0, acc1); \
            if ((tt_ & 63) == 63) {     \
                const int col_ = 128 * (tt_ >> 6) + 32 * wn + 4 * (r32 & 7) + (r32 >> 3), cch_ = col_ >> 3; \
                _Pragma("unroll") for (int mt = 0; mt < 2; ++mt) _Pragma("unroll") for (int r = 0; r < 16; ++r) { const float gt = acc0[mt][r], up = acc1[mt][r]; const float hv = gt / (1.0f + __expf(-gt)) * up; \
                    *(LAS unsigned short*)(lds + mo_hoff(64 * wm + 32 * mt + crow(r, hi), cch_) + (col_ & 7) * 2) = f2bf16(hv); } \
                MO_ZERO(); } \
            __syncthreads(); } while (0)
        G1_LOAD(s0, a0, 0); G1_LOAD(s1, a1, 1); G1_LOAD(s2, a2, 2); G1_LOAD(s3, a3, 3);
        MO_WAIT5(15, s0, a0);
        G1_WRITE(s0, a0, 0);
        __syncthreads();
        for (int t = 0; t < 128; t += 4) {
            G1_STEP(t, 0, s0, a0, s1, a1);
            G1_STEP(t + 1, 1, s1, a1, s2, a2);
            G1_STEP(t + 2, 0, s2, a2, s3, a3);
            G1_STEP(t + 3, 1, s3, a3, s0, a0);
        }
        asm volatile("s_waitcnt vmcnt(0)" : "+v"(s0.v[0]), "+v"(s0.v[1]), "+v"(s0.v[2]), "+v"(s0.v[3]), "+v"(s1.v[0]), "+v"(s1.v[1]), "+v"(s1.v[2]), "+v"(s1.v[3]), "+v"(s2.v[0]), "+v"(s2.v[1]), "+v"(s2.v[2]), "+v"(s2.v[3]),
                     "+v"(s3.v[0]), "+v"(s3.v[1]), "+v"(s3.v[2]), "+v"(s3.v[3]), "+v"(a0), "+v"(a1), "+v"(a2), "+v"(a3) :: "memory");
#undef G1_LOAD
#undef G1_WRITE
#undef G1_STEP
    }
    {
        LAS const unsigned char* const hrd = lds + mo_hoff(64 * wm + r32, hi);
        LAS const unsigned char* const brd = lds + MO_B + hi * 4096 + (64 * wn + r32) * 16;
#define G2_LOAD(SB, t) do { const int t_ = (t); mo_bload(SB, wd + 256 * (t_ >> 3), wd + 256 * (t_ >> 3) + 128, D, 32 * (t_ & 7), tid); } while (0)
#define G2_STEP(t, b, SBL, SBW) do { const int tt_ = (t); \
            MO_READ(hrd + (tt_ & 7) * 8192, 4096, brd + (b) * MO_BBUF, 512); \
            G2_LOAD(SBL, (tt_ + 4 < 64 ? tt_ + 4 : 63)); \
            __builtin_amdgcn_sched_barrier(0); \
            MO_WAIT4(12, SBW); \
            if (tt_ + 1 < 64) mo_bwrite(SBW, lds + MO_B + ((b) ^ 1) * MO_BBUF, tid); \
            MO_MMA(acc0, acc1); \
            if ((tt_ & 7) == 7) {     \
                LAS unsigned char* const stg_ = lds + MO_STG + wid * 4096; const int cidx_ = 4 * (r32 & 7) + (r32 >> 3); \
                _Pragma("unroll") for (int mt = 0; mt < 2; ++mt) { \
                    _Pragma("unroll") for (int r = 0; r < 16; ++r) { const int row_ = crow(r, hi); \
                        *(LAS unsigned short*)(stg_ + row_ * 128 + cidx_ * 2) = f2bf16(acc0[mt][r]); *(LAS unsigned short*)(stg_ + row_ * 128 + (cidx_ + 32) * 2) = f2bf16(acc1[mt][r]); } \
                    _Pragma("unroll") for (int k = 0; k < 4; ++k) { const int idx_ = lane + 64 * k, row_ = idx_ >> 3, ch_ = idx_ & 7; \
                        const u32x4 v_ = *(const LAS u32x4*)(stg_ + row_ * 128 + ch_ * 16); const int rr = rowid[64 * wm + 32 * mt + row_]; \
                        if (rr >= 0) *(u32x4*)(YB + (size_t)rr * D + 256 * (tt_ >> 3) + 64 * wn + 8 * ch_) = v_; } } \
                MO_ZERO(); } \
            __syncthreads(); } while (0)
        G2_LOAD(s0, 0); G2_LOAD(s1, 1); G2_LOAD(s2, 2); G2_LOAD(s3, 3);
        MO_WAIT4(12, s0);
        mo_bwrite(s0, lds + MO_B, tid);
        __syncthreads();
        for (int t = 0; t < 64; t += 4) {
            G2_STEP(t, 0, s0, s1);
            G2_STEP(t + 1, 1, s1, s2);
            G2_STEP(t + 2, 0, s2, s3);
            G2_STEP(t + 3, 1, s3, s0);
        }
        asm volatile("s_waitcnt vmcnt(0)" : "+v"(s0.v[0]), "+v"(s0.v[1]), "+v"(s0.v[2]), "+v"(s0.v[3]), "+v"(s1.v[0]), "+v"(s1.v[1]), "+v"(s1.v[2]), "+v"(s1.v[3]), "+v"(s2.v[0]), "+v"(s2.v[1]), "+v"(s2.v[2]), "+v"(s2.v[3]),
                     "+v"(s3.v[0]), "+v"(s3.v[1]), "+v"(s3.v[2]), "+v"(s3.v[3]) :: "memory");
#undef G2_LOAD
#undef G2_STEP
    }
#undef MO_ZERO
}

constexpr int N_PHASES = 1 + 7 * DEPTH;
#ifndef PH_MASK
#define PH_MASK 0xFFFF
#endif
#define PHON(k) (((PH_MASK) >> (k)) & 1)
#ifndef DUP_MASK
#define DUP_MASK 0
#endif
#define DUPON(k) ((((DUP_MASK) >> (k)) & 1) && (l == 0 || (((0x3FE) >> (k)) & 1)))
#ifndef MK_ONE_LAUNCH
#define MK_ONE_LAUNCH 1
#endif

__global__ void __launch_bounds__(NTHR, 2) fwd_kernel(Args args) {
    extern __shared__ __attribute__((aligned(16))) unsigned char lds_raw[];
    LAS unsigned char* lds = (LAS unsigned char*)lds_raw;
    volatile LAS unsigned* MISC = (volatile LAS unsigned*)(lds + MISC_OFF);
    const int wid = __builtin_amdgcn_readfirstlane(threadIdx.x >> 6);
    const int G = gridDim.x, bid = blockIdx.x;
    unsigned char* ws = args.ws;
    unsigned* const ctl0 = (unsigned*)(ws + WS_CTL);
    if (threadIdx.x < 64) MISC[threadIdx.x] = 0u;
    __syncthreads();
    const int lo = args.ph_lo, hi_ph = args.ph_hi;
    XcdBarrier bar; bar.bar = ctl0 + CW_BAR; bar.x = 0; bar.st = MISC + 8; bar.w0 = 0;
    if (hi_ph - lo > 1) bar = xcd_barrier_post(ctl0 + CW_BAR, MISC + 8);
#define IN(k) (lo <= (k) && (k) < hi_ph)
#define FRESH() int wid_ = wid; asm volatile("" : "+s"(wid_)); int lane_; asm volatile("v_mbcnt_lo_u32_b32 %0, -1, 0\n\tv_mbcnt_hi_u32_b32 %0, -1, %0" : "=v"(lane_)); const int tid_ = wid_ * 64 + lane_; (void)tid_
#define SEAM(k) do { if (IN(k) && IN((k) + 1)) xcd_barrier(bar); } while (0)

    const int NGW = G * NWAVES;

    if (PHON(0) && IN(0)) { FRESH(); p0_prologue(args, lds, bid, G, tid_, wid_, lane_); if ((DUP_MASK) & 1) p0_prologue(args, lds, bid, G, tid_, wid_, lane_); }
    SEAM(0);

#pragma unroll 1
    for (int lraw = 0; lraw < DEPTH; ++lraw) {
        int l = lraw; asm volatile("" : "+s"(l));
        GAS unsigned char* wsg = (GAS unsigned char*)ws; asm volatile("" : "+s"(wsg)); unsigned char* const wsl = (unsigned char*)wsg;
        unsigned* const ctl = (unsigned*)(wsl + WS_CTL);
        bf16* const WIN = (bf16*)(wsl + WS_WIN); bf16* const WOUT = (bf16*)(wsl + WS_WOUT); bf16* const W1T = (bf16*)(wsl + WS_W1T); bf16* const W2T = (bf16*)(wsl + WS_W2T); bf16* const RWT = (bf16*)(wsl + WS_RWT);
        float* const C1 = (float*)(wsl + WS_C1); bf16* const X = (bf16*)(wsl + WS_X); bf16* const XN = (bf16*)(wsl + WS_XN); bf16* const PROJ = (bf16*)(wsl + WS_PROJ); float* const AUX = (float*)(wsl + WS_AUX);
        float* const CUM = (float*)(wsl + WS_CUM); bf16* const KC = (bf16*)(wsl + WS_KC); bf16* const VC = (bf16*)(wsl + WS_VC); bf16* const MIX = (bf16*)(wsl + WS_MIX); bf16* const YB = (bf16*)(wsl + WS_YB);
        int* const LIST = (int*)(wsl + WS_LIST); float* const TW = (float*)(wsl + WS_TW);
        const int pb = 1 + 7 * l;
        if (PHON(1) && IN(pb)) {
            pg8::Gemm g{l == 0 ? XN : X, WIN + (size_t)l * NP * D, S, NP, D}; pg8::StaticOrder so; so.init(S, NP, G, bid);
            pg8::EpiProj E{PROJ, AUX, (const float*)(wsl + WS_RSTD)};
            pg8::gemm_phase<pg8::EpiProj, pg8::StaticOrder, true, true>(lds, g, so, E, wid);
            {
                const int ntile = (S / 256) * (NP / 256), rmax = (ntile + G - 1) / G, mine = (ntile - bid + G - 1) / G, nh = G * rmax - ntile;
                if (nh == 0 || mine < rmax) {
                    FRESH(); __syncthreads();
                    LAS float* const scr = (LAS float*)(lds + wid_ * 9216);
                    const int hidx = nh == 0 ? bid : bid - (G - nh), nhw = (nh == 0 ? G : nh) * NWAVES;
                    for (int j = hidx * NWAVES + wid_; j < I_L - I_WIN; j += nhw) tr_dispatch(args, (unsigned char*)wsl, l * I_L + I_WIN + j, scr, lane_);
                }
            }
            if (DUPON(1)) pg8::gemm_phase<pg8::EpiProj, pg8::StaticOrder, true, true>(lds, g, so, E, wid);
        }
        SEAM(pb);
        if (IN(pb + 2)) {
            const int x = bid & 7;
#define QHEAD(q) (ctl + CW_Q + (((l * 6 + (q)) * 8 + x) * 64))
            if (PHON(2)) { FRESH(); unsigned* const pdone = ctl + CW_PD + l * 64;
                for (;;) { const int i = dequeue(ctl + CW_PQ + l * 64, MISC + 19, tid_); if (i >= 136) break;
                    if (i < 8) cumsum_unit(i, l, AUX, args.in[5], CUM, lds, tid_); else compress_unit(i - 8, l, PROJ, W1T, W2T, C1, KC, VC, lds, wid_, lane_);
                    asm volatile("s_waitcnt vmcnt(0)" ::: "memory");
                    __syncthreads();
                    if (wid_ == 0) { __builtin_amdgcn_fence(__ATOMIC_RELEASE, "agent"); asm volatile("s_waitcnt vmcnt(0)" ::: "memory"); (void)__hip_atomic_fetch_add(pdone, 1u, __ATOMIC_RELAXED, __HIP_MEMORY_SCOPE_AGENT); }
                } }
            if (PHON(4)) { FRESH(); for (;;) { const int i = dequeue(QHEAD(1), MISC + 17, tid_); if (i >= 32) break; diff_unit(x & 3, 63 - 2 * i - (x >> 2), l, args, PROJ, MIX, lds, tid_, wid_, lane_); }
                if (DUPON(4)) for (;;) { const int i = dequeue(QHEAD(4), MISC + 17, tid_); if (i >= 32) break; diff_unit(x & 3, 63 - 2 * i - (x >> 2), l, args, PROJ, MIX, lds, tid_, wid_, lane_); } }
            if (PHON(2)) { FRESH();
                if (tid_ == 0) { unsigned* const pdone = ctl + CW_PD + l * 64; unsigned sp = 0;
                    while (__hip_atomic_load(pdone, __ATOMIC_RELAXED, __HIP_MEMORY_SCOPE_AGENT) < 136u * 64u) { __builtin_amdgcn_s_sleep(2); if (++sp > (1u << 20)) break; }
                    __builtin_amdgcn_fence(__ATOMIC_ACQUIRE, "agent"); asm volatile("s_waitcnt vmcnt(0)" ::: "memory"); }
                __syncthreads(); }
            if (PHON(3)) { FRESH(); for (;;) { const int i = dequeue(QHEAD(0), MISC + 16, tid_); if (i >= 32) break; fox_unit(x, 31 - i, PROJ, CUM, MIX, lds, tid_, wid_, lane_); }
                if (DUPON(3)) for (;;) { const int i = dequeue(QHEAD(3), MISC + 16, tid_); if (i >= 32) break; fox_unit(x, 31 - i, PROJ, CUM, MIX, lds, tid_, wid_, lane_); } }
            if (PHON(5)) { FRESH(); for (;;) { const int i = dequeue(QHEAD(2), MISC + 18, tid_); if (i >= 64) break; nsa_unit(x & 3, 127 - 2 * i - (x >> 2), args, PROJ, AUX, KC, VC, MIX, lds, tid_, wid_, lane_); }
                if (DUPON(5)) for (;;) { const int i = dequeue(QHEAD(5), MISC + 18, tid_); if (i >= 64) break; nsa_unit(x & 3, 127 - 2 * i - (x >> 2), args, PROJ, AUX, KC, VC, MIX, lds, tid_, wid_, lane_); } }
#undef QHEAD
        }
        SEAM(pb + 2);
        if (PHON(6) && IN(pb + 3)) {
            pg8::Gemm g{MIX, WOUT + (size_t)l * D * D, S, D, D}; pg8::StaticOrder so; so.init(S, D, G, bid);
            pg8::EpiRes E{nullptr, l == 0 ? XN : X, X};
            pg8::gemm_phase<pg8::EpiRes, pg8::StaticOrder, true, true>(lds, g, so, E, wid);
            if (DUPON(6)) { pg8::EpiRes E2{nullptr, X, YB}; pg8::gemm_phase<pg8::EpiRes, pg8::StaticOrder, true, true>(lds, g, so, E2, wid); }
        }
        SEAM(pb + 3);
        if (PHON(7) && IN(pb + 4)) {
            FRESH();
            for (int p = bid; p < S / 32; p += G) n2_pair(p, l, args, X, XN, RWT, ctl + CW_CNT + l * 1024, LIST, TW, lds, tid_, wid_, lane_);
            if (DUPON(7)) for (int u = bid; u < S / 16; u += G) n2_unit(u, l, args, X, XN, RWT, ctl + CW_CNT + (4 + l) * 1024, (int*)MIX, (float*)(MIX + 8 * 1024 * 1024), lds, tid_, wid_, lane_);
        }
        SEAM(pb + 4);
        if (PHON(8) && IN(pb + 5)) {
            FRESH();
            LAS int* pre = (LAS int*)(lds + MO_PRE);
            if (tid_ < 64) pre[tid_] = ((int)__hip_atomic_load(ctl + CW_CNT + l * 1024 + tid_ * 16, __ATOMIC_RELAXED, __HIP_MEMORY_SCOPE_AGENT) + 127) >> 7;
            __syncthreads();
            const int x = bid & 7, per = G >> 3;
            for (int rep = 0; rep < (DUPON(8) ? 2 : 1); ++rep)
            for (int slot = bid >> 3; ; slot += per) {
                int e = -1, c = 0, acc = 0;
                for (int k = 0; k < 8; ++k) { const int ee = x + 8 * k, n = pre[ee]; if (e < 0 && slot < acc + n) { e = ee; c = slot - acc; } acc += n; }
                if (e < 0) break;
                e = __builtin_amdgcn_readfirstlane(e); c = __builtin_amdgcn_readfirstlane(c);
                const int c0 = c * 128; const int cnt_e = (int)__hip_atomic_load(ctl + CW_CNT + l * 1024 + e * 16, __ATOMIC_RELAXED, __HIP_MEMORY_SCOPE_AGENT);
                const int nrows = (cnt_e - c0) < 128 ? (cnt_e - c0) : 128;
                moe_unit(e, c0, nrows, XN, LIST, args.in[19] + (size_t)l * 64 * D * 256, args.in[20] + (size_t)l * 64 * D * 256, args.in[21] + (size_t)l * 64 * 256 * D, YB, lds, tid_, wid_, lane_);
            }
        }
        SEAM(pb + 5);
        if (PHON(9) && IN(pb + 6)) {
            FRESH(); const int gw_ = bid * NWAVES + wid_;
            if (l + 1 < DEPTH) {
                norm_rows<1>(nullptr, X, X, XN, YB, TW, args.in[1] + (size_t)(l + 1) * D, nullptr, (float*)(wsl + WS_RSTD), gw_, NGW, lane_);
                if (DUPON(9)) norm_rows<1>(nullptr, X, PROJ, MIX, YB, TW, args.in[1] + (size_t)(l + 1) * D, nullptr, (float*)MIX, gw_, NGW, lane_);
            } else norm_rows<2>(nullptr, X, nullptr, nullptr, YB, TW, args.in[22], args.out, nullptr, gw_, NGW, lane_);
        }
        if (l + 1 < DEPTH) SEAM(pb + 6);
    }
#undef IN
#undef SEAM
}

extern "C" void kernel_launch(void* const* d_in, const int* in_sizes, int n_in, void* d_out, int out_size, void* d_ws, size_t ws_size, hipStream_t stream) {
    static int grid = 0;
    if (grid == 0) {
        if (n_in != 23 || ws_size < WS_END || out_size != S * D) { fprintf(stderr, "kernel_launch: unexpected problem (n_in %d, out %d, ws %zu)\n", n_in, out_size, ws_size); grid = -1; return; }
        int dev = 0, cus = 0, per_cu = 0;
        if (hipGetDevice(&dev) != hipSuccess || hipDeviceGetAttribute(&cus, hipDeviceAttributeMultiprocessorCount, dev) != hipSuccess) { grid = -1; return; }
        if (hipFuncSetAttribute((const void*)fwd_kernel, hipFuncAttributeMaxDynamicSharedMemorySize, LDS_BYTES) != hipSuccess) { fprintf(stderr, "kernel_launch: hipFuncSetAttribute failed\n"); grid = -1; return; }
        if (hipOccupancyMaxActiveBlocksPerMultiprocessor(&per_cu, (const void*)fwd_kernel, NTHR, LDS_BYTES) != hipSuccess || per_cu < 1) fprintf(stderr, "kernel_launch: occupancy query says %d blocks per CU\n", per_cu);
        (void)hipGetLastError();
        grid = cus;
        if (grid < 136) { fprintf(stderr, "kernel_launch: too few CUs (%d)\n", grid); }
    }
    if (grid < 0) return;
    if (hipMemsetAsync((char*)d_ws + WS_CTL, 0, CTL_ZERO_BYTES, stream) != hipSuccess) { fprintf(stderr, "kernel_launch: memset failed\n"); return; }
    Args a{};
    for (int i = 0; i < 23; ++i) a.in[i] = (const float*)d_in[i];
    a.out = (float*)d_out; a.ws = (unsigned char*)d_ws;
#if MK_ONE_LAUNCH
    a.ph_lo = 0; a.ph_hi = N_PHASES;
    hipLaunchKernelGGL(fwd_kernel, dim3(grid), dim3(NTHR), LDS_BYTES, stream, a);
#else
    for (int p = 0; p < N_PHASES; ++p) { a.ph_lo = p; a.ph_hi = p + 1; hipLaunchKernelGGL(fwd_kernel, dim3(grid), dim3(NTHR), LDS_BYTES, stream, a); }
#endif
    const hipError_t le = hipPeekAtLastError();
    if (le != hipSuccess) fprintf(stderr, "kernel_launch: launch failed: %s\n", hipGetErrorName(le));
}
```

```cpp
#include <hip/hip_runtime.h>
#include <cstdio>
#include <cstdint>
#include <cmath>
namespace pg8 {
#define PG8_LAS __attribute__((address_space(3)))
typedef unsigned short bf16_t;
typedef short bf16x8 __attribute__((ext_vector_type(8)));
typedef float f32x4 __attribute__((ext_vector_type(4)));
typedef unsigned u32x4 __attribute__((ext_vector_type(4)));
constexpr int BM = 256, BK = 64, HALF = 128, HTB = HALF * BK * 2  , STAGE_BYTES = 8 * HTB, NXCD = 8, WGM = 8;

__host__ __device__ __forceinline__ int lds_byte(int r, int c) { const int st = (r >> 4) * 2 + (c >> 5), rr = r & 15, cc = c & 31, ob = rr * 64 + cc * 2; return st * 1024 + (ob ^ (((ob >> 9) & 1) << 5)); }
__host__ __device__ __forceinline__ void stage_rc(int b, int& R, int& C) { const int st = b / 1024, sb = b % 1024, swz = sb ^ (((sb >> 9) & 1) << 5); R = (st >> 1) * 16 + swz / 64; C = (st & 1) * 32 + (swz % 64) / 2; }
__host__ __device__ __forceinline__ int perm32(int rho) { const int n = rho >> 4, i = rho & 15; return 8 * (i >> 2) + 4 * n + (i & 3); }

struct Unit { int pm, pn; };
struct Gemm { const bf16_t* A; const bf16_t* Bt; int M, N, K; };

struct StaticOrder {
    int nM, nN, nwg, G, c;
    __host__ __device__ void init(int M, int N, int G_, int c_) { nM = M / BM; nN = N / BM; nwg = nM * nN; G = G_; c = c_; }
    __host__ __device__ bool next(int i, Unit& u) const {
        const long L = (long)i * G + c; if (L >= nwg) return false;
        int wgid = (int)L; { const int q = nwg / NXCD, r = nwg % NXCD, xcd = wgid % NXCD, off = wgid / NXCD; wgid = (xcd < r ? xcd * (q + 1) : r * (q + 1) + (xcd - r) * q) + off; }
        const int nig = WGM * nN, gid = wgid / nig, fm = gid * WGM, gsz = (nM - fm) < WGM ? (nM - fm) : WGM;
        u.pm = fm + ((wgid % nig) % gsz); u.pn = (wgid % nig) / gsz; return true;
    }
    __device__ __forceinline__ void a_ready(const Unit&) const {}
    __device__ __forceinline__ void done(const Unit&) const {}
};
__device__ __forceinline__ unsigned cvt_pk_bf16(float lo, float hi) { unsigned r; asm volatile("v_cvt_pk_bf16_f32 %0, %1, %2" : "=v"(r) : "v"(lo), "v"(hi)); return r; }
struct EpiProj {
    static constexpr bool PERM = true, AFTER_DRAIN = false;
    bf16_t* O; float* aux; const float* rstd;
    __device__ __forceinline__ void operator()(const f32x4 (&acc)[2][2][4][2], const Unit& u, int wr, int wc, int fr, int fq) const {
        const int row0 = u.pm * BM + wr * 64 + fr;
        if (u.pn < 22) {
            const int col0 = u.pn * BM + wc * 32 + 8 * fq;
#pragma unroll
            for (int ai = 0; ai < 2; ++ai)
#pragma unroll
                for (int m = 0; m < 4; ++m) { bf16_t* rowp = O + (size_t)(row0 + ai * HALF + m * 16) * 5632 + col0; const float rs = rstd[row0 + ai * HALF + m * 16];
#pragma unroll
                    for (int bj = 0; bj < 2; ++bj) { const f32x4 v0 = acc[ai][bj][m][0] * rs, v1 = acc[ai][bj][m][1] * rs;
                        u32x4 w; w.x = cvt_pk_bf16(v0[0], v0[1]); w.y = cvt_pk_bf16(v0[2], v0[3]); w.z = cvt_pk_bf16(v1[0], v1[1]); w.w = cvt_pk_bf16(v1[2], v1[3]);
                        *(u32x4*)(rowp + bj * HALF) = w; } }
        } else if (wc < 2) {
            const int col0 = wc * 32 + 8 * fq;
#pragma unroll
            for (int ai = 0; ai < 2; ++ai)
#pragma unroll
                for (int m = 0; m < 4; ++m) { float* rowp = aux + (size_t)(row0 + ai * HALF + m * 16) * 64 + col0; const float rs = rstd[row0 + ai * HALF + m * 16];
                    *(f32x4*)(rowp) = acc[ai][0][m][0] * rs; *(f32x4*)(rowp + 4) = acc[ai][0][m][1] * rs; }
        }
    }
};
struct EpiRes {
    static constexpr bool PERM = true, AFTER_DRAIN = false;
    const float* basef; const bf16_t* baseb; bf16_t* out;
    __device__ __forceinline__ void operator()(const f32x4 (&acc)[2][2][4][2], const Unit& u, int wr, int wc, int fr, int fq) const {
        const int row0 = u.pm * BM + wr * 64 + fr, col0 = u.pn * BM + wc * 32 + 8 * fq;
#pragma unroll
        for (int ai = 0; ai < 2; ++ai)
#pragma unroll
            for (int m = 0; m < 4; ++m) { const size_t off = (size_t)(row0 + ai * HALF + m * 16) * 2048 + col0;
#pragma unroll
                for (int bj = 0; bj < 2; ++bj) { f32x4 v0 = acc[ai][bj][m][0], v1 = acc[ai][bj][m][1]; const size_t o = off + bj * HALF;
                    if (basef) { v0 += *(const f32x4*)(basef + o); v1 += *(const f32x4*)(basef + o + 4); }
                    else { const u32x4 b = *(const u32x4*)(baseb + o);
                        v0[0] += __uint_as_float(b.x << 16); v0[1] += __uint_as_float(b.x & 0xffff0000u); v0[2] += __uint_as_float(b.y << 16); v0[3] += __uint_as_float(b.y & 0xffff0000u);
                        v1[0] += __uint_as_float(b.z << 16); v1[1] += __uint_as_float(b.z & 0xffff0000u); v1[2] += __uint_as_float(b.w << 16); v1[3] += __uint_as_float(b.w & 0xffff0000u); }
                    u32x4 w; w.x = cvt_pk_bf16(v0[0], v0[1]); w.y = cvt_pk_bf16(v0[2], v0[3]); w.z = cvt_pk_bf16(v1[0], v1[1]); w.w = cvt_pk_bf16(v1[2], v1[3]);
                    *(u32x4*)(out + o) = w; } }
    }
};
template <class Epi, class Sched, bool ALIGN_EPI = false, bool SP2 = false>
__device__ __forceinline__ void gemm_phase(PG8_LAS unsigned char* lds, const Gemm g, const Sched& S, const Epi& E, int wid_in  ) {
    int wid = wid_in; asm volatile("" : "+s"(wid));
    int lane = (int)__builtin_amdgcn_mbcnt_hi(~0u, __builtin_amdgcn_mbcnt_lo(~0u, 0u)); asm volatile("" : "+v"(lane));
    const int tid = wid * 64 + lane, wr = wid >> 2, wc = wid & 3, fr = lane & 15, fq = lane >> 4;
    const int K = g.K, nt = K / BK;
    unsigned voffA[2], voffB[2];
#pragma unroll
    for (int i = 0; i < 2; ++i) { int R, C; stage_rc(tid * 16 + i * 8192, R, C); const int Rb = Epi::PERM ? ((R & ~31) + perm32(R & 31)) : R;
        voffA[i] = (unsigned)(R * K + C) * 2u; voffB[i] = (unsigned)(Rb * K + C) * 2u; }
    const size_t kstep = (size_t)(BK * 2);
    const size_t hstep = (size_t)HALF * K * 2;
    const size_t tstep = 2 * hstep;
    const unsigned ldsw = (unsigned)wid * 1024u;
    const int aoff = lds_byte(wr * 64 + fr, fq * 8), boff = lds_byte(wc * 32 + fr, fq * 8);
#define PG8_SA(b, h) (((b) * 2 + (h)) * HTB)
#define PG8_SB(b, h) ((4 + (b) * 2 + (h)) * HTB)
#define PG8_STAGE(bufoff, gbase, voff) do { _Pragma("unroll") for (int _i = 0; _i < 2; ++_i) \
        __builtin_amdgcn_global_load_lds((const unsigned*)((const char*)(gbase) + (voff)[_i]), (PG8_LAS unsigned*)(lds + (bufoff) + ldsw + _i * 8192), 16, 0, 0); } while (0)
#define PG8_LDA(dst, b, h) do { _Pragma("unroll") for (int m = 0; m < 4; ++m) _Pragma("unroll") for (int k = 0; k < 2; ++k) dst[m][k] = *(const PG8_LAS bf16x8*)(lds + PG8_SA(b, h) + aoff + m * 2048 + k * 1024); } while (0)
#define PG8_LDB(dst, b, h) do { _Pragma("unroll") for (int n = 0; n < 2; ++n) _Pragma("unroll") for (int k = 0; k < 2; ++k) dst[n][k] = *(const PG8_LAS bf16x8*)(lds + PG8_SB(b, h) + boff + n * 2048 + k * 1024); } while (0)
#define PG8_MMA(ai, bj, At, Bt) do { __builtin_amdgcn_s_setprio(1); _Pragma("unroll") for (int m = 0; m < 4; ++m) _Pragma("unroll") for (int n = 0; n < 2; ++n) _Pragma("unroll") for (int k = 0; k < 2; ++k) \
        acc[ai][bj][m][n] = __builtin_amdgcn_mfma_f32_16x16x32_bf16(Bt[n][k], At[m][k], acc[ai][bj][m][n], 0, 0, 0); __builtin_amdgcn_s_setprio(0); } while (0)
#define PG8_WAIT_V(n) asm volatile("s_waitcnt vmcnt(" #n ")" ::: "memory")
#define PG8_WAIT_L(n) asm volatile("s_waitcnt lgkmcnt(" #n ")" ::: "memory")
#define PG8_BAR __builtin_amdgcn_s_barrier()
#define PG8_SCHED __builtin_amdgcn_sched_barrier(0)
    Unit cur, nxt; int ui = 0;
    if (!S.next(0, cur)) return;
    f32x4 acc[2][2][4][2];
#pragma unroll
    for (int a = 0; a < 2; ++a)
#pragma unroll
        for (int b = 0; b < 2; ++b)
#pragma unroll
            for (int m = 0; m < 4; ++m)
#pragma unroll
                for (int n = 0; n < 2; ++n) acc[a][b][m][n] = (f32x4){0.f, 0.f, 0.f, 0.f};
    bf16x8 At[4][2], B0[2][2], B1[2][2];
    const char* cA = (const char*)g.A + (size_t)cur.pm * tstep; const char* cB = (const char*)g.Bt + (size_t)cur.pn * tstep;
    S.a_ready(cur);
    if constexpr (SP2) {
        PG8_STAGE(PG8_SB(0, 0), cB, voffB); PG8_STAGE(PG8_SB(0, 1), cB + hstep, voffB); PG8_STAGE(PG8_SA(0, 0), cA, voffA); PG8_STAGE(PG8_SA(0, 1), cA + hstep, voffA);
        if (wr == 1) PG8_BAR;
        PG8_WAIT_V(2); PG8_BAR;
        PG8_STAGE(PG8_SB(1, 0), cB + kstep, voffB); PG8_STAGE(PG8_SA(1, 0), cA + kstep, voffA); PG8_STAGE(PG8_SB(1, 1), cB + hstep + kstep, voffB);
        PG8_WAIT_V(6); PG8_BAR;
    } else {
        PG8_STAGE(PG8_SB(0, 0), cB, voffB); PG8_STAGE(PG8_SA(0, 0), cA, voffA); PG8_STAGE(PG8_SB(0, 1), cB + hstep, voffB); PG8_STAGE(PG8_SA(0, 1), cA + hstep, voffA);
        if (wr == 1) PG8_BAR;
        PG8_WAIT_V(4); PG8_BAR;
        PG8_STAGE(PG8_SB(1, 0), cB + kstep, voffB); PG8_STAGE(PG8_SA(1, 0), cA + kstep, voffA); PG8_STAGE(PG8_SB(1, 1), cB + hstep + kstep, voffB);
        PG8_WAIT_V(6); PG8_BAR;
    }
    for (;;) {
        const bool has_next = S.next(ui + 1, nxt);
        const char* nA = has_next ? (const char*)g.A + (size_t)nxt.pm * tstep : cA; const char* nB = has_next ? (const char*)g.Bt + (size_t)nxt.pn * tstep : cB;
        for (int t = 0; t < nt; t += 2) {
            const bool last = (t == nt - 2);
            const char* a1 = cA + (size_t)(t + 1) * kstep;
            const char* a2 = last ? nA : cA + (size_t)(t + 2) * kstep; const char* b2 = last ? nB : cB + (size_t)(t + 2) * kstep;
            const char* a3 = a2 + kstep; const char* b3 = b2 + kstep;
            if (last && has_next) S.a_ready(nxt);
            if constexpr (SP2) {
            PG8_LDB(B0, 0, 0); PG8_LDB(B1, 0, 1); PG8_SCHED; PG8_LDA(At, 0, 0); PG8_STAGE(PG8_SA(1, 1), a1 + hstep, voffA);
            PG8_WAIT_V(8); PG8_WAIT_L(0); PG8_BAR; PG8_MMA(0, 0, At, B0); PG8_MMA(0, 1, At, B1); PG8_BAR; PG8_SCHED;
            PG8_LDA(At, 0, 1); PG8_STAGE(PG8_SB(0, 0), b2, voffB); PG8_STAGE(PG8_SB(0, 1), b2 + hstep, voffB); PG8_STAGE(PG8_SA(0, 0), a2, voffA);
            PG8_WAIT_V(8); PG8_WAIT_L(0); PG8_BAR; PG8_MMA(1, 0, At, B0); PG8_MMA(1, 1, At, B1); PG8_BAR; PG8_SCHED;
            PG8_LDB(B0, 1, 0); PG8_LDB(B1, 1, 1); PG8_SCHED; PG8_LDA(At, 1, 0); PG8_STAGE(PG8_SA(0, 1), a2 + hstep, voffA);
            PG8_WAIT_V(8); PG8_WAIT_L(0); PG8_BAR; PG8_MMA(0, 0, At, B0); PG8_MMA(0, 1, At, B1); PG8_BAR; PG8_SCHED;
            PG8_LDA(At, 1, 1); PG8_STAGE(PG8_SB(1, 0), b3, voffB); PG8_STAGE(PG8_SB(1, 1), b3 + hstep, voffB); PG8_STAGE(PG8_SA(1, 0), a3, voffA);
            PG8_WAIT_V(8); PG8_WAIT_L(0); PG8_BAR; PG8_MMA(1, 0, At, B0); PG8_MMA(1, 1, At, B1); PG8_BAR; PG8_SCHED;
            } else {
            PG8_LDB(B0, 0, 0); PG8_SCHED; PG8_LDA(At, 0, 0); PG8_STAGE(PG8_SA(1, 1), a1 + hstep, voffA);
            PG8_WAIT_L(8); PG8_BAR; PG8_WAIT_L(0); PG8_MMA(0, 0, At, B0); PG8_BAR; PG8_SCHED;
            PG8_LDB(B1, 0, 1); PG8_STAGE(PG8_SB(0, 0), b2, voffB);
            PG8_BAR; PG8_WAIT_L(0); PG8_MMA(0, 1, At, B1); PG8_BAR;
            PG8_LDA(At, 0, 1); PG8_STAGE(PG8_SA(0, 0), a2, voffA);
            PG8_BAR; PG8_WAIT_L(0); PG8_MMA(1, 0, At, B0); PG8_BAR; PG8_SCHED;
            PG8_STAGE(PG8_SB(0, 1), b2 + hstep, voffB);
            PG8_WAIT_V(6); PG8_BAR; PG8_MMA(1, 1, At, B1); PG8_BAR;
            PG8_LDB(B0, 1, 0); PG8_SCHED; PG8_LDA(At, 1, 0); PG8_STAGE(PG8_SA(0, 1), a2 + hstep, voffA);
            PG8_WAIT_L(8); PG8_BAR; PG8_WAIT_L(0); PG8_MMA(0, 0, At, B0); PG8_BAR; PG8_SCHED;
            PG8_LDB(B1, 1, 1); PG8_STAGE(PG8_SB(1, 0), b3, voffB);
            PG8_BAR; PG8_WAIT_L(0); PG8_MMA(0, 1, At, B1); PG8_BAR;
            PG8_LDA(At, 1, 1); PG8_STAGE(PG8_SA(1, 0), a3, voffA);
            PG8_BAR; PG8_WAIT_L(0); PG8_MMA(1, 0, At, B0); PG8_BAR; PG8_SCHED;
            PG8_STAGE(PG8_SB(1, 1), b3 + hstep, voffB);
            PG8_WAIT_V(6); PG8_BAR; PG8_MMA(1, 1, At, B1); PG8_BAR;
            }
        }
        if constexpr (ALIGN_EPI) { if (wr == 0) PG8_BAR; }
        if constexpr (!Epi::AFTER_DRAIN) { E(acc, cur, wr, wc, fr, fq); S.done(cur); }
        if (!has_next) break;
#pragma unroll
        for (int a = 0; a < 2; ++a)
#pragma unroll
            for (int b = 0; b < 2; ++b)
#pragma unroll
                for (int m = 0; m < 4; ++m)
#pragma unroll
                    for (int n = 0; n < 2; ++n) acc[a][b][m][n] = (f32x4){0.f, 0.f, 0.f, 0.f};
        cur = nxt; cA = nA; cB = nB; ++ui;
        if constexpr (ALIGN_EPI) { if (wr == 1) PG8_BAR; }
    }
    PG8_WAIT_V(0);
    if constexpr (!ALIGN_EPI) { if (wr == 0) PG8_BAR; }
    PG8_BAR;
    if constexpr (Epi::AFTER_DRAIN) { E.fused(acc, cur, wr, wc, fr, fq, lds, wid, lane); S.done(cur); }
#undef PG8_SA
#undef PG8_SB
#undef PG8_STAGE
#undef PG8_LDA
#undef PG8_LDB
#undef PG8_MMA
#undef PG8_WAIT_V
#undef PG8_WAIT_L
#undef PG8_BAR
#undef PG8_SCHED
}
}
#define GAS __attribute__((address_space(1)))
#define LAS __attribute__((address_space(3)))
typedef unsigned short bf16;
typedef unsigned v4u __attribute__((ext_vector_type(4)));
typedef float f32x4 __attribute__((ext_vector_type(4)));
typedef short bf16x8 __attribute__((ext_vector_type(8)));
typedef GAS unsigned gu32;
typedef GAS unsigned long long gu64;
#define RLX_AGENT __ATOMIC_RELAXED, __HIP_MEMORY_SCOPE_AGENT
#define LDS_WAIT() asm volatile("s_waitcnt lgkmcnt(0)" ::: "memory")
#define VM_WAIT() asm volatile("s_waitcnt vmcnt(0)" ::: "memory")
__device__ __forceinline__ unsigned long long rt() { return __builtin_amdgcn_s_memrealtime(); }
__device__ __forceinline__ unsigned f2bf(float f) { unsigned u = __builtin_bit_cast(unsigned, f); return (u + 0x7fffu + ((u >> 16) & 1u)) >> 16; }
__device__ __forceinline__ unsigned pk2(float lo, float hi) { return f2bf(lo) | (f2bf(hi) << 16); }
#define XB_TMO      128
#define XB_XCNT(j)  (256  + 64 * (j))
#define XB_XSUB(j)  (1280 + 64 * (j))
#define XB_XGEN(j)  (2304 + 64 * (j))
#define XB_TOP      3328
#define XB_TOPGEN   3392
#define XCD_BAR_WORDS 3456
#define XB_SPIN_CAP (1u << 18)

__device__ __forceinline__ unsigned xb_ld(unsigned* p)              { return __hip_atomic_load(p, __ATOMIC_RELAXED, __HIP_MEMORY_SCOPE_AGENT); }
__device__ __forceinline__ unsigned xb_add(unsigned* p, unsigned v) { return __hip_atomic_fetch_add(p, v, __ATOMIC_RELAXED, __HIP_MEMORY_SCOPE_AGENT); }
__device__ __forceinline__ unsigned xb_xcc_id() { return (unsigned)__builtin_amdgcn_s_getreg((3 << 11) | 20) & 0xFu; }
#define XB_SPIN(cond, bar) do { unsigned _sp = 0; while (cond) { __builtin_amdgcn_s_sleep(1); \
    if ((++_sp & 255u) == 0u) { if (xb_ld(&(bar)[XB_TMO])) break; if (_sp > XB_SPIN_CAP) { atomicAdd(&(bar)[XB_TMO], 1u); break; } } } } while (0)

struct XcdBarrier {
    unsigned* bar; unsigned x;
    unsigned w0;
    volatile LAS unsigned* st;
};

__device__ __forceinline__ XcdBarrier xcd_barrier_post(unsigned* bar, volatile LAS unsigned* st) {
    XcdBarrier b; b.bar = bar; b.x = xb_xcc_id(); b.st = st; b.w0 = (__builtin_amdgcn_readfirstlane(threadIdx.x >> 6) == 0) ? 1u : 0u;
    if (threadIdx.x == 0) (void)xb_add(&bar[XB_XCNT(b.x)], 1u);
    return b;
}
__device__ __forceinline__ void xcd_barrier_complete(unsigned* bar, unsigned x, unsigned& nloc, unsigned& nx) {
    const unsigned G = gridDim.x * gridDim.y * gridDim.z;
    unsigned sum, cnt, mine, sp = 0u;
    for (;;) {
        sum = 0u; cnt = 0u; mine = 0u;
#pragma unroll
        for (unsigned j = 0; j < 16; ++j) { const unsigned c = xb_ld(&bar[XB_XCNT(j)]); sum += c; cnt += (c > 0u) ? 1u : 0u; mine = (j == x) ? c : mine; }
        if (sum == G) break;
        __builtin_amdgcn_s_sleep(1);
        if ((++sp & 255u) == 0u) { if (xb_ld(&bar[XB_TMO])) break; if (sp > XB_SPIN_CAP) { atomicAdd(&bar[XB_TMO], 1u); break; } }
    }
    nloc = mine > 0u ? mine : 1u; nx = cnt > 0u ? cnt : 1u;
}

__device__ __forceinline__ void xcd_barrier(const XcdBarrier& b) {
    asm volatile("s_waitcnt vmcnt(0)" ::: "memory");
    __syncthreads();
    if (b.w0 != 0u && __builtin_amdgcn_mbcnt_hi(~0u, __builtin_amdgcn_mbcnt_lo(~0u, 0u)) == 0u) {
        GAS unsigned* barg = (GAS unsigned*)b.bar; asm volatile("" : "+s"(barg)); unsigned* bar = (unsigned*)barg;
        __builtin_amdgcn_s_waitcnt(0);
        unsigned nloc = b.st[0], nx = b.st[1];
        if (nloc == 0u) { xcd_barrier_complete(bar, b.x, nloc, nx); b.st[0] = nloc; b.st[1] = nx; }
        const unsigned old = xb_add(&bar[XB_XSUB(b.x)], 1u);
        const unsigned gen = old / nloc;
        if (old + 1u == (gen + 1u) * nloc) {
            __builtin_amdgcn_fence(__ATOMIC_RELEASE, "agent");
            asm volatile("s_waitcnt vmcnt(0)" ::: "memory");
            const unsigned og = xb_add(&bar[XB_TOP], 1u);
            const unsigned tg = og / nx;
            if (og + 1u == (tg + 1u) * nx) xb_add(&bar[XB_TOPGEN], 1u);
            else XB_SPIN(xb_ld(&bar[XB_TOPGEN]) == tg, bar);
            __builtin_amdgcn_fence(__ATOMIC_ACQUIRE, "agent");
            xb_add(&bar[XB_XGEN(b.x)], 1u);
            asm volatile("s_waitcnt vmcnt(0)" ::: "memory");
        } else {
            XB_SPIN(xb_ld(&bar[XB_XGEN(b.x)]) == gen, bar);
            __builtin_amdgcn_fence(__ATOMIC_ACQUIRE, "agent");
            asm volatile("s_waitcnt vmcnt(0)" ::: "memory");
        }
    }
    __syncthreads();
}
typedef unsigned u32x4 __attribute__((ext_vector_type(4)));

typedef short s16x4 __attribute__((ext_vector_type(4)));
typedef float f32x16 __attribute__((ext_vector_type(16)));
typedef unsigned u32x2 __attribute__((ext_vector_type(2)));
typedef float f32x2v __attribute__((ext_vector_type(2)));

constexpr int S = 8192, D = 2048, DEPTH = 4, DIN = 5688, NP = 5888, PITCH = 5632;
constexpr int C_AQ = 0, C_AK = 512, C_AV = 1024, C_BQ = 1536, C_BK = 2048, C_BV = 2560, C_CQ = 3072, C_KC = 4096, C_VC = 4352, C_KS = 4608, C_VS = 4864, C_KW = 5120, C_VW = 5376;
constexpr float RMS_EPS = 1e-6f, NEG = -1e30f, LOG2E = 1.4426950408889634f, SCL2 = 0.125f * 1.4426950408889634f;
constexpr int NWAVES = 8, NTHR = 512;

constexpr size_t MiB = 1u << 20;
constexpr size_t WS_CTL = 0, CTL_ZERO_BYTES = 192 * 1024;
constexpr size_t WS_WIN = 2 * MiB;
constexpr size_t WS_WOUT = 96 * MiB;
constexpr size_t WS_W1T = 128 * MiB;
constexpr size_t WS_W2T = 136 * MiB;
constexpr size_t WS_RWT = 137 * MiB;
constexpr size_t WS_C1 = 139 * MiB;
constexpr size_t WS_X = 144 * MiB;
constexpr size_t WS_XN = 208 * MiB;
constexpr size_t WS_PROJ = 240 * MiB;
constexpr size_t WS_AUX = 330 * MiB;
constexpr size_t WS_CUM = 332 * MiB;
constexpr size_t WS_KC = 333 * MiB;
constexpr size_t WS_VC = 334 * MiB;
constexpr size_t WS_MIX = 336 * MiB;
constexpr size_t WS_YB = 368 * MiB;
constexpr size_t WS_LIST = 432 * MiB;
constexpr size_t WS_TW = 436 * MiB;
constexpr size_t WS_RSTD = 437 * MiB;
constexpr size_t WS_END = 440 * MiB;
constexpr int CW_BAR = 4096;
constexpr int CW_Q = 8192;
constexpr int CW_PQ = 24576, CW_PD = 25600;
constexpr int CW_G2Q = 46592;
constexpr int CW_ATC = 44544;
constexpr int CW_G2C = 41984;
constexpr int CW_CNT = 32768;

constexpr int LDS_BYTES = 160 * 1024;
constexpr int MISC_OFF = 150 * 1024;

struct Args { const float* in[23]; float* out; unsigned char* ws; int ph_lo, ph_hi; };
__device__ __forceinline__ int t5_bucket(int rel) { if (rel < 16) return rel; int b = 16;
    b += rel >= 19; b += rel >= 21; b += rel >= 24; b += rel >= 27; b += rel >= 31; b += rel >= 35; b += rel >= 40; b += rel >= 46; b += rel >= 52; b += rel >= 59; b += rel >= 67; b += rel >= 77; b += rel >= 87; b += rel >= 99; b += rel >= 113; return b; }

__device__ __forceinline__ float bf2f(unsigned short b) { return __uint_as_float((unsigned)b << 16); }
__device__ __forceinline__ float bflo(unsigned w) { return __uint_as_float(w << 16); }
__device__ __forceinline__ float bfhi(unsigned w) { return __uint_as_float(w & 0xffff0000u); }
typedef __bf16 bf16x2_t __attribute__((ext_vector_type(2)));
__device__ __forceinline__ unsigned cvtpk(float lo, float hi) { f32x2v v = {lo, hi}; bf16x2_t b = __builtin_convertvector(v, bf16x2_t); return __builtin_bit_cast(unsigned, b); }
__device__ __forceinline__ unsigned short f2bf16(float f) { return (unsigned short)(cvtpk(f, 0.f) & 0xffffu); }
__device__ __forceinline__ float wave_sum(float v) {
#pragma unroll
    for (int o = 1; o < 64; o <<= 1) v += __shfl_xor(v, o);
    return v;
}
__device__ __forceinline__ int crow(int r, int hi) { return (r & 3) + 8 * (r >> 2) + 4 * hi; }
#define MFMA32(a, b, c) __builtin_amdgcn_mfma_f32_32x32x16_bf16((a), (b), (c), 0, 0, 0)
#define MFMA16(a, b, c) __builtin_amdgcn_mfma_f32_16x16x32_bf16((a), (b), (c), 0, 0, 0)

__device__ __forceinline__ int src_col_win(int n) { if (n < 3072) return n; if (n < 5632) return n + 8; if (n < 5640) return n - 2560; if (n < 5688) return n; return -1; }

template <int MODE>
__device__ __forceinline__ void tr_item(const float* W, const float* W2, int ldw, int K, bf16* WT, int k0, int n0, LAS float* scr, int lane, const float* kgain = nullptr  ) {
    const int nq = lane & 7, kq = lane >> 3, nn = n0 + 4 * nq;
    const float* src = W; int ld = ldw; bool ok = true;
    if (MODE == 0) { src = W + nn; }
    else if (MODE == 1) { const int c = src_col_win(nn); ok = c >= 0; src = W + (ok ? c : 0); }
    else { if (nn < 8) { src = W + nn; ld = 8; } else if (nn < 72) { src = W2 + (nn - 8); ld = 64; } else { ok = false; ld = 8; } }
    f32x4 tq[8];
#pragma unroll
    for (int i = 0; i < 8; ++i) { const int kk = 8 * i + kq; tq[i] = ok ? *(const f32x4*)(src + (size_t)(k0 + kk) * ld) : (f32x4){0.f, 0.f, 0.f, 0.f}; }
#pragma unroll
    for (int i = 0; i < 8; ++i) { const int kk = 8 * i + kq; *(LAS f32x4*)(scr + kk * 36 + ((4 * nq) ^ (4 * i))) = tq[i]; }
    LDS_WAIT(); asm volatile("" ::: "memory");
    const int c = lane & 7;
    f32x4 g0 = (f32x4){1.f, 1.f, 1.f, 1.f}, g1 = g0;
    if (MODE == 1) { g0 = *(const f32x4*)(kgain + k0 + 8 * c); g1 = *(const f32x4*)(kgain + k0 + 8 * c + 4); }
#pragma unroll
    for (int j = 0; j < 4; ++j) { const int n = (lane >> 3) + 8 * j; const LAS float* s = scr + (8 * c) * 36 + (n ^ (4 * c));
        v4u o; o.x = pk2(s[0 * 36] * g0.x, s[1 * 36] * g0.y); o.y = pk2(s[2 * 36] * g0.z, s[3 * 36] * g0.w); o.z = pk2(s[4 * 36] * g1.x, s[5 * 36] * g1.y); o.w = pk2(s[6 * 36] * g1.z, s[7 * 36] * g1.w);
        *(v4u*)(WT + (size_t)(n0 + n) * K + k0 + 8 * c) = o; }
    LDS_WAIT(); asm volatile("" ::: "memory");
}

template <int MODE>
__device__ __forceinline__ void norm_rows(const float* xsrc, const bf16* xb, bf16* X, bf16* XN, const bf16* YB, const float* TW, const float* gain, float* out, float* RSTD, int gw, int NGW, int lane) {
    for (int row = gw; row < S; row += NGW) {
        f32x4 v[8];
        if (MODE == 0) { const f32x4* xr = (const f32x4*)(xsrc + (size_t)row * D) + lane;
#pragma unroll
            for (int j = 0; j < 8; ++j) v[j] = xr[64 * j];
        } else { const u32x2* xr = (const u32x2*)(xb + (size_t)row * D) + lane;
#pragma unroll
            for (int j = 0; j < 8; ++j) { const u32x2 r = xr[64 * j]; v[j] = (f32x4){bflo(r.x), bfhi(r.x), bflo(r.y), bfhi(r.y)}; } }
        if (MODE >= 1) {
            const float w0 = TW[2 * row], w1 = TW[2 * row + 1];
            const u32x2* ya = (const u32x2*)(YB + (size_t)(2 * row) * D) + lane; const u32x2* yb = (const u32x2*)(YB + (size_t)(2 * row + 1) * D) + lane;
#pragma unroll
            for (int j = 0; j < 8; ++j) { const u32x2 a = ya[64 * j], b = yb[64 * j];
                v[j].x += w0 * bflo(a.x) + w1 * bflo(b.x); v[j].y += w0 * bfhi(a.x) + w1 * bfhi(b.x);
                v[j].z += w0 * bflo(a.y) + w1 * bflo(b.y); v[j].w += w0 * bfhi(a.y) + w1 * bfhi(b.y); }
        }
        float ss = 0.f;
#pragma unroll
        for (int j = 0; j < 8; ++j) ss += (v[j].x * v[j].x + v[j].y * v[j].y) + (v[j].z * v[j].z + v[j].w * v[j].w);
        ss = wave_sum(ss);
        const float rstd = 1.0f / sqrtf(ss * (1.0f / D) + RMS_EPS);
        if (MODE <= 1) { u32x2* xo = (u32x2*)((MODE == 1 ? X : XN) + (size_t)row * D) + lane;
#pragma unroll
            for (int j = 0; j < 8; ++j) { u32x2 w; w.x = cvtpk(v[j].x, v[j].y); w.y = cvtpk(v[j].z, v[j].w); xo[64 * j] = w; }
            if (lane == 0) RSTD[row] = rstd; }
        const f32x4* gr = (const f32x4*)gain + lane;
        if (MODE < 0) { u32x2* o8 = (u32x2*)(XN + (size_t)row * D) + lane;
#pragma unroll
            for (int j = 0; j < 8; ++j) { const f32x4 g = gr[64 * j]; u32x2 w; w.x = cvtpk(v[j].x * rstd * g.x, v[j].y * rstd * g.y); w.y = cvtpk(v[j].z * rstd * g.z, v[j].w * rstd * g.w); o8[64 * j] = w; }
        } else if (MODE == 2) { f32x4* oo = (f32x4*)(out + (size_t)row * D) + lane;
#pragma unroll
            for (int j = 0; j < 8; ++j) { const f32x4 g = gr[64 * j]; oo[64 * j] = v[j] * rstd * g; } }
    }
}

constexpr int I_WIN = 32 * 184, I_WOUT = 32 * 64, I_W1 = 32 * 8, I_W2 = 4 * 2, I_RW = 32 * 3, I_L = I_WIN + I_WOUT + 2 * I_W1 + 2 * I_W2 + I_RW;
__device__ __forceinline__ void tr_dispatch(const Args& a, unsigned char* ws, int it, LAS float* scr, int lane) {
        const int l = it / I_L; int r = it % I_L;
        if (r < I_WIN) { tr_item<1>(a.in[2] + (size_t)l * D * DIN, nullptr, DIN, D, (bf16*)(ws + WS_WIN) + (size_t)l * NP * D, 64 * (r / 184), 32 * (r % 184), scr, lane, a.in[1] + (size_t)l * D); return; } r -= I_WIN;
        if (r < I_WOUT) { tr_item<0>(a.in[13] + (size_t)l * D * D, nullptr, D, D, (bf16*)(ws + WS_WOUT) + (size_t)l * D * D, 64 * (r / 64), 32 * (r % 64), scr, lane); return; } r -= I_WOUT;
        if (r < 2 * I_W1) { const int kv = r / I_W1, q = r % I_W1; tr_item<0>(a.in[kv ? 10 : 7] + (size_t)l * 2048 * 256, nullptr, 256, 2048, (bf16*)(ws + WS_W1T) + (size_t)(l * 2 + kv) * 256 * 2048, 64 * (q / 8), 32 * (q % 8), scr, lane); return; } r -= 2 * I_W1;
        if (r < 2 * I_W2) { const int kv = r / I_W2, q = r % I_W2; tr_item<0>(a.in[kv ? 11 : 8] + (size_t)l * 256 * 64, nullptr, 64, 256, (bf16*)(ws + WS_W2T) + (size_t)(l * 2 + kv) * 64 * 256, 64 * (q / 2), 32 * (q % 2), scr, lane); return; } r -= 2 * I_W2;
        tr_item<2>(a.in[15] + (size_t)l * D * 8, a.in[17] + (size_t)l * D * 64, 8, D, (bf16*)(ws + WS_RWT) + (size_t)l * 96 * D, 64 * (r / 3), 32 * (r % 3), scr, lane);
}

__device__ __forceinline__ void p0_prologue(const Args& a, LAS unsigned char* lds, int bid, int G, int tid, int wid, int lane) {
    unsigned char* ws = a.ws;
    LAS float* scr = (LAS float*)(lds + wid * 9216);
    const int gw = bid * NWAVES + wid, NGW = G * NWAVES;
    for (int j = gw; j < DEPTH * I_WIN; j += NGW) tr_dispatch(a, ws, (j / I_WIN) * I_L + (j % I_WIN), scr, lane);
    for (int b = bid; b < 256; b += G) {
        const int vec = b >> 5, cb = b & 31, l = vec >> 1, kv = vec & 1; const float* pos = a.in[kv ? 9 : 6] + (size_t)l * 2048; const float* w1 = a.in[kv ? 10 : 7] + (size_t)l * 2048 * 256 + 8 * cb;
        float acc[8];
#pragma unroll
        for (int i = 0; i < 8; ++i) acc[i] = 0.f;
#pragma unroll
        for (int j = 0; j < 4; ++j) { const int k = tid + 512 * j; const float pv = pos[k]; const f32x4 w0 = *(const f32x4*)(w1 + (size_t)k * 256), w1v = *(const f32x4*)(w1 + (size_t)k * 256 + 4);
            acc[0] += pv * w0.x; acc[1] += pv * w0.y; acc[2] += pv * w0.z; acc[3] += pv * w0.w; acc[4] += pv * w1v.x; acc[5] += pv * w1v.y; acc[6] += pv * w1v.z; acc[7] += pv * w1v.w; }
        LAS float* red = (LAS float*)(lds + 72 * 1024);
#pragma unroll
        for (int i = 0; i < 8; ++i) { const float sws = wave_sum(acc[i]); if (lane == 0) red[wid * 8 + i] = sws; }
        __syncthreads();
        if (tid < 8) { float sres = 0.f;
#pragma unroll
            for (int w = 0; w < 8; ++w) sres += red[w * 8 + tid];
            ((float*)(ws + WS_C1))[vec * 256 + 8 * cb + tid] = sres; }
        __syncthreads();
    }
    norm_rows<0>(a.in[0], nullptr, nullptr, (bf16*)(ws + WS_XN), nullptr, nullptr, a.in[1], nullptr, (float*)(ws + WS_RSTD), gw, NGW, lane);
}

__device__ __forceinline__ float gelu_tanh(float x) { const float u = 0.7978845608028654f * (x + 0.044715f * x * x * x); const float t = 1.0f - 2.0f / (__expf(2.0f * u) + 1.0f); return 0.5f * x * (1.0f + t); }

__device__ __forceinline__ void compress_unit(int u, int l, const bf16* PROJ, const bf16* W1T, const bf16* W2T, const float* C1, bf16* KC, bf16* VC, LAS unsigned char* lds, int wid, int lane) {
    const int kv = u >> 6, rb = u & 63, r32 = lane & 31, hi = lane >> 5;
    const int R = 32 * rb + r32, g = R >> 9, n = R & 511;
    const int colb = (kv ? C_VC : C_KC) + 64 * g;
    const bf16* w1 = W1T + (size_t)(l * 2 + kv) * 256 * 2048 + (size_t)(32 * wid + r32) * 2048 + 8 * hi;
    const bf16* arow = PROJ + colb + 8 * hi;
    f32x16 acc = {};
#pragma unroll 4
    for (int s = 0; s < 128; ++s) {
        int tok = 16 * n + (s >> 2); tok = tok > (S - 1) ? (S - 1) : tok;
        const bf16x8 av = *(const bf16x8*)(arow + (size_t)tok * PITCH + (s & 3) * 16);
        const bf16x8 bv = *(const bf16x8*)(w1 + 16 * s);
        acc = MFMA32(av, bv, acc);
    }
    LAS bf16* hid = (LAS bf16*)lds;
    const float c1 = C1[(l * 2 + kv) * 256 + 32 * wid + r32];
#pragma unroll
    for (int r = 0; r < 16; ++r) hid[crow(r, hi) * 264 + 32 * wid + r32] = f2bf16(gelu_tanh(acc[r] + c1));
    __syncthreads();
    if (wid < 2) {
        f32x16 acc2 = {};
        const bf16* w2 = W2T + (size_t)(l * 2 + kv) * 64 * 256 + (size_t)(32 * wid + r32) * 256 + 8 * hi;
#pragma unroll 4
        for (int s = 0; s < 16; ++s) {
            const bf16x8 av = *(const LAS bf16x8*)(hid + r32 * 264 + 16 * s + 8 * hi);
            const bf16x8 bv = *(const bf16x8*)(w2 + 16 * s);
            acc2 = MFMA32(av, bv, acc2);
        }
        bf16* outp = kv ? VC : KC;
#pragma unroll
        for (int r = 0; r < 16; ++r) { const int Rr = 32 * rb + crow(r, hi); outp[(size_t)((Rr >> 9) * 512 + (Rr & 511)) * 64 + 32 * wid + r32] = f2bf16(acc2[r]); }
    }
    __syncthreads();
}

__device__ __forceinline__ void cumsum_unit(int h, int l, const float* AUX, const float* fox_bf, float* CUM, LAS unsigned char* lds, int tid) {
    const float bfv = fox_bf[l * 8 + h];
    float v[16]; float run = 0.f;
#pragma unroll
    for (int i = 0; i < 16; ++i) { const int t = 16 * tid + i; const float z = AUX[(size_t)t * 64 + h] + bfv; const float lf = fminf(z, 0.f) - log1pf(__expf(-fabsf(z))); run += lf; v[i] = run; }
    LAS float* tot = (LAS float*)lds;
    tot[tid] = run; __syncthreads();
    float off = 0.f;
    for (int j = 0; j < tid; ++j) off += tot[j];
#pragma unroll
    for (int i = 0; i < 16; ++i) CUM[(size_t)h * S + 16 * tid + i] = off + v[i];
    __syncthreads();
}

__device__ __forceinline__ int koff(int key, int c) { return c * 1024 + (((key + c) & 63) << 4); }
__device__ __forceinline__ int voff(int key, int c) { return (c >> 2) * 4096 + (key >> 4) * 1024 + (key & 15) * 64 + (c & 3) * 16; }
typedef short v4i16_t __attribute__((ext_vector_type(4)));
__device__ __forceinline__ s16x4 vtr(LAS const unsigned char* p) { return __builtin_bit_cast(s16x4, __builtin_amdgcn_ds_read_tr16_b64_v4i16((LAS v4i16_t*)p)); }

template <int NDT> struct AState { float m, l; f32x16 o[NDT]; };
template <int NDT> __device__ __forceinline__ void astate_init(AState<NDT>& st) { st.m = 0.f; st.l = 0.f;
#pragma unroll
    for (int i = 0; i < NDT; ++i) st.o[i] = (f32x16){}; }

template <bool QLDS>
__device__ __forceinline__ void qk_tile(f32x16& p0, f32x16& p1, LAS const unsigned char* kt, int kchunk0, const bf16x8 (&qf)[4], LAS const unsigned char* qb, int r32, int hi) {
    bf16x8 ka[4], kb[4], q[4];
#pragma unroll
    for (int d0 = 0; d0 < 4; ++d0) {
        const int c = kchunk0 + 2 * d0 + hi;
        ka[d0] = *(const LAS bf16x8*)(kt + koff(r32, c));
        kb[d0] = *(const LAS bf16x8*)(kt + koff(r32 + 32, c));
        q[d0] = QLDS ? *(const LAS bf16x8*)(qb + d0 * 8192) : qf[d0];
    }
    __builtin_amdgcn_sched_barrier(0);
    p0 = (f32x16){}; p1 = (f32x16){};
#pragma unroll
    for (int d0 = 0; d0 < 4; ++d0) { p0 = MFMA32(ka[d0], q[d0], p0); p1 = MFMA32(kb[d0], q[d0], p1); }
    __builtin_amdgcn_sched_barrier(0);
}
__device__ __forceinline__ void pack_p(bf16x8 (&pw)[4], const f32x16& p0, const f32x16& p1) {
    u32x4 w;
    w.x = cvtpk(p0[0], p0[1]); w.y = cvtpk(p0[2], p0[3]); w.z = cvtpk(p0[4], p0[5]); w.w = cvtpk(p0[6], p0[7]); pw[0] = __builtin_bit_cast(bf16x8, w);
    w.x = cvtpk(p0[8], p0[9]); w.y = cvtpk(p0[10], p0[11]); w.z = cvtpk(p0[12], p0[13]); w.w = cvtpk(p0[14], p0[15]); pw[1] = __builtin_bit_cast(bf16x8, w);
    w.x = cvtpk(p1[0], p1[1]); w.y = cvtpk(p1[2], p1[3]); w.z = cvtpk(p1[4], p1[5]); w.w = cvtpk(p1[6], p1[7]); pw[2] = __builtin_bit_cast(bf16x8, w);
    w.x = cvtpk(p1[8], p1[9]); w.y = cvtpk(p1[10], p1[11]); w.z = cvtpk(p1[12], p1[13]); w.w = cvtpk(p1[14], p1[15]); pw[3] = __builtin_bit_cast(bf16x8, w);
}
struct VFrag { s16x4 lo[4], hh[4]; };
__device__ __forceinline__ LAS const unsigned char* vfrag_base(LAS const unsigned char* vt, int lane) { return vt + ((lane >> 4) & 1) * 32 + (lane & 3) * 8 + (4 * (lane >> 5) + ((lane & 15) >> 2)) * 64; }
__device__ __forceinline__ void vfrag_read(VFrag& f, LAS const unsigned char* vb, int dt) {
#pragma unroll
    for (int s = 0; s < 4; ++s) { f.lo[s] = vtr(vb + dt * 4096 + s * 1024); f.hh[s] = vtr(vb + dt * 4096 + s * 1024 + 512); }
}
__device__ __forceinline__ void vfrag_mma(f32x16& o, const VFrag& f, const bf16x8 (&pw)[4]) {
#pragma unroll
    for (int s = 0; s < 4; ++s) { const bf16x8 vf = (bf16x8){f.lo[s][0], f.lo[s][1], f.lo[s][2], f.lo[s][3], f.hh[s][0], f.hh[s][1], f.hh[s][2], f.hh[s][3]}; o = MFMA32(vf, pw[s], o); }
}
template <int NDT>
__device__ __forceinline__ void pv_tile_pre(f32x16 (&o)[NDT], const bf16x8 (&pw)[4], LAS const unsigned char* vb, VFrag& f0) {
    VFrag f1;
#pragma unroll
    for (int dt = 0; dt < NDT; dt += 2) {
        if (dt + 1 < NDT) vfrag_read(f1, vb, dt + 1);
        __builtin_amdgcn_sched_barrier(0);
        vfrag_mma(o[dt], f0, pw);
        if (dt + 1 < NDT) {
            if (dt + 2 < NDT) vfrag_read(f0, vb, dt + 2);
            __builtin_amdgcn_sched_barrier(0);
            vfrag_mma(o[dt + 1], f1, pw);
        }
    }
}
template <int NDT>
__device__ __forceinline__ void pv_tile(f32x16 (&o)[NDT], const bf16x8 (&pw)[4], LAS const unsigned char* vt, int lane) {
    LAS const unsigned char* vb = vfrag_base(vt, lane);
    VFrag f0; vfrag_read(f0, vb, 0);
    pv_tile_pre<NDT>(o, pw, vb, f0);
}
constexpr float SM_THR = 8.0f;
__device__ __forceinline__ float max3f(float a, float b, float c) { return __builtin_fmaxf(__builtin_fmaxf(a, b), c); }
__device__ __forceinline__ float halfmax(float m) { auto rr = __builtin_amdgcn_permlane32_swap(__float_as_uint(m), __float_as_uint(m), false, false); return fmaxf(__uint_as_float(rr[0]), __uint_as_float(rr[1])); }
__device__ __forceinline__ float halfsum(float v) { auto rr = __builtin_amdgcn_permlane32_swap(__float_as_uint(v), __float_as_uint(v), false, false); return __uint_as_float(rr[0]) + __uint_as_float(rr[1]); }
#ifndef SM_VPRE
#define SM_VPRE false
#endif
template <int NDT>
__device__ __forceinline__ void softmax_pv(AState<NDT>& st, f32x16& p0, f32x16& p1, LAS const unsigned char* vt, int lane) {
    LAS const unsigned char* vb = vfrag_base(vt, lane);
    constexpr bool VPRE = SM_VPRE;
    VFrag f0; if (VPRE) { vfrag_read(f0, vb, 0); __builtin_amdgcn_sched_barrier(0); }
    float ma = max3f(p0[0], p0[1], p0[2]), mb = max3f(p1[0], p1[1], p1[2]);
#pragma unroll
    for (int r = 3; r < 15; r += 2) { ma = max3f(ma, p0[r], p0[r + 1]); mb = max3f(mb, p1[r], p1[r + 1]); }
    float mx = max3f(ma, mb, fmaxf(p0[15], p1[15]));
    mx = halfmax(mx);
    if (__any(mx > SM_THR)) {
        const float d = fmaxf(mx, 0.f), alpha = __builtin_amdgcn_exp2f(-d); st.m += d; st.l *= alpha;
#pragma unroll
        for (int r = 0; r < 16; ++r) { p0[r] -= d; p1[r] -= d; }
#pragma unroll
        for (int dt = 0; dt < NDT; ++dt)
#pragma unroll
            for (int r = 0; r < 16; ++r) st.o[dt][r] *= alpha;
    }
    float rs = 0.f;
#pragma unroll
    for (int r = 0; r < 16; ++r) { p0[r] = __builtin_amdgcn_exp2f(p0[r]); p1[r] = __builtin_amdgcn_exp2f(p1[r]); rs += p0[r] + p1[r]; }
    st.l += rs;
    bf16x8 pw[4]; pack_p(pw, p0, p1);
    if (!VPRE) vfrag_read(f0, vb, 0);
    pv_tile_pre<NDT>(st.o, pw, vb, f0);
}
__device__ __forceinline__ void softmax_stats(float& m, float& l, const f32x16& p0, const f32x16& p1) {
    float mx = fmaxf(p0[0], p1[0]);
#pragma unroll
    for (int r = 1; r < 16; ++r) mx = fmaxf(mx, fmaxf(p0[r], p1[r]));
    mx = halfmax(mx);
    const float mn = fmaxf(m, mx), alpha = __builtin_amdgcn_exp2f(m - mn); m = mn;
    float rs = 0.f;
#pragma unroll
    for (int r = 0; r < 16; ++r) rs += __builtin_amdgcn_exp2f(p0[r] - mn) + __builtin_amdgcn_exp2f(p1[r] - mn);
    l = l * alpha + rs;
}

template <int KCH, int VCH> struct Stage { u32x4 k[KCH / 8], v[VCH / 8], x; };
template <int KCH, int VCH, bool XROW>
__device__ __forceinline__ void stage_load(Stage<KCH, VCH>& sg, const bf16* ksrc, const bf16* vsrc, const float* xsrc, size_t pitch, int key0, int tid) {
#pragma unroll
    for (int i = 0; i < KCH / 8; ++i) { const int idx = tid + 512 * i, key = idx / KCH, c = idx % KCH; sg.k[i] = *(const u32x4*)(ksrc + (size_t)(key0 + key) * pitch + 8 * c); }
#pragma unroll
    for (int i = 0; i < VCH / 8; ++i) { const int idx = tid + 512 * i, key = idx / VCH, c = idx % VCH; sg.v[i] = *(const u32x4*)(vsrc + (size_t)(key0 + key) * pitch + 8 * c); }
    if (XROW) sg.x = *(const u32x4*)(xsrc + key0 + 4 * (tid & 15));
}
template <int KCH, int VCH, bool XROW>
__device__ __forceinline__ void stage_write(const Stage<KCH, VCH>& sg, LAS unsigned char* kb, LAS unsigned char* vb, LAS unsigned char* xb, int tid) {
#pragma unroll
    for (int i = 0; i < KCH / 8; ++i) { const int idx = tid + 512 * i, key = idx / KCH, c = idx % KCH; *(LAS u32x4*)(kb + koff(key, c)) = sg.k[i]; }
#pragma unroll
    for (int i = 0; i < VCH / 8; ++i) { const int idx = tid + 512 * i, key = idx / VCH, c = idx % VCH; *(LAS u32x4*)(vb + voff(key, c)) = sg.v[i]; }
    if (XROW) { if (tid < 16) { f32x4 xv = __builtin_bit_cast(f32x4, sg.x); xv = xv * LOG2E; *(LAS f32x4*)(xb + 16 * tid) = xv; } }
}

template <int KCH, int VCH, bool XROW, int NST  , bool QLDS, class Fn>
__device__ __forceinline__ void kv_loop(Fn& fn, const bf16x8 (&qf)[4], LAS const unsigned char* qb, int kchunk0, const bf16* ksrc, const bf16* vsrc, const float* xsrc, size_t pitch, int t_lo, int t_hi,
                                        LAS unsigned char* KB, LAS unsigned char* VB, LAS unsigned char* XB, int tid, int lane) {
    constexpr int KBYTES = KCH * 1024, VBYTES = VCH * 1024;
    const int r32 = lane & 31, hi = lane >> 5, nt = t_hi - t_lo;
    if (NST == 1) {
        Stage<KCH, VCH> sg;
        stage_load<KCH, VCH, XROW>(sg, ksrc, vsrc, xsrc, pitch, 64 * t_lo, tid);
        stage_write<KCH, VCH, XROW>(sg, KB, VB, XB, tid);
        __syncthreads();
        for (int i = 0; i < nt; ++i) {
            const int b = i & 1;
            if (i + 1 < nt) stage_load<KCH, VCH, XROW>(sg, ksrc, vsrc, xsrc, pitch, 64 * (t_lo + i + 1), tid);
            if (fn.need(t_lo + i)) { f32x16 p0, p1; qk_tile<QLDS>(p0, p1, KB + b * KBYTES, kchunk0, qf, qb, r32, hi); fn.tile(t_lo + i, p0, p1, VB + b * VBYTES, XB + b * 256); }
            if (i + 1 < nt) stage_write<KCH, VCH, XROW>(sg, KB + (b ^ 1) * KBYTES, VB + (b ^ 1) * VBYTES, XB + (b ^ 1) * 256, tid);
            __syncthreads();
        }
        return;
    }
    Stage<KCH, VCH> sgA, sgB;
    stage_load<KCH, VCH, XROW>(sgA, ksrc, vsrc, xsrc, pitch, 64 * t_lo, tid);
    if (nt > 1) stage_load<KCH, VCH, XROW>(sgB, ksrc, vsrc, xsrc, pitch, 64 * (t_lo + 1), tid);
    stage_write<KCH, VCH, XROW>(sgA, KB, VB, XB, tid);
    __syncthreads();
    for (int i = 0; i < nt; i += 2) {
        if (i + 2 < nt) stage_load<KCH, VCH, XROW>(sgA, ksrc, vsrc, xsrc, pitch, 64 * (t_lo + i + 2), tid);
        if (fn.need(t_lo + i)) { f32x16 p0, p1; qk_tile<QLDS>(p0, p1, KB, kchunk0, qf, qb, r32, hi); fn.tile(t_lo + i, p0, p1, VB, XB); }
        if (i + 1 < nt) stage_write<KCH, VCH, XROW>(sgB, KB + KBYTES, VB + VBYTES, XB + 256, tid);
        __syncthreads();
        if (i + 1 >= nt) break;
        if (i + 3 < nt) stage_load<KCH, VCH, XROW>(sgB, ksrc, vsrc, xsrc, pitch, 64 * (t_lo + i + 3), tid);
        if (fn.need(t_lo + i + 1)) { f32x16 p0, p1; qk_tile<QLDS>(p0, p1, KB + KBYTES, kchunk0, qf, qb, r32, hi); fn.tile(t_lo + i + 1, p0, p1, VB + VBYTES, XB + 256); }
        if (i + 2 < nt) stage_write<KCH, VCH, XROW>(sgA, KB, VB, XB, tid);
        __syncthreads();
    }
}

#define SGB(mask, n) __builtin_amdgcn_sched_group_barrier(mask, n, 0)
template <int NDT>
__device__ __forceinline__ void sp_finish(AState<NDT>& st, f32x16& s0, f32x16& s1, bf16x8 (&pw)[4]) {
    float rs = 0.f;
#pragma unroll
    for (int r = 0; r < 16; ++r) { s0[r] = __builtin_amdgcn_exp2f(s0[r]); s1[r] = __builtin_amdgcn_exp2f(s1[r]); rs += s0[r] + s1[r]; }
    st.l += rs;
    pack_p(pw, s0, s1);
}
__device__ __forceinline__ float sp_rowmax(const f32x16& p0, const f32x16& p1) {
    float ma = max3f(p0[0], p0[1], p0[2]), mb = max3f(p1[0], p1[1], p1[2]);
#pragma unroll
    for (int r = 3; r < 15; r += 2) { ma = max3f(ma, p0[r], p0[r + 1]); mb = max3f(mb, p1[r], p1[r + 1]); }
    return max3f(ma, mb, fmaxf(p0[15], p1[15]));
}
template <int NDT>
__device__ __forceinline__ void sp_raise(AState<NDT>& st, f32x16& p0, f32x16& p1, float mx) {
    mx = halfmax(mx);
    if (__any(mx > SM_THR)) {
        const float d = fmaxf(mx, 0.f), alpha = __builtin_amdgcn_exp2f(-d); st.m += d; st.l *= alpha;
#pragma unroll
        for (int r = 0; r < 16; ++r) { p0[r] -= d; p1[r] -= d; }
#pragma unroll
        for (int dt = 0; dt < NDT; ++dt)
#pragma unroll
            for (int r = 0; r < 16; ++r) st.o[dt][r] *= alpha;
    }
}
__device__ __forceinline__ void sp_finish_part(int j, float& rs, f32x16& s0, f32x16& s1, u32x4 (&pu)[4]) {
#pragma unroll
    for (int r = 4 * j; r < 4 * j + 4; ++r) { s0[r] = __builtin_amdgcn_exp2f(s0[r]); s1[r] = __builtin_amdgcn_exp2f(s1[r]); rs += s0[r] + s1[r]; }
    const unsigned a0 = cvtpk(s0[4 * j], s0[4 * j + 1]), a1 = cvtpk(s0[4 * j + 2], s0[4 * j + 3]), b0 = cvtpk(s1[4 * j], s1[4 * j + 1]), b1 = cvtpk(s1[4 * j + 2], s1[4 * j + 3]);
    if (j & 1) { pu[j >> 1].z = a0; pu[j >> 1].w = a1; pu[2 + (j >> 1)].z = b0; pu[2 + (j >> 1)].w = b1; }
    else       { pu[j >> 1].x = a0; pu[j >> 1].y = a1; pu[2 + (j >> 1)].x = b0; pu[2 + (j >> 1)].y = b1; }
}
#define SP_STEADY(T, KBUF, XBUF, SP0, SP1, SN0, SN1)                                                                                                    \
    {   bf16x8 ka[4], kb[4], q[4];                                                                                                                      \
        _Pragma("unroll") for (int d0 = 0; d0 < 4; ++d0) { const int c = kchunk0 + 2 * d0 + hi;                                                         \
            ka[d0] = *(const LAS bf16x8*)((KBUF) + koff(r32, c)); kb[d0] = *(const LAS bf16x8*)((KBUF) + koff(r32 + 32, c));                             \
            q[d0] = QLDS ? *(const LAS bf16x8*)(qb + d0 * 8192) : qf[d0]; }                                                                             \
        LAS const unsigned char* vb = vfrag_base(VB + vp * VBYTES, lane);                                                                               \
        VFrag f0, f1; u32x4 pu[4]; float rs = 0.f;                                                                                                      \
        __builtin_amdgcn_sched_barrier(0);                                                                                                              \
        SN0 = (f32x16){}; SN1 = (f32x16){};                                                                                                             \
        _Pragma("unroll") for (int j = 0; j < 4; ++j) {                                                                                                 \
            SN0 = MFMA32(ka[j], q[j], SN0); SN1 = MFMA32(kb[j], q[j], SN1);                                                                             \
            sp_finish_part(j, rs, SP0, SP1, pu);                                                                                                        \
            if (NDT == 2 && j == 2) vfrag_read(f0, vb, 0);                                                                                              \
            if (NDT == 2 && j == 3) vfrag_read(f1, vb, 1);                                                                                              \
            __builtin_amdgcn_sched_barrier(0);                                                                                                          \
        }                                                                                                                                               \
        fn.st.l += rs;                                                                                                                                  \
        _Pragma("unroll") for (int k = 0; k < 4; ++k) pw[k] = __builtin_bit_cast(bf16x8, pu[k]);                                                        \
        float mx = NEG;                                                                                                                                 \
        _Pragma("unroll") for (int dt = 0; dt < NDT; dt += 2) {                                                                                         \
            if (NDT != 2) { vfrag_read(f0, vb, dt); vfrag_read(f1, vb, dt + 1); __builtin_amdgcn_sched_barrier(0); }                                    \
            _Pragma("unroll") for (int sx = 0; sx < 4; ++sx) {                                                                                          \
                { const bf16x8 vf = (bf16x8){f0.lo[sx][0], f0.lo[sx][1], f0.lo[sx][2], f0.lo[sx][3], f0.hh[sx][0], f0.hh[sx][1], f0.hh[sx][2], f0.hh[sx][3]}; fn.st.o[dt] = MFMA32(vf, pw[sx], fn.st.o[dt]); } \
                { const bf16x8 vf = (bf16x8){f1.lo[sx][0], f1.lo[sx][1], f1.lo[sx][2], f1.lo[sx][3], f1.hh[sx][0], f1.hh[sx][1], f1.hh[sx][2], f1.hh[sx][3]}; fn.st.o[dt + 1] = MFMA32(vf, pw[sx], fn.st.o[dt + 1]); } \
                if (dt == 0) { fn.score_part(sx, T, SN0, SN1, XBUF); mx = fn.max_part(sx, mx, SN0, SN1); }                                              \
                __builtin_amdgcn_sched_barrier(0);                                                                                                      \
            }                                                                                                                                           \
        }                                                                                                                                               \
        mx = fn.score_mask(T, mx, SN0, SN1);                                                                                                            \
        sp_raise<NDT>(fn.st, SN0, SN1, mx); }
template <int KCH, int VCH, bool XROW, bool QLDS, int NDT, class Fn>
__device__ __forceinline__ void kv_loop_sp(Fn& fn, const bf16x8 (&qf)[4], LAS const unsigned char* qb, int kchunk0, const bf16* ksrc, const bf16* vsrc, const float* xsrc, size_t pitch, int t_lo, int t_hi, int nw,
                                           LAS unsigned char* KB, LAS unsigned char* VB, LAS unsigned char* XB, int tid, int lane) {
    constexpr int KBYTES = KCH * 1024, VBYTES = VCH * 1024;
    const int r32 = lane & 31, hi = lane >> 5, nt = t_hi - t_lo;
    Stage<KCH, VCH> sg;
    stage_load<KCH, VCH, XROW>(sg, ksrc, vsrc, xsrc, pitch, 64 * t_lo, tid);
    stage_write<KCH, VCH, XROW>(sg, KB, VB, XB, tid);
    __syncthreads();
    f32x16 sa0, sa1, sb0, sb1; bf16x8 pw[4];
    int vc = 0, vp = 2, vn, i = 0;
#define SP_PRE(I)  if ((I) + 1 < nt) stage_load<KCH, VCH, XROW>(sg, ksrc, vsrc, xsrc, pitch, 64 * (t_lo + (I) + 1), tid);
#define SP_POST(I, KOFFN, XOFFN) vn = vc == 2 ? 0 : vc + 1; if ((I) + 1 < nt) stage_write<KCH, VCH, XROW>(sg, KB + (KOFFN), VB + vn * VBYTES, XB + (XOFFN), tid); __syncthreads(); vp = vc; vc = vn;
    SP_PRE(0)
    qk_tile<QLDS>(sa0, sa1, KB, kchunk0, qf, qb, r32, hi); fn.score(t_lo, sa0, sa1, XB); sp_raise<NDT>(fn.st, sa0, sa1, sp_rowmax(sa0, sa1));
    SP_POST(0, KBYTES, 256)
    i = 1;
    while (i + 1 < nw) {
        SP_PRE(i)
        SP_STEADY(t_lo + i, KB + KBYTES, XB + 256, sa0, sa1, sb0, sb1)
        SP_POST(i, 0, 0)
        SP_PRE(i + 1)
        SP_STEADY(t_lo + i + 1, KB, XB, sb0, sb1, sa0, sa1)
        SP_POST(i + 1, KBYTES, 256)
        i += 2;
    }
    if (i < nw) {
        SP_PRE(i)
        SP_STEADY(t_lo + i, KB + KBYTES, XB + 256, sa0, sa1, sb0, sb1)
        SP_POST(i, 0, 0)
        sa0 = sb0; sa1 = sb1; ++i;
    }
    if (i < nt) { SP_PRE(i) }
    sp_finish<NDT>(fn.st, sa0, sa1, pw); pv_tile<NDT>(fn.st.o, pw, VB + vp * VBYTES, lane);
    if (i < nt) { const int ko = (i & 1) ? 0 : KBYTES, xo = (i & 1) ? 0 : 256; SP_POST(i, ko, xo) ++i; }
    while (i < nt) { const int ko = (i & 1) ? 0 : KBYTES, xo = (i & 1) ? 0 : 256; SP_PRE(i) SP_POST(i, ko, xo) ++i; }
    __syncthreads();
#undef SP_PRE
#undef SP_POST
}

struct FoxFn {
    AState<2> st; float cq; int tq, tmin, tmax, lane;
    __device__ __forceinline__ bool need(int t) const { return 64 * t <= tmax; }
    __device__ __forceinline__ void score_part(int a, int t, f32x16& p0, f32x16& p1, LAS const unsigned char* xrow) {
        const int hi = lane >> 5; LAS const float* ck = (LAS const float*)xrow;
        const float cqm = cq - st.m;
        const f32x4 c0 = *(LAS const f32x4*)(ck + 8 * a + 4 * hi), c1 = *(LAS const f32x4*)(ck + 32 + 8 * a + 4 * hi);
#pragma unroll
        for (int i = 0; i < 4; ++i) { const int r = 4 * a + i; p0[r] = p0[r] * SCL2 + (cqm - c0[i]); p1[r] = p1[r] * SCL2 + (cqm - c1[i]); }
    }
    __device__ __forceinline__ float max_part(int a, float mx, const f32x16& p0, const f32x16& p1) const {
        return max3f(max3f(mx, p0[4 * a], p0[4 * a + 1]), max3f(p0[4 * a + 2], p0[4 * a + 3], p1[4 * a]), max3f(p1[4 * a + 1], p1[4 * a + 2], p1[4 * a + 3])); }
    __device__ __forceinline__ float score_mask(int t, float mx, f32x16& p0, f32x16& p1) const {
        const int hi = lane >> 5, k0 = 64 * t;
        if (k0 + 63 > tmin) {
#pragma unroll
            for (int r = 0; r < 16; ++r) { const int key = k0 + crow(r, hi); p0[r] = key <= tq ? p0[r] : NEG; p1[r] = key + 32 <= tq ? p1[r] : NEG; }
            mx = sp_rowmax(p0, p1);
        }
        return mx;
    }
    __device__ __forceinline__ void score(int t, f32x16& p0, f32x16& p1, LAS const unsigned char* xrow) {
#pragma unroll
        for (int a = 0; a < 4; ++a) score_part(a, t, p0, p1, xrow);
        score_mask(t, 0.f, p0, p1);
    }
};
__device__ __forceinline__ void fox_unit(int h, int qb, const bf16* PROJ, const float* CUM, bf16* MIX, LAS unsigned char* lds, int tid, int wid, int lane) {
    const int r32 = lane & 31, hi = lane >> 5, q0 = 256 * qb, tq = q0 + 32 * wid + r32;
    bf16x8 qf[4];
#pragma unroll
    for (int d0 = 0; d0 < 4; ++d0) qf[d0] = *(const bf16x8*)(PROJ + (size_t)tq * PITCH + C_BQ + 64 * h + 16 * d0 + 8 * hi);
    const float* cum = CUM + (size_t)h * S;
    FoxFn fn; astate_init<2>(fn.st); fn.cq = cum[tq] * LOG2E; fn.tq = tq; fn.tmin = q0 + 32 * wid; fn.tmax = q0 + 32 * wid + 31; fn.lane = lane;
    kv_loop_sp<8, 8, true, false, 2>(fn, qf, lds, 0, PROJ + C_BK + 64 * h, PROJ + C_BV + 64 * h, cum, PITCH, 0, 4 * (qb + 1), min(4 * (qb + 1), (fn.tmax >> 6) + 1), lds, lds + 16384, lds + 40960, tid, lane);
    const float lt = fn.st.l + __shfl_xor(fn.st.l, 32), inv = 1.0f / lt;
    bf16* orow = MIX + (size_t)tq * D + 512 + 64 * h;
#pragma unroll
    for (int dt = 0; dt < 2; ++dt)
#pragma unroll
        for (int a = 0; a < 4; ++a) { u32x2 w; w.x = cvtpk(fn.st.o[dt][4 * a] * inv, fn.st.o[dt][4 * a + 1] * inv); w.y = cvtpk(fn.st.o[dt][4 * a + 2] * inv, fn.st.o[dt][4 * a + 3] * inv);
            *(u32x2*)(orow + 32 * dt + 8 * a + 4 * hi) = w; }
}

struct DiffFn {
    AState<4> st; LAS const float* lut; int tq, tmin, tmax, lane;
    __device__ __forceinline__ bool need(int t) const { return 64 * t <= tmax; }
    __device__ __forceinline__ void tile(int t, f32x16& p0, f32x16& p1, LAS const unsigned char* vt, LAS const unsigned char*) {
        const int hi = lane >> 5, k0 = 64 * t;
        const float mref = st.m;
        if (k0 + 63 + 127 <= tmin) {
            const float b = lut[127] - mref;
#pragma unroll
            for (int r = 0; r < 16; ++r) { p0[r] = p0[r] * SCL2 + b; p1[r] = p1[r] * SCL2 + b; }
        } else {
#pragma unroll
            for (int r = 0; r < 16; ++r) { const int rel0 = tq - (k0 + crow(r, hi)); const float b0 = lut[min(max(rel0, 0), 127)] - mref; p0[r] = rel0 >= 0 ? p0[r] * SCL2 + b0 : NEG; }
            __builtin_amdgcn_sched_barrier(0);
#pragma unroll
            for (int r = 0; r < 16; ++r) { const int rel1 = tq - (k0 + 32 + crow(r, hi)); const float b1 = lut[min(max(rel1, 0), 127)] - mref; p1[r] = rel1 >= 0 ? p1[r] * SCL2 + b1 : NEG; }
            __builtin_amdgcn_sched_barrier(0);
        }
        softmax_pv<4>(st, p0, p1, vt, lane);
    }
};
__device__ __forceinline__ void diff_unit(int h, int qb, int l, const Args& a, const bf16* PROJ, bf16* MIX, LAS unsigned char* lds, int tid, int wid, int lane) {
    const int r32 = lane & 31, hi = lane >> 5, q0 = 128 * qb, map = wid & 1, qs = wid >> 1, tq = q0 + 32 * qs + r32;
    LAS float* lut = (LAS float*)(lds + 65536); LAS float* lamw = (LAS float*)(lds + 65536 + 512);
    const float lam_init = 0.8f - 0.6f * expf(-0.3f * (float)l);
    if (tid < 128) lut[tid] = a.in[12][t5_bucket(tid) * 20 + h] * LOG2E;
    if (wid == 0) { const float* dl = a.in[3] + (size_t)l * 256;
        const float s1 = wave_sum(dl[lane] * dl[64 + lane]), s2 = wave_sum(dl[128 + lane] * dl[192 + lane]);
        if (lane == 0) lamw[0] = expf(s1) - expf(s2) + lam_init; }
    bf16x8 qf[4];
#pragma unroll
    for (int d0 = 0; d0 < 4; ++d0) qf[d0] = *(const bf16x8*)(PROJ + (size_t)tq * PITCH + C_AQ + 128 * h + 64 * map + 16 * d0 + 8 * hi);
    DiffFn fn; astate_init<4>(fn.st); fn.lut = lut; fn.tq = tq; fn.tmin = q0 + 32 * qs; fn.tmax = q0 + 32 * qs + 31; fn.lane = lane;
    LAS unsigned char* const qlds = lds + 67584 + tid * 16;
#pragma unroll
    for (int d0 = 0; d0 < 4; ++d0) *(LAS bf16x8*)(qlds + d0 * 8192) = qf[d0];
    kv_loop<16, 16, false, 1, true>(fn, qf, qlds, 8 * map, PROJ + C_AK + 128 * h, PROJ + C_AV + 128 * h, nullptr, PITCH, 0, 2 * (qb + 1), lds, lds + 32768, lds, tid, lane);
    const float lt = fn.st.l + __shfl_xor(fn.st.l, 32), inv = 1.0f / lt;
    LAS float* ex = (LAS float*)(lds + qs * 16384);
    if (map == 1) {
#pragma unroll
        for (int dt = 0; dt < 4; ++dt)
#pragma unroll
            for (int r = 0; r < 16; ++r) ex[(32 * dt + crow(r, hi)) * 32 + r32] = fn.st.o[dt][r] * inv;
    }
    __syncthreads();
    if (map == 0) {
        const float lam = lamw[0]; float ss = 0.f;
#pragma unroll
        for (int dt = 0; dt < 4; ++dt)
#pragma unroll
            for (int r = 0; r < 16; ++r) { const float v = fn.st.o[dt][r] * inv - lam * ex[(32 * dt + crow(r, hi)) * 32 + r32]; fn.st.o[dt][r] = v; ss += v * v; }
        ss += __shfl_xor(ss, 32);
        const float rstd = (1.0f / sqrtf(ss * (1.0f / 128.0f) + RMS_EPS)) * (1.0f - lam_init);
        const float* sub = a.in[4] + (size_t)l * 128; bf16* orow = MIX + (size_t)tq * D + 128 * h;
#pragma unroll
        for (int dt = 0; dt < 4; ++dt)
#pragma unroll
            for (int q4 = 0; q4 < 4; ++q4) { const int d = 32 * dt + 8 * q4 + 4 * hi; const f32x4 g = *(const f32x4*)(sub + d);
                u32x2 w; w.x = cvtpk(fn.st.o[dt][4 * q4] * rstd * g.x, fn.st.o[dt][4 * q4 + 1] * rstd * g.y); w.y = cvtpk(fn.st.o[dt][4 * q4 + 2] * rstd * g.z, fn.st.o[dt][4 * q4 + 3] * rstd * g.w);
                *(u32x2*)(orow + d) = w; }
    }
    __syncthreads();
}

#ifndef NSA_DUP
#define NSA_DUP 0
#endif
constexpr int IMP_P = 132;
__device__ __forceinline__ float quad_sum(float v) {
    v += __builtin_bit_cast(float, __builtin_amdgcn_mov_dpp(__builtin_bit_cast(int, v), 0xB1, 0xF, 0xF, true));
    v += __builtin_bit_cast(float, __builtin_amdgcn_mov_dpp(__builtin_bit_cast(int, v), 0x4E, 0xF, 0xF, true));
    return v; }
#define LADD(p, v) (void)__hip_atomic_fetch_add((p), (v), __ATOMIC_RELAXED, __HIP_MEMORY_SCOPE_WORKGROUP)
constexpr int NSA_QF = 32768, NSA_SELW = 65536, NSA_LUT = 66560, NSA_IMP = 69632, NSA_FIN = 69632;

struct CmpStatFn {
    float m, l; int tq, lane, ncnt;
    __device__ __forceinline__ bool need(int) const { return true; }
    __device__ __forceinline__ void tile(int t, f32x16& p0, f32x16& p1, LAS const unsigned char*, LAS const unsigned char*) {
        const int hi = lane >> 5, n0 = 64 * t;
#pragma unroll
        for (int r = 0; r < 16; ++r) { const int n = n0 + crow(r, hi);
            p0[r] = (16 * n + 31 <= tq) ? p0[r] * SCL2 : NEG; p1[r] = (16 * (n + 32) + 31 <= tq) ? p1[r] * SCL2 : NEG; }
        softmax_stats(m, l, p0, p1);
    }
};
struct CmpPvFn {
    f32x16 o[2]; float m, invl; int tq, ql, lane; LAS float* imp;
    __device__ __forceinline__ bool need(int) const { return true; }
    __device__ __forceinline__ void tile(int t, f32x16& p0, f32x16& p1, LAS const unsigned char* vt, LAS const unsigned char*) {
        const int hi = lane >> 5, n0 = 64 * t;
#pragma unroll
        for (int r = 0; r < 16; ++r) { const int n = n0 + crow(r, hi);
            p0[r] = (16 * n + 31 <= tq) ? __builtin_amdgcn_exp2f(p0[r] * SCL2 - m) * invl : 0.f;
            p1[r] = (16 * (n + 32) + 31 <= tq) ? __builtin_amdgcn_exp2f(p1[r] * SCL2 - m) * invl : 0.f; }
        LAS float* row = imp + ql * IMP_P;
        const bool lead = (lane & 3) == 0;
#pragma unroll
        for (int a = 0; a < 4; ++a) {
            const int j0 = (n0 >> 2) + 2 * a + hi, j1 = j0 + 8;
            const float h0 = quad_sum(0.5f * p0[4 * a + 3]), h1 = quad_sum(0.5f * p1[4 * a + 3]);
            const float b0 = quad_sum(p0[4 * a] + p0[4 * a + 1] + p0[4 * a + 2]) + h0, b1 = quad_sum(p1[4 * a] + p1[4 * a + 1] + p1[4 * a + 2]) + h1;
            if (lead) {
                LADD(row + j0, b0);
                if (j0 + 1 < 128) LADD(row + j0 + 1, h0);
                if (j1 < 128) LADD(row + j1, b1);
                if (j1 + 1 < 128) LADD(row + j1 + 1, h1);
            }
        }
        bf16x8 pw[4]; pack_p(pw, p0, p1);
        pv_tile<2>(o, pw, vt, lane);
    }
};
struct SelFn {
    AState<2> st; LAS const float* lut; int tq, tmin, tmax, lane, mode; unsigned sw0, sw1, sw2, sw3, uw0, uw1, uw2, uw3;
    __device__ __forceinline__ unsigned pick(int j, unsigned a, unsigned b, unsigned c, unsigned d) const { const int w = j >> 5; const unsigned x = (w == 0) ? a : (w == 1) ? b : (w == 2) ? c : d; return (x >> (j & 31)) & 1u; }
    __device__ __forceinline__ bool need(int t) const { return mode == 1 || pick(t, uw0, uw1, uw2, uw3) != 0u; }
    __device__ __forceinline__ void tile(int t, f32x16& p0, f32x16& p1, LAS const unsigned char* vt, LAS const unsigned char*) {
        const int hi = lane >> 5, k0 = 64 * t;
        const bool bit = (mode == 1) || pick(t, sw0, sw1, sw2, sw3) != 0u;
        const bool far = k0 + 63 + 127 <= tmin;
        const bool wcut = (mode == 1) && (tmax - k0 >= 512);
        const float mref = st.m;
        if (far && !wcut) {
            const float b = lut[127] - mref;
#pragma unroll
            for (int r = 0; r < 16; ++r) { p0[r] = bit ? p0[r] * SCL2 + b : NEG; p1[r] = bit ? p1[r] * SCL2 + b : NEG; }
        } else {
#pragma unroll
            for (int r = 0; r < 16; ++r) { const int rel0 = tq - (k0 + crow(r, hi));
                const float b0 = lut[min(max(rel0, 0), 127)] - mref;
                const bool ok0 = bit && rel0 >= 0 && (mode == 0 || rel0 < 512);
                p0[r] = ok0 ? p0[r] * SCL2 + b0 : NEG; }
            __builtin_amdgcn_sched_barrier(0);
#pragma unroll
            for (int r = 0; r < 16; ++r) { const int rel1 = tq - (k0 + 32 + crow(r, hi));
                const float b1 = lut[min(max(rel1, 0), 127)] - mref;
                const bool ok1 = bit && rel1 >= 0 && (mode == 0 || rel1 < 512);
                p1[r] = ok1 ? p1[r] * SCL2 + b1 : NEG; }
            __builtin_amdgcn_sched_barrier(0);
        }
        softmax_pv<2>(st, p0, p1, vt, lane);
    }
};

__device__ __forceinline__ void nsa_unit(int g, int qb, const Args& a, const bf16* PROJ, const float* AUX, const bf16* KC, const bf16* VC, bf16* MIX, LAS unsigned char* lds, int tid, int wid, int lane) {
    const int r32 = lane & 31, hi = lane >> 5, q0 = 64 * qb, cur = qb, ql = 8 * wid + (r32 >> 2), hp = r32 & 3, tq = q0 + ql, head = 4 * g + hp;
    LAS float* imp = (LAS float*)(lds + NSA_IMP); LAS unsigned* selw = (LAS unsigned*)(lds + NSA_SELW); LAS float* lut = (LAS float*)(lds + NSA_LUT);
#pragma unroll
    for (int i = 0; i < 17; ++i) { const int e_ = tid + 512 * i; if (e_ < 64 * IMP_P) imp[e_] = 0.f; }
    if (tid < 256) selw[tid] = 0u;
    lut[tid] = a.in[12][t5_bucket(tid & 127) * 20 + 4 + 4 * g + (tid >> 7)] * LOG2E;
    bf16x8 qf[4];
#pragma unroll
    for (int d0 = 0; d0 < 4; ++d0) qf[d0] = *(const bf16x8*)(PROJ + (size_t)tq * PITCH + C_CQ + 64 * head + 16 * d0 + 8 * hi);
    LAS unsigned char* const qlds = lds + NSA_QF + tid * 16;
#pragma unroll
    for (int d0 = 0; d0 < 4; ++d0) *(LAS bf16x8*)(qlds + d0 * 8192) = qf[d0];
    const float* ga = AUX + (size_t)tq * 64 + 8 + head;
    const float gc = 1.0f / (1.0f + __expf(-ga[0])), gs = 1.0f / (1.0f + __expf(-ga[16])), gwn = 1.0f / (1.0f + __expf(-ga[32]));
    LAS float* finl = (LAS float*)(lds + NSA_FIN) + tid;
    f32x16 oc0, oc1;
    {
        int ncnt = (q0 + 32) / 16 + 1; ncnt = ncnt > 511 ? 511 : ncnt; const int ntc = (ncnt + 63) >> 6;
        const bf16* kc = KC + (size_t)g * 512 * 64; const bf16* vc = VC + (size_t)g * 512 * 64;
        CmpStatFn f1; f1.m = NEG; f1.l = 0.f; f1.tq = tq; f1.lane = lane; f1.ncnt = ncnt;
        kv_loop<8, 8, false, 1, true>(f1, qf, qlds, 0, kc, vc, nullptr, 64, 0, ntc, lds, lds + 16384, lds, tid, lane);
        if (NSA_DUP & 1) { f1.m = NEG; f1.l = 0.f; kv_loop<8, 8, false, 1, true>(f1, qf, qlds, 0, kc, vc, nullptr, 64, 0, ntc, lds, lds + 16384, lds, tid, lane); }
        const float lt = f1.l + __shfl_xor(f1.l, 32);
        CmpPvFn f2; f2.o[0] = (f32x16){}; f2.o[1] = (f32x16){}; f2.m = f1.m; f2.invl = (tq >= 31) ? 1.0f / lt : 0.f; f2.tq = tq; f2.ql = ql; f2.lane = lane; f2.imp = imp;
        if (NSA_DUP & 16) { kv_loop<8, 8, false, 1, true>(f2, qf, qlds, 0, kc, vc, nullptr, 64, 0, ntc, lds, lds + 16384, lds, tid, lane); f2.o[0] = (f32x16){}; f2.o[1] = (f32x16){};
#pragma unroll
            for (int i = 0; i < 17; ++i) { const int e_ = tid + 512 * i; if (e_ < 64 * IMP_P) imp[e_] = 0.f; }
            __syncthreads(); }
        kv_loop<8, 8, false, 1, true>(f2, qf, qlds, 0, kc, vc, nullptr, 64, 0, ntc, lds, lds + 16384, lds, tid, lane);
        oc0 = f2.o[0]; oc1 = f2.o[1];
    }
    for (int rep_ = 0; rep_ < ((NSA_DUP & 2) ? 2 : 1); ++rep_)
    if (cur < 16) { if (tid < 64) selw[tid * 4] = (2u << cur) - 1u; }
    else {
        const int qq = tid >> 3, sub = tid & 7;
        float val[16];
#pragma unroll
        for (int i = 0; i < 16; ++i) { const int j = 16 * sub + i; val[i] = (j >= 1 && j <= cur - 2) ? imp[qq * IMP_P + j] : -1.0f; }
        unsigned bits = 0u;
        for (int round = 0; round < 13; ++round) {
            float bv = val[0]; int bi = 0;
#pragma unroll
            for (int i = 1; i < 16; ++i) if (val[i] > bv) { bv = val[i]; bi = i; }
            int gj = 16 * sub + bi;
            { const float ov = __builtin_bit_cast(float, __builtin_amdgcn_mov_dpp(__builtin_bit_cast(int, bv), 0xB1, 0xF, 0xF, true)); const int oj = __builtin_amdgcn_mov_dpp(gj, 0xB1, 0xF, 0xF, true); if (ov > bv || (ov == bv && oj < gj)) { bv = ov; gj = oj; } }
            { const float ov = __builtin_bit_cast(float, __builtin_amdgcn_mov_dpp(__builtin_bit_cast(int, bv), 0x4E, 0xF, 0xF, true)); const int oj = __builtin_amdgcn_mov_dpp(gj, 0x4E, 0xF, 0xF, true); if (ov > bv || (ov == bv && oj < gj)) { bv = ov; gj = oj; } }
            { const float ov = __shfl_xor(bv, 4); const int oj = __shfl_xor(gj, 4); if (ov > bv || (ov == bv && oj < gj)) { bv = ov; gj = oj; } }
            const bool mine = (gj >> 4) == sub;
#pragma unroll
            for (int i = 0; i < 16; ++i) if (mine && (gj & 15) == i) { val[i] = -2.0f; bits |= 1u << i; }
        }
        if (sub == 0) bits |= 1u;
        if (((cur - 1) >> 4) == sub) bits |= 1u << ((cur - 1) & 15);
        if ((cur >> 4) == sub) bits |= 1u << (cur & 15);
        (void)__hip_atomic_fetch_or(selw + qq * 4 + (sub >> 1), bits << (16 * (sub & 1)), __ATOMIC_RELAXED, __HIP_MEMORY_SCOPE_WORKGROUP);
    }
    __syncthreads();
#pragma unroll
    for (int r = 0; r < 16; ++r) { finl[512 * r] = gc * oc0[r]; finl[512 * (16 + r)] = gc * oc1[r]; }
    SelFn fs; fs.lut = lut + hp * 128; fs.tq = tq; fs.tmin = q0 + 8 * wid; fs.tmax = q0 + 8 * wid + 7; fs.lane = lane;
    fs.sw0 = selw[ql * 4 + 0]; fs.sw1 = selw[ql * 4 + 1]; fs.sw2 = selw[ql * 4 + 2]; fs.sw3 = selw[ql * 4 + 3];
    { unsigned u0 = 0u, u1 = 0u, u2 = 0u, u3 = 0u;
#pragma unroll
      for (int i = 0; i < 8; ++i) { u0 |= selw[(8 * wid + i) * 4 + 0]; u1 |= selw[(8 * wid + i) * 4 + 1]; u2 |= selw[(8 * wid + i) * 4 + 2]; u3 |= selw[(8 * wid + i) * 4 + 3]; }
      fs.uw0 = __builtin_amdgcn_readfirstlane(u0); fs.uw1 = __builtin_amdgcn_readfirstlane(u1); fs.uw2 = __builtin_amdgcn_readfirstlane(u2); fs.uw3 = __builtin_amdgcn_readfirstlane(u3); }
    fs.mode = 0; astate_init<2>(fs.st);
    kv_loop<8, 8, false, 1, false>(fs, qf, qlds, 0, PROJ + C_KS + 64 * g, PROJ + C_VS + 64 * g, nullptr, PITCH, 0, cur + 1, lds, lds + 16384, lds, tid, lane);
    if (NSA_DUP & 4) { astate_init<2>(fs.st); kv_loop<8, 8, false, 1, false>(fs, qf, qlds, 0, PROJ + C_KS + 64 * g, PROJ + C_VS + 64 * g, nullptr, PITCH, 0, cur + 1, lds, lds + 16384, lds, tid, lane); }
    { const float lt = fs.st.l + __shfl_xor(fs.st.l, 32), sc = gs / lt;
#pragma unroll
      for (int r = 0; r < 16; ++r) { finl[512 * r] += sc * fs.st.o[0][r]; finl[512 * (16 + r)] += sc * fs.st.o[1][r]; } }
    fs.mode = 1; astate_init<2>(fs.st);
    kv_loop<8, 8, false, 1, false>(fs, qf, qlds, 0, PROJ + C_KW + 64 * g, PROJ + C_VW + 64 * g, nullptr, PITCH, cur >= 8 ? cur - 8 : 0, cur + 1, lds, lds + 16384, lds, tid, lane);
    if (NSA_DUP & 8) { astate_init<2>(fs.st); kv_loop<8, 8, false, 1, false>(fs, qf, qlds, 0, PROJ + C_KW + 64 * g, PROJ + C_VW + 64 * g, nullptr, PITCH, cur >= 8 ? cur - 8 : 0, cur + 1, lds, lds + 16384, lds, tid, lane); }
    { const float lt = fs.st.l + __shfl_xor(fs.st.l, 32), sc = gwn / lt;
#pragma unroll
      for (int r = 0; r < 16; ++r) { fs.st.o[0][r] = finl[512 * r] + sc * fs.st.o[0][r]; fs.st.o[1][r] = finl[512 * (16 + r)] + sc * fs.st.o[1][r]; } }
    bf16* orow = MIX + (size_t)tq * D + 1024 + 64 * head;
#pragma unroll
    for (int dt = 0; dt < 2; ++dt)
#pragma unroll
        for (int q4 = 0; q4 < 4; ++q4) { u32x2 w; w.x = cvtpk(fs.st.o[dt][4 * q4], fs.st.o[dt][4 * q4 + 1]); w.y = cvtpk(fs.st.o[dt][4 * q4 + 2], fs.st.o[dt][4 * q4 + 3]); *(u32x2*)(orow + 32 * dt + 8 * q4 + 4 * hi) = w; }
}

__device__ __forceinline__ int dequeue(unsigned* head, volatile LAS unsigned* slot, int tid) {
    if (tid == 0) *slot = __hip_atomic_fetch_add(head, 1u, __ATOMIC_RELAXED, __HIP_MEMORY_SCOPE_AGENT);
    __syncthreads();
    const int v = __builtin_amdgcn_readfirstlane((int)*slot);
    __syncthreads();
    return v;
}

constexpr int N2_HP = 4112, N2_PART = 66 * 1024, N2_LOG = 108 * 1024;
__device__ __forceinline__ void n2_unit(int u, int l, const Args& a, const bf16* X, bf16* XN, const bf16* RWT, unsigned* cnt, int* LIST, float* TW, LAS unsigned char* lds, int tid, int wid, int lane) {
    const float* gain = a.in[14] + (size_t)l * D;
#pragma unroll
    for (int rr = 0; rr < 2; ++rr) {
        const int lr = 2 * wid + rr, row = 16 * u + lr;
        const u32x2* xr = (const u32x2*)(X + (size_t)row * D) + lane;
        f32x4 v[8]; float ss = 0.f;
#pragma unroll
        for (int j = 0; j < 8; ++j) { const u32x2 r = xr[64 * j]; v[j] = (f32x4){bflo(r.x), bfhi(r.x), bflo(r.y), bfhi(r.y)}; ss += (v[j].x * v[j].x + v[j].y * v[j].y) + (v[j].z * v[j].z + v[j].w * v[j].w); }
        ss = wave_sum(ss);
        const float rstd = 1.0f / sqrtf(ss * (1.0f / D) + RMS_EPS);
        const f32x4* gr = (const f32x4*)gain + lane; u32x2* o8 = (u32x2*)(XN + (size_t)row * D) + lane;
#pragma unroll
        for (int j = 0; j < 8; ++j) { const f32x4 g = gr[64 * j]; u32x2 w; w.x = cvtpk(v[j].x * rstd * g.x, v[j].y * rstd * g.y); w.y = cvtpk(v[j].z * rstd * g.z, v[j].w * rstd * g.w);
            o8[64 * j] = w; *(LAS u32x2*)(lds + lr * N2_HP + (4 * lane + 256 * j) * 2) = w; }
    }
    __syncthreads();
    {
        const int fr = lane & 15, fq = lane >> 4;
        f32x4 acc[5];
#pragma unroll
        for (int nt = 0; nt < 5; ++nt) acc[nt] = (f32x4){0.f, 0.f, 0.f, 0.f};
        const bf16* rw = RWT + (size_t)l * 96 * D + (size_t)fr * D + 256 * wid + 8 * fq;
#pragma unroll
        for (int s = 0; s < 8; ++s) {
            const bf16x8 av = *(const LAS bf16x8*)(lds + fr * N2_HP + (256 * wid + 32 * s + 8 * fq) * 2);
#pragma unroll
            for (int nt = 0; nt < 5; ++nt) { const bf16x8 bv = *(const bf16x8*)(rw + (size_t)(16 * nt) * D + 32 * s); acc[nt] = MFMA16(av, bv, acc[nt]); }
        }
        LAS float* part = (LAS float*)(lds + N2_PART) + wid * 16 * 80;
#pragma unroll
        for (int nt = 0; nt < 5; ++nt)
#pragma unroll
            for (int i = 0; i < 4; ++i) part[(4 * fq + i) * 80 + 16 * nt + fr] = acc[nt][i];
    }
    __syncthreads();
    {
        LAS const float* part = (LAS const float*)(lds + N2_PART); LAS float* logit = (LAS float*)(lds + N2_LOG);
        for (int e = tid; e < 16 * 80; e += NTHR) { float s = 0.f;
#pragma unroll
            for (int w = 0; w < 8; ++w) s += part[w * 16 * 80 + e];
            logit[e] = s; }
    }
    __syncthreads();
    if (tid < 16) {
        LAS const float* lg = (LAS const float*)(lds + N2_LOG) + tid * 80;
        const float* bg = a.in[16] + l * 8; const float* be = a.in[18] + l * 64;
        float z[8]; float zm = -3.0e38f; int gi = 0;
#pragma unroll
        for (int i = 0; i < 8; ++i) { z[i] = lg[i] + bg[i]; if (z[i] > zm) { zm = z[i]; gi = i; } }
        float den = 0.f;
#pragma unroll
        for (int i = 0; i < 8; ++i) den += expf(z[i] - zm);
        const float gp = 1.0f / den;
        float e1 = -3.0e38f, e2 = -3.0e38f; int i1 = 0, i2 = 0;
#pragma unroll
        for (int i = 0; i < 8; ++i) { const float v = lg[8 + 8 * gi + i] + be[8 * gi + i];
            if (v > e1) { e2 = e1; i2 = i1; e1 = v; i1 = i; } else if (v > e2) { e2 = v; i2 = i; } }
        const float t2 = expf(e2 - e1), w1 = gp / (1.0f + t2), w2 = gp * t2 / (1.0f + t2);
        const int tok = 16 * u + tid, ea = 8 * gi + i1, eb = 8 * gi + i2;
        const unsigned pa = __hip_atomic_fetch_add(cnt + ea * 16, 1u, __ATOMIC_RELAXED, __HIP_MEMORY_SCOPE_AGENT);
        const unsigned pb = __hip_atomic_fetch_add(cnt + eb * 16, 1u, __ATOMIC_RELAXED, __HIP_MEMORY_SCOPE_AGENT);
        LIST[(size_t)ea * 16384 + pa] = 2 * tok; LIST[(size_t)eb * 16384 + pb] = 2 * tok + 1;
        TW[2 * tok] = w1; TW[2 * tok + 1] = w2;
    }
    __syncthreads();
}

constexpr int N2P_HALF = 16 * N2_HP, N2P_LOG = 2 * N2P_HALF;
__device__ __forceinline__ void n2_pair(int p, int l, const Args& a, const bf16* X, bf16* XN, const bf16* RWT, unsigned* cnt, int* LIST, float* TW, LAS unsigned char* lds, int tid, int wid, int lane) {
    const int half = wid >> 2, wl = wid & 3, u = 2 * p + half, th = tid & 255;
    LAS unsigned char* const hT = lds + half * N2P_HALF;
    const float* gain = a.in[14] + (size_t)l * D;
    {
        u32x2 raw[4][8];
#pragma unroll
        for (int rr = 0; rr < 4; ++rr) { const u32x2* xr = (const u32x2*)(X + (size_t)(16 * u + 4 * wl + rr) * D) + lane;
#pragma unroll
            for (int j = 0; j < 8; ++j) raw[rr][j] = xr[64 * j]; }
        f32x4 g[8]; { const f32x4* gr = (const f32x4*)gain + lane;
#pragma unroll
            for (int j = 0; j < 8; ++j) g[j] = gr[64 * j]; }
#pragma unroll
        for (int rr = 0; rr < 4; ++rr) {
            const int lr = 4 * wl + rr, row = 16 * u + lr;
            f32x4 v[8]; float ss = 0.f;
#pragma unroll
            for (int j = 0; j < 8; ++j) { const u32x2 r = raw[rr][j]; v[j] = (f32x4){bflo(r.x), bfhi(r.x), bflo(r.y), bfhi(r.y)}; ss += (v[j].x * v[j].x + v[j].y * v[j].y) + (v[j].z * v[j].z + v[j].w * v[j].w); }
            ss = wave_sum(ss);
            const float rstd = 1.0f / sqrtf(ss * (1.0f / D) + RMS_EPS);
            u32x2* o8 = (u32x2*)(XN + (size_t)row * D) + lane;
#pragma unroll
            for (int j = 0; j < 8; ++j) { u32x2 w; w.x = cvtpk(v[j].x * rstd * g[j].x, v[j].y * rstd * g[j].y); w.y = cvtpk(v[j].z * rstd * g[j].z, v[j].w * rstd * g[j].w);
                o8[64 * j] = w; *(LAS u32x2*)(hT + lr * N2_HP + (4 * lane + 256 * j) * 2) = w; }
        }
    }
    __syncthreads();
    const int fr = lane & 15, fq = lane >> 4;
    f32x4 acc[2][5];
#pragma unroll
    for (int hh = 0; hh < 2; ++hh)
#pragma unroll
        for (int nt = 0; nt < 5; ++nt) acc[hh][nt] = (f32x4){0.f, 0.f, 0.f, 0.f};
    {
        const bf16* rw = RWT + (size_t)l * 96 * D + (size_t)fr * D + 256 * wid + 8 * fq;
#pragma unroll 4
        for (int s = 0; s < 8; ++s) {
            const bf16x8 av0 = *(const LAS bf16x8*)(lds + fr * N2_HP + (256 * wid + 32 * s + 8 * fq) * 2);
            const bf16x8 av1 = *(const LAS bf16x8*)(lds + N2P_HALF + fr * N2_HP + (256 * wid + 32 * s + 8 * fq) * 2);
#pragma unroll
            for (int nt = 0; nt < 5; ++nt) { const bf16x8 bv = *(const bf16x8*)(rw + (size_t)(16 * nt) * D + 32 * s); acc[0][nt] = MFMA16(av0, bv, acc[0][nt]); acc[1][nt] = MFMA16(av1, bv, acc[1][nt]); }
        }
    }
    __syncthreads();
    {
        LAS float* part = (LAS float*)lds + wid * 32 * 80;
#pragma unroll
        for (int hh = 0; hh < 2; ++hh)
#pragma unroll
            for (int nt = 0; nt < 5; ++nt)
#pragma unroll
                for (int i = 0; i < 4; ++i) part[(16 * hh + 4 * fq + i) * 80 + 16 * nt + fr] = acc[hh][nt][i];
    }
    __syncthreads();
    {
        LAS const float* part = (LAS const float*)lds; LAS float* logit = (LAS float*)(lds + N2P_LOG);
        for (int e = tid; e < 32 * 80; e += NTHR) { float sres = 0.f;
#pragma unroll
            for (int w = 0; w < 8; ++w) sres += part[w * 32 * 80 + e];
            logit[e] = sres; }
    }
    __syncthreads();
    if (th < 16) {
        LAS const float* lg = (LAS const float*)(lds + N2P_LOG) + (16 * half + th) * 80;
        const float* bg = a.in[16] + l * 8; const float* be = a.in[18] + l * 64;
        float z[8]; float zm = -3.0e38f; int gi = 0;
#pragma unroll
        for (int i = 0; i < 8; ++i) { z[i] = lg[i] + bg[i]; if (z[i] > zm) { zm = z[i]; gi = i; } }
        float den = 0.f;
#pragma unroll
        for (int i = 0; i < 8; ++i) den += expf(z[i] - zm);
        const float gp = 1.0f / den;
        float e1 = -3.0e38f, e2 = -3.0e38f; int i1 = 0, i2 = 0;
#pragma unroll
        for (int i = 0; i < 8; ++i) { const float v = lg[8 + 8 * gi + i] + be[8 * gi + i];
            if (v > e1) { e2 = e1; i2 = i1; e1 = v; i1 = i; } else if (v > e2) { e2 = v; i2 = i; } }
        const float t2 = expf(e2 - e1), w1 = gp / (1.0f + t2), w2 = gp * t2 / (1.0f + t2);
        const int tok = 16 * u + th, ea = 8 * gi + i1, eb = 8 * gi + i2;
        const unsigned pa = __hip_atomic_fetch_add(cnt + ea * 16, 1u, __ATOMIC_RELAXED, __HIP_MEMORY_SCOPE_AGENT);
        const unsigned pb = __hip_atomic_fetch_add(cnt + eb * 16, 1u, __ATOMIC_RELAXED, __HIP_MEMORY_SCOPE_AGENT);
        LIST[(size_t)ea * 16384 + pa] = 2 * tok; LIST[(size_t)eb * 16384 + pb] = 2 * tok + 1;
        TW[2 * tok] = w1; TW[2 * tok + 1] = w2;
    }
    __syncthreads();
}

constexpr int MO_B = 65536, MO_BBUF = 16384, MO_A = 98304, MO_APITCH = 2176, MO_ABUF = 4 * MO_APITCH, MO_ROW = MO_A + 2 * MO_ABUF, MO_PRE = MO_ROW + 512;
constexpr int MO_STG = 117760;
static_assert(MO_PRE + 272 <= MO_STG && MO_STG + 8 * 4096 <= MISC_OFF, "MoE LDS map");
__device__ __forceinline__ int mo_aoff(int row, int c) { return c * MO_APITCH + ((row + 2 * c) << 4); }
__device__ __forceinline__ int mo_hoff(int row, int c) { return c * 2048 + (row << 4); }

struct MoBStage { f32x4 v[4]; };
__device__ __forceinline__ void mo_gl16(f32x4& d, const float* p) { asm volatile("global_load_dwordx4 %0, %1, off" : "=v"(d) : "v"(p) : "memory"); }
__device__ __forceinline__ void mo_gl16u(u32x4& d, const bf16* p) { asm volatile("global_load_dwordx4 %0, %1, off" : "=v"(d) : "v"(p) : "memory"); }
__device__ __forceinline__ void mo_bload(MoBStage& sg, const float* src0, const float* src1, size_t ld, int k0, int tid) {
    const int n4 = tid & 63, kg = tid >> 6;
    const float* p = (n4 < 32 ? src0 + 4 * n4 : src1 + 4 * (n4 - 32)) + (size_t)(k0 + 4 * kg) * ld;
    mo_gl16(sg.v[0], p); mo_gl16(sg.v[1], p + ld); mo_gl16(sg.v[2], p + 2 * ld); mo_gl16(sg.v[3], p + 3 * ld);
}
#define MO_WAIT5(N, SB, SA) asm volatile("s_waitcnt vmcnt(" #N ")" : "+v"(SB.v[0]), "+v"(SB.v[1]), "+v"(SB.v[2]), "+v"(SB.v[3]), "+v"(SA) :: "memory")
#define MO_WAIT4(N, SB) asm volatile("s_waitcnt vmcnt(" #N ")" : "+v"(SB.v[0]), "+v"(SB.v[1]), "+v"(SB.v[2]), "+v"(SB.v[3]) :: "memory")
__device__ __forceinline__ void mo_bwrite(const MoBStage& sg, LAS unsigned char* bb, int tid) {
    const int n4 = tid & 63, kg = tid >> 6;
#pragma unroll
    for (int i = 0; i < 4; ++i) { u32x2 w; w.x = cvtpk(sg.v[0][i], sg.v[1][i]); w.y = cvtpk(sg.v[2][i], sg.v[3][i]);
        *(LAS u32x2*)(bb + (kg >> 1) * 4096 + (32 * (n4 >> 3) + 8 * i + (n4 & 7)) * 16 + 8 * (kg & 1)) = w; }
}
#define MO_READ(AP, ASTEP, BP, B1OFF) bf16x8 fb0_[2], fb1_[2], fa_[2][2]; \
    _Pragma("unroll") for (int s_ = 0; s_ < 2; ++s_) { fb0_[s_] = *(const LAS bf16x8*)((BP) + s_ * 8192); fb1_[s_] = *(const LAS bf16x8*)((BP) + s_ * 8192 + (B1OFF)); \
        _Pragma("unroll") for (int mt = 0; mt < 2; ++mt) fa_[s_][mt] = *(const LAS bf16x8*)((AP) + s_ * (ASTEP) + mt * 512); } \
    __builtin_amdgcn_sched_barrier(0)
#define MO_MMA(ACC0, ACC1) do { __builtin_amdgcn_sched_barrier(0); _Pragma("unroll") for (int s_ = 0; s_ < 2; ++s_) _Pragma("unroll") for (int mt = 0; mt < 2; ++mt) { \
        ACC0[mt] = MFMA32(fa_[s_][mt], fb0_[s_], ACC0[mt]); ACC1[mt] = MFMA32(fa_[s_][mt], fb1_[s_], ACC1[mt]); } __builtin_amdgcn_sched_barrier(0); } while (0)

__device__ __forceinline__ void moe_unit(int e, int c0, int nrows, const bf16* XN, const int* LIST, const float* Wg, const float* Wu, const float* Wd, bf16* YB, LAS unsigned char* lds, int tid, int wid, int lane) {
    const int r32 = lane & 31, hi = lane >> 5, wn = wid & 3, wm = wid >> 2;
    LAS int* rowid = (LAS int*)(lds + MO_ROW);
    if (tid < 128) rowid[tid] = (tid < nrows) ? LIST[(size_t)e * 16384 + c0 + tid] : -1;
    __syncthreads();
    const float* wg = Wg + (size_t)e * D * 256; const float* wu = Wu + (size_t)e * D * 256; const float* wd = Wd + (size_t)e * 256 * D;
    f32x16 acc0[2], acc1[2];
#define MO_ZERO() do { acc0[0] = (f32x16){}; acc0[1] = (f32x16){}; acc1[0] = (f32x16){}; acc1[1] = (f32x16){}; } while (0)
    MO_ZERO();
    MoBStage s0, s1, s2, s3; u32x4 a0, a1, a2, a3;
    {
        const int arow = tid >> 2, ac = tid & 3; const int rid = rowid[arow]; const bf16* asrc = XN + (size_t)((rid < 0 ? 0 : rid) >> 1) * D + 8 * ac;
        LAS unsigned char* const awr = lds + MO_A + mo_aoff(arow, ac);
        LAS const unsigned char* const ard = lds + MO_A + mo_aoff(64 * wm + r32, hi);
        LAS const unsigned char* const brd = lds + MO_B + hi * 4096 + (32 * wn + r32) * 16;
#define G1_LOAD(SB, SA, t) do { const int t_ = (t); mo_gl16u(SA, asrc + 32 * (t_ & 63)); mo_bload(SB, wg + 128 * (t_ >> 6), wu + 128 * (t_ >> 6), 256, 32 * (t_ & 63), tid); } while (0)
#define G1_WRITE(SB, SA, b) do { *(LAS u32x4*)(awr + (b) * MO_ABUF) = SA; mo_bwrite(SB, lds + MO_B + (b) * MO_BBUF, tid); } while (0)
#define G1_STEP(t, b, SBL, SAL, SBW, SAW) do { const int tt_ = (t); \
            MO_READ(ard + (b) * MO_ABUF, 2 * MO_APITCH + 64, brd + (b) * MO_BBUF, 2048);     \
            G1_LOAD(SBL, SAL, (tt_ + 4 < 128 ? tt_ + 4 : 127));     \
            __builtin_amdgcn_sched_barrier(0); \
            MO_WAIT5(15, SBW, SAW); \
            if (tt_ + 1 < 128) G1_WRITE(SBW, SAW, (b) ^ 1); \
            MO_MMA(acc0, acc1); \
            if ((tt_ & 63) == 63) {     \
                const int col_ = 128 * (tt_ >> 6) + 32 * wn + 4 * (r32 & 7) + (r32 >> 3), cch_ = col_ >> 3; \
                _Pragma("unroll") for (int mt = 0; mt < 2; ++mt) _Pragma("unroll") for (int r = 0; r < 16; ++r) { const float gt = acc0[mt][r], up = acc1[mt][r]; const float hv = gt / (1.0f + __expf(-gt)) * up; \
                    *(LAS unsigned short*)(lds + mo_hoff(64 * wm + 32 * mt + crow(r, hi), cch_) + (col_ & 7) * 2) = f2bf16(hv); } \
                MO_ZERO(); } \
            __syncthreads(); } while (0)
        G1_LOAD(s0, a0, 0); G1_LOAD(s1, a1, 1); G1_LOAD(s2, a2, 2); G1_LOAD(s3, a3, 3);
        MO_WAIT5(15, s0, a0);
        G1_WRITE(s0, a0, 0);
        __syncthreads();
        for (int t = 0; t < 128; t += 4) {
            G1_STEP(t, 0, s0, a0, s1, a1);
            G1_STEP(t + 1, 1, s1, a1, s2, a2);
            G1_STEP(t + 2, 0, s2, a2, s3, a3);
            G1_STEP(t + 3, 1, s3, a3, s0, a0);
        }
        asm volatile("s_waitcnt vmcnt(0)" : "+v"(s0.v[0]), "+v"(s0.v[1]), "+v"(s0.v[2]), "+v"(s0.v[3]), "+v"(s1.v[0]), "+v"(s1.v[1]), "+v"(s1.v[2]), "+v"(s1.v[3]), "+v"(s2.v[0]), "+v"(s2.v[1]), "+v"(s2.v[2]), "+v"(s2.v[3]),
                     "+v"(s3.v[0]), "+v"(s3.v[1]), "+v"(s3.v[2]), "+v"(s3.v[3]), "+v"(a0), "+v"(a1), "+v"(a2), "+v"(a3) :: "memory");
#undef G1_LOAD
#undef G1_WRITE
#undef G1_STEP
    }
    {
        LAS const unsigned char* const hrd = lds + mo_hoff(64 * wm + r32, hi);
        LAS const unsigned char* const brd = lds + MO_B + hi * 4096 + (64 * wn + r32) * 16;
#define G2_LOAD(SB, t) do { const int t_ = (t); mo_bload(SB, wd + 256 * (t_ >> 3), wd + 256 * (t_ >> 3) + 128, D, 32 * (t_ & 7), tid); } while (0)
#define G2_STEP(t, b, SBL, SBW) do { const int tt_ = (t); \
            MO_READ(hrd + (tt_ & 7) * 8192, 4096, brd + (b) * MO_BBUF, 512); \
            G2_LOAD(SBL, (tt_ + 4 < 64 ? tt_ + 4 : 63)); \
            __builtin_amdgcn_sched_barrier(0); \
            MO_WAIT4(12, SBW); \
            if (tt_ + 1 < 64) mo_bwrite(SBW, lds + MO_B + ((b) ^ 1) * MO_BBUF, tid); \
            MO_MMA(acc0, acc1); \
            if ((tt_ & 7) == 7) {     \
                LAS unsigned char* const stg_ = lds + MO_STG + wid * 4096; const int cidx_ = 4 * (r32 & 7) + (r32 >> 3); \
                _Pragma("unroll") for (int mt = 0; mt < 2; ++mt) { \
                    _Pragma("unroll") for (int r = 0; r < 16; ++r) { const int row_ = crow(r, hi); \
                        *(LAS unsigned short*)(stg_ + row_ * 128 + cidx_ * 2) = f2bf16(acc0[mt][r]); *(LAS unsigned short*)(stg_ + row_ * 128 + (cidx_ + 32) * 2) = f2bf16(acc1[mt][r]); } \
                    _Pragma("unroll") for (int k = 0; k < 4; ++k) { const int idx_ = lane + 64 * k, row_ = idx_ >> 3, ch_ = idx_ & 7; \
                        const u32x4 v_ = *(const LAS u32x4*)(stg_ + row_ * 128 + ch_ * 16); const int rr = rowid[64 * wm + 32 * mt + row_]; \
                        if (rr >= 0) *(u32x4*)(YB + (size_t)rr * D + 256 * (tt_ >> 3) + 64 * wn + 8 * ch_) = v_; } } \
                MO_ZERO(); } \
            __syncthreads(); } while (0)
        G2_LOAD(s0, 0); G2_LOAD(s1, 1); G2_LOAD(s2, 2); G2_LOAD(s3, 3);
        MO_WAIT4(12, s0);
        mo_bwrite(s0, lds + MO_B, tid);
        __syncthreads();
        for (int t = 0; t < 64; t += 4) {
            G2_STEP(t, 0, s0, s1);
            G2_STEP(t + 1, 1, s1, s2);
            G2_STEP(t + 2, 0, s2, s3);
            G2_STEP(t + 3, 1, s3, s0);
        }
        asm volatile("s_waitcnt vmcnt(0)" : "+v"(s0.v[0]), "+v"(s0.v[1]), "+v"(s0.v[2]), "+v"(s0.v[3]), "+v"(s1.v[0]), "+v"(s1.v[1]), "+v"(s1.v[2]), "+v"(s1.v[3]), "+v"(s2.v[0]), "+v"(s2.v[1]), "+v"(s2.v[2]), "+v"(s2.v[3]),
                     "+v"(s3.v[0]), "+v"(s3.v[1]), "+v"(s3.v[2]), "+v"(s3.v[3]) :: "memory");
#undef G2_LOAD
#undef G2_STEP
    }
#undef MO_ZERO
}

constexpr int N_PHASES = 1 + 7 * DEPTH;
#ifndef PH_MASK
#define PH_MASK 0xFFFF
#endif
#define PHON(k) (((PH_MASK) >> (k)) & 1)
#ifndef DUP_MASK
#define DUP_MASK 0
#endif
#define DUPON(k) ((((DUP_MASK) >> (k)) & 1) && (l == 0 || (((0x3FE) >> (k)) & 1)))
#ifndef MK_ONE_LAUNCH
#define MK_ONE_LAUNCH 1
#endif

namespace pg8 {
struct DealOrder {
    int nM, nN, nwg, G, c, t0;
    __device__ __forceinline__ bool next(int i, Unit& u) const {
        if (t0 >= 0) { if (i > 0) return false; u.pm = nM - 1 - t0 / nN; u.pn = t0 % nN; return true; }
        const int L = i * G + c; if (L >= nwg) return false;
        const int q = nwg / NXCD, r = nwg % NXCD, xcd = L % NXCD, off = L / NXCD;
        const int wgid = (xcd < r ? xcd * (q + 1) : r * (q + 1) + (xcd - r) * q) + off;
        const int nig = WGM * nN, gid = wgid / nig, fm = gid * WGM, gsz = (nM - fm) < WGM ? (nM - fm) : WGM;
        u.pm = fm + ((wgid % nig) % gsz); u.pn = (wgid % nig) / gsz; return true;
    }
    __device__ __forceinline__ void a_ready(const Unit&) const {}
    __device__ __forceinline__ void done(const Unit&) const {}
};
}
__device__ __forceinline__ int g2_tile_pm(int L, int nM, int nN) {
    const int nwg = nM * nN, q = nwg / 8, r = nwg % 8, xcd = L % 8, off = L / 8;
    const int wgid = (xcd < r ? xcd * (q + 1) : r * (q + 1) + (xcd - r) * q) + off;
    const int nig = 8 * nN, gid = wgid / nig, fm = gid * 8, gsz = (nM - fm) < 8 ? (nM - fm) : 8;
    return fm + ((wgid % nig) % gsz);
}
__global__ void __launch_bounds__(NTHR, 2) fwd_kernel(Args args) {
    extern __shared__ __attribute__((aligned(16))) unsigned char lds_raw[];
    LAS unsigned char* lds = (LAS unsigned char*)lds_raw;
    volatile LAS unsigned* MISC = (volatile LAS unsigned*)(lds + MISC_OFF);
    const int wid = __builtin_amdgcn_readfirstlane(threadIdx.x >> 6);
    const int G = gridDim.x, bid = blockIdx.x;
    unsigned char* ws = args.ws;
    unsigned* const ctl0 = (unsigned*)(ws + WS_CTL);
    if (threadIdx.x < 64) MISC[threadIdx.x] = 0u;
    __syncthreads();
    const int lo = args.ph_lo, hi_ph = args.ph_hi;
    XcdBarrier bar; bar.bar = ctl0 + CW_BAR; bar.x = 0; bar.st = MISC + 8; bar.w0 = 0;
    if (hi_ph - lo > 1) bar = xcd_barrier_post(ctl0 + CW_BAR, MISC + 8);
#define IN(k) (lo <= (k) && (k) < hi_ph)
#define FRESH() int wid_ = wid; asm volatile("" : "+s"(wid_)); int lane_; asm volatile("v_mbcnt_lo_u32_b32 %0, -1, 0\n\tv_mbcnt_hi_u32_b32 %0, -1, %0" : "=v"(lane_)); const int tid_ = wid_ * 64 + lane_; (void)tid_
#define SEAM(k) do { if (IN(k) && IN((k) + 1)) xcd_barrier(bar); } while (0)

    const int NGW = G * NWAVES;

    if (PHON(0) && IN(0)) { FRESH(); p0_prologue(args, lds, bid, G, tid_, wid_, lane_); if ((DUP_MASK) & 1) p0_prologue(args, lds, bid, G, tid_, wid_, lane_); }
    SEAM(0);

#pragma unroll 1
    for (int lraw = 0; lraw < DEPTH; ++lraw) {
        int l = lraw; asm volatile("" : "+s"(l));
        GAS unsigned char* wsg = (GAS unsigned char*)ws; asm volatile("" : "+s"(wsg)); unsigned char* const wsl = (unsigned char*)wsg;
        unsigned* const ctl = (unsigned*)(wsl + WS_CTL);
        bf16* const WIN = (bf16*)(wsl + WS_WIN); bf16* const WOUT = (bf16*)(wsl + WS_WOUT); bf16* const W1T = (bf16*)(wsl + WS_W1T); bf16* const W2T = (bf16*)(wsl + WS_W2T); bf16* const RWT = (bf16*)(wsl + WS_RWT);
        float* const C1 = (float*)(wsl + WS_C1); bf16* const X = (bf16*)(wsl + WS_X); bf16* const XN = (bf16*)(wsl + WS_XN); bf16* const PROJ = (bf16*)(wsl + WS_PROJ); float* const AUX = (float*)(wsl + WS_AUX);
        float* const CUM = (float*)(wsl + WS_CUM); bf16* const KC = (bf16*)(wsl + WS_KC); bf16* const VC = (bf16*)(wsl + WS_VC); bf16* const MIX = (bf16*)(wsl + WS_MIX); bf16* const YB = (bf16*)(wsl + WS_YB);
        int* const LIST = (int*)(wsl + WS_LIST); float* const TW = (float*)(wsl + WS_TW);
        const int pb = 1 + 7 * l;
        if (PHON(1) && IN(pb)) {
            pg8::Gemm g{l == 0 ? XN : X, WIN + (size_t)l * NP * D, S, NP, D}; pg8::StaticOrder so; so.init(S, NP, G, bid);
            pg8::EpiProj E{PROJ, AUX, (const float*)(wsl + WS_RSTD)};
            pg8::gemm_phase<pg8::EpiProj, pg8::StaticOrder, true, true>(lds, g, so, E, wid);
            {
                const int ntile = (S / 256) * (NP / 256), rmax = (ntile + G - 1) / G, mine = (ntile - bid + G - 1) / G, nh = G * rmax - ntile;
                if (nh == 0 || mine < rmax) {
                    FRESH(); __syncthreads();
                    LAS float* const scr = (LAS float*)(lds + wid_ * 9216);
                    const int hidx = nh == 0 ? bid : bid - (G - nh), nhw = (nh == 0 ? G : nh) * NWAVES;
                    for (int j = hidx * NWAVES + wid_; j < I_L - I_WIN; j += nhw) tr_dispatch(args, (unsigned char*)wsl, l * I_L + I_WIN + j, scr, lane_);
                }
            }
            if (DUPON(1)) pg8::gemm_phase<pg8::EpiProj, pg8::StaticOrder, true, true>(lds, g, so, E, wid);
        }
        SEAM(pb);
        if (IN(pb + 2)) {
            const int x = bid & 7;
#define QHEAD(q) (ctl + CW_Q + (((l * 6 + (q)) * 8 + x) * 64))
#define ATT_PUB(panel) do { if (IN(pb + 3)) { asm volatile("s_waitcnt vmcnt(0)" ::: "memory"); __syncthreads(); \
                if (wid_ == 0) { __builtin_amdgcn_fence(__ATOMIC_RELEASE, "agent"); asm volatile("s_waitcnt vmcnt(0)" ::: "memory"); \
                    (void)__hip_atomic_fetch_add(ctl + CW_ATC + (l * 32 + (panel)) * 16, 1u, __ATOMIC_RELAXED, __HIP_MEMORY_SCOPE_AGENT); } } } while (0)
            if (PHON(2)) { FRESH(); unsigned* const pdone = ctl + CW_PD + l * 64;
                for (;;) { const int i = dequeue(ctl + CW_PQ + l * 64, MISC + 19, tid_); if (i >= 136) break;
                    if (i < 8) cumsum_unit(i, l, AUX, args.in[5], CUM, lds, tid_); else compress_unit(i - 8, l, PROJ, W1T, W2T, C1, KC, VC, lds, wid_, lane_);
                    asm volatile("s_waitcnt vmcnt(0)" ::: "memory");
                    __syncthreads();
                    if (wid_ == 0) { __builtin_amdgcn_fence(__ATOMIC_RELEASE, "agent"); asm volatile("s_waitcnt vmcnt(0)" ::: "memory"); (void)__hip_atomic_fetch_add(pdone, 1u, __ATOMIC_RELAXED, __HIP_MEMORY_SCOPE_AGENT); }
                } }
            if (PHON(4)) { FRESH(); for (;;) { const int i = dequeue(QHEAD(1), MISC + 17, tid_); if (i >= 32) break; diff_unit(x & 3, 63 - 2 * i - (x >> 2), l, args, PROJ, MIX, lds, tid_, wid_, lane_); ATT_PUB((63 - 2 * i - (x >> 2)) >> 1); }
                if (DUPON(4)) for (;;) { const int i = dequeue(QHEAD(4), MISC + 17, tid_); if (i >= 32) break; diff_unit(x & 3, 63 - 2 * i - (x >> 2), l, args, PROJ, MIX, lds, tid_, wid_, lane_); } }
            if (PHON(2)) { FRESH();
                if (tid_ == 0) { unsigned* const pdone = ctl + CW_PD + l * 64; unsigned sp = 0;
                    while (__hip_atomic_load(pdone, __ATOMIC_RELAXED, __HIP_MEMORY_SCOPE_AGENT) < 136u * 64u) { __builtin_amdgcn_s_sleep(2); if (++sp > (1u << 20)) break; }
                    __builtin_amdgcn_fence(__ATOMIC_ACQUIRE, "agent"); asm volatile("s_waitcnt vmcnt(0)" ::: "memory"); }
                __syncthreads(); }
            if (PHON(3)) { FRESH(); for (;;) { const int i = dequeue(QHEAD(0), MISC + 16, tid_); if (i >= 32) break; fox_unit(x, 31 - i, PROJ, CUM, MIX, lds, tid_, wid_, lane_); ATT_PUB(31 - i); }
                if (DUPON(3)) for (;;) { const int i = dequeue(QHEAD(3), MISC + 16, tid_); if (i >= 32) break; fox_unit(x, 31 - i, PROJ, CUM, MIX, lds, tid_, wid_, lane_); } }
            if (PHON(5)) { FRESH(); for (;;) { const int i = dequeue(QHEAD(2), MISC + 18, tid_); if (i >= 64) break; nsa_unit(x & 3, 127 - 2 * i - (x >> 2), args, PROJ, AUX, KC, VC, MIX, lds, tid_, wid_, lane_); ATT_PUB((127 - 2 * i - (x >> 2)) >> 2); }
                if (DUPON(5)) for (;;) { const int i = dequeue(QHEAD(5), MISC + 18, tid_); if (i >= 64) break; nsa_unit(x & 3, 127 - 2 * i - (x >> 2), args, PROJ, AUX, KC, VC, MIX, lds, tid_, wid_, lane_); } }
#undef QHEAD
#undef ATT_PUB
        }
        if (!(IN(pb + 2) && IN(pb + 3))) SEAM(pb + 2);
        if (PHON(6) && IN(pb + 3)) {
            pg8::Gemm g{MIX, WOUT + (size_t)l * D * D, S, D, D};
            constexpr int G2_NM = S / 256, G2_NN = D / 256, G2_NT = G2_NM * G2_NN;
            pg8::DealOrder so; so.nM = G2_NM; so.nN = G2_NN; so.nwg = G2_NT; so.G = G; so.c = bid; so.t0 = -1;
            if (IN(pb + 2)) {
                FRESH();
                if (G == G2_NT) so.t0 = dequeue(ctl + CW_G2Q + l * 64, MISC + 20, tid_);
                if (tid_ == 0) { unsigned sp = 0;
                    for (int L_ = bid; L_ < G2_NT; L_ += G) { const int pm_ = so.t0 >= 0 ? G2_NM - 1 - so.t0 / G2_NN : g2_tile_pm(L_, G2_NM, G2_NN); unsigned* const pc = ctl + CW_ATC + (l * 32 + pm_) * 16;
                        while (__hip_atomic_load(pc, __ATOMIC_RELAXED, __HIP_MEMORY_SCOPE_AGENT) < 32u * 64u) { __builtin_amdgcn_s_sleep(1); if (++sp > (1u << 20)) break; } }
                    __builtin_amdgcn_fence(__ATOMIC_ACQUIRE, "agent"); asm volatile("s_waitcnt vmcnt(0)" ::: "memory"); }
                __syncthreads();
            }
            pg8::EpiRes E{nullptr, l == 0 ? XN : X, X};
            pg8::gemm_phase<pg8::EpiRes, pg8::DealOrder, true, true>(lds, g, so, E, wid);
            if (DUPON(6)) { pg8::StaticOrder sos; sos.init(S, D, G, bid); pg8::EpiRes E2{nullptr, X, YB}; pg8::gemm_phase<pg8::EpiRes, pg8::StaticOrder, true, true>(lds, g, sos, E2, wid); }
            if (IN(pb + 4)) {
                const int t0_ = so.t0;
                asm volatile("s_waitcnt vmcnt(0)" ::: "memory");
                __syncthreads();
                FRESH();
                if (wid_ == 0) { __builtin_amdgcn_fence(__ATOMIC_RELEASE, "agent"); asm volatile("s_waitcnt vmcnt(0)" ::: "memory");
                    for (int L_ = bid; L_ < G2_NT; L_ += G) { const int pm_ = t0_ >= 0 ? G2_NM - 1 - t0_ / G2_NN : g2_tile_pm(L_, G2_NM, G2_NN);
                        (void)__hip_atomic_fetch_add(ctl + CW_G2C + (l * 32 + pm_) * 16, 1u, __ATOMIC_RELAXED, __HIP_MEMORY_SCOPE_AGENT); } }
            }
        }
        if (!(IN(pb + 3) && IN(pb + 4))) SEAM(pb + 3);
        if (PHON(7) && IN(pb + 4)) {
            FRESH();
            for (int p = bid; p < S / 32; p += G) {
                if (IN(pb + 3)) {
                    if (tid_ == 0) { unsigned* const pc = ctl + CW_G2C + (l * 32 + (p >> 3)) * 16; unsigned sp = 0;
                        while (__hip_atomic_load(pc, __ATOMIC_RELAXED, __HIP_MEMORY_SCOPE_AGENT) < (unsigned)(D / 256) * 64u) { __builtin_amdgcn_s_sleep(1); if (++sp > (1u << 20)) break; }
                        __builtin_amdgcn_fence(__ATOMIC_ACQUIRE, "agent"); asm volatile("s_waitcnt vmcnt(0)" ::: "memory"); }
                    __syncthreads();
                }
                n2_pair(p, l, args, X, XN, RWT, ctl + CW_CNT + l * 1024, LIST, TW, lds, tid_, wid_, lane_);
            }
            if (DUPON(7)) for (int u = bid; u < S / 16; u += G) n2_unit(u, l, args, X, XN, RWT, ctl + CW_CNT + (4 + l) * 1024, (int*)MIX, (float*)(MIX + 8 * 1024 * 1024), lds, tid_, wid_, lane_);
        }
        SEAM(pb + 4);
        if (PHON(8) && IN(pb + 5)) {
            FRESH();
            LAS int* pre = (LAS int*)(lds + MO_PRE);
            if (tid_ < 64) pre[tid_] = ((int)__hip_atomic_load(ctl + CW_CNT + l * 1024 + tid_ * 16, __ATOMIC_RELAXED, __HIP_MEMORY_SCOPE_AGENT) + 127) >> 7;
            __syncthreads();
            const int x = bid & 7, per = G >> 3;
            for (int rep = 0; rep < (DUPON(8) ? 2 : 1); ++rep)
            for (int slot = bid >> 3; ; slot += per) {
                int e = -1, c = 0, acc = 0;
                for (int k = 0; k < 8; ++k) { const int ee = x + 8 * k, n = pre[ee]; if (e < 0 && slot < acc + n) { e = ee; c = slot - acc; } acc += n; }
                if (e < 0) break;
                e = __builtin_amdgcn_readfirstlane(e); c = __builtin_amdgcn_readfirstlane(c);
                const int c0 = c * 128; const int cnt_e = (int)__hip_atomic_load(ctl + CW_CNT + l * 1024 + e * 16, __ATOMIC_RELAXED, __HIP_MEMORY_SCOPE_AGENT);
                const int nrows = (cnt_e - c0) < 128 ? (cnt_e - c0) : 128;
                moe_unit(e, c0, nrows, XN, LIST, args.in[19] + (size_t)l * 64 * D * 256, args.in[20] + (size_t)l * 64 * D * 256, args.in[21] + (size_t)l * 64 * 256 * D, YB, lds, tid_, wid_, lane_);
            }
        }
        SEAM(pb + 5);
        if (PHON(9) && IN(pb + 6)) {
            FRESH(); const int gw_ = bid * NWAVES + wid_;
            if (l + 1 < DEPTH) {
                norm_rows<1>(nullptr, X, X, XN, YB, TW, args.in[1] + (size_t)(l + 1) * D, nullptr, (float*)(wsl + WS_RSTD), gw_, NGW, lane_);
                if (DUPON(9)) norm_rows<1>(nullptr, X, PROJ, MIX, YB, TW, args.in[1] + (size_t)(l + 1) * D, nullptr, (float*)MIX, gw_, NGW, lane_);
            } else norm_rows<2>(nullptr, X, nullptr, nullptr, YB, TW, args.in[22], args.out, nullptr, gw_, NGW, lane_);
        }
        if (l + 1 < DEPTH) SEAM(pb + 6);
    }
#undef IN
#undef SEAM
}

extern "C" void kernel_launch(void* const* d_in, const int* in_sizes, int n_in, void* d_out, int out_size, void* d_ws, size_t ws_size, hipStream_t stream) {
    static int grid = 0;
    if (grid == 0) {
        if (n_in != 23 || ws_size < WS_END || out_size != S * D) { fprintf(stderr, "kernel_launch: unexpected problem (n_in %d, out %d, ws %zu)\n", n_in, out_size, ws_size); grid = -1; return; }
        int dev = 0, cus = 0, per_cu = 0;
        if (hipGetDevice(&dev) != hipSuccess || hipDeviceGetAttribute(&cus, hipDeviceAttributeMultiprocessorCount, dev) != hipSuccess) { grid = -1; return; }
        if (hipFuncSetAttribute((const void*)fwd_kernel, hipFuncAttributeMaxDynamicSharedMemorySize, LDS_BYTES) != hipSuccess) { fprintf(stderr, "kernel_launch: hipFuncSetAttribute failed\n"); grid = -1; return; }
        if (hipOccupancyMaxActiveBlocksPerMultiprocessor(&per_cu, (const void*)fwd_kernel, NTHR, LDS_BYTES) != hipSuccess || per_cu < 1) fprintf(stderr, "kernel_launch: occupancy query says %d blocks per CU\n", per_cu);
        (void)hipGetLastError();
        grid = cus;
        if (grid < 136) { fprintf(stderr, "kernel_launch: too few CUs (%d)\n", grid); }
    }
    if (grid < 0) return;
    if (hipMemsetAsync((char*)d_ws + WS_CTL, 0, CTL_ZERO_BYTES, stream) != hipSuccess) { fprintf(stderr, "kernel_launch: memset failed\n"); return; }
    Args a{};
    for (int i = 0; i < 23; ++i) a.in[i] = (const float*)d_in[i];
    a.out = (float*)d_out; a.ws = (unsigned char*)d_ws;
#if MK_ONE_LAUNCH
    a.ph_lo = 0; a.ph_hi = N_PHASES;
    hipLaunchKernelGGL(fwd_kernel, dim3(grid), dim3(NTHR), LDS_BYTES, stream, a);
#else
    for (int p = 0; p < N_PHASES; ++p) { a.ph_lo = p; a.ph_hi = p + 1; hipLaunchKernelGGL(fwd_kernel, dim3(grid), dim3(NTHR), LDS_BYTES, stream, a); }
#endif
    const hipError_t le = hipPeekAtLastError();
    if (le != hipSuccess) fprintf(stderr, "kernel_launch: launch failed: %s\n", hipGetErrorName(le));
}
```
